# Optimizing an MI355X kernel written in HIP

```python
import jax, jax.numpy as jnp
from jax import lax
import numpy as np

D_MODEL = 1024
BATCH = 1
SEQ = 16384
DEPTH = 2

GRID_W = 64
CTX_LEN = 256
D_MIX = D_MODEL

HGRN_WIDTH = D_MIX // 2
HGRN_HEADS = 4
HGRN_DK = HGRN_WIDTH // HGRN_HEADS
HGRN_DV = HGRN_WIDTH // HGRN_HEADS
HGRN_CHUNK = 64
GATE_FLOOR = 1e-30
POOL_WIDTH = D_MIX // 4
POOL_WINDOWS = (2, 4, 8, 16)
POOL_GROUP = POOL_WIDTH // len(POOL_WINDOWS)
FOURIER_WIDTH = D_MIX - HGRN_WIDTH - POOL_WIDTH
FOURIER_HEADS = 4
FOURIER_HEAD_DIM = FOURIER_WIDTH // FOURIER_HEADS
A4 = 4 * HGRN_WIDTH
A5 = 5 * HGRN_WIDTH
P_END = A5 + POOL_WIDTH
D_IN = P_END + FOURIER_WIDTH
N_EXPERTS = 32
TOP_K = 4
D_EXPERT = D_MODEL
SWIGLU_LIMIT = 7.0
SWIGLU_ALPHA = 1.702
EPS = 1e-6

kernel_name = 'hybrid_hgrn2_pool_fourier_moe_dit'


def rmsnorm(x, g):
    x32 = x.astype(jnp.float32)
    y = x32 * lax.rsqrt(jnp.mean(x32 * x32, axis=-1, keepdims=True) + EPS)
    return (y * g.astype(jnp.float32)).astype(x.dtype)


def modulate(x, g, shift, scale):
    return rmsnorm(x, g) * (1 + scale) + shift


def hgrn2_scan(q, k, log_f, v, s0):
    B, L, H, K = q.shape
    C = HGRN_CHUNK
    nc = L // C

    def to_chunks(t):
        return t.reshape(B, nc, C, H, t.shape[-1]).transpose(1, 0, 3, 2, 4)

    order = (jnp.arange(C)[:, None] >= jnp.arange(C)[None, :])[:, :, None]

    def step(S, inp):
        qc, kc, lfc, vc = inp
        b = jnp.cumsum(lfc, axis=-2)
        o_inter = jnp.einsum('bhtk,bhkv->bhtv', qc * jnp.exp(b), S)
        diff = b[..., :, None, :] - b[..., None, :, :]
        decay = jnp.where(order, jnp.exp(jnp.where(order, diff, 0.0)), 0.0)
        scores = jnp.einsum('bhtk,bhtsk,bhsk->bhts', qc, decay, kc)
        o = o_inter + jnp.einsum('bhts,bhsv->bhtv', scores, vc)
        b_last = b[..., -1:, :]
        S = jnp.exp(b_last[..., 0, :])[..., None] * S + jnp.einsum(
            'bhsk,bhsv->bhkv', kc * jnp.exp(b_last - b), vc)
        return S, o

    S, o = lax.scan(step, s0, (to_chunks(q), to_chunks(k), to_chunks(log_f), to_chunks(v)))
    o = o.transpose(1, 0, 3, 2, 4).reshape(B, L, H, v.shape[-1])
    return o, S


def hgrn2_bidirectional(p, lb, s0_fwd, s0_bwd):
    B, L, _ = p.shape
    q, f_fwd, f_bwd, v = jnp.split(p.astype(jnp.float32), 4, axis=-1)

    def heads(t):
        return t.reshape(B, L, HGRN_HEADS, -1)

    q = heads(jax.nn.silu(q))
    v = heads(v)

    def gates(f_pre, lb_dir):
        f = lb_dir + (1.0 - lb_dir) * jax.nn.sigmoid(f_pre)
        log_f = jnp.log(jnp.maximum(f, GATE_FLOOR))
        k = (1.0 - lb_dir) * jax.nn.sigmoid(-f_pre)
        return heads(log_f), heads(k)

    lf_f, k_f = gates(f_fwd, lb[0])
    lf_b, k_b = gates(f_bwd, lb[1])
    o_f, s_f = hgrn2_scan(q, k_f, lf_f, v, s0_fwd)

    def rev(t):
        return jnp.flip(t, axis=1)

    o_b, s_b = hgrn2_scan(rev(q), rev(k_b), rev(lf_b), rev(v), s0_bwd)
    return o_f + rev(o_b), s_f, s_b


def hgrn2_readout(o, g, norm_g):
    B, L = g.shape[:2]
    y = rmsnorm(o, norm_g).reshape(B, L, HGRN_WIDTH)
    return (y * jax.nn.sigmoid(g.astype(jnp.float32))).astype(g.dtype)


def box_mean(x, axis, w):
    n = x.shape[axis]
    lo = w // 2
    hi = w - 1 - lo
    x32 = jnp.moveaxis(x.astype(jnp.float32), axis, 0)
    cs = jnp.concatenate([jnp.zeros_like(x32[:1]), jnp.cumsum(x32, axis=0)], axis=0)
    idx = jnp.arange(n)
    upper = jnp.minimum(idx + hi + 1, n)
    lower = jnp.maximum(idx - lo, 0)
    count = (upper - lower).astype(jnp.float32).reshape((n,) + (1,) * (x32.ndim - 1))
    mean = (cs[upper] - cs[lower]) / count
    return jnp.moveaxis(mean, 0, axis).astype(x.dtype)


def pool_mixer(u, w, scale, grid):
    B, L, _ = u.shape
    outs = []
    for gi, win in enumerate(POOL_WINDOWS):
        ug = u[..., gi * POOL_GROUP:(gi + 1) * POOL_GROUP]
        if grid:
            rows = L // GRID_W
            gu = ug.reshape(B, rows, GRID_W, POOL_GROUP)
            pooled = box_mean(box_mean(gu, 1, win), 2, win).reshape(B, L, POOL_GROUP)
        else:
            pooled = box_mean(ug, 1, win)
        outs.append((pooled - ug) @ w[gi])
    return jnp.concatenate(outs, axis=-1) * scale


def fourier_mixer(u, w):
    B, L, _ = u.shape
    uh = u.astype(jnp.float32).reshape(B, L, FOURIER_HEADS, FOURIER_HEAD_DIM)
    mixed = jnp.fft.fftn(uh, axes=(1, 3), norm='ortho').real.reshape(B, L, FOURIER_WIDTH)
    return mixed.astype(u.dtype) @ w


def token_mix(p, o, grid, hgrn_norm_g, pool_w, pool_scale, fourier_w, w_out):
    a = hgrn2_readout(o, p[..., A4:A5], hgrn_norm_g)
    b = pool_mixer(p[..., A5:P_END], pool_w, pool_scale, grid)
    f = fourier_mixer(p[..., P_END:], fourier_w)
    return jnp.concatenate([a, b, f], axis=-1) @ w_out


def moe(h, router_w, router_b, w_gate_up, b_gate_up, w_down, b_down):
    shape = h.shape
    t = h.reshape(-1, shape[-1])
    logits = (t @ router_w).astype(jnp.float32) + router_b.astype(jnp.float32)
    top_vals, top_idx = lax.top_k(logits, TOP_K)
    weights = jax.nn.softmax(top_vals, axis=-1)
    combine = jnp.sum(jax.nn.one_hot(top_idx, N_EXPERTS, dtype=jnp.float32) * weights[..., None], axis=1)
    out = jnp.zeros(t.shape, jnp.float32)
    for e in range(N_EXPERTS):
        gu = t @ w_gate_up[e] + b_gate_up[e]
        gate = jnp.minimum(gu[:, :D_EXPERT], SWIGLU_LIMIT)
        up = jnp.clip(gu[:, D_EXPERT:], -SWIGLU_LIMIT, SWIGLU_LIMIT)
        y = ((up + 1) * (gate * jax.nn.sigmoid(SWIGLU_ALPHA * gate))) @ w_down[e] + b_down[e]
        out = out + combine[:, e:e + 1] * y.astype(jnp.float32)
    return out.astype(h.dtype).reshape(shape)


def setup_inputs(seed: int = 0) -> dict:
    key = jax.random.key(seed)
    ks = jax.random.split(key, 24)
    nrm = jax.random.normal
    return {
        'x': nrm(ks[0], (BATCH, SEQ, D_MODEL)),
        'c': nrm(ks[1], (BATCH, D_MODEL)),
        'ctx': nrm(ks[2], (BATCH, CTX_LEN, D_MODEL)),
        'c_ctx': nrm(ks[3], (D_MODEL,)),
        'w_ada': nrm(ks[4], (DEPTH, D_MODEL, 6 * D_MODEL)) * (0.5 * D_MODEL ** -0.5),
        'b_ada': 0.01 * nrm(ks[5], (DEPTH, 6 * D_MODEL)),
        'norm1_g': 1.0 + 0.1 * nrm(ks[6], (DEPTH, D_MODEL)),
        'norm2_g': 1.0 + 0.1 * nrm(ks[7], (DEPTH, D_MODEL)),
        'w_in': nrm(ks[8], (DEPTH, D_MODEL, D_IN)) * D_MODEL ** -0.5,
        'hgrn_lb_param': 0.5 * nrm(ks[9], (DEPTH, 2, HGRN_WIDTH)),
        'hgrn_norm_g': 1.0 + 0.1 * nrm(ks[10], (DEPTH, HGRN_HEADS, HGRN_DV)),
        'pool_w': nrm(ks[11], (DEPTH, len(POOL_WINDOWS), POOL_GROUP, POOL_GROUP)) * POOL_GROUP ** -0.5,
        'pool_scale': 1.0 + 0.1 * nrm(ks[12], (DEPTH, POOL_WIDTH)),
        'fourier_w': nrm(ks[13], (DEPTH, FOURIER_WIDTH, FOURIER_WIDTH)) * FOURIER_WIDTH ** -0.5,
        'w_out': nrm(ks[14], (DEPTH, D_MIX, D_MODEL)) * D_MIX ** -0.5,
        'router_w': nrm(ks[15], (DEPTH, D_MODEL, N_EXPERTS)) * D_MODEL ** -0.5,
        'router_b': 0.01 * nrm(ks[16], (DEPTH, N_EXPERTS)),
        'w_gate_up': nrm(ks[17], (DEPTH, N_EXPERTS, D_MODEL, 2 * D_EXPERT)) * D_MODEL ** -0.5,
        'b_gate_up': 0.01 * nrm(ks[18], (DEPTH, N_EXPERTS, 2 * D_EXPERT)),
        'w_down': nrm(ks[19], (DEPTH, N_EXPERTS, D_EXPERT, D_MODEL)) * D_EXPERT ** -0.5,
        'b_down': 0.01 * nrm(ks[20], (DEPTH, N_EXPERTS, D_MODEL)),
        'final_norm_g': 1.0 + 0.1 * nrm(ks[21], (D_MODEL,)),
    }


def reference(x, c, ctx, c_ctx, w_ada, b_ada, norm1_g, norm2_g, w_in, hgrn_lb_param,
              hgrn_norm_g, pool_w, pool_scale, fourier_w, w_out, router_w, router_b,
              w_gate_up, b_gate_up, w_down, b_down, final_norm_g):
    sm = jax.nn.softmax(hgrn_lb_param.astype(jnp.float32), axis=0)
    lb_all = jnp.cumsum(sm, axis=0) - sm[0]

    x_lat, x_ctx = x, ctx
    ctx_len = ctx.shape[1]
    for l in range(DEPTH):
        last = l == DEPTH - 1
        mod = jax.nn.silu(c) @ w_ada[l] + b_ada[l]
        mod_c = jax.nn.silu(c_ctx) @ w_ada[l] + b_ada[l]
        sh1, sc1, gt1, sh2, sc2, gt2 = jnp.split(mod[:, None, :], 6, axis=-1)
        csh1, csc1, cgt1, csh2, csc2, cgt2 = jnp.split(mod_c, 6)

        p = modulate(x_lat, norm1_g[l], sh1, sc1) @ w_in[l]
        pc = modulate(x_ctx, norm1_g[l], csh1, csc1) @ w_in[l]
        s0 = jnp.zeros((pc.shape[0], HGRN_HEADS, HGRN_DK, HGRN_DV), jnp.float32)
        o_ctx, s_fwd, s_bwd = hgrn2_bidirectional(pc[..., :A4], lb_all[l], s0, s0)
        o_lat, _, _ = hgrn2_bidirectional(p[..., :A4], lb_all[l], s_fwd, s_bwd)
        x_lat = x_lat + gt1 * token_mix(p, o_lat, True, hgrn_norm_g[l], pool_w[l],
                                        pool_scale[l], fourier_w[l], w_out[l])
        h2 = modulate(x_lat, norm2_g[l], sh2, sc2)

        if last:
            x_lat = x_lat + gt2 * moe(h2, router_w[l], router_b[l], w_gate_up[l],
                                      b_gate_up[l], w_down[l], b_down[l])
        else:
            x_ctx = x_ctx + cgt1 * token_mix(pc, o_ctx, False, hgrn_norm_g[l], pool_w[l],
                                             pool_scale[l], fourier_w[l], w_out[l])
            h2c = modulate(x_ctx, norm2_g[l], csh2, csc2)
            y = moe(jnp.concatenate([h2c, h2], axis=1), router_w[l], router_b[l],
                    w_gate_up[l], b_gate_up[l], w_down[l], b_down[l])
            x_ctx = x_ctx + cgt2 * y[:, :ctx_len]
            x_lat = x_lat + gt2 * y[:, ctx_len:]

    return rmsnorm(x_lat, final_norm_g)
```

```cpp
#include <hip/hip_runtime.h>
#include <cstdio>
#include <cstdint>
#define DUP -1
constexpr int D = 1024, LAT = 16384, CTX = 256, T = LAT + CTX, DIN = 3072, NE = 32, TOPK = 4;
constexpr int GW = 64;
#ifndef PSTR
#define PSTR DIN
#endif
constexpr int DINX = 3328, FQ_OFF = 2816;
#define GAS __attribute__((address_space(1)))
#define LAS __attribute__((address_space(3)))
typedef unsigned short bf16_t;
typedef short bf16x8 __attribute__((ext_vector_type(8)));
typedef short bf16x4 __attribute__((ext_vector_type(4)));
typedef float f32x4 __attribute__((ext_vector_type(4)));
typedef float f32x2 __attribute__((ext_vector_type(2)));
typedef unsigned u32x4 __attribute__((ext_vector_type(4)));
typedef unsigned u32x2 __attribute__((ext_vector_type(2)));
typedef GAS unsigned gu32;
#define RLX_AGENT __ATOMIC_RELAXED, __HIP_MEMORY_SCOPE_AGENT
#define LDS_WAIT() asm volatile("s_waitcnt lgkmcnt(0)" ::: "memory")
#define VM_WAIT() asm volatile("s_waitcnt vmcnt(0)" ::: "memory")
__device__ __forceinline__ unsigned f2bf(float f) { unsigned u = __builtin_bit_cast(unsigned, f); return (u + 0x7fffu + ((u >> 16) & 1u)) >> 16; }
__device__ __forceinline__ unsigned pk2(float lo, float hi) { return f2bf(lo) | (f2bf(hi) << 16); }
__device__ __forceinline__ float bf2f(unsigned short b) { return __builtin_bit_cast(float, ((unsigned)b) << 16); }
__device__ __forceinline__ float bflo(unsigned w) { return __builtin_bit_cast(float, w << 16); }
__device__ __forceinline__ float bfhi(unsigned w) { return __builtin_bit_cast(float, w & 0xffff0000u); }
__device__ __forceinline__ unsigned cvt_pk_bf16(float lo, float hi) { unsigned r; asm volatile("v_cvt_pk_bf16_f32 %0, %1, %2" : "=v"(r) : "v"(lo), "v"(hi)); return r; }
__device__ __forceinline__ float fsigm(float x) { return __builtin_amdgcn_rcpf(1.f + __builtin_amdgcn_exp2f(-1.44269504f * x)); }
__device__ __forceinline__ float lane_xor(float v, int m, int lane) { return __builtin_bit_cast(float, __builtin_amdgcn_ds_bpermute((lane ^ m) << 2, __builtin_bit_cast(int, v))); }
__device__ __forceinline__ int lane_get(int v, int src) { return __builtin_amdgcn_ds_bpermute(src << 2, v); }
__device__ __forceinline__ float wave_sum(float v, int lane) {
#pragma unroll
    for (int o = 1; o < 64; o <<= 1) v += lane_xor(v, o, lane);
    return v;
}

#define XB_TMO      128
#define XB_XCNT(j)  (256  + 64 * (j))
#define XB_XSUB(j)  (1280 + 64 * (j))
#define XB_XGEN(j)  (2304 + 64 * (j))
#define XB_TOP      3328
#define XB_TOPGEN   3392
#define XCD_BAR_WORDS 3456
#define XB_SPIN_CAP (1u << 18)
__device__ __forceinline__ unsigned xb_ld(unsigned* p)              { return __hip_atomic_load(p, __ATOMIC_RELAXED, __HIP_MEMORY_SCOPE_AGENT); }
__device__ __forceinline__ unsigned xb_add(unsigned* p, unsigned v) { return __hip_atomic_fetch_add(p, v, __ATOMIC_RELAXED, __HIP_MEMORY_SCOPE_AGENT); }
__device__ __forceinline__ unsigned xb_xcc_id() { return (unsigned)__builtin_amdgcn_s_getreg((3 << 11) | 20) & 0xFu; }
#define XB_SPIN(cond, bar) do { unsigned _sp = 0; while (cond) { __builtin_amdgcn_s_sleep(1); \
    if ((++_sp & 255u) == 0u) { if (xb_ld(&(bar)[XB_TMO])) break; if (_sp > XB_SPIN_CAP) { atomicAdd(&(bar)[XB_TMO], 1u); break; } } } } while (0)
struct XcdBarrier { unsigned* bar; unsigned x; volatile LAS unsigned* st; };
__device__ __forceinline__ XcdBarrier xcd_barrier_post(unsigned* bar, volatile LAS unsigned* st) {
    XcdBarrier b; b.bar = bar; b.x = xb_xcc_id(); b.st = st;
    if (threadIdx.x == 0) (void)xb_add(&bar[XB_XCNT(b.x)], 1u);
    return b;
}
__device__ __forceinline__ void xcd_barrier_complete(unsigned* bar, unsigned x, unsigned& nloc, unsigned& nx) {
    const unsigned G = gridDim.x * gridDim.y * gridDim.z;
    unsigned sum, cnt, mine, sp = 0u;
    for (;;) {
        sum = 0u; cnt = 0u; mine = 0u;
#pragma unroll
        for (unsigned j = 0; j < 16; ++j) { const unsigned c = xb_ld(&bar[XB_XCNT(j)]); sum += c; cnt += (c > 0u) ? 1u : 0u; mine = (j == x) ? c : mine; }
        if (sum == G) break;
        __builtin_amdgcn_s_sleep(1);
        if ((++sp & 255u) == 0u) { if (xb_ld(&bar[XB_TMO])) break; if (sp > XB_SPIN_CAP) { atomicAdd(&bar[XB_TMO], 1u); break; } }
    }
    nloc = mine > 0u ? mine : 1u; nx = cnt > 0u ? cnt : 1u;
}
__device__ __forceinline__ void xcd_barrier(const XcdBarrier& b, const int tid) {
    asm volatile("s_waitcnt vmcnt(0)" ::: "memory");
    unsigned blo = (unsigned)(unsigned long long)b.bar, bhi = (unsigned)((unsigned long long)b.bar >> 32), bx = b.x;
    asm volatile("" : "+s"(blo), "+s"(bhi), "+s"(bx));
    __syncthreads();
    if (tid == 0) {
        unsigned* bar = (unsigned*)(((unsigned long long)bhi << 32) | blo);
        __builtin_amdgcn_s_waitcnt(0);
        unsigned nloc = b.st[0], nx = b.st[1];
        if (nloc == 0u) { xcd_barrier_complete(bar, bx, nloc, nx); b.st[0] = nloc; b.st[1] = nx; }
        const unsigned old = xb_add(&bar[XB_XSUB(bx)], 1u);
        const unsigned gen = old / nloc;
        if (old + 1u == (gen + 1u) * nloc) {
            __builtin_amdgcn_fence(__ATOMIC_RELEASE, "agent");
            asm volatile("s_waitcnt vmcnt(0)" ::: "memory");
            const unsigned og = xb_add(&bar[XB_TOP], 1u);
            const unsigned tg = og / nx;
            if (og + 1u == (tg + 1u) * nx) xb_add(&bar[XB_TOPGEN], 1u);
            else XB_SPIN(xb_ld(&bar[XB_TOPGEN]) == tg, bar);
            __builtin_amdgcn_fence(__ATOMIC_ACQUIRE, "agent");
            xb_add(&bar[XB_XGEN(bx)], 1u);
            asm volatile("s_waitcnt vmcnt(0)" ::: "memory");
        } else {
            XB_SPIN(xb_ld(&bar[XB_XGEN(bx)]) == gen, bar);
            __builtin_amdgcn_fence(__ATOMIC_ACQUIRE, "agent");
            asm volatile("s_waitcnt vmcnt(0)" ::: "memory");
        }
    }
    __syncthreads();
}

namespace pg8 {
constexpr int BM = 256, BK = 64, HALF = 128, HTB = HALF * BK * 2, STAGE_BYTES = 8 * HTB, NXCD = 8, WGM = 8;
__host__ __device__ __forceinline__ int lds_byte(int r, int c) { const int st = (r >> 4) * 2 + (c >> 5), rr = r & 15, cc = c & 31, ob = rr * 64 + cc * 2; return st * 1024 + (ob ^ (((ob >> 9) & 1) << 5)); }
__host__ __device__ __forceinline__ void stage_rc(int b, int& R, int& C) { const int st = b / 1024, sb = b % 1024, swz = sb ^ (((sb >> 9) & 1) << 5); R = (st >> 1) * 16 + swz / 64; C = (st & 1) * 32 + (swz % 64) / 2; }
__host__ __device__ __forceinline__ int perm32(int rho) { const int n = rho >> 4, i = rho & 15; return 8 * (i >> 2) + 4 * n + (i & 3); }

struct Unit { int pm, pn, e, ui; };

template <class Epi, class Sched, bool ALIGN_EPI = true>
__device__ __forceinline__ void gemm_phase(LAS unsigned char* lds, const char* gA, const int K, const Sched& S, const Epi& E, const int tid) {
    const int wid = __builtin_amdgcn_readfirstlane(tid >> 6), lane = tid & 63, wr = wid >> 2, wc = wid & 3, fr = lane & 15, fq = lane >> 4;
    const int nt = K / BK;
    int Ra[2], Ca[2]; unsigned voffB[2];
#pragma unroll
    for (int i = 0; i < 2; ++i) { int R, C; stage_rc(tid * 16 + i * 8192, R, C); const int Rb = Epi::PERM ? ((R & ~31) + perm32(R & 31)) : R;
        Ra[i] = R; Ca[i] = C * 2; voffB[i] = (unsigned)(Rb * K + C) * 2u; }
    const size_t kstep = (size_t)(BK * 2);
    const size_t hstep = (size_t)HALF * K * 2;
    const unsigned ldsw = (unsigned)wid * 1024u;
    const int aoff = lds_byte(wr * 64 + fr, fq * 8), boff = lds_byte(wc * 32 + fr, fq * 8);
#define PG8_SA(b, h) (((b) * 2 + (h)) * HTB)
#define PG8_SB(b, h) ((4 + (b) * 2 + (h)) * HTB)
#define PG8_STAGE(bufoff, gbase, voff) do { _Pragma("unroll") for (int _i = 0; _i < 2; ++_i) \
        __builtin_amdgcn_global_load_lds((const unsigned*)((const char*)(gbase) + (voff)[_i]), (LAS unsigned*)(lds + (bufoff) + ldsw + _i * 8192), 16, 0, 0); } while (0)
#define PG8_LDA(dst, b, h) do { _Pragma("unroll") for (int m = 0; m < 4; ++m) _Pragma("unroll") for (int k = 0; k < 2; ++k) dst[m][k] = *(const LAS bf16x8*)(lds + PG8_SA(b, h) + aoff + m * 2048 + k * 1024); } while (0)
#define PG8_LDB(dst, b, h) do { _Pragma("unroll") for (int n = 0; n < 2; ++n) _Pragma("unroll") for (int k = 0; k < 2; ++k) dst[n][k] = *(const LAS bf16x8*)(lds + PG8_SB(b, h) + boff + n * 2048 + k * 1024); } while (0)
#define PG8_MMA(ai, bj, At, Bt) do { __builtin_amdgcn_s_setprio(1); _Pragma("unroll") for (int m = 0; m < 4; ++m) _Pragma("unroll") for (int n = 0; n < 2; ++n) _Pragma("unroll") for (int k = 0; k < 2; ++k) \
        acc[ai][bj][m][n] = __builtin_amdgcn_mfma_f32_16x16x32_bf16(Bt[n][k], At[m][k], acc[ai][bj][m][n], 0, 0, 0); __builtin_amdgcn_s_setprio(0); } while (0)
#define PG8_WAIT_V(n) asm volatile("s_waitcnt vmcnt(" #n ")" ::: "memory")
#define PG8_WAIT_L(n) asm volatile("s_waitcnt lgkmcnt(" #n ")" ::: "memory")
#define PG8_BAR __builtin_amdgcn_s_barrier()
#define PG8_SCHED __builtin_amdgcn_sched_barrier(0)
    Unit cur, nxt; int ui = 0;
    if (!S.next(0, cur)) return;
    f32x4 acc[2][2][4][2];
#pragma unroll
    for (int a = 0; a < 2; ++a)
#pragma unroll
        for (int b = 0; b < 2; ++b)
#pragma unroll
            for (int m = 0; m < 4; ++m)
#pragma unroll
                for (int n = 0; n < 2; ++n) acc[a][b][m][n] = (f32x4){0.f, 0.f, 0.f, 0.f};
    bf16x8 At[4][2], B0[2][2], B1[2][2];
    unsigned vA[2][2], vN[2][2];
#pragma unroll
    for (int h = 0; h < 2; ++h)
#pragma unroll
        for (int i = 0; i < 2; ++i) vA[h][i] = S.a_row_off(cur, h * HALF + Ra[i]) + (unsigned)Ca[i];
    const char* cB = S.b_tile(cur);
    PG8_STAGE(PG8_SB(0, 0), cB, voffB); PG8_STAGE(PG8_SB(0, 1), cB + hstep, voffB); PG8_STAGE(PG8_SA(0, 0), gA, vA[0]); PG8_STAGE(PG8_SA(0, 1), gA, vA[1]);
    if (wr == 1) PG8_BAR;
    PG8_WAIT_V(2); PG8_BAR;
    PG8_STAGE(PG8_SB(1, 0), cB + kstep, voffB); PG8_STAGE(PG8_SA(1, 0), gA + kstep, vA[0]); PG8_STAGE(PG8_SB(1, 1), cB + hstep + kstep, voffB);
    PG8_WAIT_V(6); PG8_BAR;
    for (;;) {
        const bool has_next = S.next(ui + 1, nxt);
        const char* nB = has_next ? S.b_tile(nxt) : cB;
        for (int t = 0; t < nt; t += 2) {
            const bool last = (t == nt - 2);
            if (last) {
                if (has_next) {
#pragma unroll
                    for (int h = 0; h < 2; ++h)
#pragma unroll
                        for (int i = 0; i < 2; ++i) vN[h][i] = S.a_row_off(nxt, h * HALF + Ra[i]) + (unsigned)Ca[i];
                } else {
#pragma unroll
                    for (int h = 0; h < 2; ++h)
#pragma unroll
                        for (int i = 0; i < 2; ++i) vN[h][i] = vA[h][i];
                }
                PG8_WAIT_L(0);
            }
            unsigned x2[2][2];
#pragma unroll
            for (int h = 0; h < 2; ++h)
#pragma unroll
                for (int i = 0; i < 2; ++i) x2[h][i] = last ? vN[h][i] : vA[h][i];
            const char* a1 = gA + (size_t)(t + 1) * kstep;
            const char* a2 = last ? gA : gA + (size_t)(t + 2) * kstep; const char* b2 = last ? nB : cB + (size_t)(t + 2) * kstep;
            const char* a3 = a2 + kstep; const char* b3 = b2 + kstep;
            PG8_LDB(B0, 0, 0); PG8_LDB(B1, 0, 1); PG8_SCHED; PG8_LDA(At, 0, 0); PG8_STAGE(PG8_SA(1, 1), a1, vA[1]);
            PG8_WAIT_V(8); PG8_WAIT_L(0); PG8_BAR; PG8_MMA(0, 0, At, B0); PG8_MMA(0, 1, At, B1); PG8_BAR; PG8_SCHED;
            PG8_LDA(At, 0, 1); PG8_STAGE(PG8_SB(0, 0), b2, voffB); PG8_STAGE(PG8_SB(0, 1), b2 + hstep, voffB); PG8_STAGE(PG8_SA(0, 0), a2, x2[0]);
            PG8_WAIT_V(8); PG8_WAIT_L(0); PG8_BAR; PG8_MMA(1, 0, At, B0); PG8_MMA(1, 1, At, B1); PG8_BAR; PG8_SCHED;
            PG8_LDB(B0, 1, 0); PG8_LDB(B1, 1, 1); PG8_SCHED; PG8_LDA(At, 1, 0); PG8_STAGE(PG8_SA(0, 1), a2, x2[1]);
            PG8_WAIT_V(8); PG8_WAIT_L(0); PG8_BAR; PG8_MMA(0, 0, At, B0); PG8_MMA(0, 1, At, B1); PG8_BAR; PG8_SCHED;
            PG8_LDA(At, 1, 1); PG8_STAGE(PG8_SB(1, 0), b3, voffB); PG8_STAGE(PG8_SB(1, 1), b3 + hstep, voffB); PG8_STAGE(PG8_SA(1, 0), a3, x2[0]);
            PG8_WAIT_V(8); PG8_WAIT_L(0); PG8_BAR; PG8_MMA(1, 0, At, B0); PG8_MMA(1, 1, At, B1); PG8_BAR; PG8_SCHED;
        }
        if constexpr (ALIGN_EPI) { if (wr == 0) PG8_BAR; }
        E(acc, cur, wr, wc, fr, fq);
        if (!has_next) break;
#pragma unroll
        for (int a = 0; a < 2; ++a)
#pragma unroll
            for (int b = 0; b < 2; ++b)
#pragma unroll
                for (int m = 0; m < 4; ++m)
#pragma unroll
                    for (int n = 0; n < 2; ++n) acc[a][b][m][n] = (f32x4){0.f, 0.f, 0.f, 0.f};
        cur = nxt; cB = nB; ++ui;
#pragma unroll
        for (int h = 0; h < 2; ++h)
#pragma unroll
            for (int i = 0; i < 2; ++i) vA[h][i] = vN[h][i];
        if constexpr (ALIGN_EPI) { if (wr == 1) PG8_BAR; }
    }
    PG8_WAIT_V(0);
    if constexpr (!ALIGN_EPI) { if (wr == 0) PG8_BAR; }
    PG8_BAR;
#undef PG8_SA
#undef PG8_SB
#undef PG8_STAGE
#undef PG8_LDA
#undef PG8_LDB
#undef PG8_MMA
#undef PG8_WAIT_V
#undef PG8_WAIT_L
#undef PG8_BAR
#undef PG8_SCHED
}
}
constexpr size_t MiB = 1u << 20;
constexpr int TP = T * 4 + NE * 256;
constexpr size_t WS_CTL = 0, CTL_ZERO_BYTES = 1 * MiB;
constexpr size_t WS_LB = 1 * MiB, WS_MOD = 1 * MiB + 65536;
constexpr size_t WS_WIN = 2 * MiB, WS_WOUT = 18 * MiB, WS_WF = 22 * MiB, WS_WGU = 24 * MiB, WS_WDN = 280 * MiB;
constexpr size_t WS_X = 408 * MiB, WS_H = 474 * MiB, WS_P = 508 * MiB, WS_CAT = 624 * MiB, WS_ROUTE = 658 * MiB, WS_ACT = 662 * MiB, WS_Y = 810 * MiB;
constexpr size_t WS_SU = 958 * MiB, WS_SS = 990 * MiB, WS_SD = 1022 * MiB, WS_YP = 1023 * MiB, WS_OSCR = 1040 * MiB, WS_FASTEND = 1072 * MiB;
constexpr size_t RT_TOPI = 0, RT_TOPW = 512 * 1024, RT_POS = 1024 * 1024, RT_LISTE = 1536 * 1024;
static_assert((size_t)T * 16 <= 512 * 1024 && RT_LISTE + (size_t)NE * T * 4 <= 4 * MiB, "route map");
static_assert(WS_WIN + (size_t)2 * DINX * D * 2 <= WS_WOUT && WS_WGU + (size_t)2 * NE * 2048 * 1024 * 2 <= WS_WDN && WS_WDN + (size_t)2 * NE * 1024 * 1024 * 2 <= WS_X && WS_X + (size_t)T * D * 4 <= WS_H && WS_H + (size_t)T * D * 2 <= WS_P &&
              WS_P + (size_t)T * DINX * 2 <= WS_CAT && WS_CAT + (size_t)T * D * 2 <= WS_ROUTE && WS_ACT + (size_t)TP * D * 2 <= WS_Y && WS_Y + (size_t)TP * D * 2 <= WS_SU &&
              WS_SD + (size_t)(8 * 64 * 128 + 8 * 16384) * 4 <= WS_YP && WS_YP + (size_t)128 * 128 * 2 * 256 * 2 <= WS_OSCR && WS_OSCR + (size_t)256 * 32768 * 4 <= WS_FASTEND, "ws map");
constexpr int CW_TMO = 0, CW_BAR = 4096, CW_CNT = 16384;
constexpr int RING_OFF = 0, RING_BYTES = 131072, TINFO_OFF = 131072, BT_OFF = 136192, ROWOFF_OFF = 136704, MISC_OFF = 146944, LDS_BYTES = 147456;
constexpr int NWAVES = 8, NTHR = 512;

struct Params { const float* in[22]; float* out; unsigned char* ws; };
constexpr int PTR_OFF = MISC_OFF + 64;
struct Frame {
    LAS unsigned char* lds; unsigned char* ws; int tid, lane, wave, vcu, G, bid;
    __device__ __forceinline__ const float* in(int i) const { const LAS unsigned* q = (const LAS unsigned*)(lds + PTR_OFF) + 2 * i;
        const unsigned lo = __builtin_amdgcn_readfirstlane(q[0]), hi = __builtin_amdgcn_readfirstlane(q[1]); return (const float*)(((unsigned long long)hi << 32) | lo); }
    __device__ __forceinline__ const float* x() const { return in(0); }        __device__ __forceinline__ const float* c() const { return in(1); }
    __device__ __forceinline__ const float* ctxin() const { return in(2); }    __device__ __forceinline__ const float* cctx() const { return in(3); }
    __device__ __forceinline__ const float* w_ada() const { return in(4); }    __device__ __forceinline__ const float* b_ada() const { return in(5); }
    __device__ __forceinline__ const float* norm1_g() const { return in(6); }  __device__ __forceinline__ const float* norm2_g() const { return in(7); }
    __device__ __forceinline__ const float* w_in() const { return in(8); }     __device__ __forceinline__ const float* lbp() const { return in(9); }
    __device__ __forceinline__ const float* hng() const { return in(10); }     __device__ __forceinline__ const float* pool_w() const { return in(11); }
    __device__ __forceinline__ const float* pool_s() const { return in(12); }  __device__ __forceinline__ const float* four_w() const { return in(13); }
    __device__ __forceinline__ const float* w_out() const { return in(14); }   __device__ __forceinline__ const float* router_w() const { return in(15); }
    __device__ __forceinline__ const float* router_b() const { return in(16); } __device__ __forceinline__ const float* w_gu() const { return in(17); }
    __device__ __forceinline__ const float* b_gu() const { return in(18); }    __device__ __forceinline__ const float* w_dn() const { return in(19); }
    __device__ __forceinline__ const float* b_dn() const { return in(20); }    __device__ __forceinline__ const float* fng() const { return in(21); }
    __device__ __forceinline__ float* out() const { return (float*)in(22); }
    __device__ __forceinline__ gu32* ctl() const { return (gu32*)(ws + WS_CTL); }
    __device__ __forceinline__ float* LB() const { return (float*)(ws + WS_LB); }       __device__ __forceinline__ float* MOD() const { return (float*)(ws + WS_MOD); }
    __device__ __forceinline__ float* X() const { return (float*)(ws + WS_X); }
    __device__ __forceinline__ bf16_t* Wt_in() const { return (bf16_t*)(ws + WS_WIN); }  __device__ __forceinline__ bf16_t* Wt_out() const { return (bf16_t*)(ws + WS_WOUT); }
    __device__ __forceinline__ bf16_t* Wt_gu() const { return (bf16_t*)(ws + WS_WGU); }  __device__ __forceinline__ bf16_t* Wt_dn() const { return (bf16_t*)(ws + WS_WDN); }
    __device__ __forceinline__ bf16_t* H() const { return (bf16_t*)(ws + WS_H); }        __device__ __forceinline__ bf16_t* P() const { return (bf16_t*)(ws + WS_P); }
    __device__ __forceinline__ bf16_t* CAT() const { return (bf16_t*)(ws + WS_CAT); }    __device__ __forceinline__ bf16_t* ACT() const { return (bf16_t*)(ws + WS_ACT); }
    __device__ __forceinline__ bf16_t* Y() const { return (bf16_t*)(ws + WS_Y); }
    __device__ __forceinline__ int* TOPI() const { return (int*)(ws + WS_ROUTE + RT_TOPI); }   __device__ __forceinline__ float* TOPW() const { return (float*)(ws + WS_ROUTE + RT_TOPW); }
    __device__ __forceinline__ int* POS() const { return (int*)(ws + WS_ROUTE + RT_POS); }     __device__ __forceinline__ int* LISTE() const { return (int*)(ws + WS_ROUTE + RT_LISTE); }
};
__device__ __forceinline__ void frame_init(Frame& F, const Params& p, unsigned char* lds) {
    F.lds = (LAS unsigned char*)lds; F.tid = threadIdx.x; F.lane = F.tid & 63; F.wave = __builtin_amdgcn_readfirstlane(F.tid >> 6);
    F.G = gridDim.x; F.bid = blockIdx.x; { const int bx = blockIdx.x; F.vcu = (F.G % 8 == 0) ? (bx % 8) * (F.G / 8) + bx / 8 : bx; }
    F.ws = p.ws;
    if (F.tid == 0) { LAS unsigned long long* tab = (LAS unsigned long long*)(F.lds + PTR_OFF);
#pragma unroll
        for (int i = 0; i < 22; ++i) tab[i] = (unsigned long long)p.in[i];
        tab[22] = (unsigned long long)p.out; }
    __syncthreads();
}

__device__ __forceinline__ Frame relaunder(const Frame& F) { Frame R = F; int ln; asm volatile("v_mbcnt_lo_u32_b32 %0, -1, 0\n\tv_mbcnt_hi_u32_b32 %0, -1, %0" : "=v"(ln));
    R.lane = ln; R.tid = F.wave * 64 + ln; unsigned wlo = (unsigned)(unsigned long long)F.ws, whi = (unsigned)((unsigned long long)F.ws >> 32);
    asm volatile("" : "+s"(wlo), "+s"(whi)); R.ws = (unsigned char*)(((unsigned long long)whi << 32) | wlo);
    int sw = F.wave, sv = F.vcu, sg = F.G, sb = F.bid;
    asm volatile("" : "+s"(sw), "+s"(sv), "+s"(sg), "+s"(sb));
    R.wave = sw; R.vcu = sv; R.G = sg; R.bid = sb; R.tid = sw * 64 + ln; return R; }

struct DenseOrder {
    int nM, nN, nwg, G, c, K; const char* Bt;
    __device__ void init(int nM_, int nN_, int G_, int c_, int K_, const bf16_t* Bt_) { nM = nM_; nN = nN_; nwg = nM * nN; G = G_; c = c_; K = K_; Bt = (const char*)Bt_; }
    __device__ __forceinline__ bool next(int i, pg8::Unit& u) const {
        const long L = (long)i * G + c; if (L >= nwg) return false;
        int wgid = (int)L; { const int q = nwg / pg8::NXCD, r = nwg % pg8::NXCD, xcd = wgid % pg8::NXCD, off = wgid / pg8::NXCD; wgid = (xcd < r ? xcd * (q + 1) : r * (q + 1) + (xcd - r) * q) + off; }
        const int nig = pg8::WGM * nN, gid = wgid / nig, fm = gid * pg8::WGM, gsz = (nM - fm) < pg8::WGM ? (nM - fm) : pg8::WGM;
        u.pm = fm + ((wgid % nig) % gsz); u.pn = (wgid % nig) / gsz; u.e = 0; u.ui = i; return true;
    }
    __device__ __forceinline__ const char* b_tile(const pg8::Unit& u) const { return Bt + (size_t)u.pn * 256 * K * 2; }
    __device__ __forceinline__ unsigned a_row_off(const pg8::Unit& u, int r) const { return (unsigned)(u.pm * 256 + r) * (unsigned)(K * 2); }
};
template <bool GATHER> struct MoeOrder {
    const LAS int* tinfo; const LAS unsigned* rowoff; int ntiles, nN, G, c, K; const char* W; size_t wstride;
    __device__ __forceinline__ bool next(int i, pg8::Unit& u) const {
        const int L = i * G + c; if (L >= ntiles * nN) return false;
        u.pm = L / nN; u.pn = L % nN; u.e = __builtin_amdgcn_readfirstlane(tinfo[4 * u.pm]); u.ui = i; return true;
    }
    __device__ __forceinline__ const char* b_tile(const pg8::Unit& u) const { return W + (size_t)u.e * wstride + (size_t)u.pn * 256 * K * 2; }
    __device__ __forceinline__ unsigned a_row_off(const pg8::Unit& u, int r) const { if constexpr (GATHER) return rowoff[u.ui * 256 + r]; else return (unsigned)(u.pm * 256 + r) * (unsigned)(K * 2); }
};

__device__ __forceinline__ unsigned pk_f16(float a, float b) { const _Float16 x = (_Float16)a, y = (_Float16)b; return (unsigned)__builtin_bit_cast(unsigned short, x) | ((unsigned)__builtin_bit_cast(unsigned short, y) << 16); }
__device__ __forceinline__ float f16lo(unsigned w) { return (float)__builtin_bit_cast(_Float16, (unsigned short)(w & 0xffffu)); }
__device__ __forceinline__ float f16hi(unsigned w) { return (float)__builtin_bit_cast(_Float16, (unsigned short)(w >> 16)); }
struct EpiP {
    static constexpr bool PERM = true; bf16_t* O; int ldc; const float* lb;
    __device__ __forceinline__ void operator()(const f32x4 (&acc)[2][2][4][2], const pg8::Unit& u, int wr, int wc, int fr, int fq) const {
        const int row0 = u.pm * 256 + wr * 64 + fr, col0 = u.pn * 256 + wc * 32 + 8 * fq;
        const int mode = u.pn < 2 ? 1 : (u.pn < 6 ? 2 : ((u.pn == 8 || u.pn == 9) ? 3 : 0));
        f32x4 lbv[2][2];
        if (mode == 2) {
#pragma unroll
            for (int bj = 0; bj < 2; ++bj)
#pragma unroll
                for (int n = 0; n < 2; ++n) lbv[bj][n] = *(const f32x4*)(lb + (col0 - 512) + bj * 128 + 4 * n); }
#pragma unroll
        for (int ai = 0; ai < 2; ++ai)
#pragma unroll
            for (int m = 0; m < 4; ++m) { bf16_t* rowp = O + (size_t)(row0 + ai * 128 + m * 16) * ldc + col0;
#pragma unroll
                for (int bj = 0; bj < 2; ++bj) { f32x4 v0 = acc[ai][bj][m][0], v1 = acc[ai][bj][m][1]; u32x4 w;
                    if (mode == 2) {
#pragma unroll
                        for (int j = 0; j < 4; ++j) { const float l0 = lbv[bj][0][j], l1 = lbv[bj][1][j];
                            v0[j] = __builtin_amdgcn_logf(fmaxf(l0 + (1.f - l0) * fsigm(v0[j]), 1e-30f)); v1[j] = __builtin_amdgcn_logf(fmaxf(l1 + (1.f - l1) * fsigm(v1[j]), 1e-30f)); }
                        w.x = pk_f16(v0[0], v0[1]); w.y = pk_f16(v0[2], v0[3]); w.z = pk_f16(v1[0], v1[1]); w.w = pk_f16(v1[2], v1[3]);
                    } else {
                        if (mode == 1) {
#pragma unroll
                            for (int j = 0; j < 4; ++j) { v0[j] = v0[j] * fsigm(v0[j]); v1[j] = v1[j] * fsigm(v1[j]); } }
                        if (mode == 3) {
#pragma unroll
                            for (int j = 0; j < 4; ++j) { v0[j] = fsigm(v0[j]); v1[j] = fsigm(v1[j]); } }
                        w.x = cvt_pk_bf16(v0[0], v0[1]); w.y = cvt_pk_bf16(v0[2], v0[3]); w.z = cvt_pk_bf16(v1[0], v1[1]); w.w = cvt_pk_bf16(v1[2], v1[3]); }
                    *(u32x4*)(rowp + bj * 128) = w; } }
    }
};
struct EpiRes {
    static constexpr bool PERM = false; const float* base_ctx; const float* base_lat; const float* gate_ctx; const float* gate_lat; float* Xo;
    __device__ __forceinline__ void operator()(const f32x4 (&acc)[2][2][4][2], const pg8::Unit& u, int wr, int wc, int fr, int fq) const {
        const int rt = wr * 64 + fr, col0 = u.pn * 256 + wc * 32 + 4 * fq;
        const float* base = (u.pm == 0 ? base_ctx : base_lat + (size_t)(u.pm - 1) * 256 * D) + (size_t)rt * D + col0; const float* gate = (u.pm == 0 ? gate_ctx : gate_lat) + col0;
        float* op = Xo + (size_t)(u.pm * 256 + rt) * D + col0;
#pragma unroll
        for (int bj = 0; bj < 2; ++bj)
#pragma unroll
            for (int n = 0; n < 2; ++n) { const f32x4 gv = *(const f32x4*)(gate + bj * 128 + n * 16);
#pragma unroll
                for (int ai = 0; ai < 2; ++ai) {
#pragma unroll
                    for (int m = 0; m < 4; ++m) { const size_t o = (size_t)(ai * 128 + m * 16) * D + bj * 128 + n * 16; const f32x4 b = *(const f32x4*)(base + o); *(f32x4*)(op + o) = b + gv * acc[ai][bj][m][n]; }
                    asm volatile("" ::: "memory"); } }
    }
};
struct EpiAct {
    static constexpr bool PERM = true; bf16_t* ACTo; const float* bias;
    __device__ __forceinline__ void operator()(const f32x4 (&acc)[2][2][4][2], const pg8::Unit& u, int wr, int wc, int fr, int fq) const {
        const int x0 = wc * 32 + 8 * fq; const float* bg = bias + (size_t)u.e * 2048 + 128 * u.pn + x0; const float* bu = bg + 1024;
        const f32x4 g0 = *(const f32x4*)bg, g1 = *(const f32x4*)(bg + 4), u0 = *(const f32x4*)bu, u1 = *(const f32x4*)(bu + 4);
#pragma unroll
        for (int ai = 0; ai < 2; ++ai)
#pragma unroll
            for (int m = 0; m < 4; ++m) { const int row = u.pm * 256 + ai * 128 + wr * 64 + m * 16 + fr;
                const f32x4 ga = acc[ai][0][m][0] + g0, gb = acc[ai][0][m][1] + g1, ua = acc[ai][1][m][0] + u0, ub = acc[ai][1][m][1] + u1; float r[8];
#pragma unroll
                for (int j = 0; j < 4; ++j) { const float g = fminf(ga[j], 7.f), up = fminf(fmaxf(ua[j], -7.f), 7.f); r[j] = (up + 1.f) * (g * fsigm(1.702f * g));
                                              const float g2 = fminf(gb[j], 7.f), up2 = fminf(fmaxf(ub[j], -7.f), 7.f); r[4 + j] = (up2 + 1.f) * (g2 * fsigm(1.702f * g2)); }
                u32x4 w; w.x = cvt_pk_bf16(r[0], r[1]); w.y = cvt_pk_bf16(r[2], r[3]); w.z = cvt_pk_bf16(r[4], r[5]); w.w = cvt_pk_bf16(r[6], r[7]);
                *(u32x4*)(ACTo + (size_t)row * D + 128 * u.pn + x0) = w; }
    }
};
struct EpiY {
    static constexpr bool PERM = true; bf16_t* Yo; const float* bias;
    __device__ __forceinline__ void operator()(const f32x4 (&acc)[2][2][4][2], const pg8::Unit& u, int wr, int wc, int fr, int fq) const {
        const int row0 = u.pm * 256 + wr * 64 + fr, col0 = u.pn * 256 + wc * 32 + 8 * fq; const float* bp = bias + (size_t)u.e * D + col0;
        f32x4 bv[2][2];
#pragma unroll
        for (int bj = 0; bj < 2; ++bj)
#pragma unroll
            for (int n = 0; n < 2; ++n) bv[bj][n] = *(const f32x4*)(bp + bj * 128 + 4 * n);
#pragma unroll
        for (int ai = 0; ai < 2; ++ai)
#pragma unroll
            for (int m = 0; m < 4; ++m) { bf16_t* rowp = Yo + (size_t)(row0 + ai * 128 + m * 16) * D + col0;
#pragma unroll
                for (int bj = 0; bj < 2; ++bj) { const f32x4 v0 = acc[ai][bj][m][0] + bv[bj][0], v1 = acc[ai][bj][m][1] + bv[bj][1];
                    u32x4 w; w.x = cvt_pk_bf16(v0[0], v0[1]); w.y = cvt_pk_bf16(v0[2], v0[3]); w.z = cvt_pk_bf16(v1[0], v1[1]); w.w = cvt_pk_bf16(v1[2], v1[3]);
                    *(u32x4*)(rowp + bj * 128) = w; } }
    }
};

struct CvtJob { const float* W; bf16_t* WT; int N, K, k0, n0, nrow0; };
__device__ __forceinline__ void cvt_load(const CvtJob& j, int lane, f32x4 (&r)[16]) { const GAS f32x4* src = (const GAS f32x4*)((const GAS float*)j.W + (unsigned)((j.k0 + 8 * (lane >> 3)) * j.N + j.n0 + 8 * (lane & 7)));
    const unsigned rs = (unsigned)j.N >> 2;
#pragma unroll
    for (int i = 0; i < 8; ++i) { r[2 * i] = src[i * rs]; r[2 * i + 1] = src[i * rs + 1]; } }
__device__ __forceinline__ void cvt_store(const CvtJob& j, int lane, const f32x4 (&r)[16]) {
    u32x4 b[8];
#pragma unroll
    for (int i = 0; i < 8; ++i) { b[i].x = cvt_pk_bf16(r[2 * i][0], r[2 * i][1]); b[i].y = cvt_pk_bf16(r[2 * i][2], r[2 * i][3]); b[i].z = cvt_pk_bf16(r[2 * i + 1][0], r[2 * i + 1][1]); b[i].w = cvt_pk_bf16(r[2 * i + 1][2], r[2 * i + 1][3]); }
    GAS u32x4* dst = (GAS u32x4*)((GAS bf16_t*)j.WT + (unsigned)((j.nrow0 + 8 * (lane & 7)) * j.K + j.k0 + 8 * (lane >> 3))); const unsigned rs = (unsigned)j.K >> 3;
#pragma unroll
    for (int q = 0; q < 8; ++q) { const unsigned sel = (q & 1) ? 0x07060302u : 0x05040100u; u32x4 o;
        o.x = __builtin_amdgcn_perm(b[1][q >> 1], b[0][q >> 1], sel); o.y = __builtin_amdgcn_perm(b[3][q >> 1], b[2][q >> 1], sel);
        o.z = __builtin_amdgcn_perm(b[5][q >> 1], b[4][q >> 1], sel); o.w = __builtin_amdgcn_perm(b[7][q >> 1], b[6][q >> 1], sel);
        dst[q * rs] = o; } }
constexpr int NB_IN = (FQ_OFF < DIN ? FQ_OFF : DIN) / 64, I_IN = 16 * NB_IN, I_OUT = 16 * 16, I_GU = 16 * 32, I_DN = 16 * 16;
constexpr int N_IN = 2 * I_IN, N_OUT = 2 * I_OUT, N_GU = 2 * NE * I_GU, N_DN = 2 * NE * I_DN, N_CVT = N_IN + N_OUT + N_GU + N_DN;
__device__ __forceinline__ CvtJob cvt_job(const Frame& F, int it) {
    CvtJob j; int r = it;
    if (r < N_IN) { const int l = r / I_IN, q = r % I_IN, kb = q / NB_IN, nb = q % NB_IN; j = CvtJob{F.w_in() + (size_t)l * D * DIN, F.Wt_in() + (size_t)l * DINX * D, DIN, D, 64 * kb, 64 * nb, 64 * nb}; return j; } r -= N_IN;
    if (r < N_OUT) { const int l = r / I_OUT, q = r % I_OUT, kb = q >> 4, nb = q & 15; j = CvtJob{F.w_out() + (size_t)l * D * D, F.Wt_out() + (size_t)l * D * D, D, D, 64 * kb, 64 * nb, 64 * nb}; return j; } r -= N_OUT;
    if (r < N_GU) { const int le = r / I_GU, q = r % I_GU, kb = q >> 5, nb = q & 31; const int n0 = 64 * nb, bj = n0 >> 10, xx = n0 & 1023;
        j = CvtJob{F.w_gu() + (size_t)le * D * 2048, F.Wt_gu() + (size_t)le * 2048 * D, 2048, D, 64 * kb, n0, 256 * (xx >> 7) + 128 * bj + (xx & 127)}; return j; } r -= N_GU;
    { const int le = r / I_DN, q = r % I_DN, kb = q >> 4, nb = q & 15; j = CvtJob{F.w_dn() + (size_t)le * D * D, F.Wt_dn() + (size_t)le * D * D, D, D, 64 * kb, 64 * nb, 64 * nb}; return j; }
}
__device__ __forceinline__ void ph_prologue(Frame& F) {
    const int gw = F.vcu * NWAVES + F.wave, NGW = F.G * NWAVES;
    for (int i = gw * 64 + F.lane; i < 1024; i += NGW * 64) { const float a = F.lbp()[i], b = F.lbp()[1024 + i], m = fmaxf(a, b), ea = __expf(a - m), eb = __expf(b - m); F.LB()[i] = 0.f; F.LB()[1024 + i] = eb / (ea + eb); }
    if (F.bid < 192) {
        LAS float* sc = (LAS float*)(F.lds); LAS float* part = sc + 2048;
        { const float* c = F.c(); const float* cc = F.cctx(); for (int i = F.tid; i < D; i += NTHR) { const float a = c[i], b = cc[i]; sc[i] = a * fsigm(a); sc[D + i] = b * fsigm(b); } }
        __syncthreads();
        const int l = F.bid / 96, jcol = (F.bid % 96) * 64 + F.lane; const GAS float* W = (const GAS float*)F.w_ada() + (unsigned)(l * D * 6144 + (128 * F.wave) * 6144 + jcol); float a0 = 0.f, a1 = 0.f;
#pragma unroll 16
        for (int i = 0; i < 128; ++i) { const float w = W[(unsigned)i * 6144u]; a0 += sc[128 * F.wave + i] * w; a1 += sc[D + 128 * F.wave + i] * w; }
        part[(F.wave * 2 + 0) * 64 + F.lane] = a0; part[(F.wave * 2 + 1) * 64 + F.lane] = a1;
        __syncthreads();
        if (F.tid < 128) { const int which = F.tid >> 6, col = F.tid & 63; float s = 0.f;
#pragma unroll
            for (int w = 0; w < 8; ++w) s += part[(w * 2 + which) * 64 + col];
            const int j = (F.bid % 96) * 64 + col; F.MOD()[(size_t)(l * 2 + which) * 6144 + j] = s + F.b_ada()[l * 6144 + j]; }
        __syncthreads();
    }
    int it = gw; if (it >= N_CVT) return;
    f32x4 ra[16], rb[16]; CvtJob ja = cvt_job(F, it), jb; cvt_load(ja, F.lane, ra);
    for (;;) {
        const int itb = it + NGW; const bool hb = itb < N_CVT; if (hb) { jb = cvt_job(F, itb); cvt_load(jb, F.lane, rb); }
        cvt_store(ja, F.lane, ra); if (!hb) break;
        const int ita = itb + NGW; const bool ha = ita < N_CVT; if (ha) { ja = cvt_job(F, ita); cvt_load(ja, F.lane, ra); }
        cvt_store(jb, F.lane, rb); if (!ha) break;
        it = ita;
    }
}

__device__ __forceinline__ void row_load(const float* xrow, int lane, f32x4 (&v)[4]) { const GAS f32x4* xr = (const GAS f32x4*)xrow + lane;
#pragma unroll
    for (int j = 0; j < 4; ++j) v[j] = xr[64 * j]; }
__device__ __forceinline__ float row_rstd(const f32x4 (&v)[4], int lane) { float s = 0.f;
#pragma unroll
    for (int j = 0; j < 4; ++j) s += (v[j].x * v[j].x + v[j].y * v[j].y) + (v[j].z * v[j].z + v[j].w * v[j].w);
    return rsqrtf(wave_sum(s, lane) * (1.f / D) + 1e-6f); }
__device__ __forceinline__ void row_modulate(const f32x4 (&v)[4], float r, const float* g, const float* sc, const float* sh, int lane, f32x4 (&hv)[4]) {
#pragma unroll
    for (int j = 0; j < 4; ++j) { const f32x4 gg = ((const GAS f32x4*)g)[lane + 64 * j], s1 = ((const GAS f32x4*)sc)[lane + 64 * j], s0 = ((const GAS f32x4*)sh)[lane + 64 * j];
        hv[j] = v[j] * r * gg * (s1 + 1.f) + s0; } }
__device__ __forceinline__ void row_store_bf16(bf16_t* orow, int lane, const f32x4 (&hv)[4]) { GAS u32x2* o8 = (GAS u32x2*)orow + lane;
#pragma unroll
    for (int j = 0; j < 4; ++j) { u32x2 w; w.x = pk2(hv[j].x, hv[j].y); w.y = pk2(hv[j].z, hv[j].w); o8[64 * j] = w; } }

__device__ __forceinline__ void ph_mod1(Frame& F, int l) {
    const int gw = F.vcu * NWAVES + F.wave, NGW = F.G * NWAVES;
    for (int row = gw; row < T; row += NGW) {
        const float* xr = l == 0 ? (row < CTX ? F.ctxin() + (size_t)row * D : F.x() + (size_t)(row - CTX) * D) : F.X() + (size_t)row * D;
        const float* m = F.MOD() + (size_t)(l * 2 + (row < CTX ? 1 : 0)) * 6144;
        f32x4 v[4], hv[4]; row_load(xr, F.lane, v); const float r = row_rstd(v, F.lane); row_modulate(v, r, F.norm1_g() + l * D, m + D, m, F.lane, hv); row_store_bf16(F.H() + (size_t)row * D, F.lane, hv);
    }
}

constexpr int RW_STRIDE = 1028, RSCR_OFF = 32 * RW_STRIDE * 4;
static_assert(RSCR_OFF + 4096 <= MISC_OFF, "router LDS map");
__device__ __forceinline__ void route_top4(float (&part)[16], float bias, int lane, float (&vals)[4], int (&idx)[4]) {
#pragma unroll
    for (int st = 1; st < 5; ++st) { const int M = 32 >> st, n = 16 >> st; const bool up = (lane & M) != 0;
#pragma unroll
        for (int i = 0; i < n; ++i) { const float keep = up ? part[i + n] : part[i], send = up ? part[i] : part[i + n]; part[i] = keep + lane_xor(send, M, lane); } }
    const float lg = part[0] + lane_xor(part[0], 1, lane) + bias;
    const int e = (lane >> 1) & 31; unsigned u = __builtin_bit_cast(unsigned, lg); u = (u & 0x80000000u) ? ~u : (u | 0x80000000u); unsigned key = (u & ~31u) | (unsigned)(31 - e);
#pragma unroll
    for (int s = 0; s < 4; ++s) { unsigned m = key;
#pragma unroll
        for (int d = 2; d < 64; d <<= 1) { const unsigned o = (unsigned)__builtin_amdgcn_ds_bpermute((lane ^ d) << 2, (int)m); m = o > m ? o : m; }
        const int bi = 31 - (int)(m & 31u); const unsigned vb = m & ~31u, ub = (vb & 0x80000000u) ? (vb & 0x7fffffffu) : ~vb;
        idx[s] = bi; vals[s] = __builtin_bit_cast(float, ub); key = (e == bi) ? 0u : key; }
}
__device__ __forceinline__ void ph_mod2_route(Frame& F, int l, int cbank) {
    LAS float* rwT = (LAS float*)(F.lds + RING_OFF);
    LAS int* lcnt = (LAS int*)(F.lds + RSCR_OFF); LAS int* lbase = lcnt + 32; LAS int* te = lbase + 32; LAS float* tw = (LAS float*)(te + 272); LAS int* trk = (LAS int*)(tw + 272);
    const GAS float* rw = (const GAS float*)F.router_w() + (unsigned)(l * D * NE);
    __syncthreads();
    for (int i = F.tid; i < 256 * 32; i += NTHR) { const int e = i & 31, k4 = i >> 5; f32x4 v; v[0] = rw[(4 * k4 + 0) * NE + e]; v[1] = rw[(4 * k4 + 1) * NE + e]; v[2] = rw[(4 * k4 + 2) * NE + e]; v[3] = rw[(4 * k4 + 3) * NE + e];
        *(LAS f32x4*)(rwT + e * RW_STRIDE + 4 * k4) = v; }
    if (F.tid < 32) lcnt[F.tid] = 0;
    __syncthreads();
    const int row0 = F.bid * 65;
    const float bias = F.router_b()[l * NE + ((F.lane >> 1) & 31)];
    const float* Xp = F.X(); const float* n2g = F.norm2_g() + l * D; const float* modl = F.MOD() + (size_t)(l * 2) * 6144; bf16_t* Hp = F.H();
#pragma unroll 1
    for (int pi = F.wave; pi < 33; pi += NWAVES) {
        const int ria = 2 * pi, rib = min(2 * pi + 1, 64); const bool hasb = 2 * pi + 1 < 65; const int ra = row0 + ria, rb = row0 + rib;
        int ln = F.lane; asm volatile("" : "+v"(ln));
        f32x4 va[4], vb[4]; row_load(Xp + (size_t)ra * D, ln, va); row_load(Xp + (size_t)rb * D, ln, vb);
        f32x4 ha[4], hb[4];
        { const float* m = modl + (ra < CTX ? 6144 : 0); const float r = row_rstd(va, ln); row_modulate(va, r, n2g, m + 4 * D, m + 3 * D, ln, ha); row_store_bf16(Hp + (size_t)ra * D, ln, ha); }
        { const float* m = modl + (rb < CTX ? 6144 : 0); const float r = row_rstd(vb, ln); row_modulate(vb, r, n2g, m + 4 * D, m + 3 * D, ln, hb); if (hasb) row_store_bf16(Hp + (size_t)rb * D, ln, hb); }
        float pa[16], pb[16]; const bool up32 = (ln & 32) != 0;
#pragma unroll
        for (int i = 0; i < 16; ++i) { float sa0 = 0.f, sb0 = 0.f, sa1 = 0.f, sb1 = 0.f;
#pragma unroll
            for (int j = 0; j < 4; ++j) { const f32x4 w0 = *(const LAS f32x4*)(rwT + i * RW_STRIDE + 4 * ln + 256 * j), w1 = *(const LAS f32x4*)(rwT + (i + 16) * RW_STRIDE + 4 * ln + 256 * j);
                sa0 += (ha[j].x * w0.x + ha[j].y * w0.y) + (ha[j].z * w0.z + ha[j].w * w0.w); sb0 += (hb[j].x * w0.x + hb[j].y * w0.y) + (hb[j].z * w0.z + hb[j].w * w0.w);
                sa1 += (ha[j].x * w1.x + ha[j].y * w1.y) + (ha[j].z * w1.z + ha[j].w * w1.w); sb1 += (hb[j].x * w1.x + hb[j].y * w1.y) + (hb[j].z * w1.z + hb[j].w * w1.w); }
            pa[i] = (up32 ? sa1 : sa0) + lane_xor(up32 ? sa0 : sa1, 32, ln); pb[i] = (up32 ? sb1 : sb0) + lane_xor(up32 ? sb0 : sb1, 32, ln);
            if (i & 1) __builtin_amdgcn_sched_barrier(0); }
        float vals[4]; int idx[4];
        route_top4(pa, bias, ln, vals, idx);
        if (ln == 0) { float ex[4], sum = 0.f;
#pragma unroll
            for (int s = 0; s < 4; ++s) { ex[s] = __expf(vals[s] - vals[0]); sum += ex[s]; }
            const float inv = 1.f / sum;
#pragma unroll
            for (int s = 0; s < 4; ++s) { te[ria * 4 + s] = idx[s]; tw[ria * 4 + s] = ex[s] * inv; trk[ria * 4 + s] = (int)__hip_atomic_fetch_add((LAS unsigned*)&lcnt[idx[s]], 1u, __ATOMIC_RELAXED, __HIP_MEMORY_SCOPE_WORKGROUP); } }
        route_top4(pb, bias, ln, vals, idx);
        if (ln == 0 && hasb) { float ex[4], sum = 0.f;
#pragma unroll
            for (int s = 0; s < 4; ++s) { ex[s] = __expf(vals[s] - vals[0]); sum += ex[s]; }
            const float inv = 1.f / sum;
#pragma unroll
            for (int s = 0; s < 4; ++s) { te[rib * 4 + s] = idx[s]; tw[rib * 4 + s] = ex[s] * inv; trk[rib * 4 + s] = (int)__hip_atomic_fetch_add((LAS unsigned*)&lcnt[idx[s]], 1u, __ATOMIC_RELAXED, __HIP_MEMORY_SCOPE_WORKGROUP); } }
    }
    __syncthreads();
    if (F.tid < 32) lbase[F.tid] = (int)__hip_atomic_fetch_add((unsigned*)(F.ctl() + CW_CNT + (cbank * 32 + F.tid) * 64), (unsigned)lcnt[F.tid], RLX_AGENT);
    __syncthreads();
    for (int i = F.tid; i < 65 * 4; i += NTHR) { const int row = row0 + (i >> 2), e = te[i], pos = lbase[e] + trk[i];
        F.TOPI()[row * 4 + (i & 3)] = e; F.TOPW()[row * 4 + (i & 3)] = tw[i]; F.POS()[row * 4 + (i & 3)] = pos; F.LISTE()[(size_t)e * T + pos] = row; }
    __syncthreads();
}

__device__ __forceinline__ int moe_tiles(Frame& F, int l) {
    LAS int* tinfo = (LAS int*)(F.lds + TINFO_OFF); LAS int* bt = (LAS int*)(F.lds + BT_OFF); LAS int* cn = bt + 32; LAS int* ntl = bt + 64;
    __syncthreads();
    if (F.tid < 64) {
        const int e = F.lane & 31; const int c = (int)__hip_atomic_load(F.ctl() + CW_CNT + (l * 32 + e) * 64, RLX_AGENT); const int nt = (c + 255) >> 8;
        int incl = nt;
#pragma unroll
        for (int o = 1; o < 32; o <<= 1) { const int t = lane_get(incl, (F.lane - o) & 63); if (e >= o) incl += t; }
        const int first = incl - nt;
        if (F.lane < 32) { bt[e] = first; cn[e] = c; for (int j = 0; j < nt; ++j) { LAS int* ti = tinfo + 4 * (first + j); ti[0] = e; ti[1] = 0; ti[2] = 256 * j; ti[3] = min(256, c - 256 * j); } if (e == 31) ntl[0] = incl; }
    }
    __syncthreads();
    return ntl[0];
}

__device__ __forceinline__ void ph_gateup(Frame& F, int l) {
    const int ntiles = moe_tiles(F, l);
    LAS int* tinfo = (LAS int*)(F.lds + TINFO_OFF); LAS unsigned* rowoff = (LAS unsigned*)(F.lds + ROWOFF_OFF);
    MoeOrder<true> S; S.tinfo = tinfo; S.rowoff = rowoff; S.ntiles = ntiles; S.nN = 8; S.G = F.G; S.c = F.vcu; S.K = D; S.W = (const char*)(F.Wt_gu() + (size_t)l * NE * 2048 * D); S.wstride = (size_t)2048 * D * 2;
    for (int i = 0;; ++i) { pg8::Unit u; if (!S.next(i, u) || i >= 10) break;
        if (F.tid < 256) { const int pos0 = tinfo[4 * u.pm + 2], valid = tinfo[4 * u.pm + 3]; const int tok = F.tid < valid ? F.LISTE()[(size_t)u.e * T + pos0 + F.tid] : 0; rowoff[i * 256 + F.tid] = (unsigned)tok * (unsigned)(D * 2); } }
    __syncthreads();
    EpiAct E{F.ACT(), F.b_gu() + (size_t)l * NE * 2048};
    pg8::gemm_phase<EpiAct, MoeOrder<true>, true>(F.lds + RING_OFF, (const char*)F.H(), D, S, E, F.tid);
}
__device__ __forceinline__ void ph_down(Frame& F, int l) {
    const int ntiles = moe_tiles(F, l);
    MoeOrder<false> S; S.tinfo = (LAS int*)(F.lds + TINFO_OFF); S.rowoff = nullptr; S.ntiles = ntiles; S.nN = 4; S.G = F.G; S.c = F.vcu; S.K = D; S.W = (const char*)(F.Wt_dn() + (size_t)l * NE * D * D); S.wstride = (size_t)D * D * 2;
    EpiY E{F.Y(), F.b_dn() + (size_t)l * NE * D};
    pg8::gemm_phase<EpiY, MoeOrder<false>, true>(F.lds + RING_OFF, (const char*)F.ACT(), D, S, E, F.tid);
}
__device__ __forceinline__ void ph_win(Frame& F, int l) {
    DenseOrder S; S.init(T / 256, DINX / 256, F.G, F.bid, D, F.Wt_in() + (size_t)l * DINX * D);
    EpiP E{F.P(), DINX, F.LB() + l * 1024};
    pg8::gemm_phase<EpiP, DenseOrder, true>(F.lds + RING_OFF, (const char*)F.H(), D, S, E, F.tid);
}
__device__ __forceinline__ void ph_wout(Frame& F, int l) {
    DenseOrder S; S.init(T / 256, D / 256, F.G, F.bid, D, F.Wt_out() + (size_t)l * D * D);
    const float* m = F.MOD() + (size_t)(l * 2) * 6144;
    EpiRes E{l == 0 ? F.ctxin() : F.X(), l == 0 ? F.x() : F.X() + (size_t)CTX * D, m + 6144 + 2 * D, m + 2 * D, F.X()};
    pg8::gemm_phase<EpiRes, DenseOrder, true>(F.lds + RING_OFF, (const char*)F.CAT(), D, S, E, F.tid);
}
__device__ __forceinline__ void combine_gather(const Frame& F, const LAS int* bt, int row, int ln, f32x4 (&v)[4], u32x2 (&y)[4][4], float (&w)[4]) {
    row_load(F.X() + (size_t)row * D, ln, v);
    const GAS int* ti = (const GAS int*)F.TOPI() + (unsigned)(row * 4); const GAS float* tw = (const GAS float*)F.TOPW() + (unsigned)(row * 4); const GAS int* tp = (const GAS int*)F.POS() + (unsigned)(row * 4);
#pragma unroll
    for (int q = 0; q < 4; ++q) { const int e = ti[q]; w[q] = tw[q]; const int srow = 256 * bt[e] + tp[q]; const GAS u32x2* yr = (const GAS u32x2*)((const GAS bf16_t*)F.Y() + (unsigned)srow * (unsigned)D) + ln;
#pragma unroll
        for (int j = 0; j < 4; ++j) y[q][j] = yr[64 * j]; }
}
__device__ __forceinline__ void combine_finish(const Frame& F, int l, int row, int ln, f32x4 (&v)[4], const u32x2 (&y)[4][4], const float (&w)[4]) {
    const float* m = F.MOD() + (size_t)(l * 2 + (row < CTX ? 1 : 0)) * 6144 + 5 * D;
#pragma unroll
    for (int j = 0; j < 4; ++j) { f32x4 s = (f32x4){0.f, 0.f, 0.f, 0.f};
#pragma unroll
        for (int q = 0; q < 4; ++q) s += w[q] * (f32x4){bflo(y[q][j].x), bfhi(y[q][j].x), bflo(y[q][j].y), bfhi(y[q][j].y)};
        v[j] += ((const GAS f32x4*)m)[ln + 64 * j] * s; }
    const float r = row_rstd(v, ln);
    if (l == 0) {
        GAS f32x4* xo = (GAS f32x4*)(F.X() + (size_t)row * D) + ln;
#pragma unroll
        for (int j = 0; j < 4; ++j) xo[64 * j] = v[j];
        const float* m1 = F.MOD() + (size_t)(2 + (row < CTX ? 1 : 0)) * 6144; f32x4 hv[4];
        row_modulate(v, r, F.norm1_g() + D, m1 + D, m1, ln, hv); row_store_bf16(F.H() + (size_t)row * D, ln, hv);
    } else {
        GAS f32x4* o = (GAS f32x4*)(F.out() + (size_t)(row - CTX) * D) + ln; const float* fg = F.fng();
#pragma unroll
        for (int j = 0; j < 4; ++j) o[64 * j] = v[j] * r * ((const GAS f32x4*)fg)[ln + 64 * j];
    }
}
__device__ __forceinline__ void ph_combine(Frame& F, int l) {
    (void)moe_tiles(F, l);
    const LAS int* bt = (const LAS int*)(F.lds + BT_OFF);
    const int gw = F.vcu * NWAVES + F.wave, NGW = F.G * NWAVES; const int rbeg = l == 1 ? CTX : 0;
#pragma unroll 1
    for (int ra = rbeg + gw; ra < T; ra += 2 * NGW) {
        int ln = F.lane; asm volatile("" : "+v"(ln));
        const int rb = ra + NGW; const bool hasb = rb < T; const int rbc = hasb ? rb : ra;
        f32x4 va[4], vb[4]; u32x2 ya[4][4], yb[4][4]; float wa[4], wb[4];
        combine_gather(F, bt, ra, ln, va, ya, wa); combine_gather(F, bt, rbc, ln, vb, yb, wb);
        combine_finish(F, l, ra, ln, va, ya, wa);
        if (hasb) combine_finish(F, l, rb, ln, vb, yb, wb);
    }
}
constexpr size_t WF_MA = 0, WF_MB = 128 * 1024, WF_MC = 256 * 1024, WF_PW = 512 * 1024;
constexpr int ZS = 528;
__device__ __forceinline__ f32x4 mfma16(bf16x8 a, bf16x8 b, f32x4 c) { return __builtin_amdgcn_mfma_f32_16x16x32_bf16(a, b, c, 0, 0, 0); }

__device__ __forceinline__ void ph_prologue2(Frame& F) {
    bf16_t* MA = (bf16_t*)(F.ws + WS_WF + WF_MA); bf16_t* MB = (bf16_t*)(F.ws + WS_WF + WF_MB); bf16_t* MC = (bf16_t*)(F.ws + WS_WF + WF_MC); bf16_t* PW = (bf16_t*)(F.ws + WS_WF + WF_PW);
    const int gt = F.bid * NTHR + F.tid, NT = F.G * NTHR;
    for (int i = gt; i < 256 * 256; i += NT) { const int r = i >> 8, cidx = i & 255, ri = r >> 7, k1 = r & 127, rj = cidx >> 7, t1 = cidx & 127; const float x = 2.f * (float)((k1 * t1) & 127) / 128.f;
        const float cs = cospif(x), sn = sinpif(x); const float v = ri == 0 ? (rj == 0 ? cs : -sn) : (rj == 0 ? -sn : -cs); MA[i] = (bf16_t)f2bf(v); }
    for (int i = gt; i < 128 * 256; i += NT) { const int k2 = i >> 8, cidx = i & 255, rj = cidx >> 7, t2 = cidx & 127; const float x = 2.f * (float)((k2 * t2) & 127) / 128.f; MB[i] = (bf16_t)f2bf(rj == 0 ? cospif(x) : sinpif(x)); }
    for (int i = gt; i < 256 * 512; i += NT) { const int k = i >> 9, cidx = i & 511, rj = cidx >> 8, t = cidx & 255; const float x = 2.f * (float)((k * t) & 255) / 256.f; MC[i] = (bf16_t)f2bf(rj == 0 ? cospif(x) : -sinpif(x)); }
    for (int i = gt; i < 2 * 4 * 64 * 64; i += NT) { const int lg = i >> 12, j = (i >> 6) & 63, ii = i & 63; PW[i] = (bf16_t)f2bf(F.pool_w()[(size_t)lg * 4096 + ii * 64 + j]); }
    LAS float* m12 = (LAS float*)(F.lds);
    LAS float* wt = (LAS float*)(F.lds + 32768);
    LAS float* trig = (LAS float*)(F.lds + 32768 + 65536);
    __syncthreads();
    if (F.tid < 64) { trig[F.tid] = cospif(2.f * (float)F.tid / 64.f); trig[64 + F.tid] = sinpif(2.f * (float)F.tid / 64.f); }
    for (int tile = F.bid; tile < 2 * 256; tile += F.G) {
        const int l = tile >> 8, kb = (tile >> 4) & 15, nb = tile & 15, k0 = 64 * kb, n0 = 32 * nb;
        __syncthreads();
        { const int cin = F.tid & 255, hf = F.tid >> 8, hh = cin >> 6, c = cin & 63;
#pragma unroll 1
          for (int q = 0; q < 16; ++q) { const int N = n0 + 16 * hf + q, sel = N >> 8, nn = N & 255; float s = 0.f; const float* fw = F.four_w() + (size_t)l * 65536 + (size_t)(hh * 64) * 256 + nn;
#pragma unroll 8
              for (int m = 0; m < 64; ++m) s += trig[sel * 64 + ((m * c) & 63)] * fw[m * 256];
              m12[cin * 32 + 16 * hf + q] = s; } }
        for (int i = F.tid; i < 64 * 256; i += NTHR) { const int k = i >> 8, cin = i & 255; wt[i] = F.w_in()[(size_t)l * D * DIN + (size_t)(k0 + k) * DIN + 2816 + cin]; }
        __syncthreads();
        { const int n = F.tid & 31, kq = F.tid >> 5; float a[4] = {0.f, 0.f, 0.f, 0.f};
#pragma unroll 4
          for (int cin = 0; cin < 256; ++cin) { const float mv = m12[cin * 32 + n];
#pragma unroll
              for (int i = 0; i < 4; ++i) a[i] += wt[(kq * 4 + i) * 256 + cin] * mv; }
          u32x2 w; w.x = pk2(a[0], a[1]); w.y = pk2(a[2], a[3]);
          *(u32x2*)(F.Wt_in() + (size_t)l * DINX * D + (size_t)(FQ_OFF + n0 + n) * D + k0 + kq * 4) = w; }
    }
    __syncthreads();
}

template <class SrcF> __device__ __forceinline__ void load_tile_T(LAS unsigned char* zt, const SrcF& src, int tid) {
    const int pg = tid >> 4, cc = tid & 15; u32x4 r[8];
#pragma unroll
    for (int i = 0; i < 8; ++i) r[i] = *(const GAS u32x4*)(src(8 * pg + i) + 8 * cc);
#pragma unroll
    for (int j = 0; j < 8; ++j) { const unsigned sel = (j & 1) ? 0x07060302u : 0x05040100u; u32x4 o;
        o.x = __builtin_amdgcn_perm(r[1][j >> 1], r[0][j >> 1], sel); o.y = __builtin_amdgcn_perm(r[3][j >> 1], r[2][j >> 1], sel);
        o.z = __builtin_amdgcn_perm(r[5][j >> 1], r[4][j >> 1], sel); o.w = __builtin_amdgcn_perm(r[7][j >> 1], r[6][j >> 1], sel);
        *(LAS u32x4*)(zt + (8 * cc + j) * ZS + 16 * pg) = o; }
}
__device__ __forceinline__ void tile_mma(const LAS unsigned char* zt, const bf16_t* mat_row  , f32x4 (&acc)[8], int lane) {
    const int fr = lane & 15, g = lane >> 4;
#pragma unroll
    for (int ks = 0; ks < 8; ++ks) { const bf16x8 b = *(const GAS bf16x8*)(mat_row + 32 * ks + 8 * g);
#pragma unroll
        for (int m = 0; m < 8; ++m) { const bf16x8 a = *(const LAS bf16x8*)(zt + (16 * m + fr) * ZS + (32 * ks + 8 * g) * 2); acc[m] = mfma16(a, b, acc[m]); }
        if (ks & 1) __builtin_amdgcn_sched_barrier(0); }
}
__device__ __forceinline__ void tile_mma2(const LAS unsigned char* zt, const bf16_t* mat_row0, const bf16_t* mat_row1, f32x4 (&acc0)[8], f32x4 (&acc1)[8], int lane) {
    const int fr = lane & 15, g = lane >> 4;
#pragma unroll
    for (int ks = 0; ks < 8; ++ks) { const bf16x8 b0 = *(const GAS bf16x8*)(mat_row0 + 32 * ks + 8 * g), b1 = *(const GAS bf16x8*)(mat_row1 + 32 * ks + 8 * g);
#pragma unroll
        for (int m = 0; m < 8; ++m) { const bf16x8 a = *(const LAS bf16x8*)(zt + (16 * m + fr) * ZS + (32 * ks + 8 * g) * 2); acc0[m] = mfma16(a, b0, acc0[m]); acc1[m] = mfma16(a, b1, acc1[m]); }
        __builtin_amdgcn_sched_barrier(0); }
}
struct SrcA { const bf16_t* P; int t2, hc; __device__ __forceinline__ const bf16_t* operator()(int p) const { const int ri = p >> 7, t1 = p & 127; return P + (size_t)(CTX + 128 * t1 + t2) * DINX + FQ_OFF + ri * 256 + 128 * hc; } };
struct SrcB { const bf16_t* Y; int k1, hc; __device__ __forceinline__ const bf16_t* operator()(int p) const { const int ri = p >> 7, t2 = p & 127; return Y + ((size_t)(k1 * 128 + t2) * 2 + ri) * 256 + 128 * hc; } };
struct SrcC { const bf16_t* P; int ri, hc; __device__ __forceinline__ const bf16_t* operator()(int p) const { return P + (size_t)p * DINX + FQ_OFF + ri * 256 + 128 * hc; } };

__device__ __forceinline__ void fftA_item(Frame& F, int item) {
    const int t2 = item >> 1, hc = item & 1; LAS unsigned char* zt = F.lds + RING_OFF;
    bf16_t* YP = (bf16_t*)(F.ws + WS_YP); const bf16_t* MA = (const bf16_t*)(F.ws + WS_WF + WF_MA);
    __syncthreads();
    load_tile_T(zt, SrcA{F.P(), t2, hc}, F.tid);
    __syncthreads();
    const int fr = F.lane & 15, g = F.lane >> 4, k1 = 16 * F.wave + fr;
    f32x4 ar[8], ai[8];
#pragma unroll
    for (int m = 0; m < 8; ++m) { ar[m] = (f32x4){0.f, 0.f, 0.f, 0.f}; ai[m] = (f32x4){0.f, 0.f, 0.f, 0.f}; }
    tile_mma2(zt, MA + (size_t)k1 * 256, MA + (size_t)(128 + k1) * 256, ar, ai, F.lane);
    const float x = 2.f * (float)(t2 * k1) / 16384.f; const float cs = cospif(x), sn = sinpif(x);
    bf16_t* yr = YP + ((size_t)(k1 * 128 + t2) * 2) * 256 + 128 * hc + 4 * g;
#pragma unroll
    for (int m = 0; m < 8; ++m) { const f32x4 a = ar[m], b = ai[m]; const f32x4 pr = a * cs + b * sn, pi = b * cs - a * sn;
        u32x2 w; w.x = pk2(pr[0], pr[1]); w.y = pk2(pr[2], pr[3]); *(u32x2*)(yr + 16 * m) = w;
        u32x2 v; v.x = pk2(pi[0], pi[1]); v.y = pk2(pi[2], pi[3]); *(u32x2*)(yr + 256 + 16 * m) = v; }
}
__device__ __forceinline__ void fftB_item(Frame& F, int item) {
    const int k1 = item >> 1, hc = item & 1; LAS unsigned char* zt = F.lds + RING_OFF;
    const bf16_t* YP = (const bf16_t*)(F.ws + WS_YP); const bf16_t* MB = (const bf16_t*)(F.ws + WS_WF + WF_MB);
    __syncthreads();
    load_tile_T(zt, SrcB{YP, k1, hc}, F.tid);
    __syncthreads();
    const int fr = F.lane & 15, g = F.lane >> 4, k2 = 16 * F.wave + fr;
    f32x4 acc[8];
#pragma unroll
    for (int m = 0; m < 8; ++m) acc[m] = (f32x4){0.f, 0.f, 0.f, 0.f};
    tile_mma(zt, MB + (size_t)k2 * 256, acc, F.lane);
    bf16_t* o = F.CAT() + (size_t)(CTX + k1 + 128 * k2) * D + 768 + 128 * hc + 4 * g;
#pragma unroll
    for (int m = 0; m < 8; ++m) { const f32x4 a = acc[m] * (1.f / 1024.f); u32x2 w; w.x = pk2(a[0], a[1]); w.y = pk2(a[2], a[3]); *(u32x2*)(o + 16 * m) = w; }
}
__device__ __forceinline__ void fftC_item(Frame& F, int item) {
    const int kh = item >> 1, hc = item & 1; LAS unsigned char* zt = F.lds + RING_OFF; const bf16_t* MC = (const bf16_t*)(F.ws + WS_WF + WF_MC);
    const int fr = F.lane & 15, g = F.lane >> 4, k = 128 * kh + 16 * F.wave + fr;
    f32x4 acc[8];
#pragma unroll
    for (int m = 0; m < 8; ++m) acc[m] = (f32x4){0.f, 0.f, 0.f, 0.f};
    for (int ri = 0; ri < 2; ++ri) {
        __syncthreads();
        load_tile_T(zt, SrcC{F.P(), ri, hc}, F.tid);
        __syncthreads();
        tile_mma(zt, MC + (size_t)k * 512 + ri * 256, acc, F.lane);
    }
    bf16_t* o = F.CAT() + (size_t)k * D + 768 + 128 * hc + 4 * g;
#pragma unroll
    for (int m = 0; m < 8; ++m) { const f32x4 a = acc[m] * (1.f / 128.f); u32x2 w; w.x = pk2(a[0], a[1]); w.y = pk2(a[2], a[3]); *(u32x2*)(o + 16 * m) = w; }
}

__device__ __forceinline__ void pool_item(Frame& F, int l, int item) {
    const int j = item >> 2, gi = item & 3, win = 2 << gi, lo = win >> 1, hi = win - 1 - lo;
    LAS float* V = (LAS float*)(F.lds);
    LAS unsigned* U = (LAS unsigned*)(F.lds + 65536);
    LAS unsigned char* At = F.lds + 65536 + 32768;
    const bf16_t* Pc = F.P() + 2560 + gi * 64;
    __syncthreads();
    if (j == 0) {
        for (int idx = F.tid; idx < 256 * 32; idx += NTHR) { const int t = idx >> 5, pr = idx & 31; const int a = max(t - lo, 0), b = min(t + hi, CTX - 1); float s0 = 0.f, s1 = 0.f;
            for (int r = a; r <= b; ++r) { const unsigned w = *(const GAS unsigned*)(Pc + (size_t)r * DINX + 2 * pr); s0 += bflo(w); s1 += bfhi(w); }
            const unsigned u = *(const GAS unsigned*)(Pc + (size_t)t * DINX + 2 * pr); const float inv = 1.f / (float)(b - a + 1);
            *(LAS unsigned*)(At + t * 144 + 4 * pr) = pk2(s0 * inv - bflo(u), s1 * inv - bfhi(u)); }
    } else {
        const int r0 = 4 * (j - 1);
        for (int idx = F.tid; idx < 64 * 32; idx += NTHR) { const int c = idx >> 5, pr = idx & 31; const int ra = max(r0 - lo, 0), rb = min(r0 + 3 + hi, LAT / GW - 1);
            float s0[4] = {0.f, 0.f, 0.f, 0.f}, s1[4] = {0.f, 0.f, 0.f, 0.f};
            for (int r = ra; r <= rb; ++r) { const unsigned w = *(const GAS unsigned*)(Pc + (size_t)(CTX + r * GW + c) * DINX + 2 * pr); const float x0 = bflo(w), x1 = bfhi(w);
#pragma unroll
                for (int i = 0; i < 4; ++i) { const bool in = (r >= r0 + i - lo) && (r <= r0 + i + hi); s0[i] += in ? x0 : 0.f; s1[i] += in ? x1 : 0.f; if (r == r0 + i) U[(i * 64 + c) * 32 + pr] = w; } }
#pragma unroll
            for (int i = 0; i < 4; ++i) { V[(i * 64 + c) * 64 + 2 * pr] = s0[i]; V[(i * 64 + c) * 64 + 2 * pr + 1] = s1[i]; } }
        __syncthreads();
        for (int idx = F.tid; idx < 4 * 8 * 64; idx += NTHR) { const int ch = idx & 63, cb = (idx >> 6) & 7, i = idx >> 9; const int r = r0 + i;
            const float cr = (float)(min(r + hi, LAT / GW - 1) - max(r - lo, 0) + 1); const LAS float* Vr = V + (i * 64) * 64 + ch;
            const int c0 = 8 * cb; float s = 0.f; for (int c = max(c0 - lo, 0); c <= min(c0 + hi, GW - 1); ++c) s += Vr[c * 64];
            for (int q = 0; q < 8; ++q) { const int c = c0 + q; if (q > 0) { if (c + hi <= GW - 1) s += Vr[(c + hi) * 64]; if (c - 1 - lo >= 0) s -= Vr[(c - 1 - lo) * 64]; }
                const float cc = (float)(min(c + hi, GW - 1) - max(c - lo, 0) + 1); const unsigned uw = U[(i * 64 + c) * 32 + (ch >> 1)]; const float u = (ch & 1) ? bfhi(uw) : bflo(uw);
                *(LAS unsigned short*)(At + (i * 64 + c) * 144 + 2 * ch) = (unsigned short)f2bf(s / (cr * cc) - u); } }
    }
    __syncthreads();
    const bf16_t* PW = (const bf16_t*)(F.ws + WS_WF + WF_PW) + (size_t)(l * 4 + gi) * 4096; const int fr = F.lane & 15, g = F.lane >> 4;
    f32x4 acc[4][2];
#pragma unroll
    for (int n = 0; n < 4; ++n) { acc[n][0] = (f32x4){0.f, 0.f, 0.f, 0.f}; acc[n][1] = (f32x4){0.f, 0.f, 0.f, 0.f}; }
#pragma unroll
    for (int ks = 0; ks < 2; ++ks) { bf16x8 b[2];
#pragma unroll
        for (int mt = 0; mt < 2; ++mt) b[mt] = *(const LAS bf16x8*)(At + (32 * F.wave + 16 * mt + fr) * 144 + (32 * ks + 8 * g) * 2);
#pragma unroll
        for (int n = 0; n < 4; ++n) { const bf16x8 a = *(const GAS bf16x8*)(PW + (16 * n + fr) * 64 + 32 * ks + 8 * g);
#pragma unroll
            for (int mt = 0; mt < 2; ++mt) acc[n][mt] = mfma16(a, b[mt], acc[n][mt]); } }
    const int rowbase = j == 0 ? 0 : CTX + 256 * (j - 1);
#pragma unroll
    for (int n = 0; n < 4; ++n) { const f32x4 sc = *(const GAS f32x4*)(F.pool_s() + l * 256 + gi * 64 + 16 * n + 4 * g);
#pragma unroll
        for (int mt = 0; mt < 2; ++mt) { const f32x4 a = acc[n][mt] * sc; u32x2 w; w.x = pk2(a[0], a[1]); w.y = pk2(a[2], a[3]);
            *(u32x2*)(F.CAT() + (size_t)(rowbase + 32 * F.wave + 16 * mt + fr) * D + 512 + gi * 64 + 16 * n + 4 * g) = w; } }
}

constexpr int SC_FT = 0, SC_QT = 18432, SC_VT = 36864, SC_BQ = 55296, SC_BF = 72704, SC_KT = 90112, SC_PM = 108544, SC_G = 117760, SC_TOT = 135168, SC_DEC = 137216, SC_SSQ = 138752, SC_END = 140800;
static_assert(SC_END <= MISC_OFF, "scan LDS map");
template <int DIR, bool FULL> __device__ __forceinline__ void scan_fetch(const Frame& F, int h, int row0, u32x4 (&r)[8]) {
    const GAS bf16_t* P = (const GAS bf16_t*)F.P(); const int tid = F.tid;
    if (tid < 384) { const int tile = tid >> 7, blk = tid & 127, tg = blk >> 4, kc = blk & 15; if (!FULL && tile == 1) return;
        const int colb = tile == 0 ? 512 * (1 + DIR) : (tile == 1 ? 0 : 1536); const GAS bf16_t* src = P + (unsigned)((row0 + 8 * tg) * DINX + colb + h * 128 + 8 * kc);
#pragma unroll
        for (int i = 0; i < 8; ++i) r[i] = *(const GAS u32x4*)(src + (unsigned)(i * DINX)); }
    else if (FULL && DIR == 1) { const int q = tid - 384; const GAS bf16_t* src = P + (unsigned)((row0 + (q >> 4)) * DINX + 2048 + h * 128 + 8 * (q & 15));
#pragma unroll
        for (int i = 0; i < 8; ++i) r[i] = *(const GAS u32x4*)(src + (unsigned)(i * 8 * DINX)); }
}
template <int DIR, bool FULL> __device__ __forceinline__ void scan_commit(const Frame& F, const u32x4 (&r)[8]) {
    LAS unsigned char* L = F.lds + RING_OFF; const int tid = F.tid;
    if (tid < 384) { const int tile = tid >> 7, blk = tid & 127, tg = blk >> 4, kc = blk & 15; if (!FULL && tile == 1) return;
#pragma unroll
        for (int j = 0; j < 8; ++j) { const unsigned sel = (j & 1) ? 0x07060302u : 0x05040100u; u32x4 o;
            o.x = __builtin_amdgcn_perm(r[1][j >> 1], r[0][j >> 1], sel); o.y = __builtin_amdgcn_perm(r[3][j >> 1], r[2][j >> 1], sel);
            o.z = __builtin_amdgcn_perm(r[5][j >> 1], r[4][j >> 1], sel); o.w = __builtin_amdgcn_perm(r[7][j >> 1], r[6][j >> 1], sel);
            *(LAS u32x4*)(L + tile * 18432 + (8 * kc + j) * 144 + 16 * tg) = o; } }
    else if (FULL && DIR == 1) { const int q = tid - 384; LAS unsigned char* dst = L + SC_G + (q >> 4) * 272 + 16 * (q & 15);
#pragma unroll
        for (int i = 0; i < 8; ++i) *(LAS u32x4*)(dst + i * 8 * 272) = r[i]; }
}
template <int DIR, bool FULL> __device__ __forceinline__ void scan_chunk(Frame& F, int l, int h, int nrow0, u32x4 (&pre)[8], f32x4 (&S)[8], f32x4 (&o)[4], float& segsum, const GAS float* oload = nullptr) {
    LAS unsigned char* L = F.lds + RING_OFF; int lane = F.lane; asm volatile("" : "+v"(lane));
    const int w = F.wave, tid = w * 64 + lane, fr = lane & 15, g = lane >> 4;
    LAS float* TOT = (LAS float*)(L + SC_TOT); LAS float* DEC = (LAS float*)(L + SC_DEC); LAS float* C1 = DEC + 128; LAS float* C2 = DEC + 256;
    __syncthreads();
    scan_commit<DIR, FULL>(F, pre);
    __syncthreads();
    const int k = tid & 127, qu = tid >> 7;
    float bl[16]; float run = 0.f;
    { const u32x4 fa = *(const LAS u32x4*)(L + SC_FT + k * 144 + 32 * qu), fb = *(const LAS u32x4*)(L + SC_FT + k * 144 + 32 * qu + 16); const unsigned fw[8] = {fa.x, fa.y, fa.z, fa.w, fb.x, fb.y, fb.z, fb.w};
#pragma unroll
      for (int i = 0; i < 16; ++i) { const int ti = (DIR == 0 ? i : 15 - i); run += (ti & 1) ? f16hi(fw[ti >> 1]) : f16lo(fw[ti >> 1]); bl[i] = run; } }
    TOT[qu * 128 + k] = run;
    __syncthreads();
    const float t0 = TOT[k], t1 = TOT[128 + k], t2 = TOT[256 + k], t3 = TOT[384 + k]; const float total = (t0 + t1) + (t2 + t3);
    float off, ref;
    if (DIR == 0) { off = qu == 0 ? 0.f : (qu == 1 ? t0 : (qu == 2 ? t0 + t1 : t0 + t1 + t2)); ref = t0 + t1; }
    else { off = qu == 3 ? 0.f : (qu == 2 ? t3 : (qu == 1 ? t3 + t2 : t3 + t2 + t1)); ref = t3 + t2; }
    if (qu == 0) { DEC[k] = __builtin_amdgcn_exp2f(total); C1[k] = __builtin_amdgcn_exp2f(ref); C2[k] = __builtin_amdgcn_exp2f(total - ref); segsum += total; }
    { unsigned qw[8];
      if (FULL) { const u32x4 qa = *(const LAS u32x4*)(L + SC_QT + k * 144 + 32 * qu), qb = *(const LAS u32x4*)(L + SC_QT + k * 144 + 32 * qu + 16); qw[0] = qa.x; qw[1] = qa.y; qw[2] = qa.z; qw[3] = qa.w; qw[4] = qb.x; qw[5] = qb.y; qw[6] = qb.z; qw[7] = qb.w; }
      float ktv[16]; const float sh = off - ref;
#pragma unroll
      for (int i = 0; i < 16; ++i) { const int ti = (DIR == 0 ? i : 15 - i), t = 16 * qu + ti; const float lf = i == 0 ? bl[0] : bl[i] - bl[i - 1]; const float b = bl[i] + sh;
          const float E = __builtin_amdgcn_exp2f(b), Ei = __builtin_amdgcn_rcpf(E), kk = 1.f - __builtin_amdgcn_exp2f(lf); ktv[ti] = kk * Ei;
          if (FULL) { const float qs = (ti & 1) ? bfhi(qw[ti >> 1]) : bflo(qw[ti >> 1]); *(LAS unsigned short*)(L + SC_BQ + t * 272 + 2 * k) = (unsigned short)(cvt_pk_bf16(qs * E, 0.f)); } }
      u32x4 a, b2; a.x = cvt_pk_bf16(ktv[0], ktv[1]); a.y = cvt_pk_bf16(ktv[2], ktv[3]); a.z = cvt_pk_bf16(ktv[4], ktv[5]); a.w = cvt_pk_bf16(ktv[6], ktv[7]);
      b2.x = cvt_pk_bf16(ktv[8], ktv[9]); b2.y = cvt_pk_bf16(ktv[10], ktv[11]); b2.z = cvt_pk_bf16(ktv[12], ktv[13]); b2.w = cvt_pk_bf16(ktv[14], ktv[15]);
      *(LAS u32x4*)(L + SC_KT + k * 144 + 32 * qu) = a; *(LAS u32x4*)(L + SC_KT + k * 144 + 32 * qu + 16) = b2;
      if (FULL) { const unsigned kw[8] = {a.x, a.y, a.z, a.w, b2.x, b2.y, b2.z, b2.w};
#pragma unroll
          for (int ti = 0; ti < 16; ++ti) *(LAS unsigned short*)(L + SC_BF + (16 * qu + ti) * 272 + 2 * k) = (unsigned short)((ti & 1) ? (kw[ti >> 1] >> 16) : (kw[ti >> 1] & 0xffffu)); } }
    __syncthreads();
    if (nrow0 >= 0) scan_fetch<DIR, FULL>(F, h, nrow0, pre);
    if (FULL) {
#pragma unroll
        for (int tb = 0; tb < 4; ++tb)
#pragma unroll
            for (int r = 0; r < 4; ++r) o[tb][r] = oload ? oload[(tb * 4 + r) * 512] : 0.f; }
    __builtin_amdgcn_sched_barrier(0);
    if (FULL) {
        const int tb = w >> 1;
#pragma unroll
        for (int q = 0; q < 2; ++q) { const int sb = 2 * (w & 1) + q; f32x4 acc = (f32x4){0.f, 0.f, 0.f, 0.f};
#pragma unroll
            for (int ks = 0; ks < 4; ++ks) { const bf16x8 a = *(const LAS bf16x8*)(L + SC_BF + (16 * sb + fr) * 272 + (32 * ks + 8 * g) * 2); const bf16x8 b = *(const LAS bf16x8*)(L + SC_BQ + (16 * tb + fr) * 272 + (32 * ks + 8 * g) * 2);
                acc = mfma16(a, b, acc); }
            const int t = 16 * tb + fr; float m[4];
#pragma unroll
            for (int r = 0; r < 4; ++r) { const int s = 16 * sb + 4 * g + r; const bool keep = DIR == 0 ? (s <= t) : (s >= t); m[r] = keep ? acc[r] : 0.f; }
            u32x2 wv; wv.x = pk2(m[0], m[1]); wv.y = pk2(m[2], m[3]); *(LAS u32x2*)(L + SC_PM + t * 144 + (16 * sb + 4 * g) * 2) = wv; }
        __syncthreads();
    }
    bf16x8 vt[2];
#pragma unroll
    for (int ks = 0; ks < 2; ++ks) vt[ks] = *(const LAS bf16x8*)(L + SC_VT + (16 * w + fr) * 144 + (32 * ks + 8 * g) * 2);
    if (FULL) {
        bf16x8 sf[4];
#pragma unroll
        for (int ks = 0; ks < 4; ++ks) { const f32x4 ca = *(const LAS f32x4*)(C1 + 32 * ks + 4 * g), cb = *(const LAS f32x4*)(C1 + 32 * ks + 16 + 4 * g); const f32x4 x = S[2 * ks] * ca, y = S[2 * ks + 1] * cb;
            u32x4 pkd; pkd.x = pk2(x[0], x[1]); pkd.y = pk2(x[2], x[3]); pkd.z = pk2(y[0], y[1]); pkd.w = pk2(y[2], y[3]); sf[ks] = __builtin_bit_cast(bf16x8, pkd); }
#pragma unroll
        for (int tb = 0; tb < 4; ++tb) { f32x4 acc = o[tb];
#pragma unroll
            for (int ks = 0; ks < 4; ++ks) { const u32x2 a0 = *(const LAS u32x2*)(L + SC_BQ + (16 * tb + fr) * 272 + (32 * ks + 4 * g) * 2), a1 = *(const LAS u32x2*)(L + SC_BQ + (16 * tb + fr) * 272 + (32 * ks + 16 + 4 * g) * 2);
                u32x4 pa; pa.x = a0.x; pa.y = a0.y; pa.z = a1.x; pa.w = a1.y; acc = mfma16(__builtin_bit_cast(bf16x8, pa), sf[ks], acc); }
#pragma unroll
            for (int ks = 0; ks < 2; ++ks) { const bf16x8 a = *(const LAS bf16x8*)(L + SC_PM + (16 * tb + fr) * 144 + (32 * ks + 8 * g) * 2); acc = mfma16(a, vt[ks], acc); }
            o[tb] = acc; __builtin_amdgcn_sched_barrier(0); }
    }
#pragma unroll
    for (int kb = 0; kb < 8; ++kb) { f32x4 tmp = (f32x4){0.f, 0.f, 0.f, 0.f};
#pragma unroll
        for (int ks = 0; ks < 2; ++ks) { const bf16x8 a = *(const LAS bf16x8*)(L + SC_KT + (16 * kb + fr) * 144 + (32 * ks + 8 * g) * 2); tmp = mfma16(a, vt[ks], tmp); }
        const f32x4 dc = *(const LAS f32x4*)(DEC + 16 * kb + 4 * g), c2 = *(const LAS f32x4*)(C2 + 16 * kb + 4 * g); S[kb] = dc * S[kb] + c2 * tmp; if (kb & 1) __builtin_amdgcn_sched_barrier(0); }
}
__device__ __forceinline__ void state_store(float* dst, const f32x4 (&S)[8], int w, int lane) {
    GAS float* p = (GAS float*)dst + (unsigned)(w * 2048 + lane);
#pragma unroll
    for (int kb = 0; kb < 8; ++kb)
#pragma unroll
        for (int r = 0; r < 4; ++r) p[(kb * 4 + r) * 64] = S[kb][r]; }
__device__ __forceinline__ void state_load(const float* src, f32x4 (&S)[8], int w, int lane) {
    const GAS float* p = (const GAS float*)src + (unsigned)(w * 2048 + lane);
#pragma unroll
    for (int kb = 0; kb < 8; ++kb)
#pragma unroll
        for (int r = 0; r < 4; ++r) S[kb][r] = p[(kb * 4 + r) * 64]; }
__device__ __forceinline__ float* sc_SU(Frame& F) { return (float*)(F.ws + WS_SU); }
__device__ __forceinline__ float* sc_SS(Frame& F) { return (float*)(F.ws + WS_SS); }
__device__ __forceinline__ float* sc_SD(Frame& F) { return (float*)(F.ws + WS_SD); }
__device__ __forceinline__ float* sc_CARRY(Frame& F) { return (float*)(F.ws + WS_SD) + 8 * 64 * 128; }

__device__ __forceinline__ float* sc_OSCR(Frame& F) { return (float*)(F.ws + WS_OSCR) + (size_t)F.bid * 32768; }
__device__ __forceinline__ void scanA_item(Frame& F, int l, int item) {
    const int h = item >> 6, seg = item & 63, segrow = CTX + 256 * seg; f32x4 S[8], odummy[4]; float segsum; u32x4 pre[8];
#pragma unroll
    for (int kb = 0; kb < 8; ++kb) S[kb] = (f32x4){0.f, 0.f, 0.f, 0.f};
    segsum = 0.f;
    scan_fetch<0, false>(F, h, segrow, pre);
#pragma unroll 1
    for (int c_ = 0; c_ < 4; ++c_) { int c = c_; asm volatile("" : "+s"(c)); scan_chunk<0, false>(F, l, h, c < 3 ? segrow + 64 * (c + 1) : -1, pre, S, odummy, segsum); }
    state_store(sc_SU(F) + ((size_t)(h * 2 + 0) * 64 + seg) * 16384, S, F.wave, F.lane);
    if (F.tid < 128) sc_SD(F)[((h * 2 + 0) * 64 + seg) * 128 + F.tid] = __builtin_amdgcn_exp2f(segsum);
#pragma unroll
    for (int kb = 0; kb < 8; ++kb) S[kb] = (f32x4){0.f, 0.f, 0.f, 0.f};
    segsum = 0.f;
    scan_fetch<1, false>(F, h, segrow + 192, pre);
#pragma unroll 1
    for (int c_ = 3; c_ >= 0; --c_) { int c = c_; asm volatile("" : "+s"(c)); scan_chunk<1, false>(F, l, h, c > 0 ? segrow + 64 * (c - 1) : -1, pre, S, odummy, segsum); }
    state_store(sc_SU(F) + ((size_t)(h * 2 + 1) * 64 + seg) * 16384, S, F.wave, F.lane);
    if (F.tid < 128) sc_SD(F)[((h * 2 + 1) * 64 + seg) * 128 + F.tid] = __builtin_amdgcn_exp2f(segsum);
}
__device__ __forceinline__ void scan_full(Frame& F, int l, int h, int segrow, const float* sinf, const float* sinb, float* outf, float* outb) {
    f32x4 S[8], o[4]; float segsum = 0.f; const int w = F.wave, lane = F.lane, fr = lane & 15, g = lane >> 4; u32x4 pre[8];
    GAS float* oscr = (GAS float*)sc_OSCR(F) + (unsigned)F.tid;
    if (sinf) state_load(sinf, S, w, lane); else {
#pragma unroll
        for (int kb = 0; kb < 8; ++kb) S[kb] = (f32x4){0.f, 0.f, 0.f, 0.f}; }
    scan_fetch<0, true>(F, h, segrow, pre);
#pragma unroll 1
    for (int c_ = 0; c_ < 4; ++c_) { int c = c_; asm volatile("" : "+s"(c));
        scan_chunk<0, true>(F, l, h, c < 3 ? segrow + 64 * (c + 1) : -1, pre, S, o, segsum);
#pragma unroll
        for (int tb = 0; tb < 4; ++tb)
#pragma unroll
            for (int r = 0; r < 4; ++r) (oscr + c * 8192)[(tb * 4 + r) * 512] = o[tb][r];
    }
    if (outf) state_store(outf, S, w, lane);
    VM_WAIT();
    if (sinb) state_load(sinb, S, w, lane); else {
#pragma unroll
        for (int kb = 0; kb < 8; ++kb) S[kb] = (f32x4){0.f, 0.f, 0.f, 0.f}; }
    LAS unsigned char* L = F.lds + RING_OFF; LAS float* SSQ = (LAS float*)(L + SC_SSQ);
    const float ngv = F.hng()[l * 512 + h * 128 + 16 * w + fr];
    scan_fetch<1, true>(F, h, segrow + 192, pre);
#pragma unroll 1
    for (int c_ = 3; c_ >= 0; --c_) { int c = c_; asm volatile("" : "+s"(c));
        scan_chunk<1, true>(F, l, h, c > 0 ? segrow + 64 * (c - 1) : -1, pre, S, o, segsum, oscr + c * 8192);
#pragma unroll
        for (int tb = 0; tb < 4; ++tb) { f32x4 q = o[tb] * o[tb];
#pragma unroll
            for (int m = 1; m < 16; m <<= 1) { q[0] += lane_xor(q[0], m, lane); q[1] += lane_xor(q[1], m, lane); q[2] += lane_xor(q[2], m, lane); q[3] += lane_xor(q[3], m, lane); }
            if (fr == 0) {
#pragma unroll
                for (int r = 0; r < 4; ++r) SSQ[(16 * tb + 4 * g + r) * 8 + w] = q[r]; } }
        __syncthreads();
#pragma unroll
        for (int tb = 0; tb < 4; ++tb)
#pragma unroll
            for (int r = 0; r < 4; ++r) { const int t = 16 * tb + 4 * g + r; const f32x4 p0 = *(const LAS f32x4*)(SSQ + t * 8), p1 = *(const LAS f32x4*)(SSQ + t * 8 + 4);
                const float ss = ((p0[0] + p0[1]) + (p0[2] + p0[3])) + ((p1[0] + p1[1]) + (p1[2] + p1[3])); const float rs = rsqrtf(ss * (1.f / 128.f) + 1e-6f);
                const float gp = bf2f(*(const LAS unsigned short*)(L + SC_G + t * 272 + 2 * (16 * w + fr)));
                *(LAS unsigned short*)(L + SC_BQ + t * 272 + 2 * (16 * w + fr)) = (unsigned short)f2bf(o[tb][r] * rs * ngv * gp); }
        __syncthreads();
#pragma unroll
        for (int i = 0; i < 2; ++i) { const int id = F.tid + 512 * i, row = id >> 4, cc = id & 15; const u32x4 d = *(const LAS u32x4*)(L + SC_BQ + row * 272 + 16 * cc);
            *(GAS u32x4*)((GAS bf16_t*)F.CAT() + (unsigned)((segrow + 64 * c + row) * D + h * 128 + 8 * cc)) = d; }
    }
    if (outb) state_store(outb, S, w, lane);
}
__device__ __forceinline__ void scanB(Frame& F) {
    const int e = F.bid * NTHR + F.tid; if (e >= 8 * 16384) return;
    const int hd = e >> 14, idx = e & 16383, d = hd & 1; const int ln = idx & 63, reg = (idx >> 6) & 3, kb = (idx >> 8) & 7; const int k = 16 * kb + 4 * (ln >> 4) + reg;
    const float* SU = sc_SU(F) + (size_t)hd * 64 * 16384 + idx; const float* SD = sc_SD(F) + hd * 64 * 128 + k; float* SS = sc_SS(F) + (size_t)hd * 64 * 16384 + idx;
    float S = sc_CARRY(F)[hd * 16384 + idx];
    if (d == 0) { for (int seg = 0; seg < 64; ++seg) { SS[(size_t)seg * 16384] = S; S = SD[seg * 128] * S + SU[(size_t)seg * 16384]; } }
    else { for (int seg = 63; seg >= 0; --seg) { SS[(size_t)seg * 16384] = S; S = SD[seg * 128] * S + SU[(size_t)seg * 16384]; } }
}

__device__ __forceinline__ void ph_mixA(Frame& F, int l) {
    scanA_item(F, l, F.bid);
    if (F.bid >= 4 && F.bid < 8) { const int h = F.bid - 4; scan_full(F, l, h, 0, nullptr, nullptr, sc_CARRY(F) + (h * 2 + 0) * 16384, sc_CARRY(F) + (h * 2 + 1) * 16384); }
    fftA_item(F, F.bid);
    for (int it = F.bid; it < 65 * 4; it += F.G) pool_item(F, l, it);
}
__device__ __forceinline__ void ph_mixB(Frame& F, int l) {
    scanB(F);
    fftB_item(F, F.bid);
    if (l == 0 && F.bid >= 252) fftC_item(F, F.bid - 252);
}
__device__ __forceinline__ void ph_mixC(Frame& F, int l) {
    const int item = F.bid, h = item >> 6, seg = item & 63;
    scan_full(F, l, h, CTX + 256 * seg, sc_SS(F) + ((size_t)(h * 2 + 0) * 64 + seg) * 16384, sc_SS(F) + ((size_t)(h * 2 + 1) * 64 + seg) * 16384, nullptr, nullptr);
}
#ifndef DUP
#define DUP -1
#endif
#define GRID_BAR() do { { Frame R = relaunder(F); xcd_barrier(bar, R.tid); } if (DUP == 99) { Frame R = relaunder(F); xcd_barrier(bar, R.tid); } } while (0)
__global__ void __launch_bounds__(NTHR, 2) mega_fwd(Params p) {
    extern __shared__ __attribute__((aligned(16))) unsigned char lds[];
    Frame F; frame_init(F, p, lds);
    if (F.tid < 16) ((LAS unsigned*)(F.lds + MISC_OFF))[F.tid] = 0u;
    __syncthreads();
    XcdBarrier bar = xcd_barrier_post((unsigned*)(F.ctl() + CW_BAR), (volatile LAS unsigned*)(F.lds + MISC_OFF + 32));
    { Frame R = relaunder(F); ph_prologue(R); } { Frame R = relaunder(F); ph_prologue2(R); }
    if (DUP == 0) { { Frame R = relaunder(F); ph_prologue(R); } { Frame R = relaunder(F); ph_prologue2(R); } }
    GRID_BAR();
    { Frame R = relaunder(F); ph_mod1(R, 0); }
    if (DUP == 1) { Frame R = relaunder(F); ph_mod1(R, 0); }
    GRID_BAR();
#pragma unroll 1
    for (int l = 0; l < 2; ++l) {
        { Frame R = relaunder(F); ph_win(R, l); }        if (DUP == 2) { Frame R = relaunder(F); ph_win(R, l); }        GRID_BAR();
        { Frame R = relaunder(F); ph_mixA(R, l); }       if (DUP == 3) { Frame R = relaunder(F); ph_mixA(R, l); }       GRID_BAR();
        { Frame R = relaunder(F); ph_mixB(R, l); }       if (DUP == 4) { Frame R = relaunder(F); ph_mixB(R, l); }       GRID_BAR();
        { Frame R = relaunder(F); ph_mixC(R, l); }       if (DUP == 5) { Frame R = relaunder(F); ph_mixC(R, l); }       GRID_BAR();
        { Frame R = relaunder(F); ph_wout(R, l); }       if (DUP == 6 && l == 0) { Frame R = relaunder(F); ph_wout(R, l); }   GRID_BAR();
        if (DUP == 7) { { Frame R = relaunder(F); ph_mod2_route(R, l, l + 2); } GRID_BAR(); }
        { Frame R = relaunder(F); ph_mod2_route(R, l, l); } GRID_BAR();
        { Frame R = relaunder(F); ph_gateup(R, l); }     if (DUP == 8) { Frame R = relaunder(F); ph_gateup(R, l); }     GRID_BAR();
        { Frame R = relaunder(F); ph_down(R, l); }       if (DUP == 9) { Frame R = relaunder(F); ph_down(R, l); }       GRID_BAR();
        { Frame R = relaunder(F); ph_combine(R, l); }    if (DUP == 10 && l == 1) { Frame R = relaunder(F); ph_combine(R, l); }
        if (l == 0) GRID_BAR();
    }
}
extern "C" void kernel_launch(void* const* d_in, const int* in_sizes, int n_in, void* d_out, int out_size, void* d_ws, size_t ws_size, hipStream_t stream) {
    static int ok = 0;
    if (ok == 0) {
        if (n_in != 22 || out_size != LAT * D || ws_size < WS_FASTEND) { fprintf(stderr, "kernel_launch: unexpected shapes / workspace (n_in %d, out %d, ws %zu < %zu); nothing launched\n", n_in, out_size, ws_size, (size_t)WS_FASTEND); ok = -1; return; }
        int dev = 0, cus = 0, per_cu = 0;
        if (hipGetDevice(&dev) != hipSuccess || hipDeviceGetAttribute(&cus, hipDeviceAttributeMultiprocessorCount, dev) != hipSuccess) { ok = -1; return; }
        if (hipFuncSetAttribute((const void*)mega_fwd, hipFuncAttributeMaxDynamicSharedMemorySize, LDS_BYTES) != hipSuccess) { fprintf(stderr, "kernel_launch: hipFuncSetAttribute failed\n"); ok = -1; return; }
        if (hipOccupancyMaxActiveBlocksPerMultiprocessor(&per_cu, (const void*)mega_fwd, NTHR, LDS_BYTES) != hipSuccess || per_cu < 1) fprintf(stderr, "kernel_launch: note: occupancy query reports %d workgroups per CU\n", per_cu);
        (void)hipGetLastError();
        if (cus < 256) fprintf(stderr, "kernel_launch: device has %d CUs; this kernel needs 256 co-resident workgroups (one per CU)\n", cus);
        ok = 1;
    }
    if (ok < 0) return;
    if (hipMemsetAsync((char*)d_ws + WS_CTL, 0, CTL_ZERO_BYTES, stream) != hipSuccess) return;
    Params p{}; for (int i = 0; i < 22; ++i) p.in[i] = (const float*)d_in[i]; p.out = (float*)d_out; p.ws = (unsigned char*)d_ws;
    hipLaunchKernelGGL(mega_fwd, dim3(256), dim3(NTHR), LDS_BYTES, stream, p);
}
```

```cpp
#include <hip/hip_runtime.h>
#include <cstdio>
#include <cstdint>
#define DUP -1
constexpr int D = 1024, LAT = 16384, CTX = 256, T = LAT + CTX, DIN = 3072, NE = 32, TOPK = 4;
constexpr int GW = 64;
#ifndef PSTR
#define PSTR DIN
#endif
constexpr int DINX = 3328, FQ_OFF = 2816;
#define GAS __attribute__((address_space(1)))
#define LAS __attribute__((address_space(3)))
typedef unsigned short bf16_t;
typedef short bf16x8 __attribute__((ext_vector_type(8)));
typedef short bf16x4 __attribute__((ext_vector_type(4)));
typedef float f32x4 __attribute__((ext_vector_type(4)));
typedef float f32x2 __attribute__((ext_vector_type(2)));
typedef unsigned u32x4 __attribute__((ext_vector_type(4)));
typedef unsigned u32x2 __attribute__((ext_vector_type(2)));
typedef GAS unsigned gu32;
#define RLX_AGENT __ATOMIC_RELAXED, __HIP_MEMORY_SCOPE_AGENT
#define LDS_WAIT() asm volatile("s_waitcnt lgkmcnt(0)" ::: "memory")
#define VM_WAIT() asm volatile("s_waitcnt vmcnt(0)" ::: "memory")
__device__ __forceinline__ unsigned f2bf(float f) { unsigned u = __builtin_bit_cast(unsigned, f); return (u + 0x7fffu + ((u >> 16) & 1u)) >> 16; }
__device__ __forceinline__ unsigned pk2(float lo, float hi) { return f2bf(lo) | (f2bf(hi) << 16); }
__device__ __forceinline__ float bf2f(unsigned short b) { return __builtin_bit_cast(float, ((unsigned)b) << 16); }
__device__ __forceinline__ float bflo(unsigned w) { return __builtin_bit_cast(float, w << 16); }
__device__ __forceinline__ float bfhi(unsigned w) { return __builtin_bit_cast(float, w & 0xffff0000u); }
__device__ __forceinline__ unsigned cvt_pk_bf16(float lo, float hi) { unsigned r; asm volatile("v_cvt_pk_bf16_f32 %0, %1, %2" : "=v"(r) : "v"(lo), "v"(hi)); return r; }
__device__ __forceinline__ float fsigm(float x) { return __builtin_amdgcn_rcpf(1.f + __builtin_amdgcn_exp2f(-1.44269504f * x)); }
__device__ __forceinline__ float lane_xor(float v, int m, int lane) { return __builtin_bit_cast(float, __builtin_amdgcn_ds_bpermute((lane ^ m) << 2, __builtin_bit_cast(int, v))); }
__device__ __forceinline__ int lane_get(int v, int src) { return __builtin_amdgcn_ds_bpermute(src << 2, v); }
__device__ __forceinline__ float wave_sum(float v, int lane) {
#pragma unroll
    for (int o = 1; o < 64; o <<= 1) v += lane_xor(v, o, lane);
    return v;
}

#define XB_TMO      128
#define XB_XCNT(j)  (256  + 64 * (j))
#define XB_XSUB(j)  (1280 + 64 * (j))
#define XB_XGEN(j)  (2304 + 64 * (j))
#define XB_TOP      3328
#define XB_TOPGEN   3392
#define XCD_BAR_WORDS 3456
#define XB_SPIN_CAP (1u << 18)
__device__ __forceinline__ unsigned xb_ld(unsigned* p)              { return __hip_atomic_load(p, __ATOMIC_RELAXED, __HIP_MEMORY_SCOPE_AGENT); }
__device__ __forceinline__ unsigned xb_add(unsigned* p, unsigned v) { return __hip_atomic_fetch_add(p, v, __ATOMIC_RELAXED, __HIP_MEMORY_SCOPE_AGENT); }
__device__ __forceinline__ unsigned xb_xcc_id() { return (unsigned)__builtin_amdgcn_s_getreg((3 << 11) | 20) & 0xFu; }
#define XB_SPIN(cond, bar) do { unsigned _sp = 0; while (cond) { __builtin_amdgcn_s_sleep(1); \
    if ((++_sp & 255u) == 0u) { if (xb_ld(&(bar)[XB_TMO])) break; if (_sp > XB_SPIN_CAP) { atomicAdd(&(bar)[XB_TMO], 1u); break; } } } } while (0)
struct XcdBarrier { unsigned* bar; unsigned x; volatile LAS unsigned* st; };
__device__ __forceinline__ XcdBarrier xcd_barrier_post(unsigned* bar, volatile LAS unsigned* st) {
    XcdBarrier b; b.bar = bar; b.x = xb_xcc_id(); b.st = st;
    if (threadIdx.x == 0) (void)xb_add(&bar[XB_XCNT(b.x)], 1u);
    return b;
}
__device__ __forceinline__ void xcd_barrier_complete(unsigned* bar, unsigned x, unsigned& nloc, unsigned& nx) {
    const unsigned G = gridDim.x * gridDim.y * gridDim.z;
    unsigned sum, cnt, mine, sp = 0u;
    for (;;) {
        sum = 0u; cnt = 0u; mine = 0u;
#pragma unroll
        for (unsigned j = 0; j < 16; ++j) { const unsigned c = xb_ld(&bar[XB_XCNT(j)]); sum += c; cnt += (c > 0u) ? 1u : 0u; mine = (j == x) ? c : mine; }
        if (sum == G) break;
        __builtin_amdgcn_s_sleep(1);
        if ((++sp & 255u) == 0u) { if (xb_ld(&bar[XB_TMO])) break; if (sp > XB_SPIN_CAP) { atomicAdd(&bar[XB_TMO], 1u); break; } }
    }
    nloc = mine > 0u ? mine : 1u; nx = cnt > 0u ? cnt : 1u;
}
__device__ __forceinline__ void xcd_barrier(const XcdBarrier& b, const int tid) {
    asm volatile("s_waitcnt vmcnt(0)" ::: "memory");
    unsigned blo = (unsigned)(unsigned long long)b.bar, bhi = (unsigned)((unsigned long long)b.bar >> 32), bx = b.x;
    asm volatile("" : "+s"(blo), "+s"(bhi), "+s"(bx));
    __syncthreads();
    if (tid == 0) {
        unsigned* bar = (unsigned*)(((unsigned long long)bhi << 32) | blo);
        __builtin_amdgcn_s_waitcnt(0);
        unsigned nloc = b.st[0], nx = b.st[1];
        if (nloc == 0u) { xcd_barrier_complete(bar, bx, nloc, nx); b.st[0] = nloc; b.st[1] = nx; }
        const unsigned old = xb_add(&bar[XB_XSUB(bx)], 1u);
        const unsigned gen = old / nloc;
        if (old + 1u == (gen + 1u) * nloc) {
            __builtin_amdgcn_fence(__ATOMIC_RELEASE, "agent");
            asm volatile("s_waitcnt vmcnt(0)" ::: "memory");
            const unsigned og = xb_add(&bar[XB_TOP], 1u);
            const unsigned tg = og / nx;
            if (og + 1u == (tg + 1u) * nx) xb_add(&bar[XB_TOPGEN], 1u);
            else XB_SPIN(xb_ld(&bar[XB_TOPGEN]) == tg, bar);
            __builtin_amdgcn_fence(__ATOMIC_ACQUIRE, "agent");
            xb_add(&bar[XB_XGEN(bx)], 1u);
            asm volatile("s_waitcnt vmcnt(0)" ::: "memory");
        } else {
            XB_SPIN(xb_ld(&bar[XB_XGEN(bx)]) == gen, bar);
            __builtin_amdgcn_fence(__ATOMIC_ACQUIRE, "agent");
            asm volatile("s_waitcnt vmcnt(0)" ::: "memory");
        }
    }
    __syncthreads();
}

namespace pg8 {
constexpr int BM = 256, BK = 64, HALF = 128, HTB = HALF * BK * 2, STAGE_BYTES = 8 * HTB, NXCD = 8, WGM = 8;
__host__ __device__ __forceinline__ int lds_byte(int r, int c) { const int st = (r >> 4) * 2 + (c >> 5), rr = r & 15, cc = c & 31, ob = rr * 64 + cc * 2; return st * 1024 + (ob ^ (((ob >> 9) & 1) << 5)); }
__host__ __device__ __forceinline__ void stage_rc(int b, int& R, int& C) { const int st = b / 1024, sb = b % 1024, swz = sb ^ (((sb >> 9) & 1) << 5); R = (st >> 1) * 16 + swz / 64; C = (st & 1) * 32 + (swz % 64) / 2; }
__host__ __device__ __forceinline__ int perm32(int rho) { const int n = rho >> 4, i = rho & 15; return 8 * (i >> 2) + 4 * n + (i & 3); }

struct Unit { int pm, pn, e, ui; };

typedef int i32x8 __attribute__((ext_vector_type(8)));
typedef int i32x4 __attribute__((ext_vector_type(4)));
__device__ __forceinline__ i32x8 cat8(bf16x8 a, bf16x8 b) { return __builtin_shufflevector(__builtin_bit_cast(i32x4, a), __builtin_bit_cast(i32x4, b), 0, 1, 2, 3, 4, 5, 6, 7); }
template <class Epi, class Sched, bool ALIGN_EPI = true, bool FP8 = false>
__device__ __forceinline__ void gemm_phase(LAS unsigned char* lds, const char* gA, const int Kb, const Sched& S, const Epi& E, const int tid) {
    const int wid = __builtin_amdgcn_readfirstlane(tid >> 6), lane = tid & 63, wr = wid >> 2, wc = wid & 3, fr = lane & 15, fq = lane >> 4;
    const int nt = Kb / (BK * 2);
    int Ra[2], Ca[2]; unsigned voffB[2];
#pragma unroll
    for (int i = 0; i < 2; ++i) { int R, C; stage_rc(tid * 16 + i * 8192, R, C); const int Rb = Epi::PERM ? ((R & ~31) + perm32(R & 31)) : R;
        Ra[i] = R; Ca[i] = C * 2; voffB[i] = (unsigned)(Rb * Kb + C * 2); }
    const size_t kstep = (size_t)(BK * 2);
    const size_t hstep = (size_t)HALF * Kb;
    const unsigned ldsw = (unsigned)wid * 1024u;
    const int aoff = lds_byte(wr * 64 + fr, fq * 8), boff = lds_byte(wc * 32 + fr, fq * 8);
#define PG8_SA(b, h) (((b) * 2 + (h)) * HTB)
#define PG8_SB(b, h) ((4 + (b) * 2 + (h)) * HTB)
#define PG8_STAGE(bufoff, gbase, voff) do { _Pragma("unroll") for (int _i = 0; _i < 2; ++_i) \
        __builtin_amdgcn_global_load_lds((const unsigned*)((const char*)(gbase) + (voff)[_i]), (LAS unsigned*)(lds + (bufoff) + ldsw + _i * 8192), 16, 0, 0); } while (0)
#define PG8_LDA(dst, b, h) do { _Pragma("unroll") for (int m = 0; m < 4; ++m) _Pragma("unroll") for (int k = 0; k < 2; ++k) dst[m][k] = *(const LAS bf16x8*)(lds + PG8_SA(b, h) + aoff + m * 2048 + k * 1024); } while (0)
#define PG8_LDB(dst, b, h) do { _Pragma("unroll") for (int n = 0; n < 2; ++n) _Pragma("unroll") for (int k = 0; k < 2; ++k) dst[n][k] = *(const LAS bf16x8*)(lds + PG8_SB(b, h) + boff + n * 2048 + k * 1024); } while (0)
#define PG8_MMA(ai, bj, At, Bt) do { __builtin_amdgcn_s_setprio(1); _Pragma("unroll") for (int m = 0; m < 4; ++m) _Pragma("unroll") for (int n = 0; n < 2; ++n) { \
        if constexpr (FP8) asm volatile("v_mfma_scale_f32_16x16x128_f8f6f4 %0, %1, %2, %0, %3, %3 op_sel_hi:[0,0,0]" : "+v"(acc[ai][bj][m][n]) : "v"(cat8(Bt[n][0], Bt[n][1])), "v"(cat8(At[m][0], At[m][1])), "v"(scl)); \
        else { _Pragma("unroll") for (int k = 0; k < 2; ++k) acc[ai][bj][m][n] = __builtin_amdgcn_mfma_f32_16x16x32_bf16(Bt[n][k], At[m][k], acc[ai][bj][m][n], 0, 0, 0); } } __builtin_amdgcn_s_setprio(0); } while (0)
#define PG8_WAIT_V(n) asm volatile("s_waitcnt vmcnt(" #n ")" ::: "memory")
#define PG8_WAIT_L(n) asm volatile("s_waitcnt lgkmcnt(" #n ")" ::: "memory")
#define PG8_BAR __builtin_amdgcn_s_barrier()
#define PG8_SCHED __builtin_amdgcn_sched_barrier(0)
    Unit cur, nxt; int ui = 0;
    if (!S.next(0, cur)) return;
    f32x4 acc[2][2][4][2];
#pragma unroll
    for (int a = 0; a < 2; ++a)
#pragma unroll
        for (int b = 0; b < 2; ++b)
#pragma unroll
            for (int m = 0; m < 4; ++m)
#pragma unroll
                for (int n = 0; n < 2; ++n) acc[a][b][m][n] = (f32x4){0.f, 0.f, 0.f, 0.f};
    bf16x8 At[4][2], B0[2][2], B1[2][2]; const int scl = 0x7f7f7f7f;
    unsigned vA[2][2];
#pragma unroll
    for (int h = 0; h < 2; ++h)
#pragma unroll
        for (int i = 0; i < 2; ++i) vA[h][i] = S.a_row_off(cur, h * HALF + Ra[i]) + (unsigned)Ca[i];
    const char* cB = S.b_tile(cur);
    PG8_STAGE(PG8_SB(0, 0), cB, voffB); PG8_STAGE(PG8_SB(0, 1), cB + hstep, voffB); PG8_STAGE(PG8_SA(0, 0), gA, vA[0]); PG8_STAGE(PG8_SA(0, 1), gA, vA[1]);
    if (wr == 1) PG8_BAR;
    PG8_WAIT_V(2); PG8_BAR;
    PG8_STAGE(PG8_SB(1, 0), cB + kstep, voffB); PG8_STAGE(PG8_SA(1, 0), gA + kstep, vA[0]); PG8_STAGE(PG8_SB(1, 1), cB + hstep + kstep, voffB);
    PG8_WAIT_V(6); PG8_BAR;
    for (;;) {
        const bool has_next = S.next(ui + 1, nxt);
        const char* nB = has_next ? S.b_tile(nxt) : cB;
        for (int t = 0; t < nt; t += 2) {
            const bool last = (t == nt - 2);
            unsigned tN[2][2];
#pragma unroll
            for (int h = 0; h < 2; ++h)
#pragma unroll
                for (int i = 0; i < 2; ++i) tN[h][i] = vA[h][i];
            if (last && has_next) {
#pragma unroll
                for (int h = 0; h < 2; ++h)
#pragma unroll
                    for (int i = 0; i < 2; ++i) tN[h][i] = S.a_row_off(nxt, h * HALF + Ra[i]) + (unsigned)Ca[i];
                PG8_WAIT_L(0);
            }
            const char* a1 = gA + (size_t)(t + 1) * kstep;
            const char* a2 = last ? gA : gA + (size_t)(t + 2) * kstep; const char* b2 = last ? nB : cB + (size_t)(t + 2) * kstep;
            const char* a3 = a2 + kstep; const char* b3 = b2 + kstep;
            PG8_LDB(B0, 0, 0); PG8_LDB(B1, 0, 1); PG8_SCHED; PG8_LDA(At, 0, 0); PG8_STAGE(PG8_SA(1, 1), a1, vA[1]);
#pragma unroll
            for (int h = 0; h < 2; ++h)
#pragma unroll
                for (int i = 0; i < 2; ++i) vA[h][i] = tN[h][i];
            PG8_WAIT_V(8); PG8_WAIT_L(0); PG8_BAR; PG8_MMA(0, 0, At, B0); PG8_MMA(0, 1, At, B1); PG8_BAR; PG8_SCHED;
            PG8_LDA(At, 0, 1); PG8_STAGE(PG8_SB(0, 0), b2, voffB); PG8_STAGE(PG8_SB(0, 1), b2 + hstep, voffB); PG8_STAGE(PG8_SA(0, 0), a2, vA[0]);
            PG8_WAIT_V(8); PG8_WAIT_L(0); PG8_BAR; PG8_MMA(1, 0, At, B0); PG8_MMA(1, 1, At, B1); PG8_BAR; PG8_SCHED;
            PG8_LDB(B0, 1, 0); PG8_LDB(B1, 1, 1); PG8_SCHED; PG8_LDA(At, 1, 0); PG8_STAGE(PG8_SA(0, 1), a2, vA[1]);
            PG8_WAIT_V(8); PG8_WAIT_L(0); PG8_BAR; PG8_MMA(0, 0, At, B0); PG8_MMA(0, 1, At, B1); PG8_BAR; PG8_SCHED;
            PG8_LDA(At, 1, 1); PG8_STAGE(PG8_SB(1, 0), b3, voffB); PG8_STAGE(PG8_SB(1, 1), b3 + hstep, voffB); PG8_STAGE(PG8_SA(1, 0), a3, vA[0]);
            PG8_WAIT_V(8); PG8_WAIT_L(0); PG8_BAR; PG8_MMA(1, 0, At, B0); PG8_MMA(1, 1, At, B1); PG8_BAR; PG8_SCHED;
        }
        if constexpr (ALIGN_EPI) { if (wr == 0) PG8_BAR; }
        if constexpr (FP8) asm volatile("s_nop 15\n\ts_nop 15" ::: "memory");
        E(acc, cur, wr, wc, fr, fq);
        if (!has_next) break;
#pragma unroll
        for (int a = 0; a < 2; ++a)
#pragma unroll
            for (int b = 0; b < 2; ++b)
#pragma unroll
                for (int m = 0; m < 4; ++m)
#pragma unroll
                    for (int n = 0; n < 2; ++n) acc[a][b][m][n] = (f32x4){0.f, 0.f, 0.f, 0.f};
        cur = nxt; cB = nB; ++ui;
        if constexpr (ALIGN_EPI) { if (wr == 1) PG8_BAR; }
    }
    PG8_WAIT_V(0);
    if constexpr (!ALIGN_EPI) { if (wr == 0) PG8_BAR; }
    PG8_BAR;
#undef PG8_SA
#undef PG8_SB
#undef PG8_STAGE
#undef PG8_LDA
#undef PG8_LDB
#undef PG8_MMA
#undef PG8_WAIT_V
#undef PG8_WAIT_L
#undef PG8_BAR
#undef PG8_SCHED
}
}
constexpr size_t MiB = 1u << 20;
constexpr int TP = T * 4 + NE * 256;
constexpr size_t WS_CTL = 0, CTL_ZERO_BYTES = 1 * MiB;
constexpr size_t WS_LB = 1 * MiB, WS_MOD = 1 * MiB + 65536;
constexpr size_t WS_WIN = 2 * MiB, WS_WOUT = 18 * MiB, WS_WF = 22 * MiB, WS_WGU = 24 * MiB, WS_WDN = 280 * MiB;
constexpr size_t WS_X = 408 * MiB, WS_H = 474 * MiB, WS_P = 508 * MiB, WS_CAT = 624 * MiB, WS_ROUTE = 658 * MiB, WS_ACT = 662 * MiB, WS_Y = 810 * MiB;
constexpr size_t WS_SU = 958 * MiB, WS_SS = 990 * MiB, WS_SD = 1022 * MiB, WS_YP = 1023 * MiB, WS_OSCR = 1040 * MiB, WS_H8 = 1072 * MiB, WS_FASTEND = 1090 * MiB;
#ifndef MOE_FP8
#define MOE_FP8 1
#endif
constexpr float FP8_SH = 16.f, FP8_SW = 256.f, FP8_SA = 4.f;
constexpr size_t RT_TOPI = 0, RT_TOPW = 512 * 1024, RT_POS = 1024 * 1024, RT_LISTE = 1536 * 1024;
static_assert((size_t)T * 16 <= 512 * 1024 && RT_LISTE + (size_t)NE * T * 4 <= 4 * MiB, "route map");
static_assert(WS_WIN + (size_t)2 * DINX * D * 2 <= WS_WOUT && WS_WGU + (size_t)2 * NE * 2048 * 1024 * 2 <= WS_WDN && WS_WDN + (size_t)2 * NE * 1024 * 1024 * 2 <= WS_X && WS_X + (size_t)T * D * 4 <= WS_H && WS_H + (size_t)T * D * 2 <= WS_P &&
              WS_P + (size_t)T * DINX * 2 <= WS_CAT && WS_CAT + (size_t)T * D * 2 <= WS_ROUTE && WS_ACT + (size_t)TP * D * 2 <= WS_Y && WS_Y + (size_t)TP * D * 2 <= WS_SU &&
              WS_SD + (size_t)(8 * 64 * 128 + 8 * 16384) * 4 <= WS_YP && WS_YP + (size_t)128 * 128 * 2 * 256 * 2 <= WS_OSCR && WS_OSCR + (size_t)256 * 32768 * 4 <= WS_H8 && WS_H8 + (size_t)T * D <= WS_FASTEND, "ws map");
constexpr int CW_TMO = 0, CW_BAR = 4096, CW_CNT = 16384;
constexpr int RING_OFF = 0, RING_BYTES = 131072, TINFO_OFF = 131072, BT_OFF = 136192, ROWOFF_OFF = 136704, MISC_OFF = 146944, LDS_BYTES = 147456;
constexpr int NWAVES = 8, NTHR = 512;

struct Params { const float* in[22]; float* out; unsigned char* ws; };
constexpr int PTR_OFF = MISC_OFF + 64;
struct Frame {
    LAS unsigned char* lds; unsigned char* ws; int tid, lane, wave, vcu, G, bid;
    __device__ __forceinline__ const float* in(int i) const { const LAS unsigned* q = (const LAS unsigned*)(lds + PTR_OFF) + 2 * i;
        const unsigned lo = __builtin_amdgcn_readfirstlane(q[0]), hi = __builtin_amdgcn_readfirstlane(q[1]); return (const float*)(((unsigned long long)hi << 32) | lo); }
    __device__ __forceinline__ const float* x() const { return in(0); }        __device__ __forceinline__ const float* c() const { return in(1); }
    __device__ __forceinline__ const float* ctxin() const { return in(2); }    __device__ __forceinline__ const float* cctx() const { return in(3); }
    __device__ __forceinline__ const float* w_ada() const { return in(4); }    __device__ __forceinline__ const float* b_ada() const { return in(5); }
    __device__ __forceinline__ const float* norm1_g() const { return in(6); }  __device__ __forceinline__ const float* norm2_g() const { return in(7); }
    __device__ __forceinline__ const float* w_in() const { return in(8); }     __device__ __forceinline__ const float* lbp() const { return in(9); }
    __device__ __forceinline__ const float* hng() const { return in(10); }     __device__ __forceinline__ const float* pool_w() const { return in(11); }
    __device__ __forceinline__ const float* pool_s() const { return in(12); }  __device__ __forceinline__ const float* four_w() const { return in(13); }
    __device__ __forceinline__ const float* w_out() const { return in(14); }   __device__ __forceinline__ const float* router_w() const { return in(15); }
    __device__ __forceinline__ const float* router_b() const { return in(16); } __device__ __forceinline__ const float* w_gu() const { return in(17); }
    __device__ __forceinline__ const float* b_gu() const { return in(18); }    __device__ __forceinline__ const float* w_dn() const { return in(19); }
    __device__ __forceinline__ const float* b_dn() const { return in(20); }    __device__ __forceinline__ const float* fng() const { return in(21); }
    __device__ __forceinline__ float* out() const { return (float*)in(22); }
    __device__ __forceinline__ gu32* ctl() const { return (gu32*)(ws + WS_CTL); }
    __device__ __forceinline__ float* LB() const { return (float*)(ws + WS_LB); }       __device__ __forceinline__ float* MOD() const { return (float*)(ws + WS_MOD); }
    __device__ __forceinline__ float* X() const { return (float*)(ws + WS_X); }
    __device__ __forceinline__ bf16_t* Wt_in() const { return (bf16_t*)(ws + WS_WIN); }  __device__ __forceinline__ bf16_t* Wt_out() const { return (bf16_t*)(ws + WS_WOUT); }
    __device__ __forceinline__ bf16_t* Wt_gu() const { return (bf16_t*)(ws + WS_WGU); }  __device__ __forceinline__ bf16_t* Wt_dn() const { return (bf16_t*)(ws + WS_WDN); }
    __device__ __forceinline__ bf16_t* H() const { return (bf16_t*)(ws + WS_H); }        __device__ __forceinline__ bf16_t* P() const { return (bf16_t*)(ws + WS_P); }
    __device__ __forceinline__ bf16_t* CAT() const { return (bf16_t*)(ws + WS_CAT); }    __device__ __forceinline__ bf16_t* ACT() const { return (bf16_t*)(ws + WS_ACT); }
    __device__ __forceinline__ bf16_t* Y() const { return (bf16_t*)(ws + WS_Y); }
    __device__ __forceinline__ int* TOPI() const { return (int*)(ws + WS_ROUTE + RT_TOPI); }   __device__ __forceinline__ float* TOPW() const { return (float*)(ws + WS_ROUTE + RT_TOPW); }
    __device__ __forceinline__ int* POS() const { return (int*)(ws + WS_ROUTE + RT_POS); }     __device__ __forceinline__ int* LISTE() const { return (int*)(ws + WS_ROUTE + RT_LISTE); }
};
__device__ __forceinline__ void frame_init(Frame& F, const Params& p, unsigned char* lds) {
    F.lds = (LAS unsigned char*)lds; F.tid = threadIdx.x; F.lane = F.tid & 63; F.wave = __builtin_amdgcn_readfirstlane(F.tid >> 6);
    F.G = gridDim.x; F.bid = blockIdx.x; { const int bx = blockIdx.x; F.vcu = (F.G % 8 == 0) ? (bx % 8) * (F.G / 8) + bx / 8 : bx; }
    F.ws = p.ws;
    if (F.tid == 0) { LAS unsigned long long* tab = (LAS unsigned long long*)(F.lds + PTR_OFF);
#pragma unroll
        for (int i = 0; i < 22; ++i) tab[i] = (unsigned long long)p.in[i];
        tab[22] = (unsigned long long)p.out; }
    __syncthreads();
}

__device__ __forceinline__ Frame relaunder(const Frame& F) { Frame R = F; int ln; asm volatile("v_mbcnt_lo_u32_b32 %0, -1, 0\n\tv_mbcnt_hi_u32_b32 %0, -1, %0" : "=v"(ln));
    R.lane = ln; R.tid = F.wave * 64 + ln; unsigned wlo = (unsigned)(unsigned long long)F.ws, whi = (unsigned)((unsigned long long)F.ws >> 32);
    asm volatile("" : "+s"(wlo), "+s"(whi)); R.ws = (unsigned char*)(((unsigned long long)whi << 32) | wlo);
    int sw = F.wave, sv = F.vcu, sg = F.G, sb = F.bid;
    asm volatile("" : "+s"(sw), "+s"(sv), "+s"(sg), "+s"(sb));
    R.wave = sw; R.vcu = sv; R.G = sg; R.bid = sb; R.tid = sw * 64 + ln; return R; }

struct DenseOrder {
    int nM, nN, nwg, G, c, Kb; const char* Bt;
    __device__ void init(int nM_, int nN_, int G_, int c_, int Kb_, const bf16_t* Bt_) { nM = nM_; nN = nN_; nwg = nM * nN; G = G_; c = c_; Kb = Kb_; Bt = (const char*)Bt_; }
    __device__ __forceinline__ bool next(int i, pg8::Unit& u) const {
        const long L = (long)i * G + c; if (L >= nwg) return false;
        int wgid = (int)L; { const int q = nwg / pg8::NXCD, r = nwg % pg8::NXCD, xcd = wgid % pg8::NXCD, off = wgid / pg8::NXCD; wgid = (xcd < r ? xcd * (q + 1) : r * (q + 1) + (xcd - r) * q) + off; }
        const int nig = pg8::WGM * nN, gid = wgid / nig, fm = gid * pg8::WGM, gsz = (nM - fm) < pg8::WGM ? (nM - fm) : pg8::WGM;
        u.pm = fm + ((wgid % nig) % gsz); u.pn = (wgid % nig) / gsz; u.e = 0; u.ui = i; return true;
    }
    __device__ __forceinline__ const char* b_tile(const pg8::Unit& u) const { return Bt + (size_t)u.pn * 256 * Kb; }
    __device__ __forceinline__ unsigned a_row_off(const pg8::Unit& u, int r) const { return (unsigned)(u.pm * 256 + r) * (unsigned)Kb; }
};
template <bool GATHER> struct MoeOrder {
    const LAS int* tinfo; const LAS unsigned* rowoff; int ntiles, nN, G, c, Kb; const char* W; size_t wstride;
    __device__ __forceinline__ bool next(int i, pg8::Unit& u) const {
        const int L = i * G + c; if (L >= ntiles * nN) return false;
        u.pm = L / nN; u.pn = L % nN; u.e = __builtin_amdgcn_readfirstlane(tinfo[4 * u.pm]); u.ui = i; return true;
    }
    __device__ __forceinline__ const char* b_tile(const pg8::Unit& u) const { return W + (size_t)u.e * wstride + (size_t)u.pn * 256 * Kb; }
    __device__ __forceinline__ unsigned a_row_off(const pg8::Unit& u, int r) const { if constexpr (GATHER) return rowoff[u.ui * 256 + r]; else return (unsigned)(u.pm * 256 + r) * (unsigned)Kb; }
};

__device__ __forceinline__ unsigned pk_f16(float a, float b) { const _Float16 x = (_Float16)a, y = (_Float16)b; return (unsigned)__builtin_bit_cast(unsigned short, x) | ((unsigned)__builtin_bit_cast(unsigned short, y) << 16); }
__device__ __forceinline__ float f16lo(unsigned w) { return (float)__builtin_bit_cast(_Float16, (unsigned short)(w & 0xffffu)); }
__device__ __forceinline__ float f16hi(unsigned w) { return (float)__builtin_bit_cast(_Float16, (unsigned short)(w >> 16)); }
struct EpiP {
    static constexpr bool PERM = true; bf16_t* O; int ldc; const float* lb;
    __device__ __forceinline__ void operator()(const f32x4 (&acc)[2][2][4][2], const pg8::Unit& u, int wr, int wc, int fr, int fq) const {
        const int row0 = u.pm * 256 + wr * 64 + fr, col0 = u.pn * 256 + wc * 32 + 8 * fq;
        const int mode = u.pn < 2 ? 1 : (u.pn < 6 ? 2 : ((u.pn == 8 || u.pn == 9) ? 3 : 0));
        f32x4 lbv[2][2];
        if (mode == 2) {
#pragma unroll
            for (int bj = 0; bj < 2; ++bj)
#pragma unroll
                for (int n = 0; n < 2; ++n) lbv[bj][n] = *(const f32x4*)(lb + (col0 - 512) + bj * 128 + 4 * n); }
#pragma unroll
        for (int ai = 0; ai < 2; ++ai)
#pragma unroll
            for (int m = 0; m < 4; ++m) { bf16_t* rowp = O + (size_t)(row0 + ai * 128 + m * 16) * ldc + col0;
#pragma unroll
                for (int bj = 0; bj < 2; ++bj) { f32x4 v0 = acc[ai][bj][m][0], v1 = acc[ai][bj][m][1]; u32x4 w;
                    if (mode == 2) {
#pragma unroll
                        for (int j = 0; j < 4; ++j) { const float l0 = lbv[bj][0][j], l1 = lbv[bj][1][j];
                            v0[j] = __builtin_amdgcn_logf(fmaxf(l0 + (1.f - l0) * fsigm(v0[j]), 1e-30f)); v1[j] = __builtin_amdgcn_logf(fmaxf(l1 + (1.f - l1) * fsigm(v1[j]), 1e-30f)); }
                        w.x = pk_f16(v0[0], v0[1]); w.y = pk_f16(v0[2], v0[3]); w.z = pk_f16(v1[0], v1[1]); w.w = pk_f16(v1[2], v1[3]);
                    } else {
                        if (mode == 1) {
#pragma unroll
                            for (int j = 0; j < 4; ++j) { v0[j] = v0[j] * fsigm(v0[j]); v1[j] = v1[j] * fsigm(v1[j]); } }
                        if (mode == 3) {
#pragma unroll
                            for (int j = 0; j < 4; ++j) { v0[j] = fsigm(v0[j]); v1[j] = fsigm(v1[j]); } }
                        w.x = cvt_pk_bf16(v0[0], v0[1]); w.y = cvt_pk_bf16(v0[2], v0[3]); w.z = cvt_pk_bf16(v1[0], v1[1]); w.w = cvt_pk_bf16(v1[2], v1[3]); }
                    *(u32x4*)(rowp + bj * 128) = w; } }
    }
};
struct EpiRes {
    static constexpr bool PERM = false; const float* base_ctx; const float* base_lat; const float* gate_ctx; const float* gate_lat; float* Xo;
    __device__ __forceinline__ void operator()(const f32x4 (&acc)[2][2][4][2], const pg8::Unit& u, int wr, int wc, int fr, int fq) const {
        const int rt = wr * 64 + fr, col0 = u.pn * 256 + wc * 32 + 4 * fq;
        const float* base = (u.pm == 0 ? base_ctx : base_lat + (size_t)(u.pm - 1) * 256 * D) + (size_t)rt * D + col0; const float* gate = (u.pm == 0 ? gate_ctx : gate_lat) + col0;
        float* op = Xo + (size_t)(u.pm * 256 + rt) * D + col0;
#pragma unroll
        for (int bj = 0; bj < 2; ++bj)
#pragma unroll
            for (int n = 0; n < 2; ++n) { const f32x4 gv = *(const f32x4*)(gate + bj * 128 + n * 16);
#pragma unroll
                for (int ai = 0; ai < 2; ++ai) {
#pragma unroll
                    for (int m = 0; m < 4; ++m) { const size_t o = (size_t)(ai * 128 + m * 16) * D + bj * 128 + n * 16; const f32x4 b = *(const f32x4*)(base + o); *(f32x4*)(op + o) = b + gv * acc[ai][bj][m][n]; }
                    asm volatile("" ::: "memory"); } }
    }
};
struct EpiAct {
    static constexpr bool PERM = true; bf16_t* ACTo; const float* bias;
    __device__ __forceinline__ void operator()(const f32x4 (&acc)[2][2][4][2], const pg8::Unit& u, int wr, int wc, int fr, int fq) const {
        const int x0 = wc * 32 + 8 * fq; const float* bg = bias + (size_t)u.e * 2048 + 128 * u.pn + x0; const float* bu = bg + 1024;
        const f32x4 g0 = *(const f32x4*)bg, g1 = *(const f32x4*)(bg + 4), u0 = *(const f32x4*)bu, u1 = *(const f32x4*)(bu + 4);
#pragma unroll
        for (int ai = 0; ai < 2; ++ai)
#pragma unroll
            for (int m = 0; m < 4; ++m) { const int row = u.pm * 256 + ai * 128 + wr * 64 + m * 16 + fr;
                const f32x4 ga = acc[ai][0][m][0] + g0, gb = acc[ai][0][m][1] + g1, ua = acc[ai][1][m][0] + u0, ub = acc[ai][1][m][1] + u1; float r[8];
#pragma unroll
                for (int j = 0; j < 4; ++j) { const float g = fminf(ga[j], 7.f), up = fminf(fmaxf(ua[j], -7.f), 7.f); r[j] = (up + 1.f) * (g * fsigm(1.702f * g));
                                              const float g2 = fminf(gb[j], 7.f), up2 = fminf(fmaxf(ub[j], -7.f), 7.f); r[4 + j] = (up2 + 1.f) * (g2 * fsigm(1.702f * g2)); }
                u32x4 w; w.x = cvt_pk_bf16(r[0], r[1]); w.y = cvt_pk_bf16(r[2], r[3]); w.z = cvt_pk_bf16(r[4], r[5]); w.w = cvt_pk_bf16(r[6], r[7]);
                *(u32x4*)(ACTo + (size_t)row * D + 128 * u.pn + x0) = w; }
    }
};
struct EpiY {
    static constexpr bool PERM = true; bf16_t* Yo; const float* bias;
    __device__ __forceinline__ void operator()(const f32x4 (&acc)[2][2][4][2], const pg8::Unit& u, int wr, int wc, int fr, int fq) const {
        const int row0 = u.pm * 256 + wr * 64 + fr, col0 = u.pn * 256 + wc * 32 + 8 * fq; const float* bp = bias + (size_t)u.e * D + col0;
        f32x4 bv[2][2];
#pragma unroll
        for (int bj = 0; bj < 2; ++bj)
#pragma unroll
            for (int n = 0; n < 2; ++n) bv[bj][n] = *(const f32x4*)(bp + bj * 128 + 4 * n);
#pragma unroll
        for (int ai = 0; ai < 2; ++ai)
#pragma unroll
            for (int m = 0; m < 4; ++m) { bf16_t* rowp = Yo + (size_t)(row0 + ai * 128 + m * 16) * D + col0;
#pragma unroll
                for (int bj = 0; bj < 2; ++bj) { const f32x4 v0 = acc[ai][bj][m][0] + bv[bj][0], v1 = acc[ai][bj][m][1] + bv[bj][1];
                    u32x4 w; w.x = cvt_pk_bf16(v0[0], v0[1]); w.y = cvt_pk_bf16(v0[2], v0[3]); w.z = cvt_pk_bf16(v1[0], v1[1]); w.w = cvt_pk_bf16(v1[2], v1[3]);
                    *(u32x4*)(rowp + bj * 128) = w; } }
    }
};

__device__ __forceinline__ unsigned pk4_fp8(float a, float b, float c, float d) { int r = __builtin_amdgcn_cvt_pk_fp8_f32(a, b, 0, false); r = __builtin_amdgcn_cvt_pk_fp8_f32(c, d, r, true); return (unsigned)r; }
struct EpiAct8 {
    static constexpr bool PERM = true; unsigned char* ACTo; const float* bias;
    __device__ __forceinline__ void operator()(const f32x4 (&acc)[2][2][4][2], const pg8::Unit& u, int wr, int wc, int fr, int fq) const {
        const int x0 = wc * 32 + 8 * fq; const float* bg = bias + (size_t)u.e * 2048 + 128 * u.pn + x0; const float* bu = bg + 1024; constexpr float isc = 1.f / (FP8_SH * FP8_SW);
        const f32x4 g0 = *(const f32x4*)bg, g1 = *(const f32x4*)(bg + 4), u0 = *(const f32x4*)bu, u1 = *(const f32x4*)(bu + 4);
#pragma unroll
        for (int ai = 0; ai < 2; ++ai)
#pragma unroll
            for (int m = 0; m < 4; ++m) { const int row = u.pm * 256 + ai * 128 + wr * 64 + m * 16 + fr;
                const f32x4 ga = acc[ai][0][m][0] * isc + g0, gb = acc[ai][0][m][1] * isc + g1, ua = acc[ai][1][m][0] * isc + u0, ub = acc[ai][1][m][1] * isc + u1; float r[8];
#pragma unroll
                for (int j = 0; j < 4; ++j) { const float g = fminf(ga[j], 7.f), up = fminf(fmaxf(ua[j], -7.f), 7.f); r[j] = FP8_SA * (up + 1.f) * (g * fsigm(1.702f * g));
                                              const float g2 = fminf(gb[j], 7.f), up2 = fminf(fmaxf(ub[j], -7.f), 7.f); r[4 + j] = FP8_SA * (up2 + 1.f) * (g2 * fsigm(1.702f * g2)); }
                u32x2 w; w.x = pk4_fp8(r[0], r[1], r[2], r[3]); w.y = pk4_fp8(r[4], r[5], r[6], r[7]);
                *(u32x2*)(ACTo + (size_t)row * D + 128 * u.pn + x0) = w; }
    }
};
struct EpiY8 {
    static constexpr bool PERM = true; bf16_t* Yo; const float* bias;
    __device__ __forceinline__ void operator()(const f32x4 (&acc)[2][2][4][2], const pg8::Unit& u, int wr, int wc, int fr, int fq) const {
        const int row0 = u.pm * 256 + wr * 64 + fr, col0 = u.pn * 256 + wc * 32 + 8 * fq; const float* bp = bias + (size_t)u.e * D + col0; constexpr float isc = 1.f / (FP8_SA * FP8_SW);
        f32x4 bv[2][2];
#pragma unroll
        for (int bj = 0; bj < 2; ++bj)
#pragma unroll
            for (int n = 0; n < 2; ++n) bv[bj][n] = *(const f32x4*)(bp + bj * 128 + 4 * n);
#pragma unroll
        for (int ai = 0; ai < 2; ++ai)
#pragma unroll
            for (int m = 0; m < 4; ++m) { bf16_t* rowp = Yo + (size_t)(row0 + ai * 128 + m * 16) * D + col0;
#pragma unroll
                for (int bj = 0; bj < 2; ++bj) { const f32x4 v0 = acc[ai][bj][m][0] * isc + bv[bj][0], v1 = acc[ai][bj][m][1] * isc + bv[bj][1];
                    u32x4 w; w.x = cvt_pk_bf16(v0[0], v0[1]); w.y = cvt_pk_bf16(v0[2], v0[3]); w.z = cvt_pk_bf16(v1[0], v1[1]); w.w = cvt_pk_bf16(v1[2], v1[3]);
                    *(u32x4*)(rowp + bj * 128) = w; } }
    }
};

struct CvtJob { const float* W; bf16_t* WT; int N, K, k0, n0, nrow0; };
__device__ __forceinline__ void cvt_load(const CvtJob& j, int lane, f32x4 (&r)[16]) { const GAS f32x4* src = (const GAS f32x4*)((const GAS float*)j.W + (unsigned)((j.k0 + 8 * (lane >> 3)) * j.N + j.n0 + 8 * (lane & 7)));
    const unsigned rs = (unsigned)j.N >> 2;
#pragma unroll
    for (int i = 0; i < 8; ++i) { r[2 * i] = src[i * rs]; r[2 * i + 1] = src[i * rs + 1]; } }
__device__ __forceinline__ void cvt_store(const CvtJob& j, int lane, const f32x4 (&r)[16]) {
    u32x4 b[8];
#pragma unroll
    for (int i = 0; i < 8; ++i) { b[i].x = cvt_pk_bf16(r[2 * i][0], r[2 * i][1]); b[i].y = cvt_pk_bf16(r[2 * i][2], r[2 * i][3]); b[i].z = cvt_pk_bf16(r[2 * i + 1][0], r[2 * i + 1][1]); b[i].w = cvt_pk_bf16(r[2 * i + 1][2], r[2 * i + 1][3]); }
    GAS u32x4* dst = (GAS u32x4*)((GAS bf16_t*)j.WT + (unsigned)((j.nrow0 + 8 * (lane & 7)) * j.K + j.k0 + 8 * (lane >> 3))); const unsigned rs = (unsigned)j.K >> 3;
#pragma unroll
    for (int q = 0; q < 8; ++q) { const unsigned sel = (q & 1) ? 0x07060302u : 0x05040100u; u32x4 o;
        o.x = __builtin_amdgcn_perm(b[1][q >> 1], b[0][q >> 1], sel); o.y = __builtin_amdgcn_perm(b[3][q >> 1], b[2][q >> 1], sel);
        o.z = __builtin_amdgcn_perm(b[5][q >> 1], b[4][q >> 1], sel); o.w = __builtin_amdgcn_perm(b[7][q >> 1], b[6][q >> 1], sel);
        dst[q * rs] = o; } }
__device__ __forceinline__ void cvt8_load(const CvtJob& j, int lane, f32x4 (&r)[16]) { const GAS f32x4* src = (const GAS f32x4*)((const GAS float*)j.W + (unsigned)((j.k0 + 16 * (lane >> 3)) * j.N + j.n0 + 4 * (lane & 7)));
    const unsigned rs = (unsigned)j.N >> 2;
#pragma unroll
    for (int i = 0; i < 16; ++i) r[i] = src[i * rs]; }
__device__ __forceinline__ void cvt8_store(const CvtJob& j, int lane, const f32x4 (&r)[16]) {
    GAS u32x4* dst = (GAS u32x4*)((GAS unsigned char*)j.WT + (unsigned)((j.nrow0 + 4 * (lane & 7)) * j.K + j.k0 + 16 * (lane >> 3))); const unsigned rs = (unsigned)j.K >> 4;
#pragma unroll
    for (int n = 0; n < 4; ++n) { u32x4 o;
        o.x = pk4_fp8(r[0][n] * FP8_SW, r[1][n] * FP8_SW, r[2][n] * FP8_SW, r[3][n] * FP8_SW); o.y = pk4_fp8(r[4][n] * FP8_SW, r[5][n] * FP8_SW, r[6][n] * FP8_SW, r[7][n] * FP8_SW);
        o.z = pk4_fp8(r[8][n] * FP8_SW, r[9][n] * FP8_SW, r[10][n] * FP8_SW, r[11][n] * FP8_SW); o.w = pk4_fp8(r[12][n] * FP8_SW, r[13][n] * FP8_SW, r[14][n] * FP8_SW, r[15][n] * FP8_SW);
        dst[n * rs] = o; } }
constexpr int NB_IN = (FQ_OFF < DIN ? FQ_OFF : DIN) / 64, I_IN = 16 * NB_IN, I_OUT = 16 * 16, I_GU = MOE_FP8 ? 8 * 64 : 16 * 32, I_DN = MOE_FP8 ? 8 * 32 : 16 * 16;
constexpr int N_IN = 2 * I_IN, N_OUT = 2 * I_OUT, N_GU = 2 * NE * I_GU, N_DN = 2 * NE * I_DN, N_CVT = N_IN + N_OUT + N_GU + N_DN;
__device__ __forceinline__ CvtJob cvt_job(const Frame& F, int it, bool& f8) {
    CvtJob j; int r = it; f8 = false;
    if (r < N_IN) { const int l = r / I_IN, q = r % I_IN, kb = q / NB_IN, nb = q % NB_IN; j = CvtJob{F.w_in() + (size_t)l * D * DIN, F.Wt_in() + (size_t)l * DINX * D, DIN, D, 64 * kb, 64 * nb, 64 * nb}; return j; } r -= N_IN;
    if (r < N_OUT) { const int l = r / I_OUT, q = r % I_OUT, kb = q >> 4, nb = q & 15; j = CvtJob{F.w_out() + (size_t)l * D * D, F.Wt_out() + (size_t)l * D * D, D, D, 64 * kb, 64 * nb, 64 * nb}; return j; } r -= N_OUT;
    f8 = MOE_FP8;
    if (r < N_GU) { const int le = r / I_GU, q = r % I_GU; const int kb = MOE_FP8 ? q >> 6 : q >> 5, nb = MOE_FP8 ? q & 63 : q & 31; const int n0 = (MOE_FP8 ? 32 : 64) * nb, bj = n0 >> 10, xx = n0 & 1023;
        j = CvtJob{F.w_gu() + (size_t)le * D * 2048, (bf16_t*)((unsigned char*)F.Wt_gu() + (size_t)le * 2048 * D * (MOE_FP8 ? 1 : 2)), 2048, D, (MOE_FP8 ? 128 : 64) * kb, n0, 256 * (xx >> 7) + 128 * bj + (xx & 127)}; return j; } r -= N_GU;
    { const int le = r / I_DN, q = r % I_DN; const int kb = MOE_FP8 ? q >> 5 : q >> 4, nb = MOE_FP8 ? q & 31 : q & 15; const int n0 = (MOE_FP8 ? 32 : 64) * nb;
      j = CvtJob{F.w_dn() + (size_t)le * D * D, (bf16_t*)((unsigned char*)F.Wt_dn() + (size_t)le * D * D * (MOE_FP8 ? 1 : 2)), D, D, (MOE_FP8 ? 128 : 64) * kb, n0, n0}; return j; }
}
__device__ __forceinline__ void cvt_ld(const CvtJob& j, bool f8, int lane, f32x4 (&r)[16]) { if (f8) cvt8_load(j, lane, r); else cvt_load(j, lane, r); }
__device__ __forceinline__ void cvt_st(const CvtJob& j, bool f8, int lane, const f32x4 (&r)[16]) { if (f8) cvt8_store(j, lane, r); else cvt_store(j, lane, r); }
__device__ __forceinline__ void ph_prologue(Frame& F) {
    const int gw = F.vcu * NWAVES + F.wave, NGW = F.G * NWAVES;
    for (int i = gw * 64 + F.lane; i < 1024; i += NGW * 64) { const float a = F.lbp()[i], b = F.lbp()[1024 + i], m = fmaxf(a, b), ea = __expf(a - m), eb = __expf(b - m); F.LB()[i] = 0.f; F.LB()[1024 + i] = eb / (ea + eb); }
    if (F.bid < 192) {
        LAS float* sc = (LAS float*)(F.lds); LAS float* part = sc + 2048;
        { const float* c = F.c(); const float* cc = F.cctx(); for (int i = F.tid; i < D; i += NTHR) { const float a = c[i], b = cc[i]; sc[i] = a * fsigm(a); sc[D + i] = b * fsigm(b); } }
        __syncthreads();
        const int l = F.bid / 96, jcol = (F.bid % 96) * 64 + F.lane; const GAS float* W = (const GAS float*)F.w_ada() + (unsigned)(l * D * 6144 + (128 * F.wave) * 6144 + jcol); float a0 = 0.f, a1 = 0.f;
#pragma unroll 16
        for (int i = 0; i < 128; ++i) { const float w = W[(unsigned)i * 6144u]; a0 += sc[128 * F.wave + i] * w; a1 += sc[D + 128 * F.wave + i] * w; }
        part[(F.wave * 2 + 0) * 64 + F.lane] = a0; part[(F.wave * 2 + 1) * 64 + F.lane] = a1;
        __syncthreads();
        if (F.tid < 128) { const int which = F.tid >> 6, col = F.tid & 63; float s = 0.f;
#pragma unroll
            for (int w = 0; w < 8; ++w) s += part[(w * 2 + which) * 64 + col];
            const int j = (F.bid % 96) * 64 + col; F.MOD()[(size_t)(l * 2 + which) * 6144 + j] = s + F.b_ada()[l * 6144 + j]; }
        __syncthreads();
    }
    int it = gw; if (it >= N_CVT) return;
    f32x4 ra[16], rb[16]; bool fa, fb = false; CvtJob ja = cvt_job(F, it, fa), jb; cvt_ld(ja, fa, F.lane, ra);
    for (;;) {
        const int itb = it + NGW; const bool hb = itb < N_CVT; if (hb) { jb = cvt_job(F, itb, fb); cvt_ld(jb, fb, F.lane, rb); }
        cvt_st(ja, fa, F.lane, ra); if (!hb) break;
        const int ita = itb + NGW; const bool ha = ita < N_CVT; if (ha) { ja = cvt_job(F, ita, fa); cvt_ld(ja, fa, F.lane, ra); }
        cvt_st(jb, fb, F.lane, rb); if (!ha) break;
        it = ita;
    }
}

__device__ __forceinline__ void row_load(const float* xrow, int lane, f32x4 (&v)[4]) { const GAS f32x4* xr = (const GAS f32x4*)xrow + lane;
#pragma unroll
    for (int j = 0; j < 4; ++j) v[j] = xr[64 * j]; }
__device__ __forceinline__ float row_rstd(const f32x4 (&v)[4], int lane) { float s = 0.f;
#pragma unroll
    for (int j = 0; j < 4; ++j) s += (v[j].x * v[j].x + v[j].y * v[j].y) + (v[j].z * v[j].z + v[j].w * v[j].w);
    return rsqrtf(wave_sum(s, lane) * (1.f / D) + 1e-6f); }
__device__ __forceinline__ void row_modulate(const f32x4 (&v)[4], float r, const float* g, const float* sc, const float* sh, int lane, f32x4 (&hv)[4]) {
#pragma unroll
    for (int j = 0; j < 4; ++j) { const f32x4 gg = ((const GAS f32x4*)g)[lane + 64 * j], s1 = ((const GAS f32x4*)sc)[lane + 64 * j], s0 = ((const GAS f32x4*)sh)[lane + 64 * j];
        hv[j] = v[j] * r * gg * (s1 + 1.f) + s0; } }
__device__ __forceinline__ void row_store_fp8(unsigned char* orow, int lane, const f32x4 (&hv)[4]) { GAS unsigned* o4 = (GAS unsigned*)orow + lane;
#pragma unroll
    for (int j = 0; j < 4; ++j) o4[64 * j] = pk4_fp8(hv[j].x * FP8_SH, hv[j].y * FP8_SH, hv[j].z * FP8_SH, hv[j].w * FP8_SH); }
__device__ __forceinline__ void row_store_bf16(bf16_t* orow, int lane, const f32x4 (&hv)[4]) { GAS u32x2* o8 = (GAS u32x2*)orow + lane;
#pragma unroll
    for (int j = 0; j < 4; ++j) { u32x2 w; w.x = pk2(hv[j].x, hv[j].y); w.y = pk2(hv[j].z, hv[j].w); o8[64 * j] = w; } }

__device__ __forceinline__ void ph_mod1(Frame& F, int l) {
    const int gw = F.vcu * NWAVES + F.wave, NGW = F.G * NWAVES;
    for (int row = gw; row < T; row += NGW) {
        const float* xr = l == 0 ? (row < CTX ? F.ctxin() + (size_t)row * D : F.x() + (size_t)(row - CTX) * D) : F.X() + (size_t)row * D;
        const float* m = F.MOD() + (size_t)(l * 2 + (row < CTX ? 1 : 0)) * 6144;
        f32x4 v[4], hv[4]; row_load(xr, F.lane, v); const float r = row_rstd(v, F.lane); row_modulate(v, r, F.norm1_g() + l * D, m + D, m, F.lane, hv); row_store_bf16(F.H() + (size_t)row * D, F.lane, hv);
    }
}

constexpr int RW_STRIDE = 1028, RSCR_OFF = 32 * RW_STRIDE * 4;
static_assert(RSCR_OFF + 4096 <= MISC_OFF, "router LDS map");
__device__ __forceinline__ void route_top4(float (&part)[16], float bias, int lane, float (&vals)[4], int (&idx)[4]) {
#pragma unroll
    for (int st = 1; st < 5; ++st) { const int M = 32 >> st, n = 16 >> st; const bool up = (lane & M) != 0;
#pragma unroll
        for (int i = 0; i < n; ++i) { float x = part[i], y = part[i + n]; asm volatile("" : "+v"(x), "+v"(y));
            const float keep = up ? y : x, send = up ? x : y; part[i] = keep + lane_xor(send, M, lane); } }
    const float lg = part[0] + lane_xor(part[0], 1, lane) + bias;
    const int e = (lane >> 1) & 31; unsigned u = __builtin_bit_cast(unsigned, lg); u = (u & 0x80000000u) ? ~u : (u | 0x80000000u); unsigned key = (u & ~31u) | (unsigned)(31 - e);
#pragma unroll
    for (int s = 0; s < 4; ++s) { unsigned m = key;
#pragma unroll
        for (int d = 2; d < 64; d <<= 1) { const unsigned o = (unsigned)__builtin_amdgcn_ds_bpermute((lane ^ d) << 2, (int)m); m = o > m ? o : m; }
        const int bi = 31 - (int)(m & 31u); const unsigned vb = m & ~31u, ub = (vb & 0x80000000u) ? (vb & 0x7fffffffu) : ~vb;
        idx[s] = bi; vals[s] = __builtin_bit_cast(float, ub); key = (e == bi) ? 0u : key; }
}
__device__ __forceinline__ void ph_mod2_route(Frame& F, int l, int cbank) {
    LAS float* rwT = (LAS float*)(F.lds + RING_OFF);
    LAS int* lcnt = (LAS int*)(F.lds + RSCR_OFF); LAS int* lbase = lcnt + 32; LAS int* te = lbase + 32; LAS float* tw = (LAS float*)(te + 272); LAS int* trk = (LAS int*)(tw + 272);
    const GAS float* rw = (const GAS float*)F.router_w() + (unsigned)(l * D * NE);
    __syncthreads();
    for (int i = F.tid; i < 256 * 32; i += NTHR) { const int e = i & 31, k4 = i >> 5; f32x4 v; v[0] = rw[(4 * k4 + 0) * NE + e]; v[1] = rw[(4 * k4 + 1) * NE + e]; v[2] = rw[(4 * k4 + 2) * NE + e]; v[3] = rw[(4 * k4 + 3) * NE + e];
        *(LAS f32x4*)(rwT + e * RW_STRIDE + 4 * k4) = v; }
    if (F.tid < 32) lcnt[F.tid] = 0;
    __syncthreads();
    const int row0 = F.bid * 65;
    const float bias = F.router_b()[l * NE + ((F.lane >> 1) & 31)];
    const float* Xp = F.X(); const float* n2g = F.norm2_g() + l * D; const float* modl = F.MOD() + (size_t)(l * 2) * 6144; bf16_t* Hp = F.H(); unsigned char* H8p = F.ws + WS_H8;
#pragma unroll 1
    for (int pi = F.wave; pi < 33; pi += NWAVES) {
        const int ria = 2 * pi, rib = min(2 * pi + 1, 64); const bool hasb = 2 * pi + 1 < 65; const int ra = row0 + ria, rb = row0 + rib;
        int ln = F.lane; asm volatile("" : "+v"(ln));
        f32x4 va[4], vb[4]; row_load(Xp + (size_t)ra * D, ln, va); row_load(Xp + (size_t)rb * D, ln, vb);
        f32x4 ha[4], hb[4];
        { const float* m = modl + (ra < CTX ? 6144 : 0); const float r = row_rstd(va, ln); row_modulate(va, r, n2g, m + 4 * D, m + 3 * D, ln, ha); if (MOE_FP8) row_store_fp8(H8p + (size_t)ra * D, ln, ha); else row_store_bf16(Hp + (size_t)ra * D, ln, ha); }
        { const float* m = modl + (rb < CTX ? 6144 : 0); const float r = row_rstd(vb, ln); row_modulate(vb, r, n2g, m + 4 * D, m + 3 * D, ln, hb); if (hasb) { if (MOE_FP8) row_store_fp8(H8p + (size_t)rb * D, ln, hb); else row_store_bf16(Hp + (size_t)rb * D, ln, hb); } }
        float pa[16], pb[16]; const bool up32 = (ln & 32) != 0;
#pragma unroll
        for (int i = 0; i < 16; ++i) { f32x4 A0 = (f32x4){0.f, 0.f, 0.f, 0.f}, B0 = A0, A1 = A0, B1 = A0;
#pragma unroll
            for (int j = 0; j < 4; ++j) { const f32x4 w0 = *(const LAS f32x4*)(rwT + i * RW_STRIDE + 4 * ln + 256 * j), w1 = *(const LAS f32x4*)(rwT + (i + 16) * RW_STRIDE + 4 * ln + 256 * j);
                A0 += ha[j] * w0; B0 += hb[j] * w0; A1 += ha[j] * w1; B1 += hb[j] * w1; }
            const float sa0 = (A0[0] + A0[1]) + (A0[2] + A0[3]), sb0 = (B0[0] + B0[1]) + (B0[2] + B0[3]), sa1 = (A1[0] + A1[1]) + (A1[2] + A1[3]), sb1 = (B1[0] + B1[1]) + (B1[2] + B1[3]);
            pa[i] = (up32 ? sa1 : sa0) + lane_xor(up32 ? sa0 : sa1, 32, ln); pb[i] = (up32 ? sb1 : sb0) + lane_xor(up32 ? sb0 : sb1, 32, ln);
            if (i & 1) __builtin_amdgcn_sched_barrier(0); }
        float vals[4]; int idx[4];
        route_top4(pa, bias, ln, vals, idx);
        if (ln == 0) { float ex[4], sum = 0.f;
#pragma unroll
            for (int s = 0; s < 4; ++s) { ex[s] = __expf(vals[s] - vals[0]); sum += ex[s]; }
            const float inv = 1.f / sum;
#pragma unroll
            for (int s = 0; s < 4; ++s) { te[ria * 4 + s] = idx[s]; tw[ria * 4 + s] = ex[s] * inv; trk[ria * 4 + s] = (int)__hip_atomic_fetch_add((LAS unsigned*)&lcnt[idx[s]], 1u, __ATOMIC_RELAXED, __HIP_MEMORY_SCOPE_WORKGROUP); } }
        route_top4(pb, bias, ln, vals, idx);
        if (ln == 0 && hasb) { float ex[4], sum = 0.f;
#pragma unroll
            for (int s = 0; s < 4; ++s) { ex[s] = __expf(vals[s] - vals[0]); sum += ex[s]; }
            const float inv = 1.f / sum;
#pragma unroll
            for (int s = 0; s < 4; ++s) { te[rib * 4 + s] = idx[s]; tw[rib * 4 + s] = ex[s] * inv; trk[rib * 4 + s] = (int)__hip_atomic_fetch_add((LAS unsigned*)&lcnt[idx[s]], 1u, __ATOMIC_RELAXED, __HIP_MEMORY_SCOPE_WORKGROUP); } }
    }
    __syncthreads();
    if (F.tid < 32) lbase[F.tid] = (int)__hip_atomic_fetch_add((unsigned*)(F.ctl() + CW_CNT + (cbank * 32 + F.tid) * 64), (unsigned)lcnt[F.tid], RLX_AGENT);
    __syncthreads();
    for (int i = F.tid; i < 65 * 4; i += NTHR) { const int row = row0 + (i >> 2), e = te[i], pos = lbase[e] + trk[i];
        F.TOPI()[row * 4 + (i & 3)] = e; F.TOPW()[row * 4 + (i & 3)] = tw[i]; F.POS()[row * 4 + (i & 3)] = pos; F.LISTE()[(size_t)e * T + pos] = row; }
    __syncthreads();
}

__device__ __forceinline__ int moe_tiles(Frame& F, int l) {
    LAS int* tinfo = (LAS int*)(F.lds + TINFO_OFF); LAS int* bt = (LAS int*)(F.lds + BT_OFF); LAS int* cn = bt + 32; LAS int* ntl = bt + 64;
    __syncthreads();
    if (F.tid < 64) {
        const int e = F.lane & 31; const int c = (int)__hip_atomic_load(F.ctl() + CW_CNT + (l * 32 + e) * 64, RLX_AGENT); const int nt = (c + 255) >> 8;
        int incl = nt;
#pragma unroll
        for (int o = 1; o < 32; o <<= 1) { const int t = lane_get(incl, (F.lane - o) & 63); if (e >= o) incl += t; }
        const int first = incl - nt;
        if (F.lane < 32) { bt[e] = first; cn[e] = c; for (int j = 0; j < nt; ++j) { LAS int* ti = tinfo + 4 * (first + j); ti[0] = e; ti[1] = 0; ti[2] = 256 * j; ti[3] = min(256, c - 256 * j); } if (e == 31) ntl[0] = incl; }
    }
    __syncthreads();
    return ntl[0];
}

__device__ __forceinline__ void ph_gateup(Frame& F, int l) {
    const int ntiles = moe_tiles(F, l); constexpr int EB = MOE_FP8 ? 1 : 2;
    LAS int* tinfo = (LAS int*)(F.lds + TINFO_OFF); LAS unsigned* rowoff = (LAS unsigned*)(F.lds + ROWOFF_OFF);
    MoeOrder<true> S; S.tinfo = tinfo; S.rowoff = rowoff; S.ntiles = ntiles; S.nN = 8; S.G = F.G; S.c = F.vcu; S.Kb = D * EB; S.W = (const char*)F.Wt_gu() + (size_t)l * NE * 2048 * D * EB; S.wstride = (size_t)2048 * D * EB;
    for (int i = 0;; ++i) { pg8::Unit u; if (!S.next(i, u) || i >= 10) break;
        if (F.tid < 256) { const int pos0 = tinfo[4 * u.pm + 2], valid = tinfo[4 * u.pm + 3]; const int tok = F.tid < valid ? F.LISTE()[(size_t)u.e * T + pos0 + F.tid] : 0; rowoff[i * 256 + F.tid] = (unsigned)tok * (unsigned)(D * EB); } }
    __syncthreads();
    if constexpr (MOE_FP8) { EpiAct8 E{(unsigned char*)F.ACT(), F.b_gu() + (size_t)l * NE * 2048};
        pg8::gemm_phase<EpiAct8, MoeOrder<true>, true, true>(F.lds + RING_OFF, (const char*)(F.ws + WS_H8), D, S, E, F.tid); }
    else { EpiAct E{F.ACT(), F.b_gu() + (size_t)l * NE * 2048};
        pg8::gemm_phase<EpiAct, MoeOrder<true>, true, false>(F.lds + RING_OFF, (const char*)F.H(), 2 * D, S, E, F.tid); }
}
__device__ __forceinline__ void ph_down(Frame& F, int l) {
    const int ntiles = moe_tiles(F, l); constexpr int EB = MOE_FP8 ? 1 : 2;
    MoeOrder<false> S; S.tinfo = (LAS int*)(F.lds + TINFO_OFF); S.rowoff = nullptr; S.ntiles = ntiles; S.nN = 4; S.G = F.G; S.c = F.vcu; S.Kb = D * EB; S.W = (const char*)F.Wt_dn() + (size_t)l * NE * D * D * EB; S.wstride = (size_t)D * D * EB;
    if constexpr (MOE_FP8) { EpiY8 E{F.Y(), F.b_dn() + (size_t)l * NE * D};
        pg8::gemm_phase<EpiY8, MoeOrder<false>, true, true>(F.lds + RING_OFF, (const char*)F.ACT(), D, S, E, F.tid); }
    else { EpiY E{F.Y(), F.b_dn() + (size_t)l * NE * D};
        pg8::gemm_phase<EpiY, MoeOrder<false>, true, false>(F.lds + RING_OFF, (const char*)F.ACT(), 2 * D, S, E, F.tid); }
}
__device__ __forceinline__ void ph_win(Frame& F, int l) {
    DenseOrder S; S.init(T / 256, DINX / 256, F.G, F.bid, 2 * D, F.Wt_in() + (size_t)l * DINX * D);
    EpiP E{F.P(), DINX, F.LB() + l * 1024};
    pg8::gemm_phase<EpiP, DenseOrder, true>(F.lds + RING_OFF, (const char*)F.H(), 2 * D, S, E, F.tid);
}
__device__ __forceinline__ void ph_wout(Frame& F, int l) {
    DenseOrder S; S.init(T / 256, D / 256, F.G, F.bid, 2 * D, F.Wt_out() + (size_t)l * D * D);
    const float* m = F.MOD() + (size_t)(l * 2) * 6144;
    EpiRes E{l == 0 ? F.ctxin() : F.X(), l == 0 ? F.x() : F.X() + (size_t)CTX * D, m + 6144 + 2 * D, m + 2 * D, F.X()};
    pg8::gemm_phase<EpiRes, DenseOrder, true>(F.lds + RING_OFF, (const char*)F.CAT(), 2 * D, S, E, F.tid);
}
__device__ __forceinline__ void combine_gather(const Frame& F, const LAS int* bt, int row, int ln, f32x4 (&v)[4], u32x2 (&y)[4][4], float (&w)[4]) {
    row_load(F.X() + (size_t)row * D, ln, v);
    const GAS int* ti = (const GAS int*)F.TOPI() + (unsigned)(row * 4); const GAS float* tw = (const GAS float*)F.TOPW() + (unsigned)(row * 4); const GAS int* tp = (const GAS int*)F.POS() + (unsigned)(row * 4);
#pragma unroll
    for (int q = 0; q < 4; ++q) { const int e = ti[q]; w[q] = tw[q]; const int srow = 256 * bt[e] + tp[q]; const GAS u32x2* yr = (const GAS u32x2*)((const GAS bf16_t*)F.Y() + (unsigned)srow * (unsigned)D) + ln;
#pragma unroll
        for (int j = 0; j < 4; ++j) y[q][j] = yr[64 * j]; }
}
__device__ __forceinline__ void combine_finish(const Frame& F, int l, int row, int ln, f32x4 (&v)[4], const u32x2 (&y)[4][4], const float (&w)[4]) {
    const float* m = F.MOD() + (size_t)(l * 2 + (row < CTX ? 1 : 0)) * 6144 + 5 * D;
#pragma unroll
    for (int j = 0; j < 4; ++j) { f32x4 s = (f32x4){0.f, 0.f, 0.f, 0.f};
#pragma unroll
        for (int q = 0; q < 4; ++q) s += w[q] * (f32x4){bflo(y[q][j].x), bfhi(y[q][j].x), bflo(y[q][j].y), bfhi(y[q][j].y)};
        v[j] += ((const GAS f32x4*)m)[ln + 64 * j] * s; }
    const float r = row_rstd(v, ln);
    if (l == 0) {
        GAS f32x4* xo = (GAS f32x4*)(F.X() + (size_t)row * D) + ln;
#pragma unroll
        for (int j = 0; j < 4; ++j) xo[64 * j] = v[j];
        const float* m1 = F.MOD() + (size_t)(2 + (row < CTX ? 1 : 0)) * 6144; f32x4 hv[4];
        row_modulate(v, r, F.norm1_g() + D, m1 + D, m1, ln, hv); row_store_bf16(F.H() + (size_t)row * D, ln, hv);
    } else {
        GAS f32x4* o = (GAS f32x4*)(F.out() + (size_t)(row - CTX) * D) + ln; const float* fg = F.fng();
#pragma unroll
        for (int j = 0; j < 4; ++j) o[64 * j] = v[j] * r * ((const GAS f32x4*)fg)[ln + 64 * j];
    }
}
__device__ __forceinline__ void ph_combine(Frame& F, int l) {
    (void)moe_tiles(F, l);
    const LAS int* bt = (const LAS int*)(F.lds + BT_OFF);
    const int gw = F.vcu * NWAVES + F.wave, NGW = F.G * NWAVES; const int rbeg = l == 1 ? CTX : 0;
#pragma unroll 1
    for (int ra = rbeg + gw; ra < T; ra += 2 * NGW) {
        int ln = F.lane; asm volatile("" : "+v"(ln));
        const int rb = ra + NGW; const bool hasb = rb < T; const int rbc = hasb ? rb : ra;
        f32x4 va[4], vb[4]; u32x2 ya[4][4], yb[4][4]; float wa[4], wb[4];
        combine_gather(F, bt, ra, ln, va, ya, wa); combine_gather(F, bt, rbc, ln, vb, yb, wb);
        combine_finish(F, l, ra, ln, va, ya, wa);
        if (hasb) combine_finish(F, l, rb, ln, vb, yb, wb);
    }
}
constexpr size_t WF_MA = 0, WF_MB = 128 * 1024, WF_MC = 256 * 1024, WF_PW = 512 * 1024;
constexpr int ZS = 528;
__device__ __forceinline__ f32x4 mfma16(bf16x8 a, bf16x8 b, f32x4 c) { return __builtin_amdgcn_mfma_f32_16x16x32_bf16(a, b, c, 0, 0, 0); }

__device__ __forceinline__ void ph_prologue2(Frame& F) {
    bf16_t* MA = (bf16_t*)(F.ws + WS_WF + WF_MA); bf16_t* MB = (bf16_t*)(F.ws + WS_WF + WF_MB); bf16_t* MC = (bf16_t*)(F.ws + WS_WF + WF_MC); bf16_t* PW = (bf16_t*)(F.ws + WS_WF + WF_PW);
    const int gt = F.bid * NTHR + F.tid, NT = F.G * NTHR;
    for (int i = gt; i < 256 * 256; i += NT) { const int r = i >> 8, cidx = i & 255, ri = r >> 7, k1 = r & 127, rj = cidx >> 7, t1 = cidx & 127; const float x = 2.f * (float)((k1 * t1) & 127) / 128.f;
        const float cs = cospif(x), sn = sinpif(x); const float v = ri == 0 ? (rj == 0 ? cs : -sn) : (rj == 0 ? -sn : -cs); MA[i] = (bf16_t)f2bf(v); }
    for (int i = gt; i < 128 * 256; i += NT) { const int k2 = i >> 8, cidx = i & 255, rj = cidx >> 7, t2 = cidx & 127; const float x = 2.f * (float)((k2 * t2) & 127) / 128.f; MB[i] = (bf16_t)f2bf(rj == 0 ? cospif(x) : sinpif(x)); }
    for (int i = gt; i < 256 * 512; i += NT) { const int k = i >> 9, cidx = i & 511, rj = cidx >> 8, t = cidx & 255; const float x = 2.f * (float)((k * t) & 255) / 256.f; MC[i] = (bf16_t)f2bf(rj == 0 ? cospif(x) : -sinpif(x)); }
    for (int i = gt; i < 2 * 4 * 64 * 64; i += NT) { const int lg = i >> 12, j = (i >> 6) & 63, ii = i & 63; PW[i] = (bf16_t)f2bf(F.pool_w()[(size_t)lg * 4096 + ii * 64 + j]); }
    LAS float* m12 = (LAS float*)(F.lds);
    LAS float* wt = (LAS float*)(F.lds + 32768);
    LAS float* trig = (LAS float*)(F.lds + 32768 + 65536);
    __syncthreads();
    if (F.tid < 64) { trig[F.tid] = cospif(2.f * (float)F.tid / 64.f); trig[64 + F.tid] = sinpif(2.f * (float)F.tid / 64.f); }
    for (int tile = F.bid; tile < 2 * 256; tile += F.G) {
        const int l = tile >> 8, kb = (tile >> 4) & 15, nb = tile & 15, k0 = 64 * kb, n0 = 32 * nb;
        __syncthreads();
        { const int cin = F.tid & 255, hf = F.tid >> 8, hh = cin >> 6, c = cin & 63;
#pragma unroll 1
          for (int q = 0; q < 16; ++q) { const int N = n0 + 16 * hf + q, sel = N >> 8, nn = N & 255; float s = 0.f; const float* fw = F.four_w() + (size_t)l * 65536 + (size_t)(hh * 64) * 256 + nn;
#pragma unroll 8
              for (int m = 0; m < 64; ++m) s += trig[sel * 64 + ((m * c) & 63)] * fw[m * 256];
              m12[cin * 32 + 16 * hf + q] = s; } }
        for (int i = F.tid; i < 64 * 256; i += NTHR) { const int k = i >> 8, cin = i & 255; wt[i] = F.w_in()[(size_t)l * D * DIN + (size_t)(k0 + k) * DIN + 2816 + cin]; }
        __syncthreads();
        { const int n = F.tid & 31, kq = F.tid >> 5; float a[4] = {0.f, 0.f, 0.f, 0.f};
#pragma unroll 4
          for (int cin = 0; cin < 256; ++cin) { const float mv = m12[cin * 32 + n];
#pragma unroll
              for (int i = 0; i < 4; ++i) a[i] += wt[(kq * 4 + i) * 256 + cin] * mv; }
          u32x2 w; w.x = pk2(a[0], a[1]); w.y = pk2(a[2], a[3]);
          *(u32x2*)(F.Wt_in() + (size_t)l * DINX * D + (size_t)(FQ_OFF + n0 + n) * D + k0 + kq * 4) = w; }
    }
    __syncthreads();
}

template <class SrcF> __device__ __forceinline__ void load_tile_T(LAS unsigned char* zt, const SrcF& src, int tid) {
    const int pg = tid >> 4, cc = tid & 15; u32x4 r[8];
#pragma unroll
    for (int i = 0; i < 8; ++i) r[i] = *(const GAS u32x4*)(src(8 * pg + i) + 8 * cc);
#pragma unroll
    for (int j = 0; j < 8; ++j) { const unsigned sel = (j & 1) ? 0x07060302u : 0x05040100u; u32x4 o;
        o.x = __builtin_amdgcn_perm(r[1][j >> 1], r[0][j >> 1], sel); o.y = __builtin_amdgcn_perm(r[3][j >> 1], r[2][j >> 1], sel);
        o.z = __builtin_amdgcn_perm(r[5][j >> 1], r[4][j >> 1], sel); o.w = __builtin_amdgcn_perm(r[7][j >> 1], r[6][j >> 1], sel);
        *(LAS u32x4*)(zt + (8 * cc + j) * ZS + 16 * pg) = o; }
}
__device__ __forceinline__ void tile_mma(const LAS unsigned char* zt, const bf16_t* mat_row  , f32x4 (&acc)[8], int lane) {
    const int fr = lane & 15, g = lane >> 4;
#pragma unroll
    for (int ks = 0; ks < 8; ++ks) { const bf16x8 b = *(const GAS bf16x8*)(mat_row + 32 * ks + 8 * g);
#pragma unroll
        for (int m = 0; m < 8; ++m) { const bf16x8 a = *(const LAS bf16x8*)(zt + (16 * m + fr) * ZS + (32 * ks + 8 * g) * 2); acc[m] = mfma16(a, b, acc[m]); }
        if (ks & 1) __builtin_amdgcn_sched_barrier(0); }
}
__device__ __forceinline__ void tile_mma2(const LAS unsigned char* zt, const bf16_t* mat_row0, const bf16_t* mat_row1, f32x4 (&acc0)[8], f32x4 (&acc1)[8], int lane) {
    const int fr = lane & 15, g = lane >> 4;
#pragma unroll
    for (int ks = 0; ks < 8; ++ks) { const bf16x8 b0 = *(const GAS bf16x8*)(mat_row0 + 32 * ks + 8 * g), b1 = *(const GAS bf16x8*)(mat_row1 + 32 * ks + 8 * g);
#pragma unroll
        for (int m = 0; m < 8; ++m) { const bf16x8 a = *(const LAS bf16x8*)(zt + (16 * m + fr) * ZS + (32 * ks + 8 * g) * 2); acc0[m] = mfma16(a, b0, acc0[m]); acc1[m] = mfma16(a, b1, acc1[m]); }
        __builtin_amdgcn_sched_barrier(0); }
}
struct SrcA { const bf16_t* P; int t2, hc; __device__ __forceinline__ const bf16_t* operator()(int p) const { const int ri = p >> 7, t1 = p & 127; return P + (size_t)(CTX + 128 * t1 + t2) * DINX + FQ_OFF + ri * 256 + 128 * hc; } };
struct SrcB { const bf16_t* Y; int k1, hc; __device__ __forceinline__ const bf16_t* operator()(int p) const { const int ri = p >> 7, t2 = p & 127; return Y + ((size_t)(k1 * 128 + t2) * 2 + ri) * 256 + 128 * hc; } };
struct SrcC { const bf16_t* P; int ri, hc; __device__ __forceinline__ const bf16_t* operator()(int p) const { return P + (size_t)p * DINX + FQ_OFF + ri * 256 + 128 * hc; } };

__device__ __forceinline__ void fftA_item(Frame& F, int item) {
    const int t2 = item >> 1, hc = item & 1; LAS unsigned char* zt = F.lds + RING_OFF;
    bf16_t* YP = (bf16_t*)(F.ws + WS_YP); const bf16_t* MA = (const bf16_t*)(F.ws + WS_WF + WF_MA);
    __syncthreads();
    load_tile_T(zt, SrcA{F.P(), t2, hc}, F.tid);
    __syncthreads();
    const int fr = F.lane & 15, g = F.lane >> 4, k1 = 16 * F.wave + fr;
    f32x4 ar[8], ai[8];
#pragma unroll
    for (int m = 0; m < 8; ++m) { ar[m] = (f32x4){0.f, 0.f, 0.f, 0.f}; ai[m] = (f32x4){0.f, 0.f, 0.f, 0.f}; }
    tile_mma2(zt, MA + (size_t)k1 * 256, MA + (size_t)(128 + k1) * 256, ar, ai, F.lane);
    const float x = 2.f * (float)(t2 * k1) / 16384.f; const float cs = cospif(x), sn = sinpif(x);
    bf16_t* yr = YP + ((size_t)(k1 * 128 + t2) * 2) * 256 + 128 * hc + 4 * g;
#pragma unroll
    for (int m = 0; m < 8; ++m) { const f32x4 a = ar[m], b = ai[m]; const f32x4 pr = a * cs + b * sn, pi = b * cs - a * sn;
        u32x2 w; w.x = pk2(pr[0], pr[1]); w.y = pk2(pr[2], pr[3]); *(u32x2*)(yr + 16 * m) = w;
        u32x2 v; v.x = pk2(pi[0], pi[1]); v.y = pk2(pi[2], pi[3]); *(u32x2*)(yr + 256 + 16 * m) = v; }
}
__device__ __forceinline__ void fftB_item(Frame& F, int item) {
    const int k1 = item >> 1, hc = item & 1; LAS unsigned char* zt = F.lds + RING_OFF;
    const bf16_t* YP = (const bf16_t*)(F.ws + WS_YP); const bf16_t* MB = (const bf16_t*)(F.ws + WS_WF + WF_MB);
    __syncthreads();
    load_tile_T(zt, SrcB{YP, k1, hc}, F.tid);
    __syncthreads();
    const int fr = F.lane & 15, g = F.lane >> 4, k2 = 16 * F.wave + fr;
    f32x4 acc[8];
#pragma unroll
    for (int m = 0; m < 8; ++m) acc[m] = (f32x4){0.f, 0.f, 0.f, 0.f};
    tile_mma(zt, MB + (size_t)k2 * 256, acc, F.lane);
    bf16_t* o = F.CAT() + (size_t)(CTX + k1 + 128 * k2) * D + 768 + 128 * hc + 4 * g;
#pragma unroll
    for (int m = 0; m < 8; ++m) { const f32x4 a = acc[m] * (1.f / 1024.f); u32x2 w; w.x = pk2(a[0], a[1]); w.y = pk2(a[2], a[3]); *(u32x2*)(o + 16 * m) = w; }
}
__device__ __forceinline__ void fftC_item(Frame& F, int item) {
    const int kh = item >> 1, hc = item & 1; LAS unsigned char* zt = F.lds + RING_OFF; const bf16_t* MC = (const bf16_t*)(F.ws + WS_WF + WF_MC);
    const int fr = F.lane & 15, g = F.lane >> 4, k = 128 * kh + 16 * F.wave + fr;
    f32x4 acc[8];
#pragma unroll
    for (int m = 0; m < 8; ++m) acc[m] = (f32x4){0.f, 0.f, 0.f, 0.f};
    for (int ri = 0; ri < 2; ++ri) {
        __syncthreads();
        load_tile_T(zt, SrcC{F.P(), ri, hc}, F.tid);
        __syncthreads();
        tile_mma(zt, MC + (size_t)k * 512 + ri * 256, acc, F.lane);
    }
    bf16_t* o = F.CAT() + (size_t)k * D + 768 + 128 * hc + 4 * g;
#pragma unroll
    for (int m = 0; m < 8; ++m) { const f32x4 a = acc[m] * (1.f / 128.f); u32x2 w; w.x = pk2(a[0], a[1]); w.y = pk2(a[2], a[3]); *(u32x2*)(o + 16 * m) = w; }
}

__device__ __forceinline__ void pool_item(Frame& F, int l, int item) {
    const int j = item >> 2, gi = item & 3, win = 2 << gi, lo = win >> 1, hi = win - 1 - lo;
    LAS float* V = (LAS float*)(F.lds);
    LAS unsigned* U = (LAS unsigned*)(F.lds + 65536);
    LAS unsigned char* At = F.lds + 65536 + 32768;
    const bf16_t* Pc = F.P() + 2560 + gi * 64;
    __syncthreads();
    if (j == 0) {
        for (int idx = F.tid; idx < 256 * 32; idx += NTHR) { const int t = idx >> 5, pr = idx & 31; const int a = max(t - lo, 0), b = min(t + hi, CTX - 1); float s0 = 0.f, s1 = 0.f;
            for (int r = a; r <= b; ++r) { const unsigned w = *(const GAS unsigned*)(Pc + (size_t)r * DINX + 2 * pr); s0 += bflo(w); s1 += bfhi(w); }
            const unsigned u = *(const GAS unsigned*)(Pc + (size_t)t * DINX + 2 * pr); const float inv = 1.f / (float)(b - a + 1);
            *(LAS unsigned*)(At + t * 144 + 4 * pr) = pk2(s0 * inv - bflo(u), s1 * inv - bfhi(u)); }
    } else {
        const int r0 = 4 * (j - 1);
        for (int idx = F.tid; idx < 64 * 32; idx += NTHR) { const int c = idx >> 5, pr = idx & 31; const int ra = max(r0 - lo, 0), rb = min(r0 + 3 + hi, LAT / GW - 1);
            float s0[4] = {0.f, 0.f, 0.f, 0.f}, s1[4] = {0.f, 0.f, 0.f, 0.f};
            for (int r = ra; r <= rb; ++r) { const unsigned w = *(const GAS unsigned*)(Pc + (size_t)(CTX + r * GW + c) * DINX + 2 * pr); const float x0 = bflo(w), x1 = bfhi(w);
#pragma unroll
                for (int i = 0; i < 4; ++i) { const bool in = (r >= r0 + i - lo) && (r <= r0 + i + hi); s0[i] += in ? x0 : 0.f; s1[i] += in ? x1 : 0.f; if (r == r0 + i) U[(i * 64 + c) * 32 + pr] = w; } }
#pragma unroll
            for (int i = 0; i < 4; ++i) { V[(i * 64 + c) * 64 + 2 * pr] = s0[i]; V[(i * 64 + c) * 64 + 2 * pr + 1] = s1[i]; } }
        __syncthreads();
        for (int idx = F.tid; idx < 4 * 8 * 64; idx += NTHR) { const int ch = idx & 63, cb = (idx >> 6) & 7, i = idx >> 9; const int r = r0 + i;
            const float cr = (float)(min(r + hi, LAT / GW - 1) - max(r - lo, 0) + 1); const LAS float* Vr = V + (i * 64) * 64 + ch;
            const int c0 = 8 * cb; float s = 0.f; for (int c = max(c0 - lo, 0); c <= min(c0 + hi, GW - 1); ++c) s += Vr[c * 64];
            for (int q = 0; q < 8; ++q) { const int c = c0 + q; if (q > 0) { if (c + hi <= GW - 1) s += Vr[(c + hi) * 64]; if (c - 1 - lo >= 0) s -= Vr[(c - 1 - lo) * 64]; }
                const float cc = (float)(min(c + hi, GW - 1) - max(c - lo, 0) + 1); const unsigned uw = U[(i * 64 + c) * 32 + (ch >> 1)]; const float u = (ch & 1) ? bfhi(uw) : bflo(uw);
                *(LAS unsigned short*)(At + (i * 64 + c) * 144 + 2 * ch) = (unsigned short)f2bf(s / (cr * cc) - u); } }
    }
    __syncthreads();
    const bf16_t* PW = (const bf16_t*)(F.ws + WS_WF + WF_PW) + (size_t)(l * 4 + gi) * 4096; const int fr = F.lane & 15, g = F.lane >> 4;
    f32x4 acc[4][2];
#pragma unroll
    for (int n = 0; n < 4; ++n) { acc[n][0] = (f32x4){0.f, 0.f, 0.f, 0.f}; acc[n][1] = (f32x4){0.f, 0.f, 0.f, 0.f}; }
#pragma unroll
    for (int ks = 0; ks < 2; ++ks) { bf16x8 b[2];
#pragma unroll
        for (int mt = 0; mt < 2; ++mt) b[mt] = *(const LAS bf16x8*)(At + (32 * F.wave + 16 * mt + fr) * 144 + (32 * ks + 8 * g) * 2);
#pragma unroll
        for (int n = 0; n < 4; ++n) { const bf16x8 a = *(const GAS bf16x8*)(PW + (16 * n + fr) * 64 + 32 * ks + 8 * g);
#pragma unroll
            for (int mt = 0; mt < 2; ++mt) acc[n][mt] = mfma16(a, b[mt], acc[n][mt]); } }
    const int rowbase = j == 0 ? 0 : CTX + 256 * (j - 1);
#pragma unroll
    for (int n = 0; n < 4; ++n) { const f32x4 sc = *(const GAS f32x4*)(F.pool_s() + l * 256 + gi * 64 + 16 * n + 4 * g);
#pragma unroll
        for (int mt = 0; mt < 2; ++mt) { const f32x4 a = acc[n][mt] * sc; u32x2 w; w.x = pk2(a[0], a[1]); w.y = pk2(a[2], a[3]);
            *(u32x2*)(F.CAT() + (size_t)(rowbase + 32 * F.wave + 16 * mt + fr) * D + 512 + gi * 64 + 16 * n + 4 * g) = w; } }
}

constexpr int SC_FT = 0, SC_QT = 18432, SC_VT = 36864, SC_BQ = 55296, SC_BF = 72704, SC_KT = 90112, SC_PM = 108544, SC_G = 117760, SC_TOT = 135168, SC_DEC = 137216, SC_SSQ = 138752, SC_END = 140800;
static_assert(SC_END <= MISC_OFF, "scan LDS map");
template <int DIR, bool FULL> __device__ __forceinline__ void scan_fetch(const Frame& F, int h, int row0, u32x4 (&r)[8]) {
    const GAS bf16_t* P = (const GAS bf16_t*)F.P(); const int tid = F.tid;
    if (tid < 384) { const int tile = tid >> 7, blk = tid & 127, tg = blk >> 4, kc = blk & 15; if (!FULL && tile == 1) return;
        const int colb = tile == 0 ? 512 * (1 + DIR) : (tile == 1 ? 0 : 1536); const GAS bf16_t* src = P + (unsigned)((row0 + 8 * tg) * DINX + colb + h * 128 + 8 * kc);
#pragma unroll
        for (int i = 0; i < 8; ++i) r[i] = *(const GAS u32x4*)(src + (unsigned)(i * DINX)); }
    else if (FULL && DIR == 1) { const int q = tid - 384; const GAS bf16_t* src = P + (unsigned)((row0 + (q >> 4)) * DINX + 2048 + h * 128 + 8 * (q & 15));
#pragma unroll
        for (int i = 0; i < 8; ++i) r[i] = *(const GAS u32x4*)(src + (unsigned)(i * 8 * DINX)); }
}
template <int DIR, bool FULL> __device__ __forceinline__ void scan_commit(const Frame& F, const u32x4 (&r)[8]) {
    LAS unsigned char* L = F.lds + RING_OFF; const int tid = F.tid;
    if (tid < 384) { const int tile = tid >> 7, blk = tid & 127, tg = blk >> 4, kc = blk & 15; if (!FULL && tile == 1) return;
#pragma unroll
        for (int j = 0; j < 8; ++j) { const unsigned sel = (j & 1) ? 0x07060302u : 0x05040100u; u32x4 o;
            o.x = __builtin_amdgcn_perm(r[1][j >> 1], r[0][j >> 1], sel); o.y = __builtin_amdgcn_perm(r[3][j >> 1], r[2][j >> 1], sel);
            o.z = __builtin_amdgcn_perm(r[5][j >> 1], r[4][j >> 1], sel); o.w = __builtin_amdgcn_perm(r[7][j >> 1], r[6][j >> 1], sel);
            *(LAS u32x4*)(L + tile * 18432 + (8 * kc + j) * 144 + 16 * tg) = o; } }
    else if (FULL && DIR == 1) { const int q = tid - 384; LAS unsigned char* dst = L + SC_G + (q >> 4) * 272 + 16 * (q & 15);
#pragma unroll
        for (int i = 0; i < 8; ++i) *(LAS u32x4*)(dst + i * 8 * 272) = r[i]; }
}
template <int DIR, bool FULL> __device__ __forceinline__ void scan_chunk(Frame& F, int l, int h, int nrow0, u32x4 (&pre)[8], f32x4 (&S)[8], f32x4 (&o)[4], float& segsum, const GAS float* oload = nullptr) {
    LAS unsigned char* L = F.lds + RING_OFF; int lane = F.lane; asm volatile("" : "+v"(lane));
    const int w = F.wave, tid = w * 64 + lane, fr = lane & 15, g = lane >> 4;
    LAS float* TOT = (LAS float*)(L + SC_TOT); LAS float* DEC = (LAS float*)(L + SC_DEC); LAS float* C1 = DEC + 128; LAS float* C2 = DEC + 256;
    __syncthreads();
    scan_commit<DIR, FULL>(F, pre);
    __syncthreads();
    const int k = tid & 127, qu = tid >> 7;
    float bl[16]; float run = 0.f;
    { const u32x4 fa = *(const LAS u32x4*)(L + SC_FT + k * 144 + 32 * qu), fb = *(const LAS u32x4*)(L + SC_FT + k * 144 + 32 * qu + 16); const unsigned fw[8] = {fa.x, fa.y, fa.z, fa.w, fb.x, fb.y, fb.z, fb.w};
#pragma unroll
      for (int i = 0; i < 16; ++i) { const int ti = (DIR == 0 ? i : 15 - i); run += (ti & 1) ? f16hi(fw[ti >> 1]) : f16lo(fw[ti >> 1]); bl[i] = run; } }
    TOT[qu * 128 + k] = run;
    __syncthreads();
    const float t0 = TOT[k], t1 = TOT[128 + k], t2 = TOT[256 + k], t3 = TOT[384 + k]; const float total = (t0 + t1) + (t2 + t3);
    float off, ref;
    if (DIR == 0) { off = qu == 0 ? 0.f : (qu == 1 ? t0 : (qu == 2 ? t0 + t1 : t0 + t1 + t2)); ref = t0 + t1; }
    else { off = qu == 3 ? 0.f : (qu == 2 ? t3 : (qu == 1 ? t3 + t2 : t3 + t2 + t1)); ref = t3 + t2; }
    if (qu == 0) { DEC[k] = __builtin_amdgcn_exp2f(total); C1[k] = __builtin_amdgcn_exp2f(ref); C2[k] = __builtin_amdgcn_exp2f(total - ref); segsum += total; }
    { unsigned qw[8];
      if (FULL) { const u32x4 qa = *(const LAS u32x4*)(L + SC_QT + k * 144 + 32 * qu), qb = *(const LAS u32x4*)(L + SC_QT + k * 144 + 32 * qu + 16); qw[0] = qa.x; qw[1] = qa.y; qw[2] = qa.z; qw[3] = qa.w; qw[4] = qb.x; qw[5] = qb.y; qw[6] = qb.z; qw[7] = qb.w; }
      float ktv[16]; const float sh = off - ref;
#pragma unroll
      for (int i = 0; i < 16; ++i) { const int ti = (DIR == 0 ? i : 15 - i), t = 16 * qu + ti; const float lf = i == 0 ? bl[0] : bl[i] - bl[i - 1]; const float b = bl[i] + sh;
          const float E = __builtin_amdgcn_exp2f(b), Ei = __builtin_amdgcn_rcpf(E), kk = 1.f - __builtin_amdgcn_exp2f(lf); ktv[ti] = kk * Ei;
          if (FULL) { const float qs = (ti & 1) ? bfhi(qw[ti >> 1]) : bflo(qw[ti >> 1]); *(LAS unsigned short*)(L + SC_BQ + t * 272 + 2 * k) = (unsigned short)(cvt_pk_bf16(qs * E, 0.f)); } }
      u32x4 a, b2; a.x = cvt_pk_bf16(ktv[0], ktv[1]); a.y = cvt_pk_bf16(ktv[2], ktv[3]); a.z = cvt_pk_bf16(ktv[4], ktv[5]); a.w = cvt_pk_bf16(ktv[6], ktv[7]);
      b2.x = cvt_pk_bf16(ktv[8], ktv[9]); b2.y = cvt_pk_bf16(ktv[10], ktv[11]); b2.z = cvt_pk_bf16(ktv[12], ktv[13]); b2.w = cvt_pk_bf16(ktv[14], ktv[15]);
      *(LAS u32x4*)(L + SC_KT + k * 144 + 32 * qu) = a; *(LAS u32x4*)(L + SC_KT + k * 144 + 32 * qu + 16) = b2;
      if (FULL) { const unsigned kw[8] = {a.x, a.y, a.z, a.w, b2.x, b2.y, b2.z, b2.w};
#pragma unroll
          for (int ti = 0; ti < 16; ++ti) *(LAS unsigned short*)(L + SC_BF + (16 * qu + ti) * 272 + 2 * k) = (unsigned short)((ti & 1) ? (kw[ti >> 1] >> 16) : (kw[ti >> 1] & 0xffffu)); } }
    __syncthreads();
    if (nrow0 >= 0) scan_fetch<DIR, FULL>(F, h, nrow0, pre);
    if (FULL) {
#pragma unroll
        for (int tb = 0; tb < 4; ++tb)
#pragma unroll
            for (int r = 0; r < 4; ++r) o[tb][r] = oload ? oload[(tb * 4 + r) * 512] : 0.f; }
    __builtin_amdgcn_sched_barrier(0);
    if (FULL) {
        const int tb = w >> 1;
#pragma unroll
        for (int q = 0; q < 2; ++q) { const int sb = 2 * (w & 1) + q; f32x4 acc = (f32x4){0.f, 0.f, 0.f, 0.f};
#pragma unroll
            for (int ks = 0; ks < 4; ++ks) { const bf16x8 a = *(const LAS bf16x8*)(L + SC_BF + (16 * sb + fr) * 272 + (32 * ks + 8 * g) * 2); const bf16x8 b = *(const LAS bf16x8*)(L + SC_BQ + (16 * tb + fr) * 272 + (32 * ks + 8 * g) * 2);
                acc = mfma16(a, b, acc); }
            const int t = 16 * tb + fr; float m[4];
#pragma unroll
            for (int r = 0; r < 4; ++r) { const int s = 16 * sb + 4 * g + r; const bool keep = DIR == 0 ? (s <= t) : (s >= t); m[r] = keep ? acc[r] : 0.f; }
            u32x2 wv; wv.x = pk2(m[0], m[1]); wv.y = pk2(m[2], m[3]); *(LAS u32x2*)(L + SC_PM + t * 144 + (16 * sb + 4 * g) * 2) = wv; }
        __syncthreads();
    }
    bf16x8 vt[2];
#pragma unroll
    for (int ks = 0; ks < 2; ++ks) vt[ks] = *(const LAS bf16x8*)(L + SC_VT + (16 * w + fr) * 144 + (32 * ks + 8 * g) * 2);
    if (FULL) {
        bf16x8 sf[4];
#pragma unroll
        for (int ks = 0; ks < 4; ++ks) { const f32x4 ca = *(const LAS f32x4*)(C1 + 32 * ks + 4 * g), cb = *(const LAS f32x4*)(C1 + 32 * ks + 16 + 4 * g); const f32x4 x = S[2 * ks] * ca, y = S[2 * ks + 1] * cb;
            u32x4 pkd; pkd.x = pk2(x[0], x[1]); pkd.y = pk2(x[2], x[3]); pkd.z = pk2(y[0], y[1]); pkd.w = pk2(y[2], y[3]); sf[ks] = __builtin_bit_cast(bf16x8, pkd); }
#pragma unroll
        for (int tb = 0; tb < 4; ++tb) { f32x4 acc = o[tb];
#pragma unroll
            for (int ks = 0; ks < 4; ++ks) { const u32x2 a0 = *(const LAS u32x2*)(L + SC_BQ + (16 * tb + fr) * 272 + (32 * ks + 4 * g) * 2), a1 = *(const LAS u32x2*)(L + SC_BQ + (16 * tb + fr) * 272 + (32 * ks + 16 + 4 * g) * 2);
                u32x4 pa; pa.x = a0.x; pa.y = a0.y; pa.z = a1.x; pa.w = a1.y; acc = mfma16(__builtin_bit_cast(bf16x8, pa), sf[ks], acc); }
#pragma unroll
            for (int ks = 0; ks < 2; ++ks) { const bf16x8 a = *(const LAS bf16x8*)(L + SC_PM + (16 * tb + fr) * 144 + (32 * ks + 8 * g) * 2); acc = mfma16(a, vt[ks], acc); }
            o[tb] = acc; __builtin_amdgcn_sched_barrier(0); }
    }
#pragma unroll
    for (int kb = 0; kb < 8; ++kb) { f32x4 tmp = (f32x4){0.f, 0.f, 0.f, 0.f};
#pragma unroll
        for (int ks = 0; ks < 2; ++ks) { const bf16x8 a = *(const LAS bf16x8*)(L + SC_KT + (16 * kb + fr) * 144 + (32 * ks + 8 * g) * 2); tmp = mfma16(a, vt[ks], tmp); }
        const f32x4 dc = *(const LAS f32x4*)(DEC + 16 * kb + 4 * g), c2 = *(const LAS f32x4*)(C2 + 16 * kb + 4 * g); S[kb] = dc * S[kb] + c2 * tmp; if (kb & 1) __builtin_amdgcn_sched_barrier(0); }
}
__device__ __forceinline__ void state_store(float* dst, const f32x4 (&S)[8], int w, int lane) {
    GAS float* p = (GAS float*)dst + (unsigned)(w * 2048 + lane);
#pragma unroll
    for (int kb = 0; kb < 8; ++kb)
#pragma unroll
        for (int r = 0; r < 4; ++r) p[(kb * 4 + r) * 64] = S[kb][r]; }
__device__ __forceinline__ void state_load(const float* src, f32x4 (&S)[8], int w, int lane) {
    const GAS float* p = (const GAS float*)src + (unsigned)(w * 2048 + lane);
#pragma unroll
    for (int kb = 0; kb < 8; ++kb)
#pragma unroll
        for (int r = 0; r < 4; ++r) S[kb][r] = p[(kb * 4 + r) * 64]; }
__device__ __forceinline__ float* sc_SU(Frame& F) { return (float*)(F.ws + WS_SU); }
__device__ __forceinline__ float* sc_SS(Frame& F) { return (float*)(F.ws + WS_SS); }
__device__ __forceinline__ float* sc_SD(Frame& F) { return (float*)(F.ws + WS_SD); }
__device__ __forceinline__ float* sc_CARRY(Frame& F) { return (float*)(F.ws + WS_SD) + 8 * 64 * 128; }

__device__ __forceinline__ float* sc_OSCR(Frame& F) { return (float*)(F.ws + WS_OSCR) + (size_t)F.bid * 32768; }
__device__ __forceinline__ void scanA_item(Frame& F, int l, int item) {
    const int h = item >> 6, seg = item & 63, segrow = CTX + 256 * seg; f32x4 S[8], odummy[4]; float segsum; u32x4 pre[8];
#pragma unroll
    for (int kb = 0; kb < 8; ++kb) S[kb] = (f32x4){0.f, 0.f, 0.f, 0.f};
    segsum = 0.f;
    scan_fetch<0, false>(F, h, segrow, pre);
#pragma unroll 1
    for (int c_ = 0; c_ < 4; ++c_) { int c = c_; asm volatile("" : "+s"(c)); scan_chunk<0, false>(F, l, h, c < 3 ? segrow + 64 * (c + 1) : -1, pre, S, odummy, segsum); }
    state_store(sc_SU(F) + ((size_t)(h * 2 + 0) * 64 + seg) * 16384, S, F.wave, F.lane);
    if (F.tid < 128) sc_SD(F)[((h * 2 + 0) * 64 + seg) * 128 + F.tid] = __builtin_amdgcn_exp2f(segsum);
#pragma unroll
    for (int kb = 0; kb < 8; ++kb) S[kb] = (f32x4){0.f, 0.f, 0.f, 0.f};
    segsum = 0.f;
    scan_fetch<1, false>(F, h, segrow + 192, pre);
#pragma unroll 1
    for (int c_ = 3; c_ >= 0; --c_) { int c = c_; asm volatile("" : "+s"(c)); scan_chunk<1, false>(F, l, h, c > 0 ? segrow + 64 * (c - 1) : -1, pre, S, odummy, segsum); }
    state_store(sc_SU(F) + ((size_t)(h * 2 + 1) * 64 + seg) * 16384, S, F.wave, F.lane);
    if (F.tid < 128) sc_SD(F)[((h * 2 + 1) * 64 + seg) * 128 + F.tid] = __builtin_amdgcn_exp2f(segsum);
}
__device__ __forceinline__ void scan_full(Frame& F, int l, int h, int segrow, const float* sinf, const float* sinb, float* outf, float* outb) {
    f32x4 S[8], o[4]; float segsum = 0.f; const int w = F.wave, lane = F.lane, fr = lane & 15, g = lane >> 4; u32x4 pre[8];
    GAS float* oscr = (GAS float*)sc_OSCR(F) + (unsigned)F.tid;
    if (sinf) state_load(sinf, S, w, lane); else {
#pragma unroll
        for (int kb = 0; kb < 8; ++kb) S[kb] = (f32x4){0.f, 0.f, 0.f, 0.f}; }
    scan_fetch<0, true>(F, h, segrow, pre);
#pragma unroll 1
    for (int c_ = 0; c_ < 4; ++c_) { int c = c_; asm volatile("" : "+s"(c));
        scan_chunk<0, true>(F, l, h, c < 3 ? segrow + 64 * (c + 1) : -1, pre, S, o, segsum);
#pragma unroll
        for (int tb = 0; tb < 4; ++tb)
#pragma unroll
            for (int r = 0; r < 4; ++r) (oscr + c * 8192)[(tb * 4 + r) * 512] = o[tb][r];
    }
    if (outf) state_store(outf, S, w, lane);
    VM_WAIT();
    if (sinb) state_load(sinb, S, w, lane); else {
#pragma unroll
        for (int kb = 0; kb < 8; ++kb) S[kb] = (f32x4){0.f, 0.f, 0.f, 0.f}; }
    LAS unsigned char* L = F.lds + RING_OFF; LAS float* SSQ = (LAS float*)(L + SC_SSQ);
    const float ngv = F.hng()[l * 512 + h * 128 + 16 * w + fr];
    scan_fetch<1, true>(F, h, segrow + 192, pre);
#pragma unroll 1
    for (int c_ = 3; c_ >= 0; --c_) { int c = c_; asm volatile("" : "+s"(c));
        scan_chunk<1, true>(F, l, h, c > 0 ? segrow + 64 * (c - 1) : -1, pre, S, o, segsum, oscr + c * 8192);
#pragma unroll
        for (int tb = 0; tb < 4; ++tb) { f32x4 q = o[tb] * o[tb];
#pragma unroll
            for (int m = 1; m < 16; m <<= 1) { q[0] += lane_xor(q[0], m, lane); q[1] += lane_xor(q[1], m, lane); q[2] += lane_xor(q[2], m, lane); q[3] += lane_xor(q[3], m, lane); }
            if (fr == 0) {
#pragma unroll
                for (int r = 0; r < 4; ++r) SSQ[(16 * tb + 4 * g + r) * 8 + w] = q[r]; } }
        __syncthreads();
#pragma unroll
        for (int tb = 0; tb < 4; ++tb)
#pragma unroll
            for (int r = 0; r < 4; ++r) { const int t = 16 * tb + 4 * g + r; const f32x4 p0 = *(const LAS f32x4*)(SSQ + t * 8), p1 = *(const LAS f32x4*)(SSQ + t * 8 + 4);
                const float ss = ((p0[0] + p0[1]) + (p0[2] + p0[3])) + ((p1[0] + p1[1]) + (p1[2] + p1[3])); const float rs = rsqrtf(ss * (1.f / 128.f) + 1e-6f);
                const float gp = bf2f(*(const LAS unsigned short*)(L + SC_G + t * 272 + 2 * (16 * w + fr)));
                *(LAS unsigned short*)(L + SC_BQ + t * 272 + 2 * (16 * w + fr)) = (unsigned short)f2bf(o[tb][r] * rs * ngv * gp); }
        __syncthreads();
#pragma unroll
        for (int i = 0; i < 2; ++i) { const int id = F.tid + 512 * i, row = id >> 4, cc = id & 15; const u32x4 d = *(const LAS u32x4*)(L + SC_BQ + row * 272 + 16 * cc);
            *(GAS u32x4*)((GAS bf16_t*)F.CAT() + (unsigned)((segrow + 64 * c + row) * D + h * 128 + 8 * cc)) = d; }
    }
    if (outb) state_store(outb, S, w, lane);
}
__device__ __forceinline__ void scanB(Frame& F) {
    const int e = F.bid * NTHR + F.tid; if (e >= 8 * 16384) return;
    const int hd = e >> 14, idx = e & 16383, d = hd & 1; const int ln = idx & 63, reg = (idx >> 6) & 3, kb = (idx >> 8) & 7; const int k = 16 * kb + 4 * (ln >> 4) + reg;
    const float* SU = sc_SU(F) + (size_t)hd * 64 * 16384 + idx; const float* SD = sc_SD(F) + hd * 64 * 128 + k; float* SS = sc_SS(F) + (size_t)hd * 64 * 16384 + idx;
    float S = sc_CARRY(F)[hd * 16384 + idx];
    if (d == 0) { for (int seg = 0; seg < 64; ++seg) { SS[(size_t)seg * 16384] = S; S = SD[seg * 128] * S + SU[(size_t)seg * 16384]; } }
    else { for (int seg = 63; seg >= 0; --seg) { SS[(size_t)seg * 16384] = S; S = SD[seg * 128] * S + SU[(size_t)seg * 16384]; } }
}

__device__ __forceinline__ void ph_mixA(Frame& F, int l) {
    scanA_item(F, l, F.bid);
    if (F.bid >= 4 && F.bid < 8) { const int h = F.bid - 4; scan_full(F, l, h, 0, nullptr, nullptr, sc_CARRY(F) + (h * 2 + 0) * 16384, sc_CARRY(F) + (h * 2 + 1) * 16384); }
    fftA_item(F, F.bid);
    for (int it = F.bid; it < 65 * 4; it += F.G) pool_item(F, l, it);
}
__device__ __forceinline__ void ph_mixB(Frame& F, int l) {
    scanB(F);
    fftB_item(F, F.bid);
    if (l == 0 && F.bid >= 252) fftC_item(F, F.bid - 252);
}
__device__ __forceinline__ void ph_mixC(Frame& F, int l) {
    const int item = F.bid, h = item >> 6, seg = item & 63;
    scan_full(F, l, h, CTX + 256 * seg, sc_SS(F) + ((size_t)(h * 2 + 0) * 64 + seg) * 16384, sc_SS(F) + ((size_t)(h * 2 + 1) * 64 + seg) * 16384, nullptr, nullptr);
}
#ifndef DUP
#define DUP -1
#endif
#define GRID_BAR() do { { Frame R = relaunder(F); xcd_barrier(bar, R.tid); } if (DUP == 99) { Frame R = relaunder(F); xcd_barrier(bar, R.tid); } } while (0)
__global__ void __launch_bounds__(NTHR, 2) mega_fwd(Params p) {
    extern __shared__ __attribute__((aligned(16))) unsigned char lds[];
    Frame F; frame_init(F, p, lds);
    if (F.tid < 16) ((LAS unsigned*)(F.lds + MISC_OFF))[F.tid] = 0u;
    __syncthreads();
    XcdBarrier bar = xcd_barrier_post((unsigned*)(F.ctl() + CW_BAR), (volatile LAS unsigned*)(F.lds + MISC_OFF + 32));
    { Frame R = relaunder(F); ph_prologue(R); } { Frame R = relaunder(F); ph_prologue2(R); }
    if (DUP == 0) { { Frame R = relaunder(F); ph_prologue(R); } { Frame R = relaunder(F); ph_prologue2(R); } }
    GRID_BAR();
    { Frame R = relaunder(F); ph_mod1(R, 0); }
    if (DUP == 1) { Frame R = relaunder(F); ph_mod1(R, 0); }
    GRID_BAR();
#pragma unroll 1
    for (int l = 0; l < 2; ++l) {
        { Frame R = relaunder(F); ph_win(R, l); }        if (DUP == 2) { Frame R = relaunder(F); ph_win(R, l); }        GRID_BAR();
        { Frame R = relaunder(F); ph_mixA(R, l); }       if (DUP == 3) { Frame R = relaunder(F); ph_mixA(R, l); }       GRID_BAR();
        { Frame R = relaunder(F); ph_mixB(R, l); }       if (DUP == 4) { Frame R = relaunder(F); ph_mixB(R, l); }       GRID_BAR();
        { Frame R = relaunder(F); ph_mixC(R, l); }       if (DUP == 5) { Frame R = relaunder(F); ph_mixC(R, l); }       GRID_BAR();
        { Frame R = relaunder(F); ph_wout(R, l); }       if (DUP == 6 && l == 0) { Frame R = relaunder(F); ph_wout(R, l); }   GRID_BAR();
        if (DUP == 7) { { Frame R = relaunder(F); ph_mod2_route(R, l, l + 2); } GRID_BAR(); }
        { Frame R = relaunder(F); ph_mod2_route(R, l, l); } GRID_BAR();
        { Frame R = relaunder(F); ph_gateup(R, l); }     if (DUP == 8) { Frame R = relaunder(F); ph_gateup(R, l); }     GRID_BAR();
        { Frame R = relaunder(F); ph_down(R, l); }       if (DUP == 9) { Frame R = relaunder(F); ph_down(R, l); }       GRID_BAR();
        { Frame R = relaunder(F); ph_combine(R, l); }    if (DUP == 10 && l == 1) { Frame R = relaunder(F); ph_combine(R, l); }
        if (l == 0) GRID_BAR();
    }
}
extern "C" void kernel_launch(void* const* d_in, const int* in_sizes, int n_in, void* d_out, int out_size, void* d_ws, size_t ws_size, hipStream_t stream) {
    static int ok = 0;
    if (ok == 0) {
        if (n_in != 22 || out_size != LAT * D || ws_size < WS_FASTEND) { fprintf(stderr, "kernel_launch: unexpected shapes / workspace (n_in %d, out %d, ws %zu < %zu); nothing launched\n", n_in, out_size, ws_size, (size_t)WS_FASTEND); ok = -1; return; }
        int dev = 0, cus = 0, per_cu = 0;
        if (hipGetDevice(&dev) != hipSuccess || hipDeviceGetAttribute(&cus, hipDeviceAttributeMultiprocessorCount, dev) != hipSuccess) { ok = -1; return; }
        if (hipFuncSetAttribute((const void*)mega_fwd, hipFuncAttributeMaxDynamicSharedMemorySize, LDS_BYTES) != hipSuccess) { fprintf(stderr, "kernel_launch: hipFuncSetAttribute failed\n"); ok = -1; return; }
        if (hipOccupancyMaxActiveBlocksPerMultiprocessor(&per_cu, (const void*)mega_fwd, NTHR, LDS_BYTES) != hipSuccess || per_cu < 1) fprintf(stderr, "kernel_launch: note: occupancy query reports %d workgroups per CU\n", per_cu);
        (void)hipGetLastError();
        if (cus < 256) fprintf(stderr, "kernel_launch: device has %d CUs; this kernel needs 256 co-resident workgroups (one per CU)\n", cus);
        ok = 1;
    }
    if (ok < 0) return;
    if (hipMemsetAsync((char*)d_ws + WS_CTL, 0, CTL_ZERO_BYTES, stream) != hipSuccess) return;
    Params p{}; for (int i = 0; i < 22; ++i) p.in[i] = (const float*)d_in[i]; p.out = (float*)d_out; p.ws = (unsigned char*)d_ws;
    hipLaunchKernelGGL(mega_fwd, dim3(256), dim3(NTHR), LDS_BYTES, stream, p);
}
```

```cpp
#include <hip/hip_runtime.h>
#include <cstdio>
#include <cstdint>
constexpr int D = 1024, LAT = 16384, CTX = 256, T = LAT + CTX, DIN = 3072, NE = 32, TOPK = 4;
constexpr int GW = 64;
#ifndef PSTR
#define PSTR DIN
#endif
constexpr int DINX = 3328, FQ_OFF = 2816;
#define GAS __attribute__((address_space(1)))
#define LAS __attribute__((address_space(3)))
typedef unsigned short bf16_t;
typedef short bf16x8 __attribute__((ext_vector_type(8)));
typedef short bf16x4 __attribute__((ext_vector_type(4)));
typedef float f32x4 __attribute__((ext_vector_type(4)));
typedef float f32x2 __attribute__((ext_vector_type(2)));
typedef unsigned u32x4 __attribute__((ext_vector_type(4)));
typedef unsigned u32x2 __attribute__((ext_vector_type(2)));
typedef GAS unsigned gu32;
#define RLX_AGENT __ATOMIC_RELAXED, __HIP_MEMORY_SCOPE_AGENT
#define LDS_WAIT() asm volatile("s_waitcnt lgkmcnt(0)" ::: "memory")
#define VM_WAIT() asm volatile("s_waitcnt vmcnt(0)" ::: "memory")
__device__ __forceinline__ unsigned cvt_pk_bf16(float lo, float hi) { unsigned r; asm("v_cvt_pk_bf16_f32 %0, %1, %2" : "=v"(r) : "v"(lo), "v"(hi)); return r; }
__device__ __forceinline__ unsigned f2bf(float f) { return cvt_pk_bf16(f, 0.f) & 0xffffu; }
__device__ __forceinline__ unsigned pk2(float lo, float hi) { return cvt_pk_bf16(lo, hi); }
__device__ __forceinline__ float bf2f(unsigned short b) { return __builtin_bit_cast(float, ((unsigned)b) << 16); }
__device__ __forceinline__ float bflo(unsigned w) { return __builtin_bit_cast(float, w << 16); }
__device__ __forceinline__ float bfhi(unsigned w) { return __builtin_bit_cast(float, w & 0xffff0000u); }
__device__ __forceinline__ float fsigm(float x) { return __builtin_amdgcn_rcpf(1.f + __builtin_amdgcn_exp2f(-1.44269504f * x)); }
__device__ __forceinline__ float lane_xor(float v, int m, int lane) { return __builtin_bit_cast(float, __builtin_amdgcn_ds_bpermute((lane ^ m) << 2, __builtin_bit_cast(int, v))); }
__device__ __forceinline__ int lane_get(int v, int src) { return __builtin_amdgcn_ds_bpermute(src << 2, v); }
__device__ __forceinline__ float wave_sum(float v, int lane) {
#pragma unroll
    for (int o = 1; o < 64; o <<= 1) v += lane_xor(v, o, lane);
    return v;
}

#define XB_TMO      128
#define XB_XCNT(j)  (256  + 64 * (j))
#define XB_XSUB(j)  (1280 + 64 * (j))
#define XB_XGEN(j)  (2304 + 64 * (j))
#define XB_TOP      3328
#define XB_TOPGEN   3392
#define XCD_BAR_WORDS 3456
#define XB_SPIN_CAP (1u << 18)
__device__ __forceinline__ unsigned xb_ld(unsigned* p)              { return __hip_atomic_load(p, __ATOMIC_RELAXED, __HIP_MEMORY_SCOPE_AGENT); }
__device__ __forceinline__ unsigned xb_add(unsigned* p, unsigned v) { return __hip_atomic_fetch_add(p, v, __ATOMIC_RELAXED, __HIP_MEMORY_SCOPE_AGENT); }
__device__ __forceinline__ unsigned xb_xcc_id() { return (unsigned)__builtin_amdgcn_s_getreg((3 << 11) | 20) & 0xFu; }
#define XB_SPIN(cond, bar) do { unsigned _sp = 0; while (cond) { __builtin_amdgcn_s_sleep(1); \
    if ((++_sp & 255u) == 0u) { if (xb_ld(&(bar)[XB_TMO])) break; if (_sp > XB_SPIN_CAP) { atomicAdd(&(bar)[XB_TMO], 1u); break; } } } } while (0)
struct XcdBarrier { unsigned* bar; unsigned x; volatile LAS unsigned* st; };
__device__ __forceinline__ XcdBarrier xcd_barrier_post(unsigned* bar, volatile LAS unsigned* st) {
    XcdBarrier b; b.bar = bar; b.x = xb_xcc_id(); b.st = st;
    if (threadIdx.x == 0) (void)xb_add(&bar[XB_XCNT(b.x)], 1u);
    return b;
}
__device__ __forceinline__ void xcd_barrier_complete(unsigned* bar, unsigned x, unsigned& nloc, unsigned& nx) {
    const unsigned G = gridDim.x * gridDim.y * gridDim.z;
    unsigned sum, cnt, mine, sp = 0u;
    for (;;) {
        sum = 0u; cnt = 0u; mine = 0u;
#pragma unroll
        for (unsigned j = 0; j < 16; ++j) { const unsigned c = xb_ld(&bar[XB_XCNT(j)]); sum += c; cnt += (c > 0u) ? 1u : 0u; mine = (j == x) ? c : mine; }
        if (sum == G) break;
        __builtin_amdgcn_s_sleep(1);
        if ((++sp & 255u) == 0u) { if (xb_ld(&bar[XB_TMO])) break; if (sp > XB_SPIN_CAP) { atomicAdd(&bar[XB_TMO], 1u); break; } }
    }
    nloc = mine > 0u ? mine : 1u; nx = cnt > 0u ? cnt : 1u;
}
__device__ __forceinline__ void xcd_barrier(const XcdBarrier& b, const int tid) {
    asm volatile("s_waitcnt vmcnt(0)" ::: "memory");
    unsigned blo = (unsigned)(unsigned long long)b.bar, bhi = (unsigned)((unsigned long long)b.bar >> 32), bx = b.x;
    asm volatile("" : "+s"(blo), "+s"(bhi), "+s"(bx));
    __syncthreads();
    if (tid == 0) {
        unsigned* bar = (unsigned*)(((unsigned long long)bhi << 32) | blo);
        __builtin_amdgcn_s_waitcnt(0);
        unsigned nloc = b.st[0], nx = b.st[1];
        if (nloc == 0u) { xcd_barrier_complete(bar, bx, nloc, nx); b.st[0] = nloc; b.st[1] = nx; }
        const unsigned old = xb_add(&bar[XB_XSUB(bx)], 1u);
        const unsigned gen = old / nloc;
        if (old + 1u == (gen + 1u) * nloc) {
            __builtin_amdgcn_fence(__ATOMIC_RELEASE, "agent");
            asm volatile("s_waitcnt vmcnt(0)" ::: "memory");
            const unsigned og = xb_add(&bar[XB_TOP], 1u);
            const unsigned tg = og / nx;
            if (og + 1u == (tg + 1u) * nx) xb_add(&bar[XB_TOPGEN], 1u);
            else XB_SPIN(xb_ld(&bar[XB_TOPGEN]) == tg, bar);
            __builtin_amdgcn_fence(__ATOMIC_ACQUIRE, "agent");
            xb_add(&bar[XB_XGEN(bx)], 1u);
            asm volatile("s_waitcnt vmcnt(0)" ::: "memory");
        } else {
            XB_SPIN(xb_ld(&bar[XB_XGEN(bx)]) == gen, bar);
            __builtin_amdgcn_fence(__ATOMIC_ACQUIRE, "agent");
            asm volatile("s_waitcnt vmcnt(0)" ::: "memory");
        }
    }
    __syncthreads();
}

namespace pg8 {
constexpr int BM = 256, BK = 64, HALF = 128, HTB = HALF * BK * 2, STAGE_BYTES = 8 * HTB, NXCD = 8, WGM = 8;
__host__ __device__ __forceinline__ int lds_byte(int r, int c) { const int st = (r >> 4) * 2 + (c >> 5), rr = r & 15, cc = c & 31, ob = rr * 64 + cc * 2; return st * 1024 + (ob ^ (((ob >> 9) & 1) << 5)); }
__host__ __device__ __forceinline__ void stage_rc(int b, int& R, int& C) { const int st = b / 1024, sb = b % 1024, swz = sb ^ (((sb >> 9) & 1) << 5); R = (st >> 1) * 16 + swz / 64; C = (st & 1) * 32 + (swz % 64) / 2; }
__host__ __device__ __forceinline__ int perm32(int rho) { const int n = rho >> 4, i = rho & 15; return 8 * (i >> 2) + 4 * n + (i & 3); }

struct Unit { int pm, pn, e, ui; };

typedef int i32x8 __attribute__((ext_vector_type(8)));
typedef int i32x4 __attribute__((ext_vector_type(4)));
__device__ __forceinline__ i32x8 cat8(bf16x8 a, bf16x8 b) { return __builtin_shufflevector(__builtin_bit_cast(i32x4, a), __builtin_bit_cast(i32x4, b), 0, 1, 2, 3, 4, 5, 6, 7); }
template <class Epi, class Sched, bool ALIGN_EPI = true, bool FP8 = false>
__device__ __forceinline__ void gemm_phase(LAS unsigned char* lds, const char* gA, const int Kb, const Sched& S, const Epi& E, const int tid) {
    const int wid = __builtin_amdgcn_readfirstlane(tid >> 6), lane = tid & 63, wr = wid >> 2, wc = wid & 3, fr = lane & 15, fq = lane >> 4;
    const int nt = Kb / (BK * 2);
    int Ra[2], Ca[2]; unsigned voffB[2];
#pragma unroll
    for (int i = 0; i < 2; ++i) { int R, C; stage_rc(tid * 16 + i * 8192, R, C); const int Rb = Epi::PERM ? ((R & ~31) + perm32(R & 31)) : R;
        Ra[i] = R; Ca[i] = C * 2; voffB[i] = (unsigned)(Rb * Kb + C * 2); }
    const size_t kstep = (size_t)(BK * 2);
    const size_t hstep = (size_t)HALF * Kb;
    const unsigned ldsw = (unsigned)wid * 1024u;
    const int aoff = lds_byte(wr * 64 + fr, fq * 8), boff = lds_byte(wc * 32 + fr, fq * 8);
#define PG8_SA(b, h) (((b) * 2 + (h)) * HTB)
#define PG8_SB(b, h) ((4 + (b) * 2 + (h)) * HTB)
#define PG8_STAGE(bufoff, gbase, voff) do { _Pragma("unroll") for (int _i = 0; _i < 2; ++_i) \
        __builtin_amdgcn_global_load_lds((const unsigned*)((const char*)(gbase) + (voff)[_i]), (LAS unsigned*)(lds + (bufoff) + ldsw + _i * 8192), 16, 0, 0); } while (0)
#define PG8_LDA(dst, b, h) do { _Pragma("unroll") for (int m = 0; m < 4; ++m) _Pragma("unroll") for (int k = 0; k < 2; ++k) dst[m][k] = *(const LAS bf16x8*)(lds + PG8_SA(b, h) + aoff + m * 2048 + k * 1024); } while (0)
#define PG8_LDB(dst, b, h) do { _Pragma("unroll") for (int n = 0; n < 2; ++n) _Pragma("unroll") for (int k = 0; k < 2; ++k) dst[n][k] = *(const LAS bf16x8*)(lds + PG8_SB(b, h) + boff + n * 2048 + k * 1024); } while (0)
#define PG8_MMA(ai, bj, At, Bt) do { __builtin_amdgcn_s_setprio(1); _Pragma("unroll") for (int m = 0; m < 4; ++m) _Pragma("unroll") for (int n = 0; n < 2; ++n) { \
        if constexpr (FP8) asm volatile("v_mfma_scale_f32_16x16x128_f8f6f4 %0, %1, %2, %0, %3, %3 op_sel_hi:[0,0,0]" : "+v"(acc[ai][bj][m][n]) : "v"(cat8(Bt[n][0], Bt[n][1])), "v"(cat8(At[m][0], At[m][1])), "v"(scl)); \
        else { _Pragma("unroll") for (int k = 0; k < 2; ++k) acc[ai][bj][m][n] = __builtin_amdgcn_mfma_f32_16x16x32_bf16(Bt[n][k], At[m][k], acc[ai][bj][m][n], 0, 0, 0); } } __builtin_amdgcn_s_setprio(0); } while (0)
#define PG8_WAIT_V(n) asm volatile("s_waitcnt vmcnt(" #n ")" ::: "memory")
#define PG8_WAIT_L(n) asm volatile("s_waitcnt lgkmcnt(" #n ")" ::: "memory")
#define PG8_BAR __builtin_amdgcn_s_barrier()
#define PG8_SCHED __builtin_amdgcn_sched_barrier(0)
    Unit cur, nxt; int ui = 0;
    if (!S.next(0, cur)) return;
    f32x4 acc[2][2][4][2];
#pragma unroll
    for (int a = 0; a < 2; ++a)
#pragma unroll
        for (int b = 0; b < 2; ++b)
#pragma unroll
            for (int m = 0; m < 4; ++m)
#pragma unroll
                for (int n = 0; n < 2; ++n) acc[a][b][m][n] = (f32x4){0.f, 0.f, 0.f, 0.f};
    bf16x8 At[4][2], B0[2][2], B1[2][2]; const int scl = 0x7f7f7f7f;
    unsigned vA[2][2];
#pragma unroll
    for (int h = 0; h < 2; ++h)
#pragma unroll
        for (int i = 0; i < 2; ++i) vA[h][i] = S.a_row_off(cur, h * HALF + Ra[i]) + (unsigned)Ca[i];
    const char* cB = S.b_tile(cur);
    PG8_STAGE(PG8_SB(0, 0), cB, voffB); PG8_STAGE(PG8_SB(0, 1), cB + hstep, voffB); PG8_STAGE(PG8_SA(0, 0), gA, vA[0]); PG8_STAGE(PG8_SA(0, 1), gA, vA[1]);
    if (wr == 1) PG8_BAR;
    PG8_WAIT_V(2); PG8_BAR;
    PG8_STAGE(PG8_SB(1, 0), cB + kstep, voffB); PG8_STAGE(PG8_SA(1, 0), gA + kstep, vA[0]); PG8_STAGE(PG8_SB(1, 1), cB + hstep + kstep, voffB);
    PG8_WAIT_V(6); PG8_BAR;
    for (;;) {
        const bool has_next = S.next(ui + 1, nxt);
        const char* nB = has_next ? S.b_tile(nxt) : cB;
        for (int t = 0; t < nt; t += 2) {
            const bool last = (t == nt - 2);
            unsigned tN[2][2];
#pragma unroll
            for (int h = 0; h < 2; ++h)
#pragma unroll
                for (int i = 0; i < 2; ++i) tN[h][i] = vA[h][i];
            if (last && has_next) {
#pragma unroll
                for (int h = 0; h < 2; ++h)
#pragma unroll
                    for (int i = 0; i < 2; ++i) tN[h][i] = S.a_row_off(nxt, h * HALF + Ra[i]) + (unsigned)Ca[i];
                PG8_WAIT_L(0);
            }
            const char* a1 = gA + (size_t)(t + 1) * kstep;
            const char* a2 = last ? gA : gA + (size_t)(t + 2) * kstep; const char* b2 = last ? nB : cB + (size_t)(t + 2) * kstep;
            const char* a3 = a2 + kstep; const char* b3 = b2 + kstep;
            PG8_LDB(B0, 0, 0); PG8_LDB(B1, 0, 1); PG8_SCHED; PG8_LDA(At, 0, 0); PG8_STAGE(PG8_SA(1, 1), a1, vA[1]);
#pragma unroll
            for (int h = 0; h < 2; ++h)
#pragma unroll
                for (int i = 0; i < 2; ++i) vA[h][i] = tN[h][i];
            PG8_WAIT_V(8); PG8_WAIT_L(0); PG8_BAR; PG8_MMA(0, 0, At, B0); PG8_MMA(0, 1, At, B1); PG8_BAR; PG8_SCHED;
            PG8_LDA(At, 0, 1); PG8_STAGE(PG8_SB(0, 0), b2, voffB); PG8_STAGE(PG8_SB(0, 1), b2 + hstep, voffB); PG8_STAGE(PG8_SA(0, 0), a2, vA[0]);
            PG8_WAIT_V(8); PG8_WAIT_L(0); PG8_BAR; PG8_MMA(1, 0, At, B0); PG8_MMA(1, 1, At, B1); PG8_BAR; PG8_SCHED;
            PG8_LDB(B0, 1, 0); PG8_LDB(B1, 1, 1); PG8_SCHED; PG8_LDA(At, 1, 0); PG8_STAGE(PG8_SA(0, 1), a2, vA[1]);
            PG8_WAIT_V(8); PG8_WAIT_L(0); PG8_BAR; PG8_MMA(0, 0, At, B0); PG8_MMA(0, 1, At, B1); PG8_BAR; PG8_SCHED;
            PG8_LDA(At, 1, 1); PG8_STAGE(PG8_SB(1, 0), b3, voffB); PG8_STAGE(PG8_SB(1, 1), b3 + hstep, voffB); PG8_STAGE(PG8_SA(1, 0), a3, vA[0]);
            PG8_WAIT_V(8); PG8_WAIT_L(0); PG8_BAR; PG8_MMA(1, 0, At, B0); PG8_MMA(1, 1, At, B1); PG8_BAR; PG8_SCHED;
        }
        if constexpr (ALIGN_EPI) { if (wr == 0) PG8_BAR; }
        if constexpr (FP8) asm volatile("s_nop 15\n\ts_nop 15" ::: "memory");
        E(acc, cur, wr, wc, fr, fq);
        if (!has_next) break;
#pragma unroll
        for (int a = 0; a < 2; ++a)
#pragma unroll
            for (int b = 0; b < 2; ++b)
#pragma unroll
                for (int m = 0; m < 4; ++m)
#pragma unroll
                    for (int n = 0; n < 2; ++n) acc[a][b][m][n] = (f32x4){0.f, 0.f, 0.f, 0.f};
        cur = nxt; cB = nB; ++ui;
        if constexpr (ALIGN_EPI) { if (wr == 1) PG8_BAR; }
    }
    PG8_WAIT_V(0);
    if constexpr (!ALIGN_EPI) { if (wr == 0) PG8_BAR; }
    PG8_BAR;
#undef PG8_SA
#undef PG8_SB
#undef PG8_STAGE
#undef PG8_LDA
#undef PG8_LDB
#undef PG8_MMA
#undef PG8_WAIT_V
#undef PG8_WAIT_L
#undef PG8_BAR
#undef PG8_SCHED
}
}
constexpr size_t MiB = 1u << 20;
constexpr int TP = T * 4 + NE * 256;
constexpr size_t WS_CTL = 0, CTL_ZERO_BYTES = 128 * 1024;
constexpr size_t WS_LB = 1 * MiB, WS_MOD = 1 * MiB + 65536;
constexpr size_t WS_WIN = 2 * MiB, WS_WOUT = 18 * MiB, WS_WF = 22 * MiB, WS_WGU = 24 * MiB, WS_WDN = 280 * MiB;
constexpr size_t WS_X = 408 * MiB, WS_H = 474 * MiB, WS_P = 508 * MiB, WS_CAT = 624 * MiB, WS_ROUTE = 658 * MiB, WS_ACT = 662 * MiB, WS_Y = 810 * MiB;
constexpr size_t WS_SU = 958 * MiB, WS_SS = 990 * MiB, WS_SD = 1022 * MiB, WS_YP = 1023 * MiB, WS_OSCR = 1040 * MiB, WS_H8 = 1072 * MiB, WS_CTXO = 1090 * MiB, WS_FASTEND = 1092 * MiB;
#ifndef MOE_FP8
#define MOE_FP8 1
#endif
constexpr float FP8_SH = 16.f, FP8_SW = 256.f, FP8_SA = 4.f;
constexpr size_t RT_TOPI = 0, RT_TOPW = 512 * 1024, RT_POS = 1024 * 1024, RT_LISTE = 1536 * 1024;
static_assert((size_t)T * 16 <= 512 * 1024 && RT_LISTE + (size_t)NE * T * 4 <= 4 * MiB, "route map");
static_assert(WS_WIN + (size_t)2 * DINX * D * 2 <= WS_WOUT && WS_WGU + (size_t)2 * NE * 2048 * 1024 * 2 <= WS_WDN && WS_WDN + (size_t)2 * NE * 1024 * 1024 * 2 <= WS_X && WS_X + (size_t)T * D * 4 <= WS_H && WS_H + (size_t)T * D * 2 <= WS_P &&
              WS_P + (size_t)T * DINX * 2 <= WS_CAT && WS_CAT + (size_t)T * D * 2 <= WS_ROUTE && WS_ACT + (size_t)TP * D * 2 <= WS_Y && WS_Y + (size_t)TP * D * 2 <= WS_SU &&
              WS_SD + (size_t)(8 * 64 * 128 + 8 * 16384) * 4 <= WS_YP && WS_YP + (size_t)128 * 128 * 2 * 256 * 2 <= WS_OSCR && WS_OSCR + (size_t)256 * 32768 * 4 <= WS_H8 && WS_H8 + (size_t)T * D <= WS_CTXO && WS_CTXO + (size_t)32 * 8192 * 4 <= WS_FASTEND, "ws map");
constexpr int CW_TMO = 0, CW_BAR = 4096, CW_CNT = 16384;
constexpr int RING_OFF = 0, RING_BYTES = 131072, TINFO_OFF = 131072, BT_OFF = 136192, ROWOFF_OFF = 136704, MISC_OFF = 146944, LDS_BYTES = 147456;
constexpr int NWAVES = 8, NTHR = 512;

struct Params { const float* in[22]; float* out; unsigned char* ws; };
constexpr int PTR_OFF = MISC_OFF + 64;
struct Frame {
    LAS unsigned char* lds; unsigned char* ws; int tid, lane, wave, vcu, G, bid;
    __device__ __forceinline__ const float* in(int i) const { const LAS unsigned* q = (const LAS unsigned*)(lds + PTR_OFF) + 2 * i;
        const unsigned lo = __builtin_amdgcn_readfirstlane(q[0]), hi = __builtin_amdgcn_readfirstlane(q[1]); return (const float*)(((unsigned long long)hi << 32) | lo); }
    __device__ __forceinline__ const float* x() const { return in(0); }        __device__ __forceinline__ const float* c() const { return in(1); }
    __device__ __forceinline__ const float* ctxin() const { return in(2); }    __device__ __forceinline__ const float* cctx() const { return in(3); }
    __device__ __forceinline__ const float* w_ada() const { return in(4); }    __device__ __forceinline__ const float* b_ada() const { return in(5); }
    __device__ __forceinline__ const float* norm1_g() const { return in(6); }  __device__ __forceinline__ const float* norm2_g() const { return in(7); }
    __device__ __forceinline__ const float* w_in() const { return in(8); }     __device__ __forceinline__ const float* lbp() const { return in(9); }
    __device__ __forceinline__ const float* hng() const { return in(10); }     __device__ __forceinline__ const float* pool_w() const { return in(11); }
    __device__ __forceinline__ const float* pool_s() const { return in(12); }  __device__ __forceinline__ const float* four_w() const { return in(13); }
    __device__ __forceinline__ const float* w_out() const { return in(14); }   __device__ __forceinline__ const float* router_w() const { return in(15); }
    __device__ __forceinline__ const float* router_b() const { return in(16); } __device__ __forceinline__ const float* w_gu() const { return in(17); }
    __device__ __forceinline__ const float* b_gu() const { return in(18); }    __device__ __forceinline__ const float* w_dn() const { return in(19); }
    __device__ __forceinline__ const float* b_dn() const { return in(20); }    __device__ __forceinline__ const float* fng() const { return in(21); }
    __device__ __forceinline__ float* out() const { return (float*)in(22); }
    __device__ __forceinline__ gu32* ctl() const { return (gu32*)(ws + WS_CTL); }
    __device__ __forceinline__ float* LB() const { return (float*)(ws + WS_LB); }       __device__ __forceinline__ float* MOD() const { return (float*)(ws + WS_MOD); }
    __device__ __forceinline__ float* X() const { return (float*)(ws + WS_X); }
    __device__ __forceinline__ bf16_t* Wt_in() const { return (bf16_t*)(ws + WS_WIN); }  __device__ __forceinline__ bf16_t* Wt_out() const { return (bf16_t*)(ws + WS_WOUT); }
    __device__ __forceinline__ bf16_t* Wt_gu() const { return (bf16_t*)(ws + WS_WGU); }  __device__ __forceinline__ bf16_t* Wt_dn() const { return (bf16_t*)(ws + WS_WDN); }
    __device__ __forceinline__ bf16_t* H() const { return (bf16_t*)(ws + WS_H); }        __device__ __forceinline__ bf16_t* P() const { return (bf16_t*)(ws + WS_P); }
    __device__ __forceinline__ bf16_t* CAT() const { return (bf16_t*)(ws + WS_CAT); }    __device__ __forceinline__ bf16_t* ACT() const { return (bf16_t*)(ws + WS_ACT); }
    __device__ __forceinline__ bf16_t* Y() const { return (bf16_t*)(ws + WS_Y); }
    __device__ __forceinline__ int* TOPI() const { return (int*)(ws + WS_ROUTE + RT_TOPI); }   __device__ __forceinline__ float* TOPW() const { return (float*)(ws + WS_ROUTE + RT_TOPW); }
    __device__ __forceinline__ int* POS() const { return (int*)(ws + WS_ROUTE + RT_POS); }     __device__ __forceinline__ int* LISTE() const { return (int*)(ws + WS_ROUTE + RT_LISTE); }
};
__device__ __forceinline__ void frame_init(Frame& F, const Params& p, unsigned char* lds) {
    F.lds = (LAS unsigned char*)lds; F.tid = threadIdx.x; F.lane = F.tid & 63; F.wave = __builtin_amdgcn_readfirstlane(F.tid >> 6);
    F.G = gridDim.x; F.bid = blockIdx.x; { const int bx = blockIdx.x; F.vcu = (F.G % 8 == 0) ? (bx % 8) * (F.G / 8) + bx / 8 : bx; }
    F.ws = p.ws;
    if (F.tid == 0) { LAS unsigned long long* tab = (LAS unsigned long long*)(F.lds + PTR_OFF);
#pragma unroll
        for (int i = 0; i < 22; ++i) tab[i] = (unsigned long long)p.in[i];
        tab[22] = (unsigned long long)p.out; }
    __syncthreads();
}

__device__ __forceinline__ Frame relaunder(const Frame& F) { Frame R = F; int ln; asm volatile("v_mbcnt_lo_u32_b32 %0, -1, 0\n\tv_mbcnt_hi_u32_b32 %0, -1, %0" : "=v"(ln));
    R.lane = ln; R.tid = F.wave * 64 + ln; unsigned wlo = (unsigned)(unsigned long long)F.ws, whi = (unsigned)((unsigned long long)F.ws >> 32);
    asm volatile("" : "+s"(wlo), "+s"(whi)); R.ws = (unsigned char*)(((unsigned long long)whi << 32) | wlo);
    int sw = F.wave, sv = F.vcu, sg = F.G, sb = F.bid;
    asm volatile("" : "+s"(sw), "+s"(sv), "+s"(sg), "+s"(sb));
    R.wave = sw; R.vcu = sv; R.G = sg; R.bid = sb; R.tid = sw * 64 + ln; return R; }

struct DenseOrder {
    int nM, nN, nwg, G, c, Kb, pm0; const char* Bt;
    __device__ void init(int nM_, int nN_, int G_, int c_, int Kb_, const bf16_t* Bt_, int pm0_ = 0) { nM = nM_; nN = nN_; nwg = nM * nN; G = G_; c = c_; Kb = Kb_; Bt = (const char*)Bt_; pm0 = pm0_; }
    __device__ __forceinline__ bool next(int i, pg8::Unit& u) const {
        const long L = (long)i * G + c; if (L >= nwg) return false;
        int wgid = (int)L; { const int q = nwg / pg8::NXCD, r = nwg % pg8::NXCD, xcd = wgid % pg8::NXCD, off = wgid / pg8::NXCD; wgid = (xcd < r ? xcd * (q + 1) : r * (q + 1) + (xcd - r) * q) + off; }
        const int nig = pg8::WGM * nN, gid = wgid / nig, fm = gid * pg8::WGM, gsz = (nM - fm) < pg8::WGM ? (nM - fm) : pg8::WGM;
        u.pm = pm0 + fm + ((wgid % nig) % gsz); u.pn = (wgid % nig) / gsz; u.e = 0; u.ui = i; return true;
    }
    __device__ __forceinline__ const char* b_tile(const pg8::Unit& u) const { return Bt + (size_t)u.pn * 256 * Kb; }
    __device__ __forceinline__ unsigned a_row_off(const pg8::Unit& u, int r) const { return (unsigned)(u.pm * 256 + r) * (unsigned)Kb; }
};
template <bool GATHER> struct MoeOrder {
    const LAS int* tinfo; const LAS unsigned* rowoff; int ntiles, nN, G, c, Kb; const char* W; size_t wstride;
    __device__ __forceinline__ bool next(int i, pg8::Unit& u) const {
        const int L = i * G + c; if (L >= ntiles * nN) return false;
        u.pm = L / nN; u.pn = L % nN; u.e = __builtin_amdgcn_readfirstlane(tinfo[4 * u.pm]); u.ui = i; return true;
    }
    __device__ __forceinline__ const char* b_tile(const pg8::Unit& u) const { return W + (size_t)u.e * wstride + (size_t)u.pn * 256 * Kb; }
    __device__ __forceinline__ unsigned a_row_off(const pg8::Unit& u, int r) const { if constexpr (GATHER) return rowoff[u.ui * 256 + r]; else return (unsigned)(u.pm * 256 + r) * (unsigned)Kb; }
};

__device__ __forceinline__ unsigned pk_f16(float a, float b) { const _Float16 x = (_Float16)a, y = (_Float16)b; return (unsigned)__builtin_bit_cast(unsigned short, x) | ((unsigned)__builtin_bit_cast(unsigned short, y) << 16); }
__device__ __forceinline__ float f16lo(unsigned w) { return (float)__builtin_bit_cast(_Float16, (unsigned short)(w & 0xffffu)); }
__device__ __forceinline__ float f16hi(unsigned w) { return (float)__builtin_bit_cast(_Float16, (unsigned short)(w >> 16)); }
struct EpiP {
    static constexpr bool PERM = true; bf16_t* O; int ldc; const float* lb;
    __device__ __forceinline__ void operator()(const f32x4 (&acc)[2][2][4][2], const pg8::Unit& u, int wr, int wc, int fr, int fq) const {
        const int row0 = u.pm * 256 + wr * 64 + fr, col0 = u.pn * 256 + wc * 32 + 8 * fq;
        const int mode = u.pn < 2 ? 1 : (u.pn < 6 ? 2 : ((u.pn == 8 || u.pn == 9) ? 3 : 0));
        f32x4 lbv[2][2];
        if (mode == 2) {
#pragma unroll
            for (int bj = 0; bj < 2; ++bj)
#pragma unroll
                for (int n = 0; n < 2; ++n) lbv[bj][n] = *(const f32x4*)(lb + (col0 - 512) + bj * 128 + 4 * n); }
#pragma unroll
        for (int ai = 0; ai < 2; ++ai)
#pragma unroll
            for (int m = 0; m < 4; ++m) { bf16_t* rowp = O + (size_t)(row0 + ai * 128 + m * 16) * ldc + col0;
#pragma unroll
                for (int bj = 0; bj < 2; ++bj) { f32x2 v[4]; { const f32x4 v0 = acc[ai][bj][m][0], v1 = acc[ai][bj][m][1]; v[0] = (f32x2){v0[0], v0[1]}; v[1] = (f32x2){v0[2], v0[3]}; v[2] = (f32x2){v1[0], v1[1]}; v[3] = (f32x2){v1[2], v1[3]}; }
                    u32x4 w;
                    if (mode != 0) {
                        f32x2 sg[4];
#pragma unroll
                        for (int p = 0; p < 4; ++p) { const f32x2 ex = v[p] * (-1.44269504f); f32x2 d; d.x = __builtin_amdgcn_exp2f(ex.x); d.y = __builtin_amdgcn_exp2f(ex.y); d = d + 1.0f; sg[p].x = __builtin_amdgcn_rcpf(d.x); sg[p].y = __builtin_amdgcn_rcpf(d.y); }
                        if (mode == 2) {
#pragma unroll
                            for (int p = 0; p < 4; ++p) { const f32x4 lv = lbv[bj][p >> 1]; const f32x2 lb2 = (f32x2){lv[2 * (p & 1)], lv[2 * (p & 1) + 1]}; const f32x2 f = lb2 + (1.0f - lb2) * sg[p];
                                v[p].x = __builtin_amdgcn_logf(fmaxf(f.x, 1e-30f)); v[p].y = __builtin_amdgcn_logf(fmaxf(f.y, 1e-30f)); }
                            w.x = pk_f16(v[0].x, v[0].y); w.y = pk_f16(v[1].x, v[1].y); w.z = pk_f16(v[2].x, v[2].y); w.w = pk_f16(v[3].x, v[3].y);
                        } else {
#pragma unroll
                            for (int p = 0; p < 4; ++p) v[p] = mode == 1 ? v[p] * sg[p] : sg[p];
                            w.x = cvt_pk_bf16(v[0].x, v[0].y); w.y = cvt_pk_bf16(v[1].x, v[1].y); w.z = cvt_pk_bf16(v[2].x, v[2].y); w.w = cvt_pk_bf16(v[3].x, v[3].y); }
                    } else { w.x = cvt_pk_bf16(v[0].x, v[0].y); w.y = cvt_pk_bf16(v[1].x, v[1].y); w.z = cvt_pk_bf16(v[2].x, v[2].y); w.w = cvt_pk_bf16(v[3].x, v[3].y); }
                    *(u32x4*)(rowp + bj * 128) = w; } }
    }
};
struct EpiRes {
    static constexpr bool PERM = false; const float* base_ctx; const float* base_lat; const float* gate_ctx; const float* gate_lat; float* Xo;
    __device__ __forceinline__ void operator()(const f32x4 (&acc)[2][2][4][2], const pg8::Unit& u, int wr, int wc, int fr, int fq) const {
        const int rt = wr * 64 + fr, col0 = u.pn * 256 + wc * 32 + 4 * fq;
        const float* base = (u.pm == 0 ? base_ctx : base_lat + (size_t)(u.pm - 1) * 256 * D) + (size_t)rt * D + col0; const float* gate = (u.pm == 0 ? gate_ctx : gate_lat) + col0;
        float* op = Xo + (size_t)(u.pm * 256 + rt) * D + col0;
#pragma unroll
        for (int bj = 0; bj < 2; ++bj)
#pragma unroll
            for (int n = 0; n < 2; ++n) { const f32x4 gv = *(const f32x4*)(gate + bj * 128 + n * 16);
#pragma unroll
                for (int ai = 0; ai < 2; ++ai) {
#pragma unroll
                    for (int m = 0; m < 4; ++m) { const size_t o = (size_t)(ai * 128 + m * 16) * D + bj * 128 + n * 16; const f32x4 b = *(const f32x4*)(base + o); *(f32x4*)(op + o) = b + gv * acc[ai][bj][m][n]; }
                    asm volatile("" ::: "memory"); } }
    }
};
struct EpiAct {
    static constexpr bool PERM = true; bf16_t* ACTo; const float* bias;
    __device__ __forceinline__ void operator()(const f32x4 (&acc)[2][2][4][2], const pg8::Unit& u, int wr, int wc, int fr, int fq) const {
        const int x0 = wc * 32 + 8 * fq; const float* bg = bias + (size_t)u.e * 2048 + 128 * u.pn + x0; const float* bu = bg + 1024;
        const f32x4 g0 = *(const f32x4*)bg, g1 = *(const f32x4*)(bg + 4), u0 = *(const f32x4*)bu, u1 = *(const f32x4*)(bu + 4);
#pragma unroll
        for (int ai = 0; ai < 2; ++ai)
#pragma unroll
            for (int m = 0; m < 4; ++m) { const int row = u.pm * 256 + ai * 128 + wr * 64 + m * 16 + fr;
                const f32x4 ga = acc[ai][0][m][0] + g0, gb = acc[ai][0][m][1] + g1, ua = acc[ai][1][m][0] + u0, ub = acc[ai][1][m][1] + u1; float r[8];
#pragma unroll
                for (int j = 0; j < 4; ++j) { const float g = fminf(ga[j], 7.f), up = fminf(fmaxf(ua[j], -7.f), 7.f); r[j] = (up + 1.f) * (g * fsigm(1.702f * g));
                                              const float g2 = fminf(gb[j], 7.f), up2 = fminf(fmaxf(ub[j], -7.f), 7.f); r[4 + j] = (up2 + 1.f) * (g2 * fsigm(1.702f * g2)); }
                u32x4 w; w.x = cvt_pk_bf16(r[0], r[1]); w.y = cvt_pk_bf16(r[2], r[3]); w.z = cvt_pk_bf16(r[4], r[5]); w.w = cvt_pk_bf16(r[6], r[7]);
                *(u32x4*)(ACTo + (size_t)row * D + 128 * u.pn + x0) = w; }
    }
};
struct EpiY {
    static constexpr bool PERM = true; bf16_t* Yo; const float* bias;
    __device__ __forceinline__ void operator()(const f32x4 (&acc)[2][2][4][2], const pg8::Unit& u, int wr, int wc, int fr, int fq) const {
        const int row0 = u.pm * 256 + wr * 64 + fr, col0 = u.pn * 256 + wc * 32 + 8 * fq; const float* bp = bias + (size_t)u.e * D + col0;
        f32x4 bv[2][2];
#pragma unroll
        for (int bj = 0; bj < 2; ++bj)
#pragma unroll
            for (int n = 0; n < 2; ++n) bv[bj][n] = *(const f32x4*)(bp + bj * 128 + 4 * n);
#pragma unroll
        for (int ai = 0; ai < 2; ++ai)
#pragma unroll
            for (int m = 0; m < 4; ++m) { bf16_t* rowp = Yo + (size_t)(row0 + ai * 128 + m * 16) * D + col0;
#pragma unroll
                for (int bj = 0; bj < 2; ++bj) { const f32x4 v0 = acc[ai][bj][m][0] + bv[bj][0], v1 = acc[ai][bj][m][1] + bv[bj][1];
                    u32x4 w; w.x = cvt_pk_bf16(v0[0], v0[1]); w.y = cvt_pk_bf16(v0[2], v0[3]); w.z = cvt_pk_bf16(v1[0], v1[1]); w.w = cvt_pk_bf16(v1[2], v1[3]);
                    *(u32x4*)(rowp + bj * 128) = w; } }
    }
};

__device__ __forceinline__ unsigned pk4_fp8(float a, float b, float c, float d) { int r = __builtin_amdgcn_cvt_pk_fp8_f32(a, b, 0, false); r = __builtin_amdgcn_cvt_pk_fp8_f32(c, d, r, true); return (unsigned)r; }
struct EpiAct8 {
    static constexpr bool PERM = true; unsigned char* ACTo; const float* bias;
    __device__ __forceinline__ void operator()(const f32x4 (&acc)[2][2][4][2], const pg8::Unit& u, int wr, int wc, int fr, int fq) const {
        const int x0 = wc * 32 + 8 * fq; const float* bg = bias + (size_t)u.e * 2048 + 128 * u.pn + x0; const float* bu = bg + 1024; constexpr float isc = 1.f / (FP8_SH * FP8_SW);
        f32x2 g[4], v[4];
#pragma unroll
        for (int p = 0; p < 4; ++p) { g[p] = *(const f32x2*)(bg + 2 * p); v[p] = *(const f32x2*)(bu + 2 * p); }
#pragma unroll
        for (int ai = 0; ai < 2; ++ai)
#pragma unroll
            for (int m = 0; m < 4; ++m) { const int row = u.pm * 256 + ai * 128 + wr * 64 + m * 16 + fr; f32x2 r[4];
#pragma unroll
                for (int p = 0; p < 4; ++p) { const f32x4 ga4 = acc[ai][0][m][p >> 1], ua4 = acc[ai][1][m][p >> 1];
                    f32x2 gg = (f32x2){ga4[2 * (p & 1)], ga4[2 * (p & 1) + 1]} * isc + g[p], uu = (f32x2){ua4[2 * (p & 1)], ua4[2 * (p & 1) + 1]} * isc + v[p];
                    gg.x = fminf(gg.x, 7.f); gg.y = fminf(gg.y, 7.f); uu.x = __builtin_amdgcn_fmed3f(uu.x, -7.f, 7.f); uu.y = __builtin_amdgcn_fmed3f(uu.y, -7.f, 7.f);
                    const f32x2 ex = gg * (-1.702f * 1.44269504f); f32x2 d; d.x = __builtin_amdgcn_exp2f(ex.x); d.y = __builtin_amdgcn_exp2f(ex.y); d = d + 1.0f;
                    f32x2 rc; rc.x = __builtin_amdgcn_rcpf(d.x); rc.y = __builtin_amdgcn_rcpf(d.y);
                    r[p] = (uu * FP8_SA + FP8_SA) * (gg * rc); }
                u32x2 w; w.x = pk4_fp8(r[0].x, r[0].y, r[1].x, r[1].y); w.y = pk4_fp8(r[2].x, r[2].y, r[3].x, r[3].y);
                *(u32x2*)(ACTo + (size_t)row * D + 128 * u.pn + x0) = w; }
    }
};
struct EpiY8 {
    static constexpr bool PERM = true; bf16_t* Yo; const float* bias;
    __device__ __forceinline__ void operator()(const f32x4 (&acc)[2][2][4][2], const pg8::Unit& u, int wr, int wc, int fr, int fq) const {
        const int row0 = u.pm * 256 + wr * 64 + fr, col0 = u.pn * 256 + wc * 32 + 8 * fq; const float* bp = bias + (size_t)u.e * D + col0; constexpr float isc = 1.f / (FP8_SA * FP8_SW);
        f32x4 bv[2][2];
#pragma unroll
        for (int bj = 0; bj < 2; ++bj)
#pragma unroll
            for (int n = 0; n < 2; ++n) bv[bj][n] = *(const f32x4*)(bp + bj * 128 + 4 * n);
#pragma unroll
        for (int ai = 0; ai < 2; ++ai)
#pragma unroll
            for (int m = 0; m < 4; ++m) { bf16_t* rowp = Yo + (size_t)(row0 + ai * 128 + m * 16) * D + col0;
#pragma unroll
                for (int bj = 0; bj < 2; ++bj) { const f32x4 v0 = acc[ai][bj][m][0] * isc + bv[bj][0], v1 = acc[ai][bj][m][1] * isc + bv[bj][1];
                    u32x4 w; w.x = cvt_pk_bf16(v0[0], v0[1]); w.y = cvt_pk_bf16(v0[2], v0[3]); w.z = cvt_pk_bf16(v1[0], v1[1]); w.w = cvt_pk_bf16(v1[2], v1[3]);
                    *(u32x4*)(rowp + bj * 128) = w; } }
    }
};

struct CvtJob { const float* W; bf16_t* WT; int N, K, k0, n0, nrow0; };
__device__ __forceinline__ void cvt_load(const CvtJob& j, int lane, f32x4 (&r)[16]) { const GAS f32x4* src = (const GAS f32x4*)((const GAS float*)j.W + (unsigned)((j.k0 + 8 * (lane >> 3)) * j.N + j.n0 + 8 * (lane & 7)));
    const unsigned rs = (unsigned)j.N >> 2;
#pragma unroll
    for (int i = 0; i < 8; ++i) { r[2 * i] = src[i * rs]; r[2 * i + 1] = src[i * rs + 1]; } }
__device__ __forceinline__ void cvt_store(const CvtJob& j, int lane, const f32x4 (&r)[16]) {
    u32x4 b[8];
#pragma unroll
    for (int i = 0; i < 8; ++i) { b[i].x = cvt_pk_bf16(r[2 * i][0], r[2 * i][1]); b[i].y = cvt_pk_bf16(r[2 * i][2], r[2 * i][3]); b[i].z = cvt_pk_bf16(r[2 * i + 1][0], r[2 * i + 1][1]); b[i].w = cvt_pk_bf16(r[2 * i + 1][2], r[2 * i + 1][3]); }
    GAS u32x4* dst = (GAS u32x4*)((GAS bf16_t*)j.WT + (unsigned)((j.nrow0 + 8 * (lane & 7)) * j.K + j.k0 + 8 * (lane >> 3))); const unsigned rs = (unsigned)j.K >> 3;
#pragma unroll
    for (int q = 0; q < 8; ++q) { const unsigned sel = (q & 1) ? 0x07060302u : 0x05040100u; u32x4 o;
        o.x = __builtin_amdgcn_perm(b[1][q >> 1], b[0][q >> 1], sel); o.y = __builtin_amdgcn_perm(b[3][q >> 1], b[2][q >> 1], sel);
        o.z = __builtin_amdgcn_perm(b[5][q >> 1], b[4][q >> 1], sel); o.w = __builtin_amdgcn_perm(b[7][q >> 1], b[6][q >> 1], sel);
        dst[q * rs] = o; } }
__device__ __forceinline__ void cvt8_load(const CvtJob& j, int lane, f32x4 (&r)[16]) { const GAS f32x4* src = (const GAS f32x4*)((const GAS float*)j.W + (unsigned)((j.k0 + 16 * (lane >> 3)) * j.N + j.n0 + 4 * (lane & 7)));
    const unsigned rs = (unsigned)j.N >> 2;
#pragma unroll
    for (int i = 0; i < 16; ++i) r[i] = src[i * rs]; }
__device__ __forceinline__ void cvt8_store(const CvtJob& j, int lane, const f32x4 (&r)[16]) {
    GAS u32x4* dst = (GAS u32x4*)((GAS unsigned char*)j.WT + (unsigned)((j.nrow0 + 4 * (lane & 7)) * j.K + j.k0 + 16 * (lane >> 3))); const unsigned rs = (unsigned)j.K >> 4;
#pragma unroll
    for (int n = 0; n < 4; ++n) { u32x4 o;
        o.x = pk4_fp8(r[0][n] * FP8_SW, r[1][n] * FP8_SW, r[2][n] * FP8_SW, r[3][n] * FP8_SW); o.y = pk4_fp8(r[4][n] * FP8_SW, r[5][n] * FP8_SW, r[6][n] * FP8_SW, r[7][n] * FP8_SW);
        o.z = pk4_fp8(r[8][n] * FP8_SW, r[9][n] * FP8_SW, r[10][n] * FP8_SW, r[11][n] * FP8_SW); o.w = pk4_fp8(r[12][n] * FP8_SW, r[13][n] * FP8_SW, r[14][n] * FP8_SW, r[15][n] * FP8_SW);
        dst[n * rs] = o; } }
constexpr int NB_IN = (FQ_OFF < DIN ? FQ_OFF : DIN) / 64, I_IN = 16 * NB_IN, I_OUT = 16 * 16, I_GU = MOE_FP8 ? 8 * 64 : 16 * 32, I_DN = MOE_FP8 ? 8 * 32 : 16 * 16;
constexpr int N_IN = 2 * I_IN, N_OUT = 2 * I_OUT, N_GU = 2 * NE * I_GU, N_DN = 2 * NE * I_DN, N_CVT = N_IN + N_OUT + N_GU + N_DN;
__device__ __forceinline__ CvtJob cvt_job(const Frame& F, int it, bool& f8) {
    CvtJob j; int r = it; f8 = false;
    if (r < N_IN) { const int l = r / I_IN, q = r % I_IN, kb = q / NB_IN, nb = q % NB_IN; j = CvtJob{F.w_in() + (size_t)l * D * DIN, F.Wt_in() + (size_t)l * DINX * D, DIN, D, 64 * kb, 64 * nb, 64 * nb}; return j; } r -= N_IN;
    if (r < N_OUT) { const int l = r / I_OUT, q = r % I_OUT, kb = q >> 4, nb = q & 15; j = CvtJob{F.w_out() + (size_t)l * D * D, F.Wt_out() + (size_t)l * D * D, D, D, 64 * kb, 64 * nb, 64 * nb}; return j; } r -= N_OUT;
    f8 = MOE_FP8;
    if (r < N_GU) { const int le = r / I_GU, q = r % I_GU; const int kb = MOE_FP8 ? q >> 6 : q >> 5, nb = MOE_FP8 ? q & 63 : q & 31; const int n0 = (MOE_FP8 ? 32 : 64) * nb, bj = n0 >> 10, xx = n0 & 1023;
        j = CvtJob{F.w_gu() + (size_t)le * D * 2048, (bf16_t*)((unsigned char*)F.Wt_gu() + (size_t)le * 2048 * D * (MOE_FP8 ? 1 : 2)), 2048, D, (MOE_FP8 ? 128 : 64) * kb, n0, 256 * (xx >> 7) + 128 * bj + (xx & 127)}; return j; } r -= N_GU;
    { const int le = r / I_DN, q = r % I_DN; const int kb = MOE_FP8 ? q >> 5 : q >> 4, nb = MOE_FP8 ? q & 31 : q & 15; const int n0 = (MOE_FP8 ? 32 : 64) * nb;
      j = CvtJob{F.w_dn() + (size_t)le * D * D, (bf16_t*)((unsigned char*)F.Wt_dn() + (size_t)le * D * D * (MOE_FP8 ? 1 : 2)), D, D, (MOE_FP8 ? 128 : 64) * kb, n0, n0}; return j; }
}
__device__ __forceinline__ void cvt_ld(const CvtJob& j, bool f8, int lane, f32x4 (&r)[16]) { if (f8) cvt8_load(j, lane, r); else cvt_load(j, lane, r); }
__device__ __forceinline__ void cvt_st(const CvtJob& j, bool f8, int lane, const f32x4 (&r)[16]) { if (f8) cvt8_store(j, lane, r); else cvt_store(j, lane, r); }
constexpr int WIN_UNITS = (T / 256) * (DINX / 256), WIN_BUSY = WIN_UNITS % 256, DEF_WIN = MOE_FP8 ? 3 : 0, DEF_WOUT = MOE_FP8 ? 3 : 0;
constexpr int DEF_A = (256 - WIN_BUSY) * NWAVES * DEF_WIN, DEF_B = (256 - 4) * NWAVES * DEF_WOUT, DEF_C = DEF_A, DEF_TOTAL = DEF_A + DEF_B + DEF_C;
constexpr int CVT_GU0 = N_IN + N_OUT, CVT_GU1 = CVT_GU0 + NE * I_GU;
static_assert(DEF_A + DEF_B <= NE * I_GU && DEF_C <= NE * I_GU, "deferred slices inside one layer's gate/up items");
__device__ __forceinline__ int cvt_remap(int j) { int it = j; if (it >= CVT_GU0) it += DEF_A + DEF_B; if (it >= CVT_GU1) it += DEF_C; return it; }
__device__ __forceinline__ void cvt_run(Frame& F, int first, int stride, int limit, bool remap) {
    int it = first; if (it >= limit) return;
    f32x4 ra[16], rb[16]; bool fa, fb = false; CvtJob ja = cvt_job(F, remap ? cvt_remap(it) : it, fa), jb; cvt_ld(ja, fa, F.lane, ra);
    for (;;) {
        const int itb = it + stride; const bool hb = itb < limit; if (hb) { jb = cvt_job(F, remap ? cvt_remap(itb) : itb, fb); cvt_ld(jb, fb, F.lane, rb); }
        cvt_st(ja, fa, F.lane, ra); if (!hb) break;
        const int ita = itb + stride; const bool ha = ita < limit; if (ha) { ja = cvt_job(F, remap ? cvt_remap(ita) : ita, fa); cvt_ld(ja, fa, F.lane, ra); }
        cvt_st(jb, fb, F.lane, rb); if (!ha) break;
        it = ita;
    }
}
__device__ __forceinline__ void cvt_deferred(Frame& F, int base, int slot, int per_wave) { if (per_wave == 0) return; const int first = base + (slot * NWAVES + F.wave) * per_wave; cvt_run(F, first, 1, first + per_wave, false); }
__device__ __forceinline__ void ph_prologue(Frame& F) {
    const int gw = F.vcu * NWAVES + F.wave, NGW = F.G * NWAVES;
    for (int i = gw * 64 + F.lane; i < 1024; i += NGW * 64) { const float a = F.lbp()[i], b = F.lbp()[1024 + i], m = fmaxf(a, b), ea = __expf(a - m), eb = __expf(b - m); F.LB()[i] = 0.f; F.LB()[1024 + i] = eb / (ea + eb); }
    if (F.bid < 192) {
        LAS float* sc = (LAS float*)(F.lds); LAS float* part = sc + 2048;
        { const float* c = F.c(); const float* cc = F.cctx(); for (int i = F.tid; i < D; i += NTHR) { const float a = c[i], b = cc[i]; sc[i] = a * fsigm(a); sc[D + i] = b * fsigm(b); } }
        __syncthreads();
        const int l = F.bid / 96, jcol = (F.bid % 96) * 64 + F.lane; const GAS float* W = (const GAS float*)F.w_ada() + (unsigned)(l * D * 6144 + (128 * F.wave) * 6144 + jcol); float a0 = 0.f, a1 = 0.f;
#pragma unroll 16
        for (int i = 0; i < 128; ++i) { const float w = W[(unsigned)i * 6144u]; a0 += sc[128 * F.wave + i] * w; a1 += sc[D + 128 * F.wave + i] * w; }
        part[(F.wave * 2 + 0) * 64 + F.lane] = a0; part[(F.wave * 2 + 1) * 64 + F.lane] = a1;
        __syncthreads();
        if (F.tid < 128) { const int which = F.tid >> 6, col = F.tid & 63; float s = 0.f;
#pragma unroll
            for (int w = 0; w < 8; ++w) s += part[(w * 2 + which) * 64 + col];
            const int j = (F.bid % 96) * 64 + col; F.MOD()[(size_t)(l * 2 + which) * 6144 + j] = s + F.b_ada()[l * 6144 + j]; }
        __syncthreads();
    }
    cvt_run(F, gw, NGW, N_CVT - DEF_TOTAL, true);
}
__device__ __forceinline__ void row_load(const float* xrow, int lane, f32x4 (&v)[4]) { const GAS f32x4* xr = (const GAS f32x4*)xrow + lane;
#pragma unroll
    for (int j = 0; j < 4; ++j) v[j] = xr[64 * j]; }
__device__ __forceinline__ float row_rstd(const f32x4 (&v)[4], int lane) { float s = 0.f;
#pragma unroll
    for (int j = 0; j < 4; ++j) s += (v[j].x * v[j].x + v[j].y * v[j].y) + (v[j].z * v[j].z + v[j].w * v[j].w);
    return rsqrtf(wave_sum(s, lane) * (1.f / D) + 1e-6f); }
__device__ __forceinline__ void row_modulate(const f32x4 (&v)[4], float r, const float* g, const float* sc, const float* sh, int lane, f32x4 (&hv)[4]) {
#pragma unroll
    for (int j = 0; j < 4; ++j) { const f32x4 gg = ((const GAS f32x4*)g)[lane + 64 * j], s1 = ((const GAS f32x4*)sc)[lane + 64 * j], s0 = ((const GAS f32x4*)sh)[lane + 64 * j];
        hv[j] = v[j] * r * gg * (s1 + 1.f) + s0; } }
__device__ __forceinline__ void row_store_fp8(unsigned char* orow, int lane, const f32x4 (&hv)[4]) { GAS unsigned* o4 = (GAS unsigned*)orow + lane;
#pragma unroll
    for (int j = 0; j < 4; ++j) o4[64 * j] = pk4_fp8(hv[j].x * FP8_SH, hv[j].y * FP8_SH, hv[j].z * FP8_SH, hv[j].w * FP8_SH); }
__device__ __forceinline__ void row_store_bf16(bf16_t* orow, int lane, const f32x4 (&hv)[4]) { GAS u32x2* o8 = (GAS u32x2*)orow + lane;
#pragma unroll
    for (int j = 0; j < 4; ++j) { u32x2 w; w.x = pk2(hv[j].x, hv[j].y); w.y = pk2(hv[j].z, hv[j].w); o8[64 * j] = w; } }

__device__ __forceinline__ void ph_mod1(Frame& F, int l) {
    const int gw = F.vcu * NWAVES + F.wave, NGW = F.G * NWAVES;
    for (int row = gw; row < T; row += NGW) {
        const float* xr = l == 0 ? (row < CTX ? F.ctxin() + (size_t)row * D : F.x() + (size_t)(row - CTX) * D) : F.X() + (size_t)row * D;
        const float* m = F.MOD() + (size_t)(l * 2 + (row < CTX ? 1 : 0)) * 6144;
        f32x4 v[4], hv[4]; row_load(xr, F.lane, v); const float r = row_rstd(v, F.lane); row_modulate(v, r, F.norm1_g() + l * D, m + D, m, F.lane, hv); row_store_bf16(F.H() + (size_t)row * D, F.lane, hv);
    }
}

constexpr int RW_STRIDE = 1028, RSCR_OFF = 32 * RW_STRIDE * 4;
static_assert(RSCR_OFF + 4096 <= MISC_OFF, "router LDS map");
__device__ __forceinline__ void route_top4(float (&part)[16], float bias, int lane, float (&vals)[4], int (&idx)[4]) {
#pragma unroll
    for (int st = 1; st < 5; ++st) { const int M = 32 >> st, n = 16 >> st; const bool up = (lane & M) != 0;
#pragma unroll
        for (int i = 0; i < n; ++i) { float x = part[i], y = part[i + n]; asm volatile("" : "+v"(x), "+v"(y));
            const float keep = up ? y : x, send = up ? x : y; part[i] = keep + lane_xor(send, M, lane); } }
    const float lg = part[0] + lane_xor(part[0], 1, lane) + bias;
    const int e = (lane >> 1) & 31; unsigned u = __builtin_bit_cast(unsigned, lg); u = (u & 0x80000000u) ? ~u : (u | 0x80000000u); unsigned key = (u & ~31u) | (unsigned)(31 - e);
#pragma unroll
    for (int s = 0; s < 4; ++s) { unsigned m = key;
#pragma unroll
        for (int d = 2; d < 64; d <<= 1) { const unsigned o = (unsigned)__builtin_amdgcn_ds_bpermute((lane ^ d) << 2, (int)m); m = o > m ? o : m; }
        const int bi = 31 - (int)(m & 31u); const unsigned vb = m & ~31u, ub = (vb & 0x80000000u) ? (vb & 0x7fffffffu) : ~vb;
        idx[s] = bi; vals[s] = __builtin_bit_cast(float, ub); key = (e == bi) ? 0u : key; }
}
__device__ __forceinline__ void ph_mod2_route(Frame& F, int l, int cbank) {
    LAS float* rwT = (LAS float*)(F.lds + RING_OFF);
    LAS int* lcnt = (LAS int*)(F.lds + RSCR_OFF); LAS int* lbase = lcnt + 32; LAS int* te = lbase + 32; LAS float* tw = (LAS float*)(te + 272); LAS int* trk = (LAS int*)(tw + 272);
    const GAS float* rw = (const GAS float*)F.router_w() + (unsigned)(l * D * NE);
    __syncthreads();
    for (int i = F.tid; i < 256 * 32; i += NTHR) { const int e = i & 31, k4 = i >> 5; f32x4 v; v[0] = rw[(4 * k4 + 0) * NE + e]; v[1] = rw[(4 * k4 + 1) * NE + e]; v[2] = rw[(4 * k4 + 2) * NE + e]; v[3] = rw[(4 * k4 + 3) * NE + e];
        *(LAS f32x4*)(rwT + e * RW_STRIDE + 4 * k4) = v; }
    if (F.tid < 32) lcnt[F.tid] = 0;
    __syncthreads();
    const int row0 = F.bid * 65;
    const float bias = F.router_b()[l * NE + ((F.lane >> 1) & 31)];
    const float* Xp = F.X(); const float* n2g = F.norm2_g() + l * D; const float* modl = F.MOD() + (size_t)(l * 2) * 6144; bf16_t* Hp = F.H(); unsigned char* H8p = F.ws + WS_H8;
#pragma unroll 1
    for (int pi = F.wave; pi < 33; pi += NWAVES) {
        const int ria = 2 * pi, rib = min(2 * pi + 1, 64); const bool hasb = 2 * pi + 1 < 65; const int ra = row0 + ria, rb = row0 + rib;
        int ln = F.lane; asm volatile("" : "+v"(ln));
        f32x4 va[4], vb[4]; row_load(Xp + (size_t)ra * D, ln, va); row_load(Xp + (size_t)rb * D, ln, vb);
        f32x4 ha[4], hb[4];
        { const float* m = modl + (ra < CTX ? 6144 : 0); const float r = row_rstd(va, ln); row_modulate(va, r, n2g, m + 4 * D, m + 3 * D, ln, ha); if (MOE_FP8) row_store_fp8(H8p + (size_t)ra * D, ln, ha); else row_store_bf16(Hp + (size_t)ra * D, ln, ha); }
        { const float* m = modl + (rb < CTX ? 6144 : 0); const float r = row_rstd(vb, ln); row_modulate(vb, r, n2g, m + 4 * D, m + 3 * D, ln, hb); if (hasb) { if (MOE_FP8) row_store_fp8(H8p + (size_t)rb * D, ln, hb); else row_store_bf16(Hp + (size_t)rb * D, ln, hb); } }
        float pa[16], pb[16]; const bool up32 = (ln & 32) != 0;
#pragma unroll
        for (int i = 0; i < 16; ++i) { f32x4 A0 = (f32x4){0.f, 0.f, 0.f, 0.f}, B0 = A0, A1 = A0, B1 = A0;
#pragma unroll
            for (int j = 0; j < 4; ++j) { const f32x4 w0 = *(const LAS f32x4*)(rwT + i * RW_STRIDE + 4 * ln + 256 * j), w1 = *(const LAS f32x4*)(rwT + (i + 16) * RW_STRIDE + 4 * ln + 256 * j);
                A0 += ha[j] * w0; B0 += hb[j] * w0; A1 += ha[j] * w1; B1 += hb[j] * w1; }
            const float sa0 = (A0[0] + A0[1]) + (A0[2] + A0[3]), sb0 = (B0[0] + B0[1]) + (B0[2] + B0[3]), sa1 = (A1[0] + A1[1]) + (A1[2] + A1[3]), sb1 = (B1[0] + B1[1]) + (B1[2] + B1[3]);
            pa[i] = (up32 ? sa1 : sa0) + lane_xor(up32 ? sa0 : sa1, 32, ln); pb[i] = (up32 ? sb1 : sb0) + lane_xor(up32 ? sb0 : sb1, 32, ln);
            if (i & 1) __builtin_amdgcn_sched_barrier(0); }
        float vals[4]; int idx[4];
        route_top4(pa, bias, ln, vals, idx);
        if (ln == 0) { float ex[4], sum = 0.f;
#pragma unroll
            for (int s = 0; s < 4; ++s) { ex[s] = __expf(vals[s] - vals[0]); sum += ex[s]; }
            const float inv = 1.f / sum;
#pragma unroll
            for (int s = 0; s < 4; ++s) { te[ria * 4 + s] = idx[s]; tw[ria * 4 + s] = ex[s] * inv; trk[ria * 4 + s] = (int)__hip_atomic_fetch_add((LAS unsigned*)&lcnt[idx[s]], 1u, __ATOMIC_RELAXED, __HIP_MEMORY_SCOPE_WORKGROUP); } }
        route_top4(pb, bias, ln, vals, idx);
        if (ln == 0 && hasb) { float ex[4], sum = 0.f;
#pragma unroll
            for (int s = 0; s < 4; ++s) { ex[s] = __expf(vals[s] - vals[0]); sum += ex[s]; }
            const float inv = 1.f / sum;
#pragma unroll
            for (int s = 0; s < 4; ++s) { te[rib * 4 + s] = idx[s]; tw[rib * 4 + s] = ex[s] * inv; trk[rib * 4 + s] = (int)__hip_atomic_fetch_add((LAS unsigned*)&lcnt[idx[s]], 1u, __ATOMIC_RELAXED, __HIP_MEMORY_SCOPE_WORKGROUP); } }
    }
    __syncthreads();
    if (F.tid < 32) lbase[F.tid] = (int)__hip_atomic_fetch_add((unsigned*)(F.ctl() + CW_CNT + (cbank * 32 + F.tid) * 64), (unsigned)lcnt[F.tid], RLX_AGENT);
    __syncthreads();
    for (int i = F.tid; i < 65 * 4; i += NTHR) { const int row = row0 + (i >> 2), e = te[i], pos = lbase[e] + trk[i];
        F.TOPI()[row * 4 + (i & 3)] = e; F.TOPW()[row * 4 + (i & 3)] = tw[i]; F.POS()[row * 4 + (i & 3)] = pos; F.LISTE()[(size_t)e * T + pos] = row; }
    __syncthreads();
}

__device__ __forceinline__ int moe_tiles(Frame& F, int l) {
    LAS int* tinfo = (LAS int*)(F.lds + TINFO_OFF); LAS int* bt = (LAS int*)(F.lds + BT_OFF); LAS int* cn = bt + 32; LAS int* ntl = bt + 64;
    __syncthreads();
    if (F.tid < 64) {
        const int e = F.lane & 31; const int c = (int)__hip_atomic_load(F.ctl() + CW_CNT + (l * 32 + e) * 64, RLX_AGENT); const int nt = (c + 255) >> 8;
        int incl = nt;
#pragma unroll
        for (int o = 1; o < 32; o <<= 1) { const int t = lane_get(incl, (F.lane - o) & 63); if (e >= o) incl += t; }
        const int first = incl - nt;
        if (F.lane < 32) { bt[e] = first; cn[e] = c; for (int j = 0; j < nt; ++j) { LAS int* ti = tinfo + 4 * (first + j); ti[0] = e; ti[1] = 0; ti[2] = 256 * j; ti[3] = min(256, c - 256 * j); } if (e == 31) ntl[0] = incl; }
    }
    __syncthreads();
    return ntl[0];
}

__device__ __forceinline__ void ph_gateup(Frame& F, int l) {
    const int ntiles = moe_tiles(F, l); constexpr int EB = MOE_FP8 ? 1 : 2;
    LAS int* tinfo = (LAS int*)(F.lds + TINFO_OFF); LAS unsigned* rowoff = (LAS unsigned*)(F.lds + ROWOFF_OFF);
    MoeOrder<true> S; S.tinfo = tinfo; S.rowoff = rowoff; S.ntiles = ntiles; S.nN = 8; S.G = F.G; S.c = F.vcu; S.Kb = D * EB; S.W = (const char*)F.Wt_gu() + (size_t)l * NE * 2048 * D * EB; S.wstride = (size_t)2048 * D * EB;
    for (int i = 0;; ++i) { pg8::Unit u; if (!S.next(i, u) || i >= 10) break;
        if (F.tid < 256) { const int pos0 = tinfo[4 * u.pm + 2], valid = tinfo[4 * u.pm + 3]; const int tok = F.tid < valid ? F.LISTE()[(size_t)u.e * T + pos0 + F.tid] : 0; rowoff[i * 256 + F.tid] = (unsigned)tok * (unsigned)(D * EB); } }
    __syncthreads();
    if constexpr (MOE_FP8) { EpiAct8 E{(unsigned char*)F.ACT(), F.b_gu() + (size_t)l * NE * 2048};
        pg8::gemm_phase<EpiAct8, MoeOrder<true>, true, true>(F.lds + RING_OFF, (const char*)(F.ws + WS_H8), D, S, E, F.tid); }
    else { EpiAct E{F.ACT(), F.b_gu() + (size_t)l * NE * 2048};
        pg8::gemm_phase<EpiAct, MoeOrder<true>, true, false>(F.lds + RING_OFF, (const char*)F.H(), 2 * D, S, E, F.tid); }
}
__device__ __forceinline__ void ph_down(Frame& F, int l) {
    const int ntiles = moe_tiles(F, l); constexpr int EB = MOE_FP8 ? 1 : 2;
    MoeOrder<false> S; S.tinfo = (LAS int*)(F.lds + TINFO_OFF); S.rowoff = nullptr; S.ntiles = ntiles; S.nN = 4; S.G = F.G; S.c = F.vcu; S.Kb = D * EB; S.W = (const char*)F.Wt_dn() + (size_t)l * NE * D * D * EB; S.wstride = (size_t)D * D * EB;
    if constexpr (MOE_FP8) { EpiY8 E{F.Y(), F.b_dn() + (size_t)l * NE * D};
        pg8::gemm_phase<EpiY8, MoeOrder<false>, true, true>(F.lds + RING_OFF, (const char*)F.ACT(), D, S, E, F.tid); }
    else { EpiY E{F.Y(), F.b_dn() + (size_t)l * NE * D};
        pg8::gemm_phase<EpiY, MoeOrder<false>, true, false>(F.lds + RING_OFF, (const char*)F.ACT(), 2 * D, S, E, F.tid); }
}
__device__ __forceinline__ void ph_win(Frame& F, int l) {
    DenseOrder S; S.init(T / 256, DINX / 256, F.G, F.bid, 2 * D, F.Wt_in() + (size_t)l * DINX * D);
    EpiP E{F.P(), DINX, F.LB() + l * 1024};
    pg8::gemm_phase<EpiP, DenseOrder, true>(F.lds + RING_OFF, (const char*)F.H(), 2 * D, S, E, F.tid);
    if (F.bid >= WIN_BUSY) cvt_deferred(F, l == 0 ? CVT_GU0 : CVT_GU1, F.bid - WIN_BUSY, DEF_WIN);
}
__device__ __forceinline__ void ph_wout(Frame& F, int l) {
    DenseOrder S; S.init(l == 1 ? LAT / 256 : T / 256, D / 256, F.G, F.bid, 2 * D, F.Wt_out() + (size_t)l * D * D, l == 1 ? 1 : 0);
    const float* m = F.MOD() + (size_t)(l * 2) * 6144;
    EpiRes E{l == 0 ? F.ctxin() : F.X(), l == 0 ? F.x() : F.X() + (size_t)CTX * D, m + 6144 + 2 * D, m + 2 * D, F.X()};
    pg8::gemm_phase<EpiRes, DenseOrder, true>(F.lds + RING_OFF, (const char*)F.CAT(), 2 * D, S, E, F.tid);
    if (l == 0 && F.bid >= 4) cvt_deferred(F, CVT_GU0 + DEF_A, F.bid - 4, DEF_WOUT);
}
__device__ __forceinline__ void combine_gather(const Frame& F, const LAS int* bt, int row, int ln, f32x4 (&v)[4], u32x2 (&y)[4][4], float (&w)[4]) {
    row_load(F.X() + (size_t)row * D, ln, v);
    const GAS int* ti = (const GAS int*)F.TOPI() + (unsigned)(row * 4); const GAS float* tw = (const GAS float*)F.TOPW() + (unsigned)(row * 4); const GAS int* tp = (const GAS int*)F.POS() + (unsigned)(row * 4);
#pragma unroll
    for (int q = 0; q < 4; ++q) { const int e = ti[q]; w[q] = tw[q]; const int srow = 256 * bt[e] + tp[q]; const GAS u32x2* yr = (const GAS u32x2*)((const GAS bf16_t*)F.Y() + (unsigned)srow * (unsigned)D) + ln;
#pragma unroll
        for (int j = 0; j < 4; ++j) y[q][j] = yr[64 * j]; }
}
__device__ __forceinline__ void combine_finish(const Frame& F, int l, int row, int ln, f32x4 (&v)[4], const u32x2 (&y)[4][4], const float (&w)[4]) {
    const float* m = F.MOD() + (size_t)(l * 2 + (row < CTX ? 1 : 0)) * 6144 + 5 * D;
#pragma unroll
    for (int j = 0; j < 4; ++j) { f32x4 s = (f32x4){0.f, 0.f, 0.f, 0.f};
#pragma unroll
        for (int q = 0; q < 4; ++q) s += w[q] * (f32x4){bflo(y[q][j].x), bfhi(y[q][j].x), bflo(y[q][j].y), bfhi(y[q][j].y)};
        v[j] += ((const GAS f32x4*)m)[ln + 64 * j] * s; }
    const float r = row_rstd(v, ln);
    if (l == 0) {
        GAS f32x4* xo = (GAS f32x4*)(F.X() + (size_t)row * D) + ln;
#pragma unroll
        for (int j = 0; j < 4; ++j) xo[64 * j] = v[j];
        const float* m1 = F.MOD() + (size_t)(2 + (row < CTX ? 1 : 0)) * 6144; f32x4 hv[4];
        row_modulate(v, r, F.norm1_g() + D, m1 + D, m1, ln, hv); row_store_bf16(F.H() + (size_t)row * D, ln, hv);
    } else {
        GAS f32x4* o = (GAS f32x4*)(F.out() + (size_t)(row - CTX) * D) + ln; const float* fg = F.fng();
#pragma unroll
        for (int j = 0; j < 4; ++j) o[64 * j] = v[j] * r * ((const GAS f32x4*)fg)[ln + 64 * j];
    }
}
__device__ __forceinline__ void ph_combine(Frame& F, int l) {
    (void)moe_tiles(F, l);
    const LAS int* bt = (const LAS int*)(F.lds + BT_OFF);
    const int gw = F.vcu * NWAVES + F.wave, NGW = F.G * NWAVES; const int rbeg = l == 1 ? CTX : 0;
#pragma unroll 1
    for (int ra = rbeg + gw; ra < T; ra += 2 * NGW) {
        int ln = F.lane; asm volatile("" : "+v"(ln));
        const int rb = ra + NGW; const bool hasb = rb < T; const int rbc = hasb ? rb : ra;
        f32x4 va[4], vb[4]; u32x2 ya[4][4], yb[4][4]; float wa[4], wb[4];
        combine_gather(F, bt, ra, ln, va, ya, wa); combine_gather(F, bt, rbc, ln, vb, yb, wb);
        combine_finish(F, l, ra, ln, va, ya, wa);
        if (hasb) combine_finish(F, l, rb, ln, vb, yb, wb);
    }
}
constexpr size_t WF_MA = 0, WF_MB = 128 * 1024, WF_MC = 256 * 1024, WF_PW = 512 * 1024;
constexpr int ZS = 528;
__device__ __forceinline__ f32x4 mfma16(bf16x8 a, bf16x8 b, f32x4 c) { return __builtin_amdgcn_mfma_f32_16x16x32_bf16(a, b, c, 0, 0, 0); }

__device__ __forceinline__ void ph_prologue2(Frame& F) {
    bf16_t* MA = (bf16_t*)(F.ws + WS_WF + WF_MA); bf16_t* MB = (bf16_t*)(F.ws + WS_WF + WF_MB); bf16_t* MC = (bf16_t*)(F.ws + WS_WF + WF_MC); bf16_t* PW = (bf16_t*)(F.ws + WS_WF + WF_PW);
    const int gt = F.bid * NTHR + F.tid, NT = F.G * NTHR;
    for (int i = gt; i < 256 * 256; i += NT) { const int r = i >> 8, cidx = i & 255, ri = r >> 7, k1 = r & 127, rj = cidx >> 7, t1 = cidx & 127; const float x = 2.f * (float)((k1 * t1) & 127) / 128.f;
        const float cs = cospif(x), sn = sinpif(x); const float v = ri == 0 ? (rj == 0 ? cs : -sn) : (rj == 0 ? -sn : -cs); MA[i] = (bf16_t)f2bf(v); }
    for (int i = gt; i < 128 * 256; i += NT) { const int k2 = i >> 8, cidx = i & 255, rj = cidx >> 7, t2 = cidx & 127; const float x = 2.f * (float)((k2 * t2) & 127) / 128.f; MB[i] = (bf16_t)f2bf(rj == 0 ? cospif(x) : sinpif(x)); }
    for (int i = gt; i < 256 * 512; i += NT) { const int k = i >> 9, cidx = i & 511, rj = cidx >> 8, t = cidx & 255; const float x = 2.f * (float)((k * t) & 255) / 256.f; MC[i] = (bf16_t)f2bf(rj == 0 ? cospif(x) : -sinpif(x)); }
    for (int i = gt; i < 2 * 4 * 64 * 64; i += NT) { const int lg = i >> 12, j = (i >> 6) & 63, ii = i & 63; PW[i] = (bf16_t)f2bf(F.pool_w()[(size_t)lg * 4096 + ii * 64 + j]); }
    LAS float* m12 = (LAS float*)(F.lds);
    LAS float* wt = (LAS float*)(F.lds + 32768);
    LAS float* trig = (LAS float*)(F.lds + 32768 + 65536);
    LAS float* fws = (LAS float*)(F.lds + 32768 + 65536 + 512);
    __syncthreads();
    if (F.tid < 64) { trig[F.tid] = cospif(2.f * (float)F.tid / 64.f); trig[64 + F.tid] = sinpif(2.f * (float)F.tid / 64.f); }
    for (int tile = F.bid; tile < 2 * 256; tile += F.G) {
        const int l = tile >> 8, kb = (tile >> 4) & 15, nb = tile & 15, k0 = 64 * kb, n0 = 32 * nb, sel = n0 >> 8, nn0 = n0 & 255;
        __syncthreads();
        for (int i = F.tid; i < 256 * 32; i += NTHR) fws[i] = F.four_w()[(size_t)l * 65536 + (size_t)(i >> 5) * 256 + nn0 + (i & 31)];
        __syncthreads();
        { const int cin = F.tid & 255, hf = F.tid >> 8, hh = cin >> 6, c = cin & 63; float acc[16];
#pragma unroll
          for (int q = 0; q < 16; ++q) acc[q] = 0.f;
#pragma unroll 4
          for (int m = 0; m < 64; ++m) { const float tv = trig[sel * 64 + ((m * c) & 63)]; const LAS float* fr = fws + (hh * 64 + m) * 32 + 16 * hf;
#pragma unroll
              for (int q = 0; q < 16; ++q) acc[q] += tv * fr[q]; }
#pragma unroll
          for (int q = 0; q < 16; ++q) m12[cin * 32 + 16 * hf + q] = acc[q]; }
        for (int i = F.tid; i < 64 * 256; i += NTHR) { const int k = i >> 8, cin = i & 255; wt[i] = F.w_in()[(size_t)l * D * DIN + (size_t)(k0 + k) * DIN + 2816 + cin]; }
        __syncthreads();
        { const int n = F.tid & 31, kq = F.tid >> 5; float a[4] = {0.f, 0.f, 0.f, 0.f};
#pragma unroll 4
          for (int cin = 0; cin < 256; ++cin) { const float mv = m12[cin * 32 + n];
#pragma unroll
              for (int i = 0; i < 4; ++i) a[i] += wt[(kq * 4 + i) * 256 + cin] * mv; }
          u32x2 w; w.x = pk2(a[0], a[1]); w.y = pk2(a[2], a[3]);
          *(u32x2*)(F.Wt_in() + (size_t)l * DINX * D + (size_t)(FQ_OFF + n0 + n) * D + k0 + kq * 4) = w; }
    }
    __syncthreads();
}

template <class SrcF> __device__ __forceinline__ void load_tile_T(LAS unsigned char* zt, const SrcF& src, int tid) {
    const int pg = tid >> 4, cc = tid & 15; u32x4 r[8];
#pragma unroll
    for (int i = 0; i < 8; ++i) r[i] = *(const GAS u32x4*)(src(8 * pg + i) + 8 * cc);
#pragma unroll
    for (int j = 0; j < 8; ++j) { const unsigned sel = (j & 1) ? 0x07060302u : 0x05040100u; u32x4 o;
        o.x = __builtin_amdgcn_perm(r[1][j >> 1], r[0][j >> 1], sel); o.y = __builtin_amdgcn_perm(r[3][j >> 1], r[2][j >> 1], sel);
        o.z = __builtin_amdgcn_perm(r[5][j >> 1], r[4][j >> 1], sel); o.w = __builtin_amdgcn_perm(r[7][j >> 1], r[6][j >> 1], sel);
        *(LAS u32x4*)(zt + (8 * cc + j) * ZS + 16 * pg) = o; }
}
__device__ __forceinline__ void tile_mma(const LAS unsigned char* zt, const bf16_t* mat_row  , f32x4 (&acc)[8], int lane) {
    const int fr = lane & 15, g = lane >> 4;
#pragma unroll
    for (int ks = 0; ks < 8; ++ks) { const bf16x8 b = *(const GAS bf16x8*)(mat_row + 32 * ks + 8 * g);
#pragma unroll
        for (int m = 0; m < 8; ++m) { const bf16x8 a = *(const LAS bf16x8*)(zt + (16 * m + fr) * ZS + (32 * ks + 8 * g) * 2); acc[m] = mfma16(a, b, acc[m]); }
        if (ks & 1) __builtin_amdgcn_sched_barrier(0); }
}
__device__ __forceinline__ void tile_mma2(const LAS unsigned char* zt, const bf16_t* mat_row0, const bf16_t* mat_row1, f32x4 (&acc0)[8], f32x4 (&acc1)[8], int lane) {
    const int fr = lane & 15, g = lane >> 4;
#pragma unroll
    for (int ks = 0; ks < 8; ++ks) { const bf16x8 b0 = *(const GAS bf16x8*)(mat_row0 + 32 * ks + 8 * g), b1 = *(const GAS bf16x8*)(mat_row1 + 32 * ks + 8 * g);
#pragma unroll
        for (int m = 0; m < 8; ++m) { const bf16x8 a = *(const LAS bf16x8*)(zt + (16 * m + fr) * ZS + (32 * ks + 8 * g) * 2); acc0[m] = mfma16(a, b0, acc0[m]); acc1[m] = mfma16(a, b1, acc1[m]); }
        __builtin_amdgcn_sched_barrier(0); }
}
struct SrcA { const bf16_t* P; int t2, hc; __device__ __forceinline__ const bf16_t* operator()(int p) const { const int ri = p >> 7, t1 = p & 127; return P + (size_t)(CTX + 128 * t1 + t2) * DINX + FQ_OFF + ri * 256 + 128 * hc; } };
struct SrcB { const bf16_t* Y; int k1, hc; __device__ __forceinline__ const bf16_t* operator()(int p) const { const int ri = p >> 7, t2 = p & 127; return Y + ((size_t)(k1 * 128 + t2) * 2 + ri) * 256 + 128 * hc; } };
struct SrcC { const bf16_t* P; int ri, hc; __device__ __forceinline__ const bf16_t* operator()(int p) const { return P + (size_t)p * DINX + FQ_OFF + ri * 256 + 128 * hc; } };

__device__ __forceinline__ void fftA_item(Frame& F, int item) {
    const int t2 = item >> 1, hc = item & 1; LAS unsigned char* zt = F.lds + RING_OFF;
    bf16_t* YP = (bf16_t*)(F.ws + WS_YP); const bf16_t* MA = (const bf16_t*)(F.ws + WS_WF + WF_MA);
    __syncthreads();
    load_tile_T(zt, SrcA{F.P(), t2, hc}, F.tid);
    __syncthreads();
    const int fr = F.lane & 15, g = F.lane >> 4, k1 = 16 * F.wave + fr;
    f32x4 ar[8], ai[8];
#pragma unroll
    for (int m = 0; m < 8; ++m) { ar[m] = (f32x4){0.f, 0.f, 0.f, 0.f}; ai[m] = (f32x4){0.f, 0.f, 0.f, 0.f}; }
    tile_mma2(zt, MA + (size_t)k1 * 256, MA + (size_t)(128 + k1) * 256, ar, ai, F.lane);
    const float x = 2.f * (float)(t2 * k1) / 16384.f; const float cs = cospif(x), sn = sinpif(x);
    bf16_t* yr = YP + ((size_t)(k1 * 128 + t2) * 2) * 256 + 128 * hc + 4 * g;
#pragma unroll
    for (int m = 0; m < 8; ++m) { const f32x4 a = ar[m], b = ai[m]; const f32x4 pr = a * cs + b * sn, pi = b * cs - a * sn;
        u32x2 w; w.x = pk2(pr[0], pr[1]); w.y = pk2(pr[2], pr[3]); *(u32x2*)(yr + 16 * m) = w;
        u32x2 v; v.x = pk2(pi[0], pi[1]); v.y = pk2(pi[2], pi[3]); *(u32x2*)(yr + 256 + 16 * m) = v; }
}
__device__ __forceinline__ void fftB_item(Frame& F, int item) {
    const int k1 = item >> 1, hc = item & 1; LAS unsigned char* zt = F.lds + RING_OFF;
    const bf16_t* YP = (const bf16_t*)(F.ws + WS_YP); const bf16_t* MB = (const bf16_t*)(F.ws + WS_WF + WF_MB);
    __syncthreads();
    load_tile_T(zt, SrcB{YP, k1, hc}, F.tid);
    __syncthreads();
    const int fr = F.lane & 15, g = F.lane >> 4, k2 = 16 * F.wave + fr;
    f32x4 acc[8];
#pragma unroll
    for (int m = 0; m < 8; ++m) acc[m] = (f32x4){0.f, 0.f, 0.f, 0.f};
    tile_mma(zt, MB + (size_t)k2 * 256, acc, F.lane);
    bf16_t* o = F.CAT() + (size_t)(CTX + k1 + 128 * k2) * D + 768 + 128 * hc + 4 * g;
#pragma unroll
    for (int m = 0; m < 8; ++m) { const f32x4 a = acc[m] * (1.f / 1024.f); u32x2 w; w.x = pk2(a[0], a[1]); w.y = pk2(a[2], a[3]); *(u32x2*)(o + 16 * m) = w; }
}
__device__ __forceinline__ void fftC_item(Frame& F, int item) {
    const int kh = item >> 1, hc = item & 1; LAS unsigned char* zt = F.lds + RING_OFF; const bf16_t* MC = (const bf16_t*)(F.ws + WS_WF + WF_MC);
    const int fr = F.lane & 15, g = F.lane >> 4, k = 128 * kh + 16 * F.wave + fr;
    f32x4 acc[8];
#pragma unroll
    for (int m = 0; m < 8; ++m) acc[m] = (f32x4){0.f, 0.f, 0.f, 0.f};
    for (int ri = 0; ri < 2; ++ri) {
        __syncthreads();
        load_tile_T(zt, SrcC{F.P(), ri, hc}, F.tid);
        __syncthreads();
        tile_mma(zt, MC + (size_t)k * 512 + ri * 256, acc, F.lane);
    }
    bf16_t* o = F.CAT() + (size_t)k * D + 768 + 128 * hc + 4 * g;
#pragma unroll
    for (int m = 0; m < 8; ++m) { const f32x4 a = acc[m] * (1.f / 128.f); u32x2 w; w.x = pk2(a[0], a[1]); w.y = pk2(a[2], a[3]); *(u32x2*)(o + 16 * m) = w; }
}

template <int GI> __device__ __forceinline__ void pool_sums(Frame& F, int j, LAS float* V, LAS unsigned* U, LAS unsigned char* At) {
    constexpr int win = 2 << GI, lo = win >> 1, hi = win - 1 - lo; const GAS bf16_t* Pc = (const GAS bf16_t*)F.P() + 2560 + GI * 64;
    if (j == 0) {
        for (int idx = F.tid; idx < 256 * 32; idx += NTHR) { const int t = idx >> 5, pr = idx & 31; const int a = max(t - lo, 0), b = min(t + hi, CTX - 1); unsigned w[win];
#pragma unroll
            for (int i = 0; i < win; ++i) { const int r = min(max(t - lo + i, 0), CTX - 1); w[i] = *(const GAS unsigned*)(Pc + (unsigned)(r * DINX + 2 * pr)); }
            float s0 = 0.f, s1 = 0.f;
#pragma unroll
            for (int i = 0; i < win; ++i) { const int r = t - lo + i; const bool in = r >= 0 && r <= CTX - 1; s0 += in ? bflo(w[i]) : 0.f; s1 += in ? bfhi(w[i]) : 0.f; }
            const unsigned u = w[lo]; const float inv = 1.f / (float)(b - a + 1);
            *(LAS unsigned*)(At + t * 144 + 4 * pr) = pk2(s0 * inv - bflo(u), s1 * inv - bfhi(u)); }
        return; }
    const int r0 = 4 * (j - 1); constexpr int NR = win + 3;
    for (int idx = F.tid; idx < 64 * 32; idx += NTHR) { const int c = idx >> 5, pr = idx & 31; unsigned w[NR];
#pragma unroll
        for (int i = 0; i < NR; ++i) { const int r = min(max(r0 - lo + i, 0), LAT / GW - 1); w[i] = *(const GAS unsigned*)(Pc + (unsigned)((CTX + r * GW + c) * DINX + 2 * pr)); }
        float s0[4] = {0.f, 0.f, 0.f, 0.f}, s1[4] = {0.f, 0.f, 0.f, 0.f};
#pragma unroll
        for (int i = 0; i < NR; ++i) { const int r = r0 - lo + i; const bool ok = r >= 0 && r <= LAT / GW - 1; const float x0 = ok ? bflo(w[i]) : 0.f, x1 = ok ? bfhi(w[i]) : 0.f;
#pragma unroll
            for (int q = 0; q < 4; ++q) if (i >= q && i <= q + win - 1) { s0[q] += x0; s1[q] += x1; } }
#pragma unroll
        for (int q = 0; q < 4; ++q) { V[(q * 64 + c) * 64 + 2 * pr] = s0[q]; V[(q * 64 + c) * 64 + 2 * pr + 1] = s1[q]; U[(q * 64 + c) * 32 + pr] = w[lo + q]; } }
    __syncthreads();
    for (int idx = F.tid; idx < 4 * 8 * 64; idx += NTHR) { const int ch = idx & 63, cb = (idx >> 6) & 7, i = idx >> 9; const int r = r0 + i;
        const float cr = (float)(min(r + hi, LAT / GW - 1) - max(r - lo, 0) + 1); const LAS float* Vr = V + (i * 64) * 64 + ch;
        const int c0 = 8 * cb; float s = 0.f;
#pragma unroll
        for (int q = 0; q < win; ++q) { const int c = c0 - lo + q; s += (c >= 0 && c <= GW - 1) ? Vr[min(max(c, 0), GW - 1) * 64] : 0.f; }
#pragma unroll
        for (int q = 0; q < 8; ++q) { const int c = c0 + q; if (q > 0) { if (c + hi <= GW - 1) s += Vr[(c + hi) * 64]; if (c - 1 - lo >= 0) s -= Vr[(c - 1 - lo) * 64]; }
            const float cc = (float)(min(c + hi, GW - 1) - max(c - lo, 0) + 1); const unsigned uw = U[(i * 64 + c) * 32 + (ch >> 1)]; const float u = (ch & 1) ? bfhi(uw) : bflo(uw);
            *(LAS unsigned short*)(At + (i * 64 + c) * 144 + 2 * ch) = (unsigned short)f2bf(s / (cr * cc) - u); } }
}
__device__ __forceinline__ void pool_item(Frame& F, int l, int item) {
    const int j = item >> 2, gi = item & 3;
    LAS float* V = (LAS float*)(F.lds);
    LAS unsigned* U = (LAS unsigned*)(F.lds + 65536);
    LAS unsigned char* At = F.lds + 65536 + 32768;
    __syncthreads();
    if (gi == 0) pool_sums<0>(F, j, V, U, At); else if (gi == 1) pool_sums<1>(F, j, V, U, At); else if (gi == 2) pool_sums<2>(F, j, V, U, At); else pool_sums<3>(F, j, V, U, At);
    __syncthreads();
    const bf16_t* PW = (const bf16_t*)(F.ws + WS_WF + WF_PW) + (size_t)(l * 4 + gi) * 4096; const int fr = F.lane & 15, g = F.lane >> 4;
    f32x4 acc[4][2];
#pragma unroll
    for (int n = 0; n < 4; ++n) { acc[n][0] = (f32x4){0.f, 0.f, 0.f, 0.f}; acc[n][1] = (f32x4){0.f, 0.f, 0.f, 0.f}; }
#pragma unroll
    for (int ks = 0; ks < 2; ++ks) { bf16x8 b[2];
#pragma unroll
        for (int mt = 0; mt < 2; ++mt) b[mt] = *(const LAS bf16x8*)(At + (32 * F.wave + 16 * mt + fr) * 144 + (32 * ks + 8 * g) * 2);
#pragma unroll
        for (int n = 0; n < 4; ++n) { const bf16x8 a = *(const GAS bf16x8*)(PW + (16 * n + fr) * 64 + 32 * ks + 8 * g);
#pragma unroll
            for (int mt = 0; mt < 2; ++mt) acc[n][mt] = mfma16(a, b[mt], acc[n][mt]); } }
    const int rowbase = j == 0 ? 0 : CTX + 256 * (j - 1);
#pragma unroll
    for (int n = 0; n < 4; ++n) { const f32x4 sc = *(const GAS f32x4*)(F.pool_s() + l * 256 + gi * 64 + 16 * n + 4 * g);
#pragma unroll
        for (int mt = 0; mt < 2; ++mt) { const f32x4 a = acc[n][mt] * sc; u32x2 w; w.x = pk2(a[0], a[1]); w.y = pk2(a[2], a[3]);
            *(u32x2*)(F.CAT() + (size_t)(rowbase + 32 * F.wave + 16 * mt + fr) * D + 512 + gi * 64 + 16 * n + 4 * g) = w; } }
}

constexpr int SC_FT = 0, SC_QT = 18432, SC_VT = 36864, SC_BQ = 55296, SC_BF = 72704, SC_KT = 90112, SC_PM = 108544, SC_G = 117760, SC_TOT = 135168, SC_DEC = 137216, SC_SSQ = 138752, SC_END = 140800;
static_assert(SC_END <= MISC_OFF, "scan LDS map");
template <int DIR, bool FULL> __device__ __forceinline__ void scan_fetch(const Frame& F, int h, int row0, u32x4 (&r)[8]) {
    const GAS bf16_t* P = (const GAS bf16_t*)F.P(); const int tid = F.tid;
    if (tid < 384) { const int tile = tid >> 7, blk = tid & 127, tg = blk >> 4, kc = blk & 15; if (!FULL && tile == 1) return;
        const int colb = tile == 0 ? 512 * (1 + DIR) : (tile == 1 ? 0 : 1536); const GAS bf16_t* src = P + (unsigned)((row0 + 8 * tg) * DINX + colb + h * 128 + 8 * kc);
#pragma unroll
        for (int i = 0; i < 8; ++i) r[i] = *(const GAS u32x4*)(src + (unsigned)(i * DINX)); }
    else if (FULL && DIR == 1) { const int q = tid - 384; const GAS bf16_t* src = P + (unsigned)((row0 + (q >> 4)) * DINX + 2048 + h * 128 + 8 * (q & 15));
#pragma unroll
        for (int i = 0; i < 8; ++i) r[i] = *(const GAS u32x4*)(src + (unsigned)(i * 8 * DINX)); }
}
template <int DIR, bool FULL> __device__ __forceinline__ void scan_commit(const Frame& F, const u32x4 (&r)[8]) {
    LAS unsigned char* L = F.lds + RING_OFF; const int tid = F.tid;
    if (tid < 384) { const int tile = tid >> 7, blk = tid & 127, tg = blk >> 4, kc = blk & 15; if (!FULL && tile == 1) return;
#pragma unroll
        for (int j = 0; j < 8; ++j) { const unsigned sel = (j & 1) ? 0x07060302u : 0x05040100u; u32x4 o;
            o.x = __builtin_amdgcn_perm(r[1][j >> 1], r[0][j >> 1], sel); o.y = __builtin_amdgcn_perm(r[3][j >> 1], r[2][j >> 1], sel);
            o.z = __builtin_amdgcn_perm(r[5][j >> 1], r[4][j >> 1], sel); o.w = __builtin_amdgcn_perm(r[7][j >> 1], r[6][j >> 1], sel);
            *(LAS u32x4*)(L + tile * 18432 + (8 * kc + j) * 144 + 16 * tg) = o; } }
    else if (FULL && DIR == 1) { const int q = tid - 384; LAS unsigned char* dst = L + SC_G + (q >> 4) * 272 + 16 * (q & 15);
#pragma unroll
        for (int i = 0; i < 8; ++i) *(LAS u32x4*)(dst + i * 8 * 272) = r[i]; }
}
template <int DIR, bool FULL> __device__ __forceinline__ void scan_chunk(Frame& F, int l, int h, int nrow0, u32x4 (&pre)[8], f32x4 (&S)[8], f32x4 (&o)[4], float& segsum, const GAS float* oload = nullptr, GAS float* ostore = nullptr) {
    LAS unsigned char* L = F.lds + RING_OFF; int lane = F.lane; asm volatile("" : "+v"(lane));
    const int w = F.wave, tid = w * 64 + lane, fr = lane & 15, g = lane >> 4;
    LAS float* TOT = (LAS float*)(L + SC_TOT); LAS float* DEC = (LAS float*)(L + SC_DEC); LAS float* C1 = DEC + 128; LAS float* C2 = DEC + 256;
    __syncthreads();
    scan_commit<DIR, FULL>(F, pre);
    __syncthreads();
    const int k = tid & 127, qu = tid >> 7;
    float bl[16]; float run = 0.f;
    { const u32x4 fa = *(const LAS u32x4*)(L + SC_FT + k * 144 + 32 * qu), fb = *(const LAS u32x4*)(L + SC_FT + k * 144 + 32 * qu + 16); const unsigned fw[8] = {fa.x, fa.y, fa.z, fa.w, fb.x, fb.y, fb.z, fb.w};
#pragma unroll
      for (int i = 0; i < 16; ++i) { const int ti = (DIR == 0 ? i : 15 - i); run += (ti & 1) ? f16hi(fw[ti >> 1]) : f16lo(fw[ti >> 1]); bl[i] = run; } }
    TOT[qu * 128 + k] = run;
    __syncthreads();
    const float t0 = TOT[k], t1 = TOT[128 + k], t2 = TOT[256 + k], t3 = TOT[384 + k]; const float total = (t0 + t1) + (t2 + t3);
    float off, ref;
    if (DIR == 0) { off = qu == 0 ? 0.f : (qu == 1 ? t0 : (qu == 2 ? t0 + t1 : t0 + t1 + t2)); ref = t0 + t1; }
    else { off = qu == 3 ? 0.f : (qu == 2 ? t3 : (qu == 1 ? t3 + t2 : t3 + t2 + t1)); ref = t3 + t2; }
    if (qu == 0) { DEC[k] = __builtin_amdgcn_exp2f(total); C1[k] = __builtin_amdgcn_exp2f(ref); C2[k] = __builtin_amdgcn_exp2f(total - ref); segsum += total; }
    { unsigned qw[8];
      if (FULL) { const u32x4 qa = *(const LAS u32x4*)(L + SC_QT + k * 144 + 32 * qu), qb = *(const LAS u32x4*)(L + SC_QT + k * 144 + 32 * qu + 16); qw[0] = qa.x; qw[1] = qa.y; qw[2] = qa.z; qw[3] = qa.w; qw[4] = qb.x; qw[5] = qb.y; qw[6] = qb.z; qw[7] = qb.w; }
      float ktv[16]; const float sh = off - ref;
#pragma unroll
      for (int i = 0; i < 16; ++i) { const int ti = (DIR == 0 ? i : 15 - i), t = 16 * qu + ti; const float lf = i == 0 ? bl[0] : bl[i] - bl[i - 1]; const float b = bl[i] + sh;
          const float E = __builtin_amdgcn_exp2f(b), Ei = __builtin_amdgcn_rcpf(E), kk = 1.f - __builtin_amdgcn_exp2f(lf); ktv[ti] = kk * Ei;
          if (FULL) { const float qs = (ti & 1) ? bfhi(qw[ti >> 1]) : bflo(qw[ti >> 1]); *(LAS unsigned short*)(L + SC_BQ + t * 272 + 2 * k) = (unsigned short)(cvt_pk_bf16(qs * E, 0.f)); } }
      u32x4 a, b2; a.x = cvt_pk_bf16(ktv[0], ktv[1]); a.y = cvt_pk_bf16(ktv[2], ktv[3]); a.z = cvt_pk_bf16(ktv[4], ktv[5]); a.w = cvt_pk_bf16(ktv[6], ktv[7]);
      b2.x = cvt_pk_bf16(ktv[8], ktv[9]); b2.y = cvt_pk_bf16(ktv[10], ktv[11]); b2.z = cvt_pk_bf16(ktv[12], ktv[13]); b2.w = cvt_pk_bf16(ktv[14], ktv[15]);
      *(LAS u32x4*)(L + SC_KT + k * 144 + 32 * qu) = a; *(LAS u32x4*)(L + SC_KT + k * 144 + 32 * qu + 16) = b2;
      if (FULL) { const unsigned kw[8] = {a.x, a.y, a.z, a.w, b2.x, b2.y, b2.z, b2.w};
#pragma unroll
          for (int ti = 0; ti < 16; ++ti) *(LAS unsigned short*)(L + SC_BF + (16 * qu + ti) * 272 + 2 * k) = (unsigned short)((ti & 1) ? (kw[ti >> 1] >> 16) : (kw[ti >> 1] & 0xffffu)); } }
    __syncthreads();
    if (nrow0 >= 0) scan_fetch<DIR, FULL>(F, h, nrow0, pre);
    if (FULL) {
#pragma unroll
        for (int tb = 0; tb < 4; ++tb)
#pragma unroll
            for (int r = 0; r < 4; ++r) o[tb][r] = oload ? oload[(tb * 4 + r) * 512] : 0.f; }
    __builtin_amdgcn_sched_barrier(0);
    if (FULL) {
        const int tb = w >> 1;
#pragma unroll
        for (int q = 0; q < 2; ++q) { const int sb = 2 * (w & 1) + q; f32x4 acc = (f32x4){0.f, 0.f, 0.f, 0.f};
#pragma unroll
            for (int ks = 0; ks < 4; ++ks) { const bf16x8 a = *(const LAS bf16x8*)(L + SC_BF + (16 * sb + fr) * 272 + (32 * ks + 8 * g) * 2); const bf16x8 b = *(const LAS bf16x8*)(L + SC_BQ + (16 * tb + fr) * 272 + (32 * ks + 8 * g) * 2);
                acc = mfma16(a, b, acc); }
            const int t = 16 * tb + fr; float m[4];
#pragma unroll
            for (int r = 0; r < 4; ++r) { const int s = 16 * sb + 4 * g + r; const bool keep = DIR == 0 ? (s <= t) : (s >= t); m[r] = keep ? acc[r] : 0.f; }
            u32x2 wv; wv.x = pk2(m[0], m[1]); wv.y = pk2(m[2], m[3]); *(LAS u32x2*)(L + SC_PM + t * 144 + (16 * sb + 4 * g) * 2) = wv; }
        __syncthreads();
    }
    bf16x8 vt[2];
#pragma unroll
    for (int ks = 0; ks < 2; ++ks) vt[ks] = *(const LAS bf16x8*)(L + SC_VT + (16 * w + fr) * 144 + (32 * ks + 8 * g) * 2);
    if (FULL) {
        bf16x8 sf[4];
#pragma unroll
        for (int ks = 0; ks < 4; ++ks) { const f32x4 ca = *(const LAS f32x4*)(C1 + 32 * ks + 4 * g), cb = *(const LAS f32x4*)(C1 + 32 * ks + 16 + 4 * g); const f32x4 x = S[2 * ks] * ca, y = S[2 * ks + 1] * cb;
            u32x4 pkd; pkd.x = pk2(x[0], x[1]); pkd.y = pk2(x[2], x[3]); pkd.z = pk2(y[0], y[1]); pkd.w = pk2(y[2], y[3]); sf[ks] = __builtin_bit_cast(bf16x8, pkd); }
#pragma unroll
        for (int tb = 0; tb < 4; ++tb) { f32x4 acc = o[tb];
#pragma unroll
            for (int ks = 0; ks < 4; ++ks) { const u32x2 a0 = *(const LAS u32x2*)(L + SC_BQ + (16 * tb + fr) * 272 + (32 * ks + 4 * g) * 2), a1 = *(const LAS u32x2*)(L + SC_BQ + (16 * tb + fr) * 272 + (32 * ks + 16 + 4 * g) * 2);
                u32x4 pa; pa.x = a0.x; pa.y = a0.y; pa.z = a1.x; pa.w = a1.y; acc = mfma16(__builtin_bit_cast(bf16x8, pa), sf[ks], acc); }
#pragma unroll
            for (int ks = 0; ks < 2; ++ks) { const bf16x8 a = *(const LAS bf16x8*)(L + SC_PM + (16 * tb + fr) * 144 + (32 * ks + 8 * g) * 2); acc = mfma16(a, vt[ks], acc); }
            o[tb] = acc; __builtin_amdgcn_sched_barrier(0); }
        if (ostore) {
#pragma unroll
            for (int tb = 0; tb < 4; ++tb)
#pragma unroll
                for (int r = 0; r < 4; ++r) ostore[(tb * 4 + r) * 512] = o[tb][r]; }
    }
#pragma unroll
    for (int kb = 0; kb < 8; ++kb) { f32x4 tmp = (f32x4){0.f, 0.f, 0.f, 0.f};
#pragma unroll
        for (int ks = 0; ks < 2; ++ks) { const bf16x8 a = *(const LAS bf16x8*)(L + SC_KT + (16 * kb + fr) * 144 + (32 * ks + 8 * g) * 2); tmp = mfma16(a, vt[ks], tmp); }
        const f32x4 dc = *(const LAS f32x4*)(DEC + 16 * kb + 4 * g), c2 = *(const LAS f32x4*)(C2 + 16 * kb + 4 * g); S[kb] = dc * S[kb] + c2 * tmp; if (kb & 1) __builtin_amdgcn_sched_barrier(0); }
}
__device__ __forceinline__ void state_store(float* dst, const f32x4 (&S)[8], int w, int lane) {
    GAS float* p = (GAS float*)dst + (unsigned)(w * 2048 + lane);
#pragma unroll
    for (int kb = 0; kb < 8; ++kb)
#pragma unroll
        for (int r = 0; r < 4; ++r) p[(kb * 4 + r) * 64] = S[kb][r]; }
__device__ __forceinline__ void state_load(const float* src, f32x4 (&S)[8], int w, int lane) {
    const GAS float* p = (const GAS float*)src + (unsigned)(w * 2048 + lane);
#pragma unroll
    for (int kb = 0; kb < 8; ++kb)
#pragma unroll
        for (int r = 0; r < 4; ++r) S[kb][r] = p[(kb * 4 + r) * 64]; }
__device__ __forceinline__ float* sc_SU(Frame& F) { return (float*)(F.ws + WS_SU); }
__device__ __forceinline__ float* sc_SS(Frame& F) { return (float*)(F.ws + WS_SS); }
__device__ __forceinline__ float* sc_SD(Frame& F) { return (float*)(F.ws + WS_SD); }
__device__ __forceinline__ float* sc_CARRY(Frame& F) { return (float*)(F.ws + WS_SD) + 8 * 64 * 128; }

__device__ __forceinline__ float* sc_OSCR(Frame& F) { return (float*)(F.ws + WS_OSCR) + (size_t)F.bid * 32768; }
template <int DIR> __device__ __forceinline__ void scan_states(Frame& F, int l, int h, int segrow, float* sout, float* dout) {
    f32x4 S[8], odummy[4]; float segsum = 0.f; u32x4 pre[8];
#pragma unroll
    for (int kb = 0; kb < 8; ++kb) S[kb] = (f32x4){0.f, 0.f, 0.f, 0.f};
    scan_fetch<DIR, false>(F, h, segrow + (DIR == 0 ? 0 : 192), pre);
#pragma unroll 1
    for (int i_ = 0; i_ < 4; ++i_) { int i = i_; asm volatile("" : "+s"(i)); const int c = DIR == 0 ? i : 3 - i;
        scan_chunk<DIR, false>(F, l, h, i < 3 ? segrow + 64 * (DIR == 0 ? c + 1 : c - 1) : -1, pre, S, odummy, segsum); }
    state_store(sout, S, F.wave, F.lane);
    if (dout && F.tid < 128) dout[F.tid] = __builtin_amdgcn_exp2f(segsum);
}
__device__ __forceinline__ void scanA_item(Frame& F, int l, int item) {
    const int h = item >> 6, seg = item & 63, segrow = CTX + 256 * seg;
    scan_states<0>(F, l, h, segrow, sc_SU(F) + ((size_t)(h * 2 + 0) * 64 + seg) * 16384, sc_SD(F) + ((h * 2 + 0) * 64 + seg) * 128);
    scan_states<1>(F, l, h, segrow, sc_SU(F) + ((size_t)(h * 2 + 1) * 64 + seg) * 16384, sc_SD(F) + ((h * 2 + 1) * 64 + seg) * 128);
}
__device__ __forceinline__ void scan_full(Frame& F, int l, int h, int segrow, const float* sinf, const float* sinb, float* outf, float* outb) {
    f32x4 S[8], o[4]; float segsum = 0.f; const int w = F.wave, lane = F.lane, fr = lane & 15, g = lane >> 4; u32x4 pre[8];
    GAS float* oscr = (GAS float*)sc_OSCR(F) + (unsigned)F.tid;
    if (sinf) state_load(sinf, S, w, lane); else {
#pragma unroll
        for (int kb = 0; kb < 8; ++kb) S[kb] = (f32x4){0.f, 0.f, 0.f, 0.f}; }
    scan_fetch<0, true>(F, h, segrow, pre);
#pragma unroll 1
    for (int c_ = 0; c_ < 4; ++c_) { int c = c_; asm volatile("" : "+s"(c));
        scan_chunk<0, true>(F, l, h, c < 3 ? segrow + 64 * (c + 1) : -1, pre, S, o, segsum);
#pragma unroll
        for (int tb = 0; tb < 4; ++tb)
#pragma unroll
            for (int r = 0; r < 4; ++r) (oscr + c * 8192)[(tb * 4 + r) * 512] = o[tb][r];
    }
    if (outf) state_store(outf, S, w, lane);
    VM_WAIT();
    if (sinb) state_load(sinb, S, w, lane); else {
#pragma unroll
        for (int kb = 0; kb < 8; ++kb) S[kb] = (f32x4){0.f, 0.f, 0.f, 0.f}; }
    LAS unsigned char* L = F.lds + RING_OFF; LAS float* SSQ = (LAS float*)(L + SC_SSQ);
    const float ngv = F.hng()[l * 512 + h * 128 + 16 * w + fr];
    scan_fetch<1, true>(F, h, segrow + 192, pre);
#pragma unroll 1
    for (int c_ = 3; c_ >= 0; --c_) { int c = c_; asm volatile("" : "+s"(c));
        scan_chunk<1, true>(F, l, h, c > 0 ? segrow + 64 * (c - 1) : -1, pre, S, o, segsum, oscr + c * 8192);
#pragma unroll
        for (int tb = 0; tb < 4; ++tb) { f32x4 q = o[tb] * o[tb];
#pragma unroll
            for (int m = 1; m < 16; m <<= 1) { q[0] += lane_xor(q[0], m, lane); q[1] += lane_xor(q[1], m, lane); q[2] += lane_xor(q[2], m, lane); q[3] += lane_xor(q[3], m, lane); }
            if (fr == 0) {
#pragma unroll
                for (int r = 0; r < 4; ++r) SSQ[(16 * tb + 4 * g + r) * 8 + w] = q[r]; } }
        __syncthreads();
#pragma unroll
        for (int tb = 0; tb < 4; ++tb)
#pragma unroll
            for (int r = 0; r < 4; ++r) { const int t = 16 * tb + 4 * g + r; const f32x4 p0 = *(const LAS f32x4*)(SSQ + t * 8), p1 = *(const LAS f32x4*)(SSQ + t * 8 + 4);
                const float ss = ((p0[0] + p0[1]) + (p0[2] + p0[3])) + ((p1[0] + p1[1]) + (p1[2] + p1[3])); const float rs = rsqrtf(ss * (1.f / 128.f) + 1e-6f);
                const float gp = bf2f(*(const LAS unsigned short*)(L + SC_G + t * 272 + 2 * (16 * w + fr)));
                *(LAS unsigned short*)(L + SC_BQ + t * 272 + 2 * (16 * w + fr)) = (unsigned short)f2bf(o[tb][r] * rs * ngv * gp); }
        __syncthreads();
#pragma unroll
        for (int i = 0; i < 2; ++i) { const int id = F.tid + 512 * i, row = id >> 4, cc = id & 15; const u32x4 d = *(const LAS u32x4*)(L + SC_BQ + row * 272 + 16 * cc);
            *(GAS u32x4*)((GAS bf16_t*)F.CAT() + (unsigned)((segrow + 64 * c + row) * D + h * 128 + 8 * cc)) = d; }
    }
    if (outb) state_store(outb, S, w, lane);
}
__device__ __forceinline__ GAS float* sc_CTXO(const Frame& F, int hd, int c) { return (GAS float*)(F.ws + WS_CTXO) + (unsigned)((hd * 4 + c) * 8192); }
template <int DIR> __device__ __forceinline__ void scan_dir_local(Frame& F, int l, int h, int segrow, float* sout) {
    f32x4 S[8], o[4]; float segsum = 0.f; u32x4 pre[8]; const int hd = h * 2 + DIR;
#pragma unroll
    for (int kb = 0; kb < 8; ++kb) S[kb] = (f32x4){0.f, 0.f, 0.f, 0.f};
    scan_fetch<DIR, true>(F, h, segrow + (DIR == 0 ? 0 : 192), pre);
#pragma unroll 1
    for (int i_ = 0; i_ < 4; ++i_) { int i = i_; asm volatile("" : "+s"(i)); const int c = DIR == 0 ? i : 3 - i;
        scan_chunk<DIR, true>(F, l, h, i < 3 ? segrow + 64 * (DIR == 0 ? c + 1 : c - 1) : -1, pre, S, o, segsum, nullptr, sc_CTXO(F, hd, c) + (unsigned)F.tid); }
    state_store(sout, S, F.wave, F.lane);
}
__device__ __forceinline__ void ctx_finalize(Frame& F, int l, int h) {
    LAS unsigned char* L = F.lds + RING_OFF; LAS float* SSQ = (LAS float*)(L + SC_SSQ);
    const float ngv = F.hng()[l * 512 + h * 128 + 16 * F.wave + (F.lane & 15)];
#pragma unroll 1
    for (int c_ = 0; c_ < 4; ++c_) { int c = c_; asm volatile("" : "+s"(c)); int lane = F.lane; asm volatile("" : "+v"(lane));
        const int w = F.wave, tid = w * 64 + lane, fr = lane & 15, g = lane >> 4, row0 = 64 * c;
        __syncthreads();
        { const GAS bf16_t* gp = (const GAS bf16_t*)F.P() + (unsigned)((row0 + (tid >> 4)) * DINX + 2048 + h * 128 + 8 * (tid & 15)); const int o = (tid >> 4) * 272 + 16 * (tid & 15);
          *(LAS u32x4*)(L + SC_G + o) = *(const GAS u32x4*)gp; *(LAS u32x4*)(L + SC_G + o + 32 * 272) = *(const GAS u32x4*)(gp + (unsigned)(32 * DINX)); }
        f32x4 o[4];
        { const GAS float* of = sc_CTXO(F, h * 2 + 0, c) + (unsigned)tid; const GAS float* ob = sc_CTXO(F, h * 2 + 1, c) + (unsigned)tid;
#pragma unroll
          for (int tb = 0; tb < 4; ++tb)
#pragma unroll
              for (int r = 0; r < 4; ++r) o[tb][r] = of[(tb * 4 + r) * 512] + ob[(tb * 4 + r) * 512]; }
#pragma unroll
        for (int tb = 0; tb < 4; ++tb) { f32x4 q = o[tb] * o[tb];
#pragma unroll
            for (int m = 1; m < 16; m <<= 1) { q[0] += lane_xor(q[0], m, lane); q[1] += lane_xor(q[1], m, lane); q[2] += lane_xor(q[2], m, lane); q[3] += lane_xor(q[3], m, lane); }
            if (fr == 0) {
#pragma unroll
                for (int r = 0; r < 4; ++r) SSQ[(16 * tb + 4 * g + r) * 8 + w] = q[r]; } }
        __syncthreads();
#pragma unroll
        for (int tb = 0; tb < 4; ++tb)
#pragma unroll
            for (int r = 0; r < 4; ++r) { const int t = 16 * tb + 4 * g + r; const f32x4 p0 = *(const LAS f32x4*)(SSQ + t * 8), p1 = *(const LAS f32x4*)(SSQ + t * 8 + 4);
                const float ss = ((p0[0] + p0[1]) + (p0[2] + p0[3])) + ((p1[0] + p1[1]) + (p1[2] + p1[3])); const float rs = rsqrtf(ss * (1.f / 128.f) + 1e-6f);
                const float gp = bf2f(*(const LAS unsigned short*)(L + SC_G + t * 272 + 2 * (16 * w + fr)));
                *(LAS unsigned short*)(L + SC_BQ + t * 272 + 2 * (16 * w + fr)) = (unsigned short)f2bf(o[tb][r] * rs * ngv * gp); }
        __syncthreads();
#pragma unroll
        for (int i = 0; i < 2; ++i) { const int id = tid + 512 * i, row = id >> 4, cc = id & 15; const u32x4 d = *(const LAS u32x4*)(L + SC_BQ + row * 272 + 16 * cc);
            *(GAS u32x4*)((GAS bf16_t*)F.CAT() + (unsigned)((row0 + row) * D + h * 128 + 8 * cc)) = d; }
    }
    __syncthreads();
}
__device__ __forceinline__ void scanB(Frame& F) {
    const int e = F.bid * NTHR + F.tid; if (e >= 8 * 16384) return;
    const int hd = e >> 14, idx = e & 16383, d = hd & 1; const int ln = idx & 63, reg = (idx >> 6) & 3, kb = (idx >> 8) & 7; const int k = 16 * kb + 4 * (ln >> 4) + reg;
    const float* SU = sc_SU(F) + (size_t)hd * 64 * 16384 + idx; const float* SD = sc_SD(F) + hd * 64 * 128 + k; float* SS = sc_SS(F) + (size_t)hd * 64 * 16384 + idx;
    float S = sc_CARRY(F)[hd * 16384 + idx];
    if (d == 0) { for (int seg = 0; seg < 64; ++seg) { SS[(size_t)seg * 16384] = S; S = SD[seg * 128] * S + SU[(size_t)seg * 16384]; } }
    else { for (int seg = 63; seg >= 0; --seg) { SS[(size_t)seg * 16384] = S; S = SD[seg * 128] * S + SU[(size_t)seg * 16384]; } }
}

__device__ __forceinline__ void ph_mixA(Frame& F, int l) {
    scanA_item(F, l, F.bid);
    if (l == 0) { if (F.bid >= 4 && F.bid < 12) { const int hd = F.bid - 4, h = hd >> 1;
            if (hd & 1) scan_dir_local<1>(F, l, h, 0, sc_CARRY(F) + hd * 16384); else scan_dir_local<0>(F, l, h, 0, sc_CARRY(F) + hd * 16384); } }
    else if (F.bid >= 4 && F.bid < 12) { const int hd = F.bid - 4, h = hd >> 1;
        if (hd & 1) scan_states<1>(F, l, h, 0, sc_CARRY(F) + hd * 16384, nullptr); else scan_states<0>(F, l, h, 0, sc_CARRY(F) + hd * 16384, nullptr); }
    fftA_item(F, F.bid);
    for (int it = F.bid + (l == 1 ? 4 : 0); it < 65 * 4; it += F.G) pool_item(F, l, it);
}
__device__ __forceinline__ void ph_mixB(Frame& F, int l) {
    scanB(F);
    fftB_item(F, F.bid);
    if (l == 0 && F.bid >= 252) fftC_item(F, F.bid - 252);
    if (l == 0 && F.bid >= 240 && F.bid < 244) ctx_finalize(F, l, F.bid - 240);
}
__device__ __forceinline__ void ph_mixC(Frame& F, int l) {
    const int item = F.bid, h = item >> 6, seg = item & 63;
    scan_full(F, l, h, CTX + 256 * seg, sc_SS(F) + ((size_t)(h * 2 + 0) * 64 + seg) * 16384, sc_SS(F) + ((size_t)(h * 2 + 1) * 64 + seg) * 16384, nullptr, nullptr);
}
#define GRID_BAR() do { Frame R_ = relaunder(F); xcd_barrier(bar, R_.tid); } while (0)
#define PHASE(call) do { Frame R = relaunder(F); call; } while (0)
__global__ void __launch_bounds__(NTHR, 2) mega_fwd(Params p) {
    extern __shared__ __attribute__((aligned(16))) unsigned char lds[];
    Frame F; frame_init(F, p, lds);
    if (F.tid < 16) ((LAS unsigned*)(F.lds + MISC_OFF))[F.tid] = 0u;
    __syncthreads();
    XcdBarrier bar = xcd_barrier_post((unsigned*)(F.ctl() + CW_BAR), (volatile LAS unsigned*)(F.lds + MISC_OFF + 32));
    PHASE(ph_prologue(R)); PHASE(ph_prologue2(R));
    GRID_BAR();
    PHASE(ph_mod1(R, 0));
    GRID_BAR();
#pragma unroll 1
    for (int l = 0; l < 2; ++l) {
        PHASE(ph_win(R, l));            GRID_BAR();
        PHASE(ph_mixA(R, l));           GRID_BAR();
        PHASE(ph_mixB(R, l));           GRID_BAR();
        PHASE(ph_mixC(R, l));           GRID_BAR();
        PHASE(ph_wout(R, l));           GRID_BAR();
        PHASE(ph_mod2_route(R, l, l));  GRID_BAR();
        PHASE(ph_gateup(R, l));         GRID_BAR();
        PHASE(ph_down(R, l));           GRID_BAR();
        PHASE(ph_combine(R, l));
        if (l == 0) GRID_BAR();
    }
}
extern "C" void kernel_launch(void* const* d_in, const int* in_sizes, int n_in, void* d_out, int out_size, void* d_ws, size_t ws_size, hipStream_t stream) {
    static int ok = 0;
    if (ok == 0) {
        if (n_in != 22 || out_size != LAT * D || ws_size < WS_FASTEND) { fprintf(stderr, "kernel_launch: unexpected shapes / workspace (n_in %d, out %d, ws %zu < %zu); nothing launched\n", n_in, out_size, ws_size, (size_t)WS_FASTEND); ok = -1; return; }
        int dev = 0, cus = 0, per_cu = 0;
        if (hipGetDevice(&dev) != hipSuccess || hipDeviceGetAttribute(&cus, hipDeviceAttributeMultiprocessorCount, dev) != hipSuccess) { ok = -1; return; }
        if (hipFuncSetAttribute((const void*)mega_fwd, hipFuncAttributeMaxDynamicSharedMemorySize, LDS_BYTES) != hipSuccess) { fprintf(stderr, "kernel_launch: hipFuncSetAttribute failed\n"); ok = -1; return; }
        if (hipOccupancyMaxActiveBlocksPerMultiprocessor(&per_cu, (const void*)mega_fwd, NTHR, LDS_BYTES) != hipSuccess || per_cu < 1) fprintf(stderr, "kernel_launch: note: occupancy query reports %d workgroups per CU\n", per_cu);
        (void)hipGetLastError();
        if (cus < 256) fprintf(stderr, "kernel_launch: device has %d CUs; this kernel needs 256 co-resident workgroups (one per CU)\n", cus);
        ok = 1;
    }
    if (ok < 0) return;
    if (hipMemsetAsync((char*)d_ws + WS_CTL, 0, CTL_ZERO_BYTES, stream) != hipSuccess) return;
    Params p{}; for (int i = 0; i < 22; ++i) p.in[i] = (const float*)d_in[i]; p.out = (float*)d_out; p.ws = (unsigned char*)d_ws;
    hipLaunchKernelGGL(mega_fwd, dim3(256), dim3(NTHR), LDS_BYTES, stream, p);
}
```

```cpp
#include <hip/hip_runtime.h>
#include <cstdio>
#include <cstdint>
constexpr int D = 1024, LAT = 16384, CTX = 256, T = LAT + CTX, DIN = 3072, NE = 32, TOPK = 4;
constexpr int GW = 64;
#ifndef PSTR
#define PSTR DIN
#endif
constexpr int DINX = 3328, FQ_OFF = 2816;
#define GAS __attribute__((address_space(1)))
#define LAS __attribute__((address_space(3)))
typedef unsigned short bf16_t;
typedef short bf16x8 __attribute__((ext_vector_type(8)));
typedef short bf16x4 __attribute__((ext_vector_type(4)));
typedef float f32x4 __attribute__((ext_vector_type(4)));
typedef float f32x2 __attribute__((ext_vector_type(2)));
typedef unsigned u32x4 __attribute__((ext_vector_type(4)));
typedef unsigned u32x2 __attribute__((ext_vector_type(2)));
typedef GAS unsigned gu32;
#define RLX_AGENT __ATOMIC_RELAXED, __HIP_MEMORY_SCOPE_AGENT
#define LDS_WAIT() asm volatile("s_waitcnt lgkmcnt(0)" ::: "memory")
#define VM_WAIT() asm volatile("s_waitcnt vmcnt(0)" ::: "memory")
__device__ __forceinline__ unsigned cvt_pk_bf16(float lo, float hi) { unsigned r; asm("v_cvt_pk_bf16_f32 %0, %1, %2" : "=v"(r) : "v"(lo), "v"(hi)); return r; }
__device__ __forceinline__ unsigned f2bf(float f) { return cvt_pk_bf16(f, 0.f) & 0xffffu; }
__device__ __forceinline__ unsigned pk2(float lo, float hi) { return cvt_pk_bf16(lo, hi); }
__device__ __forceinline__ float bf2f(unsigned short b) { return __builtin_bit_cast(float, ((unsigned)b) << 16); }
__device__ __forceinline__ float bflo(unsigned w) { return __builtin_bit_cast(float, w << 16); }
__device__ __forceinline__ float bfhi(unsigned w) { return __builtin_bit_cast(float, w & 0xffff0000u); }
__device__ __forceinline__ float fsigm(float x) { return __builtin_amdgcn_rcpf(1.f + __builtin_amdgcn_exp2f(-1.44269504f * x)); }
__device__ __forceinline__ float lane_xor(float v, int m, int lane) { return __builtin_bit_cast(float, __builtin_amdgcn_ds_bpermute((lane ^ m) << 2, __builtin_bit_cast(int, v))); }
__device__ __forceinline__ int lane_get(int v, int src) { return __builtin_amdgcn_ds_bpermute(src << 2, v); }
__device__ __forceinline__ float wave_sum(float v, int lane) {
#pragma unroll
    for (int o = 1; o < 64; o <<= 1) v += lane_xor(v, o, lane);
    return v;
}

#define XB_TMO      128
#define XB_XCNT(j)  (256  + 64 * (j))
#define XB_XSUB(j)  (1280 + 64 * (j))
#define XB_XGEN(j)  (2304 + 64 * (j))
#define XB_TOP      3328
#define XB_TOPGEN   3392
#define XCD_BAR_WORDS 3456
#define XB_SPIN_CAP (1u << 18)
__device__ __forceinline__ unsigned xb_ld(unsigned* p)              { return __hip_atomic_load(p, __ATOMIC_RELAXED, __HIP_MEMORY_SCOPE_AGENT); }
__device__ __forceinline__ unsigned xb_add(unsigned* p, unsigned v) { return __hip_atomic_fetch_add(p, v, __ATOMIC_RELAXED, __HIP_MEMORY_SCOPE_AGENT); }
__device__ __forceinline__ unsigned xb_xcc_id() { return (unsigned)__builtin_amdgcn_s_getreg((3 << 11) | 20) & 0xFu; }
#define XB_SPIN(cond, bar) do { unsigned _sp = 0; while (cond) { __builtin_amdgcn_s_sleep(1); \
    if ((++_sp & 255u) == 0u) { if (xb_ld(&(bar)[XB_TMO])) break; if (_sp > XB_SPIN_CAP) { atomicAdd(&(bar)[XB_TMO], 1u); break; } } } } while (0)
struct XcdBarrier { unsigned* bar; unsigned x; volatile LAS unsigned* st; };
__device__ __forceinline__ XcdBarrier xcd_barrier_post(unsigned* bar, volatile LAS unsigned* st) {
    XcdBarrier b; b.bar = bar; b.x = xb_xcc_id(); b.st = st;
    if (threadIdx.x == 0) (void)xb_add(&bar[XB_XCNT(b.x)], 1u);
    return b;
}
__device__ __forceinline__ void xcd_barrier_complete(unsigned* bar, unsigned x, unsigned& nloc, unsigned& nx) {
    const unsigned G = gridDim.x * gridDim.y * gridDim.z;
    unsigned sum, cnt, mine, sp = 0u;
    for (;;) {
        sum = 0u; cnt = 0u; mine = 0u;
#pragma unroll
        for (unsigned j = 0; j < 16; ++j) { const unsigned c = xb_ld(&bar[XB_XCNT(j)]); sum += c; cnt += (c > 0u) ? 1u : 0u; mine = (j == x) ? c : mine; }
        if (sum == G) break;
        __builtin_amdgcn_s_sleep(1);
        if ((++sp & 255u) == 0u) { if (xb_ld(&bar[XB_TMO])) break; if (sp > XB_SPIN_CAP) { atomicAdd(&bar[XB_TMO], 1u); break; } }
    }
    nloc = mine > 0u ? mine : 1u; nx = cnt > 0u ? cnt : 1u;
}
__device__ __forceinline__ void xcd_barrier(const XcdBarrier& b, const int tid) {
    asm volatile("s_waitcnt vmcnt(0)" ::: "memory");
    unsigned blo = (unsigned)(unsigned long long)b.bar, bhi = (unsigned)((unsigned long long)b.bar >> 32), bx = b.x;
    asm volatile("" : "+s"(blo), "+s"(bhi), "+s"(bx));
    __syncthreads();
    if (tid == 0) {
        unsigned* bar = (unsigned*)(((unsigned long long)bhi << 32) | blo);
        __builtin_amdgcn_s_waitcnt(0);
        unsigned nloc = b.st[0], nx = b.st[1];
        if (nloc == 0u) { xcd_barrier_complete(bar, bx, nloc, nx); b.st[0] = nloc; b.st[1] = nx; }
        const unsigned old = xb_add(&bar[XB_XSUB(bx)], 1u);
        const unsigned gen = old / nloc;
        if (old + 1u == (gen + 1u) * nloc) {
            __builtin_amdgcn_fence(__ATOMIC_RELEASE, "agent");
            asm volatile("s_waitcnt vmcnt(0)" ::: "memory");
            const unsigned og = xb_add(&bar[XB_TOP], 1u);
            const unsigned tg = og / nx;
            if (og + 1u == (tg + 1u) * nx) xb_add(&bar[XB_TOPGEN], 1u);
            else XB_SPIN(xb_ld(&bar[XB_TOPGEN]) == tg, bar);
            __builtin_amdgcn_fence(__ATOMIC_ACQUIRE, "agent");
            xb_add(&bar[XB_XGEN(bx)], 1u);
            asm volatile("s_waitcnt vmcnt(0)" ::: "memory");
        } else {
            XB_SPIN(xb_ld(&bar[XB_XGEN(bx)]) == gen, bar);
            __builtin_amdgcn_fence(__ATOMIC_ACQUIRE, "agent");
            asm volatile("s_waitcnt vmcnt(0)" ::: "memory");
        }
    }
    __syncthreads();
}

namespace pg8 {
constexpr int BM = 256, BK = 64, HALF = 128, HTB = HALF * BK * 2, STAGE_BYTES = 8 * HTB, NXCD = 8, WGM = 8;
__host__ __device__ __forceinline__ int lds_byte(int r, int c) { const int st = (r >> 4) * 2 + (c >> 5), rr = r & 15, cc = c & 31, ob = rr * 64 + cc * 2; return st * 1024 + (ob ^ (((ob >> 9) & 1) << 5)); }
__host__ __device__ __forceinline__ void stage_rc(int b, int& R, int& C) { const int st = b / 1024, sb = b % 1024, swz = sb ^ (((sb >> 9) & 1) << 5); R = (st >> 1) * 16 + swz / 64; C = (st & 1) * 32 + (swz % 64) / 2; }
__host__ __device__ __forceinline__ int perm32(int rho) { const int n = rho >> 4, i = rho & 15; return 8 * (i >> 2) + 4 * n + (i & 3); }

struct Unit { int pm, pn, e, ui; };

typedef int i32x8 __attribute__((ext_vector_type(8)));
typedef int i32x4 __attribute__((ext_vector_type(4)));
__device__ __forceinline__ i32x8 cat8(bf16x8 a, bf16x8 b) { return __builtin_shufflevector(__builtin_bit_cast(i32x4, a), __builtin_bit_cast(i32x4, b), 0, 1, 2, 3, 4, 5, 6, 7); }
template <class Epi, class Sched, bool ALIGN_EPI = true, bool FP8 = false>
__device__ __forceinline__ void gemm_phase(LAS unsigned char* lds, const char* gA, const int Kb, const Sched& S, const Epi& E, const int tid) {
    const int wid = __builtin_amdgcn_readfirstlane(tid >> 6), lane = tid & 63, wr = wid >> 2, wc = wid & 3, fr = lane & 15, fq = lane >> 4;
    const int nt = Kb / (BK * 2);
    int Ra[2], Ca[2]; unsigned voffB[2];
#pragma unroll
    for (int i = 0; i < 2; ++i) { int R, C; stage_rc(tid * 16 + i * 8192, R, C); const int Rb = Epi::PERM ? ((R & ~31) + perm32(R & 31)) : R;
        Ra[i] = R; Ca[i] = C * 2; voffB[i] = (unsigned)(Rb * Kb + C * 2); }
    const size_t kstep = (size_t)(BK * 2);
    const size_t hstep = (size_t)HALF * Kb;
    const unsigned ldsw = (unsigned)wid * 1024u;
    const int aoff = lds_byte(wr * 64 + fr, fq * 8), boff = lds_byte(wc * 32 + fr, fq * 8);
#define PG8_SA(b, h) (((b) * 2 + (h)) * HTB)
#define PG8_SB(b, h) ((4 + (b) * 2 + (h)) * HTB)
#define PG8_STAGE(bufoff, gbase, voff) do { _Pragma("unroll") for (int _i = 0; _i < 2; ++_i) \
        __builtin_amdgcn_global_load_lds((const unsigned*)((const char*)(gbase) + (voff)[_i]), (LAS unsigned*)(lds + (bufoff) + ldsw + _i * 8192), 16, 0, 0); } while (0)
#define PG8_LDA(dst, b, h) do { _Pragma("unroll") for (int m = 0; m < 4; ++m) _Pragma("unroll") for (int k = 0; k < 2; ++k) dst[m][k] = *(const LAS bf16x8*)(lds + PG8_SA(b, h) + aoff + m * 2048 + k * 1024); } while (0)
#define PG8_LDB(dst, b, h) do { _Pragma("unroll") for (int n = 0; n < 2; ++n) _Pragma("unroll") for (int k = 0; k < 2; ++k) dst[n][k] = *(const LAS bf16x8*)(lds + PG8_SB(b, h) + boff + n * 2048 + k * 1024); } while (0)
#define PG8_MMA(ai, bj, At, Bt) do { __builtin_amdgcn_s_setprio(1); _Pragma("unroll") for (int m = 0; m < 4; ++m) _Pragma("unroll") for (int n = 0; n < 2; ++n) { \
        if constexpr (FP8) asm volatile("v_mfma_scale_f32_16x16x128_f8f6f4 %0, %1, %2, %0, %3, %3 op_sel_hi:[0,0,0]" : "+v"(acc[ai][bj][m][n]) : "v"(cat8(Bt[n][0], Bt[n][1])), "v"(cat8(At[m][0], At[m][1])), "v"(scl)); \
        else { _Pragma("unroll") for (int k = 0; k < 2; ++k) acc[ai][bj][m][n] = __builtin_amdgcn_mfma_f32_16x16x32_bf16(Bt[n][k], At[m][k], acc[ai][bj][m][n], 0, 0, 0); } } __builtin_amdgcn_s_setprio(0); } while (0)
#define PG8_WAIT_V(n) asm volatile("s_waitcnt vmcnt(" #n ")" ::: "memory")
#define PG8_WAIT_L(n) asm volatile("s_waitcnt lgkmcnt(" #n ")" ::: "memory")
#define PG8_BAR __builtin_amdgcn_s_barrier()
#define PG8_SCHED __builtin_amdgcn_sched_barrier(0)
    Unit cur, nxt; int ui = 0;
    if (!S.next(0, cur)) return;
    f32x4 acc[2][2][4][2];
#pragma unroll
    for (int a = 0; a < 2; ++a)
#pragma unroll
        for (int b = 0; b < 2; ++b)
#pragma unroll
            for (int m = 0; m < 4; ++m)
#pragma unroll
                for (int n = 0; n < 2; ++n) acc[a][b][m][n] = (f32x4){0.f, 0.f, 0.f, 0.f};
    bf16x8 At[4][2], B0[2][2], B1[2][2]; const int scl = 0x7f7f7f7f;
    unsigned vA[2][2];
#pragma unroll
    for (int h = 0; h < 2; ++h)
#pragma unroll
        for (int i = 0; i < 2; ++i) vA[h][i] = S.a_row_off(cur, h * HALF + Ra[i]) + (unsigned)Ca[i];
    const char* cB = S.b_tile(cur);
    PG8_STAGE(PG8_SB(0, 0), cB, voffB); PG8_STAGE(PG8_SB(0, 1), cB + hstep, voffB); PG8_STAGE(PG8_SA(0, 0), gA, vA[0]); PG8_STAGE(PG8_SA(0, 1), gA, vA[1]);
    if (wr == 1) PG8_BAR;
    PG8_WAIT_V(2); PG8_BAR;
    PG8_STAGE(PG8_SB(1, 0), cB + kstep, voffB); PG8_STAGE(PG8_SA(1, 0), gA + kstep, vA[0]); PG8_STAGE(PG8_SB(1, 1), cB + hstep + kstep, voffB);
    PG8_WAIT_V(6); PG8_BAR;
    for (;;) {
        const bool has_next = S.next(ui + 1, nxt);
        const char* nB = has_next ? S.b_tile(nxt) : cB;
        for (int t = 0; t < nt; t += 2) {
            const bool last = (t == nt - 2);
            unsigned tN[2][2];
#pragma unroll
            for (int h = 0; h < 2; ++h)
#pragma unroll
                for (int i = 0; i < 2; ++i) tN[h][i] = vA[h][i];
            if (last && has_next) {
#pragma unroll
                for (int h = 0; h < 2; ++h)
#pragma unroll
                    for (int i = 0; i < 2; ++i) tN[h][i] = S.a_row_off(nxt, h * HALF + Ra[i]) + (unsigned)Ca[i];
                PG8_WAIT_L(0);
            }
            const char* a1 = gA + (size_t)(t + 1) * kstep;
            const char* a2 = last ? gA : gA + (size_t)(t + 2) * kstep; const char* b2 = last ? nB : cB + (size_t)(t + 2) * kstep;
            const char* a3 = a2 + kstep; const char* b3 = b2 + kstep;
            PG8_LDB(B0, 0, 0); PG8_LDB(B1, 0, 1); PG8_SCHED; PG8_LDA(At, 0, 0); PG8_STAGE(PG8_SA(1, 1), a1, vA[1]);
#pragma unroll
            for (int h = 0; h < 2; ++h)
#pragma unroll
                for (int i = 0; i < 2; ++i) vA[h][i] = tN[h][i];
            PG8_WAIT_V(8); PG8_WAIT_L(0); PG8_BAR; PG8_MMA(0, 0, At, B0); PG8_MMA(0, 1, At, B1); PG8_BAR; PG8_SCHED;
            PG8_LDA(At, 0, 1); PG8_STAGE(PG8_SB(0, 0), b2, voffB); PG8_STAGE(PG8_SB(0, 1), b2 + hstep, voffB); PG8_STAGE(PG8_SA(0, 0), a2, vA[0]);
            PG8_WAIT_V(8); PG8_WAIT_L(0); PG8_BAR; PG8_MMA(1, 0, At, B0); PG8_MMA(1, 1, At, B1); PG8_BAR; PG8_SCHED;
            PG8_LDB(B0, 1, 0); PG8_LDB(B1, 1, 1); PG8_SCHED; PG8_LDA(At, 1, 0); PG8_STAGE(PG8_SA(0, 1), a2, vA[1]);
            PG8_WAIT_V(8); PG8_WAIT_L(0); PG8_BAR; PG8_MMA(0, 0, At, B0); PG8_MMA(0, 1, At, B1); PG8_BAR; PG8_SCHED;
            PG8_LDA(At, 1, 1); PG8_STAGE(PG8_SB(1, 0), b3, voffB); PG8_STAGE(PG8_SB(1, 1), b3 + hstep, voffB); PG8_STAGE(PG8_SA(1, 0), a3, vA[0]);
            PG8_WAIT_V(8); PG8_WAIT_L(0); PG8_BAR; PG8_MMA(1, 0, At, B0); PG8_MMA(1, 1, At, B1); PG8_BAR; PG8_SCHED;
        }
        if constexpr (ALIGN_EPI) { if (wr == 0) PG8_BAR; }
        if constexpr (FP8) asm volatile("s_nop 15\n\ts_nop 15" ::: "memory");
        E(acc, cur, wr, wc, fr, fq);
        if (!has_next) break;
#pragma unroll
        for (int a = 0; a < 2; ++a)
#pragma unroll
            for (int b = 0; b < 2; ++b)
#pragma unroll
                for (int m = 0; m < 4; ++m)
#pragma unroll
                    for (int n = 0; n < 2; ++n) acc[a][b][m][n] = (f32x4){0.f, 0.f, 0.f, 0.f};
        cur = nxt; cB = nB; ++ui;
        if constexpr (ALIGN_EPI) { if (wr == 1) PG8_BAR; }
    }
    PG8_WAIT_V(0);
    if constexpr (!ALIGN_EPI) { if (wr == 0) PG8_BAR; }
    PG8_BAR;
#undef PG8_SA
#undef PG8_SB
#undef PG8_STAGE
#undef PG8_LDA
#undef PG8_LDB
#undef PG8_MMA
#undef PG8_WAIT_V
#undef PG8_WAIT_L
#undef PG8_BAR
#undef PG8_SCHED
}
}
constexpr size_t MiB = 1u << 20;
constexpr int TP = T * 4 + NE * 256;
constexpr size_t WS_CTL = 0, CTL_ZERO_BYTES = 128 * 1024;
constexpr size_t WS_LB = 1 * MiB, WS_MOD = 1 * MiB + 65536;
constexpr size_t WS_WIN = 2 * MiB, WS_WOUT = 18 * MiB, WS_WF = 22 * MiB, WS_WGU = 24 * MiB, WS_WDN = 280 * MiB;
constexpr size_t WS_X = 408 * MiB, WS_H = 474 * MiB, WS_P = 508 * MiB, WS_CAT = 624 * MiB, WS_ROUTE = 658 * MiB, WS_ACT = 662 * MiB, WS_Y = 810 * MiB;
constexpr size_t WS_SU = 958 * MiB, WS_SS = 990 * MiB, WS_SD = 1022 * MiB, WS_YP = 1023 * MiB, WS_OSCR = 1040 * MiB, WS_H8 = 1072 * MiB, WS_CTXO = 1090 * MiB, WS_FASTEND = 1092 * MiB;
#ifndef MOE_FP8
#define MOE_FP8 1
#endif
constexpr float FP8_SH = 16.f, FP8_SW = 256.f, FP8_SA = 4.f;
constexpr size_t RT_TOPI = 0, RT_TOPW = 512 * 1024, RT_POS = 1024 * 1024, RT_LISTE = 1536 * 1024;
static_assert((size_t)T * 16 <= 512 * 1024 && RT_LISTE + (size_t)NE * T * 4 <= 4 * MiB, "route map");
static_assert(WS_WIN + (size_t)2 * DINX * D * 2 <= WS_WOUT && WS_WGU + (size_t)2 * NE * 2048 * 1024 * 2 <= WS_WDN && WS_WDN + (size_t)2 * NE * 1024 * 1024 * 2 <= WS_X && WS_X + (size_t)T * D * 4 <= WS_H && WS_H + (size_t)T * D * 2 <= WS_P &&
              WS_P + (size_t)T * DINX * 2 <= WS_CAT && WS_CAT + (size_t)T * D * 2 <= WS_ROUTE && WS_ACT + (size_t)TP * D * 2 <= WS_Y && WS_Y + (size_t)TP * D * 2 <= WS_SU &&
              WS_SD + (size_t)(8 * 64 * 128 + 8 * 16384) * 4 <= WS_YP && WS_YP + (size_t)128 * 128 * 2 * 256 * 2 <= WS_OSCR && WS_OSCR + (size_t)256 * 32768 * 4 <= WS_H8 && WS_H8 + (size_t)T * D <= WS_CTXO && WS_CTXO + (size_t)32 * 8192 * 4 <= WS_FASTEND, "ws map");
constexpr int CW_TMO = 0, CW_BAR = 4096, CW_CNT = 16384;
constexpr int RING_OFF = 0, RING_BYTES = 131072, TINFO_OFF = 131072, BT_OFF = 136192, ROWOFF_OFF = 136704, MISC_OFF = 146944, LDS_BYTES = 147456;
constexpr int NWAVES = 8, NTHR = 512;

struct Params { const float* in[22]; float* out; unsigned char* ws; };
constexpr int PTR_OFF = MISC_OFF + 64;
struct Frame {
    LAS unsigned char* lds; unsigned char* ws; int tid, lane, wave, vcu, G, bid;
    __device__ __forceinline__ const float* in(int i) const { const LAS unsigned* q = (const LAS unsigned*)(lds + PTR_OFF) + 2 * i;
        const unsigned lo = __builtin_amdgcn_readfirstlane(q[0]), hi = __builtin_amdgcn_readfirstlane(q[1]); return (const float*)(((unsigned long long)hi << 32) | lo); }
    __device__ __forceinline__ const float* x() const { return in(0); }        __device__ __forceinline__ const float* c() const { return in(1); }
    __device__ __forceinline__ const float* ctxin() const { return in(2); }    __device__ __forceinline__ const float* cctx() const { return in(3); }
    __device__ __forceinline__ const float* w_ada() const { return in(4); }    __device__ __forceinline__ const float* b_ada() const { return in(5); }
    __device__ __forceinline__ const float* norm1_g() const { return in(6); }  __device__ __forceinline__ const float* norm2_g() const { return in(7); }
    __device__ __forceinline__ const float* w_in() const { return in(8); }     __device__ __forceinline__ const float* lbp() const { return in(9); }
    __device__ __forceinline__ const float* hng() const { return in(10); }     __device__ __forceinline__ const float* pool_w() const { return in(11); }
    __device__ __forceinline__ const float* pool_s() const { return in(12); }  __device__ __forceinline__ const float* four_w() const { return in(13); }
    __device__ __forceinline__ const float* w_out() const { return in(14); }   __device__ __forceinline__ const float* router_w() const { return in(15); }
    __device__ __forceinline__ const float* router_b() const { return in(16); } __device__ __forceinline__ const float* w_gu() const { return in(17); }
    __device__ __forceinline__ const float* b_gu() const { return in(18); }    __device__ __forceinline__ const float* w_dn() const { return in(19); }
    __device__ __forceinline__ const float* b_dn() const { return in(20); }    __device__ __forceinline__ const float* fng() const { return in(21); }
    __device__ __forceinline__ float* out() const { return (float*)in(22); }
    __device__ __forceinline__ gu32* ctl() const { return (gu32*)(ws + WS_CTL); }
    __device__ __forceinline__ float* LB() const { return (float*)(ws + WS_LB); }       __device__ __forceinline__ float* MOD() const { return (float*)(ws + WS_MOD); }
    __device__ __forceinline__ float* X() const { return (float*)(ws + WS_X); }
    __device__ __forceinline__ bf16_t* Wt_in() const { return (bf16_t*)(ws + WS_WIN); }  __device__ __forceinline__ bf16_t* Wt_out() const { return (bf16_t*)(ws + WS_WOUT); }
    __device__ __forceinline__ bf16_t* Wt_gu() const { return (bf16_t*)(ws + WS_WGU); }  __device__ __forceinline__ bf16_t* Wt_dn() const { return (bf16_t*)(ws + WS_WDN); }
    __device__ __forceinline__ bf16_t* H() const { return (bf16_t*)(ws + WS_H); }        __device__ __forceinline__ bf16_t* P() const { return (bf16_t*)(ws + WS_P); }
    __device__ __forceinline__ bf16_t* CAT() const { return (bf16_t*)(ws + WS_CAT); }    __device__ __forceinline__ bf16_t* ACT() const { return (bf16_t*)(ws + WS_ACT); }
    __device__ __forceinline__ bf16_t* Y() const { return (bf16_t*)(ws + WS_Y); }
    __device__ __forceinline__ int* TOPI() const { return (int*)(ws + WS_ROUTE + RT_TOPI); }   __device__ __forceinline__ float* TOPW() const { return (float*)(ws + WS_ROUTE + RT_TOPW); }
    __device__ __forceinline__ int* POS() const { return (int*)(ws + WS_ROUTE + RT_POS); }     __device__ __forceinline__ int* LISTE() const { return (int*)(ws + WS_ROUTE + RT_LISTE); }
};
__device__ __forceinline__ void frame_init(Frame& F, const Params& p, unsigned char* lds) {
    F.lds = (LAS unsigned char*)lds; F.tid = threadIdx.x; F.lane = F.tid & 63; F.wave = __builtin_amdgcn_readfirstlane(F.tid >> 6);
    F.G = gridDim.x; F.bid = blockIdx.x; { const int bx = blockIdx.x; F.vcu = (F.G % 8 == 0) ? (bx % 8) * (F.G / 8) + bx / 8 : bx; }
    F.ws = p.ws;
    if (F.tid == 0) { LAS unsigned long long* tab = (LAS unsigned long long*)(F.lds + PTR_OFF);
#pragma unroll
        for (int i = 0; i < 22; ++i) tab[i] = (unsigned long long)p.in[i];
        tab[22] = (unsigned long long)p.out; }
    __syncthreads();
}

__device__ __forceinline__ Frame relaunder(const Frame& F) { Frame R = F; int ln; asm volatile("v_mbcnt_lo_u32_b32 %0, -1, 0\n\tv_mbcnt_hi_u32_b32 %0, -1, %0" : "=v"(ln));
    R.lane = ln; R.tid = F.wave * 64 + ln; unsigned wlo = (unsigned)(unsigned long long)F.ws, whi = (unsigned)((unsigned long long)F.ws >> 32);
    asm volatile("" : "+s"(wlo), "+s"(whi)); R.ws = (unsigned char*)(((unsigned long long)whi << 32) | wlo);
    int sw = F.wave, sv = F.vcu, sg = F.G, sb = F.bid;
    asm volatile("" : "+s"(sw), "+s"(sv), "+s"(sg), "+s"(sb));
    R.wave = sw; R.vcu = sv; R.G = sg; R.bid = sb; R.tid = sw * 64 + ln; return R; }

struct DenseOrder {
    int nM, nN, nwg, G, c, Kb, pm0; const char* Bt;
    __device__ void init(int nM_, int nN_, int G_, int c_, int Kb_, const bf16_t* Bt_, int pm0_ = 0) { nM = nM_; nN = nN_; nwg = nM * nN; G = G_; c = c_; Kb = Kb_; Bt = (const char*)Bt_; pm0 = pm0_; }
    __device__ __forceinline__ bool next(int i, pg8::Unit& u) const {
        const long L = (long)i * G + c; if (L >= nwg) return false;
        int wgid = (int)L; { const int q = nwg / pg8::NXCD, r = nwg % pg8::NXCD, xcd = wgid % pg8::NXCD, off = wgid / pg8::NXCD; wgid = (xcd < r ? xcd * (q + 1) : r * (q + 1) + (xcd - r) * q) + off; }
        const int nig = pg8::WGM * nN, gid = wgid / nig, fm = gid * pg8::WGM, gsz = (nM - fm) < pg8::WGM ? (nM - fm) : pg8::WGM;
        u.pm = pm0 + fm + ((wgid % nig) % gsz); u.pn = (wgid % nig) / gsz; u.e = 0; u.ui = i; return true;
    }
    __device__ __forceinline__ const char* b_tile(const pg8::Unit& u) const { return Bt + (size_t)u.pn * 256 * Kb; }
    __device__ __forceinline__ unsigned a_row_off(const pg8::Unit& u, int r) const { return (unsigned)(u.pm * 256 + r) * (unsigned)Kb; }
};
template <bool GATHER> struct MoeOrder {
    const LAS int* tinfo; const LAS unsigned* rowoff; int ntiles, nN, G, c, Kb; const char* W; size_t wstride;
    __device__ __forceinline__ bool next(int i, pg8::Unit& u) const {
        const int L = i * G + c; if (L >= ntiles * nN) return false;
        u.pm = L / nN; u.pn = L % nN; u.e = __builtin_amdgcn_readfirstlane(tinfo[4 * u.pm]); u.ui = i; return true;
    }
    __device__ __forceinline__ const char* b_tile(const pg8::Unit& u) const { return W + (size_t)u.e * wstride + (size_t)u.pn * 256 * Kb; }
    __device__ __forceinline__ unsigned a_row_off(const pg8::Unit& u, int r) const { if constexpr (GATHER) return rowoff[u.ui * 256 + r]; else return (unsigned)(u.pm * 256 + r) * (unsigned)Kb; }
};

__device__ __forceinline__ unsigned pk_f16(float a, float b) { const _Float16 x = (_Float16)a, y = (_Float16)b; return (unsigned)__builtin_bit_cast(unsigned short, x) | ((unsigned)__builtin_bit_cast(unsigned short, y) << 16); }
__device__ __forceinline__ float f16lo(unsigned w) { return (float)__builtin_bit_cast(_Float16, (unsigned short)(w & 0xffffu)); }
__device__ __forceinline__ float f16hi(unsigned w) { return (float)__builtin_bit_cast(_Float16, (unsigned short)(w >> 16)); }
struct EpiP {
    static constexpr bool PERM = true; bf16_t* O; int ldc; const float* lb;
    __device__ __forceinline__ void operator()(const f32x4 (&acc)[2][2][4][2], const pg8::Unit& u, int wr, int wc, int fr, int fq) const {
        const int row0 = u.pm * 256 + wr * 64 + fr, col0 = u.pn * 256 + wc * 32 + 8 * fq;
        const int mode = u.pn < 2 ? 1 : (u.pn < 6 ? 2 : ((u.pn == 8 || u.pn == 9) ? 3 : 0));
        f32x4 lbv[2][2];
        if (mode == 2) {
#pragma unroll
            for (int bj = 0; bj < 2; ++bj)
#pragma unroll
                for (int n = 0; n < 2; ++n) lbv[bj][n] = *(const f32x4*)(lb + (col0 - 512) + bj * 128 + 4 * n); }
#pragma unroll
        for (int ai = 0; ai < 2; ++ai)
#pragma unroll
            for (int m = 0; m < 4; ++m) { bf16_t* rowp = O + (size_t)(row0 + ai * 128 + m * 16) * ldc + col0;
#pragma unroll
                for (int bj = 0; bj < 2; ++bj) { f32x2 v[4]; { const f32x4 v0 = acc[ai][bj][m][0], v1 = acc[ai][bj][m][1]; v[0] = (f32x2){v0[0], v0[1]}; v[1] = (f32x2){v0[2], v0[3]}; v[2] = (f32x2){v1[0], v1[1]}; v[3] = (f32x2){v1[2], v1[3]}; }
                    u32x4 w;
                    if (mode != 0) {
                        f32x2 sg[4];
#pragma unroll
                        for (int p = 0; p < 4; ++p) { const f32x2 ex = v[p] * (-1.44269504f); f32x2 d; d.x = __builtin_amdgcn_exp2f(ex.x); d.y = __builtin_amdgcn_exp2f(ex.y); d = d + 1.0f; sg[p].x = __builtin_amdgcn_rcpf(d.x); sg[p].y = __builtin_amdgcn_rcpf(d.y); }
                        if (mode == 2) {
#pragma unroll
                            for (int p = 0; p < 4; ++p) { const f32x4 lv = lbv[bj][p >> 1]; const f32x2 lb2 = (f32x2){lv[2 * (p & 1)], lv[2 * (p & 1) + 1]}; const f32x2 f = lb2 + (1.0f - lb2) * sg[p];
                                v[p].x = __builtin_amdgcn_logf(fmaxf(f.x, 1e-30f)); v[p].y = __builtin_amdgcn_logf(fmaxf(f.y, 1e-30f)); }
                            w.x = pk_f16(v[0].x, v[0].y); w.y = pk_f16(v[1].x, v[1].y); w.z = pk_f16(v[2].x, v[2].y); w.w = pk_f16(v[3].x, v[3].y);
                        } else {
#pragma unroll
                            for (int p = 0; p < 4; ++p) v[p] = mode == 1 ? v[p] * sg[p] : sg[p];
                            w.x = cvt_pk_bf16(v[0].x, v[0].y); w.y = cvt_pk_bf16(v[1].x, v[1].y); w.z = cvt_pk_bf16(v[2].x, v[2].y); w.w = cvt_pk_bf16(v[3].x, v[3].y); }
                    } else { w.x = cvt_pk_bf16(v[0].x, v[0].y); w.y = cvt_pk_bf16(v[1].x, v[1].y); w.z = cvt_pk_bf16(v[2].x, v[2].y); w.w = cvt_pk_bf16(v[3].x, v[3].y); }
                    *(u32x4*)(rowp + bj * 128) = w; } }
    }
};
struct EpiRes {
    static constexpr bool PERM = false; const float* base_ctx; const float* base_lat; const float* gate_ctx; const float* gate_lat; float* Xo;
    __device__ __forceinline__ void operator()(const f32x4 (&acc)[2][2][4][2], const pg8::Unit& u, int wr, int wc, int fr, int fq) const {
        const int rt = wr * 64 + fr, col0 = u.pn * 256 + wc * 32 + 4 * fq;
        const float* base = (u.pm == 0 ? base_ctx : base_lat + (size_t)(u.pm - 1) * 256 * D) + (size_t)rt * D + col0; const float* gate = (u.pm == 0 ? gate_ctx : gate_lat) + col0;
        float* op = Xo + (size_t)(u.pm * 256 + rt) * D + col0;
#pragma unroll
        for (int bj = 0; bj < 2; ++bj)
#pragma unroll
            for (int n = 0; n < 2; ++n) { const f32x4 gv = *(const f32x4*)(gate + bj * 128 + n * 16);
#pragma unroll
                for (int ai = 0; ai < 2; ++ai) {
#pragma unroll
                    for (int m = 0; m < 4; ++m) { const size_t o = (size_t)(ai * 128 + m * 16) * D + bj * 128 + n * 16; const f32x4 b = *(const f32x4*)(base + o); *(f32x4*)(op + o) = b + gv * acc[ai][bj][m][n]; }
                    asm volatile("" ::: "memory"); } }
    }
};
struct EpiAct {
    static constexpr bool PERM = true; bf16_t* ACTo; const float* bias;
    __device__ __forceinline__ void operator()(const f32x4 (&acc)[2][2][4][2], const pg8::Unit& u, int wr, int wc, int fr, int fq) const {
        const int x0 = wc * 32 + 8 * fq; const float* bg = bias + (size_t)u.e * 2048 + 128 * u.pn + x0; const float* bu = bg + 1024;
        const f32x4 g0 = *(const f32x4*)bg, g1 = *(const f32x4*)(bg + 4), u0 = *(const f32x4*)bu, u1 = *(const f32x4*)(bu + 4);
#pragma unroll
        for (int ai = 0; ai < 2; ++ai)
#pragma unroll
            for (int m = 0; m < 4; ++m) { const int row = u.pm * 256 + ai * 128 + wr * 64 + m * 16 + fr;
                const f32x4 ga = acc[ai][0][m][0] + g0, gb = acc[ai][0][m][1] + g1, ua = acc[ai][1][m][0] + u0, ub = acc[ai][1][m][1] + u1; float r[8];
#pragma unroll
                for (int j = 0; j < 4; ++j) { const float g = fminf(ga[j], 7.f), up = fminf(fmaxf(ua[j], -7.f), 7.f); r[j] = (up + 1.f) * (g * fsigm(1.702f * g));
                                              const float g2 = fminf(gb[j], 7.f), up2 = fminf(fmaxf(ub[j], -7.f), 7.f); r[4 + j] = (up2 + 1.f) * (g2 * fsigm(1.702f * g2)); }
                u32x4 w; w.x = cvt_pk_bf16(r[0], r[1]); w.y = cvt_pk_bf16(r[2], r[3]); w.z = cvt_pk_bf16(r[4], r[5]); w.w = cvt_pk_bf16(r[6], r[7]);
                *(u32x4*)(ACTo + (size_t)row * D + 128 * u.pn + x0) = w; }
    }
};
struct EpiY {
    static constexpr bool PERM = true; bf16_t* Yo; const float* bias;
    __device__ __forceinline__ void operator()(const f32x4 (&acc)[2][2][4][2], const pg8::Unit& u, int wr, int wc, int fr, int fq) const {
        const int row0 = u.pm * 256 + wr * 64 + fr, col0 = u.pn * 256 + wc * 32 + 8 * fq; const float* bp = bias + (size_t)u.e * D + col0;
        f32x4 bv[2][2];
#pragma unroll
        for (int bj = 0; bj < 2; ++bj)
#pragma unroll
            for (int n = 0; n < 2; ++n) bv[bj][n] = *(const f32x4*)(bp + bj * 128 + 4 * n);
#pragma unroll
        for (int ai = 0; ai < 2; ++ai)
#pragma unroll
            for (int m = 0; m < 4; ++m) { bf16_t* rowp = Yo + (size_t)(row0 + ai * 128 + m * 16) * D + col0;
#pragma unroll
                for (int bj = 0; bj < 2; ++bj) { const f32x4 v0 = acc[ai][bj][m][0] + bv[bj][0], v1 = acc[ai][bj][m][1] + bv[bj][1];
                    u32x4 w; w.x = cvt_pk_bf16(v0[0], v0[1]); w.y = cvt_pk_bf16(v0[2], v0[3]); w.z = cvt_pk_bf16(v1[0], v1[1]); w.w = cvt_pk_bf16(v1[2], v1[3]);
                    *(u32x4*)(rowp + bj * 128) = w; } }
    }
};

__device__ __forceinline__ unsigned pk4_fp8(float a, float b, float c, float d) { int r = __builtin_amdgcn_cvt_pk_fp8_f32(a, b, 0, false); r = __builtin_amdgcn_cvt_pk_fp8_f32(c, d, r, true); return (unsigned)r; }
struct EpiAct8 {
    static constexpr bool PERM = true; unsigned char* ACTo; const float* bias;
    __device__ __forceinline__ void operator()(const f32x4 (&acc)[2][2][4][2], const pg8::Unit& u, int wr, int wc, int fr, int fq) const {
        const int x0 = wc * 32 + 8 * fq; const float* bg = bias + (size_t)u.e * 2048 + 128 * u.pn + x0; const float* bu = bg + 1024; constexpr float isc = 1.f / (FP8_SH * FP8_SW);
        f32x2 g[4], v[4];
#pragma unroll
        for (int p = 0; p < 4; ++p) { g[p] = *(const f32x2*)(bg + 2 * p); v[p] = *(const f32x2*)(bu + 2 * p); }
#pragma unroll
        for (int ai = 0; ai < 2; ++ai)
#pragma unroll
            for (int m = 0; m < 4; ++m) { const int row = u.pm * 256 + ai * 128 + wr * 64 + m * 16 + fr; f32x2 r[4];
#pragma unroll
                for (int p = 0; p < 4; ++p) { const f32x4 ga4 = acc[ai][0][m][p >> 1], ua4 = acc[ai][1][m][p >> 1];
                    f32x2 gg = (f32x2){ga4[2 * (p & 1)], ga4[2 * (p & 1) + 1]} * isc + g[p], uu = (f32x2){ua4[2 * (p & 1)], ua4[2 * (p & 1) + 1]} * isc + v[p];
                    gg.x = fminf(gg.x, 7.f); gg.y = fminf(gg.y, 7.f); uu.x = __builtin_amdgcn_fmed3f(uu.x, -7.f, 7.f); uu.y = __builtin_amdgcn_fmed3f(uu.y, -7.f, 7.f);
                    const f32x2 ex = gg * (-1.702f * 1.44269504f); f32x2 d; d.x = __builtin_amdgcn_exp2f(ex.x); d.y = __builtin_amdgcn_exp2f(ex.y); d = d + 1.0f;
                    f32x2 rc; rc.x = __builtin_amdgcn_rcpf(d.x); rc.y = __builtin_amdgcn_rcpf(d.y);
                    r[p] = (uu * FP8_SA + FP8_SA) * (gg * rc); }
                u32x2 w; w.x = pk4_fp8(r[0].x, r[0].y, r[1].x, r[1].y); w.y = pk4_fp8(r[2].x, r[2].y, r[3].x, r[3].y);
                *(u32x2*)(ACTo + (size_t)row * D + 128 * u.pn + x0) = w; }
    }
};
struct EpiY8 {
    static constexpr bool PERM = true; bf16_t* Yo; const float* bias;
    __device__ __forceinline__ void operator()(const f32x4 (&acc)[2][2][4][2], const pg8::Unit& u, int wr, int wc, int fr, int fq) const {
        const int row0 = u.pm * 256 + wr * 64 + fr, col0 = u.pn * 256 + wc * 32 + 8 * fq; const float* bp = bias + (size_t)u.e * D + col0; constexpr float isc = 1.f / (FP8_SA * FP8_SW);
        f32x4 bv[2][2];
#pragma unroll
        for (int bj = 0; bj < 2; ++bj)
#pragma unroll
            for (int n = 0; n < 2; ++n) bv[bj][n] = *(const f32x4*)(bp + bj * 128 + 4 * n);
#pragma unroll
        for (int ai = 0; ai < 2; ++ai)
#pragma unroll
            for (int m = 0; m < 4; ++m) { bf16_t* rowp = Yo + (size_t)(row0 + ai * 128 + m * 16) * D + col0;
#pragma unroll
                for (int bj = 0; bj < 2; ++bj) { const f32x4 v0 = acc[ai][bj][m][0] * isc + bv[bj][0], v1 = acc[ai][bj][m][1] * isc + bv[bj][1];
                    u32x4 w; w.x = cvt_pk_bf16(v0[0], v0[1]); w.y = cvt_pk_bf16(v0[2], v0[3]); w.z = cvt_pk_bf16(v1[0], v1[1]); w.w = cvt_pk_bf16(v1[2], v1[3]);
                    *(u32x4*)(rowp + bj * 128) = w; } }
    }
};

struct CvtJob { const float* W; bf16_t* WT; int N, K, k0, n0, nrow0; };
__device__ __forceinline__ void cvt_load(const CvtJob& j, int lane, f32x4 (&r)[16]) { const GAS f32x4* src = (const GAS f32x4*)((const GAS float*)j.W + (unsigned)((j.k0 + 8 * (lane >> 3)) * j.N + j.n0 + 8 * (lane & 7)));
    const unsigned rs = (unsigned)j.N >> 2;
#pragma unroll
    for (int i = 0; i < 8; ++i) { r[2 * i] = src[i * rs]; r[2 * i + 1] = src[i * rs + 1]; } }
__device__ __forceinline__ void cvt_store(const CvtJob& j, int lane, const f32x4 (&r)[16]) {
    u32x4 b[8];
#pragma unroll
    for (int i = 0; i < 8; ++i) { b[i].x = cvt_pk_bf16(r[2 * i][0], r[2 * i][1]); b[i].y = cvt_pk_bf16(r[2 * i][2], r[2 * i][3]); b[i].z = cvt_pk_bf16(r[2 * i + 1][0], r[2 * i + 1][1]); b[i].w = cvt_pk_bf16(r[2 * i + 1][2], r[2 * i + 1][3]); }
    GAS u32x4* dst = (GAS u32x4*)((GAS bf16_t*)j.WT + (unsigned)((j.nrow0 + 8 * (lane & 7)) * j.K + j.k0 + 8 * (lane >> 3))); const unsigned rs = (unsigned)j.K >> 3;
#pragma unroll
    for (int q = 0; q < 8; ++q) { const unsigned sel = (q & 1) ? 0x07060302u : 0x05040100u; u32x4 o;
        o.x = __builtin_amdgcn_perm(b[1][q >> 1], b[0][q >> 1], sel); o.y = __builtin_amdgcn_perm(b[3][q >> 1], b[2][q >> 1], sel);
        o.z = __builtin_amdgcn_perm(b[5][q >> 1], b[4][q >> 1], sel); o.w = __builtin_amdgcn_perm(b[7][q >> 1], b[6][q >> 1], sel);
        dst[q * rs] = o; } }
__device__ __forceinline__ void cvt8_load(const CvtJob& j, int lane, f32x4 (&r)[16]) { const GAS f32x4* src = (const GAS f32x4*)((const GAS float*)j.W + (unsigned)((j.k0 + 16 * (lane >> 3)) * j.N + j.n0 + 4 * (lane & 7)));
    const unsigned rs = (unsigned)j.N >> 2;
#pragma unroll
    for (int i = 0; i < 16; ++i) r[i] = src[i * rs]; }
__device__ __forceinline__ void cvt8_store(const CvtJob& j, int lane, const f32x4 (&r)[16]) {
    GAS u32x4* dst = (GAS u32x4*)((GAS unsigned char*)j.WT + (unsigned)((j.nrow0 + 4 * (lane & 7)) * j.K + j.k0 + 16 * (lane >> 3))); const unsigned rs = (unsigned)j.K >> 4;
#pragma unroll
    for (int n = 0; n < 4; ++n) { u32x4 o;
        o.x = pk4_fp8(r[0][n] * FP8_SW, r[1][n] * FP8_SW, r[2][n] * FP8_SW, r[3][n] * FP8_SW); o.y = pk4_fp8(r[4][n] * FP8_SW, r[5][n] * FP8_SW, r[6][n] * FP8_SW, r[7][n] * FP8_SW);
        o.z = pk4_fp8(r[8][n] * FP8_SW, r[9][n] * FP8_SW, r[10][n] * FP8_SW, r[11][n] * FP8_SW); o.w = pk4_fp8(r[12][n] * FP8_SW, r[13][n] * FP8_SW, r[14][n] * FP8_SW, r[15][n] * FP8_SW);
        dst[n * rs] = o; } }
constexpr int NB_IN = (FQ_OFF < DIN ? FQ_OFF : DIN) / 64, I_IN = 16 * NB_IN, I_OUT = 16 * 16, I_GU = MOE_FP8 ? 8 * 64 : 16 * 32, I_DN = MOE_FP8 ? 8 * 32 : 16 * 16;
constexpr int N_IN = 2 * I_IN, N_OUT = 2 * I_OUT, N_GU = 2 * NE * I_GU, N_DN = 2 * NE * I_DN, N_CVT = N_IN + N_OUT + N_GU + N_DN;
__device__ __forceinline__ CvtJob cvt_job(const Frame& F, int it, bool& f8) {
    CvtJob j; int r = it; f8 = false;
    if (r < N_IN) { const int l = r / I_IN, q = r % I_IN, kb = q / NB_IN, nb = q % NB_IN; j = CvtJob{F.w_in() + (size_t)l * D * DIN, F.Wt_in() + (size_t)l * DINX * D, DIN, D, 64 * kb, 64 * nb, 64 * nb}; return j; } r -= N_IN;
    if (r < N_OUT) { const int l = r / I_OUT, q = r % I_OUT, kb = q >> 4, nb = q & 15; j = CvtJob{F.w_out() + (size_t)l * D * D, F.Wt_out() + (size_t)l * D * D, D, D, 64 * kb, 64 * nb, 64 * nb}; return j; } r -= N_OUT;
    f8 = MOE_FP8;
    if (r < N_GU) { const int le = r / I_GU, q = r % I_GU; const int kb = MOE_FP8 ? q >> 6 : q >> 5, nb = MOE_FP8 ? q & 63 : q & 31; const int n0 = (MOE_FP8 ? 32 : 64) * nb, bj = n0 >> 10, xx = n0 & 1023;
        j = CvtJob{F.w_gu() + (size_t)le * D * 2048, (bf16_t*)((unsigned char*)F.Wt_gu() + (size_t)le * 2048 * D * (MOE_FP8 ? 1 : 2)), 2048, D, (MOE_FP8 ? 128 : 64) * kb, n0, 256 * (xx >> 7) + 128 * bj + (xx & 127)}; return j; } r -= N_GU;
    { const int le = r / I_DN, q = r % I_DN; const int kb = MOE_FP8 ? q >> 5 : q >> 4, nb = MOE_FP8 ? q & 31 : q & 15; const int n0 = (MOE_FP8 ? 32 : 64) * nb;
      j = CvtJob{F.w_dn() + (size_t)le * D * D, (bf16_t*)((unsigned char*)F.Wt_dn() + (size_t)le * D * D * (MOE_FP8 ? 1 : 2)), D, D, (MOE_FP8 ? 128 : 64) * kb, n0, n0}; return j; }
}
__device__ __forceinline__ void cvt_ld(const CvtJob& j, bool f8, int lane, f32x4 (&r)[16]) { if (f8) cvt8_load(j, lane, r); else cvt_load(j, lane, r); }
__device__ __forceinline__ void cvt_st(const CvtJob& j, bool f8, int lane, const f32x4 (&r)[16]) { if (f8) cvt8_store(j, lane, r); else cvt_store(j, lane, r); }
constexpr int WIN_UNITS = (T / 256) * (DINX / 256), WIN_BUSY = WIN_UNITS % 256, DEF_WIN = MOE_FP8 ? 3 : 0, DEF_WOUT = MOE_FP8 ? 3 : 0;
constexpr int DEF_A = (256 - WIN_BUSY) * NWAVES * DEF_WIN, DEF_B = (256 - 4) * NWAVES * DEF_WOUT, DEF_C = DEF_A, DEF_TOTAL = DEF_A + DEF_B + DEF_C;
constexpr int CVT_GU0 = N_IN + N_OUT, CVT_GU1 = CVT_GU0 + NE * I_GU;
static_assert(DEF_A + DEF_B <= NE * I_GU && DEF_C <= NE * I_GU, "deferred slices inside one layer's gate/up items");
__device__ __forceinline__ int cvt_remap(int j) { int it = j; if (it >= CVT_GU0) it += DEF_A + DEF_B; if (it >= CVT_GU1) it += DEF_C; return it; }
__device__ __forceinline__ void cvt_run(Frame& F, int first, int stride, int limit, bool remap) {
    int it = first; if (it >= limit) return;
    f32x4 ra[16], rb[16]; bool fa, fb = false; CvtJob ja = cvt_job(F, remap ? cvt_remap(it) : it, fa), jb; cvt_ld(ja, fa, F.lane, ra);
    for (;;) {
        const int itb = it + stride; const bool hb = itb < limit; if (hb) { jb = cvt_job(F, remap ? cvt_remap(itb) : itb, fb); cvt_ld(jb, fb, F.lane, rb); }
        cvt_st(ja, fa, F.lane, ra); if (!hb) break;
        const int ita = itb + stride; const bool ha = ita < limit; if (ha) { ja = cvt_job(F, remap ? cvt_remap(ita) : ita, fa); cvt_ld(ja, fa, F.lane, ra); }
        cvt_st(jb, fb, F.lane, rb); if (!ha) break;
        it = ita;
    }
}
__device__ __forceinline__ void cvt_deferred(Frame& F, int base, int slot, int per_wave) { if (per_wave == 0) return; const int first = base + (slot * NWAVES + F.wave) * per_wave; cvt_run(F, first, 1, first + per_wave, false); }
__device__ __forceinline__ void ph_prologue(Frame& F) {
    const int gw = F.vcu * NWAVES + F.wave, NGW = F.G * NWAVES;
    for (int i = gw * 64 + F.lane; i < 1024; i += NGW * 64) { const float a = F.lbp()[i], b = F.lbp()[1024 + i], m = fmaxf(a, b), ea = __expf(a - m), eb = __expf(b - m); F.LB()[i] = 0.f; F.LB()[1024 + i] = eb / (ea + eb); }
    if (F.bid < 192) {
        LAS float* sc = (LAS float*)(F.lds); LAS float* part = sc + 2048;
        { const float* c = F.c(); const float* cc = F.cctx(); for (int i = F.tid; i < D; i += NTHR) { const float a = c[i], b = cc[i]; sc[i] = a * fsigm(a); sc[D + i] = b * fsigm(b); } }
        __syncthreads();
        const int l = F.bid / 96, jcol = (F.bid % 96) * 64 + F.lane; const GAS float* W = (const GAS float*)F.w_ada() + (unsigned)(l * D * 6144 + (128 * F.wave) * 6144 + jcol); float a0 = 0.f, a1 = 0.f;
#pragma unroll 16
        for (int i = 0; i < 128; ++i) { const float w = W[(unsigned)i * 6144u]; a0 += sc[128 * F.wave + i] * w; a1 += sc[D + 128 * F.wave + i] * w; }
        part[(F.wave * 2 + 0) * 64 + F.lane] = a0; part[(F.wave * 2 + 1) * 64 + F.lane] = a1;
        __syncthreads();
        if (F.tid < 128) { const int which = F.tid >> 6, col = F.tid & 63; float s = 0.f;
#pragma unroll
            for (int w = 0; w < 8; ++w) s += part[(w * 2 + which) * 64 + col];
            const int j = (F.bid % 96) * 64 + col; F.MOD()[(size_t)(l * 2 + which) * 6144 + j] = s + F.b_ada()[l * 6144 + j]; }
        __syncthreads();
    }
    cvt_run(F, gw, NGW, N_CVT - DEF_TOTAL, true);
}
__device__ __forceinline__ void row_load(const float* xrow, int lane, f32x4 (&v)[4]) { const GAS f32x4* xr = (const GAS f32x4*)xrow + lane;
#pragma unroll
    for (int j = 0; j < 4; ++j) v[j] = xr[64 * j]; }
__device__ __forceinline__ float row_rstd(const f32x4 (&v)[4], int lane) { float s = 0.f;
#pragma unroll
    for (int j = 0; j < 4; ++j) s += (v[j].x * v[j].x + v[j].y * v[j].y) + (v[j].z * v[j].z + v[j].w * v[j].w);
    return rsqrtf(wave_sum(s, lane) * (1.f / D) + 1e-6f); }
__device__ __forceinline__ void row_modulate(const f32x4 (&v)[4], float r, const float* g, const float* sc, const float* sh, int lane, f32x4 (&hv)[4]) {
#pragma unroll
    for (int j = 0; j < 4; ++j) { const f32x4 gg = ((const GAS f32x4*)g)[lane + 64 * j], s1 = ((const GAS f32x4*)sc)[lane + 64 * j], s0 = ((const GAS f32x4*)sh)[lane + 64 * j];
        hv[j] = v[j] * r * gg * (s1 + 1.f) + s0; } }
__device__ __forceinline__ void row_store_fp8(unsigned char* orow, int lane, const f32x4 (&hv)[4]) { GAS unsigned* o4 = (GAS unsigned*)orow + lane;
#pragma unroll
    for (int j = 0; j < 4; ++j) o4[64 * j] = pk4_fp8(hv[j].x * FP8_SH, hv[j].y * FP8_SH, hv[j].z * FP8_SH, hv[j].w * FP8_SH); }
__device__ __forceinline__ void row_store_bf16(bf16_t* orow, int lane, const f32x4 (&hv)[4]) { GAS u32x2* o8 = (GAS u32x2*)orow + lane;
#pragma unroll
    for (int j = 0; j < 4; ++j) { u32x2 w; w.x = pk2(hv[j].x, hv[j].y); w.y = pk2(hv[j].z, hv[j].w); o8[64 * j] = w; } }

__device__ __forceinline__ void ph_mod1(Frame& F, int l) {
    const int gw = F.vcu * NWAVES + F.wave, NGW = F.G * NWAVES;
    for (int row = gw; row < T; row += NGW) {
        const float* xr = l == 0 ? (row < CTX ? F.ctxin() + (size_t)row * D : F.x() + (size_t)(row - CTX) * D) : F.X() + (size_t)row * D;
        const float* m = F.MOD() + (size_t)(l * 2 + (row < CTX ? 1 : 0)) * 6144;
        f32x4 v[4], hv[4]; row_load(xr, F.lane, v); const float r = row_rstd(v, F.lane); row_modulate(v, r, F.norm1_g() + l * D, m + D, m, F.lane, hv); row_store_bf16(F.H() + (size_t)row * D, F.lane, hv);
    }
}

constexpr int RW_STRIDE = 1028, RSCR_OFF = 32 * RW_STRIDE * 4;
static_assert(RSCR_OFF + 4096 <= MISC_OFF, "router LDS map");
__device__ __forceinline__ void route_top4(float (&part)[16], float bias, int lane, float (&vals)[4], int (&idx)[4]) {
#pragma unroll
    for (int st = 1; st < 5; ++st) { const int M = 32 >> st, n = 16 >> st; const bool up = (lane & M) != 0;
#pragma unroll
        for (int i = 0; i < n; ++i) { float x = part[i], y = part[i + n]; asm volatile("" : "+v"(x), "+v"(y));
            const float keep = up ? y : x, send = up ? x : y; part[i] = keep + lane_xor(send, M, lane); } }
    const float lg = part[0] + lane_xor(part[0], 1, lane) + bias;
    const int e = (lane >> 1) & 31; unsigned u = __builtin_bit_cast(unsigned, lg); u = (u & 0x80000000u) ? ~u : (u | 0x80000000u); unsigned key = (u & ~31u) | (unsigned)(31 - e);
#pragma unroll
    for (int s = 0; s < 4; ++s) { unsigned m = key;
#pragma unroll
        for (int d = 2; d < 64; d <<= 1) { const unsigned o = (unsigned)__builtin_amdgcn_ds_bpermute((lane ^ d) << 2, (int)m); m = o > m ? o : m; }
        const int bi = 31 - (int)(m & 31u); const unsigned vb = m & ~31u, ub = (vb & 0x80000000u) ? (vb & 0x7fffffffu) : ~vb;
        idx[s] = bi; vals[s] = __builtin_bit_cast(float, ub); key = (e == bi) ? 0u : key; }
}
__device__ __forceinline__ void ph_mod2_route(Frame& F, int l, int cbank) {
    LAS float* rwT = (LAS float*)(F.lds + RING_OFF);
    LAS int* lcnt = (LAS int*)(F.lds + RSCR_OFF); LAS int* lbase = lcnt + 32; LAS int* te = lbase + 32; LAS float* tw = (LAS float*)(te + 272); LAS int* trk = (LAS int*)(tw + 272);
    const GAS float* rw = (const GAS float*)F.router_w() + (unsigned)(l * D * NE);
    __syncthreads();
    for (int i = F.tid; i < 256 * 32; i += NTHR) { const int e = i & 31, k4 = i >> 5; f32x4 v; v[0] = rw[(4 * k4 + 0) * NE + e]; v[1] = rw[(4 * k4 + 1) * NE + e]; v[2] = rw[(4 * k4 + 2) * NE + e]; v[3] = rw[(4 * k4 + 3) * NE + e];
        *(LAS f32x4*)(rwT + e * RW_STRIDE + 4 * k4) = v; }
    if (F.tid < 32) lcnt[F.tid] = 0;
    __syncthreads();
    const int row0 = F.bid * 65;
    const float bias = F.router_b()[l * NE + ((F.lane >> 1) & 31)];
    const float* Xp = F.X(); const float* n2g = F.norm2_g() + l * D; const float* modl = F.MOD() + (size_t)(l * 2) * 6144; bf16_t* Hp = F.H(); unsigned char* H8p = F.ws + WS_H8;
#pragma unroll 1
    for (int pi = F.wave; pi < 33; pi += NWAVES) {
        const int ria = 2 * pi, rib = min(2 * pi + 1, 64); const bool hasb = 2 * pi + 1 < 65; const int ra = row0 + ria, rb = row0 + rib;
        int ln = F.lane; asm volatile("" : "+v"(ln));
        f32x4 va[4], vb[4]; row_load(Xp + (size_t)ra * D, ln, va); row_load(Xp + (size_t)rb * D, ln, vb);
        f32x4 ha[4], hb[4];
        { const float* m = modl + (ra < CTX ? 6144 : 0); const float r = row_rstd(va, ln); row_modulate(va, r, n2g, m + 4 * D, m + 3 * D, ln, ha); if (MOE_FP8) row_store_fp8(H8p + (size_t)ra * D, ln, ha); else row_store_bf16(Hp + (size_t)ra * D, ln, ha); }
        { const float* m = modl + (rb < CTX ? 6144 : 0); const float r = row_rstd(vb, ln); row_modulate(vb, r, n2g, m + 4 * D, m + 3 * D, ln, hb); if (hasb) { if (MOE_FP8) row_store_fp8(H8p + (size_t)rb * D, ln, hb); else row_store_bf16(Hp + (size_t)rb * D, ln, hb); } }
        float pa[16], pb[16]; const bool up32 = (ln & 32) != 0;
#pragma unroll
        for (int i = 0; i < 16; ++i) { f32x4 A0 = (f32x4){0.f, 0.f, 0.f, 0.f}, B0 = A0, A1 = A0, B1 = A0;
#pragma unroll
            for (int j = 0; j < 4; ++j) { const f32x4 w0 = *(const LAS f32x4*)(rwT + i * RW_STRIDE + 4 * ln + 256 * j), w1 = *(const LAS f32x4*)(rwT + (i + 16) * RW_STRIDE + 4 * ln + 256 * j);
                A0 += ha[j] * w0; B0 += hb[j] * w0; A1 += ha[j] * w1; B1 += hb[j] * w1; }
            const float sa0 = (A0[0] + A0[1]) + (A0[2] + A0[3]), sb0 = (B0[0] + B0[1]) + (B0[2] + B0[3]), sa1 = (A1[0] + A1[1]) + (A1[2] + A1[3]), sb1 = (B1[0] + B1[1]) + (B1[2] + B1[3]);
            pa[i] = (up32 ? sa1 : sa0) + lane_xor(up32 ? sa0 : sa1, 32, ln); pb[i] = (up32 ? sb1 : sb0) + lane_xor(up32 ? sb0 : sb1, 32, ln);
            if (i & 1) __builtin_amdgcn_sched_barrier(0); }
        float vals[4]; int idx[4];
        route_top4(pa, bias, ln, vals, idx);
        if (ln == 0) { float ex[4], sum = 0.f;
#pragma unroll
            for (int s = 0; s < 4; ++s) { ex[s] = __expf(vals[s] - vals[0]); sum += ex[s]; }
            const float inv = 1.f / sum;
#pragma unroll
            for (int s = 0; s < 4; ++s) { te[ria * 4 + s] = idx[s]; tw[ria * 4 + s] = ex[s] * inv; trk[ria * 4 + s] = (int)__hip_atomic_fetch_add((LAS unsigned*)&lcnt[idx[s]], 1u, __ATOMIC_RELAXED, __HIP_MEMORY_SCOPE_WORKGROUP); } }
        route_top4(pb, bias, ln, vals, idx);
        if (ln == 0 && hasb) { float ex[4], sum = 0.f;
#pragma unroll
            for (int s = 0; s < 4; ++s) { ex[s] = __expf(vals[s] - vals[0]); sum += ex[s]; }
            const float inv = 1.f / sum;
#pragma unroll
            for (int s = 0; s < 4; ++s) { te[rib * 4 + s] = idx[s]; tw[rib * 4 + s] = ex[s] * inv; trk[rib * 4 + s] = (int)__hip_atomic_fetch_add((LAS unsigned*)&lcnt[idx[s]], 1u, __ATOMIC_RELAXED, __HIP_MEMORY_SCOPE_WORKGROUP); } }
    }
    __syncthreads();
    if (F.tid < 32) lbase[F.tid] = (int)__hip_atomic_fetch_add((unsigned*)(F.ctl() + CW_CNT + (cbank * 32 + F.tid) * 64), (unsigned)lcnt[F.tid], RLX_AGENT);
    __syncthreads();
    for (int i = F.tid; i < 65 * 4; i += NTHR) { const int row = row0 + (i >> 2), e = te[i], pos = lbase[e] + trk[i];
        F.TOPI()[row * 4 + (i & 3)] = e; F.TOPW()[row * 4 + (i & 3)] = tw[i]; F.POS()[row * 4 + (i & 3)] = pos; F.LISTE()[(size_t)e * T + pos] = row; }
    __syncthreads();
}

__device__ __forceinline__ int moe_tiles(Frame& F, int l) {
    LAS int* tinfo = (LAS int*)(F.lds + TINFO_OFF); LAS int* bt = (LAS int*)(F.lds + BT_OFF); LAS int* cn = bt + 32; LAS int* ntl = bt + 64;
    __syncthreads();
    if (F.tid < 64) {
        const int e = F.lane & 31; const int c = (int)__hip_atomic_load(F.ctl() + CW_CNT + (l * 32 + e) * 64, RLX_AGENT); const int nt = (c + 255) >> 8;
        int incl = nt;
#pragma unroll
        for (int o = 1; o < 32; o <<= 1) { const int t = lane_get(incl, (F.lane - o) & 63); if (e >= o) incl += t; }
        const int first = incl - nt;
        if (F.lane < 32) { bt[e] = first; cn[e] = c; for (int j = 0; j < nt; ++j) { LAS int* ti = tinfo + 4 * (first + j); ti[0] = e; ti[1] = 0; ti[2] = 256 * j; ti[3] = min(256, c - 256 * j); } if (e == 31) ntl[0] = incl; }
    }
    __syncthreads();
    return ntl[0];
}

__device__ __forceinline__ void ph_gateup(Frame& F, int l) {
    const int ntiles = moe_tiles(F, l); constexpr int EB = MOE_FP8 ? 1 : 2;
    LAS int* tinfo = (LAS int*)(F.lds + TINFO_OFF); LAS unsigned* rowoff = (LAS unsigned*)(F.lds + ROWOFF_OFF);
    MoeOrder<true> S; S.tinfo = tinfo; S.rowoff = rowoff; S.ntiles = ntiles; S.nN = 8; S.G = F.G; S.c = F.vcu; S.Kb = D * EB; S.W = (const char*)F.Wt_gu() + (size_t)l * NE * 2048 * D * EB; S.wstride = (size_t)2048 * D * EB;
    for (int i = 0;; ++i) { pg8::Unit u; if (!S.next(i, u) || i >= 10) break;
        if (F.tid < 256) { const int pos0 = tinfo[4 * u.pm + 2], valid = tinfo[4 * u.pm + 3]; const int tok = F.tid < valid ? F.LISTE()[(size_t)u.e * T + pos0 + F.tid] : 0; rowoff[i * 256 + F.tid] = (unsigned)tok * (unsigned)(D * EB); } }
    __syncthreads();
    if constexpr (MOE_FP8) { EpiAct8 E{(unsigned char*)F.ACT(), F.b_gu() + (size_t)l * NE * 2048};
        pg8::gemm_phase<EpiAct8, MoeOrder<true>, true, true>(F.lds + RING_OFF, (const char*)(F.ws + WS_H8), D, S, E, F.tid); }
    else { EpiAct E{F.ACT(), F.b_gu() + (size_t)l * NE * 2048};
        pg8::gemm_phase<EpiAct, MoeOrder<true>, true, false>(F.lds + RING_OFF, (const char*)F.H(), 2 * D, S, E, F.tid); }
}
__device__ __forceinline__ void ph_down(Frame& F, int l) {
    const int ntiles = moe_tiles(F, l); constexpr int EB = MOE_FP8 ? 1 : 2;
    MoeOrder<false> S; S.tinfo = (LAS int*)(F.lds + TINFO_OFF); S.rowoff = nullptr; S.ntiles = ntiles; S.nN = 4; S.G = F.G; S.c = F.vcu; S.Kb = D * EB; S.W = (const char*)F.Wt_dn() + (size_t)l * NE * D * D * EB; S.wstride = (size_t)D * D * EB;
    if constexpr (MOE_FP8) { EpiY8 E{F.Y(), F.b_dn() + (size_t)l * NE * D};
        pg8::gemm_phase<EpiY8, MoeOrder<false>, true, true>(F.lds + RING_OFF, (const char*)F.ACT(), D, S, E, F.tid); }
    else { EpiY E{F.Y(), F.b_dn() + (size_t)l * NE * D};
        pg8::gemm_phase<EpiY, MoeOrder<false>, true, false>(F.lds + RING_OFF, (const char*)F.ACT(), 2 * D, S, E, F.tid); }
}
__device__ __forceinline__ void ph_win(Frame& F, int l) {
    DenseOrder S; S.init(T / 256, DINX / 256, F.G, F.bid, 2 * D, F.Wt_in() + (size_t)l * DINX * D);
    EpiP E{F.P(), DINX, F.LB() + l * 1024};
    pg8::gemm_phase<EpiP, DenseOrder, true>(F.lds + RING_OFF, (const char*)F.H(), 2 * D, S, E, F.tid);
    if (F.bid >= WIN_BUSY) cvt_deferred(F, l == 0 ? CVT_GU0 : CVT_GU1, F.bid - WIN_BUSY, DEF_WIN);
}
__device__ __forceinline__ void ph_wout(Frame& F, int l) {
    DenseOrder S; S.init(l == 1 ? LAT / 256 : T / 256, D / 256, F.G, F.bid, 2 * D, F.Wt_out() + (size_t)l * D * D, l == 1 ? 1 : 0);
    const float* m = F.MOD() + (size_t)(l * 2) * 6144;
    EpiRes E{l == 0 ? F.ctxin() : F.X(), l == 0 ? F.x() : F.X() + (size_t)CTX * D, m + 6144 + 2 * D, m + 2 * D, F.X()};
    pg8::gemm_phase<EpiRes, DenseOrder, true>(F.lds + RING_OFF, (const char*)F.CAT(), 2 * D, S, E, F.tid);
    if (l == 0 && F.bid >= 4) cvt_deferred(F, CVT_GU0 + DEF_A, F.bid - 4, DEF_WOUT);
}
__device__ __forceinline__ void combine_gather(const Frame& F, const LAS int* bt, int row, int ln, f32x4 (&v)[4], u32x2 (&y)[4][4], float (&w)[4]) {
    row_load(F.X() + (size_t)row * D, ln, v);
    const GAS int* ti = (const GAS int*)F.TOPI() + (unsigned)(row * 4); const GAS float* tw = (const GAS float*)F.TOPW() + (unsigned)(row * 4); const GAS int* tp = (const GAS int*)F.POS() + (unsigned)(row * 4);
#pragma unroll
    for (int q = 0; q < 4; ++q) { const int e = ti[q]; w[q] = tw[q]; const int srow = 256 * bt[e] + tp[q]; const GAS u32x2* yr = (const GAS u32x2*)((const GAS bf16_t*)F.Y() + (unsigned)srow * (unsigned)D) + ln;
#pragma unroll
        for (int j = 0; j < 4; ++j) y[q][j] = yr[64 * j]; }
}
__device__ __forceinline__ void combine_finish(const Frame& F, int l, int row, int ln, f32x4 (&v)[4], const u32x2 (&y)[4][4], const float (&w)[4]) {
    const float* m = F.MOD() + (size_t)(l * 2 + (row < CTX ? 1 : 0)) * 6144 + 5 * D;
#pragma unroll
    for (int j = 0; j < 4; ++j) { f32x4 s = (f32x4){0.f, 0.f, 0.f, 0.f};
#pragma unroll
        for (int q = 0; q < 4; ++q) s += w[q] * (f32x4){bflo(y[q][j].x), bfhi(y[q][j].x), bflo(y[q][j].y), bfhi(y[q][j].y)};
        v[j] += ((const GAS f32x4*)m)[ln + 64 * j] * s; }
    const float r = row_rstd(v, ln);
    if (l == 0) {
        GAS f32x4* xo = (GAS f32x4*)(F.X() + (size_t)row * D) + ln;
#pragma unroll
        for (int j = 0; j < 4; ++j) xo[64 * j] = v[j];
        const float* m1 = F.MOD() + (size_t)(2 + (row < CTX ? 1 : 0)) * 6144; f32x4 hv[4];
        row_modulate(v, r, F.norm1_g() + D, m1 + D, m1, ln, hv); row_store_bf16(F.H() + (size_t)row * D, ln, hv);
    } else {
        GAS f32x4* o = (GAS f32x4*)(F.out() + (size_t)(row - CTX) * D) + ln; const float* fg = F.fng();
#pragma unroll
        for (int j = 0; j < 4; ++j) o[64 * j] = v[j] * r * ((const GAS f32x4*)fg)[ln + 64 * j];
    }
}
__device__ __forceinline__ void ph_combine(Frame& F, int l) {
    (void)moe_tiles(F, l);
    const LAS int* bt = (const LAS int*)(F.lds + BT_OFF);
    const int gw = F.vcu * NWAVES + F.wave, NGW = F.G * NWAVES; const int rbeg = l == 1 ? CTX : 0;
#pragma unroll 1
    for (int ra = rbeg + gw; ra < T; ra += 2 * NGW) {
        int ln = F.lane; asm volatile("" : "+v"(ln));
        const int rb = ra + NGW; const bool hasb = rb < T; const int rbc = hasb ? rb : ra;
        f32x4 va[4], vb[4]; u32x2 ya[4][4], yb[4][4]; float wa[4], wb[4];
        combine_gather(F, bt, ra, ln, va, ya, wa); combine_gather(F, bt, rbc, ln, vb, yb, wb);
        combine_finish(F, l, ra, ln, va, ya, wa);
        if (hasb) combine_finish(F, l, rb, ln, vb, yb, wb);
    }
}
constexpr size_t WF_MA = 0, WF_MB = 128 * 1024, WF_MC = 256 * 1024, WF_PW = 512 * 1024;
constexpr int ZS = 528;
__device__ __forceinline__ f32x4 mfma16(bf16x8 a, bf16x8 b, f32x4 c) { return __builtin_amdgcn_mfma_f32_16x16x32_bf16(a, b, c, 0, 0, 0); }

__device__ __forceinline__ void ph_prologue2(Frame& F) {
    bf16_t* MA = (bf16_t*)(F.ws + WS_WF + WF_MA); bf16_t* MB = (bf16_t*)(F.ws + WS_WF + WF_MB); bf16_t* MC = (bf16_t*)(F.ws + WS_WF + WF_MC); bf16_t* PW = (bf16_t*)(F.ws + WS_WF + WF_PW);
    const int gt = F.bid * NTHR + F.tid, NT = F.G * NTHR;
    for (int i = gt; i < 256 * 256; i += NT) { const int r = i >> 8, cidx = i & 255, ri = r >> 7, k1 = r & 127, rj = cidx >> 7, t1 = cidx & 127; const float x = 2.f * (float)((k1 * t1) & 127) / 128.f;
        const float cs = cospif(x), sn = sinpif(x); const float v = ri == 0 ? (rj == 0 ? cs : -sn) : (rj == 0 ? -sn : -cs); MA[i] = (bf16_t)f2bf(v); }
    for (int i = gt; i < 128 * 256; i += NT) { const int k2 = i >> 8, cidx = i & 255, rj = cidx >> 7, t2 = cidx & 127; const float x = 2.f * (float)((k2 * t2) & 127) / 128.f; MB[i] = (bf16_t)f2bf(rj == 0 ? cospif(x) : sinpif(x)); }
    for (int i = gt; i < 256 * 512; i += NT) { const int k = i >> 9, cidx = i & 511, rj = cidx >> 8, t = cidx & 255; const float x = 2.f * (float)((k * t) & 255) / 256.f; MC[i] = (bf16_t)f2bf(rj == 0 ? cospif(x) : -sinpif(x)); }
    for (int i = gt; i < 2 * 4 * 64 * 64; i += NT) { const int lg = i >> 12, j = (i >> 6) & 63, ii = i & 63; PW[i] = (bf16_t)f2bf(F.pool_w()[(size_t)lg * 4096 + ii * 64 + j]); }
    LAS float* m12 = (LAS float*)(F.lds);
    LAS float* wt = (LAS float*)(F.lds + 32768);
    LAS float* trig = (LAS float*)(F.lds + 32768 + 65536);
    LAS float* fws = (LAS float*)(F.lds + 32768 + 65536 + 512);
    __syncthreads();
    if (F.tid < 64) { trig[F.tid] = cospif(2.f * (float)F.tid / 64.f); trig[64 + F.tid] = sinpif(2.f * (float)F.tid / 64.f); }
    for (int tile = F.bid; tile < 2 * 256; tile += F.G) {
        const int l = tile >> 8, kb = (tile >> 4) & 15, nb = tile & 15, k0 = 64 * kb, n0 = 32 * nb, sel = n0 >> 8, nn0 = n0 & 255;
        __syncthreads();
        for (int i = F.tid; i < 256 * 32; i += NTHR) fws[i] = F.four_w()[(size_t)l * 65536 + (size_t)(i >> 5) * 256 + nn0 + (i & 31)];
        __syncthreads();
        { const int cin = F.tid & 255, hf = F.tid >> 8, hh = cin >> 6, c = cin & 63; float acc[16];
#pragma unroll
          for (int q = 0; q < 16; ++q) acc[q] = 0.f;
#pragma unroll 4
          for (int m = 0; m < 64; ++m) { const float tv = trig[sel * 64 + ((m * c) & 63)]; const LAS float* fr = fws + (hh * 64 + m) * 32 + 16 * hf;
#pragma unroll
              for (int q = 0; q < 16; ++q) acc[q] += tv * fr[q]; }
#pragma unroll
          for (int q = 0; q < 16; ++q) m12[cin * 32 + 16 * hf + q] = acc[q]; }
        for (int i = F.tid; i < 64 * 256; i += NTHR) { const int k = i >> 8, cin = i & 255; wt[i] = F.w_in()[(size_t)l * D * DIN + (size_t)(k0 + k) * DIN + 2816 + cin]; }
        __syncthreads();
        { const int n = F.tid & 31, kq = F.tid >> 5; float a[4] = {0.f, 0.f, 0.f, 0.f};
#pragma unroll 4
          for (int cin = 0; cin < 256; ++cin) { const float mv = m12[cin * 32 + n];
#pragma unroll
              for (int i = 0; i < 4; ++i) a[i] += wt[(kq * 4 + i) * 256 + cin] * mv; }
          u32x2 w; w.x = pk2(a[0], a[1]); w.y = pk2(a[2], a[3]);
          *(u32x2*)(F.Wt_in() + (size_t)l * DINX * D + (size_t)(FQ_OFF + n0 + n) * D + k0 + kq * 4) = w; }
    }
    __syncthreads();
}

template <class SrcF> __device__ __forceinline__ void load_tile_T(LAS unsigned char* zt, const SrcF& src, int tid) {
    const int pg = tid >> 4, cc = tid & 15; u32x4 r[8];
#pragma unroll
    for (int i = 0; i < 8; ++i) r[i] = *(const GAS u32x4*)(src(8 * pg + i) + 8 * cc);
#pragma unroll
    for (int j = 0; j < 8; ++j) { const unsigned sel = (j & 1) ? 0x07060302u : 0x05040100u; u32x4 o;
        o.x = __builtin_amdgcn_perm(r[1][j >> 1], r[0][j >> 1], sel); o.y = __builtin_amdgcn_perm(r[3][j >> 1], r[2][j >> 1], sel);
        o.z = __builtin_amdgcn_perm(r[5][j >> 1], r[4][j >> 1], sel); o.w = __builtin_amdgcn_perm(r[7][j >> 1], r[6][j >> 1], sel);
        *(LAS u32x4*)(zt + (8 * cc + j) * ZS + 16 * pg) = o; }
}
__device__ __forceinline__ void tile_mma(const LAS unsigned char* zt, const bf16_t* mat_row  , f32x4 (&acc)[8], int lane) {
    const int fr = lane & 15, g = lane >> 4;
#pragma unroll
    for (int ks = 0; ks < 8; ++ks) { const bf16x8 b = *(const GAS bf16x8*)(mat_row + 32 * ks + 8 * g);
#pragma unroll
        for (int m = 0; m < 8; ++m) { const bf16x8 a = *(const LAS bf16x8*)(zt + (16 * m + fr) * ZS + (32 * ks + 8 * g) * 2); acc[m] = mfma16(a, b, acc[m]); }
        if (ks & 1) __builtin_amdgcn_sched_barrier(0); }
}
__device__ __forceinline__ void tile_mma2(const LAS unsigned char* zt, const bf16_t* mat_row0, const bf16_t* mat_row1, f32x4 (&acc0)[8], f32x4 (&acc1)[8], int lane) {
    const int fr = lane & 15, g = lane >> 4;
#pragma unroll
    for (int ks = 0; ks < 8; ++ks) { const bf16x8 b0 = *(const GAS bf16x8*)(mat_row0 + 32 * ks + 8 * g), b1 = *(const GAS bf16x8*)(mat_row1 + 32 * ks + 8 * g);
#pragma unroll
        for (int m = 0; m < 8; ++m) { const bf16x8 a = *(const LAS bf16x8*)(zt + (16 * m + fr) * ZS + (32 * ks + 8 * g) * 2); acc0[m] = mfma16(a, b0, acc0[m]); acc1[m] = mfma16(a, b1, acc1[m]); }
        __builtin_amdgcn_sched_barrier(0); }
}
struct SrcA { const bf16_t* P; int t2, hc; __device__ __forceinline__ const bf16_t* operator()(int p) const { const int ri = p >> 7, t1 = p & 127; return P + (size_t)(CTX + 128 * t1 + t2) * DINX + FQ_OFF + ri * 256 + 128 * hc; } };
struct SrcB { const bf16_t* Y; int k1, hc; __device__ __forceinline__ const bf16_t* operator()(int p) const { const int ri = p >> 7, t2 = p & 127; return Y + ((size_t)(k1 * 128 + t2) * 2 + ri) * 256 + 128 * hc; } };
struct SrcC { const bf16_t* P; int ri, hc; __device__ __forceinline__ const bf16_t* operator()(int p) const { return P + (size_t)p * DINX + FQ_OFF + ri * 256 + 128 * hc; } };

__device__ __forceinline__ void fftA_item(Frame& F, int item) {
    const int t2 = item >> 1, hc = item & 1; LAS unsigned char* zt = F.lds + RING_OFF;
    bf16_t* YP = (bf16_t*)(F.ws + WS_YP); const bf16_t* MA = (const bf16_t*)(F.ws + WS_WF + WF_MA);
    __syncthreads();
    load_tile_T(zt, SrcA{F.P(), t2, hc}, F.tid);
    __syncthreads();
    const int fr = F.lane & 15, g = F.lane >> 4, k1 = 16 * F.wave + fr;
    f32x4 ar[8], ai[8];
#pragma unroll
    for (int m = 0; m < 8; ++m) { ar[m] = (f32x4){0.f, 0.f, 0.f, 0.f}; ai[m] = (f32x4){0.f, 0.f, 0.f, 0.f}; }
    tile_mma2(zt, MA + (size_t)k1 * 256, MA + (size_t)(128 + k1) * 256, ar, ai, F.lane);
    const float x = 2.f * (float)(t2 * k1) / 16384.f; const float cs = cospif(x), sn = sinpif(x);
    bf16_t* yr = YP + ((size_t)(k1 * 128 + t2) * 2) * 256 + 128 * hc + 4 * g;
#pragma unroll
    for (int m = 0; m < 8; ++m) { const f32x4 a = ar[m], b = ai[m]; const f32x4 pr = a * cs + b * sn, pi = b * cs - a * sn;
        u32x2 w; w.x = pk2(pr[0], pr[1]); w.y = pk2(pr[2], pr[3]); *(u32x2*)(yr + 16 * m) = w;
        u32x2 v; v.x = pk2(pi[0], pi[1]); v.y = pk2(pi[2], pi[3]); *(u32x2*)(yr + 256 + 16 * m) = v; }
}
__device__ __forceinline__ void fftB_item(Frame& F, int item) {
    const int k1 = item >> 1, hc = item & 1; LAS unsigned char* zt = F.lds + RING_OFF;
    const bf16_t* YP = (const bf16_t*)(F.ws + WS_YP); const bf16_t* MB = (const bf16_t*)(F.ws + WS_WF + WF_MB);
    __syncthreads();
    load_tile_T(zt, SrcB{YP, k1, hc}, F.tid);
    __syncthreads();
    const int fr = F.lane & 15, g = F.lane >> 4, k2 = 16 * F.wave + fr;
    f32x4 acc[8];
#pragma unroll
    for (int m = 0; m < 8; ++m) acc[m] = (f32x4){0.f, 0.f, 0.f, 0.f};
    tile_mma(zt, MB + (size_t)k2 * 256, acc, F.lane);
    bf16_t* o = F.CAT() + (size_t)(CTX + k1 + 128 * k2) * D + 768 + 128 * hc + 4 * g;
#pragma unroll
    for (int m = 0; m < 8; ++m) { const f32x4 a = acc[m] * (1.f / 1024.f); u32x2 w; w.x = pk2(a[0], a[1]); w.y = pk2(a[2], a[3]); *(u32x2*)(o + 16 * m) = w; }
}
__device__ __forceinline__ void fftC_item(Frame& F, int item) {
    const int kh = item >> 1, hc = item & 1; LAS unsigned char* zt = F.lds + RING_OFF; const bf16_t* MC = (const bf16_t*)(F.ws + WS_WF + WF_MC);
    const int fr = F.lane & 15, g = F.lane >> 4, k = 128 * kh + 16 * F.wave + fr;
    f32x4 acc[8];
#pragma unroll
    for (int m = 0; m < 8; ++m) acc[m] = (f32x4){0.f, 0.f, 0.f, 0.f};
    for (int ri = 0; ri < 2; ++ri) {
        __syncthreads();
        load_tile_T(zt, SrcC{F.P(), ri, hc}, F.tid);
        __syncthreads();
        tile_mma(zt, MC + (size_t)k * 512 + ri * 256, acc, F.lane);
    }
    bf16_t* o = F.CAT() + (size_t)k * D + 768 + 128 * hc + 4 * g;
#pragma unroll
    for (int m = 0; m < 8; ++m) { const f32x4 a = acc[m] * (1.f / 128.f); u32x2 w; w.x = pk2(a[0], a[1]); w.y = pk2(a[2], a[3]); *(u32x2*)(o + 16 * m) = w; }
}

template <int GI> __device__ __forceinline__ void pool_sums(Frame& F, int j, LAS float* V, LAS unsigned* U, LAS unsigned char* At) {
    constexpr int win = 2 << GI, lo = win >> 1, hi = win - 1 - lo; const GAS bf16_t* Pc = (const GAS bf16_t*)F.P() + 2560 + GI * 64;
    if (j == 0) {
        for (int idx = F.tid; idx < 256 * 8; idx += NTHR) { const int t = idx >> 3, p8 = idx & 7; const int a = max(t - lo, 0), b = min(t + hi, CTX - 1); u32x4 w[win];
#pragma unroll
            for (int i = 0; i < win; ++i) { const int r = min(max(t - lo + i, 0), CTX - 1); w[i] = *(const GAS u32x4*)(Pc + (unsigned)(r * DINX + 8 * p8)); }
            f32x4 s0 = (f32x4){0.f, 0.f, 0.f, 0.f}, s1 = s0;
#pragma unroll
            for (int i = 0; i < win; ++i) { const int r = t - lo + i; const bool in = r >= 0 && r <= CTX - 1; const u32x4 x = w[i];
                const f32x4 e = (f32x4){bflo(x.x), bflo(x.y), bflo(x.z), bflo(x.w)}, o = (f32x4){bfhi(x.x), bfhi(x.y), bfhi(x.z), bfhi(x.w)}; if (in) { s0 += e; s1 += o; } }
            const u32x4 u = w[lo]; const float inv = 1.f / (float)(b - a + 1); u32x4 ov;
            ov.x = pk2(s0[0] * inv - bflo(u.x), s1[0] * inv - bfhi(u.x)); ov.y = pk2(s0[1] * inv - bflo(u.y), s1[1] * inv - bfhi(u.y));
            ov.z = pk2(s0[2] * inv - bflo(u.z), s1[2] * inv - bfhi(u.z)); ov.w = pk2(s0[3] * inv - bflo(u.w), s1[3] * inv - bfhi(u.w));
            *(LAS u32x4*)(At + t * 144 + 16 * p8) = ov; }
        return; }
    const int r0 = 4 * (j - 1); constexpr int NR = win + 3;
    { const int c = F.tid >> 3, p8 = F.tid & 7; u32x4 w[NR];
#pragma unroll
        for (int i = 0; i < NR; ++i) { const int r = min(max(r0 - lo + i, 0), LAT / GW - 1); w[i] = *(const GAS u32x4*)(Pc + (unsigned)((CTX + r * GW + c) * DINX + 8 * p8)); }
        f32x4 s0[4], s1[4];
#pragma unroll
        for (int q = 0; q < 4; ++q) { s0[q] = (f32x4){0.f, 0.f, 0.f, 0.f}; s1[q] = (f32x4){0.f, 0.f, 0.f, 0.f}; }
#pragma unroll
        for (int i = 0; i < NR; ++i) { const int r = r0 - lo + i; const bool ok = r >= 0 && r <= LAT / GW - 1; const u32x4 x = w[i];
            f32x4 e = (f32x4){bflo(x.x), bflo(x.y), bflo(x.z), bflo(x.w)}, o = (f32x4){bfhi(x.x), bfhi(x.y), bfhi(x.z), bfhi(x.w)}; if (!ok) { e = (f32x4){0.f, 0.f, 0.f, 0.f}; o = e; }
#pragma unroll
            for (int q = 0; q < 4; ++q) if (i >= q && i <= q + win - 1) { s0[q] += e; s1[q] += o; } }
#pragma unroll
        for (int q = 0; q < 4; ++q) { LAS float* vp = V + (q * 64 + c) * 64 + 8 * p8;
            *(LAS f32x4*)vp = (f32x4){s0[q][0], s1[q][0], s0[q][1], s1[q][1]}; *(LAS f32x4*)(vp + 4) = (f32x4){s0[q][2], s1[q][2], s0[q][3], s1[q][3]};
            *(LAS u32x4*)(U + (q * 64 + c) * 32 + 4 * p8) = w[lo + q]; } }
    __syncthreads();
    for (int idx = F.tid; idx < 4 * 8 * 64; idx += NTHR) { const int ch = idx & 63, cb = (idx >> 6) & 7, i = idx >> 9; const int r = r0 + i;
        const float cr = (float)(min(r + hi, LAT / GW - 1) - max(r - lo, 0) + 1); const LAS float* Vr = V + (i * 64) * 64 + ch;
        const int c0 = 8 * cb; float s = 0.f;
#pragma unroll
        for (int q = 0; q < win; ++q) { const int c = c0 - lo + q; s += (c >= 0 && c <= GW - 1) ? Vr[min(max(c, 0), GW - 1) * 64] : 0.f; }
#pragma unroll
        for (int q = 0; q < 8; ++q) { const int c = c0 + q; if (q > 0) { if (c + hi <= GW - 1) s += Vr[(c + hi) * 64]; if (c - 1 - lo >= 0) s -= Vr[(c - 1 - lo) * 64]; }
            const float cc = (float)(min(c + hi, GW - 1) - max(c - lo, 0) + 1); const unsigned uw = U[(i * 64 + c) * 32 + (ch >> 1)]; const float u = (ch & 1) ? bfhi(uw) : bflo(uw);
            *(LAS unsigned short*)(At + (i * 64 + c) * 144 + 2 * ch) = (unsigned short)f2bf(s / (cr * cc) - u); } }
}
__device__ __forceinline__ void pool_item(Frame& F, int l, int item) {
    const int j = item >> 2, gi = item & 3;
    LAS float* V = (LAS float*)(F.lds);
    LAS unsigned* U = (LAS unsigned*)(F.lds + 65536);
    LAS unsigned char* At = F.lds + 65536 + 32768;
    __syncthreads();
    if (gi == 0) pool_sums<0>(F, j, V, U, At); else if (gi == 1) pool_sums<1>(F, j, V, U, At); else if (gi == 2) pool_sums<2>(F, j, V, U, At); else pool_sums<3>(F, j, V, U, At);
    __syncthreads();
    const bf16_t* PW = (const bf16_t*)(F.ws + WS_WF + WF_PW) + (size_t)(l * 4 + gi) * 4096; const int fr = F.lane & 15, g = F.lane >> 4;
    f32x4 acc[4][2];
#pragma unroll
    for (int n = 0; n < 4; ++n) { acc[n][0] = (f32x4){0.f, 0.f, 0.f, 0.f}; acc[n][1] = (f32x4){0.f, 0.f, 0.f, 0.f}; }
#pragma unroll
    for (int ks = 0; ks < 2; ++ks) { bf16x8 b[2];
#pragma unroll
        for (int mt = 0; mt < 2; ++mt) b[mt] = *(const LAS bf16x8*)(At + (32 * F.wave + 16 * mt + fr) * 144 + (32 * ks + 8 * g) * 2);
#pragma unroll
        for (int n = 0; n < 4; ++n) { const bf16x8 a = *(const GAS bf16x8*)(PW + (16 * n + fr) * 64 + 32 * ks + 8 * g);
#pragma unroll
            for (int mt = 0; mt < 2; ++mt) acc[n][mt] = mfma16(a, b[mt], acc[n][mt]); } }
    const int rowbase = j == 0 ? 0 : CTX + 256 * (j - 1);
#pragma unroll
    for (int n = 0; n < 4; ++n) { const f32x4 sc = *(const GAS f32x4*)(F.pool_s() + l * 256 + gi * 64 + 16 * n + 4 * g);
#pragma unroll
        for (int mt = 0; mt < 2; ++mt) { const f32x4 a = acc[n][mt] * sc; u32x2 w; w.x = pk2(a[0], a[1]); w.y = pk2(a[2], a[3]);
            *(u32x2*)(F.CAT() + (size_t)(rowbase + 32 * F.wave + 16 * mt + fr) * D + 512 + gi * 64 + 16 * n + 4 * g) = w; } }
}

constexpr int SC_FT = 0, SC_QT = 18432, SC_VT = 36864, SC_BQ = 55296, SC_BF = 72704, SC_KT = 90112, SC_PM = 108544, SC_G = 117760, SC_TOT = 135168, SC_DEC = 137216, SC_SSQ = 138752, SC_END = 140800;
static_assert(SC_END <= MISC_OFF, "scan LDS map");
template <int DIR, bool FULL> __device__ __forceinline__ void scan_fetch(const Frame& F, int h, int row0, u32x4 (&r)[8]) {
    const GAS bf16_t* P = (const GAS bf16_t*)F.P(); const int tid = F.tid;
    if (tid < 384) { const int tile = tid >> 7, blk = tid & 127, tg = blk >> 4, kc = blk & 15; if (!FULL && tile == 1) return;
        const int colb = tile == 0 ? 512 * (1 + DIR) : (tile == 1 ? 0 : 1536); const GAS bf16_t* src = P + (unsigned)((row0 + 8 * tg) * DINX + colb + h * 128 + 8 * kc);
#pragma unroll
        for (int i = 0; i < 8; ++i) r[i] = *(const GAS u32x4*)(src + (unsigned)(i * DINX)); }
    else if (FULL && DIR == 1) { const int q = tid - 384; const GAS bf16_t* src = P + (unsigned)((row0 + (q >> 4)) * DINX + 2048 + h * 128 + 8 * (q & 15));
#pragma unroll
        for (int i = 0; i < 8; ++i) r[i] = *(const GAS u32x4*)(src + (unsigned)(i * 8 * DINX)); }
}
template <int DIR, bool FULL> __device__ __forceinline__ void scan_commit(const Frame& F, const u32x4 (&r)[8]) {
    LAS unsigned char* L = F.lds + RING_OFF; const int tid = F.tid;
    if (tid < 384) { const int tile = tid >> 7, blk = tid & 127, tg = blk >> 4, kc = blk & 15; if (!FULL && tile == 1) return;
#pragma unroll
        for (int j = 0; j < 8; ++j) { const unsigned sel = (j & 1) ? 0x07060302u : 0x05040100u; u32x4 o;
            o.x = __builtin_amdgcn_perm(r[1][j >> 1], r[0][j >> 1], sel); o.y = __builtin_amdgcn_perm(r[3][j >> 1], r[2][j >> 1], sel);
            o.z = __builtin_amdgcn_perm(r[5][j >> 1], r[4][j >> 1], sel); o.w = __builtin_amdgcn_perm(r[7][j >> 1], r[6][j >> 1], sel);
            *(LAS u32x4*)(L + tile * 18432 + (8 * kc + j) * 144 + 16 * tg) = o; } }
    else if (FULL && DIR == 1) { const int q = tid - 384; LAS unsigned char* dst = L + SC_G + (q >> 4) * 272 + 16 * (q & 15);
#pragma unroll
        for (int i = 0; i < 8; ++i) *(LAS u32x4*)(dst + i * 8 * 272) = r[i]; }
}
template <int DIR, bool FULL> __device__ __forceinline__ void scan_chunk(Frame& F, int l, int h, int nrow0, u32x4 (&pre)[8], f32x4 (&S)[8], f32x4 (&o)[4], float& segsum, const GAS float* oload = nullptr, GAS float* ostore = nullptr) {
    LAS unsigned char* L = F.lds + RING_OFF; int lane = F.lane; asm volatile("" : "+v"(lane));
    const int w = F.wave, tid = w * 64 + lane, fr = lane & 15, g = lane >> 4;
    LAS float* TOT = (LAS float*)(L + SC_TOT); LAS float* DEC = (LAS float*)(L + SC_DEC); LAS float* C1 = DEC + 128; LAS float* C2 = DEC + 256;
    __syncthreads();
    scan_commit<DIR, FULL>(F, pre);
    __syncthreads();
    const int k = tid & 127, qu = tid >> 7;
    float bl[16]; float run = 0.f;
    { const u32x4 fa = *(const LAS u32x4*)(L + SC_FT + k * 144 + 32 * qu), fb = *(const LAS u32x4*)(L + SC_FT + k * 144 + 32 * qu + 16); const unsigned fw[8] = {fa.x, fa.y, fa.z, fa.w, fb.x, fb.y, fb.z, fb.w};
#pragma unroll
      for (int i = 0; i < 16; ++i) { const int ti = (DIR == 0 ? i : 15 - i); run += (ti & 1) ? f16hi(fw[ti >> 1]) : f16lo(fw[ti >> 1]); bl[i] = run; } }
    TOT[qu * 128 + k] = run;
    __syncthreads();
    const float t0 = TOT[k], t1 = TOT[128 + k], t2 = TOT[256 + k], t3 = TOT[384 + k]; const float total = (t0 + t1) + (t2 + t3);
    float off, ref;
    if (DIR == 0) { off = qu == 0 ? 0.f : (qu == 1 ? t0 : (qu == 2 ? t0 + t1 : t0 + t1 + t2)); ref = t0 + t1; }
    else { off = qu == 3 ? 0.f : (qu == 2 ? t3 : (qu == 1 ? t3 + t2 : t3 + t2 + t1)); ref = t3 + t2; }
    if (qu == 0) { DEC[k] = __builtin_amdgcn_exp2f(total); C1[k] = __builtin_amdgcn_exp2f(ref); C2[k] = __builtin_amdgcn_exp2f(total - ref); segsum += total; }
    { unsigned qw[8];
      if (FULL) { const u32x4 qa = *(const LAS u32x4*)(L + SC_QT + k * 144 + 32 * qu), qb = *(const LAS u32x4*)(L + SC_QT + k * 144 + 32 * qu + 16); qw[0] = qa.x; qw[1] = qa.y; qw[2] = qa.z; qw[3] = qa.w; qw[4] = qb.x; qw[5] = qb.y; qw[6] = qb.z; qw[7] = qb.w; }
      float ktv[16]; const float sh = off - ref;
#pragma unroll
      for (int i = 0; i < 16; ++i) { const int ti = (DIR == 0 ? i : 15 - i), t = 16 * qu + ti; const float lf = i == 0 ? bl[0] : bl[i] - bl[i - 1]; const float b = bl[i] + sh;
          const float E = __builtin_amdgcn_exp2f(b), Ei = __builtin_amdgcn_rcpf(E), kk = 1.f - __builtin_amdgcn_exp2f(lf); ktv[ti] = kk * Ei;
          if (FULL) { const float qs = (ti & 1) ? bfhi(qw[ti >> 1]) : bflo(qw[ti >> 1]); *(LAS unsigned short*)(L + SC_BQ + t * 272 + 2 * k) = (unsigned short)(cvt_pk_bf16(qs * E, 0.f)); } }
      u32x4 a, b2; a.x = cvt_pk_bf16(ktv[0], ktv[1]); a.y = cvt_pk_bf16(ktv[2], ktv[3]); a.z = cvt_pk_bf16(ktv[4], ktv[5]); a.w = cvt_pk_bf16(ktv[6], ktv[7]);
      b2.x = cvt_pk_bf16(ktv[8], ktv[9]); b2.y = cvt_pk_bf16(ktv[10], ktv[11]); b2.z = cvt_pk_bf16(ktv[12], ktv[13]); b2.w = cvt_pk_bf16(ktv[14], ktv[15]);
      *(LAS u32x4*)(L + SC_KT + k * 144 + 32 * qu) = a; *(LAS u32x4*)(L + SC_KT + k * 144 + 32 * qu + 16) = b2;
      if (FULL) { const unsigned kw[8] = {a.x, a.y, a.z, a.w, b2.x, b2.y, b2.z, b2.w};
#pragma unroll
          for (int ti = 0; ti < 16; ++ti) *(LAS unsigned short*)(L + SC_BF + (16 * qu + ti) * 272 + 2 * k) = (unsigned short)((ti & 1) ? (kw[ti >> 1] >> 16) : (kw[ti >> 1] & 0xffffu)); } }
    __syncthreads();
    if (nrow0 >= 0) scan_fetch<DIR, FULL>(F, h, nrow0, pre);
    if (FULL) {
#pragma unroll
        for (int tb = 0; tb < 4; ++tb)
#pragma unroll
            for (int r = 0; r < 4; ++r) o[tb][r] = oload ? oload[(tb * 4 + r) * 512] : 0.f; }
    __builtin_amdgcn_sched_barrier(0);
    if (FULL) {
        const int tb = w >> 1;
#pragma unroll
        for (int q = 0; q < 2; ++q) { const int sb = 2 * (w & 1) + q; f32x4 acc = (f32x4){0.f, 0.f, 0.f, 0.f};
#pragma unroll
            for (int ks = 0; ks < 4; ++ks) { const bf16x8 a = *(const LAS bf16x8*)(L + SC_BF + (16 * sb + fr) * 272 + (32 * ks + 8 * g) * 2); const bf16x8 b = *(const LAS bf16x8*)(L + SC_BQ + (16 * tb + fr) * 272 + (32 * ks + 8 * g) * 2);
                acc = mfma16(a, b, acc); }
            const int t = 16 * tb + fr; float m[4];
#pragma unroll
            for (int r = 0; r < 4; ++r) { const int s = 16 * sb + 4 * g + r; const bool keep = DIR == 0 ? (s <= t) : (s >= t); m[r] = keep ? acc[r] : 0.f; }
            u32x2 wv; wv.x = pk2(m[0], m[1]); wv.y = pk2(m[2], m[3]); *(LAS u32x2*)(L + SC_PM + t * 144 + (16 * sb + 4 * g) * 2) = wv; }
        __syncthreads();
    }
    bf16x8 vt[2];
#pragma unroll
    for (int ks = 0; ks < 2; ++ks) vt[ks] = *(const LAS bf16x8*)(L + SC_VT + (16 * w + fr) * 144 + (32 * ks + 8 * g) * 2);
    if (FULL) {
        bf16x8 sf[4];
#pragma unroll
        for (int ks = 0; ks < 4; ++ks) { const f32x4 ca = *(const LAS f32x4*)(C1 + 32 * ks + 4 * g), cb = *(const LAS f32x4*)(C1 + 32 * ks + 16 + 4 * g); const f32x4 x = S[2 * ks] * ca, y = S[2 * ks + 1] * cb;
            u32x4 pkd; pkd.x = pk2(x[0], x[1]); pkd.y = pk2(x[2], x[3]); pkd.z = pk2(y[0], y[1]); pkd.w = pk2(y[2], y[3]); sf[ks] = __builtin_bit_cast(bf16x8, pkd); }
#pragma unroll
        for (int tb = 0; tb < 4; ++tb) { f32x4 acc = o[tb];
#pragma unroll
            for (int ks = 0; ks < 4; ++ks) { const u32x2 a0 = *(const LAS u32x2*)(L + SC_BQ + (16 * tb + fr) * 272 + (32 * ks + 4 * g) * 2), a1 = *(const LAS u32x2*)(L + SC_BQ + (16 * tb + fr) * 272 + (32 * ks + 16 + 4 * g) * 2);
                u32x4 pa; pa.x = a0.x; pa.y = a0.y; pa.z = a1.x; pa.w = a1.y; acc = mfma16(__builtin_bit_cast(bf16x8, pa), sf[ks], acc); }
#pragma unroll
            for (int ks = 0; ks < 2; ++ks) { const bf16x8 a = *(const LAS bf16x8*)(L + SC_PM + (16 * tb + fr) * 144 + (32 * ks + 8 * g) * 2); acc = mfma16(a, vt[ks], acc); }
            o[tb] = acc; __builtin_amdgcn_sched_barrier(0); }
        if (ostore) {
#pragma unroll
            for (int tb = 0; tb < 4; ++tb)
#pragma unroll
                for (int r = 0; r < 4; ++r) ostore[(tb * 4 + r) * 512] = o[tb][r]; }
    }
#pragma unroll
    for (int kb = 0; kb < 8; ++kb) { f32x4 tmp = (f32x4){0.f, 0.f, 0.f, 0.f};
#pragma unroll
        for (int ks = 0; ks < 2; ++ks) { const bf16x8 a = *(const LAS bf16x8*)(L + SC_KT + (16 * kb + fr) * 144 + (32 * ks + 8 * g) * 2); tmp = mfma16(a, vt[ks], tmp); }
        const f32x4 dc = *(const LAS f32x4*)(DEC + 16 * kb + 4 * g), c2 = *(const LAS f32x4*)(C2 + 16 * kb + 4 * g); S[kb] = dc * S[kb] + c2 * tmp; if (kb & 1) __builtin_amdgcn_sched_barrier(0); }
}
__device__ __forceinline__ void state_store(float* dst, const f32x4 (&S)[8], int w, int lane) {
    GAS float* p = (GAS float*)dst + (unsigned)(w * 2048 + lane);
#pragma unroll
    for (int kb = 0; kb < 8; ++kb)
#pragma unroll
        for (int r = 0; r < 4; ++r) p[(kb * 4 + r) * 64] = S[kb][r]; }
__device__ __forceinline__ void state_load(const float* src, f32x4 (&S)[8], int w, int lane) {
    const GAS float* p = (const GAS float*)src + (unsigned)(w * 2048 + lane);
#pragma unroll
    for (int kb = 0; kb < 8; ++kb)
#pragma unroll
        for (int r = 0; r < 4; ++r) S[kb][r] = p[(kb * 4 + r) * 64]; }
__device__ __forceinline__ float* sc_SU(Frame& F) { return (float*)(F.ws + WS_SU); }
__device__ __forceinline__ float* sc_SS(Frame& F) { return (float*)(F.ws + WS_SS); }
__device__ __forceinline__ float* sc_SD(Frame& F) { return (float*)(F.ws + WS_SD); }
__device__ __forceinline__ float* sc_CARRY(Frame& F) { return (float*)(F.ws + WS_SD) + 8 * 64 * 128; }

__device__ __forceinline__ float* sc_OSCR(Frame& F) { return (float*)(F.ws + WS_OSCR) + (size_t)F.bid * 32768; }
template <int DIR> __device__ __forceinline__ void scan_states(Frame& F, int l, int h, int segrow, float* sout, float* dout) {
    f32x4 S[8], odummy[4]; float segsum = 0.f; u32x4 pre[8];
#pragma unroll
    for (int kb = 0; kb < 8; ++kb) S[kb] = (f32x4){0.f, 0.f, 0.f, 0.f};
    scan_fetch<DIR, false>(F, h, segrow + (DIR == 0 ? 0 : 192), pre);
#pragma unroll 1
    for (int i_ = 0; i_ < 4; ++i_) { int i = i_; asm volatile("" : "+s"(i)); const int c = DIR == 0 ? i : 3 - i;
        scan_chunk<DIR, false>(F, l, h, i < 3 ? segrow + 64 * (DIR == 0 ? c + 1 : c - 1) : -1, pre, S, odummy, segsum); }
    state_store(sout, S, F.wave, F.lane);
    if (dout && F.tid < 128) dout[F.tid] = __builtin_amdgcn_exp2f(segsum);
}
__device__ __forceinline__ void scanA_item(Frame& F, int l, int item) {
    const int h = item >> 6, seg = item & 63, segrow = CTX + 256 * seg;
    scan_states<0>(F, l, h, segrow, sc_SU(F) + ((size_t)(h * 2 + 0) * 64 + seg) * 16384, sc_SD(F) + ((h * 2 + 0) * 64 + seg) * 128);
    scan_states<1>(F, l, h, segrow, sc_SU(F) + ((size_t)(h * 2 + 1) * 64 + seg) * 16384, sc_SD(F) + ((h * 2 + 1) * 64 + seg) * 128);
}
__device__ __forceinline__ void scan_full(Frame& F, int l, int h, int segrow, const float* sinf, const float* sinb, float* outf, float* outb) {
    f32x4 S[8], o[4]; float segsum = 0.f; const int w = F.wave, lane = F.lane, fr = lane & 15, g = lane >> 4; u32x4 pre[8];
    GAS float* oscr = (GAS float*)sc_OSCR(F) + (unsigned)F.tid;
    if (sinf) state_load(sinf, S, w, lane); else {
#pragma unroll
        for (int kb = 0; kb < 8; ++kb) S[kb] = (f32x4){0.f, 0.f, 0.f, 0.f}; }
    scan_fetch<0, true>(F, h, segrow, pre);
#pragma unroll 1
    for (int c_ = 0; c_ < 4; ++c_) { int c = c_; asm volatile("" : "+s"(c));
        scan_chunk<0, true>(F, l, h, c < 3 ? segrow + 64 * (c + 1) : -1, pre, S, o, segsum);
#pragma unroll
        for (int tb = 0; tb < 4; ++tb)
#pragma unroll
            for (int r = 0; r < 4; ++r) (oscr + c * 8192)[(tb * 4 + r) * 512] = o[tb][r];
    }
    if (outf) state_store(outf, S, w, lane);
    VM_WAIT();
    if (sinb) state_load(sinb, S, w, lane); else {
#pragma unroll
        for (int kb = 0; kb < 8; ++kb) S[kb] = (f32x4){0.f, 0.f, 0.f, 0.f}; }
    LAS unsigned char* L = F.lds + RING_OFF; LAS float* SSQ = (LAS float*)(L + SC_SSQ);
    const float ngv = F.hng()[l * 512 + h * 128 + 16 * w + fr];
    scan_fetch<1, true>(F, h, segrow + 192, pre);
#pragma unroll 1
    for (int c_ = 3; c_ >= 0; --c_) { int c = c_; asm volatile("" : "+s"(c));
        scan_chunk<1, true>(F, l, h, c > 0 ? segrow + 64 * (c - 1) : -1, pre, S, o, segsum, oscr + c * 8192);
#pragma unroll
        for (int tb = 0; tb < 4; ++tb) { f32x4 q = o[tb] * o[tb];
#pragma unroll
            for (int m = 1; m < 16; m <<= 1) { q[0] += lane_xor(q[0], m, lane); q[1] += lane_xor(q[1], m, lane); q[2] += lane_xor(q[2], m, lane); q[3] += lane_xor(q[3], m, lane); }
            if (fr == 0) {
#pragma unroll
                for (int r = 0; r < 4; ++r) SSQ[(16 * tb + 4 * g + r) * 8 + w] = q[r]; } }
        __syncthreads();
#pragma unroll
        for (int tb = 0; tb < 4; ++tb)
#pragma unroll
            for (int r = 0; r < 4; ++r) { const int t = 16 * tb + 4 * g + r; const f32x4 p0 = *(const LAS f32x4*)(SSQ + t * 8), p1 = *(const LAS f32x4*)(SSQ + t * 8 + 4);
                const float ss = ((p0[0] + p0[1]) + (p0[2] + p0[3])) + ((p1[0] + p1[1]) + (p1[2] + p1[3])); const float rs = rsqrtf(ss * (1.f / 128.f) + 1e-6f);
                const float gp = bf2f(*(const LAS unsigned short*)(L + SC_G + t * 272 + 2 * (16 * w + fr)));
                *(LAS unsigned short*)(L + SC_BQ + t * 272 + 2 * (16 * w + fr)) = (unsigned short)f2bf(o[tb][r] * rs * ngv * gp); }
        __syncthreads();
#pragma unroll
        for (int i = 0; i < 2; ++i) { const int id = F.tid + 512 * i, row = id >> 4, cc = id & 15; const u32x4 d = *(const LAS u32x4*)(L + SC_BQ + row * 272 + 16 * cc);
            *(GAS u32x4*)((GAS bf16_t*)F.CAT() + (unsigned)((segrow + 64 * c + row) * D + h * 128 + 8 * cc)) = d; }
    }
    if (outb) state_store(outb, S, w, lane);
}
__device__ __forceinline__ GAS float* sc_CTXO(const Frame& F, int hd, int c) { return (GAS float*)(F.ws + WS_CTXO) + (unsigned)((hd * 4 + c) * 8192); }
template <int DIR> __device__ __forceinline__ void scan_dir_local(Frame& F, int l, int h, int segrow, float* sout) {
    f32x4 S[8], o[4]; float segsum = 0.f; u32x4 pre[8]; const int hd = h * 2 + DIR;
#pragma unroll
    for (int kb = 0; kb < 8; ++kb) S[kb] = (f32x4){0.f, 0.f, 0.f, 0.f};
    scan_fetch<DIR, true>(F, h, segrow + (DIR == 0 ? 0 : 192), pre);
#pragma unroll 1
    for (int i_ = 0; i_ < 4; ++i_) { int i = i_; asm volatile("" : "+s"(i)); const int c = DIR == 0 ? i : 3 - i;
        scan_chunk<DIR, true>(F, l, h, i < 3 ? segrow + 64 * (DIR == 0 ? c + 1 : c - 1) : -1, pre, S, o, segsum, nullptr, sc_CTXO(F, hd, c) + (unsigned)F.tid); }
    state_store(sout, S, F.wave, F.lane);
}
__device__ __forceinline__ void ctx_finalize(Frame& F, int l, int h) {
    LAS unsigned char* L = F.lds + RING_OFF; LAS float* SSQ = (LAS float*)(L + SC_SSQ);
    const float ngv = F.hng()[l * 512 + h * 128 + 16 * F.wave + (F.lane & 15)];
#pragma unroll 1
    for (int c_ = 0; c_ < 4; ++c_) { int c = c_; asm volatile("" : "+s"(c)); int lane = F.lane; asm volatile("" : "+v"(lane));
        const int w = F.wave, tid = w * 64 + lane, fr = lane & 15, g = lane >> 4, row0 = 64 * c;
        __syncthreads();
        { const GAS bf16_t* gp = (const GAS bf16_t*)F.P() + (unsigned)((row0 + (tid >> 4)) * DINX + 2048 + h * 128 + 8 * (tid & 15)); const int o = (tid >> 4) * 272 + 16 * (tid & 15);
          *(LAS u32x4*)(L + SC_G + o) = *(const GAS u32x4*)gp; *(LAS u32x4*)(L + SC_G + o + 32 * 272) = *(const GAS u32x4*)(gp + (unsigned)(32 * DINX)); }
        f32x4 o[4];
        { const GAS float* of = sc_CTXO(F, h * 2 + 0, c) + (unsigned)tid; const GAS float* ob = sc_CTXO(F, h * 2 + 1, c) + (unsigned)tid;
#pragma unroll
          for (int tb = 0; tb < 4; ++tb)
#pragma unroll
              for (int r = 0; r < 4; ++r) o[tb][r] = of[(tb * 4 + r) * 512] + ob[(tb * 4 + r) * 512]; }
#pragma unroll
        for (int tb = 0; tb < 4; ++tb) { f32x4 q = o[tb] * o[tb];
#pragma unroll
            for (int m = 1; m < 16; m <<= 1) { q[0] += lane_xor(q[0], m, lane); q[1] += lane_xor(q[1], m, lane); q[2] += lane_xor(q[2], m, lane); q[3] += lane_xor(q[3], m, lane); }
            if (fr == 0) {
#pragma unroll
                for (int r = 0; r < 4; ++r) SSQ[(16 * tb + 4 * g + r) * 8 + w] = q[r]; } }
        __syncthreads();
#pragma unroll
        for (int tb = 0; tb < 4; ++tb)
#pragma unroll
            for (int r = 0; r < 4; ++r) { const int t = 16 * tb + 4 * g + r; const f32x4 p0 = *(const LAS f32x4*)(SSQ + t * 8), p1 = *(const LAS f32x4*)(SSQ + t * 8 + 4);
                const float ss = ((p0[0] + p0[1]) + (p0[2] + p0[3])) + ((p1[0] + p1[1]) + (p1[2] + p1[3])); const float rs = rsqrtf(ss * (1.f / 128.f) + 1e-6f);
                const float gp = bf2f(*(const LAS unsigned short*)(L + SC_G + t * 272 + 2 * (16 * w + fr)));
                *(LAS unsigned short*)(L + SC_BQ + t * 272 + 2 * (16 * w + fr)) = (unsigned short)f2bf(o[tb][r] * rs * ngv * gp); }
        __syncthreads();
#pragma unroll
        for (int i = 0; i < 2; ++i) { const int id = tid + 512 * i, row = id >> 4, cc = id & 15; const u32x4 d = *(const LAS u32x4*)(L + SC_BQ + row * 272 + 16 * cc);
            *(GAS u32x4*)((GAS bf16_t*)F.CAT() + (unsigned)((row0 + row) * D + h * 128 + 8 * cc)) = d; }
    }
    __syncthreads();
}
__device__ __forceinline__ void scanB(Frame& F) {
    const int e = F.bid * NTHR + F.tid; if (e >= 8 * 16384) return;
    const int hd = e >> 14, idx = e & 16383, d = hd & 1; const int ln = idx & 63, reg = (idx >> 6) & 3, kb = (idx >> 8) & 7; const int k = 16 * kb + 4 * (ln >> 4) + reg;
    const float* SU = sc_SU(F) + (size_t)hd * 64 * 16384 + idx; const float* SD = sc_SD(F) + hd * 64 * 128 + k; float* SS = sc_SS(F) + (size_t)hd * 64 * 16384 + idx;
    float S = sc_CARRY(F)[hd * 16384 + idx];
    if (d == 0) { for (int seg = 0; seg < 64; ++seg) { SS[(size_t)seg * 16384] = S; S = SD[seg * 128] * S + SU[(size_t)seg * 16384]; } }
    else { for (int seg = 63; seg >= 0; --seg) { SS[(size_t)seg * 16384] = S; S = SD[seg * 128] * S + SU[(size_t)seg * 16384]; } }
}

__device__ __forceinline__ void ph_mixA(Frame& F, int l) {
    scanA_item(F, l, F.bid);
    if (F.bid >= 4 && F.bid < 12) { const int hd = F.bid - 4, h = hd >> 1;
        if (l == 0) { if (hd & 1) scan_dir_local<1>(F, l, h, 0, sc_CARRY(F) + hd * 16384); else scan_dir_local<0>(F, l, h, 0, sc_CARRY(F) + hd * 16384); }
        else { if (hd & 1) scan_states<1>(F, l, h, 0, sc_CARRY(F) + hd * 16384, nullptr); else scan_states<0>(F, l, h, 0, sc_CARRY(F) + hd * 16384, nullptr); }
        return; }
    fftA_item(F, F.bid);
    if (F.bid >= 12 && F.bid < 20) fftA_item(F, F.bid - 8);
    if (l == 0) { pool_item(F, l, F.bid); if (F.bid >= 20 && F.bid < 28) pool_item(F, l, F.bid - 16); else if (F.bid >= 28 && F.bid < 32) pool_item(F, l, F.bid + 228); }
    else { pool_item(F, l, F.bid + 4); if (F.bid >= 20 && F.bid < 28) pool_item(F, l, F.bid - 12); }
}
__device__ __forceinline__ void ph_mixB(Frame& F, int l) {
    scanB(F);
    fftB_item(F, F.bid);
    if (l == 0 && F.bid >= 252) fftC_item(F, F.bid - 252);
    if (l == 0 && F.bid >= 240 && F.bid < 244) ctx_finalize(F, l, F.bid - 240);
}
__device__ __forceinline__ void ph_mixC(Frame& F, int l) {
    const int item = F.bid, h = item >> 6, seg = item & 63;
    scan_full(F, l, h, CTX + 256 * seg, sc_SS(F) + ((size_t)(h * 2 + 0) * 64 + seg) * 16384, sc_SS(F) + ((size_t)(h * 2 + 1) * 64 + seg) * 16384, nullptr, nullptr);
}
#define GRID_BAR() do { Frame R_ = relaunder(F); xcd_barrier(bar, R_.tid); } while (0)
#define PHASE(call) do { Frame R = relaunder(F); call; } while (0)
__global__ void __launch_bounds__(NTHR, 2) mega_fwd(Params p) {
    extern __shared__ __attribute__((aligned(16))) unsigned char lds[];
    Frame F; frame_init(F, p, lds);
    if (F.tid < 16) ((LAS unsigned*)(F.lds + MISC_OFF))[F.tid] = 0u;
    __syncthreads();
    XcdBarrier bar = xcd_barrier_post((unsigned*)(F.ctl() + CW_BAR), (volatile LAS unsigned*)(F.lds + MISC_OFF + 32));
    PHASE(ph_prologue(R)); PHASE(ph_prologue2(R));
    GRID_BAR();
    PHASE(ph_mod1(R, 0));
    GRID_BAR();
#pragma unroll 1
    for (int l = 0; l < 2; ++l) {
        PHASE(ph_win(R, l));            GRID_BAR();
        PHASE(ph_mixA(R, l));           GRID_BAR();
        PHASE(ph_mixB(R, l));           GRID_BAR();
        PHASE(ph_mixC(R, l));           GRID_BAR();
        PHASE(ph_wout(R, l));           GRID_BAR();
        PHASE(ph_mod2_route(R, l, l));  GRID_BAR();
        PHASE(ph_gateup(R, l));         GRID_BAR();
        PHASE(ph_down(R, l));           GRID_BAR();
        PHASE(ph_combine(R, l));
        if (l == 0) GRID_BAR();
    }
}
extern "C" void kernel_launch(void* const* d_in, const int* in_sizes, int n_in, void* d_out, int out_size, void* d_ws, size_t ws_size, hipStream_t stream) {
    static int ok = 0;
    if (ok == 0) {
        if (n_in != 22 || out_size != LAT * D || ws_size < WS_FASTEND) { fprintf(stderr, "kernel_launch: unexpected shapes / workspace (n_in %d, out %d, ws %zu < %zu); nothing launched\n", n_in, out_size, ws_size, (size_t)WS_FASTEND); ok = -1; return; }
        int dev = 0, cus = 0, per_cu = 0;
        if (hipGetDevice(&dev) != hipSuccess || hipDeviceGetAttribute(&cus, hipDeviceAttributeMultiprocessorCount, dev) != hipSuccess) { ok = -1; return; }
        if (hipFuncSetAttribute((const void*)mega_fwd, hipFuncAttributeMaxDynamicSharedMemorySize, LDS_BYTES) != hipSuccess) { fprintf(stderr, "kernel_launch: hipFuncSetAttribute failed\n"); ok = -1; return; }
        if (hipOccupancyMaxActiveBlocksPerMultiprocessor(&per_cu, (const void*)mega_fwd, NTHR, LDS_BYTES) != hipSuccess || per_cu < 1) fprintf(stderr, "kernel_launch: note: occupancy query reports %d workgroups per CU\n", per_cu);
        (void)hipGetLastError();
        if (cus < 256) fprintf(stderr, "kernel_launch: device has %d CUs; this kernel needs 256 co-resident workgroups (one per CU)\n", cus);
        ok = 1;
    }
    if (ok < 0) return;
    if (hipMemsetAsync((char*)d_ws + WS_CTL, 0, CTL_ZERO_BYTES, stream) != hipSuccess) return;
    Params p{}; for (int i = 0; i < 22; ++i) p.in[i] = (const float*)d_in[i]; p.out = (float*)d_out; p.ws = (unsigned char*)d_ws;
    hipLaunchKernelGGL(mega_fwd, dim3(256), dim3(NTHR), LDS_BYTES, stream, p);
}
```

```cpp
#include <hip/hip_runtime.h>
#include <cstdio>
#include <cstdint>
constexpr int D = 1024, LAT = 16384, CTX = 256, T = LAT + CTX, DIN = 3072, NE = 32, TOPK = 4;
constexpr int GW = 64;
#ifndef PSTR
#define PSTR DIN
#endif
constexpr int DINX = 3328, FQ_OFF = 2816;
#define GAS __attribute__((address_space(1)))
#define LAS __attribute__((address_space(3)))
typedef unsigned short bf16_t;
typedef short bf16x8 __attribute__((ext_vector_type(8)));
typedef short bf16x4 __attribute__((ext_vector_type(4)));
typedef float f32x4 __attribute__((ext_vector_type(4)));
typedef float f32x2 __attribute__((ext_vector_type(2)));
typedef unsigned u32x4 __attribute__((ext_vector_type(4)));
typedef unsigned u32x2 __attribute__((ext_vector_type(2)));
typedef GAS unsigned gu32;
#define RLX_AGENT __ATOMIC_RELAXED, __HIP_MEMORY_SCOPE_AGENT
#define LDS_WAIT() asm volatile("s_waitcnt lgkmcnt(0)" ::: "memory")
#define VM_WAIT() asm volatile("s_waitcnt vmcnt(0)" ::: "memory")
__device__ __forceinline__ unsigned cvt_pk_bf16(float lo, float hi) { unsigned r; asm("v_cvt_pk_bf16_f32 %0, %1, %2" : "=v"(r) : "v"(lo), "v"(hi)); return r; }
__device__ __forceinline__ unsigned f2bf(float f) { return cvt_pk_bf16(f, 0.f) & 0xffffu; }
__device__ __forceinline__ unsigned pk2(float lo, float hi) { return cvt_pk_bf16(lo, hi); }
__device__ __forceinline__ float bf2f(unsigned short b) { return __builtin_bit_cast(float, ((unsigned)b) << 16); }
__device__ __forceinline__ float bflo(unsigned w) { return __builtin_bit_cast(float, w << 16); }
__device__ __forceinline__ float bfhi(unsigned w) { return __builtin_bit_cast(float, w & 0xffff0000u); }
__device__ __forceinline__ float fsigm(float x) { return __builtin_amdgcn_rcpf(1.f + __builtin_amdgcn_exp2f(-1.44269504f * x)); }
__device__ __forceinline__ float lane_xor(float v, int m, int lane) { return __builtin_bit_cast(float, __builtin_amdgcn_ds_bpermute((lane ^ m) << 2, __builtin_bit_cast(int, v))); }
__device__ __forceinline__ int lane_get(int v, int src) { return __builtin_amdgcn_ds_bpermute(src << 2, v); }
__device__ __forceinline__ float wave_sum(float v, int lane) {
#pragma unroll
    for (int o = 1; o < 64; o <<= 1) v += lane_xor(v, o, lane);
    return v;
}

#define XB_TMO      128
#define XB_XCNT(j)  (256  + 64 * (j))
#define XB_XSUB(j)  (1280 + 64 * (j))
#define XB_XGEN(j)  (2304 + 64 * (j))
#define XB_TOP      3328
#define XB_TOPGEN   3392
#define XCD_BAR_WORDS 3456
#define XB_SPIN_CAP (1u << 18)
__device__ __forceinline__ unsigned xb_ld(unsigned* p)              { return __hip_atomic_load(p, __ATOMIC_RELAXED, __HIP_MEMORY_SCOPE_AGENT); }
__device__ __forceinline__ unsigned xb_add(unsigned* p, unsigned v) { return __hip_atomic_fetch_add(p, v, __ATOMIC_RELAXED, __HIP_MEMORY_SCOPE_AGENT); }
__device__ __forceinline__ unsigned xb_xcc_id() { return (unsigned)__builtin_amdgcn_s_getreg((3 << 11) | 20) & 0xFu; }
#define XB_SPIN(cond, bar) do { unsigned _sp = 0; while (cond) { __builtin_amdgcn_s_sleep(1); \
    if ((++_sp & 255u) == 0u) { if (xb_ld(&(bar)[XB_TMO])) break; if (_sp > XB_SPIN_CAP) { atomicAdd(&(bar)[XB_TMO], 1u); break; } } } } while (0)
struct XcdBarrier { unsigned* bar; unsigned x; volatile LAS unsigned* st; };
__device__ __forceinline__ XcdBarrier xcd_barrier_post(unsigned* bar, volatile LAS unsigned* st) {
    XcdBarrier b; b.bar = bar; b.x = xb_xcc_id(); b.st = st;
    if (threadIdx.x == 0) (void)xb_add(&bar[XB_XCNT(b.x)], 1u);
    return b;
}
__device__ __forceinline__ void xcd_barrier_complete(unsigned* bar, unsigned x, unsigned& nloc, unsigned& nx) {
    const unsigned G = gridDim.x * gridDim.y * gridDim.z;
    unsigned sum, cnt, mine, sp = 0u;
    for (;;) {
        sum = 0u; cnt = 0u; mine = 0u;
#pragma unroll
        for (unsigned j = 0; j < 16; ++j) { const unsigned c = xb_ld(&bar[XB_XCNT(j)]); sum += c; cnt += (c > 0u) ? 1u : 0u; mine = (j == x) ? c : mine; }
        if (sum == G) break;
        __builtin_amdgcn_s_sleep(1);
        if ((++sp & 255u) == 0u) { if (xb_ld(&bar[XB_TMO])) break; if (sp > XB_SPIN_CAP) { atomicAdd(&bar[XB_TMO], 1u); break; } }
    }
    nloc = mine > 0u ? mine : 1u; nx = cnt > 0u ? cnt : 1u;
}
__device__ __forceinline__ void xcd_barrier(const XcdBarrier& b, const int tid) {
    asm volatile("s_waitcnt vmcnt(0)" ::: "memory");
    unsigned blo = (unsigned)(unsigned long long)b.bar, bhi = (unsigned)((unsigned long long)b.bar >> 32), bx = b.x;
    asm volatile("" : "+s"(blo), "+s"(bhi), "+s"(bx));
    __syncthreads();
    if (tid == 0) {
        unsigned* bar = (unsigned*)(((unsigned long long)bhi << 32) | blo);
        __builtin_amdgcn_s_waitcnt(0);
        unsigned nloc = b.st[0], nx = b.st[1];
        if (nloc == 0u) { xcd_barrier_complete(bar, bx, nloc, nx); b.st[0] = nloc; b.st[1] = nx; }
        const unsigned old = xb_add(&bar[XB_XSUB(bx)], 1u);
        const unsigned gen = old / nloc;
        if (old + 1u == (gen + 1u) * nloc) {
            __builtin_amdgcn_fence(__ATOMIC_RELEASE, "agent");
            asm volatile("s_waitcnt vmcnt(0)" ::: "memory");
            const unsigned og = xb_add(&bar[XB_TOP], 1u);
            const unsigned tg = og / nx;
            if (og + 1u == (tg + 1u) * nx) xb_add(&bar[XB_TOPGEN], 1u);
            else XB_SPIN(xb_ld(&bar[XB_TOPGEN]) == tg, bar);
            __builtin_amdgcn_fence(__ATOMIC_ACQUIRE, "agent");
            xb_add(&bar[XB_XGEN(bx)], 1u);
            asm volatile("s_waitcnt vmcnt(0)" ::: "memory");
        } else {
            XB_SPIN(xb_ld(&bar[XB_XGEN(bx)]) == gen, bar);
            __builtin_amdgcn_fence(__ATOMIC_ACQUIRE, "agent");
            asm volatile("s_waitcnt vmcnt(0)" ::: "memory");
        }
    }
    __syncthreads();
}

namespace pg8 {
constexpr int BM = 256, BK = 64, HALF = 128, HTB = HALF * BK * 2, STAGE_BYTES = 8 * HTB, NXCD = 8, WGM = 8;
__host__ __device__ __forceinline__ int lds_byte(int r, int c) { const int st = (r >> 4) * 2 + (c >> 5), rr = r & 15, cc = c & 31, ob = rr * 64 + cc * 2; return st * 1024 + (ob ^ (((ob >> 9) & 1) << 5)); }
__host__ __device__ __forceinline__ void stage_rc(int b, int& R, int& C) { const int st = b / 1024, sb = b % 1024, swz = sb ^ (((sb >> 9) & 1) << 5); R = (st >> 1) * 16 + swz / 64; C = (st & 1) * 32 + (swz % 64) / 2; }
__host__ __device__ __forceinline__ int perm32(int rho) { const int n = rho >> 4, i = rho & 15; return 8 * (i >> 2) + 4 * n + (i & 3); }

struct Unit { int pm, pn, e, ui; };

typedef int i32x8 __attribute__((ext_vector_type(8)));
typedef int i32x4 __attribute__((ext_vector_type(4)));
__device__ __forceinline__ i32x8 cat8(bf16x8 a, bf16x8 b) { return __builtin_shufflevector(__builtin_bit_cast(i32x4, a), __builtin_bit_cast(i32x4, b), 0, 1, 2, 3, 4, 5, 6, 7); }
template <class Epi, class Sched, bool ALIGN_EPI = true, bool FP8 = false>
__device__ __forceinline__ void gemm_phase(LAS unsigned char* lds, const char* gA, const int Kb, const Sched& S, const Epi& E, const int tid) {
    const int wid = __builtin_amdgcn_readfirstlane(tid >> 6), lane = tid & 63, wr = wid >> 2, wc = wid & 3, fr = lane & 15, fq = lane >> 4;
    const int nt = Kb / (BK * 2);
    int Ra[2], Ca[2]; unsigned voffB[2];
#pragma unroll
    for (int i = 0; i < 2; ++i) { int R, C; stage_rc(tid * 16 + i * 8192, R, C); const int Rb = Epi::PERM ? ((R & ~31) + perm32(R & 31)) : R;
        Ra[i] = R; Ca[i] = C * 2; voffB[i] = (unsigned)(Rb * Kb + C * 2); }
    const size_t kstep = (size_t)(BK * 2);
    const size_t hstep = (size_t)HALF * Kb;
    const unsigned ldsw = (unsigned)wid * 1024u;
    const int aoff = lds_byte(wr * 64 + fr, fq * 8), boff = lds_byte(wc * 32 + fr, fq * 8);
#define PG8_SA(b, h) (((b) * 2 + (h)) * HTB)
#define PG8_SB(b, h) ((4 + (b) * 2 + (h)) * HTB)
#define PG8_STAGE(bufoff, gbase, voff) do { _Pragma("unroll") for (int _i = 0; _i < 2; ++_i) \
        __builtin_amdgcn_global_load_lds((const unsigned*)((const char*)(gbase) + (voff)[_i]), (LAS unsigned*)(lds + (bufoff) + ldsw + _i * 8192), 16, 0, 0); } while (0)
#define PG8_LDA(dst, b, h) do { _Pragma("unroll") for (int m = 0; m < 4; ++m) _Pragma("unroll") for (int k = 0; k < 2; ++k) dst[m][k] = *(const LAS bf16x8*)(lds + PG8_SA(b, h) + aoff + m * 2048 + k * 1024); } while (0)
#define PG8_LDB(dst, b, h) do { _Pragma("unroll") for (int n = 0; n < 2; ++n) _Pragma("unroll") for (int k = 0; k < 2; ++k) dst[n][k] = *(const LAS bf16x8*)(lds + PG8_SB(b, h) + boff + n * 2048 + k * 1024); } while (0)
#define PG8_MMA(ai, bj, At, Bt) do { __builtin_amdgcn_s_setprio(1); _Pragma("unroll") for (int m = 0; m < 4; ++m) _Pragma("unroll") for (int n = 0; n < 2; ++n) { \
        if constexpr (FP8) asm volatile("v_mfma_scale_f32_16x16x128_f8f6f4 %0, %1, %2, %0, %3, %3 op_sel_hi:[0,0,0]" : "+v"(acc[ai][bj][m][n]) : "v"(cat8(Bt[n][0], Bt[n][1])), "v"(cat8(At[m][0], At[m][1])), "v"(scl)); \
        else { _Pragma("unroll") for (int k = 0; k < 2; ++k) acc[ai][bj][m][n] = __builtin_amdgcn_mfma_f32_16x16x32_bf16(Bt[n][k], At[m][k], acc[ai][bj][m][n], 0, 0, 0); } } __builtin_amdgcn_s_setprio(0); } while (0)
#define PG8_WAIT_V(n) asm volatile("s_waitcnt vmcnt(" #n ")" ::: "memory")
#define PG8_WAIT_L(n) asm volatile("s_waitcnt lgkmcnt(" #n ")" ::: "memory")
#define PG8_BAR __builtin_amdgcn_s_barrier()
#define PG8_SCHED __builtin_amdgcn_sched_barrier(0)
    Unit cur, nxt; int ui = 0;
    if (!S.next(0, cur)) return;
    f32x4 acc[2][2][4][2];
#pragma unroll
    for (int a = 0; a < 2; ++a)
#pragma unroll
        for (int b = 0; b < 2; ++b)
#pragma unroll
            for (int m = 0; m < 4; ++m)
#pragma unroll
                for (int n = 0; n < 2; ++n) acc[a][b][m][n] = (f32x4){0.f, 0.f, 0.f, 0.f};
    bf16x8 At[4][2], B0[2][2], B1[2][2]; const int scl = 0x7f7f7f7f;
    unsigned vA[2][2];
#pragma unroll
    for (int h = 0; h < 2; ++h)
#pragma unroll
        for (int i = 0; i < 2; ++i) vA[h][i] = S.a_row_off(cur, h * HALF + Ra[i]) + (unsigned)Ca[i];
    const char* cB = S.b_tile(cur);
    PG8_STAGE(PG8_SB(0, 0), cB, voffB); PG8_STAGE(PG8_SB(0, 1), cB + hstep, voffB); PG8_STAGE(PG8_SA(0, 0), gA, vA[0]); PG8_STAGE(PG8_SA(0, 1), gA, vA[1]);
    if (wr == 1) PG8_BAR;
    PG8_WAIT_V(2); PG8_BAR;
    PG8_STAGE(PG8_SB(1, 0), cB + kstep, voffB); PG8_STAGE(PG8_SA(1, 0), gA + kstep, vA[0]); PG8_STAGE(PG8_SB(1, 1), cB + hstep + kstep, voffB);
    PG8_WAIT_V(6); PG8_BAR;
    for (;;) {
        const bool has_next = S.next(ui + 1, nxt);
        const char* nB = has_next ? S.b_tile(nxt) : cB;
        for (int t = 0; t < nt; t += 2) {
            const bool last = (t == nt - 2);
            unsigned tN[2][2];
#pragma unroll
            for (int h = 0; h < 2; ++h)
#pragma unroll
                for (int i = 0; i < 2; ++i) tN[h][i] = vA[h][i];
            if (last && has_next) {
#pragma unroll
                for (int h = 0; h < 2; ++h)
#pragma unroll
                    for (int i = 0; i < 2; ++i) tN[h][i] = S.a_row_off(nxt, h * HALF + Ra[i]) + (unsigned)Ca[i];
                PG8_WAIT_L(0);
            }
            const char* a1 = gA + (size_t)(t + 1) * kstep;
            const char* a2 = last ? gA : gA + (size_t)(t + 2) * kstep; const char* b2 = last ? nB : cB + (size_t)(t + 2) * kstep;
            const char* a3 = a2 + kstep; const char* b3 = b2 + kstep;
            PG8_LDB(B0, 0, 0); PG8_LDB(B1, 0, 1); PG8_SCHED; PG8_LDA(At, 0, 0); PG8_STAGE(PG8_SA(1, 1), a1, vA[1]);
#pragma unroll
            for (int h = 0; h < 2; ++h)
#pragma unroll
                for (int i = 0; i < 2; ++i) vA[h][i] = tN[h][i];
            PG8_WAIT_V(8); PG8_WAIT_L(0); PG8_BAR; PG8_MMA(0, 0, At, B0); PG8_MMA(0, 1, At, B1); PG8_BAR; PG8_SCHED;
            PG8_LDA(At, 0, 1); PG8_STAGE(PG8_SB(0, 0), b2, voffB); PG8_STAGE(PG8_SB(0, 1), b2 + hstep, voffB); PG8_STAGE(PG8_SA(0, 0), a2, vA[0]);
            PG8_WAIT_V(8); PG8_WAIT_L(0); PG8_BAR; PG8_MMA(1, 0, At, B0); PG8_MMA(1, 1, At, B1); PG8_BAR; PG8_SCHED;
            PG8_LDB(B0, 1, 0); PG8_LDB(B1, 1, 1); PG8_SCHED; PG8_LDA(At, 1, 0); PG8_STAGE(PG8_SA(0, 1), a2, vA[1]);
            PG8_WAIT_V(8); PG8_WAIT_L(0); PG8_BAR; PG8_MMA(0, 0, At, B0); PG8_MMA(0, 1, At, B1); PG8_BAR; PG8_SCHED;
            PG8_LDA(At, 1, 1); PG8_STAGE(PG8_SB(1, 0), b3, voffB); PG8_STAGE(PG8_SB(1, 1), b3 + hstep, voffB); PG8_STAGE(PG8_SA(1, 0), a3, vA[0]);
            PG8_WAIT_V(8); PG8_WAIT_L(0); PG8_BAR; PG8_MMA(1, 0, At, B0); PG8_MMA(1, 1, At, B1); PG8_BAR; PG8_SCHED;
        }
        if constexpr (ALIGN_EPI) { if (wr == 0) PG8_BAR; }
        if constexpr (FP8) asm volatile("s_nop 15\n\ts_nop 15" ::: "memory");
        E(acc, cur, wr, wc, fr, fq);
        if (!has_next) break;
#pragma unroll
        for (int a = 0; a < 2; ++a)
#pragma unroll
            for (int b = 0; b < 2; ++b)
#pragma unroll
                for (int m = 0; m < 4; ++m)
#pragma unroll
                    for (int n = 0; n < 2; ++n) acc[a][b][m][n] = (f32x4){0.f, 0.f, 0.f, 0.f};
        cur = nxt; cB = nB; ++ui;
        if constexpr (ALIGN_EPI) { if (wr == 1) PG8_BAR; }
    }
    PG8_WAIT_V(0);
    if constexpr (!ALIGN_EPI) { if (wr == 0) PG8_BAR; }
    PG8_BAR;
#undef PG8_SA
#undef PG8_SB
#undef PG8_STAGE
#undef PG8_LDA
#undef PG8_LDB
#undef PG8_MMA
#undef PG8_WAIT_V
#undef PG8_WAIT_L
#undef PG8_BAR
#undef PG8_SCHED
}
}
constexpr size_t MiB = 1u << 20;
constexpr int TP = T * 4 + NE * 256;
constexpr size_t WS_CTL = 0, CTL_ZERO_BYTES = 128 * 1024;
constexpr size_t WS_LB = 1 * MiB, WS_MOD = 1 * MiB + 65536;
constexpr size_t WS_WIN = 2 * MiB, WS_WOUT = 18 * MiB, WS_WF = 22 * MiB, WS_WGU = 24 * MiB, WS_WDN = 280 * MiB;
constexpr size_t WS_X = 408 * MiB, WS_H = 474 * MiB, WS_P = 508 * MiB, WS_CAT = 624 * MiB, WS_ROUTE = 658 * MiB, WS_ACT = 662 * MiB, WS_Y = 810 * MiB;
constexpr size_t WS_SU = 958 * MiB, WS_SS = 990 * MiB, WS_SD = 1022 * MiB, WS_YP = 1023 * MiB, WS_OSCR = 1040 * MiB, WS_H8 = 1072 * MiB, WS_CTXO = 1090 * MiB, WS_FASTEND = 1092 * MiB;
#ifndef MOE_FP8
#define MOE_FP8 1
#endif
constexpr float FP8_SH = 16.f, FP8_SW = 256.f, FP8_SA = 4.f;
constexpr size_t RT_TOPI = 0, RT_TOPW = 512 * 1024, RT_POS = 1024 * 1024, RT_LISTE = 1536 * 1024;
static_assert((size_t)T * 16 <= 512 * 1024 && RT_LISTE + (size_t)NE * T * 4 <= 4 * MiB, "route map");
static_assert(WS_WIN + (size_t)2 * DINX * D * 2 <= WS_WOUT && WS_WGU + (size_t)2 * NE * 2048 * 1024 * 2 <= WS_WDN && WS_WDN + (size_t)2 * NE * 1024 * 1024 * 2 <= WS_X && WS_X + (size_t)T * D * 4 <= WS_H && WS_H + (size_t)T * D * 2 <= WS_P &&
              WS_P + (size_t)T * DINX * 2 <= WS_CAT && WS_CAT + (size_t)T * D * 2 <= WS_ROUTE && WS_ACT + (size_t)TP * D * 2 <= WS_Y && WS_Y + (size_t)TP * D * 2 <= WS_SU &&
              WS_SD + (size_t)(8 * 64 * 128 + 8 * 16384) * 4 <= WS_YP && WS_YP + (size_t)128 * 128 * 2 * 256 * 2 <= WS_OSCR && WS_OSCR + (size_t)256 * 32768 * 4 <= WS_H8 && WS_H8 + (size_t)T * D <= WS_CTXO && WS_CTXO + (size_t)32 * 8192 * 4 <= WS_FASTEND, "ws map");
constexpr int CW_TMO = 0, CW_BAR = 4096, CW_CNT = 16384;
constexpr int RING_OFF = 0, RING_BYTES = 131072, TINFO_OFF = 131072, BT_OFF = 136192, ROWOFF_OFF = 136704, MISC_OFF = 146944, LDS_BYTES = 147456;
constexpr int NWAVES = 8, NTHR = 512;

struct Params { const float* in[22]; float* out; unsigned char* ws; };
constexpr int PTR_OFF = MISC_OFF + 64;
struct Frame {
    LAS unsigned char* lds; unsigned char* ws; int tid, lane, wave, vcu, G, bid;
    __device__ __forceinline__ const float* in(int i) const { const LAS unsigned* q = (const LAS unsigned*)(lds + PTR_OFF) + 2 * i;
        const unsigned lo = __builtin_amdgcn_readfirstlane(q[0]), hi = __builtin_amdgcn_readfirstlane(q[1]); return (const float*)(((unsigned long long)hi << 32) | lo); }
    __device__ __forceinline__ const float* x() const { return in(0); }        __device__ __forceinline__ const float* c() const { return in(1); }
    __device__ __forceinline__ const float* ctxin() const { return in(2); }    __device__ __forceinline__ const float* cctx() const { return in(3); }
    __device__ __forceinline__ const float* w_ada() const { return in(4); }    __device__ __forceinline__ const float* b_ada() const { return in(5); }
    __device__ __forceinline__ const float* norm1_g() const { return in(6); }  __device__ __forceinline__ const float* norm2_g() const { return in(7); }
    __device__ __forceinline__ const float* w_in() const { return in(8); }     __device__ __forceinline__ const float* lbp() const { return in(9); }
    __device__ __forceinline__ const float* hng() const { return in(10); }     __device__ __forceinline__ const float* pool_w() const { return in(11); }
    __device__ __forceinline__ const float* pool_s() const { return in(12); }  __device__ __forceinline__ const float* four_w() const { return in(13); }
    __device__ __forceinline__ const float* w_out() const { return in(14); }   __device__ __forceinline__ const float* router_w() const { return in(15); }
    __device__ __forceinline__ const float* router_b() const { return in(16); } __device__ __forceinline__ const float* w_gu() const { return in(17); }
    __device__ __forceinline__ const float* b_gu() const { return in(18); }    __device__ __forceinline__ const float* w_dn() const { return in(19); }
    __device__ __forceinline__ const float* b_dn() const { return in(20); }    __device__ __forceinline__ const float* fng() const { return in(21); }
    __device__ __forceinline__ float* out() const { return (float*)in(22); }
    __device__ __forceinline__ gu32* ctl() const { return (gu32*)(ws + WS_CTL); }
    __device__ __forceinline__ float* LB() const { return (float*)(ws + WS_LB); }       __device__ __forceinline__ float* MOD() const { return (float*)(ws + WS_MOD); }
    __device__ __forceinline__ float* X() const { return (float*)(ws + WS_X); }
    __device__ __forceinline__ bf16_t* Wt_in() const { return (bf16_t*)(ws + WS_WIN); }  __device__ __forceinline__ bf16_t* Wt_out() const { return (bf16_t*)(ws + WS_WOUT); }
    __device__ __forceinline__ bf16_t* Wt_gu() const { return (bf16_t*)(ws + WS_WGU); }  __device__ __forceinline__ bf16_t* Wt_dn() const { return (bf16_t*)(ws + WS_WDN); }
    __device__ __forceinline__ bf16_t* H() const { return (bf16_t*)(ws + WS_H); }        __device__ __forceinline__ bf16_t* P() const { return (bf16_t*)(ws + WS_P); }
    __device__ __forceinline__ bf16_t* CAT() const { return (bf16_t*)(ws + WS_CAT); }    __device__ __forceinline__ bf16_t* ACT() const { return (bf16_t*)(ws + WS_ACT); }
    __device__ __forceinline__ bf16_t* Y() const { return (bf16_t*)(ws + WS_Y); }
    __device__ __forceinline__ int* TOPI() const { return (int*)(ws + WS_ROUTE + RT_TOPI); }   __device__ __forceinline__ float* TOPW() const { return (float*)(ws + WS_ROUTE + RT_TOPW); }
    __device__ __forceinline__ int* POS() const { return (int*)(ws + WS_ROUTE + RT_POS); }     __device__ __forceinline__ int* LISTE() const { return (int*)(ws + WS_ROUTE + RT_LISTE); }
};
__device__ __forceinline__ void frame_init(Frame& F, const Params& p, unsigned char* lds) {
    F.lds = (LAS unsigned char*)lds; F.tid = threadIdx.x; F.lane = F.tid & 63; F.wave = __builtin_amdgcn_readfirstlane(F.tid >> 6);
    F.G = gridDim.x; F.bid = blockIdx.x; { const int bx = blockIdx.x; F.vcu = (F.G % 8 == 0) ? (bx % 8) * (F.G / 8) + bx / 8 : bx; }
    F.ws = p.ws;
    if (F.tid == 0) { LAS unsigned long long* tab = (LAS unsigned long long*)(F.lds + PTR_OFF);
#pragma unroll
        for (int i = 0; i < 22; ++i) tab[i] = (unsigned long long)p.in[i];
        tab[22] = (unsigned long long)p.out; }
    __syncthreads();
}

__device__ __forceinline__ Frame relaunder(const Frame& F) { Frame R = F; int ln; asm volatile("v_mbcnt_lo_u32_b32 %0, -1, 0\n\tv_mbcnt_hi_u32_b32 %0, -1, %0" : "=v"(ln));
    R.lane = ln; R.tid = F.wave * 64 + ln; unsigned wlo = (unsigned)(unsigned long long)F.ws, whi = (unsigned)((unsigned long long)F.ws >> 32);
    asm volatile("" : "+s"(wlo), "+s"(whi)); R.ws = (unsigned char*)(((unsigned long long)whi << 32) | wlo);
    int sw = F.wave, sv = F.vcu, sg = F.G, sb = F.bid;
    asm volatile("" : "+s"(sw), "+s"(sv), "+s"(sg), "+s"(sb));
    R.wave = sw; R.vcu = sv; R.G = sg; R.bid = sb; R.tid = sw * 64 + ln; return R; }

struct DenseOrder {
    int nM, nN, nwg, G, c, Kb, pm0; const char* Bt;
    __device__ void init(int nM_, int nN_, int G_, int c_, int Kb_, const bf16_t* Bt_, int pm0_ = 0) { nM = nM_; nN = nN_; nwg = nM * nN; G = G_; c = c_; Kb = Kb_; Bt = (const char*)Bt_; pm0 = pm0_; }
    __device__ __forceinline__ bool next(int i, pg8::Unit& u) const {
        const long L = (long)i * G + c; if (L >= nwg) return false;
        int wgid = (int)L; { const int q = nwg / pg8::NXCD, r = nwg % pg8::NXCD, xcd = wgid % pg8::NXCD, off = wgid / pg8::NXCD; wgid = (xcd < r ? xcd * (q + 1) : r * (q + 1) + (xcd - r) * q) + off; }
        const int nig = pg8::WGM * nN, gid = wgid / nig, fm = gid * pg8::WGM, gsz = (nM - fm) < pg8::WGM ? (nM - fm) : pg8::WGM;
        u.pm = pm0 + fm + ((wgid % nig) % gsz); u.pn = (wgid % nig) / gsz; u.e = 0; u.ui = i; return true;
    }
    __device__ __forceinline__ const char* b_tile(const pg8::Unit& u) const { return Bt + (size_t)u.pn * 256 * Kb; }
    __device__ __forceinline__ unsigned a_row_off(const pg8::Unit& u, int r) const { return (unsigned)(u.pm * 256 + r) * (unsigned)Kb; }
};
template <bool GATHER> struct MoeOrder {
    const LAS int* tinfo; const LAS unsigned* rowoff; int ntiles, nN, G, c, Kb; const char* W; size_t wstride;
    __device__ __forceinline__ bool next(int i, pg8::Unit& u) const {
        const int L = i * G + c; if (L >= ntiles * nN) return false;
        u.pm = L / nN; u.pn = L % nN; u.e = __builtin_amdgcn_readfirstlane(tinfo[4 * u.pm]); u.ui = i; return true;
    }
    __device__ __forceinline__ const char* b_tile(const pg8::Unit& u) const { return W + (size_t)u.e * wstride + (size_t)u.pn * 256 * Kb; }
    __device__ __forceinline__ unsigned a_row_off(const pg8::Unit& u, int r) const { if constexpr (GATHER) return rowoff[u.ui * 256 + r]; else return (unsigned)(u.pm * 256 + r) * (unsigned)Kb; }
};

__device__ __forceinline__ unsigned pk_f16(float a, float b) { const _Float16 x = (_Float16)a, y = (_Float16)b; return (unsigned)__builtin_bit_cast(unsigned short, x) | ((unsigned)__builtin_bit_cast(unsigned short, y) << 16); }
__device__ __forceinline__ float f16lo(unsigned w) { return (float)__builtin_bit_cast(_Float16, (unsigned short)(w & 0xffffu)); }
__device__ __forceinline__ float f16hi(unsigned w) { return (float)__builtin_bit_cast(_Float16, (unsigned short)(w >> 16)); }
struct EpiP {
    static constexpr bool PERM = true; bf16_t* O; int ldc; const float* lb;
    __device__ __forceinline__ void operator()(const f32x4 (&acc)[2][2][4][2], const pg8::Unit& u, int wr, int wc, int fr, int fq) const {
        const int row0 = u.pm * 256 + wr * 64 + fr, col0 = u.pn * 256 + wc * 32 + 8 * fq;
        const int mode = u.pn < 2 ? 1 : (u.pn < 6 ? 2 : ((u.pn == 8 || u.pn == 9) ? 3 : 0));
        f32x4 lbv[2][2];
        if (mode == 2) {
#pragma unroll
            for (int bj = 0; bj < 2; ++bj)
#pragma unroll
                for (int n = 0; n < 2; ++n) lbv[bj][n] = *(const f32x4*)(lb + (col0 - 512) + bj * 128 + 4 * n); }
#pragma unroll
        for (int ai = 0; ai < 2; ++ai)
#pragma unroll
            for (int m = 0; m < 4; ++m) { bf16_t* rowp = O + (size_t)(row0 + ai * 128 + m * 16) * ldc + col0;
#pragma unroll
                for (int bj = 0; bj < 2; ++bj) { f32x2 v[4]; { const f32x4 v0 = acc[ai][bj][m][0], v1 = acc[ai][bj][m][1]; v[0] = (f32x2){v0[0], v0[1]}; v[1] = (f32x2){v0[2], v0[3]}; v[2] = (f32x2){v1[0], v1[1]}; v[3] = (f32x2){v1[2], v1[3]}; }
                    u32x4 w;
                    if (mode != 0) {
                        f32x2 sg[4];
#pragma unroll
                        for (int p = 0; p < 4; ++p) { const f32x2 ex = v[p] * (-1.44269504f); f32x2 d; d.x = __builtin_amdgcn_exp2f(ex.x); d.y = __builtin_amdgcn_exp2f(ex.y); d = d + 1.0f; sg[p].x = __builtin_amdgcn_rcpf(d.x); sg[p].y = __builtin_amdgcn_rcpf(d.y); }
                        if (mode == 2) {
#pragma unroll
                            for (int p = 0; p < 4; ++p) { const f32x4 lv = lbv[bj][p >> 1]; const f32x2 lb2 = (f32x2){lv[2 * (p & 1)], lv[2 * (p & 1) + 1]}; const f32x2 f = lb2 + (1.0f - lb2) * sg[p];
                                v[p].x = __builtin_amdgcn_logf(fmaxf(f.x, 1e-30f)); v[p].y = __builtin_amdgcn_logf(fmaxf(f.y, 1e-30f)); }
                            w.x = pk_f16(v[0].x, v[0].y); w.y = pk_f16(v[1].x, v[1].y); w.z = pk_f16(v[2].x, v[2].y); w.w = pk_f16(v[3].x, v[3].y);
                        } else {
#pragma unroll
                            for (int p = 0; p < 4; ++p) v[p] = mode == 1 ? v[p] * sg[p] : sg[p];
                            w.x = cvt_pk_bf16(v[0].x, v[0].y); w.y = cvt_pk_bf16(v[1].x, v[1].y); w.z = cvt_pk_bf16(v[2].x, v[2].y); w.w = cvt_pk_bf16(v[3].x, v[3].y); }
                    } else { w.x = cvt_pk_bf16(v[0].x, v[0].y); w.y = cvt_pk_bf16(v[1].x, v[1].y); w.z = cvt_pk_bf16(v[2].x, v[2].y); w.w = cvt_pk_bf16(v[3].x, v[3].y); }
                    *(u32x4*)(rowp + bj * 128) = w; } }
    }
};
struct EpiRes {
    static constexpr bool PERM = false; const float* base_ctx; const float* base_lat; const float* gate_ctx; const float* gate_lat; float* Xo;
    __device__ __forceinline__ void operator()(const f32x4 (&acc)[2][2][4][2], const pg8::Unit& u, int wr, int wc, int fr, int fq) const {
        const int rt = wr * 64 + fr, col0 = u.pn * 256 + wc * 32 + 4 * fq;
        const float* base = (u.pm == 0 ? base_ctx : base_lat + (size_t)(u.pm - 1) * 256 * D) + (size_t)rt * D + col0; const float* gate = (u.pm == 0 ? gate_ctx : gate_lat) + col0;
        float* op = Xo + (size_t)(u.pm * 256 + rt) * D + col0;
#pragma unroll
        for (int bj = 0; bj < 2; ++bj)
#pragma unroll
            for (int n = 0; n < 2; ++n) { const f32x4 gv = *(const f32x4*)(gate + bj * 128 + n * 16);
#pragma unroll
                for (int ai = 0; ai < 2; ++ai) {
#pragma unroll
                    for (int m = 0; m < 4; ++m) { const size_t o = (size_t)(ai * 128 + m * 16) * D + bj * 128 + n * 16; const f32x4 b = *(const f32x4*)(base + o); *(f32x4*)(op + o) = b + gv * acc[ai][bj][m][n]; }
                    asm volatile("" ::: "memory"); } }
    }
};
struct EpiAct {
    static constexpr bool PERM = true; bf16_t* ACTo; const float* bias;
    __device__ __forceinline__ void operator()(const f32x4 (&acc)[2][2][4][2], const pg8::Unit& u, int wr, int wc, int fr, int fq) const {
        const int x0 = wc * 32 + 8 * fq; const float* bg = bias + (size_t)u.e * 2048 + 128 * u.pn + x0; const float* bu = bg + 1024;
        const f32x4 g0 = *(const f32x4*)bg, g1 = *(const f32x4*)(bg + 4), u0 = *(const f32x4*)bu, u1 = *(const f32x4*)(bu + 4);
#pragma unroll
        for (int ai = 0; ai < 2; ++ai)
#pragma unroll
            for (int m = 0; m < 4; ++m) { const int row = u.pm * 256 + ai * 128 + wr * 64 + m * 16 + fr;
                const f32x4 ga = acc[ai][0][m][0] + g0, gb = acc[ai][0][m][1] + g1, ua = acc[ai][1][m][0] + u0, ub = acc[ai][1][m][1] + u1; float r[8];
#pragma unroll
                for (int j = 0; j < 4; ++j) { const float g = fminf(ga[j], 7.f), up = fminf(fmaxf(ua[j], -7.f), 7.f); r[j] = (up + 1.f) * (g * fsigm(1.702f * g));
                                              const float g2 = fminf(gb[j], 7.f), up2 = fminf(fmaxf(ub[j], -7.f), 7.f); r[4 + j] = (up2 + 1.f) * (g2 * fsigm(1.702f * g2)); }
                u32x4 w; w.x = cvt_pk_bf16(r[0], r[1]); w.y = cvt_pk_bf16(r[2], r[3]); w.z = cvt_pk_bf16(r[4], r[5]); w.w = cvt_pk_bf16(r[6], r[7]);
                *(u32x4*)(ACTo + (size_t)row * D + 128 * u.pn + x0) = w; }
    }
};
struct EpiY {
    static constexpr bool PERM = true; bf16_t* Yo; const float* bias;
    __device__ __forceinline__ void operator()(const f32x4 (&acc)[2][2][4][2], const pg8::Unit& u, int wr, int wc, int fr, int fq) const {
        const int row0 = u.pm * 256 + wr * 64 + fr, col0 = u.pn * 256 + wc * 32 + 8 * fq; const float* bp = bias + (size_t)u.e * D + col0;
        f32x4 bv[2][2];
#pragma unroll
        for (int bj = 0; bj < 2; ++bj)
#pragma unroll
            for (int n = 0; n < 2; ++n) bv[bj][n] = *(const f32x4*)(bp + bj * 128 + 4 * n);
#pragma unroll
        for (int ai = 0; ai < 2; ++ai)
#pragma unroll
            for (int m = 0; m < 4; ++m) { bf16_t* rowp = Yo + (size_t)(row0 + ai * 128 + m * 16) * D + col0;
#pragma unroll
                for (int bj = 0; bj < 2; ++bj) { const f32x4 v0 = acc[ai][bj][m][0] + bv[bj][0], v1 = acc[ai][bj][m][1] + bv[bj][1];
                    u32x4 w; w.x = cvt_pk_bf16(v0[0], v0[1]); w.y = cvt_pk_bf16(v0[2], v0[3]); w.z = cvt_pk_bf16(v1[0], v1[1]); w.w = cvt_pk_bf16(v1[2], v1[3]);
                    *(u32x4*)(rowp + bj * 128) = w; } }
    }
};

__device__ __forceinline__ unsigned pk4_fp8(float a, float b, float c, float d) { int r = __builtin_amdgcn_cvt_pk_fp8_f32(a, b, 0, false); r = __builtin_amdgcn_cvt_pk_fp8_f32(c, d, r, true); return (unsigned)r; }
struct EpiAct8 {
    static constexpr bool PERM = true; unsigned char* ACTo; const float* bias;
    __device__ __forceinline__ void operator()(const f32x4 (&acc)[2][2][4][2], const pg8::Unit& u, int wr, int wc, int fr, int fq) const {
        const int x0 = wc * 32 + 8 * fq; const float* bg = bias + (size_t)u.e * 2048 + 128 * u.pn + x0; const float* bu = bg + 1024; constexpr float isc = 1.f / (FP8_SH * FP8_SW);
        f32x2 g[4], v[4];
#pragma unroll
        for (int p = 0; p < 4; ++p) { g[p] = *(const f32x2*)(bg + 2 * p); v[p] = *(const f32x2*)(bu + 2 * p); }
#pragma unroll
        for (int ai = 0; ai < 2; ++ai)
#pragma unroll
            for (int m = 0; m < 4; ++m) { const int row = u.pm * 256 + ai * 128 + wr * 64 + m * 16 + fr; f32x2 r[4];
#pragma unroll
                for (int p = 0; p < 4; ++p) { const f32x4 ga4 = acc[ai][0][m][p >> 1], ua4 = acc[ai][1][m][p >> 1];
                    f32x2 gg = (f32x2){ga4[2 * (p & 1)], ga4[2 * (p & 1) + 1]} * isc + g[p], uu = (f32x2){ua4[2 * (p & 1)], ua4[2 * (p & 1) + 1]} * isc + v[p];
                    gg.x = fminf(gg.x, 7.f); gg.y = fminf(gg.y, 7.f); uu.x = __builtin_amdgcn_fmed3f(uu.x, -7.f, 7.f); uu.y = __builtin_amdgcn_fmed3f(uu.y, -7.f, 7.f);
                    const f32x2 ex = gg * (-1.702f * 1.44269504f); f32x2 d; d.x = __builtin_amdgcn_exp2f(ex.x); d.y = __builtin_amdgcn_exp2f(ex.y); d = d + 1.0f;
                    f32x2 rc; rc.x = __builtin_amdgcn_rcpf(d.x); rc.y = __builtin_amdgcn_rcpf(d.y);
                    r[p] = (uu * FP8_SA + FP8_SA) * (gg * rc); }
                u32x2 w; w.x = pk4_fp8(r[0].x, r[0].y, r[1].x, r[1].y); w.y = pk4_fp8(r[2].x, r[2].y, r[3].x, r[3].y);
                *(u32x2*)(ACTo + (size_t)row * D + 128 * u.pn + x0) = w; }
    }
};
struct EpiY8 {
    static constexpr bool PERM = true; bf16_t* Yo; const float* bias;
    __device__ __forceinline__ void operator()(const f32x4 (&acc)[2][2][4][2], const pg8::Unit& u, int wr, int wc, int fr, int fq) const {
        const int row0 = u.pm * 256 + wr * 64 + fr, col0 = u.pn * 256 + wc * 32 + 8 * fq; const float* bp = bias + (size_t)u.e * D + col0; constexpr float isc = 1.f / (FP8_SA * FP8_SW);
        f32x4 bv[2][2];
#pragma unroll
        for (int bj = 0; bj < 2; ++bj)
#pragma unroll
            for (int n = 0; n < 2; ++n) bv[bj][n] = *(const f32x4*)(bp + bj * 128 + 4 * n);
#pragma unroll
        for (int ai = 0; ai < 2; ++ai)
#pragma unroll
            for (int m = 0; m < 4; ++m) { bf16_t* rowp = Yo + (size_t)(row0 + ai * 128 + m * 16) * D + col0;
#pragma unroll
                for (int bj = 0; bj < 2; ++bj) { const f32x4 v0 = acc[ai][bj][m][0] * isc + bv[bj][0], v1 = acc[ai][bj][m][1] * isc + bv[bj][1];
                    u32x4 w; w.x = cvt_pk_bf16(v0[0], v0[1]); w.y = cvt_pk_bf16(v0[2], v0[3]); w.z = cvt_pk_bf16(v1[0], v1[1]); w.w = cvt_pk_bf16(v1[2], v1[3]);
                    *(u32x4*)(rowp + bj * 128) = w; } }
    }
};

struct CvtJob { const float* W; bf16_t* WT; int N, K, k0, n0, nrow0; };
__device__ __forceinline__ void cvt_load(const CvtJob& j, int lane, f32x4 (&r)[16]) { const GAS f32x4* src = (const GAS f32x4*)((const GAS float*)j.W + (unsigned)((j.k0 + 8 * (lane >> 3)) * j.N + j.n0 + 8 * (lane & 7)));
    const unsigned rs = (unsigned)j.N >> 2;
#pragma unroll
    for (int i = 0; i < 8; ++i) { r[2 * i] = src[i * rs]; r[2 * i + 1] = src[i * rs + 1]; } }
__device__ __forceinline__ void cvt_store(const CvtJob& j, int lane, const f32x4 (&r)[16]) {
    u32x4 b[8];
#pragma unroll
    for (int i = 0; i < 8; ++i) { b[i].x = cvt_pk_bf16(r[2 * i][0], r[2 * i][1]); b[i].y = cvt_pk_bf16(r[2 * i][2], r[2 * i][3]); b[i].z = cvt_pk_bf16(r[2 * i + 1][0], r[2 * i + 1][1]); b[i].w = cvt_pk_bf16(r[2 * i + 1][2], r[2 * i + 1][3]); }
    GAS u32x4* dst = (GAS u32x4*)((GAS bf16_t*)j.WT + (unsigned)((j.nrow0 + 8 * (lane & 7)) * j.K + j.k0 + 8 * (lane >> 3))); const unsigned rs = (unsigned)j.K >> 3;
#pragma unroll
    for (int q = 0; q < 8; ++q) { const unsigned sel = (q & 1) ? 0x07060302u : 0x05040100u; u32x4 o;
        o.x = __builtin_amdgcn_perm(b[1][q >> 1], b[0][q >> 1], sel); o.y = __builtin_amdgcn_perm(b[3][q >> 1], b[2][q >> 1], sel);
        o.z = __builtin_amdgcn_perm(b[5][q >> 1], b[4][q >> 1], sel); o.w = __builtin_amdgcn_perm(b[7][q >> 1], b[6][q >> 1], sel);
        dst[q * rs] = o; } }
__device__ __forceinline__ void cvt8_load(const CvtJob& j, int lane, f32x4 (&r)[16]) { const GAS f32x4* src = (const GAS f32x4*)((const GAS float*)j.W + (unsigned)((j.k0 + 16 * (lane >> 3)) * j.N + j.n0 + 4 * (lane & 7)));
    const unsigned rs = (unsigned)j.N >> 2;
#pragma unroll
    for (int i = 0; i < 16; ++i) r[i] = src[i * rs]; }
__device__ __forceinline__ void cvt8_store(const CvtJob& j, int lane, const f32x4 (&r)[16]) {
    GAS u32x4* dst = (GAS u32x4*)((GAS unsigned char*)j.WT + (unsigned)((j.nrow0 + 4 * (lane & 7)) * j.K + j.k0 + 16 * (lane >> 3))); const unsigned rs = (unsigned)j.K >> 4;
#pragma unroll
    for (int n = 0; n < 4; ++n) { u32x4 o;
        o.x = pk4_fp8(r[0][n] * FP8_SW, r[1][n] * FP8_SW, r[2][n] * FP8_SW, r[3][n] * FP8_SW); o.y = pk4_fp8(r[4][n] * FP8_SW, r[5][n] * FP8_SW, r[6][n] * FP8_SW, r[7][n] * FP8_SW);
        o.z = pk4_fp8(r[8][n] * FP8_SW, r[9][n] * FP8_SW, r[10][n] * FP8_SW, r[11][n] * FP8_SW); o.w = pk4_fp8(r[12][n] * FP8_SW, r[13][n] * FP8_SW, r[14][n] * FP8_SW, r[15][n] * FP8_SW);
        dst[n * rs] = o; } }
constexpr int NB_IN = (FQ_OFF < DIN ? FQ_OFF : DIN) / 64, I_IN = 16 * NB_IN, I_OUT = 16 * 16, I_GU = MOE_FP8 ? 8 * 64 : 16 * 32, I_DN = MOE_FP8 ? 8 * 32 : 16 * 16;
constexpr int N_IN = 2 * I_IN, N_OUT = 2 * I_OUT, N_GU = 2 * NE * I_GU, N_DN = 2 * NE * I_DN, N_CVT = N_IN + N_OUT + N_GU + N_DN;
__device__ __forceinline__ CvtJob cvt_job(const Frame& F, int it, bool& f8) {
    CvtJob j; int r = it; f8 = false;
    if (r < N_IN) { const int l = r / I_IN, q = r % I_IN, kb = q / NB_IN, nb = q % NB_IN; j = CvtJob{F.w_in() + (size_t)l * D * DIN, F.Wt_in() + (size_t)l * DINX * D, DIN, D, 64 * kb, 64 * nb, 64 * nb}; return j; } r -= N_IN;
    if (r < N_OUT) { const int l = r / I_OUT, q = r % I_OUT, kb = q >> 4, nb = q & 15; j = CvtJob{F.w_out() + (size_t)l * D * D, F.Wt_out() + (size_t)l * D * D, D, D, 64 * kb, 64 * nb, 64 * nb}; return j; } r -= N_OUT;
    f8 = MOE_FP8;
    if (r < N_GU) { const int le = r / I_GU, q = r % I_GU; const int kb = MOE_FP8 ? q >> 6 : q >> 5, nb = MOE_FP8 ? q & 63 : q & 31; const int n0 = (MOE_FP8 ? 32 : 64) * nb, bj = n0 >> 10, xx = n0 & 1023;
        j = CvtJob{F.w_gu() + (size_t)le * D * 2048, (bf16_t*)((unsigned char*)F.Wt_gu() + (size_t)le * 2048 * D * (MOE_FP8 ? 1 : 2)), 2048, D, (MOE_FP8 ? 128 : 64) * kb, n0, 256 * (xx >> 7) + 128 * bj + (xx & 127)}; return j; } r -= N_GU;
    { const int le = r / I_DN, q = r % I_DN; const int kb = MOE_FP8 ? q >> 5 : q >> 4, nb = MOE_FP8 ? q & 31 : q & 15; const int n0 = (MOE_FP8 ? 32 : 64) * nb;
      j = CvtJob{F.w_dn() + (size_t)le * D * D, (bf16_t*)((unsigned char*)F.Wt_dn() + (size_t)le * D * D * (MOE_FP8 ? 1 : 2)), D, D, (MOE_FP8 ? 128 : 64) * kb, n0, n0}; return j; }
}
__device__ __forceinline__ void cvt_ld(const CvtJob& j, bool f8, int lane, f32x4 (&r)[16]) { if (f8) cvt8_load(j, lane, r); else cvt_load(j, lane, r); }
__device__ __forceinline__ void cvt_st(const CvtJob& j, bool f8, int lane, const f32x4 (&r)[16]) { if (f8) cvt8_store(j, lane, r); else cvt_store(j, lane, r); }
constexpr int WIN_UNITS = (T / 256) * (DINX / 256), WIN_BUSY = WIN_UNITS % 256, DEF_WIN = MOE_FP8 ? 3 : 0, DEF_WOUT = MOE_FP8 ? 3 : 0;
constexpr int DEF_A = (256 - WIN_BUSY) * NWAVES * DEF_WIN, DEF_B = (256 - 4) * NWAVES * DEF_WOUT, DEF_C = DEF_A, DEF_TOTAL = DEF_A + DEF_B + DEF_C;
constexpr int CVT_GU0 = N_IN + N_OUT, CVT_GU1 = CVT_GU0 + NE * I_GU;
static_assert(DEF_A + DEF_B <= NE * I_GU && DEF_C <= NE * I_GU, "deferred slices inside one layer's gate/up items");
__device__ __forceinline__ int cvt_remap(int j) { int it = j; if (it >= CVT_GU0) it += DEF_A + DEF_B; if (it >= CVT_GU1) it += DEF_C; return it; }
__device__ __forceinline__ void cvt_run(Frame& F, int first, int stride, int limit, bool remap) {
    int it = first; if (it >= limit) return;
    f32x4 ra[16], rb[16]; bool fa, fb = false; CvtJob ja = cvt_job(F, remap ? cvt_remap(it) : it, fa), jb; cvt_ld(ja, fa, F.lane, ra);
    for (;;) {
        const int itb = it + stride; const bool hb = itb < limit; if (hb) { jb = cvt_job(F, remap ? cvt_remap(itb) : itb, fb); cvt_ld(jb, fb, F.lane, rb); }
        cvt_st(ja, fa, F.lane, ra); if (!hb) break;
        const int ita = itb + stride; const bool ha = ita < limit; if (ha) { ja = cvt_job(F, remap ? cvt_remap(ita) : ita, fa); cvt_ld(ja, fa, F.lane, ra); }
        cvt_st(jb, fb, F.lane, rb); if (!ha) break;
        it = ita;
    }
}
__device__ __forceinline__ void cvt_deferred(Frame& F, int base, int slot, int per_wave) { if (per_wave == 0) return; const int first = base + (slot * NWAVES + F.wave) * per_wave; cvt_run(F, first, 1, first + per_wave, false); }
__device__ __forceinline__ void ph_prologue(Frame& F) {
    const int gw = F.vcu * NWAVES + F.wave, NGW = F.G * NWAVES;
    for (int i = gw * 64 + F.lane; i < 1024; i += NGW * 64) { const float a = F.lbp()[i], b = F.lbp()[1024 + i], m = fmaxf(a, b), ea = __expf(a - m), eb = __expf(b - m); F.LB()[i] = 0.f; F.LB()[1024 + i] = eb / (ea + eb); }
    if (F.bid < 192) {
        LAS float* sc = (LAS float*)(F.lds); LAS float* part = sc + 2048;
        { const float* c = F.c(); const float* cc = F.cctx(); for (int i = F.tid; i < D; i += NTHR) { const float a = c[i], b = cc[i]; sc[i] = a * fsigm(a); sc[D + i] = b * fsigm(b); } }
        __syncthreads();
        const int l = F.bid / 96, jcol = (F.bid % 96) * 64 + F.lane; const GAS float* W = (const GAS float*)F.w_ada() + (unsigned)(l * D * 6144 + (128 * F.wave) * 6144 + jcol); float a0 = 0.f, a1 = 0.f;
#pragma unroll 16
        for (int i = 0; i < 128; ++i) { const float w = W[(unsigned)i * 6144u]; a0 += sc[128 * F.wave + i] * w; a1 += sc[D + 128 * F.wave + i] * w; }
        part[(F.wave * 2 + 0) * 64 + F.lane] = a0; part[(F.wave * 2 + 1) * 64 + F.lane] = a1;
        __syncthreads();
        if (F.tid < 128) { const int which = F.tid >> 6, col = F.tid & 63; float s = 0.f;
#pragma unroll
            for (int w = 0; w < 8; ++w) s += part[(w * 2 + which) * 64 + col];
            const int j = (F.bid % 96) * 64 + col; F.MOD()[(size_t)(l * 2 + which) * 6144 + j] = s + F.b_ada()[l * 6144 + j]; }
        __syncthreads();
    }
    cvt_run(F, gw, NGW, N_CVT - DEF_TOTAL, true);
}
__device__ __forceinline__ void row_load(const float* xrow, int lane, f32x4 (&v)[4]) { const GAS f32x4* xr = (const GAS f32x4*)xrow + lane;
#pragma unroll
    for (int j = 0; j < 4; ++j) v[j] = xr[64 * j]; }
__device__ __forceinline__ float row_rstd(const f32x4 (&v)[4], int lane) { float s = 0.f;
#pragma unroll
    for (int j = 0; j < 4; ++j) s += (v[j].x * v[j].x + v[j].y * v[j].y) + (v[j].z * v[j].z + v[j].w * v[j].w);
    return rsqrtf(wave_sum(s, lane) * (1.f / D) + 1e-6f); }
__device__ __forceinline__ void row_modulate(const f32x4 (&v)[4], float r, const float* g, const float* sc, const float* sh, int lane, f32x4 (&hv)[4]) {
#pragma unroll
    for (int j = 0; j < 4; ++j) { const f32x4 gg = ((const GAS f32x4*)g)[lane + 64 * j], s1 = ((const GAS f32x4*)sc)[lane + 64 * j], s0 = ((const GAS f32x4*)sh)[lane + 64 * j];
        hv[j] = v[j] * r * gg * (s1 + 1.f) + s0; } }
__device__ __forceinline__ void row_store_fp8(unsigned char* orow, int lane, const f32x4 (&hv)[4]) { GAS unsigned* o4 = (GAS unsigned*)orow + lane;
#pragma unroll
    for (int j = 0; j < 4; ++j) o4[64 * j] = pk4_fp8(hv[j].x * FP8_SH, hv[j].y * FP8_SH, hv[j].z * FP8_SH, hv[j].w * FP8_SH); }
__device__ __forceinline__ void row_store_bf16(bf16_t* orow, int lane, const f32x4 (&hv)[4]) { GAS u32x2* o8 = (GAS u32x2*)orow + lane;
#pragma unroll
    for (int j = 0; j < 4; ++j) { u32x2 w; w.x = pk2(hv[j].x, hv[j].y); w.y = pk2(hv[j].z, hv[j].w); o8[64 * j] = w; } }

__device__ __forceinline__ void ph_mod1(Frame& F, int l) {
    const int gw = F.vcu * NWAVES + F.wave, NGW = F.G * NWAVES;
    for (int row = gw; row < T; row += NGW) {
        const float* xr = l == 0 ? (row < CTX ? F.ctxin() + (size_t)row * D : F.x() + (size_t)(row - CTX) * D) : F.X() + (size_t)row * D;
        const float* m = F.MOD() + (size_t)(l * 2 + (row < CTX ? 1 : 0)) * 6144;
        f32x4 v[4], hv[4]; row_load(xr, F.lane, v); const float r = row_rstd(v, F.lane); row_modulate(v, r, F.norm1_g() + l * D, m + D, m, F.lane, hv); row_store_bf16(F.H() + (size_t)row * D, F.lane, hv);
    }
}

constexpr int RA_ST = 2064, RA_HALF = 16 * RA_ST, RA_BUF = 2 * RA_HALF;
constexpr int RLG_OFF = 2 * RA_BUF, RSCR_OFF = RLG_OFF + 8592;
static_assert(8 * 80 * 32 * 4 <= RLG_OFF && 65 * 33 * 4 <= 8592 && RSCR_OFF + 3520 <= MISC_OFF && RSCR_OFF % 16 == 0, "router LDS map");
__device__ __forceinline__ void split2(float a, float b, unsigned& hi, unsigned& lo) { hi = cvt_pk_bf16(a, b); lo = cvt_pk_bf16(a - bflo(hi), b - bfhi(hi)); }
__device__ __forceinline__ void ph_mod2_route(Frame& F, int l, int cbank) {
    LAS unsigned char* L = F.lds + RING_OFF; LAS float* LG = (LAS float*)(L + RLG_OFF);
    LAS int* lcnt = (LAS int*)(L + RSCR_OFF); LAS int* lbase = lcnt + 32; LAS int* te = lbase + 32; LAS float* tw = (LAS float*)(te + 272); LAS int* trk = (LAS int*)(tw + 272);
    int ln = F.lane; asm volatile("" : "+v"(ln)); const int w = F.wave, fr = ln & 15, g = ln >> 4;
    __syncthreads();
    if (F.tid < 32) lcnt[F.tid] = 0;
    const int row0 = F.bid * 65;
    const float* Xp = F.X(); const float* n2g = F.norm2_g() + l * D; const float* modl = F.MOD() + (size_t)(l * 2) * 6144; bf16_t* Hp = F.H(); unsigned char* H8p = F.ws + WS_H8;
    f32x4 v[2][4];
#pragma unroll
    for (int i = 0; i < 2; ++i) row_load(Xp + (size_t)(row0 + min(2 * w + i, 64)) * D, ln, v[i]);
    bf16x8 Bh[4][2], Bl[4][2];
    { const GAS float* rw = (const GAS float*)F.router_w() + (unsigned)(l * D * NE + (128 * w + 8 * g) * NE + fr);
#pragma unroll
      for (int s_ = 0; s_ < 4; ++s_)
#pragma unroll
          for (int nb = 0; nb < 2; ++nb) { float x[8];
#pragma unroll
              for (int i = 0; i < 8; ++i) x[i] = rw[(32 * s_ + i) * NE + 16 * nb];
              unsigned h_[4], l_[4]; split2(x[0], x[1], h_[0], l_[0]); split2(x[2], x[3], h_[1], l_[1]); split2(x[4], x[5], h_[2], l_[2]); split2(x[6], x[7], h_[3], l_[3]); const u32x4 hi = (u32x4){h_[0], h_[1], h_[2], h_[3]}, lo = (u32x4){l_[0], l_[1], l_[2], l_[3]};
              Bh[s_][nb] = __builtin_bit_cast(bf16x8, hi); Bl[s_][nb] = __builtin_bit_cast(bf16x8, lo); } }
    f32x4 acc[5][2];
#pragma unroll
    for (int b = 0; b < 5; ++b) { acc[b][0] = (f32x4){0.f, 0.f, 0.f, 0.f}; acc[b][1] = (f32x4){0.f, 0.f, 0.f, 0.f}; }
#pragma unroll
    for (int b = 0; b < 5; ++b) {
        LAS unsigned char* Ab = L + (b & 1) * RA_BUF;
#pragma unroll
        for (int i = 0; i < 2; ++i) { const int lr = 16 * b + 2 * w + i, row = row0 + min(lr, 64); const float* m = modl + (row < CTX ? 6144 : 0);
            const float rs = row_rstd(v[i], ln); f32x4 h[4]; row_modulate(v[i], rs, n2g, m + 4 * D, m + 3 * D, ln, h);
            if (lr < 65) { if (MOE_FP8) row_store_fp8(H8p + (size_t)row * D, ln, h); else row_store_bf16(Hp + (size_t)row * D, ln, h); }
#pragma unroll
            for (int j = 0; j < 4; ++j) { unsigned h0, l0, h1, l1; split2(h[j].x, h[j].y, h0, l0); split2(h[j].z, h[j].w, h1, l1); const u32x2 hi = (u32x2){h0, h1}, lo = (u32x2){l0, l1};
                LAS unsigned char* ap = Ab + (2 * w + i) * RA_ST + (4 * ln + 256 * j) * 2; *(LAS u32x2*)ap = hi; *(LAS u32x2*)(ap + RA_HALF) = lo; } }
        if (b < 4) {
#pragma unroll
            for (int i = 0; i < 2; ++i) row_load(Xp + (size_t)(row0 + min(16 * (b + 1) + 2 * w + i, 64)) * D, ln, v[i]); }
        __syncthreads();
#pragma unroll
        for (int s_ = 0; s_ < 4; ++s_) { const LAS unsigned char* ap = Ab + fr * RA_ST + (128 * w + 32 * s_ + 8 * g) * 2; const bf16x8 ah = *(const LAS bf16x8*)ap, al = *(const LAS bf16x8*)(ap + RA_HALF);
#pragma unroll
            for (int nb = 0; nb < 2; ++nb) { f32x4 c = acc[b][nb]; c = __builtin_amdgcn_mfma_f32_16x16x32_bf16(ah, Bh[s_][nb], c, 0, 0, 0); c = __builtin_amdgcn_mfma_f32_16x16x32_bf16(ah, Bl[s_][nb], c, 0, 0, 0);
                c = __builtin_amdgcn_mfma_f32_16x16x32_bf16(al, Bh[s_][nb], c, 0, 0, 0); acc[b][nb] = c; } }
    }
    __syncthreads();
    { LAS float* PT = (LAS float*)L;
#pragma unroll
      for (int b = 0; b < 5; ++b)
#pragma unroll
          for (int nb = 0; nb < 2; ++nb)
#pragma unroll
              for (int r = 0; r < 4; ++r) PT[(w * 80 + 16 * b + 4 * g + r) * 32 + 16 * nb + fr] = acc[b][nb][r];
      __syncthreads();
      for (int i = F.tid; i < 65 * 32; i += NTHR) { const int row = i >> 5, e = i & 31; float sacc = F.router_b()[l * NE + e];
#pragma unroll
          for (int w2 = 0; w2 < 8; ++w2) sacc += PT[(w2 * 80 + row) * 32 + e];
          LG[row * 33 + e] = sacc; } }
    __syncthreads();
    if (F.tid < 65) { const int row = F.tid; float bv[4] = {-3.0e38f, -3.0e38f, -3.0e38f, -3.0e38f}; int bi[4] = {0, 0, 0, 0};
#pragma unroll
        for (int e = 0; e < 32; ++e) { const float x = LG[row * 33 + e]; const bool c0 = x > bv[0], c1 = x > bv[1], c2 = x > bv[2], c3 = x > bv[3];
            bv[3] = c2 ? bv[2] : (c3 ? x : bv[3]); bi[3] = c2 ? bi[2] : (c3 ? e : bi[3]); bv[2] = c1 ? bv[1] : (c2 ? x : bv[2]); bi[2] = c1 ? bi[1] : (c2 ? e : bi[2]);
            bv[1] = c0 ? bv[0] : (c1 ? x : bv[1]); bi[1] = c0 ? bi[0] : (c1 ? e : bi[1]); bv[0] = c0 ? x : bv[0]; bi[0] = c0 ? e : bi[0]; }
        float ex[4], sum = 0.f;
#pragma unroll
        for (int q = 0; q < 4; ++q) { ex[q] = __expf(bv[q] - bv[0]); sum += ex[q]; }
        const float inv = 1.f / sum;
#pragma unroll
        for (int q = 0; q < 4; ++q) { te[row * 4 + q] = bi[q]; tw[row * 4 + q] = ex[q] * inv; trk[row * 4 + q] = (int)__hip_atomic_fetch_add((LAS unsigned*)&lcnt[bi[q]], 1u, __ATOMIC_RELAXED, __HIP_MEMORY_SCOPE_WORKGROUP); } }
    __syncthreads();
    if (F.tid < 32) lbase[F.tid] = (int)__hip_atomic_fetch_add((unsigned*)(F.ctl() + CW_CNT + (cbank * 32 + F.tid) * 64), (unsigned)lcnt[F.tid], RLX_AGENT);
    __syncthreads();
    for (int i = F.tid; i < 65 * 4; i += NTHR) { const int row = row0 + (i >> 2), e = te[i], pos = lbase[e] + trk[i];
        F.TOPI()[row * 4 + (i & 3)] = e; F.TOPW()[row * 4 + (i & 3)] = tw[i]; F.POS()[row * 4 + (i & 3)] = pos; F.LISTE()[(size_t)e * T + pos] = row; }
    __syncthreads();
}

__device__ __forceinline__ int moe_tiles(Frame& F, int l) {
    LAS int* tinfo = (LAS int*)(F.lds + TINFO_OFF); LAS int* bt = (LAS int*)(F.lds + BT_OFF); LAS int* cn = bt + 32; LAS int* ntl = bt + 64;
    __syncthreads();
    if (F.tid < 64) {
        const int e = F.lane & 31; const int c = (int)__hip_atomic_load(F.ctl() + CW_CNT + (l * 32 + e) * 64, RLX_AGENT); const int nt = (c + 255) >> 8;
        int incl = nt;
#pragma unroll
        for (int o = 1; o < 32; o <<= 1) { const int t = lane_get(incl, (F.lane - o) & 63); if (e >= o) incl += t; }
        const int first = incl - nt;
        if (F.lane < 32) { bt[e] = first; cn[e] = c; for (int j = 0; j < nt; ++j) { LAS int* ti = tinfo + 4 * (first + j); ti[0] = e; ti[1] = 0; ti[2] = 256 * j; ti[3] = min(256, c - 256 * j); } if (e == 31) ntl[0] = incl; }
    }
    __syncthreads();
    return ntl[0];
}

__device__ __forceinline__ void ph_gateup(Frame& F, int l) {
    const int ntiles = moe_tiles(F, l); constexpr int EB = MOE_FP8 ? 1 : 2;
    LAS int* tinfo = (LAS int*)(F.lds + TINFO_OFF); LAS unsigned* rowoff = (LAS unsigned*)(F.lds + ROWOFF_OFF);
    MoeOrder<true> S; S.tinfo = tinfo; S.rowoff = rowoff; S.ntiles = ntiles; S.nN = 8; S.G = F.G; S.c = F.vcu; S.Kb = D * EB; S.W = (const char*)F.Wt_gu() + (size_t)l * NE * 2048 * D * EB; S.wstride = (size_t)2048 * D * EB;
    for (int i = 0;; ++i) { pg8::Unit u; if (!S.next(i, u) || i >= 10) break;
        if (F.tid < 256) { const int pos0 = tinfo[4 * u.pm + 2], valid = tinfo[4 * u.pm + 3]; const int tok = F.tid < valid ? F.LISTE()[(size_t)u.e * T + pos0 + F.tid] : 0; rowoff[i * 256 + F.tid] = (unsigned)tok * (unsigned)(D * EB); } }
    __syncthreads();
    if constexpr (MOE_FP8) { EpiAct8 E{(unsigned char*)F.ACT(), F.b_gu() + (size_t)l * NE * 2048};
        pg8::gemm_phase<EpiAct8, MoeOrder<true>, true, true>(F.lds + RING_OFF, (const char*)(F.ws + WS_H8), D, S, E, F.tid); }
    else { EpiAct E{F.ACT(), F.b_gu() + (size_t)l * NE * 2048};
        pg8::gemm_phase<EpiAct, MoeOrder<true>, true, false>(F.lds + RING_OFF, (const char*)F.H(), 2 * D, S, E, F.tid); }
}
__device__ __forceinline__ void ph_down(Frame& F, int l) {
    const int ntiles = moe_tiles(F, l); constexpr int EB = MOE_FP8 ? 1 : 2;
    MoeOrder<false> S; S.tinfo = (LAS int*)(F.lds + TINFO_OFF); S.rowoff = nullptr; S.ntiles = ntiles; S.nN = 4; S.G = F.G; S.c = F.vcu; S.Kb = D * EB; S.W = (const char*)F.Wt_dn() + (size_t)l * NE * D * D * EB; S.wstride = (size_t)D * D * EB;
    if constexpr (MOE_FP8) { EpiY8 E{F.Y(), F.b_dn() + (size_t)l * NE * D};
        pg8::gemm_phase<EpiY8, MoeOrder<false>, true, true>(F.lds + RING_OFF, (const char*)F.ACT(), D, S, E, F.tid); }
    else { EpiY E{F.Y(), F.b_dn() + (size_t)l * NE * D};
        pg8::gemm_phase<EpiY, MoeOrder<false>, true, false>(F.lds + RING_OFF, (const char*)F.ACT(), 2 * D, S, E, F.tid); }
}
__device__ __forceinline__ void ph_win(Frame& F, int l) {
    DenseOrder S; S.init(T / 256, DINX / 256, F.G, F.bid, 2 * D, F.Wt_in() + (size_t)l * DINX * D);
    EpiP E{F.P(), DINX, F.LB() + l * 1024};
    pg8::gemm_phase<EpiP, DenseOrder, true>(F.lds + RING_OFF, (const char*)F.H(), 2 * D, S, E, F.tid);
    if (F.bid >= WIN_BUSY) cvt_deferred(F, l == 0 ? CVT_GU0 : CVT_GU1, F.bid - WIN_BUSY, DEF_WIN);
}
__device__ __forceinline__ void ph_wout(Frame& F, int l) {
    DenseOrder S; S.init(l == 1 ? LAT / 256 : T / 256, D / 256, F.G, F.bid, 2 * D, F.Wt_out() + (size_t)l * D * D, l == 1 ? 1 : 0);
    const float* m = F.MOD() + (size_t)(l * 2) * 6144;
    EpiRes E{l == 0 ? F.ctxin() : F.X(), l == 0 ? F.x() : F.X() + (size_t)CTX * D, m + 6144 + 2 * D, m + 2 * D, F.X()};
    pg8::gemm_phase<EpiRes, DenseOrder, true>(F.lds + RING_OFF, (const char*)F.CAT(), 2 * D, S, E, F.tid);
    if (l == 0 && F.bid >= 4) cvt_deferred(F, CVT_GU0 + DEF_A, F.bid - 4, DEF_WOUT);
}
__device__ __forceinline__ void combine_gather(const Frame& F, const LAS int* bt, int row, int ln, f32x4 (&v)[4], u32x2 (&y)[4][4], float (&w)[4]) {
    row_load(F.X() + (size_t)row * D, ln, v);
    const GAS int* ti = (const GAS int*)F.TOPI() + (unsigned)(row * 4); const GAS float* tw = (const GAS float*)F.TOPW() + (unsigned)(row * 4); const GAS int* tp = (const GAS int*)F.POS() + (unsigned)(row * 4);
#pragma unroll
    for (int q = 0; q < 4; ++q) { const int e = ti[q]; w[q] = tw[q]; const int srow = 256 * bt[e] + tp[q]; const GAS u32x2* yr = (const GAS u32x2*)((const GAS bf16_t*)F.Y() + (unsigned)srow * (unsigned)D) + ln;
#pragma unroll
        for (int j = 0; j < 4; ++j) y[q][j] = yr[64 * j]; }
}
__device__ __forceinline__ void combine_finish(const Frame& F, int l, int row, int ln, f32x4 (&v)[4], const u32x2 (&y)[4][4], const float (&w)[4]) {
    const float* m = F.MOD() + (size_t)(l * 2 + (row < CTX ? 1 : 0)) * 6144 + 5 * D;
#pragma unroll
    for (int j = 0; j < 4; ++j) { f32x4 s = (f32x4){0.f, 0.f, 0.f, 0.f};
#pragma unroll
        for (int q = 0; q < 4; ++q) s += w[q] * (f32x4){bflo(y[q][j].x), bfhi(y[q][j].x), bflo(y[q][j].y), bfhi(y[q][j].y)};
        v[j] += ((const GAS f32x4*)m)[ln + 64 * j] * s; }
    const float r = row_rstd(v, ln);
    if (l == 0) {
        GAS f32x4* xo = (GAS f32x4*)(F.X() + (size_t)row * D) + ln;
#pragma unroll
        for (int j = 0; j < 4; ++j) xo[64 * j] = v[j];
        const float* m1 = F.MOD() + (size_t)(2 + (row < CTX ? 1 : 0)) * 6144; f32x4 hv[4];
        row_modulate(v, r, F.norm1_g() + D, m1 + D, m1, ln, hv); row_store_bf16(F.H() + (size_t)row * D, ln, hv);
    } else {
        GAS f32x4* o = (GAS f32x4*)(F.out() + (size_t)(row - CTX) * D) + ln; const float* fg = F.fng();
#pragma unroll
        for (int j = 0; j < 4; ++j) o[64 * j] = v[j] * r * ((const GAS f32x4*)fg)[ln + 64 * j];
    }
}
__device__ __forceinline__ void ph_combine(Frame& F, int l) {
    (void)moe_tiles(F, l);
    const LAS int* bt = (const LAS int*)(F.lds + BT_OFF);
    const int gw = F.vcu * NWAVES + F.wave, NGW = F.G * NWAVES; const int rbeg = l == 1 ? CTX : 0;
#pragma unroll 1
    for (int ra = rbeg + gw; ra < T; ra += 2 * NGW) {
        int ln = F.lane; asm volatile("" : "+v"(ln));
        const int rb = ra + NGW; const bool hasb = rb < T; const int rbc = hasb ? rb : ra;
        f32x4 va[4], vb[4]; u32x2 ya[4][4], yb[4][4]; float wa[4], wb[4];
        combine_gather(F, bt, ra, ln, va, ya, wa); combine_gather(F, bt, rbc, ln, vb, yb, wb);
        combine_finish(F, l, ra, ln, va, ya, wa);
        if (hasb) combine_finish(F, l, rb, ln, vb, yb, wb);
    }
}
constexpr size_t WF_MA = 0, WF_MB = 128 * 1024, WF_MC = 256 * 1024, WF_PW = 512 * 1024;
constexpr int ZS = 528;
__device__ __forceinline__ f32x4 mfma16(bf16x8 a, bf16x8 b, f32x4 c) { return __builtin_amdgcn_mfma_f32_16x16x32_bf16(a, b, c, 0, 0, 0); }

__device__ __forceinline__ void ph_prologue2(Frame& F) {
    bf16_t* MA = (bf16_t*)(F.ws + WS_WF + WF_MA); bf16_t* MB = (bf16_t*)(F.ws + WS_WF + WF_MB); bf16_t* MC = (bf16_t*)(F.ws + WS_WF + WF_MC); bf16_t* PW = (bf16_t*)(F.ws + WS_WF + WF_PW);
    const int gt = F.bid * NTHR + F.tid, NT = F.G * NTHR;
    for (int i = gt; i < 256 * 256; i += NT) { const int r = i >> 8, cidx = i & 255, ri = r >> 7, k1 = r & 127, rj = cidx >> 7, t1 = cidx & 127; const float x = 2.f * (float)((k1 * t1) & 127) / 128.f;
        const float cs = cospif(x), sn = sinpif(x); const float v = ri == 0 ? (rj == 0 ? cs : -sn) : (rj == 0 ? -sn : -cs); MA[i] = (bf16_t)f2bf(v); }
    for (int i = gt; i < 128 * 256; i += NT) { const int k2 = i >> 8, cidx = i & 255, rj = cidx >> 7, t2 = cidx & 127; const float x = 2.f * (float)((k2 * t2) & 127) / 128.f; MB[i] = (bf16_t)f2bf(rj == 0 ? cospif(x) : sinpif(x)); }
    for (int i = gt; i < 256 * 512; i += NT) { const int k = i >> 9, cidx = i & 511, rj = cidx >> 8, t = cidx & 255; const float x = 2.f * (float)((k * t) & 255) / 256.f; MC[i] = (bf16_t)f2bf(rj == 0 ? cospif(x) : -sinpif(x)); }
    for (int i = gt; i < 2 * 4 * 64 * 64; i += NT) { const int lg = i >> 12, j = (i >> 6) & 63, ii = i & 63; PW[i] = (bf16_t)f2bf(F.pool_w()[(size_t)lg * 4096 + ii * 64 + j]); }
    LAS float* m12 = (LAS float*)(F.lds);
    LAS float* wt = (LAS float*)(F.lds + 32768);
    LAS float* trig = (LAS float*)(F.lds + 32768 + 65536);
    LAS float* fws = (LAS float*)(F.lds + 32768 + 65536 + 512);
    __syncthreads();
    if (F.tid < 64) { trig[F.tid] = cospif(2.f * (float)F.tid / 64.f); trig[64 + F.tid] = sinpif(2.f * (float)F.tid / 64.f); }
    for (int tile = F.bid; tile < 2 * 256; tile += F.G) {
        const int l = tile >> 8, kb = (tile >> 4) & 15, nb = tile & 15, k0 = 64 * kb, n0 = 32 * nb, sel = n0 >> 8, nn0 = n0 & 255;
        __syncthreads();
        for (int i = F.tid; i < 256 * 32; i += NTHR) fws[i] = F.four_w()[(size_t)l * 65536 + (size_t)(i >> 5) * 256 + nn0 + (i & 31)];
        __syncthreads();
        { const int cin = F.tid & 255, hf = F.tid >> 8, hh = cin >> 6, c = cin & 63; float acc[16];
#pragma unroll
          for (int q = 0; q < 16; ++q) acc[q] = 0.f;
#pragma unroll 4
          for (int m = 0; m < 64; ++m) { const float tv = trig[sel * 64 + ((m * c) & 63)]; const LAS float* fr = fws + (hh * 64 + m) * 32 + 16 * hf;
#pragma unroll
              for (int q = 0; q < 16; ++q) acc[q] += tv * fr[q]; }
#pragma unroll
          for (int q = 0; q < 16; ++q) m12[cin * 32 + 16 * hf + q] = acc[q]; }
        for (int i = F.tid; i < 64 * 256; i += NTHR) { const int k = i >> 8, cin = i & 255; wt[i] = F.w_in()[(size_t)l * D * DIN + (size_t)(k0 + k) * DIN + 2816 + cin]; }
        __syncthreads();
        { const int n = F.tid & 31, kq = F.tid >> 5; float a[4] = {0.f, 0.f, 0.f, 0.f};
#pragma unroll 4
          for (int cin = 0; cin < 256; ++cin) { const float mv = m12[cin * 32 + n];
#pragma unroll
              for (int i = 0; i < 4; ++i) a[i] += wt[(kq * 4 + i) * 256 + cin] * mv; }
          u32x2 w; w.x = pk2(a[0], a[1]); w.y = pk2(a[2], a[3]);
          *(u32x2*)(F.Wt_in() + (size_t)l * DINX * D + (size_t)(FQ_OFF + n0 + n) * D + k0 + kq * 4) = w; }
    }
    __syncthreads();
}

template <class SrcF> __device__ __forceinline__ void load_tile_T(LAS unsigned char* zt, const SrcF& src, int tid) {
    const int pg = tid >> 4, cc = tid & 15; u32x4 r[8];
#pragma unroll
    for (int i = 0; i < 8; ++i) r[i] = *(const GAS u32x4*)(src(8 * pg + i) + 8 * cc);
#pragma unroll
    for (int j = 0; j < 8; ++j) { const unsigned sel = (j & 1) ? 0x07060302u : 0x05040100u; u32x4 o;
        o.x = __builtin_amdgcn_perm(r[1][j >> 1], r[0][j >> 1], sel); o.y = __builtin_amdgcn_perm(r[3][j >> 1], r[2][j >> 1], sel);
        o.z = __builtin_amdgcn_perm(r[5][j >> 1], r[4][j >> 1], sel); o.w = __builtin_amdgcn_perm(r[7][j >> 1], r[6][j >> 1], sel);
        *(LAS u32x4*)(zt + (8 * cc + j) * ZS + 16 * pg) = o; }
}
__device__ __forceinline__ void tile_mma(const LAS unsigned char* zt, const bf16_t* mat_row  , f32x4 (&acc)[8], int lane) {
    const int fr = lane & 15, g = lane >> 4;
#pragma unroll
    for (int ks = 0; ks < 8; ++ks) { const bf16x8 b = *(const GAS bf16x8*)(mat_row + 32 * ks + 8 * g);
#pragma unroll
        for (int m = 0; m < 8; ++m) { const bf16x8 a = *(const LAS bf16x8*)(zt + (16 * m + fr) * ZS + (32 * ks + 8 * g) * 2); acc[m] = mfma16(a, b, acc[m]); }
        if (ks & 1) __builtin_amdgcn_sched_barrier(0); }
}
__device__ __forceinline__ void tile_mma2(const LAS unsigned char* zt, const bf16_t* mat_row0, const bf16_t* mat_row1, f32x4 (&acc0)[8], f32x4 (&acc1)[8], int lane) {
    const int fr = lane & 15, g = lane >> 4;
#pragma unroll
    for (int ks = 0; ks < 8; ++ks) { const bf16x8 b0 = *(const GAS bf16x8*)(mat_row0 + 32 * ks + 8 * g), b1 = *(const GAS bf16x8*)(mat_row1 + 32 * ks + 8 * g);
#pragma unroll
        for (int m = 0; m < 8; ++m) { const bf16x8 a = *(const LAS bf16x8*)(zt + (16 * m + fr) * ZS + (32 * ks + 8 * g) * 2); acc0[m] = mfma16(a, b0, acc0[m]); acc1[m] = mfma16(a, b1, acc1[m]); }
        __builtin_amdgcn_sched_barrier(0); }
}
struct SrcA { const bf16_t* P; int t2, hc; __device__ __forceinline__ const bf16_t* operator()(int p) const { const int ri = p >> 7, t1 = p & 127; return P + (size_t)(CTX + 128 * t1 + t2) * DINX + FQ_OFF + ri * 256 + 128 * hc; } };
struct SrcB { const bf16_t* Y; int k1, hc; __device__ __forceinline__ const bf16_t* operator()(int p) const { const int ri = p >> 7, t2 = p & 127; return Y + ((size_t)(k1 * 128 + t2) * 2 + ri) * 256 + 128 * hc; } };
struct SrcC { const bf16_t* P; int ri, hc; __device__ __forceinline__ const bf16_t* operator()(int p) const { return P + (size_t)p * DINX + FQ_OFF + ri * 256 + 128 * hc; } };

__device__ __forceinline__ void fftA_item(Frame& F, int item) {
    const int t2 = item >> 1, hc = item & 1; LAS unsigned char* zt = F.lds + RING_OFF;
    bf16_t* YP = (bf16_t*)(F.ws + WS_YP); const bf16_t* MA = (const bf16_t*)(F.ws + WS_WF + WF_MA);
    __syncthreads();
    load_tile_T(zt, SrcA{F.P(), t2, hc}, F.tid);
    __syncthreads();
    const int fr = F.lane & 15, g = F.lane >> 4, k1 = 16 * F.wave + fr;
    f32x4 ar[8], ai[8];
#pragma unroll
    for (int m = 0; m < 8; ++m) { ar[m] = (f32x4){0.f, 0.f, 0.f, 0.f}; ai[m] = (f32x4){0.f, 0.f, 0.f, 0.f}; }
    tile_mma2(zt, MA + (size_t)k1 * 256, MA + (size_t)(128 + k1) * 256, ar, ai, F.lane);
    const float x = 2.f * (float)(t2 * k1) / 16384.f; const float cs = cospif(x), sn = sinpif(x);
    bf16_t* yr = YP + ((size_t)(k1 * 128 + t2) * 2) * 256 + 128 * hc + 4 * g;
#pragma unroll
    for (int m = 0; m < 8; ++m) { const f32x4 a = ar[m], b = ai[m]; const f32x4 pr = a * cs + b * sn, pi = b * cs - a * sn;
        u32x2 w; w.x = pk2(pr[0], pr[1]); w.y = pk2(pr[2], pr[3]); *(u32x2*)(yr + 16 * m) = w;
        u32x2 v; v.x = pk2(pi[0], pi[1]); v.y = pk2(pi[2], pi[3]); *(u32x2*)(yr + 256 + 16 * m) = v; }
}
__device__ __forceinline__ void fftB_item(Frame& F, int item) {
    const int k1 = item >> 1, hc = item & 1; LAS unsigned char* zt = F.lds + RING_OFF;
    const bf16_t* YP = (const bf16_t*)(F.ws + WS_YP); const bf16_t* MB = (const bf16_t*)(F.ws + WS_WF + WF_MB);
    __syncthreads();
    load_tile_T(zt, SrcB{YP, k1, hc}, F.tid);
    __syncthreads();
    const int fr = F.lane & 15, g = F.lane >> 4, k2 = 16 * F.wave + fr;
    f32x4 acc[8];
#pragma unroll
    for (int m = 0; m < 8; ++m) acc[m] = (f32x4){0.f, 0.f, 0.f, 0.f};
    tile_mma(zt, MB + (size_t)k2 * 256, acc, F.lane);
    bf16_t* o = F.CAT() + (size_t)(CTX + k1 + 128 * k2) * D + 768 + 128 * hc + 4 * g;
#pragma unroll
    for (int m = 0; m < 8; ++m) { const f32x4 a = acc[m] * (1.f / 1024.f); u32x2 w; w.x = pk2(a[0], a[1]); w.y = pk2(a[2], a[3]); *(u32x2*)(o + 16 * m) = w; }
}
__device__ __forceinline__ void fftC_item(Frame& F, int item) {
    const int kh = item >> 1, hc = item & 1; LAS unsigned char* zt = F.lds + RING_OFF; const bf16_t* MC = (const bf16_t*)(F.ws + WS_WF + WF_MC);
    const int fr = F.lane & 15, g = F.lane >> 4, k = 128 * kh + 16 * F.wave + fr;
    f32x4 acc[8];
#pragma unroll
    for (int m = 0; m < 8; ++m) acc[m] = (f32x4){0.f, 0.f, 0.f, 0.f};
    for (int ri = 0; ri < 2; ++ri) {
        __syncthreads();
        load_tile_T(zt, SrcC{F.P(), ri, hc}, F.tid);
        __syncthreads();
        tile_mma(zt, MC + (size_t)k * 512 + ri * 256, acc, F.lane);
    }
    bf16_t* o = F.CAT() + (size_t)k * D + 768 + 128 * hc + 4 * g;
#pragma unroll
    for (int m = 0; m < 8; ++m) { const f32x4 a = acc[m] * (1.f / 128.f); u32x2 w; w.x = pk2(a[0], a[1]); w.y = pk2(a[2], a[3]); *(u32x2*)(o + 16 * m) = w; }
}

template <int GI> __device__ __forceinline__ void pool_sums(Frame& F, int j, LAS float* V, LAS unsigned* U, LAS unsigned char* At) {
    constexpr int win = 2 << GI, lo = win >> 1, hi = win - 1 - lo; const GAS bf16_t* Pc = (const GAS bf16_t*)F.P() + 2560 + GI * 64;
    if (j == 0) {
        for (int idx = F.tid; idx < 256 * 8; idx += NTHR) { const int t = idx >> 3, p8 = idx & 7; const int a = max(t - lo, 0), b = min(t + hi, CTX - 1); u32x4 w[win];
#pragma unroll
            for (int i = 0; i < win; ++i) { const int r = min(max(t - lo + i, 0), CTX - 1); w[i] = *(const GAS u32x4*)(Pc + (unsigned)(r * DINX + 8 * p8)); }
            f32x4 s0 = (f32x4){0.f, 0.f, 0.f, 0.f}, s1 = s0;
#pragma unroll
            for (int i = 0; i < win; ++i) { const int r = t - lo + i; const bool in = r >= 0 && r <= CTX - 1; const u32x4 x = w[i];
                const f32x4 e = (f32x4){bflo(x.x), bflo(x.y), bflo(x.z), bflo(x.w)}, o = (f32x4){bfhi(x.x), bfhi(x.y), bfhi(x.z), bfhi(x.w)}; if (in) { s0 += e; s1 += o; } }
            const u32x4 u = w[lo]; const float inv = 1.f / (float)(b - a + 1); u32x4 ov;
            ov.x = pk2(s0[0] * inv - bflo(u.x), s1[0] * inv - bfhi(u.x)); ov.y = pk2(s0[1] * inv - bflo(u.y), s1[1] * inv - bfhi(u.y));
            ov.z = pk2(s0[2] * inv - bflo(u.z), s1[2] * inv - bfhi(u.z)); ov.w = pk2(s0[3] * inv - bflo(u.w), s1[3] * inv - bfhi(u.w));
            *(LAS u32x4*)(At + t * 144 + 16 * p8) = ov; }
        return; }
    const int r0 = 4 * (j - 1); constexpr int NR = win + 3;
    { const int c = F.tid >> 3, p8 = F.tid & 7; u32x4 w[NR];
#pragma unroll
        for (int i = 0; i < NR; ++i) { const int r = min(max(r0 - lo + i, 0), LAT / GW - 1); w[i] = *(const GAS u32x4*)(Pc + (unsigned)((CTX + r * GW + c) * DINX + 8 * p8)); }
        f32x4 s0[4], s1[4];
#pragma unroll
        for (int q = 0; q < 4; ++q) { s0[q] = (f32x4){0.f, 0.f, 0.f, 0.f}; s1[q] = (f32x4){0.f, 0.f, 0.f, 0.f}; }
#pragma unroll
        for (int i = 0; i < NR; ++i) { const int r = r0 - lo + i; const bool ok = r >= 0 && r <= LAT / GW - 1; const u32x4 x = w[i];
            f32x4 e = (f32x4){bflo(x.x), bflo(x.y), bflo(x.z), bflo(x.w)}, o = (f32x4){bfhi(x.x), bfhi(x.y), bfhi(x.z), bfhi(x.w)}; if (!ok) { e = (f32x4){0.f, 0.f, 0.f, 0.f}; o = e; }
#pragma unroll
            for (int q = 0; q < 4; ++q) if (i >= q && i <= q + win - 1) { s0[q] += e; s1[q] += o; } }
#pragma unroll
        for (int q = 0; q < 4; ++q) { LAS float* vp = V + (q * 64 + c) * 64 + 8 * p8;
            *(LAS f32x4*)vp = (f32x4){s0[q][0], s1[q][0], s0[q][1], s1[q][1]}; *(LAS f32x4*)(vp + 4) = (f32x4){s0[q][2], s1[q][2], s0[q][3], s1[q][3]};
            *(LAS u32x4*)(U + (q * 64 + c) * 32 + 4 * p8) = w[lo + q]; } }
    __syncthreads();
    for (int idx = F.tid; idx < 4 * 8 * 64; idx += NTHR) { const int ch = idx & 63, cb = (idx >> 6) & 7, i = idx >> 9; const int r = r0 + i;
        const float cr = (float)(min(r + hi, LAT / GW - 1) - max(r - lo, 0) + 1); const LAS float* Vr = V + (i * 64) * 64 + ch;
        const int c0 = 8 * cb; float s = 0.f;
#pragma unroll
        for (int q = 0; q < win; ++q) { const int c = c0 - lo + q; s += (c >= 0 && c <= GW - 1) ? Vr[min(max(c, 0), GW - 1) * 64] : 0.f; }
#pragma unroll
        for (int q = 0; q < 8; ++q) { const int c = c0 + q; if (q > 0) { if (c + hi <= GW - 1) s += Vr[(c + hi) * 64]; if (c - 1 - lo >= 0) s -= Vr[(c - 1 - lo) * 64]; }
            const float cc = (float)(min(c + hi, GW - 1) - max(c - lo, 0) + 1); const unsigned uw = U[(i * 64 + c) * 32 + (ch >> 1)]; const float u = (ch & 1) ? bfhi(uw) : bflo(uw);
            *(LAS unsigned short*)(At + (i * 64 + c) * 144 + 2 * ch) = (unsigned short)f2bf(s / (cr * cc) - u); } }
}
__device__ __forceinline__ void pool_item(Frame& F, int l, int item) {
    const int j = item >> 2, gi = item & 3;
    LAS float* V = (LAS float*)(F.lds);
    LAS unsigned* U = (LAS unsigned*)(F.lds + 65536);
    LAS unsigned char* At = F.lds + 65536 + 32768;
    __syncthreads();
    if (gi == 0) pool_sums<0>(F, j, V, U, At); else if (gi == 1) pool_sums<1>(F, j, V, U, At); else if (gi == 2) pool_sums<2>(F, j, V, U, At); else pool_sums<3>(F, j, V, U, At);
    __syncthreads();
    const bf16_t* PW = (const bf16_t*)(F.ws + WS_WF + WF_PW) + (size_t)(l * 4 + gi) * 4096; const int fr = F.lane & 15, g = F.lane >> 4;
    f32x4 acc[4][2];
#pragma unroll
    for (int n = 0; n < 4; ++n) { acc[n][0] = (f32x4){0.f, 0.f, 0.f, 0.f}; acc[n][1] = (f32x4){0.f, 0.f, 0.f, 0.f}; }
#pragma unroll
    for (int ks = 0; ks < 2; ++ks) { bf16x8 b[2];
#pragma unroll
        for (int mt = 0; mt < 2; ++mt) b[mt] = *(const LAS bf16x8*)(At + (32 * F.wave + 16 * mt + fr) * 144 + (32 * ks + 8 * g) * 2);
#pragma unroll
        for (int n = 0; n < 4; ++n) { const bf16x8 a = *(const GAS bf16x8*)(PW + (16 * n + fr) * 64 + 32 * ks + 8 * g);
#pragma unroll
            for (int mt = 0; mt < 2; ++mt) acc[n][mt] = mfma16(a, b[mt], acc[n][mt]); } }
    const int rowbase = j == 0 ? 0 : CTX + 256 * (j - 1);
#pragma unroll
    for (int n = 0; n < 4; ++n) { const f32x4 sc = *(const GAS f32x4*)(F.pool_s() + l * 256 + gi * 64 + 16 * n + 4 * g);
#pragma unroll
        for (int mt = 0; mt < 2; ++mt) { const f32x4 a = acc[n][mt] * sc; u32x2 w; w.x = pk2(a[0], a[1]); w.y = pk2(a[2], a[3]);
            *(u32x2*)(F.CAT() + (size_t)(rowbase + 32 * F.wave + 16 * mt + fr) * D + 512 + gi * 64 + 16 * n + 4 * g) = w; } }
}

constexpr int SC_FT = 0, SC_QT = 18432, SC_VT = 36864, SC_BQ = 55296, SC_BF = 72704, SC_KT = 90112, SC_PM = 108544, SC_G = 117760, SC_TOT = 135168, SC_DEC = 137216, SC_SSQ = 138752, SC_END = 140800;
static_assert(SC_END <= MISC_OFF, "scan LDS map");
template <int DIR, bool FULL> __device__ __forceinline__ void scan_fetch(const Frame& F, int h, int row0, u32x4 (&r)[8]) {
    const GAS bf16_t* P = (const GAS bf16_t*)F.P(); const int tid = F.tid;
    if (tid < 384) { const int tile = tid >> 7, blk = tid & 127, tg = blk >> 4, kc = blk & 15; if (!FULL && tile == 1) return;
        const int colb = tile == 0 ? 512 * (1 + DIR) : (tile == 1 ? 0 : 1536); const GAS bf16_t* src = P + (unsigned)((row0 + 8 * tg) * DINX + colb + h * 128 + 8 * kc);
#pragma unroll
        for (int i = 0; i < 8; ++i) r[i] = *(const GAS u32x4*)(src + (unsigned)(i * DINX)); }
    else if (FULL && DIR == 1) { const int q = tid - 384; const GAS bf16_t* src = P + (unsigned)((row0 + (q >> 4)) * DINX + 2048 + h * 128 + 8 * (q & 15));
#pragma unroll
        for (int i = 0; i < 8; ++i) r[i] = *(const GAS u32x4*)(src + (unsigned)(i * 8 * DINX)); }
}
template <int DIR, bool FULL> __device__ __forceinline__ void scan_commit(const Frame& F, const u32x4 (&r)[8]) {
    LAS unsigned char* L = F.lds + RING_OFF; const int tid = F.tid;
    if (tid < 384) { const int tile = tid >> 7, blk = tid & 127, tg = blk >> 4, kc = blk & 15; if (!FULL && tile == 1) return;
#pragma unroll
        for (int j = 0; j < 8; ++j) { const unsigned sel = (j & 1) ? 0x07060302u : 0x05040100u; u32x4 o;
            o.x = __builtin_amdgcn_perm(r[1][j >> 1], r[0][j >> 1], sel); o.y = __builtin_amdgcn_perm(r[3][j >> 1], r[2][j >> 1], sel);
            o.z = __builtin_amdgcn_perm(r[5][j >> 1], r[4][j >> 1], sel); o.w = __builtin_amdgcn_perm(r[7][j >> 1], r[6][j >> 1], sel);
            *(LAS u32x4*)(L + tile * 18432 + (8 * kc + j) * 144 + 16 * tg) = o; } }
    else if (FULL && DIR == 1) { const int q = tid - 384; LAS unsigned char* dst = L + SC_G + (q >> 4) * 272 + 16 * (q & 15);
#pragma unroll
        for (int i = 0; i < 8; ++i) *(LAS u32x4*)(dst + i * 8 * 272) = r[i]; }
}
template <int DIR, bool FULL> __device__ __forceinline__ void scan_chunk(Frame& F, int l, int h, int nrow0, u32x4 (&pre)[8], f32x4 (&S)[8], f32x4 (&o)[4], float& segsum, const GAS float* oload = nullptr, GAS float* ostore = nullptr) {
    LAS unsigned char* L = F.lds + RING_OFF; int lane = F.lane; asm volatile("" : "+v"(lane));
    const int w = F.wave, tid = w * 64 + lane, fr = lane & 15, g = lane >> 4;
    LAS float* TOT = (LAS float*)(L + SC_TOT); LAS float* DEC = (LAS float*)(L + SC_DEC); LAS float* C1 = DEC + 128; LAS float* C2 = DEC + 256;
    __syncthreads();
    scan_commit<DIR, FULL>(F, pre);
    __syncthreads();
    const int k = tid & 127, qu = tid >> 7;
    float bl[16]; float run = 0.f;
    { const u32x4 fa = *(const LAS u32x4*)(L + SC_FT + k * 144 + 32 * qu), fb = *(const LAS u32x4*)(L + SC_FT + k * 144 + 32 * qu + 16); const unsigned fw[8] = {fa.x, fa.y, fa.z, fa.w, fb.x, fb.y, fb.z, fb.w};
#pragma unroll
      for (int i = 0; i < 16; ++i) { const int ti = (DIR == 0 ? i : 15 - i); run += (ti & 1) ? f16hi(fw[ti >> 1]) : f16lo(fw[ti >> 1]); bl[i] = run; } }
    TOT[qu * 128 + k] = run;
    __syncthreads();
    const float t0 = TOT[k], t1 = TOT[128 + k], t2 = TOT[256 + k], t3 = TOT[384 + k]; const float total = (t0 + t1) + (t2 + t3);
    float off, ref;
    if (DIR == 0) { off = qu == 0 ? 0.f : (qu == 1 ? t0 : (qu == 2 ? t0 + t1 : t0 + t1 + t2)); ref = t0 + t1; }
    else { off = qu == 3 ? 0.f : (qu == 2 ? t3 : (qu == 1 ? t3 + t2 : t3 + t2 + t1)); ref = t3 + t2; }
    if (qu == 0) { DEC[k] = __builtin_amdgcn_exp2f(total); C1[k] = __builtin_amdgcn_exp2f(ref); C2[k] = __builtin_amdgcn_exp2f(total - ref); segsum += total; }
    { unsigned qw[8];
      if (FULL) { const u32x4 qa = *(const LAS u32x4*)(L + SC_QT + k * 144 + 32 * qu), qb = *(const LAS u32x4*)(L + SC_QT + k * 144 + 32 * qu + 16); qw[0] = qa.x; qw[1] = qa.y; qw[2] = qa.z; qw[3] = qa.w; qw[4] = qb.x; qw[5] = qb.y; qw[6] = qb.z; qw[7] = qb.w; }
      float ktv[16]; const float sh = off - ref;
#pragma unroll
      for (int i = 0; i < 16; ++i) { const int ti = (DIR == 0 ? i : 15 - i), t = 16 * qu + ti; const float lf = i == 0 ? bl[0] : bl[i] - bl[i - 1]; const float b = bl[i] + sh;
          const float E = __builtin_amdgcn_exp2f(b), Ei = __builtin_amdgcn_rcpf(E), kk = 1.f - __builtin_amdgcn_exp2f(lf); ktv[ti] = kk * Ei;
          if (FULL) { const float qs = (ti & 1) ? bfhi(qw[ti >> 1]) : bflo(qw[ti >> 1]); *(LAS unsigned short*)(L + SC_BQ + t * 272 + 2 * k) = (unsigned short)(cvt_pk_bf16(qs * E, 0.f)); } }
      u32x4 a, b2; a.x = cvt_pk_bf16(ktv[0], ktv[1]); a.y = cvt_pk_bf16(ktv[2], ktv[3]); a.z = cvt_pk_bf16(ktv[4], ktv[5]); a.w = cvt_pk_bf16(ktv[6], ktv[7]);
      b2.x = cvt_pk_bf16(ktv[8], ktv[9]); b2.y = cvt_pk_bf16(ktv[10], ktv[11]); b2.z = cvt_pk_bf16(ktv[12], ktv[13]); b2.w = cvt_pk_bf16(ktv[14], ktv[15]);
      *(LAS u32x4*)(L + SC_KT + k * 144 + 32 * qu) = a; *(LAS u32x4*)(L + SC_KT + k * 144 + 32 * qu + 16) = b2;
      if (FULL) { const unsigned kw[8] = {a.x, a.y, a.z, a.w, b2.x, b2.y, b2.z, b2.w};
#pragma unroll
          for (int ti = 0; ti < 16; ++ti) *(LAS unsigned short*)(L + SC_BF + (16 * qu + ti) * 272 + 2 * k) = (unsigned short)((ti & 1) ? (kw[ti >> 1] >> 16) : (kw[ti >> 1] & 0xffffu)); } }
    __syncthreads();
    if (nrow0 >= 0) scan_fetch<DIR, FULL>(F, h, nrow0, pre);
    if (FULL) {
#pragma unroll
        for (int tb = 0; tb < 4; ++tb)
#pragma unroll
            for (int r = 0; r < 4; ++r) o[tb][r] = oload ? oload[(tb * 4 + r) * 512] : 0.f; }
    __builtin_amdgcn_sched_barrier(0);
    if (FULL) {
        const int tb = w >> 1;
#pragma unroll
        for (int q = 0; q < 2; ++q) { const int sb = 2 * (w & 1) + q; f32x4 acc = (f32x4){0.f, 0.f, 0.f, 0.f};
#pragma unroll
            for (int ks = 0; ks < 4; ++ks) { const bf16x8 a = *(const LAS bf16x8*)(L + SC_BF + (16 * sb + fr) * 272 + (32 * ks + 8 * g) * 2); const bf16x8 b = *(const LAS bf16x8*)(L + SC_BQ + (16 * tb + fr) * 272 + (32 * ks + 8 * g) * 2);
                acc = mfma16(a, b, acc); }
            const int t = 16 * tb + fr; float m[4];
#pragma unroll
            for (int r = 0; r < 4; ++r) { const int s = 16 * sb + 4 * g + r; const bool keep = DIR == 0 ? (s <= t) : (s >= t); m[r] = keep ? acc[r] : 0.f; }
            u32x2 wv; wv.x = pk2(m[0], m[1]); wv.y = pk2(m[2], m[3]); *(LAS u32x2*)(L + SC_PM + t * 144 + (16 * sb + 4 * g) * 2) = wv; }
        __syncthreads();
    }
    bf16x8 vt[2];
#pragma unroll
    for (int ks = 0; ks < 2; ++ks) vt[ks] = *(const LAS bf16x8*)(L + SC_VT + (16 * w + fr) * 144 + (32 * ks + 8 * g) * 2);
    if (FULL) {
        bf16x8 sf[4];
#pragma unroll
        for (int ks = 0; ks < 4; ++ks) { const f32x4 ca = *(const LAS f32x4*)(C1 + 32 * ks + 4 * g), cb = *(const LAS f32x4*)(C1 + 32 * ks + 16 + 4 * g); const f32x4 x = S[2 * ks] * ca, y = S[2 * ks + 1] * cb;
            u32x4 pkd; pkd.x = pk2(x[0], x[1]); pkd.y = pk2(x[2], x[3]); pkd.z = pk2(y[0], y[1]); pkd.w = pk2(y[2], y[3]); sf[ks] = __builtin_bit_cast(bf16x8, pkd); }
#pragma unroll
        for (int tb = 0; tb < 4; ++tb) { f32x4 acc = o[tb];
#pragma unroll
            for (int ks = 0; ks < 4; ++ks) { const u32x2 a0 = *(const LAS u32x2*)(L + SC_BQ + (16 * tb + fr) * 272 + (32 * ks + 4 * g) * 2), a1 = *(const LAS u32x2*)(L + SC_BQ + (16 * tb + fr) * 272 + (32 * ks + 16 + 4 * g) * 2);
                u32x4 pa; pa.x = a0.x; pa.y = a0.y; pa.z = a1.x; pa.w = a1.y; acc = mfma16(__builtin_bit_cast(bf16x8, pa), sf[ks], acc); }
#pragma unroll
            for (int ks = 0; ks < 2; ++ks) { const bf16x8 a = *(const LAS bf16x8*)(L + SC_PM + (16 * tb + fr) * 144 + (32 * ks + 8 * g) * 2); acc = mfma16(a, vt[ks], acc); }
            o[tb] = acc; __builtin_amdgcn_sched_barrier(0); }
        if (ostore) {
#pragma unroll
            for (int tb = 0; tb < 4; ++tb)
#pragma unroll
                for (int r = 0; r < 4; ++r) ostore[(tb * 4 + r) * 512] = o[tb][r]; }
    }
#pragma unroll
    for (int kb = 0; kb < 8; ++kb) { f32x4 tmp = (f32x4){0.f, 0.f, 0.f, 0.f};
#pragma unroll
        for (int ks = 0; ks < 2; ++ks) { const bf16x8 a = *(const LAS bf16x8*)(L + SC_KT + (16 * kb + fr) * 144 + (32 * ks + 8 * g) * 2); tmp = mfma16(a, vt[ks], tmp); }
        const f32x4 dc = *(const LAS f32x4*)(DEC + 16 * kb + 4 * g), c2 = *(const LAS f32x4*)(C2 + 16 * kb + 4 * g); S[kb] = dc * S[kb] + c2 * tmp; if (kb & 1) __builtin_amdgcn_sched_barrier(0); }
}
__device__ __forceinline__ void state_store(float* dst, const f32x4 (&S)[8], int w, int lane) {
    GAS float* p = (GAS float*)dst + (unsigned)(w * 2048 + lane);
#pragma unroll
    for (int kb = 0; kb < 8; ++kb)
#pragma unroll
        for (int r = 0; r < 4; ++r) p[(kb * 4 + r) * 64] = S[kb][r]; }
__device__ __forceinline__ void state_load(const float* src, f32x4 (&S)[8], int w, int lane) {
    const GAS float* p = (const GAS float*)src + (unsigned)(w * 2048 + lane);
#pragma unroll
    for (int kb = 0; kb < 8; ++kb)
#pragma unroll
        for (int r = 0; r < 4; ++r) S[kb][r] = p[(kb * 4 + r) * 64]; }
__device__ __forceinline__ float* sc_SU(Frame& F) { return (float*)(F.ws + WS_SU); }
__device__ __forceinline__ float* sc_SS(Frame& F) { return (float*)(F.ws + WS_SS); }
__device__ __forceinline__ float* sc_SD(Frame& F) { return (float*)(F.ws + WS_SD); }
__device__ __forceinline__ float* sc_CARRY(Frame& F) { return (float*)(F.ws + WS_SD) + 8 * 64 * 128; }

__device__ __forceinline__ float* sc_OSCR(Frame& F) { return (float*)(F.ws + WS_OSCR) + (size_t)F.bid * 32768; }
template <int DIR> __device__ __forceinline__ void scan_states(Frame& F, int l, int h, int segrow, float* sout, float* dout) {
    f32x4 S[8], odummy[4]; float segsum = 0.f; u32x4 pre[8];
#pragma unroll
    for (int kb = 0; kb < 8; ++kb) S[kb] = (f32x4){0.f, 0.f, 0.f, 0.f};
    scan_fetch<DIR, false>(F, h, segrow + (DIR == 0 ? 0 : 192), pre);
#pragma unroll 1
    for (int i_ = 0; i_ < 4; ++i_) { int i = i_; asm volatile("" : "+s"(i)); const int c = DIR == 0 ? i : 3 - i;
        scan_chunk<DIR, false>(F, l, h, i < 3 ? segrow + 64 * (DIR == 0 ? c + 1 : c - 1) : -1, pre, S, odummy, segsum); }
    state_store(sout, S, F.wave, F.lane);
    if (dout && F.tid < 128) dout[F.tid] = __builtin_amdgcn_exp2f(segsum);
}
__device__ __forceinline__ void scanA_item(Frame& F, int l, int item) {
    const int h = item >> 6, seg = item & 63, segrow = CTX + 256 * seg;
    scan_states<0>(F, l, h, segrow, sc_SU(F) + ((size_t)(h * 2 + 0) * 64 + seg) * 16384, sc_SD(F) + ((h * 2 + 0) * 64 + seg) * 128);
    scan_states<1>(F, l, h, segrow, sc_SU(F) + ((size_t)(h * 2 + 1) * 64 + seg) * 16384, sc_SD(F) + ((h * 2 + 1) * 64 + seg) * 128);
}
__device__ __forceinline__ void scan_full(Frame& F, int l, int h, int segrow, const float* sinf, const float* sinb, float* outf, float* outb) {
    f32x4 S[8], o[4]; float segsum = 0.f; const int w = F.wave, lane = F.lane, fr = lane & 15, g = lane >> 4; u32x4 pre[8];
    GAS float* oscr = (GAS float*)sc_OSCR(F) + (unsigned)F.tid;
    if (sinf) state_load(sinf, S, w, lane); else {
#pragma unroll
        for (int kb = 0; kb < 8; ++kb) S[kb] = (f32x4){0.f, 0.f, 0.f, 0.f}; }
    scan_fetch<0, true>(F, h, segrow, pre);
#pragma unroll 1
    for (int c_ = 0; c_ < 4; ++c_) { int c = c_; asm volatile("" : "+s"(c));
        scan_chunk<0, true>(F, l, h, c < 3 ? segrow + 64 * (c + 1) : -1, pre, S, o, segsum);
#pragma unroll
        for (int tb = 0; tb < 4; ++tb)
#pragma unroll
            for (int r = 0; r < 4; ++r) (oscr + c * 8192)[(tb * 4 + r) * 512] = o[tb][r];
    }
    if (outf) state_store(outf, S, w, lane);
    VM_WAIT();
    if (sinb) state_load(sinb, S, w, lane); else {
#pragma unroll
        for (int kb = 0; kb < 8; ++kb) S[kb] = (f32x4){0.f, 0.f, 0.f, 0.f}; }
    LAS unsigned char* L = F.lds + RING_OFF; LAS float* SSQ = (LAS float*)(L + SC_SSQ);
    const float ngv = F.hng()[l * 512 + h * 128 + 16 * w + fr];
    scan_fetch<1, true>(F, h, segrow + 192, pre);
#pragma unroll 1
    for (int c_ = 3; c_ >= 0; --c_) { int c = c_; asm volatile("" : "+s"(c));
        scan_chunk<1, true>(F, l, h, c > 0 ? segrow + 64 * (c - 1) : -1, pre, S, o, segsum, oscr + c * 8192);
#pragma unroll
        for (int tb = 0; tb < 4; ++tb) { f32x4 q = o[tb] * o[tb];
#pragma unroll
            for (int m = 1; m < 16; m <<= 1) { q[0] += lane_xor(q[0], m, lane); q[1] += lane_xor(q[1], m, lane); q[2] += lane_xor(q[2], m, lane); q[3] += lane_xor(q[3], m, lane); }
            if (fr == 0) {
#pragma unroll
                for (int r = 0; r < 4; ++r) SSQ[(16 * tb + 4 * g + r) * 8 + w] = q[r]; } }
        __syncthreads();
#pragma unroll
        for (int tb = 0; tb < 4; ++tb)
#pragma unroll
            for (int r = 0; r < 4; ++r) { const int t = 16 * tb + 4 * g + r; const f32x4 p0 = *(const LAS f32x4*)(SSQ + t * 8), p1 = *(const LAS f32x4*)(SSQ + t * 8 + 4);
                const float ss = ((p0[0] + p0[1]) + (p0[2] + p0[3])) + ((p1[0] + p1[1]) + (p1[2] + p1[3])); const float rs = rsqrtf(ss * (1.f / 128.f) + 1e-6f);
                const float gp = bf2f(*(const LAS unsigned short*)(L + SC_G + t * 272 + 2 * (16 * w + fr)));
                *(LAS unsigned short*)(L + SC_BQ + t * 272 + 2 * (16 * w + fr)) = (unsigned short)f2bf(o[tb][r] * rs * ngv * gp); }
        __syncthreads();
#pragma unroll
        for (int i = 0; i < 2; ++i) { const int id = F.tid + 512 * i, row = id >> 4, cc = id & 15; const u32x4 d = *(const LAS u32x4*)(L + SC_BQ + row * 272 + 16 * cc);
            *(GAS u32x4*)((GAS bf16_t*)F.CAT() + (unsigned)((segrow + 64 * c + row) * D + h * 128 + 8 * cc)) = d; }
    }
    if (outb) state_store(outb, S, w, lane);
}
__device__ __forceinline__ GAS float* sc_CTXO(const Frame& F, int hd, int c) { return (GAS float*)(F.ws + WS_CTXO) + (unsigned)((hd * 4 + c) * 8192); }
template <int DIR> __device__ __forceinline__ void scan_dir_local(Frame& F, int l, int h, int segrow, float* sout) {
    f32x4 S[8], o[4]; float segsum = 0.f; u32x4 pre[8]; const int hd = h * 2 + DIR;
#pragma unroll
    for (int kb = 0; kb < 8; ++kb) S[kb] = (f32x4){0.f, 0.f, 0.f, 0.f};
    scan_fetch<DIR, true>(F, h, segrow + (DIR == 0 ? 0 : 192), pre);
#pragma unroll 1
    for (int i_ = 0; i_ < 4; ++i_) { int i = i_; asm volatile("" : "+s"(i)); const int c = DIR == 0 ? i : 3 - i;
        scan_chunk<DIR, true>(F, l, h, i < 3 ? segrow + 64 * (DIR == 0 ? c + 1 : c - 1) : -1, pre, S, o, segsum, nullptr, sc_CTXO(F, hd, c) + (unsigned)F.tid); }
    state_store(sout, S, F.wave, F.lane);
}
__device__ __forceinline__ void ctx_finalize(Frame& F, int l, int h) {
    LAS unsigned char* L = F.lds + RING_OFF; LAS float* SSQ = (LAS float*)(L + SC_SSQ);
    const float ngv = F.hng()[l * 512 + h * 128 + 16 * F.wave + (F.lane & 15)];
#pragma unroll 1
    for (int c_ = 0; c_ < 4; ++c_) { int c = c_; asm volatile("" : "+s"(c)); int lane = F.lane; asm volatile("" : "+v"(lane));
        const int w = F.wave, tid = w * 64 + lane, fr = lane & 15, g = lane >> 4, row0 = 64 * c;
        __syncthreads();
        { const GAS bf16_t* gp = (const GAS bf16_t*)F.P() + (unsigned)((row0 + (tid >> 4)) * DINX + 2048 + h * 128 + 8 * (tid & 15)); const int o = (tid >> 4) * 272 + 16 * (tid & 15);
          *(LAS u32x4*)(L + SC_G + o) = *(const GAS u32x4*)gp; *(LAS u32x4*)(L + SC_G + o + 32 * 272) = *(const GAS u32x4*)(gp + (unsigned)(32 * DINX)); }
        f32x4 o[4];
        { const GAS float* of = sc_CTXO(F, h * 2 + 0, c) + (unsigned)tid; const GAS float* ob = sc_CTXO(F, h * 2 + 1, c) + (unsigned)tid;
#pragma unroll
          for (int tb = 0; tb < 4; ++tb)
#pragma unroll
              for (int r = 0; r < 4; ++r) o[tb][r] = of[(tb * 4 + r) * 512] + ob[(tb * 4 + r) * 512]; }
#pragma unroll
        for (int tb = 0; tb < 4; ++tb) { f32x4 q = o[tb] * o[tb];
#pragma unroll
            for (int m = 1; m < 16; m <<= 1) { q[0] += lane_xor(q[0], m, lane); q[1] += lane_xor(q[1], m, lane); q[2] += lane_xor(q[2], m, lane); q[3] += lane_xor(q[3], m, lane); }
            if (fr == 0) {
#pragma unroll
                for (int r = 0; r < 4; ++r) SSQ[(16 * tb + 4 * g + r) * 8 + w] = q[r]; } }
        __syncthreads();
#pragma unroll
        for (int tb = 0; tb < 4; ++tb)
#pragma unroll
            for (int r = 0; r < 4; ++r) { const int t = 16 * tb + 4 * g + r; const f32x4 p0 = *(const LAS f32x4*)(SSQ + t * 8), p1 = *(const LAS f32x4*)(SSQ + t * 8 + 4);
                const float ss = ((p0[0] + p0[1]) + (p0[2] + p0[3])) + ((p1[0] + p1[1]) + (p1[2] + p1[3])); const float rs = rsqrtf(ss * (1.f / 128.f) + 1e-6f);
                const float gp = bf2f(*(const LAS unsigned short*)(L + SC_G + t * 272 + 2 * (16 * w + fr)));
                *(LAS unsigned short*)(L + SC_BQ + t * 272 + 2 * (16 * w + fr)) = (unsigned short)f2bf(o[tb][r] * rs * ngv * gp); }
        __syncthreads();
#pragma unroll
        for (int i = 0; i < 2; ++i) { const int id = tid + 512 * i, row = id >> 4, cc = id & 15; const u32x4 d = *(const LAS u32x4*)(L + SC_BQ + row * 272 + 16 * cc);
            *(GAS u32x4*)((GAS bf16_t*)F.CAT() + (unsigned)((row0 + row) * D + h * 128 + 8 * cc)) = d; }
    }
    __syncthreads();
}
__device__ __forceinline__ void scanB(Frame& F) {
    const int e = F.bid * NTHR + F.tid; if (e >= 8 * 16384) return;
    const int hd = e >> 14, idx = e & 16383, d = hd & 1; const int ln = idx & 63, reg = (idx >> 6) & 3, kb = (idx >> 8) & 7; const int k = 16 * kb + 4 * (ln >> 4) + reg;
    const float* SU = sc_SU(F) + (size_t)hd * 64 * 16384 + idx; const float* SD = sc_SD(F) + hd * 64 * 128 + k; float* SS = sc_SS(F) + (size_t)hd * 64 * 16384 + idx;
    float S = sc_CARRY(F)[hd * 16384 + idx];
    if (d == 0) { for (int seg = 0; seg < 64; ++seg) { SS[(size_t)seg * 16384] = S; S = SD[seg * 128] * S + SU[(size_t)seg * 16384]; } }
    else { for (int seg = 63; seg >= 0; --seg) { SS[(size_t)seg * 16384] = S; S = SD[seg * 128] * S + SU[(size_t)seg * 16384]; } }
}

__device__ __forceinline__ void ph_mixA(Frame& F, int l) {
    scanA_item(F, l, F.bid);
    if (F.bid >= 4 && F.bid < 12) { const int hd = F.bid - 4, h = hd >> 1;
        if (l == 0) { if (hd & 1) scan_dir_local<1>(F, l, h, 0, sc_CARRY(F) + hd * 16384); else scan_dir_local<0>(F, l, h, 0, sc_CARRY(F) + hd * 16384); }
        else { if (hd & 1) scan_states<1>(F, l, h, 0, sc_CARRY(F) + hd * 16384, nullptr); else scan_states<0>(F, l, h, 0, sc_CARRY(F) + hd * 16384, nullptr); }
        return; }
    fftA_item(F, F.bid);
    if (F.bid >= 12 && F.bid < 20) fftA_item(F, F.bid - 8);
    if (l == 0) { pool_item(F, l, F.bid); if (F.bid >= 20 && F.bid < 28) pool_item(F, l, F.bid - 16); else if (F.bid >= 28 && F.bid < 32) pool_item(F, l, F.bid + 228); }
    else { pool_item(F, l, F.bid + 4); if (F.bid >= 20 && F.bid < 28) pool_item(F, l, F.bid - 12); }
}
__device__ __forceinline__ void ph_mixB(Frame& F, int l) {
    scanB(F);
    fftB_item(F, F.bid);
    if (l == 0 && F.bid >= 252) fftC_item(F, F.bid - 252);
    if (l == 0 && F.bid >= 240 && F.bid < 244) ctx_finalize(F, l, F.bid - 240);
}
__device__ __forceinline__ void ph_mixC(Frame& F, int l) {
    const int item = F.bid, h = item >> 6, seg = item & 63;
    scan_full(F, l, h, CTX + 256 * seg, sc_SS(F) + ((size_t)(h * 2 + 0) * 64 + seg) * 16384, sc_SS(F) + ((size_t)(h * 2 + 1) * 64 + seg) * 16384, nullptr, nullptr);
}
#define GRID_BAR() do { Frame R_ = relaunder(F); xcd_barrier(bar, R_.tid); } while (0)
#define PHASE(call) do { Frame R = relaunder(F); call; } while (0)
__global__ void __launch_bounds__(NTHR, 2) mega_fwd(Params p) {
    extern __shared__ __attribute__((aligned(16))) unsigned char lds[];
    Frame F; frame_init(F, p, lds);
    if (F.tid < 16) ((LAS unsigned*)(F.lds + MISC_OFF))[F.tid] = 0u;
    __syncthreads();
    XcdBarrier bar = xcd_barrier_post((unsigned*)(F.ctl() + CW_BAR), (volatile LAS unsigned*)(F.lds + MISC_OFF + 32));
    PHASE(ph_prologue(R)); PHASE(ph_prologue2(R));
    GRID_BAR();
    PHASE(ph_mod1(R, 0));
    GRID_BAR();
#pragma unroll 1
    for (int l = 0; l < 2; ++l) {
        PHASE(ph_win(R, l));            GRID_BAR();
        PHASE(ph_mixA(R, l));           GRID_BAR();
        PHASE(ph_mixB(R, l));           GRID_BAR();
        PHASE(ph_mixC(R, l));           GRID_BAR();
        PHASE(ph_wout(R, l));           GRID_BAR();
        PHASE(ph_mod2_route(R, l, l));  GRID_BAR();
        PHASE(ph_gateup(R, l));         GRID_BAR();
        PHASE(ph_down(R, l));           GRID_BAR();
        PHASE(ph_combine(R, l));
        if (l == 0) GRID_BAR();
    }
}
extern "C" void kernel_launch(void* const* d_in, const int* in_sizes, int n_in, void* d_out, int out_size, void* d_ws, size_t ws_size, hipStream_t stream) {
    static int ok = 0;
    if (ok == 0) {
        if (n_in != 22 || out_size != LAT * D || ws_size < WS_FASTEND) { fprintf(stderr, "kernel_launch: unexpected shapes / workspace (n_in %d, out %d, ws %zu < %zu); nothing launched\n", n_in, out_size, ws_size, (size_t)WS_FASTEND); ok = -1; return; }
        int dev = 0, cus = 0, per_cu = 0;
        if (hipGetDevice(&dev) != hipSuccess || hipDeviceGetAttribute(&cus, hipDeviceAttributeMultiprocessorCount, dev) != hipSuccess) { ok = -1; return; }
        if (hipFuncSetAttribute((const void*)mega_fwd, hipFuncAttributeMaxDynamicSharedMemorySize, LDS_BYTES) != hipSuccess) { fprintf(stderr, "kernel_launch: hipFuncSetAttribute failed\n"); ok = -1; return; }
        if (hipOccupancyMaxActiveBlocksPerMultiprocessor(&per_cu, (const void*)mega_fwd, NTHR, LDS_BYTES) != hipSuccess || per_cu < 1) fprintf(stderr, "kernel_launch: note: occupancy query reports %d workgroups per CU\n", per_cu);
        (void)hipGetLastError();
        if (cus < 256) fprintf(stderr, "kernel_launch: device has %d CUs; this kernel needs 256 co-resident workgroups (one per CU)\n", cus);
        ok = 1;
    }
    if (ok < 0) return;
    if (hipMemsetAsync((char*)d_ws + WS_CTL, 0, CTL_ZERO_BYTES, stream) != hipSuccess) return;
    Params p{}; for (int i = 0; i < 22; ++i) p.in[i] = (const float*)d_in[i]; p.out = (float*)d_out; p.ws = (unsigned char*)d_ws;
    hipLaunchKernelGGL(mega_fwd, dim3(256), dim3(NTHR), LDS_BYTES, stream, p);
}
```

```cpp
#include <hip/hip_runtime.h>
#include <cstdio>
#include <cstdint>
constexpr int D = 1024, LAT = 16384, CTX = 256, T = LAT + CTX, DIN = 3072, NE = 32, TOPK = 4;
constexpr int GW = 64;
#ifndef PSTR
#define PSTR DIN
#endif
constexpr int DINX = 3328, FQ_OFF = 2816;
#define GAS __attribute__((address_space(1)))
#define LAS __attribute__((address_space(3)))
typedef unsigned short bf16_t;
typedef short bf16x8 __attribute__((ext_vector_type(8)));
typedef short bf16x4 __attribute__((ext_vector_type(4)));
typedef float f32x4 __attribute__((ext_vector_type(4)));
typedef float f32x2 __attribute__((ext_vector_type(2)));
typedef unsigned u32x4 __attribute__((ext_vector_type(4)));
typedef unsigned u32x2 __attribute__((ext_vector_type(2)));
typedef GAS unsigned gu32;
#define RLX_AGENT __ATOMIC_RELAXED, __HIP_MEMORY_SCOPE_AGENT
#define LDS_WAIT() asm volatile("s_waitcnt lgkmcnt(0)" ::: "memory")
#define VM_WAIT() asm volatile("s_waitcnt vmcnt(0)" ::: "memory")
__device__ __forceinline__ unsigned cvt_pk_bf16(float lo, float hi) { unsigned r; asm("v_cvt_pk_bf16_f32 %0, %1, %2" : "=v"(r) : "v"(lo), "v"(hi)); return r; }
__device__ __forceinline__ unsigned f2bf(float f) { return cvt_pk_bf16(f, 0.f) & 0xffffu; }
__device__ __forceinline__ unsigned pk2(float lo, float hi) { return cvt_pk_bf16(lo, hi); }
__device__ __forceinline__ float bf2f(unsigned short b) { return __builtin_bit_cast(float, ((unsigned)b) << 16); }
__device__ __forceinline__ float bflo(unsigned w) { return __builtin_bit_cast(float, w << 16); }
__device__ __forceinline__ float bfhi(unsigned w) { return __builtin_bit_cast(float, w & 0xffff0000u); }
__device__ __forceinline__ float fsigm(float x) { return __builtin_amdgcn_rcpf(1.f + __builtin_amdgcn_exp2f(-1.44269504f * x)); }
__device__ __forceinline__ float lane_xor(float v, int m, int lane) { return __builtin_bit_cast(float, __builtin_amdgcn_ds_bpermute((lane ^ m) << 2, __builtin_bit_cast(int, v))); }
__device__ __forceinline__ int lane_get(int v, int src) { return __builtin_amdgcn_ds_bpermute(src << 2, v); }
__device__ __forceinline__ float wave_sum(float v, int lane) {
#pragma unroll
    for (int o = 1; o < 64; o <<= 1) v += lane_xor(v, o, lane);
    return v;
}

#define XB_TMO      128
#define XB_XCNT(j)  (256  + 64 * (j))
#define XB_XSUB(j)  (1280 + 64 * (j))
#define XB_XGEN(j)  (2304 + 64 * (j))
#define XB_TOP      3328
#define XB_TOPGEN   3392
#define XCD_BAR_WORDS 3456
#define XB_SPIN_CAP (1u << 18)
__device__ __forceinline__ unsigned xb_ld(unsigned* p)              { return __hip_atomic_load(p, __ATOMIC_RELAXED, __HIP_MEMORY_SCOPE_AGENT); }
__device__ __forceinline__ unsigned xb_add(unsigned* p, unsigned v) { return __hip_atomic_fetch_add(p, v, __ATOMIC_RELAXED, __HIP_MEMORY_SCOPE_AGENT); }
__device__ __forceinline__ unsigned xb_xcc_id() { return (unsigned)__builtin_amdgcn_s_getreg((3 << 11) | 20) & 0xFu; }
#define XB_SPIN(cond, bar) do { unsigned _sp = 0; while (cond) { __builtin_amdgcn_s_sleep(1); \
    if ((++_sp & 255u) == 0u) { if (xb_ld(&(bar)[XB_TMO])) break; if (_sp > XB_SPIN_CAP) { atomicAdd(&(bar)[XB_TMO], 1u); break; } } } } while (0)
struct XcdBarrier { unsigned* bar; unsigned x; volatile LAS unsigned* st; };
__device__ __forceinline__ XcdBarrier xcd_barrier_post(unsigned* bar, volatile LAS unsigned* st) {
    XcdBarrier b; b.bar = bar; b.x = xb_xcc_id(); b.st = st;
    if (threadIdx.x == 0) (void)xb_add(&bar[XB_XCNT(b.x)], 1u);
    return b;
}
__device__ __forceinline__ void xcd_barrier_complete(unsigned* bar, unsigned x, unsigned& nloc, unsigned& nx) {
    const unsigned G = gridDim.x * gridDim.y * gridDim.z;
    unsigned sum, cnt, mine, sp = 0u;
    for (;;) {
        sum = 0u; cnt = 0u; mine = 0u;
#pragma unroll
        for (unsigned j = 0; j < 16; ++j) { const unsigned c = xb_ld(&bar[XB_XCNT(j)]); sum += c; cnt += (c > 0u) ? 1u : 0u; mine = (j == x) ? c : mine; }
        if (sum == G) break;
        __builtin_amdgcn_s_sleep(1);
        if ((++sp & 255u) == 0u) { if (xb_ld(&bar[XB_TMO])) break; if (sp > XB_SPIN_CAP) { atomicAdd(&bar[XB_TMO], 1u); break; } }
    }
    nloc = mine > 0u ? mine : 1u; nx = cnt > 0u ? cnt : 1u;
}
__device__ __forceinline__ void xcd_barrier(const XcdBarrier& b, const int tid) {
    asm volatile("s_waitcnt vmcnt(0)" ::: "memory");
    unsigned blo = (unsigned)(unsigned long long)b.bar, bhi = (unsigned)((unsigned long long)b.bar >> 32), bx = b.x;
    asm volatile("" : "+s"(blo), "+s"(bhi), "+s"(bx));
    __syncthreads();
    if (tid == 0) {
        unsigned* bar = (unsigned*)(((unsigned long long)bhi << 32) | blo);
        __builtin_amdgcn_s_waitcnt(0);
        unsigned nloc = b.st[0], nx = b.st[1];
        if (nloc == 0u) { xcd_barrier_complete(bar, bx, nloc, nx); b.st[0] = nloc; b.st[1] = nx; }
        const unsigned old = xb_add(&bar[XB_XSUB(bx)], 1u);
        const unsigned gen = old / nloc;
        if (old + 1u == (gen + 1u) * nloc) {
            __builtin_amdgcn_fence(__ATOMIC_RELEASE, "agent");
            asm volatile("s_waitcnt vmcnt(0)" ::: "memory");
            const unsigned og = xb_add(&bar[XB_TOP], 1u);
            const unsigned tg = og / nx;
            if (og + 1u == (tg + 1u) * nx) xb_add(&bar[XB_TOPGEN], 1u);
            else XB_SPIN(xb_ld(&bar[XB_TOPGEN]) == tg, bar);
            __builtin_amdgcn_fence(__ATOMIC_ACQUIRE, "agent");
            xb_add(&bar[XB_XGEN(bx)], 1u);
            asm volatile("s_waitcnt vmcnt(0)" ::: "memory");
        } else {
            XB_SPIN(xb_ld(&bar[XB_XGEN(bx)]) == gen, bar);
            __builtin_amdgcn_fence(__ATOMIC_ACQUIRE, "agent");
            asm volatile("s_waitcnt vmcnt(0)" ::: "memory");
        }
    }
    __syncthreads();
}

namespace pg8 {
constexpr int BM = 256, BK = 64, HALF = 128, HTB = HALF * BK * 2, STAGE_BYTES = 8 * HTB, NXCD = 8, WGM = 8;
__host__ __device__ __forceinline__ int lds_byte(int r, int c) { const int st = (r >> 4) * 2 + (c >> 5), rr = r & 15, cc = c & 31, ob = rr * 64 + cc * 2; return st * 1024 + (ob ^ (((ob >> 9) & 1) << 5)); }
__host__ __device__ __forceinline__ void stage_rc(int b, int& R, int& C) { const int st = b / 1024, sb = b % 1024, swz = sb ^ (((sb >> 9) & 1) << 5); R = (st >> 1) * 16 + swz / 64; C = (st & 1) * 32 + (swz % 64) / 2; }
__host__ __device__ __forceinline__ int perm32(int rho) { const int n = rho >> 4, i = rho & 15; return 8 * (i >> 2) + 4 * n + (i & 3); }

struct Unit { int pm, pn, e, ui; };

typedef int i32x8 __attribute__((ext_vector_type(8)));
typedef int i32x4 __attribute__((ext_vector_type(4)));
__device__ __forceinline__ i32x8 cat8(bf16x8 a, bf16x8 b) { return __builtin_shufflevector(__builtin_bit_cast(i32x4, a), __builtin_bit_cast(i32x4, b), 0, 1, 2, 3, 4, 5, 6, 7); }
template <class Epi, class Sched, bool ALIGN_EPI = true, bool FP8 = false>
__device__ __forceinline__ void gemm_phase(LAS unsigned char* lds, const char* gA, const int Kb, const Sched& S, const Epi& E, const int tid) {
    const int wid = __builtin_amdgcn_readfirstlane(tid >> 6), lane = tid & 63, wr = wid >> 2, wc = wid & 3, fr = lane & 15, fq = lane >> 4;
    const int nt = Kb / (BK * 2);
    int Ra[2], Ca[2]; unsigned voffB[2];
#pragma unroll
    for (int i = 0; i < 2; ++i) { int R, C; stage_rc(tid * 16 + i * 8192, R, C); const int Rb = Epi::PERM ? ((R & ~31) + perm32(R & 31)) : R;
        Ra[i] = R; Ca[i] = C * 2; voffB[i] = (unsigned)(Rb * Kb + C * 2); }
    const size_t kstep = (size_t)(BK * 2);
    const size_t hstep = (size_t)HALF * Kb;
    const unsigned ldsw = (unsigned)wid * 1024u;
    const int aoff = lds_byte(wr * 64 + fr, fq * 8), boff = lds_byte(wc * 32 + fr, fq * 8);
#define PG8_SA(b, h) (((b) * 2 + (h)) * HTB)
#define PG8_SB(b, h) ((4 + (b) * 2 + (h)) * HTB)
#define PG8_STAGE(bufoff, gbase, voff) do { _Pragma("unroll") for (int _i = 0; _i < 2; ++_i) \
        __builtin_amdgcn_global_load_lds((const unsigned*)((const char*)(gbase) + (voff)[_i]), (LAS unsigned*)(lds + (bufoff) + ldsw + _i * 8192), 16, 0, 0); } while (0)
#define PG8_LDA(dst, b, h) do { _Pragma("unroll") for (int m = 0; m < 4; ++m) _Pragma("unroll") for (int k = 0; k < 2; ++k) dst[m][k] = *(const LAS bf16x8*)(lds + PG8_SA(b, h) + aoff + m * 2048 + k * 1024); } while (0)
#define PG8_LDB(dst, b, h) do { _Pragma("unroll") for (int n = 0; n < 2; ++n) _Pragma("unroll") for (int k = 0; k < 2; ++k) dst[n][k] = *(const LAS bf16x8*)(lds + PG8_SB(b, h) + boff + n * 2048 + k * 1024); } while (0)
#define PG8_MMA(ai, bj, At, Bt) do { __builtin_amdgcn_s_setprio(1); _Pragma("unroll") for (int m = 0; m < 4; ++m) _Pragma("unroll") for (int n = 0; n < 2; ++n) { \
        if constexpr (FP8) asm volatile("v_mfma_scale_f32_16x16x128_f8f6f4 %0, %1, %2, %0, %3, %3 op_sel_hi:[0,0,0]" : "+v"(acc[ai][bj][m][n]) : "v"(cat8(Bt[n][0], Bt[n][1])), "v"(cat8(At[m][0], At[m][1])), "v"(scl)); \
        else { _Pragma("unroll") for (int k = 0; k < 2; ++k) acc[ai][bj][m][n] = __builtin_amdgcn_mfma_f32_16x16x32_bf16(Bt[n][k], At[m][k], acc[ai][bj][m][n], 0, 0, 0); } } __builtin_amdgcn_s_setprio(0); } while (0)
#define PG8_WAIT_V(n) asm volatile("s_waitcnt vmcnt(" #n ")" ::: "memory")
#define PG8_WAIT_L(n) asm volatile("s_waitcnt lgkmcnt(" #n ")" ::: "memory")
#define PG8_BAR __builtin_amdgcn_s_barrier()
#define PG8_SCHED __builtin_amdgcn_sched_barrier(0)
    Unit cur, nxt; int ui = 0;
    if (!S.next(0, cur)) return;
    f32x4 acc[2][2][4][2];
#pragma unroll
    for (int a = 0; a < 2; ++a)
#pragma unroll
        for (int b = 0; b < 2; ++b)
#pragma unroll
            for (int m = 0; m < 4; ++m)
#pragma unroll
                for (int n = 0; n < 2; ++n) acc[a][b][m][n] = (f32x4){0.f, 0.f, 0.f, 0.f};
    bf16x8 At[4][2], B0[2][2], B1[2][2]; const int scl = 0x7f7f7f7f;
    unsigned vA[2][2];
#pragma unroll
    for (int h = 0; h < 2; ++h)
#pragma unroll
        for (int i = 0; i < 2; ++i) vA[h][i] = S.a_row_off(cur, h * HALF + Ra[i]) + (unsigned)Ca[i];
    const char* cB = S.b_tile(cur);
    PG8_STAGE(PG8_SB(0, 0), cB, voffB); PG8_STAGE(PG8_SB(0, 1), cB + hstep, voffB); PG8_STAGE(PG8_SA(0, 0), gA, vA[0]); PG8_STAGE(PG8_SA(0, 1), gA, vA[1]);
    if (wr == 1) PG8_BAR;
    PG8_WAIT_V(2); PG8_BAR;
    PG8_STAGE(PG8_SB(1, 0), cB + kstep, voffB); PG8_STAGE(PG8_SA(1, 0), gA + kstep, vA[0]); PG8_STAGE(PG8_SB(1, 1), cB + hstep + kstep, voffB);
    PG8_WAIT_V(6); PG8_BAR;
    for (;;) {
        const bool has_next = S.next(ui + 1, nxt);
        const char* nB = has_next ? S.b_tile(nxt) : cB;
        for (int t = 0; t < nt; t += 2) {
            const bool last = (t == nt - 2);
            unsigned tN[2][2];
#pragma unroll
            for (int h = 0; h < 2; ++h)
#pragma unroll
                for (int i = 0; i < 2; ++i) tN[h][i] = vA[h][i];
            if (last && has_next) {
#pragma unroll
                for (int h = 0; h < 2; ++h)
#pragma unroll
                    for (int i = 0; i < 2; ++i) tN[h][i] = S.a_row_off(nxt, h * HALF + Ra[i]) + (unsigned)Ca[i];
                PG8_WAIT_L(0);
            }
            const char* a1 = gA + (size_t)(t + 1) * kstep;
            const char* a2 = last ? gA : gA + (size_t)(t + 2) * kstep; const char* b2 = last ? nB : cB + (size_t)(t + 2) * kstep;
            const char* a3 = a2 + kstep; const char* b3 = b2 + kstep;
            PG8_LDB(B0, 0, 0); PG8_LDB(B1, 0, 1); PG8_SCHED; PG8_LDA(At, 0, 0); PG8_STAGE(PG8_SA(1, 1), a1, vA[1]);
#pragma unroll
            for (int h = 0; h < 2; ++h)
#pragma unroll
                for (int i = 0; i < 2; ++i) vA[h][i] = tN[h][i];
            PG8_WAIT_V(8); PG8_WAIT_L(0); PG8_BAR; PG8_MMA(0, 0, At, B0); PG8_MMA(0, 1, At, B1); PG8_BAR; PG8_SCHED;
            PG8_LDA(At, 0, 1); PG8_STAGE(PG8_SB(0, 0), b2, voffB); PG8_STAGE(PG8_SB(0, 1), b2 + hstep, voffB); PG8_STAGE(PG8_SA(0, 0), a2, vA[0]);
            PG8_WAIT_V(8); PG8_WAIT_L(0); PG8_BAR; PG8_MMA(1, 0, At, B0); PG8_MMA(1, 1, At, B1); PG8_BAR; PG8_SCHED;
            PG8_LDB(B0, 1, 0); PG8_LDB(B1, 1, 1); PG8_SCHED; PG8_LDA(At, 1, 0); PG8_STAGE(PG8_SA(0, 1), a2, vA[1]);
            PG8_WAIT_V(8); PG8_WAIT_L(0); PG8_BAR; PG8_MMA(0, 0, At, B0); PG8_MMA(0, 1, At, B1); PG8_BAR; PG8_SCHED;
            PG8_LDA(At, 1, 1); PG8_STAGE(PG8_SB(1, 0), b3, voffB); PG8_STAGE(PG8_SB(1, 1), b3 + hstep, voffB); PG8_STAGE(PG8_SA(1, 0), a3, vA[0]);
            PG8_WAIT_V(8); PG8_WAIT_L(0); PG8_BAR; PG8_MMA(1, 0, At, B0); PG8_MMA(1, 1, At, B1); PG8_BAR; PG8_SCHED;
        }
        if constexpr (ALIGN_EPI) { if (wr == 0) PG8_BAR; }
        if constexpr (FP8) asm volatile("s_nop 15\n\ts_nop 15" ::: "memory");
        E(acc, cur, wr, wc, fr, fq);
        if (!has_next) break;
#pragma unroll
        for (int a = 0; a < 2; ++a)
#pragma unroll
            for (int b = 0; b < 2; ++b)
#pragma unroll
                for (int m = 0; m < 4; ++m)
#pragma unroll
                    for (int n = 0; n < 2; ++n) acc[a][b][m][n] = (f32x4){0.f, 0.f, 0.f, 0.f};
        cur = nxt; cB = nB; ++ui;
        if constexpr (ALIGN_EPI) { if (wr == 1) PG8_BAR; }
    }
    PG8_WAIT_V(0);
    if constexpr (!ALIGN_EPI) { if (wr == 0) PG8_BAR; }
    PG8_BAR;
#undef PG8_SA
#undef PG8_SB
#undef PG8_STAGE
#undef PG8_LDA
#undef PG8_LDB
#undef PG8_MMA
#undef PG8_WAIT_V
#undef PG8_WAIT_L
#undef PG8_BAR
#undef PG8_SCHED
}
}
constexpr size_t MiB = 1u << 20;
constexpr int TP = T * 4 + NE * 256;
constexpr size_t WS_CTL = 0, CTL_ZERO_BYTES = 128 * 1024;
constexpr size_t WS_LB = 1 * MiB, WS_MOD = 1 * MiB + 65536;
constexpr size_t WS_WIN = 2 * MiB, WS_WOUT = 18 * MiB, WS_WF = 22 * MiB, WS_WGU = 24 * MiB, WS_WDN = 280 * MiB;
constexpr size_t WS_X = 408 * MiB, WS_H = 474 * MiB, WS_P = 508 * MiB, WS_CAT = 624 * MiB, WS_ROUTE = 658 * MiB, WS_ACT = 662 * MiB, WS_Y = 810 * MiB;
constexpr size_t WS_SU = 958 * MiB, WS_SS = 990 * MiB, WS_SD = 1022 * MiB, WS_YP = 1023 * MiB, WS_OSCR = 1040 * MiB, WS_H8 = 1072 * MiB, WS_CTXO = 1090 * MiB, WS_FASTEND = 1092 * MiB;
#ifndef MOE_FP8
#define MOE_FP8 1
#endif
constexpr float FP8_SH = 16.f, FP8_SW = 256.f, FP8_SA = 4.f;
constexpr size_t RT_TOPI = 0, RT_TOPW = 512 * 1024, RT_POS = 1024 * 1024, RT_LISTE = 1536 * 1024;
static_assert((size_t)T * 16 <= 512 * 1024 && RT_LISTE + (size_t)NE * T * 4 <= 4 * MiB, "route map");
static_assert(WS_WIN + (size_t)2 * DINX * D * 2 <= WS_WOUT && WS_WGU + (size_t)2 * NE * 2048 * 1024 * 2 <= WS_WDN && WS_WDN + (size_t)2 * NE * 1024 * 1024 * 2 <= WS_X && WS_X + (size_t)T * D * 4 <= WS_H && WS_H + (size_t)T * D * 2 <= WS_P &&
              WS_P + (size_t)T * DINX * 2 <= WS_CAT && WS_CAT + (size_t)T * D * 2 <= WS_ROUTE && WS_ACT + (size_t)TP * D * 2 <= WS_Y && WS_Y + (size_t)TP * D * 2 <= WS_SU &&
              WS_SD + (size_t)(8 * 64 * 128 + 8 * 16384) * 4 <= WS_YP && WS_YP + (size_t)128 * 128 * 2 * 256 * 2 <= WS_OSCR && WS_OSCR + (size_t)256 * 32768 * 4 <= WS_H8 && WS_H8 + (size_t)T * D <= WS_CTXO && WS_CTXO + (size_t)32 * 8192 * 4 <= WS_FASTEND, "ws map");
constexpr int CW_TMO = 0, CW_BAR = 4096, CW_CNT = 16384;
constexpr int RING_OFF = 0, RING_BYTES = 131072, TINFO_OFF = 131072, BT_OFF = 136192, ROWOFF_OFF = 136704, MISC_OFF = 146944, LDS_BYTES = 147456;
constexpr int NWAVES = 8, NTHR = 512;

struct Params { const float* in[22]; float* out; unsigned char* ws; };
constexpr int PTR_OFF = MISC_OFF + 64;
struct Frame {
    LAS unsigned char* lds; unsigned char* ws; int tid, lane, wave, vcu, G, bid;
    __device__ __forceinline__ const float* in(int i) const { const LAS unsigned* q = (const LAS unsigned*)(lds + PTR_OFF) + 2 * i;
        const unsigned lo = __builtin_amdgcn_readfirstlane(q[0]), hi = __builtin_amdgcn_readfirstlane(q[1]); return (const float*)(((unsigned long long)hi << 32) | lo); }
    __device__ __forceinline__ const float* x() const { return in(0); }        __device__ __forceinline__ const float* c() const { return in(1); }
    __device__ __forceinline__ const float* ctxin() const { return in(2); }    __device__ __forceinline__ const float* cctx() const { return in(3); }
    __device__ __forceinline__ const float* w_ada() const { return in(4); }    __device__ __forceinline__ const float* b_ada() const { return in(5); }
    __device__ __forceinline__ const float* norm1_g() const { return in(6); }  __device__ __forceinline__ const float* norm2_g() const { return in(7); }
    __device__ __forceinline__ const float* w_in() const { return in(8); }     __device__ __forceinline__ const float* lbp() const { return in(9); }
    __device__ __forceinline__ const float* hng() const { return in(10); }     __device__ __forceinline__ const float* pool_w() const { return in(11); }
    __device__ __forceinline__ const float* pool_s() const { return in(12); }  __device__ __forceinline__ const float* four_w() const { return in(13); }
    __device__ __forceinline__ const float* w_out() const { return in(14); }   __device__ __forceinline__ const float* router_w() const { return in(15); }
    __device__ __forceinline__ const float* router_b() const { return in(16); } __device__ __forceinline__ const float* w_gu() const { return in(17); }
    __device__ __forceinline__ const float* b_gu() const { return in(18); }    __device__ __forceinline__ const float* w_dn() const { return in(19); }
    __device__ __forceinline__ const float* b_dn() const { return in(20); }    __device__ __forceinline__ const float* fng() const { return in(21); }
    __device__ __forceinline__ float* out() const { return (float*)in(22); }
    __device__ __forceinline__ gu32* ctl() const { return (gu32*)(ws + WS_CTL); }
    __device__ __forceinline__ float* LB() const { return (float*)(ws + WS_LB); }       __device__ __forceinline__ float* MOD() const { return (float*)(ws + WS_MOD); }
    __device__ __forceinline__ float* X() const { return (float*)(ws + WS_X); }
    __device__ __forceinline__ bf16_t* Wt_in() const { return (bf16_t*)(ws + WS_WIN); }  __device__ __forceinline__ bf16_t* Wt_out() const { return (bf16_t*)(ws + WS_WOUT); }
    __device__ __forceinline__ bf16_t* Wt_gu() const { return (bf16_t*)(ws + WS_WGU); }  __device__ __forceinline__ bf16_t* Wt_dn() const { return (bf16_t*)(ws + WS_WDN); }
    __device__ __forceinline__ bf16_t* H() const { return (bf16_t*)(ws + WS_H); }        __device__ __forceinline__ bf16_t* P() const { return (bf16_t*)(ws + WS_P); }
    __device__ __forceinline__ bf16_t* CAT() const { return (bf16_t*)(ws + WS_CAT); }    __device__ __forceinline__ bf16_t* ACT() const { return (bf16_t*)(ws + WS_ACT); }
    __device__ __forceinline__ bf16_t* Y() const { return (bf16_t*)(ws + WS_Y); }
    __device__ __forceinline__ int* TOPI() const { return (int*)(ws + WS_ROUTE + RT_TOPI); }   __device__ __forceinline__ float* TOPW() const { return (float*)(ws + WS_ROUTE + RT_TOPW); }
    __device__ __forceinline__ int* POS() const { return (int*)(ws + WS_ROUTE + RT_POS); }     __device__ __forceinline__ int* LISTE() const { return (int*)(ws + WS_ROUTE + RT_LISTE); }
};
__device__ __forceinline__ void frame_init(Frame& F, const Params& p, unsigned char* lds) {
    F.lds = (LAS unsigned char*)lds; F.tid = threadIdx.x; F.lane = F.tid & 63; F.wave = __builtin_amdgcn_readfirstlane(F.tid >> 6);
    F.G = gridDim.x; F.bid = blockIdx.x; { const int bx = blockIdx.x; F.vcu = (F.G % 8 == 0) ? (bx % 8) * (F.G / 8) + bx / 8 : bx; }
    F.ws = p.ws;
    if (F.tid == 0) { LAS unsigned long long* tab = (LAS unsigned long long*)(F.lds + PTR_OFF);
#pragma unroll
        for (int i = 0; i < 22; ++i) tab[i] = (unsigned long long)p.in[i];
        tab[22] = (unsigned long long)p.out; }
    __syncthreads();
}

__device__ __forceinline__ Frame relaunder(const Frame& F) { Frame R = F; int ln; asm volatile("v_mbcnt_lo_u32_b32 %0, -1, 0\n\tv_mbcnt_hi_u32_b32 %0, -1, %0" : "=v"(ln));
    R.lane = ln; R.tid = F.wave * 64 + ln; unsigned wlo = (unsigned)(unsigned long long)F.ws, whi = (unsigned)((unsigned long long)F.ws >> 32);
    asm volatile("" : "+s"(wlo), "+s"(whi)); R.ws = (unsigned char*)(((unsigned long long)whi << 32) | wlo);
    int sw = F.wave, sv = F.vcu, sg = F.G, sb = F.bid;
    asm volatile("" : "+s"(sw), "+s"(sv), "+s"(sg), "+s"(sb));
    R.wave = sw; R.vcu = sv; R.G = sg; R.bid = sb; R.tid = sw * 64 + ln; return R; }

struct DenseOrder {
    int nM, nN, nwg, G, c, Kb, pm0; const char* Bt;
    __device__ void init(int nM_, int nN_, int G_, int c_, int Kb_, const bf16_t* Bt_, int pm0_ = 0) { nM = nM_; nN = nN_; nwg = nM * nN; G = G_; c = c_; Kb = Kb_; Bt = (const char*)Bt_; pm0 = pm0_; }
    __device__ __forceinline__ bool next(int i, pg8::Unit& u) const {
        const long L = (long)i * G + c; if (L >= nwg) return false;
        int wgid = (int)L; { const int q = nwg / pg8::NXCD, r = nwg % pg8::NXCD, xcd = wgid % pg8::NXCD, off = wgid / pg8::NXCD; wgid = (xcd < r ? xcd * (q + 1) : r * (q + 1) + (xcd - r) * q) + off; }
        const int nig = pg8::WGM * nN, gid = wgid / nig, fm = gid * pg8::WGM, gsz = (nM - fm) < pg8::WGM ? (nM - fm) : pg8::WGM;
        u.pm = pm0 + fm + ((wgid % nig) % gsz); u.pn = (wgid % nig) / gsz; u.e = 0; u.ui = i; return true;
    }
    __device__ __forceinline__ const char* b_tile(const pg8::Unit& u) const { return Bt + (size_t)u.pn * 256 * Kb; }
    __device__ __forceinline__ unsigned a_row_off(const pg8::Unit& u, int r) const { return (unsigned)(u.pm * 256 + r) * (unsigned)Kb; }
};
template <bool GATHER> struct MoeOrder {
    const LAS int* tinfo; const LAS unsigned* rowoff; int ntiles, nN, G, c, Kb; const char* W; size_t wstride;
    __device__ __forceinline__ bool next(int i, pg8::Unit& u) const {
        const int L = i * G + c; if (L >= ntiles * nN) return false;
        u.pm = L / nN; u.pn = L % nN; u.e = __builtin_amdgcn_readfirstlane(tinfo[4 * u.pm]); u.ui = i; return true;
    }
    __device__ __forceinline__ const char* b_tile(const pg8::Unit& u) const { return W + (size_t)u.e * wstride + (size_t)u.pn * 256 * Kb; }
    __device__ __forceinline__ unsigned a_row_off(const pg8::Unit& u, int r) const { if constexpr (GATHER) return rowoff[u.ui * 256 + r]; else return (unsigned)(u.pm * 256 + r) * (unsigned)Kb; }
};

__device__ __forceinline__ unsigned pk_f16(float a, float b) { const _Float16 x = (_Float16)a, y = (_Float16)b; return (unsigned)__builtin_bit_cast(unsigned short, x) | ((unsigned)__builtin_bit_cast(unsigned short, y) << 16); }
__device__ __forceinline__ float f16lo(unsigned w) { return (float)__builtin_bit_cast(_Float16, (unsigned short)(w & 0xffffu)); }
__device__ __forceinline__ float f16hi(unsigned w) { return (float)__builtin_bit_cast(_Float16, (unsigned short)(w >> 16)); }
struct EpiP {
    static constexpr bool PERM = true; bf16_t* O; int ldc; const float* lb;
    __device__ __forceinline__ void operator()(const f32x4 (&acc)[2][2][4][2], const pg8::Unit& u, int wr, int wc, int fr, int fq) const {
        const int row0 = u.pm * 256 + wr * 64 + fr, col0 = u.pn * 256 + wc * 32 + 8 * fq;
        const int mode = u.pn < 2 ? 1 : (u.pn < 6 ? 2 : ((u.pn == 8 || u.pn == 9) ? 3 : 0));
        f32x4 lbv[2][2];
        if (mode == 2) {
#pragma unroll
            for (int bj = 0; bj < 2; ++bj)
#pragma unroll
                for (int n = 0; n < 2; ++n) lbv[bj][n] = *(const f32x4*)(lb + (col0 - 512) + bj * 128 + 4 * n); }
#pragma unroll
        for (int ai = 0; ai < 2; ++ai)
#pragma unroll
            for (int m = 0; m < 4; ++m) { bf16_t* rowp = O + (size_t)(row0 + ai * 128 + m * 16) * ldc + col0;
#pragma unroll
                for (int bj = 0; bj < 2; ++bj) { f32x2 v[4]; { const f32x4 v0 = acc[ai][bj][m][0], v1 = acc[ai][bj][m][1]; v[0] = (f32x2){v0[0], v0[1]}; v[1] = (f32x2){v0[2], v0[3]}; v[2] = (f32x2){v1[0], v1[1]}; v[3] = (f32x2){v1[2], v1[3]}; }
                    u32x4 w;
                    if (mode != 0) {
                        f32x2 sg[4];
#pragma unroll
                        for (int p = 0; p < 4; ++p) { const f32x2 ex = v[p] * (-1.44269504f); f32x2 d; d.x = __builtin_amdgcn_exp2f(ex.x); d.y = __builtin_amdgcn_exp2f(ex.y); d = d + 1.0f; sg[p].x = __builtin_amdgcn_rcpf(d.x); sg[p].y = __builtin_amdgcn_rcpf(d.y); }
                        if (mode == 2) {
#pragma unroll
                            for (int p = 0; p < 4; ++p) { const f32x4 lv = lbv[bj][p >> 1]; const f32x2 lb2 = (f32x2){lv[2 * (p & 1)], lv[2 * (p & 1) + 1]}; const f32x2 f = lb2 + (1.0f - lb2) * sg[p];
                                v[p].x = __builtin_amdgcn_logf(fmaxf(f.x, 1e-30f)); v[p].y = __builtin_amdgcn_logf(fmaxf(f.y, 1e-30f)); }
                            w.x = pk_f16(v[0].x, v[0].y); w.y = pk_f16(v[1].x, v[1].y); w.z = pk_f16(v[2].x, v[2].y); w.w = pk_f16(v[3].x, v[3].y);
                        } else {
#pragma unroll
                            for (int p = 0; p < 4; ++p) v[p] = mode == 1 ? v[p] * sg[p] : sg[p];
                            w.x = cvt_pk_bf16(v[0].x, v[0].y); w.y = cvt_pk_bf16(v[1].x, v[1].y); w.z = cvt_pk_bf16(v[2].x, v[2].y); w.w = cvt_pk_bf16(v[3].x, v[3].y); }
                    } else { w.x = cvt_pk_bf16(v[0].x, v[0].y); w.y = cvt_pk_bf16(v[1].x, v[1].y); w.z = cvt_pk_bf16(v[2].x, v[2].y); w.w = cvt_pk_bf16(v[3].x, v[3].y); }
                    *(u32x4*)(rowp + bj * 128) = w; } }
    }
};
struct EpiRes {
    static constexpr bool PERM = false; const float* base_ctx; const float* base_lat; const float* gate_ctx; const float* gate_lat; float* Xo;
    __device__ __forceinline__ void operator()(const f32x4 (&acc)[2][2][4][2], const pg8::Unit& u, int wr, int wc, int fr, int fq) const {
        const int rt = wr * 64 + fr, col0 = u.pn * 256 + wc * 32 + 4 * fq;
        const float* base = (u.pm == 0 ? base_ctx : base_lat + (size_t)(u.pm - 1) * 256 * D) + (size_t)rt * D + col0; const float* gate = (u.pm == 0 ? gate_ctx : gate_lat) + col0;
        float* op = Xo + (size_t)(u.pm * 256 + rt) * D + col0;
#pragma unroll
        for (int bj = 0; bj < 2; ++bj)
#pragma unroll
            for (int n = 0; n < 2; ++n) { const f32x4 gv = *(const f32x4*)(gate + bj * 128 + n * 16);
#pragma unroll
                for (int ai = 0; ai < 2; ++ai) {
#pragma unroll
                    for (int m = 0; m < 4; ++m) { const size_t o = (size_t)(ai * 128 + m * 16) * D + bj * 128 + n * 16; const f32x4 b = *(const f32x4*)(base + o); *(f32x4*)(op + o) = b + gv * acc[ai][bj][m][n]; }
                    asm volatile("" ::: "memory"); } }
    }
};
struct EpiAct {
    static constexpr bool PERM = true; bf16_t* ACTo; const float* bias;
    __device__ __forceinline__ void operator()(const f32x4 (&acc)[2][2][4][2], const pg8::Unit& u, int wr, int wc, int fr, int fq) const {
        const int x0 = wc * 32 + 8 * fq; const float* bg = bias + (size_t)u.e * 2048 + 128 * u.pn + x0; const float* bu = bg + 1024;
        const f32x4 g0 = *(const f32x4*)bg, g1 = *(const f32x4*)(bg + 4), u0 = *(const f32x4*)bu, u1 = *(const f32x4*)(bu + 4);
#pragma unroll
        for (int ai = 0; ai < 2; ++ai)
#pragma unroll
            for (int m = 0; m < 4; ++m) { const int row = u.pm * 256 + ai * 128 + wr * 64 + m * 16 + fr;
                const f32x4 ga = acc[ai][0][m][0] + g0, gb = acc[ai][0][m][1] + g1, ua = acc[ai][1][m][0] + u0, ub = acc[ai][1][m][1] + u1; float r[8];
#pragma unroll
                for (int j = 0; j < 4; ++j) { const float g = fminf(ga[j], 7.f), up = fminf(fmaxf(ua[j], -7.f), 7.f); r[j] = (up + 1.f) * (g * fsigm(1.702f * g));
                                              const float g2 = fminf(gb[j], 7.f), up2 = fminf(fmaxf(ub[j], -7.f), 7.f); r[4 + j] = (up2 + 1.f) * (g2 * fsigm(1.702f * g2)); }
                u32x4 w; w.x = cvt_pk_bf16(r[0], r[1]); w.y = cvt_pk_bf16(r[2], r[3]); w.z = cvt_pk_bf16(r[4], r[5]); w.w = cvt_pk_bf16(r[6], r[7]);
                *(u32x4*)(ACTo + (size_t)row * D + 128 * u.pn + x0) = w; }
    }
};
struct EpiY {
    static constexpr bool PERM = true; bf16_t* Yo; const float* bias;
    __device__ __forceinline__ void operator()(const f32x4 (&acc)[2][2][4][2], const pg8::Unit& u, int wr, int wc, int fr, int fq) const {
        const int row0 = u.pm * 256 + wr * 64 + fr, col0 = u.pn * 256 + wc * 32 + 8 * fq; const float* bp = bias + (size_t)u.e * D + col0;
        f32x4 bv[2][2];
#pragma unroll
        for (int bj = 0; bj < 2; ++bj)
#pragma unroll
            for (int n = 0; n < 2; ++n) bv[bj][n] = *(const f32x4*)(bp + bj * 128 + 4 * n);
#pragma unroll
        for (int ai = 0; ai < 2; ++ai)
#pragma unroll
            for (int m = 0; m < 4; ++m) { bf16_t* rowp = Yo + (size_t)(row0 + ai * 128 + m * 16) * D + col0;
#pragma unroll
                for (int bj = 0; bj < 2; ++bj) { const f32x4 v0 = acc[ai][bj][m][0] + bv[bj][0], v1 = acc[ai][bj][m][1] + bv[bj][1];
                    u32x4 w; w.x = cvt_pk_bf16(v0[0], v0[1]); w.y = cvt_pk_bf16(v0[2], v0[3]); w.z = cvt_pk_bf16(v1[0], v1[1]); w.w = cvt_pk_bf16(v1[2], v1[3]);
                    *(u32x4*)(rowp + bj * 128) = w; } }
    }
};

__device__ __forceinline__ unsigned pk4_fp8(float a, float b, float c, float d) { int r = __builtin_amdgcn_cvt_pk_fp8_f32(a, b, 0, false); r = __builtin_amdgcn_cvt_pk_fp8_f32(c, d, r, true); return (unsigned)r; }
struct EpiAct8 {
    static constexpr bool PERM = true; unsigned char* ACTo; const float* bias;
    __device__ __forceinline__ void operator()(const f32x4 (&acc)[2][2][4][2], const pg8::Unit& u, int wr, int wc, int fr, int fq) const {
        const int x0 = wc * 32 + 8 * fq; const float* bg = bias + (size_t)u.e * 2048 + 128 * u.pn + x0; const float* bu = bg + 1024; constexpr float isc = 1.f / (FP8_SH * FP8_SW);
        f32x2 g[4], v[4];
#pragma unroll
        for (int p = 0; p < 4; ++p) { g[p] = *(const f32x2*)(bg + 2 * p); v[p] = *(const f32x2*)(bu + 2 * p); }
#pragma unroll
        for (int ai = 0; ai < 2; ++ai)
#pragma unroll
            for (int m = 0; m < 4; ++m) { const int row = u.pm * 256 + ai * 128 + wr * 64 + m * 16 + fr; f32x2 r[4];
#pragma unroll
                for (int p = 0; p < 4; ++p) { const f32x4 ga4 = acc[ai][0][m][p >> 1], ua4 = acc[ai][1][m][p >> 1];
                    f32x2 gg = (f32x2){ga4[2 * (p & 1)], ga4[2 * (p & 1) + 1]} * isc + g[p], uu = (f32x2){ua4[2 * (p & 1)], ua4[2 * (p & 1) + 1]} * isc + v[p];
                    gg.x = fminf(gg.x, 7.f); gg.y = fminf(gg.y, 7.f); uu.x = __builtin_amdgcn_fmed3f(uu.x, -7.f, 7.f); uu.y = __builtin_amdgcn_fmed3f(uu.y, -7.f, 7.f);
                    const f32x2 ex = gg * (-1.702f * 1.44269504f); f32x2 d; d.x = __builtin_amdgcn_exp2f(ex.x); d.y = __builtin_amdgcn_exp2f(ex.y); d = d + 1.0f;
                    f32x2 rc; rc.x = __builtin_amdgcn_rcpf(d.x); rc.y = __builtin_amdgcn_rcpf(d.y);
                    r[p] = (uu * FP8_SA + FP8_SA) * (gg * rc); }
                u32x2 w; w.x = pk4_fp8(r[0].x, r[0].y, r[1].x, r[1].y); w.y = pk4_fp8(r[2].x, r[2].y, r[3].x, r[3].y);
                *(u32x2*)(ACTo + (size_t)row * D + 128 * u.pn + x0) = w; }
    }
};
struct EpiY8 {
    static constexpr bool PERM = true; bf16_t* Yo; const float* bias;
    __device__ __forceinline__ void operator()(const f32x4 (&acc)[2][2][4][2], const pg8::Unit& u, int wr, int wc, int fr, int fq) const {
        const int row0 = u.pm * 256 + wr * 64 + fr, col0 = u.pn * 256 + wc * 32 + 8 * fq; const float* bp = bias + (size_t)u.e * D + col0; constexpr float isc = 1.f / (FP8_SA * FP8_SW);
        f32x4 bv[2][2];
#pragma unroll
        for (int bj = 0; bj < 2; ++bj)
#pragma unroll
            for (int n = 0; n < 2; ++n) bv[bj][n] = *(const f32x4*)(bp + bj * 128 + 4 * n);
#pragma unroll
        for (int ai = 0; ai < 2; ++ai)
#pragma unroll
            for (int m = 0; m < 4; ++m) { bf16_t* rowp = Yo + (size_t)(row0 + ai * 128 + m * 16) * D + col0;
#pragma unroll
                for (int bj = 0; bj < 2; ++bj) { const f32x4 v0 = acc[ai][bj][m][0] * isc + bv[bj][0], v1 = acc[ai][bj][m][1] * isc + bv[bj][1];
                    u32x4 w; w.x = cvt_pk_bf16(v0[0], v0[1]); w.y = cvt_pk_bf16(v0[2], v0[3]); w.z = cvt_pk_bf16(v1[0], v1[1]); w.w = cvt_pk_bf16(v1[2], v1[3]);
                    *(u32x4*)(rowp + bj * 128) = w; } }
    }
};

struct CvtJob { const float* W; bf16_t* WT; int N, K, k0, n0, nrow0; };
__device__ __forceinline__ void cvt_load(const CvtJob& j, int lane, f32x4 (&r)[16]) { const GAS f32x4* src = (const GAS f32x4*)((const GAS float*)j.W + (unsigned)((j.k0 + 8 * (lane >> 3)) * j.N + j.n0 + 8 * (lane & 7)));
    const unsigned rs = (unsigned)j.N >> 2;
#pragma unroll
    for (int i = 0; i < 8; ++i) { r[2 * i] = src[i * rs]; r[2 * i + 1] = src[i * rs + 1]; } }
__device__ __forceinline__ void cvt_store(const CvtJob& j, int lane, const f32x4 (&r)[16]) {
    u32x4 b[8];
#pragma unroll
    for (int i = 0; i < 8; ++i) { b[i].x = cvt_pk_bf16(r[2 * i][0], r[2 * i][1]); b[i].y = cvt_pk_bf16(r[2 * i][2], r[2 * i][3]); b[i].z = cvt_pk_bf16(r[2 * i + 1][0], r[2 * i + 1][1]); b[i].w = cvt_pk_bf16(r[2 * i + 1][2], r[2 * i + 1][3]); }
    GAS u32x4* dst = (GAS u32x4*)((GAS bf16_t*)j.WT + (unsigned)((j.nrow0 + 8 * (lane & 7)) * j.K + j.k0 + 8 * (lane >> 3))); const unsigned rs = (unsigned)j.K >> 3;
#pragma unroll
    for (int q = 0; q < 8; ++q) { const unsigned sel = (q & 1) ? 0x07060302u : 0x05040100u; u32x4 o;
        o.x = __builtin_amdgcn_perm(b[1][q >> 1], b[0][q >> 1], sel); o.y = __builtin_amdgcn_perm(b[3][q >> 1], b[2][q >> 1], sel);
        o.z = __builtin_amdgcn_perm(b[5][q >> 1], b[4][q >> 1], sel); o.w = __builtin_amdgcn_perm(b[7][q >> 1], b[6][q >> 1], sel);
        dst[q * rs] = o; } }
__device__ __forceinline__ void cvt8_load(const CvtJob& j, int lane, f32x4 (&r)[16]) { const GAS f32x4* src = (const GAS f32x4*)((const GAS float*)j.W + (unsigned)((j.k0 + 16 * (lane >> 3)) * j.N + j.n0 + 4 * (lane & 7)));
    const unsigned rs = (unsigned)j.N >> 2;
#pragma unroll
    for (int i = 0; i < 16; ++i) r[i] = src[i * rs]; }
__device__ __forceinline__ void cvt8_store(const CvtJob& j, int lane, const f32x4 (&r)[16]) {
    GAS u32x4* dst = (GAS u32x4*)((GAS unsigned char*)j.WT + (unsigned)((j.nrow0 + 4 * (lane & 7)) * j.K + j.k0 + 16 * (lane >> 3))); const unsigned rs = (unsigned)j.K >> 4;
#pragma unroll
    for (int n = 0; n < 4; ++n) { u32x4 o;
        o.x = pk4_fp8(r[0][n] * FP8_SW, r[1][n] * FP8_SW, r[2][n] * FP8_SW, r[3][n] * FP8_SW); o.y = pk4_fp8(r[4][n] * FP8_SW, r[5][n] * FP8_SW, r[6][n] * FP8_SW, r[7][n] * FP8_SW);
        o.z = pk4_fp8(r[8][n] * FP8_SW, r[9][n] * FP8_SW, r[10][n] * FP8_SW, r[11][n] * FP8_SW); o.w = pk4_fp8(r[12][n] * FP8_SW, r[13][n] * FP8_SW, r[14][n] * FP8_SW, r[15][n] * FP8_SW);
        dst[n * rs] = o; } }
constexpr int NB_IN = (FQ_OFF < DIN ? FQ_OFF : DIN) / 64, I_IN = 16 * NB_IN, I_OUT = 16 * 16, I_GU = MOE_FP8 ? 8 * 64 : 16 * 32, I_DN = MOE_FP8 ? 8 * 32 : 16 * 16;
constexpr int N_IN = 2 * I_IN, N_OUT = 2 * I_OUT, N_GU = 2 * NE * I_GU, N_DN = 2 * NE * I_DN, N_CVT = N_IN + N_OUT + N_GU + N_DN;
__device__ __forceinline__ CvtJob cvt_job(const Frame& F, int it, bool& f8) {
    CvtJob j; int r = it; f8 = false;
    if (r < N_IN) { const int l = r / I_IN, q = r % I_IN, kb = q / NB_IN, nb = q % NB_IN; j = CvtJob{F.w_in() + (size_t)l * D * DIN, F.Wt_in() + (size_t)l * DINX * D, DIN, D, 64 * kb, 64 * nb, 64 * nb}; return j; } r -= N_IN;
    if (r < N_OUT) { const int l = r / I_OUT, q = r % I_OUT, kb = q >> 4, nb = q & 15; j = CvtJob{F.w_out() + (size_t)l * D * D, F.Wt_out() + (size_t)l * D * D, D, D, 64 * kb, 64 * nb, 64 * nb}; return j; } r -= N_OUT;
    f8 = MOE_FP8;
    if (r < N_GU) { const int le = r / I_GU, q = r % I_GU; const int kb = MOE_FP8 ? q >> 6 : q >> 5, nb = MOE_FP8 ? q & 63 : q & 31; const int n0 = (MOE_FP8 ? 32 : 64) * nb, bj = n0 >> 10, xx = n0 & 1023;
        j = CvtJob{F.w_gu() + (size_t)le * D * 2048, (bf16_t*)((unsigned char*)F.Wt_gu() + (size_t)le * 2048 * D * (MOE_FP8 ? 1 : 2)), 2048, D, (MOE_FP8 ? 128 : 64) * kb, n0, 256 * (xx >> 7) + 128 * bj + (xx & 127)}; return j; } r -= N_GU;
    { const int le = r / I_DN, q = r % I_DN; const int kb = MOE_FP8 ? q >> 5 : q >> 4, nb = MOE_FP8 ? q & 31 : q & 15; const int n0 = (MOE_FP8 ? 32 : 64) * nb;
      j = CvtJob{F.w_dn() + (size_t)le * D * D, (bf16_t*)((unsigned char*)F.Wt_dn() + (size_t)le * D * D * (MOE_FP8 ? 1 : 2)), D, D, (MOE_FP8 ? 128 : 64) * kb, n0, n0}; return j; }
}
__device__ __forceinline__ void cvt_ld(const CvtJob& j, bool f8, int lane, f32x4 (&r)[16]) { if (f8) cvt8_load(j, lane, r); else cvt_load(j, lane, r); }
__device__ __forceinline__ void cvt_st(const CvtJob& j, bool f8, int lane, const f32x4 (&r)[16]) { if (f8) cvt8_store(j, lane, r); else cvt_store(j, lane, r); }
constexpr int WIN_UNITS = (T / 256) * (DINX / 256), WIN_BUSY = WIN_UNITS % 256, DEF_WIN = MOE_FP8 ? 3 : 0, DEF_WOUT = MOE_FP8 ? 3 : 0;
constexpr int DEF_A = (256 - WIN_BUSY) * NWAVES * DEF_WIN, DEF_B = (256 - 4) * NWAVES * DEF_WOUT, DEF_C = DEF_A, DEF_TOTAL = DEF_A + DEF_B + DEF_C;
constexpr int CVT_GU0 = N_IN + N_OUT, CVT_GU1 = CVT_GU0 + NE * I_GU;
static_assert(DEF_A + DEF_B <= NE * I_GU && DEF_C <= NE * I_GU, "deferred slices inside one layer's gate/up items");
__device__ __forceinline__ int cvt_remap(int j) { int it = j; if (it >= CVT_GU0) it += DEF_A + DEF_B; if (it >= CVT_GU1) it += DEF_C; return it; }
__device__ __forceinline__ void cvt_run(Frame& F, int first, int stride, int limit, bool remap) {
    int it = first; if (it >= limit) return;
    f32x4 ra[16], rb[16]; bool fa, fb = false; CvtJob ja = cvt_job(F, remap ? cvt_remap(it) : it, fa), jb; cvt_ld(ja, fa, F.lane, ra);
    for (;;) {
        const int itb = it + stride; const bool hb = itb < limit; if (hb) { jb = cvt_job(F, remap ? cvt_remap(itb) : itb, fb); cvt_ld(jb, fb, F.lane, rb); }
        cvt_st(ja, fa, F.lane, ra); if (!hb) break;
        const int ita = itb + stride; const bool ha = ita < limit; if (ha) { ja = cvt_job(F, remap ? cvt_remap(ita) : ita, fa); cvt_ld(ja, fa, F.lane, ra); }
        cvt_st(jb, fb, F.lane, rb); if (!ha) break;
        it = ita;
    }
}
__device__ __forceinline__ void cvt_deferred(Frame& F, int base, int slot, int per_wave) { if (per_wave == 0) return; const int first = base + (slot * NWAVES + F.wave) * per_wave; cvt_run(F, first, 1, first + per_wave, false); }
__device__ __forceinline__ void ph_prologue(Frame& F) {
    const int gw = F.vcu * NWAVES + F.wave, NGW = F.G * NWAVES;
    for (int i = gw * 64 + F.lane; i < 1024; i += NGW * 64) { const float a = F.lbp()[i], b = F.lbp()[1024 + i], m = fmaxf(a, b), ea = __expf(a - m), eb = __expf(b - m); F.LB()[i] = 0.f; F.LB()[1024 + i] = eb / (ea + eb); }
    if (F.bid < 192) {
        LAS float* sc = (LAS float*)(F.lds); LAS float* part = sc + 2048;
        { const float* c = F.c(); const float* cc = F.cctx(); for (int i = F.tid; i < D; i += NTHR) { const float a = c[i], b = cc[i]; sc[i] = a * fsigm(a); sc[D + i] = b * fsigm(b); } }
        __syncthreads();
        const int l = F.bid / 96, jcol = (F.bid % 96) * 64 + F.lane; const GAS float* W = (const GAS float*)F.w_ada() + (unsigned)(l * D * 6144 + (128 * F.wave) * 6144 + jcol); float a0 = 0.f, a1 = 0.f;
#pragma unroll 16
        for (int i = 0; i < 128; ++i) { const float w = W[(unsigned)i * 6144u]; a0 += sc[128 * F.wave + i] * w; a1 += sc[D + 128 * F.wave + i] * w; }
        part[(F.wave * 2 + 0) * 64 + F.lane] = a0; part[(F.wave * 2 + 1) * 64 + F.lane] = a1;
        __syncthreads();
        if (F.tid < 128) { const int which = F.tid >> 6, col = F.tid & 63; float s = 0.f;
#pragma unroll
            for (int w = 0; w < 8; ++w) s += part[(w * 2 + which) * 64 + col];
            const int j = (F.bid % 96) * 64 + col; F.MOD()[(size_t)(l * 2 + which) * 6144 + j] = s + F.b_ada()[l * 6144 + j]; }
        __syncthreads();
    }
    cvt_run(F, gw, NGW, N_CVT - DEF_TOTAL, true);
}
__device__ __forceinline__ void row_load(const float* xrow, int lane, f32x4 (&v)[4]) { const GAS f32x4* xr = (const GAS f32x4*)xrow + lane;
#pragma unroll
    for (int j = 0; j < 4; ++j) v[j] = xr[64 * j]; }
__device__ __forceinline__ float row_rstd(const f32x4 (&v)[4], int lane) { float s = 0.f;
#pragma unroll
    for (int j = 0; j < 4; ++j) s += (v[j].x * v[j].x + v[j].y * v[j].y) + (v[j].z * v[j].z + v[j].w * v[j].w);
    return rsqrtf(wave_sum(s, lane) * (1.f / D) + 1e-6f); }
__device__ __forceinline__ void row_modulate(const f32x4 (&v)[4], float r, const float* g, const float* sc, const float* sh, int lane, f32x4 (&hv)[4]) {
#pragma unroll
    for (int j = 0; j < 4; ++j) { const f32x4 gg = ((const GAS f32x4*)g)[lane + 64 * j], s1 = ((const GAS f32x4*)sc)[lane + 64 * j], s0 = ((const GAS f32x4*)sh)[lane + 64 * j];
        hv[j] = v[j] * r * gg * (s1 + 1.f) + s0; } }
__device__ __forceinline__ void row_store_fp8(unsigned char* orow, int lane, const f32x4 (&hv)[4]) { GAS unsigned* o4 = (GAS unsigned*)orow + lane;
#pragma unroll
    for (int j = 0; j < 4; ++j) o4[64 * j] = pk4_fp8(hv[j].x * FP8_SH, hv[j].y * FP8_SH, hv[j].z * FP8_SH, hv[j].w * FP8_SH); }
__device__ __forceinline__ void row_store_bf16(bf16_t* orow, int lane, const f32x4 (&hv)[4]) { GAS u32x2* o8 = (GAS u32x2*)orow + lane;
#pragma unroll
    for (int j = 0; j < 4; ++j) { u32x2 w; w.x = pk2(hv[j].x, hv[j].y); w.y = pk2(hv[j].z, hv[j].w); o8[64 * j] = w; } }

__device__ __forceinline__ void ph_mod1(Frame& F, int l) {
    const int gw = F.vcu * NWAVES + F.wave, NGW = F.G * NWAVES;
    for (int row = gw; row < T; row += NGW) {
        const float* xr = l == 0 ? (row < CTX ? F.ctxin() + (size_t)row * D : F.x() + (size_t)(row - CTX) * D) : F.X() + (size_t)row * D;
        const float* m = F.MOD() + (size_t)(l * 2 + (row < CTX ? 1 : 0)) * 6144;
        f32x4 v[4], hv[4]; row_load(xr, F.lane, v); const float r = row_rstd(v, F.lane); row_modulate(v, r, F.norm1_g() + l * D, m + D, m, F.lane, hv); row_store_bf16(F.H() + (size_t)row * D, F.lane, hv);
    }
}

constexpr int RA_ST = 2064, RA_HALF = 16 * RA_ST, RA_BUF = 2 * RA_HALF;
constexpr int RLG_OFF = 2 * RA_BUF, RSCR_OFF = RLG_OFF + 8592;
static_assert(8 * 80 * 32 * 4 <= RLG_OFF && 65 * 33 * 4 <= 8592 && RSCR_OFF + 3520 <= MISC_OFF && RSCR_OFF % 16 == 0, "router LDS map");
__device__ __forceinline__ void split2(float a, float b, unsigned& hi, unsigned& lo) { hi = cvt_pk_bf16(a, b); lo = cvt_pk_bf16(a - bflo(hi), b - bfhi(hi)); }
__device__ __forceinline__ void ph_mod2_route(Frame& F, int l, int cbank) {
    LAS unsigned char* L = F.lds + RING_OFF; LAS float* LG = (LAS float*)(L + RLG_OFF);
    LAS int* lcnt = (LAS int*)(L + RSCR_OFF); LAS int* lbase = lcnt + 32; LAS int* te = lbase + 32; LAS float* tw = (LAS float*)(te + 272); LAS int* trk = (LAS int*)(tw + 272);
    int ln = F.lane; asm volatile("" : "+v"(ln)); const int w = F.wave, fr = ln & 15, g = ln >> 4;
    __syncthreads();
    if (F.tid < 32) lcnt[F.tid] = 0;
    const int row0 = F.bid * 65;
    const float* Xp = F.X(); const float* n2g = F.norm2_g() + l * D; const float* modl = F.MOD() + (size_t)(l * 2) * 6144; bf16_t* Hp = F.H(); unsigned char* H8p = F.ws + WS_H8;
    f32x4 v[2][4];
#pragma unroll
    for (int i = 0; i < 2; ++i) row_load(Xp + (size_t)(row0 + min(2 * w + i, 64)) * D, ln, v[i]);
    bf16x8 Bh[4][2], Bl[4][2];
    { const GAS float* rw = (const GAS float*)F.router_w() + (unsigned)(l * D * NE + (128 * w + 8 * g) * NE + fr);
#pragma unroll
      for (int s_ = 0; s_ < 4; ++s_)
#pragma unroll
          for (int nb = 0; nb < 2; ++nb) { float x[8];
#pragma unroll
              for (int i = 0; i < 8; ++i) x[i] = rw[(32 * s_ + i) * NE + 16 * nb];
              unsigned h_[4], l_[4]; split2(x[0], x[1], h_[0], l_[0]); split2(x[2], x[3], h_[1], l_[1]); split2(x[4], x[5], h_[2], l_[2]); split2(x[6], x[7], h_[3], l_[3]); const u32x4 hi = (u32x4){h_[0], h_[1], h_[2], h_[3]}, lo = (u32x4){l_[0], l_[1], l_[2], l_[3]};
              Bh[s_][nb] = __builtin_bit_cast(bf16x8, hi); Bl[s_][nb] = __builtin_bit_cast(bf16x8, lo); } }
    f32x4 acc[5][2];
#pragma unroll
    for (int b = 0; b < 5; ++b) { acc[b][0] = (f32x4){0.f, 0.f, 0.f, 0.f}; acc[b][1] = (f32x4){0.f, 0.f, 0.f, 0.f}; }
#pragma unroll
    for (int b = 0; b < 5; ++b) {
        LAS unsigned char* Ab = L + (b & 1) * RA_BUF;
#pragma unroll
        for (int i = 0; i < 2; ++i) { const int lr = 16 * b + 2 * w + i, row = row0 + min(lr, 64); const float* m = modl + (row < CTX ? 6144 : 0);
            const float rs = row_rstd(v[i], ln); f32x4 h[4]; row_modulate(v[i], rs, n2g, m + 4 * D, m + 3 * D, ln, h);
            if (lr < 65) { if (MOE_FP8) row_store_fp8(H8p + (size_t)row * D, ln, h); else row_store_bf16(Hp + (size_t)row * D, ln, h); }
#pragma unroll
            for (int j = 0; j < 4; ++j) { unsigned h0, l0, h1, l1; split2(h[j].x, h[j].y, h0, l0); split2(h[j].z, h[j].w, h1, l1); const u32x2 hi = (u32x2){h0, h1}, lo = (u32x2){l0, l1};
                LAS unsigned char* ap = Ab + (2 * w + i) * RA_ST + (4 * ln + 256 * j) * 2; *(LAS u32x2*)ap = hi; *(LAS u32x2*)(ap + RA_HALF) = lo; } }
        if (b < 4) {
#pragma unroll
            for (int i = 0; i < 2; ++i) row_load(Xp + (size_t)(row0 + min(16 * (b + 1) + 2 * w + i, 64)) * D, ln, v[i]); }
        __syncthreads();
#pragma unroll
        for (int s_ = 0; s_ < 4; ++s_) { const LAS unsigned char* ap = Ab + fr * RA_ST + (128 * w + 32 * s_ + 8 * g) * 2; const bf16x8 ah = *(const LAS bf16x8*)ap, al = *(const LAS bf16x8*)(ap + RA_HALF);
#pragma unroll
            for (int nb = 0; nb < 2; ++nb) { f32x4 c = acc[b][nb]; c = __builtin_amdgcn_mfma_f32_16x16x32_bf16(ah, Bh[s_][nb], c, 0, 0, 0); c = __builtin_amdgcn_mfma_f32_16x16x32_bf16(ah, Bl[s_][nb], c, 0, 0, 0);
                c = __builtin_amdgcn_mfma_f32_16x16x32_bf16(al, Bh[s_][nb], c, 0, 0, 0); acc[b][nb] = c; } }
    }
    __syncthreads();
    { LAS float* PT = (LAS float*)L;
#pragma unroll
      for (int b = 0; b < 5; ++b)
#pragma unroll
          for (int nb = 0; nb < 2; ++nb)
#pragma unroll
              for (int r = 0; r < 4; ++r) PT[(w * 80 + 16 * b + 4 * g + r) * 32 + 16 * nb + fr] = acc[b][nb][r];
      __syncthreads();
      for (int i = F.tid; i < 65 * 32; i += NTHR) { const int row = i >> 5, e = i & 31; float sacc = F.router_b()[l * NE + e];
#pragma unroll
          for (int w2 = 0; w2 < 8; ++w2) sacc += PT[(w2 * 80 + row) * 32 + e];
          LG[row * 33 + e] = sacc; } }
    __syncthreads();
    if (F.tid < 65) { const int row = F.tid; float bv[4] = {-3.0e38f, -3.0e38f, -3.0e38f, -3.0e38f}; int bi[4] = {0, 0, 0, 0};
#pragma unroll
        for (int e = 0; e < 32; ++e) { const float x = LG[row * 33 + e]; const bool c0 = x > bv[0], c1 = x > bv[1], c2 = x > bv[2], c3 = x > bv[3];
            bv[3] = c2 ? bv[2] : (c3 ? x : bv[3]); bi[3] = c2 ? bi[2] : (c3 ? e : bi[3]); bv[2] = c1 ? bv[1] : (c2 ? x : bv[2]); bi[2] = c1 ? bi[1] : (c2 ? e : bi[2]);
            bv[1] = c0 ? bv[0] : (c1 ? x : bv[1]); bi[1] = c0 ? bi[0] : (c1 ? e : bi[1]); bv[0] = c0 ? x : bv[0]; bi[0] = c0 ? e : bi[0]; }
        float ex[4], sum = 0.f;
#pragma unroll
        for (int q = 0; q < 4; ++q) { ex[q] = __expf(bv[q] - bv[0]); sum += ex[q]; }
        const float inv = 1.f / sum;
#pragma unroll
        for (int q = 0; q < 4; ++q) { te[row * 4 + q] = bi[q]; tw[row * 4 + q] = ex[q] * inv; trk[row * 4 + q] = (int)__hip_atomic_fetch_add((LAS unsigned*)&lcnt[bi[q]], 1u, __ATOMIC_RELAXED, __HIP_MEMORY_SCOPE_WORKGROUP); } }
    __syncthreads();
    if (F.tid < 32) lbase[F.tid] = (int)__hip_atomic_fetch_add((unsigned*)(F.ctl() + CW_CNT + (cbank * 32 + F.tid) * 64), (unsigned)lcnt[F.tid], RLX_AGENT);
    __syncthreads();
    for (int i = F.tid; i < 65 * 4; i += NTHR) { const int row = row0 + (i >> 2), e = te[i], pos = lbase[e] + trk[i];
        F.TOPI()[row * 4 + (i & 3)] = e; F.TOPW()[row * 4 + (i & 3)] = tw[i]; F.POS()[row * 4 + (i & 3)] = pos; F.LISTE()[(size_t)e * T + pos] = row; }
    __syncthreads();
}

__device__ __forceinline__ int moe_tiles(Frame& F, int l) {
    LAS int* tinfo = (LAS int*)(F.lds + TINFO_OFF); LAS int* bt = (LAS int*)(F.lds + BT_OFF); LAS int* cn = bt + 32; LAS int* ntl = bt + 64;
    __syncthreads();
    if (F.tid < 64) {
        const int e = F.lane & 31; const int c = (int)__hip_atomic_load(F.ctl() + CW_CNT + (l * 32 + e) * 64, RLX_AGENT); const int nt = (c + 255) >> 8;
        int incl = nt;
#pragma unroll
        for (int o = 1; o < 32; o <<= 1) { const int t = lane_get(incl, (F.lane - o) & 63); if (e >= o) incl += t; }
        const int first = incl - nt;
        if (F.lane < 32) { bt[e] = first; cn[e] = c; for (int j = 0; j < nt; ++j) { LAS int* ti = tinfo + 4 * (first + j); ti[0] = e; ti[1] = 0; ti[2] = 256 * j; ti[3] = min(256, c - 256 * j); } if (e == 31) ntl[0] = incl; }
    }
    __syncthreads();
    return ntl[0];
}

__device__ __forceinline__ void ph_gateup(Frame& F, int l) {
    const int ntiles = moe_tiles(F, l); constexpr int EB = MOE_FP8 ? 1 : 2;
    LAS int* tinfo = (LAS int*)(F.lds + TINFO_OFF); LAS unsigned* rowoff = (LAS unsigned*)(F.lds + ROWOFF_OFF);
    MoeOrder<true> S; S.tinfo = tinfo; S.rowoff = rowoff; S.ntiles = ntiles; S.nN = 8; S.G = F.G; S.c = F.vcu; S.Kb = D * EB; S.W = (const char*)F.Wt_gu() + (size_t)l * NE * 2048 * D * EB; S.wstride = (size_t)2048 * D * EB;
    for (int i = 0;; ++i) { pg8::Unit u; if (!S.next(i, u) || i >= 10) break;
        if (F.tid < 256) { const int pos0 = tinfo[4 * u.pm + 2], valid = tinfo[4 * u.pm + 3]; const int tok = F.tid < valid ? F.LISTE()[(size_t)u.e * T + pos0 + F.tid] : 0; rowoff[i * 256 + F.tid] = (unsigned)tok * (unsigned)(D * EB); } }
    __syncthreads();
    if constexpr (MOE_FP8) { EpiAct8 E{(unsigned char*)F.ACT(), F.b_gu() + (size_t)l * NE * 2048};
        pg8::gemm_phase<EpiAct8, MoeOrder<true>, true, true>(F.lds + RING_OFF, (const char*)(F.ws + WS_H8), D, S, E, F.tid); }
    else { EpiAct E{F.ACT(), F.b_gu() + (size_t)l * NE * 2048};
        pg8::gemm_phase<EpiAct, MoeOrder<true>, true, false>(F.lds + RING_OFF, (const char*)F.H(), 2 * D, S, E, F.tid); }
}
__device__ __forceinline__ void ph_down(Frame& F, int l) {
    const int ntiles = moe_tiles(F, l); constexpr int EB = MOE_FP8 ? 1 : 2;
    MoeOrder<false> S; S.tinfo = (LAS int*)(F.lds + TINFO_OFF); S.rowoff = nullptr; S.ntiles = ntiles; S.nN = 4; S.G = F.G; S.c = F.vcu; S.Kb = D * EB; S.W = (const char*)F.Wt_dn() + (size_t)l * NE * D * D * EB; S.wstride = (size_t)D * D * EB;
    if constexpr (MOE_FP8) { EpiY8 E{F.Y(), F.b_dn() + (size_t)l * NE * D};
        pg8::gemm_phase<EpiY8, MoeOrder<false>, true, true>(F.lds + RING_OFF, (const char*)F.ACT(), D, S, E, F.tid); }
    else { EpiY E{F.Y(), F.b_dn() + (size_t)l * NE * D};
        pg8::gemm_phase<EpiY, MoeOrder<false>, true, false>(F.lds + RING_OFF, (const char*)F.ACT(), 2 * D, S, E, F.tid); }
}
__device__ __forceinline__ void ph_win(Frame& F, int l) {
    DenseOrder S; S.init(T / 256, DINX / 256, F.G, F.bid, 2 * D, F.Wt_in() + (size_t)l * DINX * D);
    EpiP E{F.P(), DINX, F.LB() + l * 1024};
    pg8::gemm_phase<EpiP, DenseOrder, true>(F.lds + RING_OFF, (const char*)F.H(), 2 * D, S, E, F.tid);
    if (F.bid >= WIN_BUSY) cvt_deferred(F, l == 0 ? CVT_GU0 : CVT_GU1, F.bid - WIN_BUSY, DEF_WIN);
}
__device__ __forceinline__ void ph_wout(Frame& F, int l) {
    DenseOrder S; S.init(l == 1 ? LAT / 256 : T / 256, D / 256, F.G, F.bid, 2 * D, F.Wt_out() + (size_t)l * D * D, l == 1 ? 1 : 0);
    const float* m = F.MOD() + (size_t)(l * 2) * 6144;
    EpiRes E{l == 0 ? F.ctxin() : F.X(), l == 0 ? F.x() : F.X() + (size_t)CTX * D, m + 6144 + 2 * D, m + 2 * D, F.X()};
    pg8::gemm_phase<EpiRes, DenseOrder, true>(F.lds + RING_OFF, (const char*)F.CAT(), 2 * D, S, E, F.tid);
    if (l == 0 && F.bid >= 4) cvt_deferred(F, CVT_GU0 + DEF_A, F.bid - 4, DEF_WOUT);
}
__device__ __forceinline__ void combine_gather(const Frame& F, const LAS int* bt, int row, int ln, f32x4 (&v)[4], u32x2 (&y)[4][4], float (&w)[4]) {
    row_load(F.X() + (size_t)row * D, ln, v);
    const GAS int* ti = (const GAS int*)F.TOPI() + (unsigned)(row * 4); const GAS float* tw = (const GAS float*)F.TOPW() + (unsigned)(row * 4); const GAS int* tp = (const GAS int*)F.POS() + (unsigned)(row * 4);
#pragma unroll
    for (int q = 0; q < 4; ++q) { const int e = ti[q]; w[q] = tw[q]; const int srow = 256 * bt[e] + tp[q]; const GAS u32x2* yr = (const GAS u32x2*)((const GAS bf16_t*)F.Y() + (unsigned)srow * (unsigned)D) + ln;
#pragma unroll
        for (int j = 0; j < 4; ++j) y[q][j] = yr[64 * j]; }
}
__device__ __forceinline__ void combine_finish(const Frame& F, int l, int row, int ln, f32x4 (&v)[4], const u32x2 (&y)[4][4], const float (&w)[4]) {
    const float* m = F.MOD() + (size_t)(l * 2 + (row < CTX ? 1 : 0)) * 6144 + 5 * D;
#pragma unroll
    for (int j = 0; j < 4; ++j) { f32x4 s = (f32x4){0.f, 0.f, 0.f, 0.f};
#pragma unroll
        for (int q = 0; q < 4; ++q) s += w[q] * (f32x4){bflo(y[q][j].x), bfhi(y[q][j].x), bflo(y[q][j].y), bfhi(y[q][j].y)};
        v[j] += ((const GAS f32x4*)m)[ln + 64 * j] * s; }
    const float r = row_rstd(v, ln);
    if (l == 0) {
        GAS f32x4* xo = (GAS f32x4*)(F.X() + (size_t)row * D) + ln;
#pragma unroll
        for (int j = 0; j < 4; ++j) xo[64 * j] = v[j];
        const float* m1 = F.MOD() + (size_t)(2 + (row < CTX ? 1 : 0)) * 6144; f32x4 hv[4];
        row_modulate(v, r, F.norm1_g() + D, m1 + D, m1, ln, hv); row_store_bf16(F.H() + (size_t)row * D, ln, hv);
    } else {
        GAS f32x4* o = (GAS f32x4*)(F.out() + (size_t)(row - CTX) * D) + ln; const float* fg = F.fng();
#pragma unroll
        for (int j = 0; j < 4; ++j) o[64 * j] = v[j] * r * ((const GAS f32x4*)fg)[ln + 64 * j];
    }
}
__device__ __forceinline__ void ph_combine(Frame& F, int l) {
    (void)moe_tiles(F, l);
    const LAS int* bt = (const LAS int*)(F.lds + BT_OFF);
    const int gw = F.vcu * NWAVES + F.wave, NGW = F.G * NWAVES; const int rbeg = l == 1 ? CTX : 0;
#pragma unroll 1
    for (int ra = rbeg + gw; ra < T; ra += 2 * NGW) {
        int ln = F.lane; asm volatile("" : "+v"(ln));
        const int rb = ra + NGW; const bool hasb = rb < T; const int rbc = hasb ? rb : ra;
        f32x4 va[4], vb[4]; u32x2 ya[4][4], yb[4][4]; float wa[4], wb[4];
        combine_gather(F, bt, ra, ln, va, ya, wa); combine_gather(F, bt, rbc, ln, vb, yb, wb);
        combine_finish(F, l, ra, ln, va, ya, wa);
        if (hasb) combine_finish(F, l, rb, ln, vb, yb, wb);
    }
}
constexpr size_t WF_MA = 0, WF_MB = 128 * 1024, WF_MC = 256 * 1024, WF_PW = 512 * 1024;
constexpr int ZS = 528;
__device__ __forceinline__ f32x4 mfma16(bf16x8 a, bf16x8 b, f32x4 c) { return __builtin_amdgcn_mfma_f32_16x16x32_bf16(a, b, c, 0, 0, 0); }

__device__ __forceinline__ void ph_prologue2(Frame& F) {
    bf16_t* MA = (bf16_t*)(F.ws + WS_WF + WF_MA); bf16_t* MB = (bf16_t*)(F.ws + WS_WF + WF_MB); bf16_t* MC = (bf16_t*)(F.ws + WS_WF + WF_MC); bf16_t* PW = (bf16_t*)(F.ws + WS_WF + WF_PW);
    const int gt = F.bid * NTHR + F.tid, NT = F.G * NTHR;
    for (int i = gt; i < 256 * 256; i += NT) { const int r = i >> 8, cidx = i & 255, ri = r >> 7, k1 = r & 127, rj = cidx >> 7, t1 = cidx & 127; const float x = 2.f * (float)((k1 * t1) & 127) / 128.f;
        const float cs = cospif(x), sn = sinpif(x); const float v = ri == 0 ? (rj == 0 ? cs : -sn) : (rj == 0 ? -sn : -cs); MA[i] = (bf16_t)f2bf(v); }
    for (int i = gt; i < 128 * 256; i += NT) { const int k2 = i >> 8, cidx = i & 255, rj = cidx >> 7, t2 = cidx & 127; const float x = 2.f * (float)((k2 * t2) & 127) / 128.f; MB[i] = (bf16_t)f2bf(rj == 0 ? cospif(x) : sinpif(x)); }
    for (int i = gt; i < 256 * 512; i += NT) { const int k = i >> 9, cidx = i & 511, rj = cidx >> 8, t = cidx & 255; const float x = 2.f * (float)((k * t) & 255) / 256.f; MC[i] = (bf16_t)f2bf(rj == 0 ? cospif(x) : -sinpif(x)); }
    for (int i = gt; i < 2 * 4 * 64 * 64; i += NT) { const int lg = i >> 12, j = (i >> 6) & 63, ii = i & 63; PW[i] = (bf16_t)f2bf(F.pool_w()[(size_t)lg * 4096 + ii * 64 + j]); }
    LAS float* m12T = (LAS float*)(F.lds);
    LAS float* trig = (LAS float*)(F.lds + 33280);
    LAS float* fws = (LAS float*)(F.lds + 33280 + 512);
    __syncthreads();
    if (F.tid < 64) { trig[F.tid] = cospif(2.f * (float)F.tid / 64.f); trig[64 + F.tid] = sinpif(2.f * (float)F.tid / 64.f); }
    for (int tile = F.bid; tile < 2 * 256; tile += F.G) {
        const int l = tile >> 8, kb = (tile >> 4) & 15, nb = tile & 15, k0 = 64 * kb, n0 = 32 * nb, sel = n0 >> 8, nn0 = n0 & 255;
        const int mb = F.wave >> 1, nh = F.wave & 1, fr = F.lane & 15, g = F.lane >> 4;
        __syncthreads();
        f32x4 wa[8][2];
        { const GAS f32x4* wp = (const GAS f32x4*)((const GAS float*)F.w_in() + (unsigned)(l * D * DIN + (k0 + 16 * mb + fr) * DIN + 2816 + 8 * g));
#pragma unroll
          for (int s_ = 0; s_ < 8; ++s_) { wa[s_][0] = wp[8 * s_]; wa[s_][1] = wp[8 * s_ + 1]; } }
        for (int i = F.tid; i < 256 * 32; i += NTHR) fws[i] = F.four_w()[(size_t)l * 65536 + (size_t)(i >> 5) * 256 + nn0 + (i & 31)];
        __syncthreads();
        { const int cin = F.tid & 255, hf = F.tid >> 8, hh = cin >> 6, c = cin & 63; float acc[16];
#pragma unroll
          for (int q = 0; q < 16; ++q) acc[q] = 0.f;
#pragma unroll 4
          for (int m = 0; m < 64; ++m) { const float tv = trig[sel * 64 + ((m * c) & 63)]; const LAS float* fr_ = fws + (hh * 64 + m) * 32 + 16 * hf;
#pragma unroll
              for (int q = 0; q < 16; ++q) acc[q] += tv * fr_[q]; }
#pragma unroll
          for (int q = 0; q < 16; ++q) m12T[(16 * hf + q) * 260 + cin] = acc[q]; }
        __syncthreads();
        f32x4 o = (f32x4){0.f, 0.f, 0.f, 0.f};
#pragma unroll
        for (int s_ = 0; s_ < 8; ++s_) { const LAS float* bp = m12T + (16 * nh + fr) * 260 + 32 * s_ + 8 * g; const f32x4 b0 = *(const LAS f32x4*)bp, b1 = *(const LAS f32x4*)(bp + 4);
            unsigned ah[4], al[4], bh[4], bl[4];
            split2(wa[s_][0][0], wa[s_][0][1], ah[0], al[0]); split2(wa[s_][0][2], wa[s_][0][3], ah[1], al[1]); split2(wa[s_][1][0], wa[s_][1][1], ah[2], al[2]); split2(wa[s_][1][2], wa[s_][1][3], ah[3], al[3]);
            split2(b0[0], b0[1], bh[0], bl[0]); split2(b0[2], b0[3], bh[1], bl[1]); split2(b1[0], b1[1], bh[2], bl[2]); split2(b1[2], b1[3], bh[3], bl[3]);
            const bf16x8 AH = __builtin_bit_cast(bf16x8, (u32x4){ah[0], ah[1], ah[2], ah[3]}), AL = __builtin_bit_cast(bf16x8, (u32x4){al[0], al[1], al[2], al[3]});
            const bf16x8 BH = __builtin_bit_cast(bf16x8, (u32x4){bh[0], bh[1], bh[2], bh[3]}), BL = __builtin_bit_cast(bf16x8, (u32x4){bl[0], bl[1], bl[2], bl[3]});
            o = mfma16(AH, BH, o); o = mfma16(AH, BL, o); o = mfma16(AL, BH, o); }
        { float o0 = o[0], o1 = o[1], o2 = o[2], o3 = o[3]; asm volatile("s_nop 15\n\ts_nop 7" : "+v"(o0), "+v"(o1), "+v"(o2), "+v"(o3));
          u32x2 wv; wv.x = pk2(o0, o1); wv.y = pk2(o2, o3);
          *(u32x2*)(F.Wt_in() + (size_t)l * DINX * D + (size_t)(FQ_OFF + n0 + 16 * nh + fr) * D + k0 + 16 * mb + 4 * g) = wv; }
    }
    __syncthreads();
}

template <class SrcF> __device__ __forceinline__ void load_tile_T(LAS unsigned char* zt, const SrcF& src, int tid) {
    const int pg = tid >> 4, cc = tid & 15; u32x4 r[8];
#pragma unroll
    for (int i = 0; i < 8; ++i) r[i] = *(const GAS u32x4*)(src(8 * pg + i) + 8 * cc);
#pragma unroll
    for (int j = 0; j < 8; ++j) { const unsigned sel = (j & 1) ? 0x07060302u : 0x05040100u; u32x4 o;
        o.x = __builtin_amdgcn_perm(r[1][j >> 1], r[0][j >> 1], sel); o.y = __builtin_amdgcn_perm(r[3][j >> 1], r[2][j >> 1], sel);
        o.z = __builtin_amdgcn_perm(r[5][j >> 1], r[4][j >> 1], sel); o.w = __builtin_amdgcn_perm(r[7][j >> 1], r[6][j >> 1], sel);
        *(LAS u32x4*)(zt + (8 * cc + j) * ZS + 16 * pg) = o; }
}
__device__ __forceinline__ void tile_mma(const LAS unsigned char* zt, const bf16_t* mat_row  , f32x4 (&acc)[8], int lane) {
    const int fr = lane & 15, g = lane >> 4;
#pragma unroll
    for (int ks = 0; ks < 8; ++ks) { const bf16x8 b = *(const GAS bf16x8*)(mat_row + 32 * ks + 8 * g);
#pragma unroll
        for (int m = 0; m < 8; ++m) { const bf16x8 a = *(const LAS bf16x8*)(zt + (16 * m + fr) * ZS + (32 * ks + 8 * g) * 2); acc[m] = mfma16(a, b, acc[m]); }
        if (ks & 1) __builtin_amdgcn_sched_barrier(0); }
}
__device__ __forceinline__ void tile_mma2(const LAS unsigned char* zt, const bf16_t* mat_row0, const bf16_t* mat_row1, f32x4 (&acc0)[8], f32x4 (&acc1)[8], int lane) {
    const int fr = lane & 15, g = lane >> 4;
#pragma unroll
    for (int ks = 0; ks < 8; ++ks) { const bf16x8 b0 = *(const GAS bf16x8*)(mat_row0 + 32 * ks + 8 * g), b1 = *(const GAS bf16x8*)(mat_row1 + 32 * ks + 8 * g);
#pragma unroll
        for (int m = 0; m < 8; ++m) { const bf16x8 a = *(const LAS bf16x8*)(zt + (16 * m + fr) * ZS + (32 * ks + 8 * g) * 2); acc0[m] = mfma16(a, b0, acc0[m]); acc1[m] = mfma16(a, b1, acc1[m]); }
        __builtin_amdgcn_sched_barrier(0); }
}
struct SrcA { const bf16_t* P; int t2, hc; __device__ __forceinline__ const bf16_t* operator()(int p) const { const int ri = p >> 7, t1 = p & 127; return P + (size_t)(CTX + 128 * t1 + t2) * DINX + FQ_OFF + ri * 256 + 128 * hc; } };
struct SrcB { const bf16_t* Y; int k1, hc; __device__ __forceinline__ const bf16_t* operator()(int p) const { const int ri = p >> 7, t2 = p & 127; return Y + ((size_t)(k1 * 128 + t2) * 2 + ri) * 256 + 128 * hc; } };
struct SrcC { const bf16_t* P; int ri, hc; __device__ __forceinline__ const bf16_t* operator()(int p) const { return P + (size_t)p * DINX + FQ_OFF + ri * 256 + 128 * hc; } };

__device__ __forceinline__ void fftA_item(Frame& F, int item) {
    const int t2 = item >> 1, hc = item & 1; LAS unsigned char* zt = F.lds + RING_OFF;
    bf16_t* YP = (bf16_t*)(F.ws + WS_YP); const bf16_t* MA = (const bf16_t*)(F.ws + WS_WF + WF_MA);
    __syncthreads();
    load_tile_T(zt, SrcA{F.P(), t2, hc}, F.tid);
    __syncthreads();
    const int fr = F.lane & 15, g = F.lane >> 4, k1 = 16 * F.wave + fr;
    f32x4 ar[8], ai[8];
#pragma unroll
    for (int m = 0; m < 8; ++m) { ar[m] = (f32x4){0.f, 0.f, 0.f, 0.f}; ai[m] = (f32x4){0.f, 0.f, 0.f, 0.f}; }
    tile_mma2(zt, MA + (size_t)k1 * 256, MA + (size_t)(128 + k1) * 256, ar, ai, F.lane);
    const float x = 2.f * (float)(t2 * k1) / 16384.f; const float cs = cospif(x), sn = sinpif(x);
    bf16_t* yr = YP + ((size_t)(k1 * 128 + t2) * 2) * 256 + 128 * hc + 4 * g;
#pragma unroll
    for (int m = 0; m < 8; ++m) { const f32x4 a = ar[m], b = ai[m]; const f32x4 pr = a * cs + b * sn, pi = b * cs - a * sn;
        u32x2 w; w.x = pk2(pr[0], pr[1]); w.y = pk2(pr[2], pr[3]); *(u32x2*)(yr + 16 * m) = w;
        u32x2 v; v.x = pk2(pi[0], pi[1]); v.y = pk2(pi[2], pi[3]); *(u32x2*)(yr + 256 + 16 * m) = v; }
}
__device__ __forceinline__ void fftB_item(Frame& F, int item) {
    const int k1 = item >> 1, hc = item & 1; LAS unsigned char* zt = F.lds + RING_OFF;
    const bf16_t* YP = (const bf16_t*)(F.ws + WS_YP); const bf16_t* MB = (const bf16_t*)(F.ws + WS_WF + WF_MB);
    __syncthreads();
    load_tile_T(zt, SrcB{YP, k1, hc}, F.tid);
    __syncthreads();
    const int fr = F.lane & 15, g = F.lane >> 4, k2 = 16 * F.wave + fr;
    f32x4 acc[8];
#pragma unroll
    for (int m = 0; m < 8; ++m) acc[m] = (f32x4){0.f, 0.f, 0.f, 0.f};
    tile_mma(zt, MB + (size_t)k2 * 256, acc, F.lane);
    bf16_t* o = F.CAT() + (size_t)(CTX + k1 + 128 * k2) * D + 768 + 128 * hc + 4 * g;
#pragma unroll
    for (int m = 0; m < 8; ++m) { const f32x4 a = acc[m] * (1.f / 1024.f); u32x2 w; w.x = pk2(a[0], a[1]); w.y = pk2(a[2], a[3]); *(u32x2*)(o + 16 * m) = w; }
}
__device__ __forceinline__ void fftC_item(Frame& F, int item) {
    const int kh = item >> 1, hc = item & 1; LAS unsigned char* zt = F.lds + RING_OFF; const bf16_t* MC = (const bf16_t*)(F.ws + WS_WF + WF_MC);
    const int fr = F.lane & 15, g = F.lane >> 4, k = 128 * kh + 16 * F.wave + fr;
    f32x4 acc[8];
#pragma unroll
    for (int m = 0; m < 8; ++m) acc[m] = (f32x4){0.f, 0.f, 0.f, 0.f};
    for (int ri = 0; ri < 2; ++ri) {
        __syncthreads();
        load_tile_T(zt, SrcC{F.P(), ri, hc}, F.tid);
        __syncthreads();
        tile_mma(zt, MC + (size_t)k * 512 + ri * 256, acc, F.lane);
    }
    bf16_t* o = F.CAT() + (size_t)k * D + 768 + 128 * hc + 4 * g;
#pragma unroll
    for (int m = 0; m < 8; ++m) { const f32x4 a = acc[m] * (1.f / 128.f); u32x2 w; w.x = pk2(a[0], a[1]); w.y = pk2(a[2], a[3]); *(u32x2*)(o + 16 * m) = w; }
}

template <int GI> __device__ __forceinline__ void pool_sums(Frame& F, int j, LAS float* V, LAS unsigned* U, LAS unsigned char* At) {
    constexpr int win = 2 << GI, lo = win >> 1, hi = win - 1 - lo; const GAS bf16_t* Pc = (const GAS bf16_t*)F.P() + 2560 + GI * 64;
    if (j == 0) {
        for (int idx = F.tid; idx < 256 * 8; idx += NTHR) { const int t = idx >> 3, p8 = idx & 7; const int a = max(t - lo, 0), b = min(t + hi, CTX - 1); u32x4 w[win];
#pragma unroll
            for (int i = 0; i < win; ++i) { const int r = min(max(t - lo + i, 0), CTX - 1); w[i] = *(const GAS u32x4*)(Pc + (unsigned)(r * DINX + 8 * p8)); }
            f32x4 s0 = (f32x4){0.f, 0.f, 0.f, 0.f}, s1 = s0;
#pragma unroll
            for (int i = 0; i < win; ++i) { const int r = t - lo + i; const bool in = r >= 0 && r <= CTX - 1; const u32x4 x = w[i];
                const f32x4 e = (f32x4){bflo(x.x), bflo(x.y), bflo(x.z), bflo(x.w)}, o = (f32x4){bfhi(x.x), bfhi(x.y), bfhi(x.z), bfhi(x.w)}; if (in) { s0 += e; s1 += o; } }
            const u32x4 u = w[lo]; const float inv = 1.f / (float)(b - a + 1); u32x4 ov;
            ov.x = pk2(s0[0] * inv - bflo(u.x), s1[0] * inv - bfhi(u.x)); ov.y = pk2(s0[1] * inv - bflo(u.y), s1[1] * inv - bfhi(u.y));
            ov.z = pk2(s0[2] * inv - bflo(u.z), s1[2] * inv - bfhi(u.z)); ov.w = pk2(s0[3] * inv - bflo(u.w), s1[3] * inv - bfhi(u.w));
            *(LAS u32x4*)(At + t * 144 + 16 * p8) = ov; }
        return; }
    const int r0 = 4 * (j - 1); constexpr int NR = win + 3;
    { const int c = F.tid >> 3, p8 = F.tid & 7; u32x4 w[NR];
#pragma unroll
        for (int i = 0; i < NR; ++i) { const int r = min(max(r0 - lo + i, 0), LAT / GW - 1); w[i] = *(const GAS u32x4*)(Pc + (unsigned)((CTX + r * GW + c) * DINX + 8 * p8)); }
        f32x4 s0[4], s1[4];
#pragma unroll
        for (int q = 0; q < 4; ++q) { s0[q] = (f32x4){0.f, 0.f, 0.f, 0.f}; s1[q] = (f32x4){0.f, 0.f, 0.f, 0.f}; }
#pragma unroll
        for (int i = 0; i < NR; ++i) { const int r = r0 - lo + i; const bool ok = r >= 0 && r <= LAT / GW - 1; const u32x4 x = w[i];
            f32x4 e = (f32x4){bflo(x.x), bflo(x.y), bflo(x.z), bflo(x.w)}, o = (f32x4){bfhi(x.x), bfhi(x.y), bfhi(x.z), bfhi(x.w)}; if (!ok) { e = (f32x4){0.f, 0.f, 0.f, 0.f}; o = e; }
#pragma unroll
            for (int q = 0; q < 4; ++q) if (i >= q && i <= q + win - 1) { s0[q] += e; s1[q] += o; } }
#pragma unroll
        for (int q = 0; q < 4; ++q) { LAS float* vp = V + (q * 64 + c) * 64 + 8 * p8;
            *(LAS f32x4*)vp = (f32x4){s0[q][0], s1[q][0], s0[q][1], s1[q][1]}; *(LAS f32x4*)(vp + 4) = (f32x4){s0[q][2], s1[q][2], s0[q][3], s1[q][3]};
            *(LAS u32x4*)(U + (q * 64 + c) * 32 + 4 * p8) = w[lo + q]; } }
    __syncthreads();
    for (int idx = F.tid; idx < 4 * 8 * 64; idx += NTHR) { const int ch = idx & 63, cb = (idx >> 6) & 7, i = idx >> 9; const int r = r0 + i;
        const float cr = (float)(min(r + hi, LAT / GW - 1) - max(r - lo, 0) + 1); const LAS float* Vr = V + (i * 64) * 64 + ch;
        const int c0 = 8 * cb; float s = 0.f;
#pragma unroll
        for (int q = 0; q < win; ++q) { const int c = c0 - lo + q; s += (c >= 0 && c <= GW - 1) ? Vr[min(max(c, 0), GW - 1) * 64] : 0.f; }
#pragma unroll
        for (int q = 0; q < 8; ++q) { const int c = c0 + q; if (q > 0) { if (c + hi <= GW - 1) s += Vr[(c + hi) * 64]; if (c - 1 - lo >= 0) s -= Vr[(c - 1 - lo) * 64]; }
            const float cc = (float)(min(c + hi, GW - 1) - max(c - lo, 0) + 1); const unsigned uw = U[(i * 64 + c) * 32 + (ch >> 1)]; const float u = (ch & 1) ? bfhi(uw) : bflo(uw);
            *(LAS unsigned short*)(At + (i * 64 + c) * 144 + 2 * ch) = (unsigned short)f2bf(s / (cr * cc) - u); } }
}
__device__ __forceinline__ void pool_item(Frame& F, int l, int item) {
    const int j = item >> 2, gi = item & 3;
    LAS float* V = (LAS float*)(F.lds);
    LAS unsigned* U = (LAS unsigned*)(F.lds + 65536);
    LAS unsigned char* At = F.lds + 65536 + 32768;
    __syncthreads();
    if (gi == 0) pool_sums<0>(F, j, V, U, At); else if (gi == 1) pool_sums<1>(F, j, V, U, At); else if (gi == 2) pool_sums<2>(F, j, V, U, At); else pool_sums<3>(F, j, V, U, At);
    __syncthreads();
    const bf16_t* PW = (const bf16_t*)(F.ws + WS_WF + WF_PW) + (size_t)(l * 4 + gi) * 4096; const int fr = F.lane & 15, g = F.lane >> 4;
    f32x4 acc[4][2];
#pragma unroll
    for (int n = 0; n < 4; ++n) { acc[n][0] = (f32x4){0.f, 0.f, 0.f, 0.f}; acc[n][1] = (f32x4){0.f, 0.f, 0.f, 0.f}; }
#pragma unroll
    for (int ks = 0; ks < 2; ++ks) { bf16x8 b[2];
#pragma unroll
        for (int mt = 0; mt < 2; ++mt) b[mt] = *(const LAS bf16x8*)(At + (32 * F.wave + 16 * mt + fr) * 144 + (32 * ks + 8 * g) * 2);
#pragma unroll
        for (int n = 0; n < 4; ++n) { const bf16x8 a = *(const GAS bf16x8*)(PW + (16 * n + fr) * 64 + 32 * ks + 8 * g);
#pragma unroll
            for (int mt = 0; mt < 2; ++mt) acc[n][mt] = mfma16(a, b[mt], acc[n][mt]); } }
    const int rowbase = j == 0 ? 0 : CTX + 256 * (j - 1);
#pragma unroll
    for (int n = 0; n < 4; ++n) { const f32x4 sc = *(const GAS f32x4*)(F.pool_s() + l * 256 + gi * 64 + 16 * n + 4 * g);
#pragma unroll
        for (int mt = 0; mt < 2; ++mt) { const f32x4 a = acc[n][mt] * sc; u32x2 w; w.x = pk2(a[0], a[1]); w.y = pk2(a[2], a[3]);
            *(u32x2*)(F.CAT() + (size_t)(rowbase + 32 * F.wave + 16 * mt + fr) * D + 512 + gi * 64 + 16 * n + 4 * g) = w; } }
}

constexpr int SC_FT = 0, SC_QT = 18432, SC_VT = 36864, SC_BQ = 55296, SC_BF = 72704, SC_KT = 90112, SC_PM = 108544, SC_G = 117760, SC_TOT = 135168, SC_DEC = 137216, SC_SSQ = 138752, SC_END = 140800;
static_assert(SC_END <= MISC_OFF, "scan LDS map");
template <int DIR, bool FULL> __device__ __forceinline__ void scan_fetch(const Frame& F, int h, int row0, u32x4 (&r)[8]) {
    const GAS bf16_t* P = (const GAS bf16_t*)F.P(); const int tid = F.tid;
    if (tid < 384) { const int tile = tid >> 7, blk = tid & 127, tg = blk >> 4, kc = blk & 15; if (!FULL && tile == 1) return;
        const int colb = tile == 0 ? 512 * (1 + DIR) : (tile == 1 ? 0 : 1536); const GAS bf16_t* src = P + (unsigned)((row0 + 8 * tg) * DINX + colb + h * 128 + 8 * kc);
#pragma unroll
        for (int i = 0; i < 8; ++i) r[i] = *(const GAS u32x4*)(src + (unsigned)(i * DINX)); }
    else if (FULL && DIR == 1) { const int q = tid - 384; const GAS bf16_t* src = P + (unsigned)((row0 + (q >> 4)) * DINX + 2048 + h * 128 + 8 * (q & 15));
#pragma unroll
        for (int i = 0; i < 8; ++i) r[i] = *(const GAS u32x4*)(src + (unsigned)(i * 8 * DINX)); }
}
template <int DIR, bool FULL> __device__ __forceinline__ void scan_commit(const Frame& F, const u32x4 (&r)[8]) {
    LAS unsigned char* L = F.lds + RING_OFF; const int tid = F.tid;
    if (tid < 384) { const int tile = tid >> 7, blk = tid & 127, tg = blk >> 4, kc = blk & 15; if (!FULL && tile == 1) return;
#pragma unroll
        for (int j = 0; j < 8; ++j) { const unsigned sel = (j & 1) ? 0x07060302u : 0x05040100u; u32x4 o;
            o.x = __builtin_amdgcn_perm(r[1][j >> 1], r[0][j >> 1], sel); o.y = __builtin_amdgcn_perm(r[3][j >> 1], r[2][j >> 1], sel);
            o.z = __builtin_amdgcn_perm(r[5][j >> 1], r[4][j >> 1], sel); o.w = __builtin_amdgcn_perm(r[7][j >> 1], r[6][j >> 1], sel);
            *(LAS u32x4*)(L + tile * 18432 + (8 * kc + j) * 144 + 16 * tg) = o; } }
    else if (FULL && DIR == 1) { const int q = tid - 384; LAS unsigned char* dst = L + SC_G + (q >> 4) * 272 + 16 * (q & 15);
#pragma unroll
        for (int i = 0; i < 8; ++i) *(LAS u32x4*)(dst + i * 8 * 272) = r[i]; }
}
template <int DIR, bool FULL> __device__ __forceinline__ void scan_chunk(Frame& F, int l, int h, int nrow0, u32x4 (&pre)[8], f32x4 (&S)[8], f32x4 (&o)[4], float& segsum, const GAS float* oload = nullptr, GAS float* ostore = nullptr) {
    LAS unsigned char* L = F.lds + RING_OFF; int lane = F.lane; asm volatile("" : "+v"(lane));
    const int w = F.wave, tid = w * 64 + lane, fr = lane & 15, g = lane >> 4;
    LAS float* TOT = (LAS float*)(L + SC_TOT); LAS float* DEC = (LAS float*)(L + SC_DEC); LAS float* C1 = DEC + 128; LAS float* C2 = DEC + 256;
    __syncthreads();
    scan_commit<DIR, FULL>(F, pre);
    __syncthreads();
    const int k = tid & 127, qu = tid >> 7;
    float bl[16]; float run = 0.f;
    { const u32x4 fa = *(const LAS u32x4*)(L + SC_FT + k * 144 + 32 * qu), fb = *(const LAS u32x4*)(L + SC_FT + k * 144 + 32 * qu + 16); const unsigned fw[8] = {fa.x, fa.y, fa.z, fa.w, fb.x, fb.y, fb.z, fb.w};
#pragma unroll
      for (int i = 0; i < 16; ++i) { const int ti = (DIR == 0 ? i : 15 - i); run += (ti & 1) ? f16hi(fw[ti >> 1]) : f16lo(fw[ti >> 1]); bl[i] = run; } }
    TOT[qu * 128 + k] = run;
    __syncthreads();
    const float t0 = TOT[k], t1 = TOT[128 + k], t2 = TOT[256 + k], t3 = TOT[384 + k]; const float total = (t0 + t1) + (t2 + t3);
    float off, ref;
    if (DIR == 0) { off = qu == 0 ? 0.f : (qu == 1 ? t0 : (qu == 2 ? t0 + t1 : t0 + t1 + t2)); ref = t0 + t1; }
    else { off = qu == 3 ? 0.f : (qu == 2 ? t3 : (qu == 1 ? t3 + t2 : t3 + t2 + t1)); ref = t3 + t2; }
    if (qu == 0) { DEC[k] = __builtin_amdgcn_exp2f(total); C1[k] = __builtin_amdgcn_exp2f(ref); C2[k] = __builtin_amdgcn_exp2f(total - ref); segsum += total; }
    { unsigned qw[8];
      if (FULL) { const u32x4 qa = *(const LAS u32x4*)(L + SC_QT + k * 144 + 32 * qu), qb = *(const LAS u32x4*)(L + SC_QT + k * 144 + 32 * qu + 16); qw[0] = qa.x; qw[1] = qa.y; qw[2] = qa.z; qw[3] = qa.w; qw[4] = qb.x; qw[5] = qb.y; qw[6] = qb.z; qw[7] = qb.w; }
      float ktv[16]; const float sh = off - ref;
#pragma unroll
      for (int i = 0; i < 16; ++i) { const int ti = (DIR == 0 ? i : 15 - i), t = 16 * qu + ti; const float lf = i == 0 ? bl[0] : bl[i] - bl[i - 1]; const float b = bl[i] + sh;
          const float E = __builtin_amdgcn_exp2f(b), Ei = __builtin_amdgcn_rcpf(E), kk = 1.f - __builtin_amdgcn_exp2f(lf); ktv[ti] = kk * Ei;
          if (FULL) { const float qs = (ti & 1) ? bfhi(qw[ti >> 1]) : bflo(qw[ti >> 1]); *(LAS unsigned short*)(L + SC_BQ + t * 272 + 2 * k) = (unsigned short)(cvt_pk_bf16(qs * E, 0.f)); } }
      u32x4 a, b2; a.x = cvt_pk_bf16(ktv[0], ktv[1]); a.y = cvt_pk_bf16(ktv[2], ktv[3]); a.z = cvt_pk_bf16(ktv[4], ktv[5]); a.w = cvt_pk_bf16(ktv[6], ktv[7]);
      b2.x = cvt_pk_bf16(ktv[8], ktv[9]); b2.y = cvt_pk_bf16(ktv[10], ktv[11]); b2.z = cvt_pk_bf16(ktv[12], ktv[13]); b2.w = cvt_pk_bf16(ktv[14], ktv[15]);
      *(LAS u32x4*)(L + SC_KT + k * 144 + 32 * qu) = a; *(LAS u32x4*)(L + SC_KT + k * 144 + 32 * qu + 16) = b2;
      if (FULL) { const unsigned kw[8] = {a.x, a.y, a.z, a.w, b2.x, b2.y, b2.z, b2.w};
#pragma unroll
          for (int ti = 0; ti < 16; ++ti) *(LAS unsigned short*)(L + SC_BF + (16 * qu + ti) * 272 + 2 * k) = (unsigned short)((ti & 1) ? (kw[ti >> 1] >> 16) : (kw[ti >> 1] & 0xffffu)); } }
    __syncthreads();
    if (nrow0 >= 0) scan_fetch<DIR, FULL>(F, h, nrow0, pre);
    if (FULL) {
#pragma unroll
        for (int tb = 0; tb < 4; ++tb)
#pragma unroll
            for (int r = 0; r < 4; ++r) o[tb][r] = oload ? oload[(tb * 4 + r) * 512] : 0.f; }
    __builtin_amdgcn_sched_barrier(0);
    if (FULL) {
        const int tb = w >> 1;
#pragma unroll
        for (int q = 0; q < 2; ++q) { const int sb = 2 * (w & 1) + q; f32x4 acc = (f32x4){0.f, 0.f, 0.f, 0.f};
#pragma unroll
            for (int ks = 0; ks < 4; ++ks) { const bf16x8 a = *(const LAS bf16x8*)(L + SC_BF + (16 * sb + fr) * 272 + (32 * ks + 8 * g) * 2); const bf16x8 b = *(const LAS bf16x8*)(L + SC_BQ + (16 * tb + fr) * 272 + (32 * ks + 8 * g) * 2);
                acc = mfma16(a, b, acc); }
            const int t = 16 * tb + fr; float m[4];
#pragma unroll
            for (int r = 0; r < 4; ++r) { const int s = 16 * sb + 4 * g + r; const bool keep = DIR == 0 ? (s <= t) : (s >= t); m[r] = keep ? acc[r] : 0.f; }
            u32x2 wv; wv.x = pk2(m[0], m[1]); wv.y = pk2(m[2], m[3]); *(LAS u32x2*)(L + SC_PM + t * 144 + (16 * sb + 4 * g) * 2) = wv; }
        __syncthreads();
    }
    bf16x8 vt[2];
#pragma unroll
    for (int ks = 0; ks < 2; ++ks) vt[ks] = *(const LAS bf16x8*)(L + SC_VT + (16 * w + fr) * 144 + (32 * ks + 8 * g) * 2);
    if (FULL) {
        bf16x8 sf[4];
#pragma unroll
        for (int ks = 0; ks < 4; ++ks) { const f32x4 ca = *(const LAS f32x4*)(C1 + 32 * ks + 4 * g), cb = *(const LAS f32x4*)(C1 + 32 * ks + 16 + 4 * g); const f32x4 x = S[2 * ks] * ca, y = S[2 * ks + 1] * cb;
            u32x4 pkd; pkd.x = pk2(x[0], x[1]); pkd.y = pk2(x[2], x[3]); pkd.z = pk2(y[0], y[1]); pkd.w = pk2(y[2], y[3]); sf[ks] = __builtin_bit_cast(bf16x8, pkd); }
#pragma unroll
        for (int tb = 0; tb < 4; ++tb) { f32x4 acc = o[tb];
#pragma unroll
            for (int ks = 0; ks < 4; ++ks) { const u32x2 a0 = *(const LAS u32x2*)(L + SC_BQ + (16 * tb + fr) * 272 + (32 * ks + 4 * g) * 2), a1 = *(const LAS u32x2*)(L + SC_BQ + (16 * tb + fr) * 272 + (32 * ks + 16 + 4 * g) * 2);
                u32x4 pa; pa.x = a0.x; pa.y = a0.y; pa.z = a1.x; pa.w = a1.y; acc = mfma16(__builtin_bit_cast(bf16x8, pa), sf[ks], acc); }
#pragma unroll
            for (int ks = 0; ks < 2; ++ks) { const bf16x8 a = *(const LAS bf16x8*)(L + SC_PM + (16 * tb + fr) * 144 + (32 * ks + 8 * g) * 2); acc = mfma16(a, vt[ks], acc); }
            o[tb] = acc; __builtin_amdgcn_sched_barrier(0); }
        if (ostore) {
#pragma unroll
            for (int tb = 0; tb < 4; ++tb)
#pragma unroll
                for (int r = 0; r < 4; ++r) ostore[(tb * 4 + r) * 512] = o[tb][r]; }
    }
#pragma unroll
    for (int kb = 0; kb < 8; ++kb) { f32x4 tmp = (f32x4){0.f, 0.f, 0.f, 0.f};
#pragma unroll
        for (int ks = 0; ks < 2; ++ks) { const bf16x8 a = *(const LAS bf16x8*)(L + SC_KT + (16 * kb + fr) * 144 + (32 * ks + 8 * g) * 2); tmp = mfma16(a, vt[ks], tmp); }
        const f32x4 dc = *(const LAS f32x4*)(DEC + 16 * kb + 4 * g), c2 = *(const LAS f32x4*)(C2 + 16 * kb + 4 * g); S[kb] = dc * S[kb] + c2 * tmp; if (kb & 1) __builtin_amdgcn_sched_barrier(0); }
}
__device__ __forceinline__ void state_store(float* dst, const f32x4 (&S)[8], int w, int lane) {
    GAS float* p = (GAS float*)dst + (unsigned)(w * 2048 + lane);
#pragma unroll
    for (int kb = 0; kb < 8; ++kb)
#pragma unroll
        for (int r = 0; r < 4; ++r) p[(kb * 4 + r) * 64] = S[kb][r]; }
__device__ __forceinline__ void state_load(const float* src, f32x4 (&S)[8], int w, int lane) {
    const GAS float* p = (const GAS float*)src + (unsigned)(w * 2048 + lane);
#pragma unroll
    for (int kb = 0; kb < 8; ++kb)
#pragma unroll
        for (int r = 0; r < 4; ++r) S[kb][r] = p[(kb * 4 + r) * 64]; }
__device__ __forceinline__ float* sc_SU(Frame& F) { return (float*)(F.ws + WS_SU); }
__device__ __forceinline__ float* sc_SS(Frame& F) { return (float*)(F.ws + WS_SS); }
__device__ __forceinline__ float* sc_SD(Frame& F) { return (float*)(F.ws + WS_SD); }
__device__ __forceinline__ float* sc_CARRY(Frame& F) { return (float*)(F.ws + WS_SD) + 8 * 64 * 128; }

__device__ __forceinline__ float* sc_OSCR(Frame& F) { return (float*)(F.ws + WS_OSCR) + (size_t)F.bid * 32768; }
template <int DIR> __device__ __forceinline__ void scan_states(Frame& F, int l, int h, int segrow, float* sout, float* dout) {
    f32x4 S[8], odummy[4]; float segsum = 0.f; u32x4 pre[8];
#pragma unroll
    for (int kb = 0; kb < 8; ++kb) S[kb] = (f32x4){0.f, 0.f, 0.f, 0.f};
    scan_fetch<DIR, false>(F, h, segrow + (DIR == 0 ? 0 : 192), pre);
#pragma unroll 1
    for (int i_ = 0; i_ < 4; ++i_) { int i = i_; asm volatile("" : "+s"(i)); const int c = DIR == 0 ? i : 3 - i;
        scan_chunk<DIR, false>(F, l, h, i < 3 ? segrow + 64 * (DIR == 0 ? c + 1 : c - 1) : -1, pre, S, odummy, segsum); }
    state_store(sout, S, F.wave, F.lane);
    if (dout && F.tid < 128) dout[F.tid] = __builtin_amdgcn_exp2f(segsum);
}
__device__ __forceinline__ void scanA_item(Frame& F, int l, int item) {
    const int h = item >> 6, seg = item & 63, segrow = CTX + 256 * seg;
    scan_states<0>(F, l, h, segrow, sc_SU(F) + ((size_t)(h * 2 + 0) * 64 + seg) * 16384, sc_SD(F) + ((h * 2 + 0) * 64 + seg) * 128);
    scan_states<1>(F, l, h, segrow, sc_SU(F) + ((size_t)(h * 2 + 1) * 64 + seg) * 16384, sc_SD(F) + ((h * 2 + 1) * 64 + seg) * 128);
}
__device__ __forceinline__ void scan_full(Frame& F, int l, int h, int segrow, const float* sinf, const float* sinb, float* outf, float* outb) {
    f32x4 S[8], o[4]; float segsum = 0.f; const int w = F.wave, lane = F.lane, fr = lane & 15, g = lane >> 4; u32x4 pre[8];
    GAS float* oscr = (GAS float*)sc_OSCR(F) + (unsigned)F.tid;
    if (sinf) state_load(sinf, S, w, lane); else {
#pragma unroll
        for (int kb = 0; kb < 8; ++kb) S[kb] = (f32x4){0.f, 0.f, 0.f, 0.f}; }
    scan_fetch<0, true>(F, h, segrow, pre);
#pragma unroll 1
    for (int c_ = 0; c_ < 4; ++c_) { int c = c_; asm volatile("" : "+s"(c));
        scan_chunk<0, true>(F, l, h, c < 3 ? segrow + 64 * (c + 1) : -1, pre, S, o, segsum);
#pragma unroll
        for (int tb = 0; tb < 4; ++tb)
#pragma unroll
            for (int r = 0; r < 4; ++r) (oscr + c * 8192)[(tb * 4 + r) * 512] = o[tb][r];
    }
    if (outf) state_store(outf, S, w, lane);
    VM_WAIT();
    if (sinb) state_load(sinb, S, w, lane); else {
#pragma unroll
        for (int kb = 0; kb < 8; ++kb) S[kb] = (f32x4){0.f, 0.f, 0.f, 0.f}; }
    LAS unsigned char* L = F.lds + RING_OFF; LAS float* SSQ = (LAS float*)(L + SC_SSQ);
    const float ngv = F.hng()[l * 512 + h * 128 + 16 * w + fr];
    scan_fetch<1, true>(F, h, segrow + 192, pre);
#pragma unroll 1
    for (int c_ = 3; c_ >= 0; --c_) { int c = c_; asm volatile("" : "+s"(c));
        scan_chunk<1, true>(F, l, h, c > 0 ? segrow + 64 * (c - 1) : -1, pre, S, o, segsum, oscr + c * 8192);
#pragma unroll
        for (int tb = 0; tb < 4; ++tb) { f32x4 q = o[tb] * o[tb];
#pragma unroll
            for (int m = 1; m < 16; m <<= 1) { q[0] += lane_xor(q[0], m, lane); q[1] += lane_xor(q[1], m, lane); q[2] += lane_xor(q[2], m, lane); q[3] += lane_xor(q[3], m, lane); }
            if (fr == 0) {
#pragma unroll
                for (int r = 0; r < 4; ++r) SSQ[(16 * tb + 4 * g + r) * 8 + w] = q[r]; } }
        __syncthreads();
#pragma unroll
        for (int tb = 0; tb < 4; ++tb)
#pragma unroll
            for (int r = 0; r < 4; ++r) { const int t = 16 * tb + 4 * g + r; const f32x4 p0 = *(const LAS f32x4*)(SSQ + t * 8), p1 = *(const LAS f32x4*)(SSQ + t * 8 + 4);
                const float ss = ((p0[0] + p0[1]) + (p0[2] + p0[3])) + ((p1[0] + p1[1]) + (p1[2] + p1[3])); const float rs = rsqrtf(ss * (1.f / 128.f) + 1e-6f);
                const float gp = bf2f(*(const LAS unsigned short*)(L + SC_G + t * 272 + 2 * (16 * w + fr)));
                *(LAS unsigned short*)(L + SC_BQ + t * 272 + 2 * (16 * w + fr)) = (unsigned short)f2bf(o[tb][r] * rs * ngv * gp); }
        __syncthreads();
#pragma unroll
        for (int i = 0; i < 2; ++i) { const int id = F.tid + 512 * i, row = id >> 4, cc = id & 15; const u32x4 d = *(const LAS u32x4*)(L + SC_BQ + row * 272 + 16 * cc);
            *(GAS u32x4*)((GAS bf16_t*)F.CAT() + (unsigned)((segrow + 64 * c + row) * D + h * 128 + 8 * cc)) = d; }
    }
    if (outb) state_store(outb, S, w, lane);
}
__device__ __forceinline__ GAS float* sc_CTXO(const Frame& F, int hd, int c) { return (GAS float*)(F.ws + WS_CTXO) + (unsigned)((hd * 4 + c) * 8192); }
template <int DIR> __device__ __forceinline__ void scan_dir_local(Frame& F, int l, int h, int segrow, float* sout) {
    f32x4 S[8], o[4]; float segsum = 0.f; u32x4 pre[8]; const int hd = h * 2 + DIR;
#pragma unroll
    for (int kb = 0; kb < 8; ++kb) S[kb] = (f32x4){0.f, 0.f, 0.f, 0.f};
    scan_fetch<DIR, true>(F, h, segrow + (DIR == 0 ? 0 : 192), pre);
#pragma unroll 1
    for (int i_ = 0; i_ < 4; ++i_) { int i = i_; asm volatile("" : "+s"(i)); const int c = DIR == 0 ? i : 3 - i;
        scan_chunk<DIR, true>(F, l, h, i < 3 ? segrow + 64 * (DIR == 0 ? c + 1 : c - 1) : -1, pre, S, o, segsum, nullptr, sc_CTXO(F, hd, c) + (unsigned)F.tid); }
    state_store(sout, S, F.wave, F.lane);
}
__device__ __forceinline__ void ctx_finalize(Frame& F, int l, int h) {
    LAS unsigned char* L = F.lds + RING_OFF; LAS float* SSQ = (LAS float*)(L + SC_SSQ);
    const float ngv = F.hng()[l * 512 + h * 128 + 16 * F.wave + (F.lane & 15)];
#pragma unroll 1
    for (int c_ = 0; c_ < 4; ++c_) { int c = c_; asm volatile("" : "+s"(c)); int lane = F.lane; asm volatile("" : "+v"(lane));
        const int w = F.wave, tid = w * 64 + lane, fr = lane & 15, g = lane >> 4, row0 = 64 * c;
        __syncthreads();
        { const GAS bf16_t* gp = (const GAS bf16_t*)F.P() + (unsigned)((row0 + (tid >> 4)) * DINX + 2048 + h * 128 + 8 * (tid & 15)); const int o = (tid >> 4) * 272 + 16 * (tid & 15);
          *(LAS u32x4*)(L + SC_G + o) = *(const GAS u32x4*)gp; *(LAS u32x4*)(L + SC_G + o + 32 * 272) = *(const GAS u32x4*)(gp + (unsigned)(32 * DINX)); }
        f32x4 o[4];
        { const GAS float* of = sc_CTXO(F, h * 2 + 0, c) + (unsigned)tid; const GAS float* ob = sc_CTXO(F, h * 2 + 1, c) + (unsigned)tid;
#pragma unroll
          for (int tb = 0; tb < 4; ++tb)
#pragma unroll
              for (int r = 0; r < 4; ++r) o[tb][r] = of[(tb * 4 + r) * 512] + ob[(tb * 4 + r) * 512]; }
#pragma unroll
        for (int tb = 0; tb < 4; ++tb) { f32x4 q = o[tb] * o[tb];
#pragma unroll
            for (int m = 1; m < 16; m <<= 1) { q[0] += lane_xor(q[0], m, lane); q[1] += lane_xor(q[1], m, lane); q[2] += lane_xor(q[2], m, lane); q[3] += lane_xor(q[3], m, lane); }
            if (fr == 0) {
#pragma unroll
                for (int r = 0; r < 4; ++r) SSQ[(16 * tb + 4 * g + r) * 8 + w] = q[r]; } }
        __syncthreads();
#pragma unroll
        for (int tb = 0; tb < 4; ++tb)
#pragma unroll
            for (int r = 0; r < 4; ++r) { const int t = 16 * tb + 4 * g + r; const f32x4 p0 = *(const LAS f32x4*)(SSQ + t * 8), p1 = *(const LAS f32x4*)(SSQ + t * 8 + 4);
                const float ss = ((p0[0] + p0[1]) + (p0[2] + p0[3])) + ((p1[0] + p1[1]) + (p1[2] + p1[3])); const float rs = rsqrtf(ss * (1.f / 128.f) + 1e-6f);
                const float gp = bf2f(*(const LAS unsigned short*)(L + SC_G + t * 272 + 2 * (16 * w + fr)));
                *(LAS unsigned short*)(L + SC_BQ + t * 272 + 2 * (16 * w + fr)) = (unsigned short)f2bf(o[tb][r] * rs * ngv * gp); }
        __syncthreads();
#pragma unroll
        for (int i = 0; i < 2; ++i) { const int id = tid + 512 * i, row = id >> 4, cc = id & 15; const u32x4 d = *(const LAS u32x4*)(L + SC_BQ + row * 272 + 16 * cc);
            *(GAS u32x4*)((GAS bf16_t*)F.CAT() + (unsigned)((row0 + row) * D + h * 128 + 8 * cc)) = d; }
    }
    __syncthreads();
}
__device__ __forceinline__ void scanB(Frame& F) {
    const int e = F.bid * NTHR + F.tid; if (e >= 8 * 16384) return;
    const int hd = e >> 14, idx = e & 16383, d = hd & 1; const int ln = idx & 63, reg = (idx >> 6) & 3, kb = (idx >> 8) & 7; const int k = 16 * kb + 4 * (ln >> 4) + reg;
    const float* SU = sc_SU(F) + (size_t)hd * 64 * 16384 + idx; const float* SD = sc_SD(F) + hd * 64 * 128 + k; float* SS = sc_SS(F) + (size_t)hd * 64 * 16384 + idx;
    float S = sc_CARRY(F)[hd * 16384 + idx];
    if (d == 0) { for (int seg = 0; seg < 64; ++seg) { SS[(size_t)seg * 16384] = S; S = SD[seg * 128] * S + SU[(size_t)seg * 16384]; } }
    else { for (int seg = 63; seg >= 0; --seg) { SS[(size_t)seg * 16384] = S; S = SD[seg * 128] * S + SU[(size_t)seg * 16384]; } }
}

__device__ __forceinline__ void ph_mixA(Frame& F, int l) {
    scanA_item(F, l, F.bid);
    if (F.bid >= 4 && F.bid < 12) { const int hd = F.bid - 4, h = hd >> 1;
        if (l == 0) { if (hd & 1) scan_dir_local<1>(F, l, h, 0, sc_CARRY(F) + hd * 16384); else scan_dir_local<0>(F, l, h, 0, sc_CARRY(F) + hd * 16384); }
        else { if (hd & 1) scan_states<1>(F, l, h, 0, sc_CARRY(F) + hd * 16384, nullptr); else scan_states<0>(F, l, h, 0, sc_CARRY(F) + hd * 16384, nullptr); }
        return; }
    fftA_item(F, F.bid);
    if (F.bid >= 12 && F.bid < 20) fftA_item(F, F.bid - 8);
    if (l == 0) { pool_item(F, l, F.bid); if (F.bid >= 20 && F.bid < 28) pool_item(F, l, F.bid - 16); else if (F.bid >= 28 && F.bid < 32) pool_item(F, l, F.bid + 228); }
    else { pool_item(F, l, F.bid + 4); if (F.bid >= 20 && F.bid < 28) pool_item(F, l, F.bid - 12); }
}
__device__ __forceinline__ void ph_mixB(Frame& F, int l) {
    scanB(F);
    fftB_item(F, F.bid);
    if (l == 0 && F.bid >= 252) fftC_item(F, F.bid - 252);
    if (l == 0 && F.bid >= 240 && F.bid < 244) ctx_finalize(F, l, F.bid - 240);
}
__device__ __forceinline__ void ph_mixC(Frame& F, int l) {
    const int item = F.bid, h = item >> 6, seg = item & 63;
    scan_full(F, l, h, CTX + 256 * seg, sc_SS(F) + ((size_t)(h * 2 + 0) * 64 + seg) * 16384, sc_SS(F) + ((size_t)(h * 2 + 1) * 64 + seg) * 16384, nullptr, nullptr);
}
#define GRID_BAR() do { Frame R_ = relaunder(F); xcd_barrier(bar, R_.tid); } while (0)
#define PHASE(call) do { Frame R = relaunder(F); call; } while (0)
__global__ void __launch_bounds__(NTHR, 2) mega_fwd(Params p) {
    extern __shared__ __attribute__((aligned(16))) unsigned char lds[];
    Frame F; frame_init(F, p, lds);
    if (F.tid < 16) ((LAS unsigned*)(F.lds + MISC_OFF))[F.tid] = 0u;
    __syncthreads();
    XcdBarrier bar = xcd_barrier_post((unsigned*)(F.ctl() + CW_BAR), (volatile LAS unsigned*)(F.lds + MISC_OFF + 32));
    PHASE(ph_prologue(R)); PHASE(ph_prologue2(R));
    GRID_BAR();
    PHASE(ph_mod1(R, 0));
    GRID_BAR();
#pragma unroll 1
    for (int l = 0; l < 2; ++l) {
        PHASE(ph_win(R, l));            GRID_BAR();
        PHASE(ph_mixA(R, l));           GRID_BAR();
        PHASE(ph_mixB(R, l));           GRID_BAR();
        PHASE(ph_mixC(R, l));           GRID_BAR();
        PHASE(ph_wout(R, l));           GRID_BAR();
        PHASE(ph_mod2_route(R, l, l));  GRID_BAR();
        PHASE(ph_gateup(R, l));         GRID_BAR();
        PHASE(ph_down(R, l));           GRID_BAR();
        PHASE(ph_combine(R, l));
        if (l == 0) GRID_BAR();
    }
}
extern "C" void kernel_launch(void* const* d_in, const int* in_sizes, int n_in, void* d_out, int out_size, void* d_ws, size_t ws_size, hipStream_t stream) {
    static int ok = 0;
    if (ok == 0) {
        if (n_in != 22 || out_size != LAT * D || ws_size < WS_FASTEND) { fprintf(stderr, "kernel_launch: unexpected shapes / workspace (n_in %d, out %d, ws %zu < %zu); nothing launched\n", n_in, out_size, ws_size, (size_t)WS_FASTEND); ok = -1; return; }
        int dev = 0, cus = 0, per_cu = 0;
        if (hipGetDevice(&dev) != hipSuccess || hipDeviceGetAttribute(&cus, hipDeviceAttributeMultiprocessorCount, dev) != hipSuccess) { ok = -1; return; }
        if (hipFuncSetAttribute((const void*)mega_fwd, hipFuncAttributeMaxDynamicSharedMemorySize, LDS_BYTES) != hipSuccess) { fprintf(stderr, "kernel_launch: hipFuncSetAttribute failed\n"); ok = -1; return; }
        if (hipOccupancyMaxActiveBlocksPerMultiprocessor(&per_cu, (const void*)mega_fwd, NTHR, LDS_BYTES) != hipSuccess || per_cu < 1) fprintf(stderr, "kernel_launch: note: occupancy query reports %d workgroups per CU\n", per_cu);
        (void)hipGetLastError();
        if (cus < 256) fprintf(stderr, "kernel_launch: device has %d CUs; this kernel needs 256 co-resident workgroups (one per CU)\n", cus);
        ok = 1;
    }
    if (ok < 0) return;
    if (hipMemsetAsync((char*)d_ws + WS_CTL, 0, CTL_ZERO_BYTES, stream) != hipSuccess) return;
    Params p{}; for (int i = 0; i < 22; ++i) p.in[i] = (const float*)d_in[i]; p.out = (float*)d_out; p.ws = (unsigned char*)d_ws;
    hipLaunchKernelGGL(mega_fwd, dim3(256), dim3(NTHR), LDS_BYTES, stream, p);
}
```

```cpp
#include <hip/hip_runtime.h>
#include <cstdio>
#include <cstdint>
constexpr int D = 1024, LAT = 16384, CTX = 256, T = LAT + CTX, DIN = 3072, NE = 32, TOPK = 4;
constexpr int GW = 64;
#ifndef PSTR
#define PSTR DIN
#endif
constexpr int DINX = 3328, FQ_OFF = 2816;
#define GAS __attribute__((address_space(1)))
#define LAS __attribute__((address_space(3)))
typedef unsigned short bf16_t;
typedef short bf16x8 __attribute__((ext_vector_type(8)));
typedef short bf16x4 __attribute__((ext_vector_type(4)));
typedef float f32x4 __attribute__((ext_vector_type(4)));
typedef float f32x2 __attribute__((ext_vector_type(2)));
typedef unsigned u32x4 __attribute__((ext_vector_type(4)));
typedef unsigned u32x2 __attribute__((ext_vector_type(2)));
typedef GAS unsigned gu32;
#define RLX_AGENT __ATOMIC_RELAXED, __HIP_MEMORY_SCOPE_AGENT
#define LDS_WAIT() asm volatile("s_waitcnt lgkmcnt(0)" ::: "memory")
#define VM_WAIT() asm volatile("s_waitcnt vmcnt(0)" ::: "memory")
__device__ __forceinline__ unsigned cvt_pk_bf16(float lo, float hi) { unsigned r; asm("v_cvt_pk_bf16_f32 %0, %1, %2" : "=v"(r) : "v"(lo), "v"(hi)); return r; }
__device__ __forceinline__ unsigned f2bf(float f) { return cvt_pk_bf16(f, 0.f) & 0xffffu; }
__device__ __forceinline__ unsigned pk2(float lo, float hi) { return cvt_pk_bf16(lo, hi); }
__device__ __forceinline__ float bf2f(unsigned short b) { return __builtin_bit_cast(float, ((unsigned)b) << 16); }
__device__ __forceinline__ float bflo(unsigned w) { return __builtin_bit_cast(float, w << 16); }
__device__ __forceinline__ float bfhi(unsigned w) { return __builtin_bit_cast(float, w & 0xffff0000u); }
__device__ __forceinline__ float fsigm(float x) { return __builtin_amdgcn_rcpf(1.f + __builtin_amdgcn_exp2f(-1.44269504f * x)); }
__device__ __forceinline__ float lane_xor(float v, int m, int lane) { return __builtin_bit_cast(float, __builtin_amdgcn_ds_bpermute((lane ^ m) << 2, __builtin_bit_cast(int, v))); }
__device__ __forceinline__ int lane_get(int v, int src) { return __builtin_amdgcn_ds_bpermute(src << 2, v); }
__device__ __forceinline__ float wave_sum(float v, int lane) {
#pragma unroll
    for (int o = 1; o < 64; o <<= 1) v += lane_xor(v, o, lane);
    return v;
}

#define XB_TMO      128
#define XB_XCNT(j)  (256  + 64 * (j))
#define XB_XSUB(j)  (1280 + 64 * (j))
#define XB_XGEN(j)  (2304 + 64 * (j))
#define XB_TOP      3328
#define XB_TOPGEN   3392
#define XCD_BAR_WORDS 3456
#define XB_SPIN_CAP (1u << 18)
__device__ __forceinline__ unsigned xb_ld(unsigned* p)              { return __hip_atomic_load(p, __ATOMIC_RELAXED, __HIP_MEMORY_SCOPE_AGENT); }
__device__ __forceinline__ unsigned xb_add(unsigned* p, unsigned v) { return __hip_atomic_fetch_add(p, v, __ATOMIC_RELAXED, __HIP_MEMORY_SCOPE_AGENT); }
__device__ __forceinline__ unsigned xb_xcc_id() { return (unsigned)__builtin_amdgcn_s_getreg((3 << 11) | 20) & 0xFu; }
#define XB_SPIN(cond, bar) do { unsigned _sp = 0; while (cond) { __builtin_amdgcn_s_sleep(1); \
    if ((++_sp & 255u) == 0u) { if (xb_ld(&(bar)[XB_TMO])) break; if (_sp > XB_SPIN_CAP) { atomicAdd(&(bar)[XB_TMO], 1u); break; } } } } while (0)
struct XcdBarrier { unsigned* bar; unsigned x; volatile LAS unsigned* st; };
__device__ __forceinline__ XcdBarrier xcd_barrier_post(unsigned* bar, volatile LAS unsigned* st) {
    XcdBarrier b; b.bar = bar; b.x = xb_xcc_id(); b.st = st;
    if (threadIdx.x == 0) (void)xb_add(&bar[XB_XCNT(b.x)], 1u);
    return b;
}
__device__ __forceinline__ void xcd_barrier_complete(unsigned* bar, unsigned x, unsigned& nloc, unsigned& nx) {
    const unsigned G = gridDim.x * gridDim.y * gridDim.z;
    unsigned sum, cnt, mine, sp = 0u;
    for (;;) {
        sum = 0u; cnt = 0u; mine = 0u;
#pragma unroll
        for (unsigned j = 0; j < 16; ++j) { const unsigned c = xb_ld(&bar[XB_XCNT(j)]); sum += c; cnt += (c > 0u) ? 1u : 0u; mine = (j == x) ? c : mine; }
        if (sum == G) break;
        __builtin_amdgcn_s_sleep(1);
        if ((++sp & 255u) == 0u) { if (xb_ld(&bar[XB_TMO])) break; if (sp > XB_SPIN_CAP) { atomicAdd(&bar[XB_TMO], 1u); break; } }
    }
    nloc = mine > 0u ? mine : 1u; nx = cnt > 0u ? cnt : 1u;
}
__device__ __forceinline__ void xcd_barrier(const XcdBarrier& b, const int tid) {
    asm volatile("s_waitcnt vmcnt(0)" ::: "memory");
    unsigned blo = (unsigned)(unsigned long long)b.bar, bhi = (unsigned)((unsigned long long)b.bar >> 32), bx = b.x;
    asm volatile("" : "+s"(blo), "+s"(bhi), "+s"(bx));
    __syncthreads();
    if (tid == 0) {
        unsigned* bar = (unsigned*)(((unsigned long long)bhi << 32) | blo);
        __builtin_amdgcn_s_waitcnt(0);
        unsigned nloc = b.st[0], nx = b.st[1];
        if (nloc == 0u) { xcd_barrier_complete(bar, bx, nloc, nx); b.st[0] = nloc; b.st[1] = nx; }
        const unsigned old = xb_add(&bar[XB_XSUB(bx)], 1u);
        const unsigned gen = old / nloc;
        if (old + 1u == (gen + 1u) * nloc) {
            __builtin_amdgcn_fence(__ATOMIC_RELEASE, "agent");
            asm volatile("s_waitcnt vmcnt(0)" ::: "memory");
            const unsigned og = xb_add(&bar[XB_TOP], 1u);
            const unsigned tg = og / nx;
            if (og + 1u == (tg + 1u) * nx) xb_add(&bar[XB_TOPGEN], 1u);
            else XB_SPIN(xb_ld(&bar[XB_TOPGEN]) == tg, bar);
            __builtin_amdgcn_fence(__ATOMIC_ACQUIRE, "agent");
            xb_add(&bar[XB_XGEN(bx)], 1u);
            asm volatile("s_waitcnt vmcnt(0)" ::: "memory");
        } else {
            XB_SPIN(xb_ld(&bar[XB_XGEN(bx)]) == gen, bar);
            __builtin_amdgcn_fence(__ATOMIC_ACQUIRE, "agent");
            asm volatile("s_waitcnt vmcnt(0)" ::: "memory");
        }
    }
    __syncthreads();
}

namespace pg8 {
constexpr int BM = 256, BK = 64, HALF = 128, HTB = HALF * BK * 2, STAGE_BYTES = 8 * HTB, NXCD = 8, WGM = 8;
__host__ __device__ __forceinline__ int lds_byte(int r, int c) { const int st = (r >> 4) * 2 + (c >> 5), rr = r & 15, cc = c & 31, ob = rr * 64 + cc * 2; return st * 1024 + (ob ^ (((ob >> 9) & 1) << 5)); }
__host__ __device__ __forceinline__ void stage_rc(int b, int& R, int& C) { const int st = b / 1024, sb = b % 1024, swz = sb ^ (((sb >> 9) & 1) << 5); R = (st >> 1) * 16 + swz / 64; C = (st & 1) * 32 + (swz % 64) / 2; }
__host__ __device__ __forceinline__ int perm32(int rho) { const int n = rho >> 4, i = rho & 15; return 8 * (i >> 2) + 4 * n + (i & 3); }

struct Unit { int pm, pn, e, ui; };

typedef int i32x8 __attribute__((ext_vector_type(8)));
typedef int i32x4 __attribute__((ext_vector_type(4)));
__device__ __forceinline__ i32x8 cat8(bf16x8 a, bf16x8 b) { return __builtin_shufflevector(__builtin_bit_cast(i32x4, a), __builtin_bit_cast(i32x4, b), 0, 1, 2, 3, 4, 5, 6, 7); }
template <class Epi, class Sched, bool ALIGN_EPI = true, bool FP8 = false>
__device__ __forceinline__ void gemm_phase(LAS unsigned char* lds, const char* gA, const int Kb, const Sched& S, const Epi& E, const int tid) {
    const int wid = __builtin_amdgcn_readfirstlane(tid >> 6), lane = tid & 63, wr = wid >> 2, wc = wid & 3, fr = lane & 15, fq = lane >> 4;
    const int nt = Kb / (BK * 2);
    int Ra[2], Ca[2]; unsigned voffB[2];
#pragma unroll
    for (int i = 0; i < 2; ++i) { int R, C; stage_rc(tid * 16 + i * 8192, R, C); const int Rb = Epi::PERM ? ((R & ~31) + perm32(R & 31)) : R;
        Ra[i] = R; Ca[i] = C * 2; voffB[i] = (unsigned)(Rb * Kb + C * 2); }
    const size_t kstep = (size_t)(BK * 2);
    const size_t hstep = (size_t)HALF * Kb;
    const unsigned ldsw = (unsigned)wid * 1024u;
    const int aoff = lds_byte(wr * 64 + fr, fq * 8), boff = lds_byte(wc * 32 + fr, fq * 8);
#define PG8_SA(b, h) (((b) * 2 + (h)) * HTB)
#define PG8_SB(b, h) ((4 + (b) * 2 + (h)) * HTB)
#define PG8_STAGE(bufoff, gbase, voff) do { _Pragma("unroll") for (int _i = 0; _i < 2; ++_i) \
        __builtin_amdgcn_global_load_lds((const unsigned*)((const char*)(gbase) + (voff)[_i]), (LAS unsigned*)(lds + (bufoff) + ldsw + _i * 8192), 16, 0, 0); } while (0)
#define PG8_LDA(dst, b, h) do { _Pragma("unroll") for (int m = 0; m < 4; ++m) _Pragma("unroll") for (int k = 0; k < 2; ++k) dst[m][k] = *(const LAS bf16x8*)(lds + PG8_SA(b, h) + aoff + m * 2048 + k * 1024); } while (0)
#define PG8_LDB(dst, b, h) do { _Pragma("unroll") for (int n = 0; n < 2; ++n) _Pragma("unroll") for (int k = 0; k < 2; ++k) dst[n][k] = *(const LAS bf16x8*)(lds + PG8_SB(b, h) + boff + n * 2048 + k * 1024); } while (0)
#define PG8_MMA(ai, bj, At, Bt) do { __builtin_amdgcn_s_setprio(1); _Pragma("unroll") for (int m = 0; m < 4; ++m) _Pragma("unroll") for (int n = 0; n < 2; ++n) { \
        if constexpr (FP8) asm volatile("v_mfma_scale_f32_16x16x128_f8f6f4 %0, %1, %2, %0, %3, %3 op_sel_hi:[0,0,0]" : "+v"(acc[ai][bj][m][n]) : "v"(cat8(Bt[n][0], Bt[n][1])), "v"(cat8(At[m][0], At[m][1])), "v"(scl)); \
        else { _Pragma("unroll") for (int k = 0; k < 2; ++k) acc[ai][bj][m][n] = __builtin_amdgcn_mfma_f32_16x16x32_bf16(Bt[n][k], At[m][k], acc[ai][bj][m][n], 0, 0, 0); } } __builtin_amdgcn_s_setprio(0); } while (0)
#define PG8_WAIT_V(n) asm volatile("s_waitcnt vmcnt(" #n ")" ::: "memory")
#define PG8_WAIT_L(n) asm volatile("s_waitcnt lgkmcnt(" #n ")" ::: "memory")
#define PG8_BAR __builtin_amdgcn_s_barrier()
#define PG8_SCHED __builtin_amdgcn_sched_barrier(0)
    Unit cur, nxt; int ui = 0;
    if (!S.next(0, cur)) return;
    f32x4 acc[2][2][4][2];
#pragma unroll
    for (int a = 0; a < 2; ++a)
#pragma unroll
        for (int b = 0; b < 2; ++b)
#pragma unroll
            for (int m = 0; m < 4; ++m)
#pragma unroll
                for (int n = 0; n < 2; ++n) acc[a][b][m][n] = (f32x4){0.f, 0.f, 0.f, 0.f};
    bf16x8 At[4][2], B0[2][2], B1[2][2]; const int scl = 0x7f7f7f7f;
    unsigned vA[2][2];
#pragma unroll
    for (int h = 0; h < 2; ++h)
#pragma unroll
        for (int i = 0; i < 2; ++i) vA[h][i] = S.a_row_off(cur, h * HALF + Ra[i]) + (unsigned)Ca[i];
    const char* cB = S.b_tile(cur);
    PG8_STAGE(PG8_SB(0, 0), cB, voffB); PG8_STAGE(PG8_SB(0, 1), cB + hstep, voffB); PG8_STAGE(PG8_SA(0, 0), gA, vA[0]); PG8_STAGE(PG8_SA(0, 1), gA, vA[1]);
    if (wr == 1) PG8_BAR;
    PG8_WAIT_V(2); PG8_BAR;
    PG8_STAGE(PG8_SB(1, 0), cB + kstep, voffB); PG8_STAGE(PG8_SA(1, 0), gA + kstep, vA[0]); PG8_STAGE(PG8_SB(1, 1), cB + hstep + kstep, voffB);
    PG8_WAIT_V(6); PG8_BAR;
    for (;;) {
        const bool has_next = S.next(ui + 1, nxt);
        const char* nB = has_next ? S.b_tile(nxt) : cB;
        for (int t = 0; t < nt; t += 2) {
            const bool last = (t == nt - 2);
            unsigned tN[2][2];
#pragma unroll
            for (int h = 0; h < 2; ++h)
#pragma unroll
                for (int i = 0; i < 2; ++i) tN[h][i] = vA[h][i];
            if (last && has_next) {
#pragma unroll
                for (int h = 0; h < 2; ++h)
#pragma unroll
                    for (int i = 0; i < 2; ++i) tN[h][i] = S.a_row_off(nxt, h * HALF + Ra[i]) + (unsigned)Ca[i];
                PG8_WAIT_L(0);
            }
            const char* a1 = gA + (size_t)(t + 1) * kstep;
            const char* a2 = last ? gA : gA + (size_t)(t + 2) * kstep; const char* b2 = last ? nB : cB + (size_t)(t + 2) * kstep;
            const char* a3 = a2 + kstep; const char* b3 = b2 + kstep;
            PG8_LDB(B0, 0, 0); PG8_LDB(B1, 0, 1); PG8_SCHED; PG8_LDA(At, 0, 0); PG8_STAGE(PG8_SA(1, 1), a1, vA[1]);
#pragma unroll
            for (int h = 0; h < 2; ++h)
#pragma unroll
                for (int i = 0; i < 2; ++i) vA[h][i] = tN[h][i];
            PG8_WAIT_V(8); PG8_WAIT_L(0); PG8_BAR; PG8_MMA(0, 0, At, B0); PG8_MMA(0, 1, At, B1); PG8_BAR; PG8_SCHED;
            PG8_LDA(At, 0, 1); PG8_STAGE(PG8_SB(0, 0), b2, voffB); PG8_STAGE(PG8_SB(0, 1), b2 + hstep, voffB); PG8_STAGE(PG8_SA(0, 0), a2, vA[0]);
            PG8_WAIT_V(8); PG8_WAIT_L(0); PG8_BAR; PG8_MMA(1, 0, At, B0); PG8_MMA(1, 1, At, B1); PG8_BAR; PG8_SCHED;
            PG8_LDB(B0, 1, 0); PG8_LDB(B1, 1, 1); PG8_SCHED; PG8_LDA(At, 1, 0); PG8_STAGE(PG8_SA(0, 1), a2, vA[1]);
            PG8_WAIT_V(8); PG8_WAIT_L(0); PG8_BAR; PG8_MMA(0, 0, At, B0); PG8_MMA(0, 1, At, B1); PG8_BAR; PG8_SCHED;
            PG8_LDA(At, 1, 1); PG8_STAGE(PG8_SB(1, 0), b3, voffB); PG8_STAGE(PG8_SB(1, 1), b3 + hstep, voffB); PG8_STAGE(PG8_SA(1, 0), a3, vA[0]);
            PG8_WAIT_V(8); PG8_WAIT_L(0); PG8_BAR; PG8_MMA(1, 0, At, B0); PG8_MMA(1, 1, At, B1); PG8_BAR; PG8_SCHED;
        }
        if constexpr (ALIGN_EPI) { if (wr == 0) PG8_BAR; }
        if constexpr (FP8) asm volatile("s_nop 15\n\ts_nop 15" ::: "memory");
        E(acc, cur, wr, wc, fr, fq);
        if (!has_next) break;
#pragma unroll
        for (int a = 0; a < 2; ++a)
#pragma unroll
            for (int b = 0; b < 2; ++b)
#pragma unroll
                for (int m = 0; m < 4; ++m)
#pragma unroll
                    for (int n = 0; n < 2; ++n) acc[a][b][m][n] = (f32x4){0.f, 0.f, 0.f, 0.f};
        cur = nxt; cB = nB; ++ui;
        if constexpr (ALIGN_EPI) { if (wr == 1) PG8_BAR; }
    }
    PG8_WAIT_V(0);
    if constexpr (!ALIGN_EPI) { if (wr == 0) PG8_BAR; }
    PG8_BAR;
#undef PG8_SA
#undef PG8_SB
#undef PG8_STAGE
#undef PG8_LDA
#undef PG8_LDB
#undef PG8_MMA
#undef PG8_WAIT_V
#undef PG8_WAIT_L
#undef PG8_BAR
#undef PG8_SCHED
}
}
constexpr size_t MiB = 1u << 20;
constexpr int TP = T * 4 + NE * 256;
constexpr size_t WS_CTL = 0, CTL_ZERO_BYTES = 128 * 1024;
constexpr size_t WS_LB = 1 * MiB, WS_MOD = 1 * MiB + 65536;
constexpr size_t WS_WIN = 2 * MiB, WS_WOUT = 18 * MiB, WS_WF = 22 * MiB, WS_WGU = 24 * MiB, WS_WDN = 280 * MiB;
constexpr size_t WS_X = 408 * MiB, WS_H = 474 * MiB, WS_P = 508 * MiB, WS_CAT = 624 * MiB, WS_ROUTE = 658 * MiB, WS_ACT = 662 * MiB, WS_Y = 810 * MiB;
constexpr size_t WS_SU = 958 * MiB, WS_SS = 990 * MiB, WS_SD = 1022 * MiB, WS_YP = 1023 * MiB, WS_OSCR = 1040 * MiB, WS_H8 = 1072 * MiB, WS_CTXO = 1090 * MiB, WS_FASTEND = 1092 * MiB;
#ifndef MOE_FP8
#define MOE_FP8 1
#endif
constexpr float FP8_SH = 16.f, FP8_SW = 256.f, FP8_SA = 4.f;
constexpr size_t RT_TOPI = 0, RT_TOPW = 512 * 1024, RT_POS = 1024 * 1024, RT_LISTE = 1536 * 1024;
static_assert((size_t)T * 16 <= 512 * 1024 && RT_LISTE + (size_t)NE * T * 4 <= 4 * MiB, "route map");
static_assert(WS_WIN + (size_t)2 * DINX * D * 2 <= WS_WOUT && WS_WGU + (size_t)2 * NE * 2048 * 1024 * 2 <= WS_WDN && WS_WDN + (size_t)2 * NE * 1024 * 1024 * 2 <= WS_X && WS_X + (size_t)T * D * 4 <= WS_H && WS_H + (size_t)T * D * 2 <= WS_P &&
              WS_P + (size_t)T * DINX * 2 <= WS_CAT && WS_CAT + (size_t)T * D * 2 <= WS_ROUTE && WS_ACT + (size_t)TP * D * 2 <= WS_Y && WS_Y + (size_t)TP * D * 2 <= WS_SU &&
              WS_SD + (size_t)(8 * 64 * 128 + 8 * 16384) * 4 <= WS_YP && WS_YP + (size_t)128 * 128 * 2 * 256 * 2 <= WS_OSCR && WS_OSCR + (size_t)256 * 32768 * 4 <= WS_H8 && WS_H8 + (size_t)T * D <= WS_CTXO && WS_CTXO + (size_t)32 * 8192 * 4 <= WS_FASTEND, "ws map");
constexpr int CW_TMO = 0, CW_BAR = 4096, CW_CNT = 16384;
constexpr int RING_OFF = 0, RING_BYTES = 131072, TINFO_OFF = 131072, BT_OFF = 136192, ROWOFF_OFF = 136704, MISC_OFF = 146944, LDS_BYTES = 147456;
constexpr int NWAVES = 8, NTHR = 512;

struct Params { const float* in[22]; float* out; unsigned char* ws; };
constexpr int PTR_OFF = MISC_OFF + 64;
struct Frame {
    LAS unsigned char* lds; unsigned char* ws; int tid, lane, wave, vcu, G, bid;
    __device__ __forceinline__ const float* in(int i) const { const LAS unsigned* q = (const LAS unsigned*)(lds + PTR_OFF) + 2 * i;
        const unsigned lo = __builtin_amdgcn_readfirstlane(q[0]), hi = __builtin_amdgcn_readfirstlane(q[1]); return (const float*)(((unsigned long long)hi << 32) | lo); }
    __device__ __forceinline__ const float* x() const { return in(0); }        __device__ __forceinline__ const float* c() const { return in(1); }
    __device__ __forceinline__ const float* ctxin() const { return in(2); }    __device__ __forceinline__ const float* cctx() const { return in(3); }
    __device__ __forceinline__ const float* w_ada() const { return in(4); }    __device__ __forceinline__ const float* b_ada() const { return in(5); }
    __device__ __forceinline__ const float* norm1_g() const { return in(6); }  __device__ __forceinline__ const float* norm2_g() const { return in(7); }
    __device__ __forceinline__ const float* w_in() const { return in(8); }     __device__ __forceinline__ const float* lbp() const { return in(9); }
    __device__ __forceinline__ const float* hng() const { return in(10); }     __device__ __forceinline__ const float* pool_w() const { return in(11); }
    __device__ __forceinline__ const float* pool_s() const { return in(12); }  __device__ __forceinline__ const float* four_w() const { return in(13); }
    __device__ __forceinline__ const float* w_out() const { return in(14); }   __device__ __forceinline__ const float* router_w() const { return in(15); }
    __device__ __forceinline__ const float* router_b() const { return in(16); } __device__ __forceinline__ const float* w_gu() const { return in(17); }
    __device__ __forceinline__ const float* b_gu() const { return in(18); }    __device__ __forceinline__ const float* w_dn() const { return in(19); }
    __device__ __forceinline__ const float* b_dn() const { return in(20); }    __device__ __forceinline__ const float* fng() const { return in(21); }
    __device__ __forceinline__ float* out() const { return (float*)in(22); }
    __device__ __forceinline__ gu32* ctl() const { return (gu32*)(ws + WS_CTL); }
    __device__ __forceinline__ float* LB() const { return (float*)(ws + WS_LB); }       __device__ __forceinline__ float* MOD() const { return (float*)(ws + WS_MOD); }
    __device__ __forceinline__ float* X() const { return (float*)(ws + WS_X); }
    __device__ __forceinline__ bf16_t* Wt_in() const { return (bf16_t*)(ws + WS_WIN); }  __device__ __forceinline__ bf16_t* Wt_out() const { return (bf16_t*)(ws + WS_WOUT); }
    __device__ __forceinline__ bf16_t* Wt_gu() const { return (bf16_t*)(ws + WS_WGU); }  __device__ __forceinline__ bf16_t* Wt_dn() const { return (bf16_t*)(ws + WS_WDN); }
    __device__ __forceinline__ bf16_t* H() const { return (bf16_t*)(ws + WS_H); }        __device__ __forceinline__ bf16_t* P() const { return (bf16_t*)(ws + WS_P); }
    __device__ __forceinline__ bf16_t* CAT() const { return (bf16_t*)(ws + WS_CAT); }    __device__ __forceinline__ bf16_t* ACT() const { return (bf16_t*)(ws + WS_ACT); }
    __device__ __forceinline__ bf16_t* Y() const { return (bf16_t*)(ws + WS_Y); }
    __device__ __forceinline__ int* TOPI() const { return (int*)(ws + WS_ROUTE + RT_TOPI); }   __device__ __forceinline__ float* TOPW() const { return (float*)(ws + WS_ROUTE + RT_TOPW); }
    __device__ __forceinline__ int* POS() const { return (int*)(ws + WS_ROUTE + RT_POS); }     __device__ __forceinline__ int* LISTE() const { return (int*)(ws + WS_ROUTE + RT_LISTE); }
};
__device__ __forceinline__ void frame_init(Frame& F, const Params& p, unsigned char* lds) {
    F.lds = (LAS unsigned char*)lds; F.tid = threadIdx.x; F.lane = F.tid & 63; F.wave = __builtin_amdgcn_readfirstlane(F.tid >> 6);
    F.G = gridDim.x; F.bid = blockIdx.x; { const int bx = blockIdx.x; F.vcu = (F.G % 8 == 0) ? (bx % 8) * (F.G / 8) + bx / 8 : bx; }
    F.ws = p.ws;
    if (F.tid == 0) { LAS unsigned long long* tab = (LAS unsigned long long*)(F.lds + PTR_OFF);
#pragma unroll
        for (int i = 0; i < 22; ++i) tab[i] = (unsigned long long)p.in[i];
        tab[22] = (unsigned long long)p.out; }
    __syncthreads();
}

__device__ __forceinline__ Frame relaunder(const Frame& F) { Frame R = F; int ln; asm volatile("v_mbcnt_lo_u32_b32 %0, -1, 0\n\tv_mbcnt_hi_u32_b32 %0, -1, %0" : "=v"(ln));
    R.lane = ln; R.tid = F.wave * 64 + ln; unsigned wlo = (unsigned)(unsigned long long)F.ws, whi = (unsigned)((unsigned long long)F.ws >> 32);
    asm volatile("" : "+s"(wlo), "+s"(whi)); R.ws = (unsigned char*)(((unsigned long long)whi << 32) | wlo);
    int sw = F.wave, sv = F.vcu, sg = F.G, sb = F.bid;
    asm volatile("" : "+s"(sw), "+s"(sv), "+s"(sg), "+s"(sb));
    R.wave = sw; R.vcu = sv; R.G = sg; R.bid = sb; R.tid = sw * 64 + ln; return R; }

struct DenseOrder {
    int nM, nN, nwg, G, c, Kb, pm0; const char* Bt;
    __device__ void init(int nM_, int nN_, int G_, int c_, int Kb_, const bf16_t* Bt_, int pm0_ = 0) { nM = nM_; nN = nN_; nwg = nM * nN; G = G_; c = c_; Kb = Kb_; Bt = (const char*)Bt_; pm0 = pm0_; }
    __device__ __forceinline__ bool next(int i, pg8::Unit& u) const {
        const long L = (long)i * G + c; if (L >= nwg) return false;
        int wgid = (int)L; { const int q = nwg / pg8::NXCD, r = nwg % pg8::NXCD, xcd = wgid % pg8::NXCD, off = wgid / pg8::NXCD; wgid = (xcd < r ? xcd * (q + 1) : r * (q + 1) + (xcd - r) * q) + off; }
        const int nig = pg8::WGM * nN, gid = wgid / nig, fm = gid * pg8::WGM, gsz = (nM - fm) < pg8::WGM ? (nM - fm) : pg8::WGM;
        u.pm = pm0 + fm + ((wgid % nig) % gsz); u.pn = (wgid % nig) / gsz; u.e = 0; u.ui = i; return true;
    }
    __device__ __forceinline__ const char* b_tile(const pg8::Unit& u) const { return Bt + (size_t)u.pn * 256 * Kb; }
    __device__ __forceinline__ unsigned a_row_off(const pg8::Unit& u, int r) const { return (unsigned)(u.pm * 256 + r) * (unsigned)Kb; }
};
template <bool GATHER> struct MoeOrder {
    const LAS int* tinfo; const LAS unsigned* rowoff; int ntiles, nN, G, c, Kb; const char* W; size_t wstride;
    __device__ __forceinline__ bool next(int i, pg8::Unit& u) const {
        const int L = i * G + c; if (L >= ntiles * nN) return false;
        u.pm = L / nN; u.pn = L % nN; u.e = __builtin_amdgcn_readfirstlane(tinfo[4 * u.pm]); u.ui = i; return true;
    }
    __device__ __forceinline__ const char* b_tile(const pg8::Unit& u) const { return W + (size_t)u.e * wstride + (size_t)u.pn * 256 * Kb; }
    __device__ __forceinline__ unsigned a_row_off(const pg8::Unit& u, int r) const { if constexpr (GATHER) return rowoff[u.ui * 256 + r]; else return (unsigned)(u.pm * 256 + r) * (unsigned)Kb; }
};

__device__ __forceinline__ unsigned pk_f16(float a, float b) { const _Float16 x = (_Float16)a, y = (_Float16)b; return (unsigned)__builtin_bit_cast(unsigned short, x) | ((unsigned)__builtin_bit_cast(unsigned short, y) << 16); }
__device__ __forceinline__ float f16lo(unsigned w) { return (float)__builtin_bit_cast(_Float16, (unsigned short)(w & 0xffffu)); }
__device__ __forceinline__ float f16hi(unsigned w) { return (float)__builtin_bit_cast(_Float16, (unsigned short)(w >> 16)); }
struct EpiP {
    static constexpr bool PERM = true; bf16_t* O; int ldc; const float* lb;
    __device__ __forceinline__ void operator()(const f32x4 (&acc)[2][2][4][2], const pg8::Unit& u, int wr, int wc, int fr, int fq) const {
        const int row0 = u.pm * 256 + wr * 64 + fr, col0 = u.pn * 256 + wc * 32 + 8 * fq;
        const int mode = u.pn < 2 ? 1 : (u.pn < 6 ? 2 : ((u.pn == 8 || u.pn == 9) ? 3 : 0));
        f32x4 lbv[2][2];
        if (mode == 2) {
#pragma unroll
            for (int bj = 0; bj < 2; ++bj)
#pragma unroll
                for (int n = 0; n < 2; ++n) lbv[bj][n] = *(const f32x4*)(lb + (col0 - 512) + bj * 128 + 4 * n); }
#pragma unroll
        for (int ai = 0; ai < 2; ++ai)
#pragma unroll
            for (int m = 0; m < 4; ++m) { bf16_t* rowp = O + (size_t)(row0 + ai * 128 + m * 16) * ldc + col0;
#pragma unroll
                for (int bj = 0; bj < 2; ++bj) { f32x2 v[4]; { const f32x4 v0 = acc[ai][bj][m][0], v1 = acc[ai][bj][m][1]; v[0] = (f32x2){v0[0], v0[1]}; v[1] = (f32x2){v0[2], v0[3]}; v[2] = (f32x2){v1[0], v1[1]}; v[3] = (f32x2){v1[2], v1[3]}; }
                    u32x4 w;
                    if (mode != 0) {
                        f32x2 sg[4];
#pragma unroll
                        for (int p = 0; p < 4; ++p) { const f32x2 ex = v[p] * (-1.44269504f); f32x2 d; d.x = __builtin_amdgcn_exp2f(ex.x); d.y = __builtin_amdgcn_exp2f(ex.y); d = d + 1.0f; sg[p].x = __builtin_amdgcn_rcpf(d.x); sg[p].y = __builtin_amdgcn_rcpf(d.y); }
                        if (mode == 2) {
#pragma unroll
                            for (int p = 0; p < 4; ++p) { const f32x4 lv = lbv[bj][p >> 1]; const f32x2 lb2 = (f32x2){lv[2 * (p & 1)], lv[2 * (p & 1) + 1]}; const f32x2 f = lb2 + (1.0f - lb2) * sg[p];
                                v[p].x = __builtin_amdgcn_logf(fmaxf(f.x, 1e-30f)); v[p].y = __builtin_amdgcn_logf(fmaxf(f.y, 1e-30f)); }
                            w.x = pk_f16(v[0].x, v[0].y); w.y = pk_f16(v[1].x, v[1].y); w.z = pk_f16(v[2].x, v[2].y); w.w = pk_f16(v[3].x, v[3].y);
                        } else {
#pragma unroll
                            for (int p = 0; p < 4; ++p) v[p] = mode == 1 ? v[p] * sg[p] : sg[p];
                            w.x = cvt_pk_bf16(v[0].x, v[0].y); w.y = cvt_pk_bf16(v[1].x, v[1].y); w.z = cvt_pk_bf16(v[2].x, v[2].y); w.w = cvt_pk_bf16(v[3].x, v[3].y); }
                    } else { w.x = cvt_pk_bf16(v[0].x, v[0].y); w.y = cvt_pk_bf16(v[1].x, v[1].y); w.z = cvt_pk_bf16(v[2].x, v[2].y); w.w = cvt_pk_bf16(v[3].x, v[3].y); }
                    *(u32x4*)(rowp + bj * 128) = w; } }
    }
};
struct EpiRes {
    static constexpr bool PERM = false; const float* base_ctx; const float* base_lat; const float* gate_ctx; const float* gate_lat; float* Xo;
    __device__ __forceinline__ void operator()(const f32x4 (&acc)[2][2][4][2], const pg8::Unit& u, int wr, int wc, int fr, int fq) const {
        const int rt = wr * 64 + fr, col0 = u.pn * 256 + wc * 32 + 4 * fq;
        const float* base = (u.pm == 0 ? base_ctx : base_lat + (size_t)(u.pm - 1) * 256 * D) + (size_t)rt * D + col0; const float* gate = (u.pm == 0 ? gate_ctx : gate_lat) + col0;
        float* op = Xo + (size_t)(u.pm * 256 + rt) * D + col0;
#pragma unroll
        for (int bj = 0; bj < 2; ++bj)
#pragma unroll
            for (int n = 0; n < 2; ++n) { const f32x4 gv = *(const f32x4*)(gate + bj * 128 + n * 16);
#pragma unroll
                for (int ai = 0; ai < 2; ++ai) {
#pragma unroll
                    for (int m = 0; m < 4; ++m) { const size_t o = (size_t)(ai * 128 + m * 16) * D + bj * 128 + n * 16; const f32x4 b = *(const f32x4*)(base + o); *(f32x4*)(op + o) = b + gv * acc[ai][bj][m][n]; }
                    asm volatile("" ::: "memory"); } }
    }
};
struct EpiAct {
    static constexpr bool PERM = true; bf16_t* ACTo; const float* bias;
    __device__ __forceinline__ void operator()(const f32x4 (&acc)[2][2][4][2], const pg8::Unit& u, int wr, int wc, int fr, int fq) const {
        const int x0 = wc * 32 + 8 * fq; const float* bg = bias + (size_t)u.e * 2048 + 128 * u.pn + x0; const float* bu = bg + 1024;
        const f32x4 g0 = *(const f32x4*)bg, g1 = *(const f32x4*)(bg + 4), u0 = *(const f32x4*)bu, u1 = *(const f32x4*)(bu + 4);
#pragma unroll
        for (int ai = 0; ai < 2; ++ai)
#pragma unroll
            for (int m = 0; m < 4; ++m) { const int row = u.pm * 256 + ai * 128 + wr * 64 + m * 16 + fr;
                const f32x4 ga = acc[ai][0][m][0] + g0, gb = acc[ai][0][m][1] + g1, ua = acc[ai][1][m][0] + u0, ub = acc[ai][1][m][1] + u1; float r[8];
#pragma unroll
                for (int j = 0; j < 4; ++j) { const float g = fminf(ga[j], 7.f), up = fminf(fmaxf(ua[j], -7.f), 7.f); r[j] = (up + 1.f) * (g * fsigm(1.702f * g));
                                              const float g2 = fminf(gb[j], 7.f), up2 = fminf(fmaxf(ub[j], -7.f), 7.f); r[4 + j] = (up2 + 1.f) * (g2 * fsigm(1.702f * g2)); }
                u32x4 w; w.x = cvt_pk_bf16(r[0], r[1]); w.y = cvt_pk_bf16(r[2], r[3]); w.z = cvt_pk_bf16(r[4], r[5]); w.w = cvt_pk_bf16(r[6], r[7]);
                *(u32x4*)(ACTo + (size_t)row * D + 128 * u.pn + x0) = w; }
    }
};
struct EpiY {
    static constexpr bool PERM = true; bf16_t* Yo; const float* bias;
    __device__ __forceinline__ void operator()(const f32x4 (&acc)[2][2][4][2], const pg8::Unit& u, int wr, int wc, int fr, int fq) const {
        const int row0 = u.pm * 256 + wr * 64 + fr, col0 = u.pn * 256 + wc * 32 + 8 * fq; const float* bp = bias + (size_t)u.e * D + col0;
        f32x4 bv[2][2];
#pragma unroll
        for (int bj = 0; bj < 2; ++bj)
#pragma unroll
            for (int n = 0; n < 2; ++n) bv[bj][n] = *(const f32x4*)(bp + bj * 128 + 4 * n);
#pragma unroll
        for (int ai = 0; ai < 2; ++ai)
#pragma unroll
            for (int m = 0; m < 4; ++m) { bf16_t* rowp = Yo + (size_t)(row0 + ai * 128 + m * 16) * D + col0;
#pragma unroll
                for (int bj = 0; bj < 2; ++bj) { const f32x4 v0 = acc[ai][bj][m][0] + bv[bj][0], v1 = acc[ai][bj][m][1] + bv[bj][1];
                    u32x4 w; w.x = cvt_pk_bf16(v0[0], v0[1]); w.y = cvt_pk_bf16(v0[2], v0[3]); w.z = cvt_pk_bf16(v1[0], v1[1]); w.w = cvt_pk_bf16(v1[2], v1[3]);
                    *(u32x4*)(rowp + bj * 128) = w; } }
    }
};

__device__ __forceinline__ unsigned pk4_fp8(float a, float b, float c, float d) { int r = __builtin_amdgcn_cvt_pk_fp8_f32(a, b, 0, false); r = __builtin_amdgcn_cvt_pk_fp8_f32(c, d, r, true); return (unsigned)r; }
struct EpiAct8 {
    static constexpr bool PERM = true; unsigned char* ACTo; const float* bias;
    __device__ __forceinline__ void operator()(const f32x4 (&acc)[2][2][4][2], const pg8::Unit& u, int wr, int wc, int fr, int fq) const {
        const int x0 = wc * 32 + 8 * fq; const float* bg = bias + (size_t)u.e * 2048 + 128 * u.pn + x0; const float* bu = bg + 1024; constexpr float isc = 1.f / (FP8_SH * FP8_SW);
        f32x2 g[4], v[4];
#pragma unroll
        for (int p = 0; p < 4; ++p) { g[p] = *(const f32x2*)(bg + 2 * p); v[p] = *(const f32x2*)(bu + 2 * p); }
#pragma unroll
        for (int ai = 0; ai < 2; ++ai)
#pragma unroll
            for (int m = 0; m < 4; ++m) { const int row = u.pm * 256 + ai * 128 + wr * 64 + m * 16 + fr; f32x2 r[4];
#pragma unroll
                for (int p = 0; p < 4; ++p) { const f32x4 ga4 = acc[ai][0][m][p >> 1], ua4 = acc[ai][1][m][p >> 1];
                    f32x2 gg = (f32x2){ga4[2 * (p & 1)], ga4[2 * (p & 1) + 1]} * isc + g[p], uu = (f32x2){ua4[2 * (p & 1)], ua4[2 * (p & 1) + 1]} * isc + v[p];
                    gg.x = fminf(gg.x, 7.f); gg.y = fminf(gg.y, 7.f); uu.x = __builtin_amdgcn_fmed3f(uu.x, -7.f, 7.f); uu.y = __builtin_amdgcn_fmed3f(uu.y, -7.f, 7.f);
                    const f32x2 ex = gg * (-1.702f * 1.44269504f); f32x2 d; d.x = __builtin_amdgcn_exp2f(ex.x); d.y = __builtin_amdgcn_exp2f(ex.y); d = d + 1.0f;
                    f32x2 rc; rc.x = __builtin_amdgcn_rcpf(d.x); rc.y = __builtin_amdgcn_rcpf(d.y);
                    r[p] = (uu * FP8_SA + FP8_SA) * (gg * rc); }
                u32x2 w; w.x = pk4_fp8(r[0].x, r[0].y, r[1].x, r[1].y); w.y = pk4_fp8(r[2].x, r[2].y, r[3].x, r[3].y);
                *(u32x2*)(ACTo + (size_t)row * D + 128 * u.pn + x0) = w; }
    }
};
struct EpiY8 {
    static constexpr bool PERM = true; bf16_t* Yo; const float* bias;
    __device__ __forceinline__ void operator()(const f32x4 (&acc)[2][2][4][2], const pg8::Unit& u, int wr, int wc, int fr, int fq) const {
        const int row0 = u.pm * 256 + wr * 64 + fr, col0 = u.pn * 256 + wc * 32 + 8 * fq; const float* bp = bias + (size_t)u.e * D + col0; constexpr float isc = 1.f / (FP8_SA * FP8_SW);
        f32x4 bv[2][2];
#pragma unroll
        for (int bj = 0; bj < 2; ++bj)
#pragma unroll
            for (int n = 0; n < 2; ++n) bv[bj][n] = *(const f32x4*)(bp + bj * 128 + 4 * n);
#pragma unroll
        for (int ai = 0; ai < 2; ++ai)
#pragma unroll
            for (int m = 0; m < 4; ++m) { bf16_t* rowp = Yo + (size_t)(row0 + ai * 128 + m * 16) * D + col0;
#pragma unroll
                for (int bj = 0; bj < 2; ++bj) { const f32x4 v0 = acc[ai][bj][m][0] * isc + bv[bj][0], v1 = acc[ai][bj][m][1] * isc + bv[bj][1];
                    u32x4 w; w.x = cvt_pk_bf16(v0[0], v0[1]); w.y = cvt_pk_bf16(v0[2], v0[3]); w.z = cvt_pk_bf16(v1[0], v1[1]); w.w = cvt_pk_bf16(v1[2], v1[3]);
                    *(u32x4*)(rowp + bj * 128) = w; } }
    }
};

struct CvtJob { const float* W; bf16_t* WT; int N, K, k0, n0, nrow0; };
__device__ __forceinline__ void cvt_load(const CvtJob& j, int lane, f32x4 (&r)[16]) { const GAS f32x4* src = (const GAS f32x4*)((const GAS float*)j.W + (unsigned)((j.k0 + 8 * (lane >> 3)) * j.N + j.n0 + 8 * (lane & 7)));
    const unsigned rs = (unsigned)j.N >> 2;
#pragma unroll
    for (int i = 0; i < 8; ++i) { r[2 * i] = src[i * rs]; r[2 * i + 1] = src[i * rs + 1]; } }
__device__ __forceinline__ void cvt_store(const CvtJob& j, int lane, const f32x4 (&r)[16]) {
    u32x4 b[8];
#pragma unroll
    for (int i = 0; i < 8; ++i) { b[i].x = cvt_pk_bf16(r[2 * i][0], r[2 * i][1]); b[i].y = cvt_pk_bf16(r[2 * i][2], r[2 * i][3]); b[i].z = cvt_pk_bf16(r[2 * i + 1][0], r[2 * i + 1][1]); b[i].w = cvt_pk_bf16(r[2 * i + 1][2], r[2 * i + 1][3]); }
    GAS u32x4* dst = (GAS u32x4*)((GAS bf16_t*)j.WT + (unsigned)((j.nrow0 + 8 * (lane & 7)) * j.K + j.k0 + 8 * (lane >> 3))); const unsigned rs = (unsigned)j.K >> 3;
#pragma unroll
    for (int q = 0; q < 8; ++q) { const unsigned sel = (q & 1) ? 0x07060302u : 0x05040100u; u32x4 o;
        o.x = __builtin_amdgcn_perm(b[1][q >> 1], b[0][q >> 1], sel); o.y = __builtin_amdgcn_perm(b[3][q >> 1], b[2][q >> 1], sel);
        o.z = __builtin_amdgcn_perm(b[5][q >> 1], b[4][q >> 1], sel); o.w = __builtin_amdgcn_perm(b[7][q >> 1], b[6][q >> 1], sel);
        dst[q * rs] = o; } }
__device__ __forceinline__ void cvt8_load(const CvtJob& j, int lane, f32x4 (&r)[16]) { const GAS f32x4* src = (const GAS f32x4*)((const GAS float*)j.W + (unsigned)((j.k0 + 16 * (lane >> 3)) * j.N + j.n0 + 4 * (lane & 7)));
    const unsigned rs = (unsigned)j.N >> 2;
#pragma unroll
    for (int i = 0; i < 16; ++i) r[i] = src[i * rs]; }
__device__ __forceinline__ void cvt8_store(const CvtJob& j, int lane, const f32x4 (&r)[16]) {
    GAS u32x4* dst = (GAS u32x4*)((GAS unsigned char*)j.WT + (unsigned)((j.nrow0 + 4 * (lane & 7)) * j.K + j.k0 + 16 * (lane >> 3))); const unsigned rs = (unsigned)j.K >> 4;
#pragma unroll
    for (int n = 0; n < 4; ++n) { u32x4 o;
        o.x = pk4_fp8(r[0][n] * FP8_SW, r[1][n] * FP8_SW, r[2][n] * FP8_SW, r[3][n] * FP8_SW); o.y = pk4_fp8(r[4][n] * FP8_SW, r[5][n] * FP8_SW, r[6][n] * FP8_SW, r[7][n] * FP8_SW);
        o.z = pk4_fp8(r[8][n] * FP8_SW, r[9][n] * FP8_SW, r[10][n] * FP8_SW, r[11][n] * FP8_SW); o.w = pk4_fp8(r[12][n] * FP8_SW, r[13][n] * FP8_SW, r[14][n] * FP8_SW, r[15][n] * FP8_SW);
        dst[n * rs] = o; } }
constexpr int NB_IN = (FQ_OFF < DIN ? FQ_OFF : DIN) / 64, I_IN = 16 * NB_IN, I_OUT = 16 * 16, I_GU = MOE_FP8 ? 8 * 64 : 16 * 32, I_DN = MOE_FP8 ? 8 * 32 : 16 * 16;
constexpr int N_IN = 2 * I_IN, N_OUT = 2 * I_OUT, N_GU = 2 * NE * I_GU, N_DN = 2 * NE * I_DN, N_CVT = N_IN + N_OUT + N_GU + N_DN;
__device__ __forceinline__ CvtJob cvt_job(const Frame& F, int it, bool& f8) {
    CvtJob j; int r = it; f8 = false;
    if (r < N_IN) { const int l = r / I_IN, q = r % I_IN, kb = q / NB_IN, nb = q % NB_IN; j = CvtJob{F.w_in() + (size_t)l * D * DIN, F.Wt_in() + (size_t)l * DINX * D, DIN, D, 64 * kb, 64 * nb, 64 * nb}; return j; } r -= N_IN;
    if (r < N_OUT) { const int l = r / I_OUT, q = r % I_OUT, kb = q >> 4, nb = q & 15; j = CvtJob{F.w_out() + (size_t)l * D * D, F.Wt_out() + (size_t)l * D * D, D, D, 64 * kb, 64 * nb, 64 * nb}; return j; } r -= N_OUT;
    f8 = MOE_FP8;
    if (r < N_GU) { const int le = r / I_GU, q = r % I_GU; const int kb = MOE_FP8 ? q >> 6 : q >> 5, nb = MOE_FP8 ? q & 63 : q & 31; const int n0 = (MOE_FP8 ? 32 : 64) * nb, bj = n0 >> 10, xx = n0 & 1023;
        j = CvtJob{F.w_gu() + (size_t)le * D * 2048, (bf16_t*)((unsigned char*)F.Wt_gu() + (size_t)le * 2048 * D * (MOE_FP8 ? 1 : 2)), 2048, D, (MOE_FP8 ? 128 : 64) * kb, n0, 256 * (xx >> 7) + 128 * bj + (xx & 127)}; return j; } r -= N_GU;
    { const int le = r / I_DN, q = r % I_DN; const int kb = MOE_FP8 ? q >> 5 : q >> 4, nb = MOE_FP8 ? q & 31 : q & 15; const int n0 = (MOE_FP8 ? 32 : 64) * nb;
      j = CvtJob{F.w_dn() + (size_t)le * D * D, (bf16_t*)((unsigned char*)F.Wt_dn() + (size_t)le * D * D * (MOE_FP8 ? 1 : 2)), D, D, (MOE_FP8 ? 128 : 64) * kb, n0, n0}; return j; }
}
__device__ __forceinline__ void cvt_ld(const CvtJob& j, bool f8, int lane, f32x4 (&r)[16]) { if (f8) cvt8_load(j, lane, r); else cvt_load(j, lane, r); }
__device__ __forceinline__ void cvt_st(const CvtJob& j, bool f8, int lane, const f32x4 (&r)[16]) { if (f8) cvt8_store(j, lane, r); else cvt_store(j, lane, r); }
constexpr int WIN_UNITS = (T / 256) * (DINX / 256), WIN_BUSY = WIN_UNITS % 256, DEF_WIN = MOE_FP8 ? 3 : 0, DEF_WOUT = MOE_FP8 ? 3 : 0;
constexpr int DEF_A = (256 - WIN_BUSY) * NWAVES * DEF_WIN, DEF_B = (256 - 4) * NWAVES * DEF_WOUT, DEF_C = DEF_A, DEF_TOTAL = DEF_A + DEF_B + DEF_C;
constexpr int CVT_GU0 = N_IN + N_OUT, CVT_GU1 = CVT_GU0 + NE * I_GU;
static_assert(DEF_A + DEF_B <= NE * I_GU && DEF_C <= NE * I_GU, "deferred slices inside one layer's gate/up items");
__device__ __forceinline__ int cvt_remap(int j) { int it = j; if (it >= CVT_GU0) it += DEF_A + DEF_B; if (it >= CVT_GU1) it += DEF_C; return it; }
__device__ __forceinline__ void cvt_run(Frame& F, int first, int stride, int limit, bool remap) {
    int it = first; if (it >= limit) return;
    f32x4 ra[16], rb[16]; bool fa, fb = false; CvtJob ja = cvt_job(F, remap ? cvt_remap(it) : it, fa), jb; cvt_ld(ja, fa, F.lane, ra);
    for (;;) {
        const int itb = it + stride; const bool hb = itb < limit; if (hb) { jb = cvt_job(F, remap ? cvt_remap(itb) : itb, fb); cvt_ld(jb, fb, F.lane, rb); }
        cvt_st(ja, fa, F.lane, ra); if (!hb) break;
        const int ita = itb + stride; const bool ha = ita < limit; if (ha) { ja = cvt_job(F, remap ? cvt_remap(ita) : ita, fa); cvt_ld(ja, fa, F.lane, ra); }
        cvt_st(jb, fb, F.lane, rb); if (!ha) break;
        it = ita;
    }
}
__device__ __forceinline__ void cvt_deferred(Frame& F, int base, int slot, int per_wave) { if (per_wave == 0) return; const int first = base + (slot * NWAVES + F.wave) * per_wave; cvt_run(F, first, 1, first + per_wave, false); }
__device__ __forceinline__ void ph_prologue(Frame& F) {
    const int gw = F.vcu * NWAVES + F.wave, NGW = F.G * NWAVES;
    for (int i = gw * 64 + F.lane; i < 1024; i += NGW * 64) { const float a = F.lbp()[i], b = F.lbp()[1024 + i], m = fmaxf(a, b), ea = __expf(a - m), eb = __expf(b - m); F.LB()[i] = 0.f; F.LB()[1024 + i] = eb / (ea + eb); }
    if (F.bid < 192) {
        LAS float* sc = (LAS float*)(F.lds); LAS float* part = sc + 2048;
        { const float* c = F.c(); const float* cc = F.cctx(); for (int i = F.tid; i < D; i += NTHR) { const float a = c[i], b = cc[i]; sc[i] = a * fsigm(a); sc[D + i] = b * fsigm(b); } }
        __syncthreads();
        const int l = F.bid / 96, jcol = (F.bid % 96) * 64 + F.lane; const GAS float* W = (const GAS float*)F.w_ada() + (unsigned)(l * D * 6144 + (128 * F.wave) * 6144 + jcol); float a0 = 0.f, a1 = 0.f;
#pragma unroll 16
        for (int i = 0; i < 128; ++i) { const float w = W[(unsigned)i * 6144u]; a0 += sc[128 * F.wave + i] * w; a1 += sc[D + 128 * F.wave + i] * w; }
        part[(F.wave * 2 + 0) * 64 + F.lane] = a0; part[(F.wave * 2 + 1) * 64 + F.lane] = a1;
        __syncthreads();
        if (F.tid < 128) { const int which = F.tid >> 6, col = F.tid & 63; float s = 0.f;
#pragma unroll
            for (int w = 0; w < 8; ++w) s += part[(w * 2 + which) * 64 + col];
            const int j = (F.bid % 96) * 64 + col; F.MOD()[(size_t)(l * 2 + which) * 6144 + j] = s + F.b_ada()[l * 6144 + j]; }
        __syncthreads();
    }
    cvt_run(F, gw, NGW, N_CVT - DEF_TOTAL, true);
}
__device__ __forceinline__ void row_load(const float* xrow, int lane, f32x4 (&v)[4]) { const GAS f32x4* xr = (const GAS f32x4*)xrow + lane;
#pragma unroll
    for (int j = 0; j < 4; ++j) v[j] = xr[64 * j]; }
__device__ __forceinline__ float row_rstd(const f32x4 (&v)[4], int lane) { float s = 0.f;
#pragma unroll
    for (int j = 0; j < 4; ++j) s += (v[j].x * v[j].x + v[j].y * v[j].y) + (v[j].z * v[j].z + v[j].w * v[j].w);
    return rsqrtf(wave_sum(s, lane) * (1.f / D) + 1e-6f); }
__device__ __forceinline__ void row_modulate(const f32x4 (&v)[4], float r, const float* g, const float* sc, const float* sh, int lane, f32x4 (&hv)[4]) {
#pragma unroll
    for (int j = 0; j < 4; ++j) { const f32x4 gg = ((const GAS f32x4*)g)[lane + 64 * j], s1 = ((const GAS f32x4*)sc)[lane + 64 * j], s0 = ((const GAS f32x4*)sh)[lane + 64 * j];
        hv[j] = v[j] * r * gg * (s1 + 1.f) + s0; } }
__device__ __forceinline__ void row_store_fp8(unsigned char* orow, int lane, const f32x4 (&hv)[4]) { GAS unsigned* o4 = (GAS unsigned*)orow + lane;
#pragma unroll
    for (int j = 0; j < 4; ++j) o4[64 * j] = pk4_fp8(hv[j].x * FP8_SH, hv[j].y * FP8_SH, hv[j].z * FP8_SH, hv[j].w * FP8_SH); }
__device__ __forceinline__ void row_store_bf16(bf16_t* orow, int lane, const f32x4 (&hv)[4]) { GAS u32x2* o8 = (GAS u32x2*)orow + lane;
#pragma unroll
    for (int j = 0; j < 4; ++j) { u32x2 w; w.x = pk2(hv[j].x, hv[j].y); w.y = pk2(hv[j].z, hv[j].w); o8[64 * j] = w; } }

__device__ __forceinline__ void ph_mod1(Frame& F, int l) {
    const int gw = F.vcu * NWAVES + F.wave, NGW = F.G * NWAVES;
    for (int row = gw; row < T; row += NGW) {
        const float* xr = l == 0 ? (row < CTX ? F.ctxin() + (size_t)row * D : F.x() + (size_t)(row - CTX) * D) : F.X() + (size_t)row * D;
        const float* m = F.MOD() + (size_t)(l * 2 + (row < CTX ? 1 : 0)) * 6144;
        f32x4 v[4], hv[4]; row_load(xr, F.lane, v); const float r = row_rstd(v, F.lane); row_modulate(v, r, F.norm1_g() + l * D, m + D, m, F.lane, hv); row_store_bf16(F.H() + (size_t)row * D, F.lane, hv);
    }
}

constexpr int RA_ST = 2064, RA_HALF = 16 * RA_ST, RA_BUF = 2 * RA_HALF;
constexpr int RLG_OFF = 2 * RA_BUF, RSCR_OFF = RLG_OFF + 8592;
static_assert(8 * 80 * 32 * 4 <= RLG_OFF && 65 * 33 * 4 <= 8592 && RSCR_OFF + 3520 <= MISC_OFF && RSCR_OFF % 16 == 0, "router LDS map");
__device__ __forceinline__ void split2(float a, float b, unsigned& hi, unsigned& lo) { hi = cvt_pk_bf16(a, b); lo = cvt_pk_bf16(a - bflo(hi), b - bfhi(hi)); }
__device__ __forceinline__ void ph_mod2_route(Frame& F, int l, int cbank) {
    LAS unsigned char* L = F.lds + RING_OFF; LAS float* LG = (LAS float*)(L + RLG_OFF);
    LAS int* lcnt = (LAS int*)(L + RSCR_OFF); LAS int* lbase = lcnt + 32; LAS int* te = lbase + 32; LAS float* tw = (LAS float*)(te + 272); LAS int* trk = (LAS int*)(tw + 272);
    int ln = F.lane; asm volatile("" : "+v"(ln)); const int w = F.wave, fr = ln & 15, g = ln >> 4;
    __syncthreads();
    if (F.tid < 32) lcnt[F.tid] = 0;
    const int row0 = F.bid * 65;
    const float* Xp = F.X(); const float* n2g = F.norm2_g() + l * D; const float* modl = F.MOD() + (size_t)(l * 2) * 6144; bf16_t* Hp = F.H(); unsigned char* H8p = F.ws + WS_H8;
    f32x4 v[2][4];
#pragma unroll
    for (int i = 0; i < 2; ++i) row_load(Xp + (size_t)(row0 + min(2 * w + i, 64)) * D, ln, v[i]);
    bf16x8 Bh[4][2], Bl[4][2];
    { const GAS float* rw = (const GAS float*)F.router_w() + (unsigned)(l * D * NE + (128 * w + 8 * g) * NE + fr);
#pragma unroll
      for (int s_ = 0; s_ < 4; ++s_)
#pragma unroll
          for (int nb = 0; nb < 2; ++nb) { float x[8];
#pragma unroll
              for (int i = 0; i < 8; ++i) x[i] = rw[(32 * s_ + i) * NE + 16 * nb];
              unsigned h_[4], l_[4]; split2(x[0], x[1], h_[0], l_[0]); split2(x[2], x[3], h_[1], l_[1]); split2(x[4], x[5], h_[2], l_[2]); split2(x[6], x[7], h_[3], l_[3]); const u32x4 hi = (u32x4){h_[0], h_[1], h_[2], h_[3]}, lo = (u32x4){l_[0], l_[1], l_[2], l_[3]};
              Bh[s_][nb] = __builtin_bit_cast(bf16x8, hi); Bl[s_][nb] = __builtin_bit_cast(bf16x8, lo); } }
    f32x4 acc[5][2];
#pragma unroll
    for (int b = 0; b < 5; ++b) { acc[b][0] = (f32x4){0.f, 0.f, 0.f, 0.f}; acc[b][1] = (f32x4){0.f, 0.f, 0.f, 0.f}; }
#pragma unroll
    for (int b = 0; b < 5; ++b) {
        LAS unsigned char* Ab = L + (b & 1) * RA_BUF;
#pragma unroll
        for (int i = 0; i < 2; ++i) { const int lr = 16 * b + 2 * w + i, row = row0 + min(lr, 64); const float* m = modl + (row < CTX ? 6144 : 0);
            const float rs = row_rstd(v[i], ln); f32x4 h[4]; row_modulate(v[i], rs, n2g, m + 4 * D, m + 3 * D, ln, h);
            if (lr < 65) { if (MOE_FP8) row_store_fp8(H8p + (size_t)row * D, ln, h); else row_store_bf16(Hp + (size_t)row * D, ln, h); }
#pragma unroll
            for (int j = 0; j < 4; ++j) { unsigned h0, l0, h1, l1; split2(h[j].x, h[j].y, h0, l0); split2(h[j].z, h[j].w, h1, l1); const u32x2 hi = (u32x2){h0, h1}, lo = (u32x2){l0, l1};
                LAS unsigned char* ap = Ab + (2 * w + i) * RA_ST + (4 * ln + 256 * j) * 2; *(LAS u32x2*)ap = hi; *(LAS u32x2*)(ap + RA_HALF) = lo; } }
        if (b < 4) {
#pragma unroll
            for (int i = 0; i < 2; ++i) row_load(Xp + (size_t)(row0 + min(16 * (b + 1) + 2 * w + i, 64)) * D, ln, v[i]); }
        __syncthreads();
#pragma unroll
        for (int s_ = 0; s_ < 4; ++s_) { const LAS unsigned char* ap = Ab + fr * RA_ST + (128 * w + 32 * s_ + 8 * g) * 2; const bf16x8 ah = *(const LAS bf16x8*)ap, al = *(const LAS bf16x8*)(ap + RA_HALF);
#pragma unroll
            for (int nb = 0; nb < 2; ++nb) { f32x4 c = acc[b][nb]; c = __builtin_amdgcn_mfma_f32_16x16x32_bf16(ah, Bh[s_][nb], c, 0, 0, 0); c = __builtin_amdgcn_mfma_f32_16x16x32_bf16(ah, Bl[s_][nb], c, 0, 0, 0);
                c = __builtin_amdgcn_mfma_f32_16x16x32_bf16(al, Bh[s_][nb], c, 0, 0, 0); acc[b][nb] = c; } }
    }
    __syncthreads();
    { LAS float* PT = (LAS float*)L;
#pragma unroll
      for (int b = 0; b < 5; ++b)
#pragma unroll
          for (int nb = 0; nb < 2; ++nb)
#pragma unroll
              for (int r = 0; r < 4; ++r) PT[(w * 80 + 16 * b + 4 * g + r) * 32 + 16 * nb + fr] = acc[b][nb][r];
      __syncthreads();
      for (int i = F.tid; i < 65 * 32; i += NTHR) { const int row = i >> 5, e = i & 31; float sacc = F.router_b()[l * NE + e];
#pragma unroll
          for (int w2 = 0; w2 < 8; ++w2) sacc += PT[(w2 * 80 + row) * 32 + e];
          LG[row * 33 + e] = sacc; } }
    __syncthreads();
    if (F.tid < 65) { const int row = F.tid; float bv[4] = {-3.0e38f, -3.0e38f, -3.0e38f, -3.0e38f}; int bi[4] = {0, 0, 0, 0};
#pragma unroll
        for (int e = 0; e < 32; ++e) { const float x = LG[row * 33 + e]; const bool c0 = x > bv[0], c1 = x > bv[1], c2 = x > bv[2], c3 = x > bv[3];
            bv[3] = c2 ? bv[2] : (c3 ? x : bv[3]); bi[3] = c2 ? bi[2] : (c3 ? e : bi[3]); bv[2] = c1 ? bv[1] : (c2 ? x : bv[2]); bi[2] = c1 ? bi[1] : (c2 ? e : bi[2]);
            bv[1] = c0 ? bv[0] : (c1 ? x : bv[1]); bi[1] = c0 ? bi[0] : (c1 ? e : bi[1]); bv[0] = c0 ? x : bv[0]; bi[0] = c0 ? e : bi[0]; }
        float ex[4], sum = 0.f;
#pragma unroll
        for (int q = 0; q < 4; ++q) { ex[q] = __expf(bv[q] - bv[0]); sum += ex[q]; }
        const float inv = 1.f / sum;
#pragma unroll
        for (int q = 0; q < 4; ++q) { te[row * 4 + q] = bi[q]; tw[row * 4 + q] = ex[q] * inv; trk[row * 4 + q] = (int)__hip_atomic_fetch_add((LAS unsigned*)&lcnt[bi[q]], 1u, __ATOMIC_RELAXED, __HIP_MEMORY_SCOPE_WORKGROUP); } }
    __syncthreads();
    if (F.tid < 32) lbase[F.tid] = (int)__hip_atomic_fetch_add((unsigned*)(F.ctl() + CW_CNT + (cbank * 32 + F.tid) * 64), (unsigned)lcnt[F.tid], RLX_AGENT);
    __syncthreads();
    for (int i = F.tid; i < 65 * 4; i += NTHR) { const int row = row0 + (i >> 2), e = te[i], pos = lbase[e] + trk[i];
        F.TOPI()[row * 4 + (i & 3)] = e; F.TOPW()[row * 4 + (i & 3)] = tw[i]; F.POS()[row * 4 + (i & 3)] = pos; F.LISTE()[(size_t)e * T + pos] = row; }
    __syncthreads();
}

__device__ __forceinline__ int moe_tiles(Frame& F, int l) {
    LAS int* tinfo = (LAS int*)(F.lds + TINFO_OFF); LAS int* bt = (LAS int*)(F.lds + BT_OFF); LAS int* cn = bt + 32; LAS int* ntl = bt + 64;
    __syncthreads();
    if (F.tid < 64) {
        const int e = F.lane & 31; const int c = (int)__hip_atomic_load(F.ctl() + CW_CNT + (l * 32 + e) * 64, RLX_AGENT); const int nt = (c + 255) >> 8;
        int incl = nt;
#pragma unroll
        for (int o = 1; o < 32; o <<= 1) { const int t = lane_get(incl, (F.lane - o) & 63); if (e >= o) incl += t; }
        const int first = incl - nt;
        if (F.lane < 32) { bt[e] = first; cn[e] = c; for (int j = 0; j < nt; ++j) { LAS int* ti = tinfo + 4 * (first + j); ti[0] = e; ti[1] = 0; ti[2] = 256 * j; ti[3] = min(256, c - 256 * j); } if (e == 31) ntl[0] = incl; }
    }
    __syncthreads();
    return ntl[0];
}

__device__ __forceinline__ void ph_gateup(Frame& F, int l) {
    const int ntiles = moe_tiles(F, l); constexpr int EB = MOE_FP8 ? 1 : 2;
    LAS int* tinfo = (LAS int*)(F.lds + TINFO_OFF); LAS unsigned* rowoff = (LAS unsigned*)(F.lds + ROWOFF_OFF);
    MoeOrder<true> S; S.tinfo = tinfo; S.rowoff = rowoff; S.ntiles = ntiles; S.nN = 8; S.G = F.G; S.c = F.vcu; S.Kb = D * EB; S.W = (const char*)F.Wt_gu() + (size_t)l * NE * 2048 * D * EB; S.wstride = (size_t)2048 * D * EB;
    for (int i = 0;; ++i) { pg8::Unit u; if (!S.next(i, u) || i >= 10) break;
        if (F.tid < 256) { const int pos0 = tinfo[4 * u.pm + 2], valid = tinfo[4 * u.pm + 3]; const int tok = F.tid < valid ? F.LISTE()[(size_t)u.e * T + pos0 + F.tid] : 0; rowoff[i * 256 + F.tid] = (unsigned)tok * (unsigned)(D * EB); } }
    __syncthreads();
    if constexpr (MOE_FP8) { EpiAct8 E{(unsigned char*)F.ACT(), F.b_gu() + (size_t)l * NE * 2048};
        pg8::gemm_phase<EpiAct8, MoeOrder<true>, true, true>(F.lds + RING_OFF, (const char*)(F.ws + WS_H8), D, S, E, F.tid); }
    else { EpiAct E{F.ACT(), F.b_gu() + (size_t)l * NE * 2048};
        pg8::gemm_phase<EpiAct, MoeOrder<true>, true, false>(F.lds + RING_OFF, (const char*)F.H(), 2 * D, S, E, F.tid); }
}
__device__ __forceinline__ void ph_down(Frame& F, int l) {
    const int ntiles = moe_tiles(F, l); constexpr int EB = MOE_FP8 ? 1 : 2;
    MoeOrder<false> S; S.tinfo = (LAS int*)(F.lds + TINFO_OFF); S.rowoff = nullptr; S.ntiles = ntiles; S.nN = 4; S.G = F.G; S.c = F.vcu; S.Kb = D * EB; S.W = (const char*)F.Wt_dn() + (size_t)l * NE * D * D * EB; S.wstride = (size_t)D * D * EB;
    if constexpr (MOE_FP8) { EpiY8 E{F.Y(), F.b_dn() + (size_t)l * NE * D};
        pg8::gemm_phase<EpiY8, MoeOrder<false>, true, true>(F.lds + RING_OFF, (const char*)F.ACT(), D, S, E, F.tid); }
    else { EpiY E{F.Y(), F.b_dn() + (size_t)l * NE * D};
        pg8::gemm_phase<EpiY, MoeOrder<false>, true, false>(F.lds + RING_OFF, (const char*)F.ACT(), 2 * D, S, E, F.tid); }
}
__device__ __forceinline__ void ph_win(Frame& F, int l) {
    DenseOrder S; S.init(T / 256, DINX / 256, F.G, F.bid, 2 * D, F.Wt_in() + (size_t)l * DINX * D);
    EpiP E{F.P(), DINX, F.LB() + l * 1024};
    pg8::gemm_phase<EpiP, DenseOrder, true>(F.lds + RING_OFF, (const char*)F.H(), 2 * D, S, E, F.tid);
    if (F.bid >= WIN_BUSY) cvt_deferred(F, l == 0 ? CVT_GU0 : CVT_GU1, F.bid - WIN_BUSY, DEF_WIN);
}
__device__ __forceinline__ void ph_wout(Frame& F, int l) {
    DenseOrder S; S.init(l == 1 ? LAT / 256 : T / 256, D / 256, F.G, F.bid, 2 * D, F.Wt_out() + (size_t)l * D * D, l == 1 ? 1 : 0);
    const float* m = F.MOD() + (size_t)(l * 2) * 6144;
    EpiRes E{l == 0 ? F.ctxin() : F.X(), l == 0 ? F.x() : F.X() + (size_t)CTX * D, m + 6144 + 2 * D, m + 2 * D, F.X()};
    pg8::gemm_phase<EpiRes, DenseOrder, true>(F.lds + RING_OFF, (const char*)F.CAT(), 2 * D, S, E, F.tid);
    if (l == 0 && F.bid >= 4) cvt_deferred(F, CVT_GU0 + DEF_A, F.bid - 4, DEF_WOUT);
}
__device__ __forceinline__ void combine_gather(const Frame& F, const LAS int* bt, int row, int ln, f32x4 (&v)[4], u32x2 (&y)[4][4], float (&w)[4]) {
    row_load(F.X() + (size_t)row * D, ln, v);
    const GAS int* ti = (const GAS int*)F.TOPI() + (unsigned)(row * 4); const GAS float* tw = (const GAS float*)F.TOPW() + (unsigned)(row * 4); const GAS int* tp = (const GAS int*)F.POS() + (unsigned)(row * 4);
#pragma unroll
    for (int q = 0; q < 4; ++q) { const int e = ti[q]; w[q] = tw[q]; const int srow = 256 * bt[e] + tp[q]; const GAS u32x2* yr = (const GAS u32x2*)((const GAS bf16_t*)F.Y() + (unsigned)srow * (unsigned)D) + ln;
#pragma unroll
        for (int j = 0; j < 4; ++j) y[q][j] = yr[64 * j]; }
}
__device__ __forceinline__ void combine_finish(const Frame& F, int l, int row, int ln, f32x4 (&v)[4], const u32x2 (&y)[4][4], const float (&w)[4]) {
    const float* m = F.MOD() + (size_t)(l * 2 + (row < CTX ? 1 : 0)) * 6144 + 5 * D;
#pragma unroll
    for (int j = 0; j < 4; ++j) { f32x4 s = (f32x4){0.f, 0.f, 0.f, 0.f};
#pragma unroll
        for (int q = 0; q < 4; ++q) s += w[q] * (f32x4){bflo(y[q][j].x), bfhi(y[q][j].x), bflo(y[q][j].y), bfhi(y[q][j].y)};
        v[j] += ((const GAS f32x4*)m)[ln + 64 * j] * s; }
    const float r = row_rstd(v, ln);
    if (l == 0) {
        GAS f32x4* xo = (GAS f32x4*)(F.X() + (size_t)row * D) + ln;
#pragma unroll
        for (int j = 0; j < 4; ++j) xo[64 * j] = v[j];
        const float* m1 = F.MOD() + (size_t)(2 + (row < CTX ? 1 : 0)) * 6144; f32x4 hv[4];
        row_modulate(v, r, F.norm1_g() + D, m1 + D, m1, ln, hv); row_store_bf16(F.H() + (size_t)row * D, ln, hv);
    } else {
        GAS f32x4* o = (GAS f32x4*)(F.out() + (size_t)(row - CTX) * D) + ln; const float* fg = F.fng();
#pragma unroll
        for (int j = 0; j < 4; ++j) o[64 * j] = v[j] * r * ((const GAS f32x4*)fg)[ln + 64 * j];
    }
}
__device__ __forceinline__ void ph_combine(Frame& F, int l) {
    (void)moe_tiles(F, l);
    const LAS int* bt = (const LAS int*)(F.lds + BT_OFF);
    const int gw = F.vcu * NWAVES + F.wave, NGW = F.G * NWAVES; const int rbeg = l == 1 ? CTX : 0;
#pragma unroll 1
    for (int ra = rbeg + gw; ra < T; ra += 2 * NGW) {
        int ln = F.lane; asm volatile("" : "+v"(ln));
        const int rb = ra + NGW; const bool hasb = rb < T; const int rbc = hasb ? rb : ra;
        f32x4 va[4], vb[4]; u32x2 ya[4][4], yb[4][4]; float wa[4], wb[4];
        combine_gather(F, bt, ra, ln, va, ya, wa); combine_gather(F, bt, rbc, ln, vb, yb, wb);
        combine_finish(F, l, ra, ln, va, ya, wa);
        if (hasb) combine_finish(F, l, rb, ln, vb, yb, wb);
    }
}
constexpr size_t WF_MA = 0, WF_MB = 128 * 1024, WF_MC = 256 * 1024, WF_PW = 512 * 1024;
constexpr int ZS = 528;
__device__ __forceinline__ f32x4 mfma16(bf16x8 a, bf16x8 b, f32x4 c) { return __builtin_amdgcn_mfma_f32_16x16x32_bf16(a, b, c, 0, 0, 0); }

__device__ __forceinline__ void ph_prologue2(Frame& F) {
    bf16_t* MA = (bf16_t*)(F.ws + WS_WF + WF_MA); bf16_t* MB = (bf16_t*)(F.ws + WS_WF + WF_MB); bf16_t* MC = (bf16_t*)(F.ws + WS_WF + WF_MC); bf16_t* PW = (bf16_t*)(F.ws + WS_WF + WF_PW);
    const int gt = F.bid * NTHR + F.tid, NT = F.G * NTHR;
    for (int i = gt; i < 256 * 256; i += NT) { const int r = i >> 8, cidx = i & 255, ri = r >> 7, k1 = r & 127, rj = cidx >> 7, t1 = cidx & 127; const float x = 2.f * (float)((k1 * t1) & 127) / 128.f;
        const float cs = cospif(x), sn = sinpif(x); const float v = ri == 0 ? (rj == 0 ? cs : -sn) : (rj == 0 ? -sn : -cs); MA[i] = (bf16_t)f2bf(v); }
    for (int i = gt; i < 128 * 256; i += NT) { const int k2 = i >> 8, cidx = i & 255, rj = cidx >> 7, t2 = cidx & 127; const float x = 2.f * (float)((k2 * t2) & 127) / 128.f; MB[i] = (bf16_t)f2bf(rj == 0 ? cospif(x) : sinpif(x)); }
    for (int i = gt; i < 256 * 512; i += NT) { const int k = i >> 9, cidx = i & 511, rj = cidx >> 8, t = cidx & 255; const float x = 2.f * (float)((k * t) & 255) / 256.f; MC[i] = (bf16_t)f2bf(rj == 0 ? cospif(x) : -sinpif(x)); }
    for (int i = gt; i < 2 * 4 * 64 * 64; i += NT) { const int lg = i >> 12, j = (i >> 6) & 63, ii = i & 63; PW[i] = (bf16_t)f2bf(F.pool_w()[(size_t)lg * 4096 + ii * 64 + j]); }
    LAS float* m12T = (LAS float*)(F.lds);
    LAS float* trig = (LAS float*)(F.lds + 33280);
    LAS float* fws = (LAS float*)(F.lds + 33280 + 512);
    __syncthreads();
    if (F.tid < 64) { trig[F.tid] = cospif(2.f * (float)F.tid / 64.f); trig[64 + F.tid] = sinpif(2.f * (float)F.tid / 64.f); }
    __syncthreads();
    bf16x8 TH[2], TL[2];
    { const int c = 16 * (F.wave >> 1) + (F.lane & 15), g = F.lane >> 4, sel0 = (F.bid & 15) >> 3;
#pragma unroll
      for (int s_ = 0; s_ < 2; ++s_) { float t[8];
#pragma unroll
          for (int i = 0; i < 8; ++i) t[i] = trig[sel0 * 64 + (((32 * s_ + 8 * g + i) * c) & 63)];
          unsigned h_[4], l_[4]; split2(t[0], t[1], h_[0], l_[0]); split2(t[2], t[3], h_[1], l_[1]); split2(t[4], t[5], h_[2], l_[2]); split2(t[6], t[7], h_[3], l_[3]);
          TH[s_] = __builtin_bit_cast(bf16x8, (u32x4){h_[0], h_[1], h_[2], h_[3]}); TL[s_] = __builtin_bit_cast(bf16x8, (u32x4){l_[0], l_[1], l_[2], l_[3]}); } }
    for (int tile = F.bid; tile < 2 * 256; tile += F.G) {
        const int l = tile >> 8, kb = (tile >> 4) & 15, nb = tile & 15, k0 = 64 * kb, n0 = 32 * nb, sel = n0 >> 8, nn0 = n0 & 255;
        const int mb = F.wave >> 1, nh = F.wave & 1, fr = F.lane & 15, g = F.lane >> 4;
        __syncthreads();
        f32x4 wa[8][2];
        { const GAS f32x4* wp = (const GAS f32x4*)((const GAS float*)F.w_in() + (unsigned)(l * D * DIN + (k0 + 16 * mb + fr) * DIN + 2816 + 8 * g));
#pragma unroll
          for (int s_ = 0; s_ < 8; ++s_) { wa[s_][0] = wp[8 * s_]; wa[s_][1] = wp[8 * s_ + 1]; } }
        for (int i = F.tid; i < 256 * 32; i += NTHR) fws[i] = F.four_w()[(size_t)l * 65536 + (size_t)(i >> 5) * 256 + nn0 + (i & 31)];
        __syncthreads();
#pragma unroll
        for (int hh = 0; hh < 4; ++hh) { f32x4 mm = (f32x4){0.f, 0.f, 0.f, 0.f};
#pragma unroll
            for (int s_ = 0; s_ < 2; ++s_) { float t[8];
#pragma unroll
                for (int i = 0; i < 8; ++i) t[i] = fws[(hh * 64 + 32 * s_ + 8 * g + i) * 32 + 16 * nh + fr];
                unsigned h_[4], l_[4]; split2(t[0], t[1], h_[0], l_[0]); split2(t[2], t[3], h_[1], l_[1]); split2(t[4], t[5], h_[2], l_[2]); split2(t[6], t[7], h_[3], l_[3]);
                const bf16x8 BH = __builtin_bit_cast(bf16x8, (u32x4){h_[0], h_[1], h_[2], h_[3]}), BL = __builtin_bit_cast(bf16x8, (u32x4){l_[0], l_[1], l_[2], l_[3]});
                mm = mfma16(TH[s_], BH, mm); mm = mfma16(TH[s_], BL, mm); mm = mfma16(TL[s_], BH, mm); }
            *(LAS f32x4*)(m12T + (16 * nh + fr) * 260 + hh * 64 + 16 * mb + 4 * g) = mm; }
        __syncthreads();
        f32x4 o = (f32x4){0.f, 0.f, 0.f, 0.f};
#pragma unroll
        for (int s_ = 0; s_ < 8; ++s_) { const LAS float* bp = m12T + (16 * nh + fr) * 260 + 32 * s_ + 8 * g; const f32x4 b0 = *(const LAS f32x4*)bp, b1 = *(const LAS f32x4*)(bp + 4);
            unsigned ah[4], al[4], bh[4], bl[4];
            split2(wa[s_][0][0], wa[s_][0][1], ah[0], al[0]); split2(wa[s_][0][2], wa[s_][0][3], ah[1], al[1]); split2(wa[s_][1][0], wa[s_][1][1], ah[2], al[2]); split2(wa[s_][1][2], wa[s_][1][3], ah[3], al[3]);
            split2(b0[0], b0[1], bh[0], bl[0]); split2(b0[2], b0[3], bh[1], bl[1]); split2(b1[0], b1[1], bh[2], bl[2]); split2(b1[2], b1[3], bh[3], bl[3]);
            const bf16x8 AH = __builtin_bit_cast(bf16x8, (u32x4){ah[0], ah[1], ah[2], ah[3]}), AL = __builtin_bit_cast(bf16x8, (u32x4){al[0], al[1], al[2], al[3]});
            const bf16x8 BH = __builtin_bit_cast(bf16x8, (u32x4){bh[0], bh[1], bh[2], bh[3]}), BL = __builtin_bit_cast(bf16x8, (u32x4){bl[0], bl[1], bl[2], bl[3]});
            o = mfma16(AH, BH, o); o = mfma16(AH, BL, o); o = mfma16(AL, BH, o); }
        { float o0 = o[0], o1 = o[1], o2 = o[2], o3 = o[3]; asm volatile("s_nop 15\n\ts_nop 7" : "+v"(o0), "+v"(o1), "+v"(o2), "+v"(o3));
          u32x2 wv; wv.x = pk2(o0, o1); wv.y = pk2(o2, o3);
          *(u32x2*)(F.Wt_in() + (size_t)l * DINX * D + (size_t)(FQ_OFF + n0 + 16 * nh + fr) * D + k0 + 16 * mb + 4 * g) = wv; }
    }
    __syncthreads();
}

template <class SrcF> __device__ __forceinline__ void load_tile_T(LAS unsigned char* zt, const SrcF& src, int tid) {
    const int pg = tid >> 4, cc = tid & 15; u32x4 r[8];
#pragma unroll
    for (int i = 0; i < 8; ++i) r[i] = *(const GAS u32x4*)(src(8 * pg + i) + 8 * cc);
#pragma unroll
    for (int j = 0; j < 8; ++j) { const unsigned sel = (j & 1) ? 0x07060302u : 0x05040100u; u32x4 o;
        o.x = __builtin_amdgcn_perm(r[1][j >> 1], r[0][j >> 1], sel); o.y = __builtin_amdgcn_perm(r[3][j >> 1], r[2][j >> 1], sel);
        o.z = __builtin_amdgcn_perm(r[5][j >> 1], r[4][j >> 1], sel); o.w = __builtin_amdgcn_perm(r[7][j >> 1], r[6][j >> 1], sel);
        *(LAS u32x4*)(zt + (8 * cc + j) * ZS + 16 * pg) = o; }
}
__device__ __forceinline__ void tile_mma(const LAS unsigned char* zt, const bf16_t* mat_row  , f32x4 (&acc)[8], int lane) {
    const int fr = lane & 15, g = lane >> 4;
#pragma unroll
    for (int ks = 0; ks < 8; ++ks) { const bf16x8 b = *(const GAS bf16x8*)(mat_row + 32 * ks + 8 * g);
#pragma unroll
        for (int m = 0; m < 8; ++m) { const bf16x8 a = *(const LAS bf16x8*)(zt + (16 * m + fr) * ZS + (32 * ks + 8 * g) * 2); acc[m] = mfma16(a, b, acc[m]); }
        if (ks & 1) __builtin_amdgcn_sched_barrier(0); }
}
__device__ __forceinline__ void tile_mma2(const LAS unsigned char* zt, const bf16_t* mat_row0, const bf16_t* mat_row1, f32x4 (&acc0)[8], f32x4 (&acc1)[8], int lane) {
    const int fr = lane & 15, g = lane >> 4;
#pragma unroll
    for (int ks = 0; ks < 8; ++ks) { const bf16x8 b0 = *(const GAS bf16x8*)(mat_row0 + 32 * ks + 8 * g), b1 = *(const GAS bf16x8*)(mat_row1 + 32 * ks + 8 * g);
#pragma unroll
        for (int m = 0; m < 8; ++m) { const bf16x8 a = *(const LAS bf16x8*)(zt + (16 * m + fr) * ZS + (32 * ks + 8 * g) * 2); acc0[m] = mfma16(a, b0, acc0[m]); acc1[m] = mfma16(a, b1, acc1[m]); }
        __builtin_amdgcn_sched_barrier(0); }
}
struct SrcA { const bf16_t* P; int t2, hc; __device__ __forceinline__ const bf16_t* operator()(int p) const { const int ri = p >> 7, t1 = p & 127; return P + (size_t)(CTX + 128 * t1 + t2) * DINX + FQ_OFF + ri * 256 + 128 * hc; } };
struct SrcB { const bf16_t* Y; int k1, hc; __device__ __forceinline__ const bf16_t* operator()(int p) const { const int ri = p >> 7, t2 = p & 127; return Y + ((size_t)(k1 * 128 + t2) * 2 + ri) * 256 + 128 * hc; } };
struct SrcC { const bf16_t* P; int ri, hc; __device__ __forceinline__ const bf16_t* operator()(int p) const { return P + (size_t)p * DINX + FQ_OFF + ri * 256 + 128 * hc; } };

__device__ __forceinline__ void fftA_item(Frame& F, int item) {
    const int t2 = item >> 1, hc = item & 1; LAS unsigned char* zt = F.lds + RING_OFF;
    bf16_t* YP = (bf16_t*)(F.ws + WS_YP); const bf16_t* MA = (const bf16_t*)(F.ws + WS_WF + WF_MA);
    __syncthreads();
    load_tile_T(zt, SrcA{F.P(), t2, hc}, F.tid);
    __syncthreads();
    const int fr = F.lane & 15, g = F.lane >> 4, k1 = 16 * F.wave + fr;
    f32x4 ar[8], ai[8];
#pragma unroll
    for (int m = 0; m < 8; ++m) { ar[m] = (f32x4){0.f, 0.f, 0.f, 0.f}; ai[m] = (f32x4){0.f, 0.f, 0.f, 0.f}; }
    tile_mma2(zt, MA + (size_t)k1 * 256, MA + (size_t)(128 + k1) * 256, ar, ai, F.lane);
    const float x = 2.f * (float)(t2 * k1) / 16384.f; const float cs = cospif(x), sn = sinpif(x);
    bf16_t* yr = YP + ((size_t)(k1 * 128 + t2) * 2) * 256 + 128 * hc + 4 * g;
#pragma unroll
    for (int m = 0; m < 8; ++m) { const f32x4 a = ar[m], b = ai[m]; const f32x4 pr = a * cs + b * sn, pi = b * cs - a * sn;
        u32x2 w; w.x = pk2(pr[0], pr[1]); w.y = pk2(pr[2], pr[3]); *(u32x2*)(yr + 16 * m) = w;
        u32x2 v; v.x = pk2(pi[0], pi[1]); v.y = pk2(pi[2], pi[3]); *(u32x2*)(yr + 256 + 16 * m) = v; }
}
__device__ __forceinline__ void fftB_item(Frame& F, int item) {
    const int k1 = item >> 1, hc = item & 1; LAS unsigned char* zt = F.lds + RING_OFF;
    const bf16_t* YP = (const bf16_t*)(F.ws + WS_YP); const bf16_t* MB = (const bf16_t*)(F.ws + WS_WF + WF_MB);
    __syncthreads();
    load_tile_T(zt, SrcB{YP, k1, hc}, F.tid);
    __syncthreads();
    const int fr = F.lane & 15, g = F.lane >> 4, k2 = 16 * F.wave + fr;
    f32x4 acc[8];
#pragma unroll
    for (int m = 0; m < 8; ++m) acc[m] = (f32x4){0.f, 0.f, 0.f, 0.f};
    tile_mma(zt, MB + (size_t)k2 * 256, acc, F.lane);
    bf16_t* o = F.CAT() + (size_t)(CTX + k1 + 128 * k2) * D + 768 + 128 * hc + 4 * g;
#pragma unroll
    for (int m = 0; m < 8; ++m) { const f32x4 a = acc[m] * (1.f / 1024.f); u32x2 w; w.x = pk2(a[0], a[1]); w.y = pk2(a[2], a[3]); *(u32x2*)(o + 16 * m) = w; }
}
__device__ __forceinline__ void fftC_item(Frame& F, int item) {
    const int kh = item >> 1, hc = item & 1; LAS unsigned char* zt = F.lds + RING_OFF; const bf16_t* MC = (const bf16_t*)(F.ws + WS_WF + WF_MC);
    const int fr = F.lane & 15, g = F.lane >> 4, k = 128 * kh + 16 * F.wave + fr;
    f32x4 acc[8];
#pragma unroll
    for (int m = 0; m < 8; ++m) acc[m] = (f32x4){0.f, 0.f, 0.f, 0.f};
    for (int ri = 0; ri < 2; ++ri) {
        __syncthreads();
        load_tile_T(zt, SrcC{F.P(), ri, hc}, F.tid);
        __syncthreads();
        tile_mma(zt, MC + (size_t)k * 512 + ri * 256, acc, F.lane);
    }
    bf16_t* o = F.CAT() + (size_t)k * D + 768 + 128 * hc + 4 * g;
#pragma unroll
    for (int m = 0; m < 8; ++m) { const f32x4 a = acc[m] * (1.f / 128.f); u32x2 w; w.x = pk2(a[0], a[1]); w.y = pk2(a[2], a[3]); *(u32x2*)(o + 16 * m) = w; }
}

template <int GI> __device__ __forceinline__ void pool_sums(Frame& F, int j, LAS float* V, LAS unsigned* U, LAS unsigned char* At) {
    constexpr int win = 2 << GI, lo = win >> 1, hi = win - 1 - lo; const GAS bf16_t* Pc = (const GAS bf16_t*)F.P() + 2560 + GI * 64;
    if (j == 0) {
        for (int idx = F.tid; idx < 256 * 8; idx += NTHR) { const int t = idx >> 3, p8 = idx & 7; const int a = max(t - lo, 0), b = min(t + hi, CTX - 1); u32x4 w[win];
#pragma unroll
            for (int i = 0; i < win; ++i) { const int r = min(max(t - lo + i, 0), CTX - 1); w[i] = *(const GAS u32x4*)(Pc + (unsigned)(r * DINX + 8 * p8)); }
            f32x4 s0 = (f32x4){0.f, 0.f, 0.f, 0.f}, s1 = s0;
#pragma unroll
            for (int i = 0; i < win; ++i) { const int r = t - lo + i; const bool in = r >= 0 && r <= CTX - 1; const u32x4 x = w[i];
                const f32x4 e = (f32x4){bflo(x.x), bflo(x.y), bflo(x.z), bflo(x.w)}, o = (f32x4){bfhi(x.x), bfhi(x.y), bfhi(x.z), bfhi(x.w)}; if (in) { s0 += e; s1 += o; } }
            const u32x4 u = w[lo]; const float inv = 1.f / (float)(b - a + 1); u32x4 ov;
            ov.x = pk2(s0[0] * inv - bflo(u.x), s1[0] * inv - bfhi(u.x)); ov.y = pk2(s0[1] * inv - bflo(u.y), s1[1] * inv - bfhi(u.y));
            ov.z = pk2(s0[2] * inv - bflo(u.z), s1[2] * inv - bfhi(u.z)); ov.w = pk2(s0[3] * inv - bflo(u.w), s1[3] * inv - bfhi(u.w));
            *(LAS u32x4*)(At + t * 144 + 16 * p8) = ov; }
        return; }
    const int r0 = 4 * (j - 1); constexpr int NR = win + 3;
    { const int c = F.tid >> 3, p8 = F.tid & 7; u32x4 w[NR];
#pragma unroll
        for (int i = 0; i < NR; ++i) { const int r = min(max(r0 - lo + i, 0), LAT / GW - 1); w[i] = *(const GAS u32x4*)(Pc + (unsigned)((CTX + r * GW + c) * DINX + 8 * p8)); }
        f32x4 s0[4], s1[4];
#pragma unroll
        for (int q = 0; q < 4; ++q) { s0[q] = (f32x4){0.f, 0.f, 0.f, 0.f}; s1[q] = (f32x4){0.f, 0.f, 0.f, 0.f}; }
#pragma unroll
        for (int i = 0; i < NR; ++i) { const int r = r0 - lo + i; const bool ok = r >= 0 && r <= LAT / GW - 1; const u32x4 x = w[i];
            f32x4 e = (f32x4){bflo(x.x), bflo(x.y), bflo(x.z), bflo(x.w)}, o = (f32x4){bfhi(x.x), bfhi(x.y), bfhi(x.z), bfhi(x.w)}; if (!ok) { e = (f32x4){0.f, 0.f, 0.f, 0.f}; o = e; }
#pragma unroll
            for (int q = 0; q < 4; ++q) if (i >= q && i <= q + win - 1) { s0[q] += e; s1[q] += o; } }
#pragma unroll
        for (int q = 0; q < 4; ++q) { LAS float* vp = V + (q * 64 + c) * 64 + 8 * p8;
            *(LAS f32x4*)vp = (f32x4){s0[q][0], s1[q][0], s0[q][1], s1[q][1]}; *(LAS f32x4*)(vp + 4) = (f32x4){s0[q][2], s1[q][2], s0[q][3], s1[q][3]};
            *(LAS u32x4*)(U + (q * 64 + c) * 32 + 4 * p8) = w[lo + q]; } }
    __syncthreads();
    for (int idx = F.tid; idx < 4 * 8 * 64; idx += NTHR) { const int ch = idx & 63, cb = (idx >> 6) & 7, i = idx >> 9; const int r = r0 + i;
        const float cr = (float)(min(r + hi, LAT / GW - 1) - max(r - lo, 0) + 1); const LAS float* Vr = V + (i * 64) * 64 + ch;
        const int c0 = 8 * cb; float s = 0.f;
#pragma unroll
        for (int q = 0; q < win; ++q) { const int c = c0 - lo + q; s += (c >= 0 && c <= GW - 1) ? Vr[min(max(c, 0), GW - 1) * 64] : 0.f; }
#pragma unroll
        for (int q = 0; q < 8; ++q) { const int c = c0 + q; if (q > 0) { if (c + hi <= GW - 1) s += Vr[(c + hi) * 64]; if (c - 1 - lo >= 0) s -= Vr[(c - 1 - lo) * 64]; }
            const float cc = (float)(min(c + hi, GW - 1) - max(c - lo, 0) + 1); const unsigned uw = U[(i * 64 + c) * 32 + (ch >> 1)]; const float u = (ch & 1) ? bfhi(uw) : bflo(uw);
            *(LAS unsigned short*)(At + (i * 64 + c) * 144 + 2 * ch) = (unsigned short)f2bf(s / (cr * cc) - u); } }
}
__device__ __forceinline__ void pool_item(Frame& F, int l, int item) {
    const int j = item >> 2, gi = item & 3;
    LAS float* V = (LAS float*)(F.lds);
    LAS unsigned* U = (LAS unsigned*)(F.lds + 65536);
    LAS unsigned char* At = F.lds + 65536 + 32768;
    __syncthreads();
    if (gi == 0) pool_sums<0>(F, j, V, U, At); else if (gi == 1) pool_sums<1>(F, j, V, U, At); else if (gi == 2) pool_sums<2>(F, j, V, U, At); else pool_sums<3>(F, j, V, U, At);
    __syncthreads();
    const bf16_t* PW = (const bf16_t*)(F.ws + WS_WF + WF_PW) + (size_t)(l * 4 + gi) * 4096; const int fr = F.lane & 15, g = F.lane >> 4;
    f32x4 acc[4][2];
#pragma unroll
    for (int n = 0; n < 4; ++n) { acc[n][0] = (f32x4){0.f, 0.f, 0.f, 0.f}; acc[n][1] = (f32x4){0.f, 0.f, 0.f, 0.f}; }
#pragma unroll
    for (int ks = 0; ks < 2; ++ks) { bf16x8 b[2];
#pragma unroll
        for (int mt = 0; mt < 2; ++mt) b[mt] = *(const LAS bf16x8*)(At + (32 * F.wave + 16 * mt + fr) * 144 + (32 * ks + 8 * g) * 2);
#pragma unroll
        for (int n = 0; n < 4; ++n) { const bf16x8 a = *(const GAS bf16x8*)(PW + (16 * n + fr) * 64 + 32 * ks + 8 * g);
#pragma unroll
            for (int mt = 0; mt < 2; ++mt) acc[n][mt] = mfma16(a, b[mt], acc[n][mt]); } }
    const int rowbase = j == 0 ? 0 : CTX + 256 * (j - 1);
#pragma unroll
    for (int n = 0; n < 4; ++n) { const f32x4 sc = *(const GAS f32x4*)(F.pool_s() + l * 256 + gi * 64 + 16 * n + 4 * g);
#pragma unroll
        for (int mt = 0; mt < 2; ++mt) { const f32x4 a = acc[n][mt] * sc; u32x2 w; w.x = pk2(a[0], a[1]); w.y = pk2(a[2], a[3]);
            *(u32x2*)(F.CAT() + (size_t)(rowbase + 32 * F.wave + 16 * mt + fr) * D + 512 + gi * 64 + 16 * n + 4 * g) = w; } }
}

constexpr int SC_FT = 0, SC_QT = 18432, SC_VT = 36864, SC_BQ = 55296, SC_BF = 72704, SC_KT = 90112, SC_PM = 108544, SC_G = 117760, SC_TOT = 135168, SC_DEC = 137216, SC_SSQ = 138752, SC_END = 140800;
static_assert(SC_END <= MISC_OFF, "scan LDS map");
template <int DIR, bool FULL> __device__ __forceinline__ void scan_fetch(const Frame& F, int h, int row0, u32x4 (&r)[8]) {
    const GAS bf16_t* P = (const GAS bf16_t*)F.P(); const int tid = F.tid;
    if (tid < 384) { const int tile = tid >> 7, blk = tid & 127, tg = blk >> 4, kc = blk & 15; if (!FULL && tile == 1) return;
        const int colb = tile == 0 ? 512 * (1 + DIR) : (tile == 1 ? 0 : 1536); const GAS bf16_t* src = P + (unsigned)((row0 + 8 * tg) * DINX + colb + h * 128 + 8 * kc);
#pragma unroll
        for (int i = 0; i < 8; ++i) r[i] = *(const GAS u32x4*)(src + (unsigned)(i * DINX)); }
    else if (FULL && DIR == 1) { const int q = tid - 384; const GAS bf16_t* src = P + (unsigned)((row0 + (q >> 4)) * DINX + 2048 + h * 128 + 8 * (q & 15));
#pragma unroll
        for (int i = 0; i < 8; ++i) r[i] = *(const GAS u32x4*)(src + (unsigned)(i * 8 * DINX)); }
}
template <int DIR, bool FULL> __device__ __forceinline__ void scan_commit(const Frame& F, const u32x4 (&r)[8]) {
    LAS unsigned char* L = F.lds + RING_OFF; const int tid = F.tid;
    if (tid < 384) { const int tile = tid >> 7, blk = tid & 127, tg = blk >> 4, kc = blk & 15; if (!FULL && tile == 1) return;
#pragma unroll
        for (int j = 0; j < 8; ++j) { const unsigned sel = (j & 1) ? 0x07060302u : 0x05040100u; u32x4 o;
            o.x = __builtin_amdgcn_perm(r[1][j >> 1], r[0][j >> 1], sel); o.y = __builtin_amdgcn_perm(r[3][j >> 1], r[2][j >> 1], sel);
            o.z = __builtin_amdgcn_perm(r[5][j >> 1], r[4][j >> 1], sel); o.w = __builtin_amdgcn_perm(r[7][j >> 1], r[6][j >> 1], sel);
            *(LAS u32x4*)(L + tile * 18432 + (8 * kc + j) * 144 + 16 * tg) = o; } }
    else if (FULL && DIR == 1) { const int q = tid - 384; LAS unsigned char* dst = L + SC_G + (q >> 4) * 272 + 16 * (q & 15);
#pragma unroll
        for (int i = 0; i < 8; ++i) *(LAS u32x4*)(dst + i * 8 * 272) = r[i]; }
}
template <int DIR, bool FULL> __device__ __forceinline__ void scan_chunk(Frame& F, int l, int h, int nrow0, u32x4 (&pre)[8], f32x4 (&S)[8], f32x4 (&o)[4], float& segsum, const GAS float* oload = nullptr, GAS float* ostore = nullptr) {
    LAS unsigned char* L = F.lds + RING_OFF; int lane = F.lane; asm volatile("" : "+v"(lane));
    const int w = F.wave, tid = w * 64 + lane, fr = lane & 15, g = lane >> 4;
    LAS float* TOT = (LAS float*)(L + SC_TOT); LAS float* DEC = (LAS float*)(L + SC_DEC); LAS float* C1 = DEC + 128; LAS float* C2 = DEC + 256;
    __syncthreads();
    scan_commit<DIR, FULL>(F, pre);
    __syncthreads();
    const int k = tid & 127, qu = tid >> 7;
    float bl[16]; float run = 0.f;
    { const u32x4 fa = *(const LAS u32x4*)(L + SC_FT + k * 144 + 32 * qu), fb = *(const LAS u32x4*)(L + SC_FT + k * 144 + 32 * qu + 16); const unsigned fw[8] = {fa.x, fa.y, fa.z, fa.w, fb.x, fb.y, fb.z, fb.w};
#pragma unroll
      for (int i = 0; i < 16; ++i) { const int ti = (DIR == 0 ? i : 15 - i); run += (ti & 1) ? f16hi(fw[ti >> 1]) : f16lo(fw[ti >> 1]); bl[i] = run; } }
    TOT[qu * 128 + k] = run;
    __syncthreads();
    const float t0 = TOT[k], t1 = TOT[128 + k], t2 = TOT[256 + k], t3 = TOT[384 + k]; const float total = (t0 + t1) + (t2 + t3);
    float off, ref;
    if (DIR == 0) { off = qu == 0 ? 0.f : (qu == 1 ? t0 : (qu == 2 ? t0 + t1 : t0 + t1 + t2)); ref = t0 + t1; }
    else { off = qu == 3 ? 0.f : (qu == 2 ? t3 : (qu == 1 ? t3 + t2 : t3 + t2 + t1)); ref = t3 + t2; }
    if (qu == 0) { DEC[k] = __builtin_amdgcn_exp2f(total); C1[k] = __builtin_amdgcn_exp2f(ref); C2[k] = __builtin_amdgcn_exp2f(total - ref); segsum += total; }
    { unsigned qw[8];
      if (FULL) { const u32x4 qa = *(const LAS u32x4*)(L + SC_QT + k * 144 + 32 * qu), qb = *(const LAS u32x4*)(L + SC_QT + k * 144 + 32 * qu + 16); qw[0] = qa.x; qw[1] = qa.y; qw[2] = qa.z; qw[3] = qa.w; qw[4] = qb.x; qw[5] = qb.y; qw[6] = qb.z; qw[7] = qb.w; }
      float ktv[16]; const float sh = off - ref;
#pragma unroll
      for (int i = 0; i < 16; ++i) { const int ti = (DIR == 0 ? i : 15 - i), t = 16 * qu + ti; const float lf = i == 0 ? bl[0] : bl[i] - bl[i - 1]; const float b = bl[i] + sh;
          const float E = __builtin_amdgcn_exp2f(b), Ei = __builtin_amdgcn_rcpf(E), kk = 1.f - __builtin_amdgcn_exp2f(lf); ktv[ti] = kk * Ei;
          if (FULL) { const float qs = (ti & 1) ? bfhi(qw[ti >> 1]) : bflo(qw[ti >> 1]); *(LAS unsigned short*)(L + SC_BQ + t * 272 + 2 * k) = (unsigned short)(cvt_pk_bf16(qs * E, 0.f)); } }
      u32x4 a, b2; a.x = cvt_pk_bf16(ktv[0], ktv[1]); a.y = cvt_pk_bf16(ktv[2], ktv[3]); a.z = cvt_pk_bf16(ktv[4], ktv[5]); a.w = cvt_pk_bf16(ktv[6], ktv[7]);
      b2.x = cvt_pk_bf16(ktv[8], ktv[9]); b2.y = cvt_pk_bf16(ktv[10], ktv[11]); b2.z = cvt_pk_bf16(ktv[12], ktv[13]); b2.w = cvt_pk_bf16(ktv[14], ktv[15]);
      *(LAS u32x4*)(L + SC_KT + k * 144 + 32 * qu) = a; *(LAS u32x4*)(L + SC_KT + k * 144 + 32 * qu + 16) = b2;
      if (FULL) { const unsigned kw[8] = {a.x, a.y, a.z, a.w, b2.x, b2.y, b2.z, b2.w};
#pragma unroll
          for (int ti = 0; ti < 16; ++ti) *(LAS unsigned short*)(L + SC_BF + (16 * qu + ti) * 272 + 2 * k) = (unsigned short)((ti & 1) ? (kw[ti >> 1] >> 16) : (kw[ti >> 1] & 0xffffu)); } }
    __syncthreads();
    if (nrow0 >= 0) scan_fetch<DIR, FULL>(F, h, nrow0, pre);
    if (FULL) {
#pragma unroll
        for (int tb = 0; tb < 4; ++tb)
#pragma unroll
            for (int r = 0; r < 4; ++r) o[tb][r] = oload ? oload[(tb * 4 + r) * 512] : 0.f; }
    __builtin_amdgcn_sched_barrier(0);
    if (FULL) {
        const int tb = w >> 1;
#pragma unroll
        for (int q = 0; q < 2; ++q) { const int sb = 2 * (w & 1) + q; f32x4 acc = (f32x4){0.f, 0.f, 0.f, 0.f};
#pragma unroll
            for (int ks = 0; ks < 4; ++ks) { const bf16x8 a = *(const LAS bf16x8*)(L + SC_BF + (16 * sb + fr) * 272 + (32 * ks + 8 * g) * 2); const bf16x8 b = *(const LAS bf16x8*)(L + SC_BQ + (16 * tb + fr) * 272 + (32 * ks + 8 * g) * 2);
                acc = mfma16(a, b, acc); }
            const int t = 16 * tb + fr; float m[4];
#pragma unroll
            for (int r = 0; r < 4; ++r) { const int s = 16 * sb + 4 * g + r; const bool keep = DIR == 0 ? (s <= t) : (s >= t); m[r] = keep ? acc[r] : 0.f; }
            u32x2 wv; wv.x = pk2(m[0], m[1]); wv.y = pk2(m[2], m[3]); *(LAS u32x2*)(L + SC_PM + t * 144 + (16 * sb + 4 * g) * 2) = wv; }
        __syncthreads();
    }
    bf16x8 vt[2];
#pragma unroll
    for (int ks = 0; ks < 2; ++ks) vt[ks] = *(const LAS bf16x8*)(L + SC_VT + (16 * w + fr) * 144 + (32 * ks + 8 * g) * 2);
    if (FULL) {
        bf16x8 sf[4];
#pragma unroll
        for (int ks = 0; ks < 4; ++ks) { const f32x4 ca = *(const LAS f32x4*)(C1 + 32 * ks + 4 * g), cb = *(const LAS f32x4*)(C1 + 32 * ks + 16 + 4 * g); const f32x4 x = S[2 * ks] * ca, y = S[2 * ks + 1] * cb;
            u32x4 pkd; pkd.x = pk2(x[0], x[1]); pkd.y = pk2(x[2], x[3]); pkd.z = pk2(y[0], y[1]); pkd.w = pk2(y[2], y[3]); sf[ks] = __builtin_bit_cast(bf16x8, pkd); }
#pragma unroll
        for (int tb = 0; tb < 4; ++tb) { f32x4 acc = o[tb];
#pragma unroll
            for (int ks = 0; ks < 4; ++ks) { const u32x2 a0 = *(const LAS u32x2*)(L + SC_BQ + (16 * tb + fr) * 272 + (32 * ks + 4 * g) * 2), a1 = *(const LAS u32x2*)(L + SC_BQ + (16 * tb + fr) * 272 + (32 * ks + 16 + 4 * g) * 2);
                u32x4 pa; pa.x = a0.x; pa.y = a0.y; pa.z = a1.x; pa.w = a1.y; acc = mfma16(__builtin_bit_cast(bf16x8, pa), sf[ks], acc); }
#pragma unroll
            for (int ks = 0; ks < 2; ++ks) { const bf16x8 a = *(const LAS bf16x8*)(L + SC_PM + (16 * tb + fr) * 144 + (32 * ks + 8 * g) * 2); acc = mfma16(a, vt[ks], acc); }
            o[tb] = acc; __builtin_amdgcn_sched_barrier(0); }
        if (ostore) {
#pragma unroll
            for (int tb = 0; tb < 4; ++tb)
#pragma unroll
                for (int r = 0; r < 4; ++r) ostore[(tb * 4 + r) * 512] = o[tb][r]; }
    }
#pragma unroll
    for (int kb = 0; kb < 8; ++kb) { f32x4 tmp = (f32x4){0.f, 0.f, 0.f, 0.f};
#pragma unroll
        for (int ks = 0; ks < 2; ++ks) { const bf16x8 a = *(const LAS bf16x8*)(L + SC_KT + (16 * kb + fr) * 144 + (32 * ks + 8 * g) * 2); tmp = mfma16(a, vt[ks], tmp); }
        const f32x4 dc = *(const LAS f32x4*)(DEC + 16 * kb + 4 * g), c2 = *(const LAS f32x4*)(C2 + 16 * kb + 4 * g); S[kb] = dc * S[kb] + c2 * tmp; if (kb & 1) __builtin_amdgcn_sched_barrier(0); }
}
__device__ __forceinline__ void state_store(float* dst, const f32x4 (&S)[8], int w, int lane) {
    GAS float* p = (GAS float*)dst + (unsigned)(w * 2048 + lane);
#pragma unroll
    for (int kb = 0; kb < 8; ++kb)
#pragma unroll
        for (int r = 0; r < 4; ++r) p[(kb * 4 + r) * 64] = S[kb][r]; }
__device__ __forceinline__ void state_load(const float* src, f32x4 (&S)[8], int w, int lane) {
    const GAS float* p = (const GAS float*)src + (unsigned)(w * 2048 + lane);
#pragma unroll
    for (int kb = 0; kb < 8; ++kb)
#pragma unroll
        for (int r = 0; r < 4; ++r) S[kb][r] = p[(kb * 4 + r) * 64]; }
__device__ __forceinline__ float* sc_SU(Frame& F) { return (float*)(F.ws + WS_SU); }
__device__ __forceinline__ float* sc_SS(Frame& F) { return (float*)(F.ws + WS_SS); }
__device__ __forceinline__ float* sc_SD(Frame& F) { return (float*)(F.ws + WS_SD); }
__device__ __forceinline__ float* sc_CARRY(Frame& F) { return (float*)(F.ws + WS_SD) + 8 * 64 * 128; }

__device__ __forceinline__ float* sc_OSCR(Frame& F) { return (float*)(F.ws + WS_OSCR) + (size_t)F.bid * 32768; }
template <int DIR> __device__ __forceinline__ void scan_states(Frame& F, int l, int h, int segrow, float* sout, float* dout) {
    f32x4 S[8], odummy[4]; float segsum = 0.f; u32x4 pre[8];
#pragma unroll
    for (int kb = 0; kb < 8; ++kb) S[kb] = (f32x4){0.f, 0.f, 0.f, 0.f};
    scan_fetch<DIR, false>(F, h, segrow + (DIR == 0 ? 0 : 192), pre);
#pragma unroll 1
    for (int i_ = 0; i_ < 4; ++i_) { int i = i_; asm volatile("" : "+s"(i)); const int c = DIR == 0 ? i : 3 - i;
        scan_chunk<DIR, false>(F, l, h, i < 3 ? segrow + 64 * (DIR == 0 ? c + 1 : c - 1) : -1, pre, S, odummy, segsum); }
    state_store(sout, S, F.wave, F.lane);
    if (dout && F.tid < 128) dout[F.tid] = __builtin_amdgcn_exp2f(segsum);
}
__device__ __forceinline__ void scanA_item(Frame& F, int l, int item) {
    const int h = item >> 6, seg = item & 63, segrow = CTX + 256 * seg;
    scan_states<0>(F, l, h, segrow, sc_SU(F) + ((size_t)(h * 2 + 0) * 64 + seg) * 16384, sc_SD(F) + ((h * 2 + 0) * 64 + seg) * 128);
    scan_states<1>(F, l, h, segrow, sc_SU(F) + ((size_t)(h * 2 + 1) * 64 + seg) * 16384, sc_SD(F) + ((h * 2 + 1) * 64 + seg) * 128);
}
__device__ __forceinline__ void scan_full(Frame& F, int l, int h, int segrow, const float* sinf, const float* sinb, float* outf, float* outb) {
    f32x4 S[8], o[4]; float segsum = 0.f; const int w = F.wave, lane = F.lane, fr = lane & 15, g = lane >> 4; u32x4 pre[8];
    GAS float* oscr = (GAS float*)sc_OSCR(F) + (unsigned)F.tid;
    if (sinf) state_load(sinf, S, w, lane); else {
#pragma unroll
        for (int kb = 0; kb < 8; ++kb) S[kb] = (f32x4){0.f, 0.f, 0.f, 0.f}; }
    scan_fetch<0, true>(F, h, segrow, pre);
#pragma unroll 1
    for (int c_ = 0; c_ < 4; ++c_) { int c = c_; asm volatile("" : "+s"(c));
        scan_chunk<0, true>(F, l, h, c < 3 ? segrow + 64 * (c + 1) : -1, pre, S, o, segsum);
#pragma unroll
        for (int tb = 0; tb < 4; ++tb)
#pragma unroll
            for (int r = 0; r < 4; ++r) (oscr + c * 8192)[(tb * 4 + r) * 512] = o[tb][r];
    }
    if (outf) state_store(outf, S, w, lane);
    VM_WAIT();
    if (sinb) state_load(sinb, S, w, lane); else {
#pragma unroll
        for (int kb = 0; kb < 8; ++kb) S[kb] = (f32x4){0.f, 0.f, 0.f, 0.f}; }
    LAS unsigned char* L = F.lds + RING_OFF; LAS float* SSQ = (LAS float*)(L + SC_SSQ);
    const float ngv = F.hng()[l * 512 + h * 128 + 16 * w + fr];
    scan_fetch<1, true>(F, h, segrow + 192, pre);
#pragma unroll 1
    for (int c_ = 3; c_ >= 0; --c_) { int c = c_; asm volatile("" : "+s"(c));
        scan_chunk<1, true>(F, l, h, c > 0 ? segrow + 64 * (c - 1) : -1, pre, S, o, segsum, oscr + c * 8192);
#pragma unroll
        for (int tb = 0; tb < 4; ++tb) { f32x4 q = o[tb] * o[tb];
#pragma unroll
            for (int m = 1; m < 16; m <<= 1) { q[0] += lane_xor(q[0], m, lane); q[1] += lane_xor(q[1], m, lane); q[2] += lane_xor(q[2], m, lane); q[3] += lane_xor(q[3], m, lane); }
            if (fr == 0) {
#pragma unroll
                for (int r = 0; r < 4; ++r) SSQ[(16 * tb + 4 * g + r) * 8 + w] = q[r]; } }
        __syncthreads();
#pragma unroll
        for (int tb = 0; tb < 4; ++tb)
#pragma unroll
            for (int r = 0; r < 4; ++r) { const int t = 16 * tb + 4 * g + r; const f32x4 p0 = *(const LAS f32x4*)(SSQ + t * 8), p1 = *(const LAS f32x4*)(SSQ + t * 8 + 4);
                const float ss = ((p0[0] + p0[1]) + (p0[2] + p0[3])) + ((p1[0] + p1[1]) + (p1[2] + p1[3])); const float rs = rsqrtf(ss * (1.f / 128.f) + 1e-6f);
                const float gp = bf2f(*(const LAS unsigned short*)(L + SC_G + t * 272 + 2 * (16 * w + fr)));
                *(LAS unsigned short*)(L + SC_BQ + t * 272 + 2 * (16 * w + fr)) = (unsigned short)f2bf(o[tb][r] * rs * ngv * gp); }
        __syncthreads();
#pragma unroll
        for (int i = 0; i < 2; ++i) { const int id = F.tid + 512 * i, row = id >> 4, cc = id & 15; const u32x4 d = *(const LAS u32x4*)(L + SC_BQ + row * 272 + 16 * cc);
            *(GAS u32x4*)((GAS bf16_t*)F.CAT() + (unsigned)((segrow + 64 * c + row) * D + h * 128 + 8 * cc)) = d; }
    }
    if (outb) state_store(outb, S, w, lane);
}
__device__ __forceinline__ GAS float* sc_CTXO(const Frame& F, int hd, int c) { return (GAS float*)(F.ws + WS_CTXO) + (unsigned)((hd * 4 + c) * 8192); }
template <int DIR> __device__ __forceinline__ void scan_dir_local(Frame& F, int l, int h, int segrow, float* sout) {
    f32x4 S[8], o[4]; float segsum = 0.f; u32x4 pre[8]; const int hd = h * 2 + DIR;
#pragma unroll
    for (int kb = 0; kb < 8; ++kb) S[kb] = (f32x4){0.f, 0.f, 0.f, 0.f};
    scan_fetch<DIR, true>(F, h, segrow + (DIR == 0 ? 0 : 192), pre);
#pragma unroll 1
    for (int i_ = 0; i_ < 4; ++i_) { int i = i_; asm volatile("" : "+s"(i)); const int c = DIR == 0 ? i : 3 - i;
        scan_chunk<DIR, true>(F, l, h, i < 3 ? segrow + 64 * (DIR == 0 ? c + 1 : c - 1) : -1, pre, S, o, segsum, nullptr, sc_CTXO(F, hd, c) + (unsigned)F.tid); }
    state_store(sout, S, F.wave, F.lane);
}
__device__ __forceinline__ void ctx_finalize(Frame& F, int l, int h) {
    LAS unsigned char* L = F.lds + RING_OFF; LAS float* SSQ = (LAS float*)(L + SC_SSQ);
    const float ngv = F.hng()[l * 512 + h * 128 + 16 * F.wave + (F.lane & 15)];
#pragma unroll 1
    for (int c_ = 0; c_ < 4; ++c_) { int c = c_; asm volatile("" : "+s"(c)); int lane = F.lane; asm volatile("" : "+v"(lane));
        const int w = F.wave, tid = w * 64 + lane, fr = lane & 15, g = lane >> 4, row0 = 64 * c;
        __syncthreads();
        { const GAS bf16_t* gp = (const GAS bf16_t*)F.P() + (unsigned)((row0 + (tid >> 4)) * DINX + 2048 + h * 128 + 8 * (tid & 15)); const int o = (tid >> 4) * 272 + 16 * (tid & 15);
          *(LAS u32x4*)(L + SC_G + o) = *(const GAS u32x4*)gp; *(LAS u32x4*)(L + SC_G + o + 32 * 272) = *(const GAS u32x4*)(gp + (unsigned)(32 * DINX)); }
        f32x4 o[4];
        { const GAS float* of = sc_CTXO(F, h * 2 + 0, c) + (unsigned)tid; const GAS float* ob = sc_CTXO(F, h * 2 + 1, c) + (unsigned)tid;
#pragma unroll
          for (int tb = 0; tb < 4; ++tb)
#pragma unroll
              for (int r = 0; r < 4; ++r) o[tb][r] = of[(tb * 4 + r) * 512] + ob[(tb * 4 + r) * 512]; }
#pragma unroll
        for (int tb = 0; tb < 4; ++tb) { f32x4 q = o[tb] * o[tb];
#pragma unroll
            for (int m = 1; m < 16; m <<= 1) { q[0] += lane_xor(q[0], m, lane); q[1] += lane_xor(q[1], m, lane); q[2] += lane_xor(q[2], m, lane); q[3] += lane_xor(q[3], m, lane); }
            if (fr == 0) {
#pragma unroll
                for (int r = 0; r < 4; ++r) SSQ[(16 * tb + 4 * g + r) * 8 + w] = q[r]; } }
        __syncthreads();
#pragma unroll
        for (int tb = 0; tb < 4; ++tb)
#pragma unroll
            for (int r = 0; r < 4; ++r) { const int t = 16 * tb + 4 * g + r; const f32x4 p0 = *(const LAS f32x4*)(SSQ + t * 8), p1 = *(const LAS f32x4*)(SSQ + t * 8 + 4);
                const float ss = ((p0[0] + p0[1]) + (p0[2] + p0[3])) + ((p1[0] + p1[1]) + (p1[2] + p1[3])); const float rs = rsqrtf(ss * (1.f / 128.f) + 1e-6f);
                const float gp = bf2f(*(const LAS unsigned short*)(L + SC_G + t * 272 + 2 * (16 * w + fr)));
                *(LAS unsigned short*)(L + SC_BQ + t * 272 + 2 * (16 * w + fr)) = (unsigned short)f2bf(o[tb][r] * rs * ngv * gp); }
        __syncthreads();
#pragma unroll
        for (int i = 0; i < 2; ++i) { const int id = tid + 512 * i, row = id >> 4, cc = id & 15; const u32x4 d = *(const LAS u32x4*)(L + SC_BQ + row * 272 + 16 * cc);
            *(GAS u32x4*)((GAS bf16_t*)F.CAT() + (unsigned)((row0 + row) * D + h * 128 + 8 * cc)) = d; }
    }
    __syncthreads();
}
__device__ __forceinline__ void scanB(Frame& F) {
    const int e = F.bid * NTHR + F.tid; if (e >= 8 * 16384) return;
    const int hd = e >> 14, idx = e & 16383, d = hd & 1; const int ln = idx & 63, reg = (idx >> 6) & 3, kb = (idx >> 8) & 7; const int k = 16 * kb + 4 * (ln >> 4) + reg;
    const float* SU = sc_SU(F) + (size_t)hd * 64 * 16384 + idx; const float* SD = sc_SD(F) + hd * 64 * 128 + k; float* SS = sc_SS(F) + (size_t)hd * 64 * 16384 + idx;
    float S = sc_CARRY(F)[hd * 16384 + idx];
    if (d == 0) { for (int seg = 0; seg < 64; ++seg) { SS[(size_t)seg * 16384] = S; S = SD[seg * 128] * S + SU[(size_t)seg * 16384]; } }
    else { for (int seg = 63; seg >= 0; --seg) { SS[(size_t)seg * 16384] = S; S = SD[seg * 128] * S + SU[(size_t)seg * 16384]; } }
}

__device__ __forceinline__ void ph_mixA(Frame& F, int l) {
    scanA_item(F, l, F.bid);
    if (F.bid >= 4 && F.bid < 12) { const int hd = F.bid - 4, h = hd >> 1;
        if (l == 0) { if (hd & 1) scan_dir_local<1>(F, l, h, 0, sc_CARRY(F) + hd * 16384); else scan_dir_local<0>(F, l, h, 0, sc_CARRY(F) + hd * 16384); }
        else { if (hd & 1) scan_states<1>(F, l, h, 0, sc_CARRY(F) + hd * 16384, nullptr); else scan_states<0>(F, l, h, 0, sc_CARRY(F) + hd * 16384, nullptr); }
        return; }
    fftA_item(F, F.bid);
    if (F.bid >= 12 && F.bid < 20) fftA_item(F, F.bid - 8);
    if (l == 0) { pool_item(F, l, F.bid); if (F.bid >= 20 && F.bid < 28) pool_item(F, l, F.bid - 16); else if (F.bid >= 28 && F.bid < 32) pool_item(F, l, F.bid + 228); }
    else { pool_item(F, l, F.bid + 4); if (F.bid >= 20 && F.bid < 28) pool_item(F, l, F.bid - 12); }
}
__device__ __forceinline__ void ph_mixB(Frame& F, int l) {
    scanB(F);
    fftB_item(F, F.bid);
    if (l == 0 && F.bid >= 252) fftC_item(F, F.bid - 252);
    if (l == 0 && F.bid >= 240 && F.bid < 244) ctx_finalize(F, l, F.bid - 240);
}
__device__ __forceinline__ void ph_mixC(Frame& F, int l) {
    const int item = F.bid, h = item >> 6, seg = item & 63;
    scan_full(F, l, h, CTX + 256 * seg, sc_SS(F) + ((size_t)(h * 2 + 0) * 64 + seg) * 16384, sc_SS(F) + ((size_t)(h * 2 + 1) * 64 + seg) * 16384, nullptr, nullptr);
}
#define GRID_BAR() do { Frame R_ = relaunder(F); xcd_barrier(bar, R_.tid); } while (0)
#define PHASE(call) do { Frame R = relaunder(F); call; } while (0)
__global__ void __launch_bounds__(NTHR, 2) mega_fwd(Params p) {
    extern __shared__ __attribute__((aligned(16))) unsigned char lds[];
    Frame F; frame_init(F, p, lds);
    if (F.tid < 16) ((LAS unsigned*)(F.lds + MISC_OFF))[F.tid] = 0u;
    __syncthreads();
    XcdBarrier bar = xcd_barrier_post((unsigned*)(F.ctl() + CW_BAR), (volatile LAS unsigned*)(F.lds + MISC_OFF + 32));
    PHASE(ph_prologue(R)); PHASE(ph_prologue2(R));
    GRID_BAR();
    PHASE(ph_mod1(R, 0));
    GRID_BAR();
#pragma unroll 1
    for (int l = 0; l < 2; ++l) {
        PHASE(ph_win(R, l));            GRID_BAR();
        PHASE(ph_mixA(R, l));           GRID_BAR();
        PHASE(ph_mixB(R, l));           GRID_BAR();
        PHASE(ph_mixC(R, l));           GRID_BAR();
        PHASE(ph_wout(R, l));           GRID_BAR();
        PHASE(ph_mod2_route(R, l, l));  GRID_BAR();
        PHASE(ph_gateup(R, l));         GRID_BAR();
        PHASE(ph_down(R, l));           GRID_BAR();
        PHASE(ph_combine(R, l));
        if (l == 0) GRID_BAR();
    }
}
extern "C" void kernel_launch(void* const* d_in, const int* in_sizes, int n_in, void* d_out, int out_size, void* d_ws, size_t ws_size, hipStream_t stream) {
    static int ok = 0;
    if (ok == 0) {
        if (n_in != 22 || out_size != LAT * D || ws_size < WS_FASTEND) { fprintf(stderr, "kernel_launch: unexpected shapes / workspace (n_in %d, out %d, ws %zu < %zu); nothing launched\n", n_in, out_size, ws_size, (size_t)WS_FASTEND); ok = -1; return; }
        int dev = 0, cus = 0, per_cu = 0;
        if (hipGetDevice(&dev) != hipSuccess || hipDeviceGetAttribute(&cus, hipDeviceAttributeMultiprocessorCount, dev) != hipSuccess) { ok = -1; return; }
        if (hipFuncSetAttribute((const void*)mega_fwd, hipFuncAttributeMaxDynamicSharedMemorySize, LDS_BYTES) != hipSuccess) { fprintf(stderr, "kernel_launch: hipFuncSetAttribute failed\n"); ok = -1; return; }
        if (hipOccupancyMaxActiveBlocksPerMultiprocessor(&per_cu, (const void*)mega_fwd, NTHR, LDS_BYTES) != hipSuccess || per_cu < 1) fprintf(stderr, "kernel_launch: note: occupancy query reports %d workgroups per CU\n", per_cu);
        (void)hipGetLastError();
        if (cus < 256) fprintf(stderr, "kernel_launch: device has %d CUs; this kernel needs 256 co-resident workgroups (one per CU)\n", cus);
        ok = 1;
    }
    if (ok < 0) return;
    if (hipMemsetAsync((char*)d_ws + WS_CTL, 0, CTL_ZERO_BYTES, stream) != hipSuccess) return;
    Params p{}; for (int i = 0; i < 22; ++i) p.in[i] = (const float*)d_in[i]; p.out = (float*)d_out; p.ws = (unsigned char*)d_ws;
    hipLaunchKernelGGL(mega_fwd, dim3(256), dim3(NTHR), LDS_BYTES, stream, p);
}
```

```cpp
#include <hip/hip_runtime.h>
#include <cstdio>
#include <cstdint>
constexpr int D = 1024, LAT = 16384, CTX = 256, T = LAT + CTX, DIN = 3072, NE = 32, TOPK = 4;
constexpr int GW = 64;
#ifndef PSTR
#define PSTR DIN
#endif
constexpr int DINX = 3328, FQ_OFF = 2816;
#define GAS __attribute__((address_space(1)))
#define LAS __attribute__((address_space(3)))
typedef unsigned short bf16_t;
typedef short bf16x8 __attribute__((ext_vector_type(8)));
typedef short bf16x4 __attribute__((ext_vector_type(4)));
typedef float f32x4 __attribute__((ext_vector_type(4)));
typedef float f32x2 __attribute__((ext_vector_type(2)));
typedef unsigned u32x4 __attribute__((ext_vector_type(4)));
typedef unsigned u32x2 __attribute__((ext_vector_type(2)));
typedef GAS unsigned gu32;
#define RLX_AGENT __ATOMIC_RELAXED, __HIP_MEMORY_SCOPE_AGENT
#define LDS_WAIT() asm volatile("s_waitcnt lgkmcnt(0)" ::: "memory")
#define VM_WAIT() asm volatile("s_waitcnt vmcnt(0)" ::: "memory")
__device__ __forceinline__ unsigned cvt_pk_bf16(float lo, float hi) { unsigned r; asm("v_cvt_pk_bf16_f32 %0, %1, %2" : "=v"(r) : "v"(lo), "v"(hi)); return r; }
__device__ __forceinline__ unsigned f2bf(float f) { return cvt_pk_bf16(f, 0.f) & 0xffffu; }
__device__ __forceinline__ unsigned pk2(float lo, float hi) { return cvt_pk_bf16(lo, hi); }
__device__ __forceinline__ float bf2f(unsigned short b) { return __builtin_bit_cast(float, ((unsigned)b) << 16); }
__device__ __forceinline__ float bflo(unsigned w) { return __builtin_bit_cast(float, w << 16); }
__device__ __forceinline__ float bfhi(unsigned w) { return __builtin_bit_cast(float, w & 0xffff0000u); }
__device__ __forceinline__ float fsigm(float x) { return __builtin_amdgcn_rcpf(1.f + __builtin_amdgcn_exp2f(-1.44269504f * x)); }
__device__ __forceinline__ float lane_xor(float v, int m, int lane) { return __builtin_bit_cast(float, __builtin_amdgcn_ds_bpermute((lane ^ m) << 2, __builtin_bit_cast(int, v))); }
__device__ __forceinline__ int lane_get(int v, int src) { return __builtin_amdgcn_ds_bpermute(src << 2, v); }
__device__ __forceinline__ float wave_sum(float v, int lane) {
#pragma unroll
    for (int o = 1; o < 64; o <<= 1) v += lane_xor(v, o, lane);
    return v;
}

#define XB_TMO      128
#define XB_XCNT(j)  (256  + 64 * (j))
#define XB_XSUB(j)  (1280 + 64 * (j))
#define XB_XGEN(j)  (2304 + 64 * (j))
#define XB_TOP      3328
#define XB_TOPGEN   3392
#define XCD_BAR_WORDS 3456
#define XB_SPIN_CAP (1u << 18)
__device__ __forceinline__ unsigned xb_ld(unsigned* p)              { return __hip_atomic_load(p, __ATOMIC_RELAXED, __HIP_MEMORY_SCOPE_AGENT); }
__device__ __forceinline__ unsigned xb_add(unsigned* p, unsigned v) { return __hip_atomic_fetch_add(p, v, __ATOMIC_RELAXED, __HIP_MEMORY_SCOPE_AGENT); }
__device__ __forceinline__ unsigned xb_xcc_id() { return (unsigned)__builtin_amdgcn_s_getreg((3 << 11) | 20) & 0xFu; }
#define XB_SPIN(cond, bar) do { unsigned _sp = 0; while (cond) { __builtin_amdgcn_s_sleep(1); \
    if ((++_sp & 255u) == 0u) { if (xb_ld(&(bar)[XB_TMO])) break; if (_sp > XB_SPIN_CAP) { atomicAdd(&(bar)[XB_TMO], 1u); break; } } } } while (0)
struct XcdBarrier { unsigned* bar; unsigned x; volatile LAS unsigned* st; };
__device__ __forceinline__ XcdBarrier xcd_barrier_post(unsigned* bar, volatile LAS unsigned* st) {
    XcdBarrier b; b.bar = bar; b.x = xb_xcc_id(); b.st = st;
    if (threadIdx.x == 0) (void)xb_add(&bar[XB_XCNT(b.x)], 1u);
    return b;
}
__device__ __forceinline__ void xcd_barrier_complete(unsigned* bar, unsigned x, unsigned& nloc, unsigned& nx) {
    const unsigned G = gridDim.x * gridDim.y * gridDim.z;
    unsigned sum, cnt, mine, sp = 0u;
    for (;;) {
        sum = 0u; cnt = 0u; mine = 0u;
#pragma unroll
        for (unsigned j = 0; j < 16; ++j) { const unsigned c = xb_ld(&bar[XB_XCNT(j)]); sum += c; cnt += (c > 0u) ? 1u : 0u; mine = (j == x) ? c : mine; }
        if (sum == G) break;
        __builtin_amdgcn_s_sleep(1);
        if ((++sp & 255u) == 0u) { if (xb_ld(&bar[XB_TMO])) break; if (sp > XB_SPIN_CAP) { atomicAdd(&bar[XB_TMO], 1u); break; } }
    }
    nloc = mine > 0u ? mine : 1u; nx = cnt > 0u ? cnt : 1u;
}
__device__ __forceinline__ void xcd_barrier(const XcdBarrier& b, const int tid) {
    asm volatile("s_waitcnt vmcnt(0)" ::: "memory");
    unsigned blo = (unsigned)(unsigned long long)b.bar, bhi = (unsigned)((unsigned long long)b.bar >> 32), bx = b.x;
    asm volatile("" : "+s"(blo), "+s"(bhi), "+s"(bx));
    __syncthreads();
    if (tid == 0) {
        unsigned* bar = (unsigned*)(((unsigned long long)bhi << 32) | blo);
        __builtin_amdgcn_s_waitcnt(0);
        unsigned nloc = b.st[0], nx = b.st[1];
        if (nloc == 0u) { xcd_barrier_complete(bar, bx, nloc, nx); b.st[0] = nloc; b.st[1] = nx; }
        const unsigned old = xb_add(&bar[XB_XSUB(bx)], 1u);
        const unsigned gen = old / nloc;
        if (old + 1u == (gen + 1u) * nloc) {
            __builtin_amdgcn_fence(__ATOMIC_RELEASE, "agent");
            asm volatile("s_waitcnt vmcnt(0)" ::: "memory");
            const unsigned og = xb_add(&bar[XB_TOP], 1u);
            const unsigned tg = og / nx;
            if (og + 1u == (tg + 1u) * nx) xb_add(&bar[XB_TOPGEN], 1u);
            else XB_SPIN(xb_ld(&bar[XB_TOPGEN]) == tg, bar);
            __builtin_amdgcn_fence(__ATOMIC_ACQUIRE, "agent");
            xb_add(&bar[XB_XGEN(bx)], 1u);
            asm volatile("s_waitcnt vmcnt(0)" ::: "memory");
        } else {
            XB_SPIN(xb_ld(&bar[XB_XGEN(bx)]) == gen, bar);
            __builtin_amdgcn_fence(__ATOMIC_ACQUIRE, "agent");
            asm volatile("s_waitcnt vmcnt(0)" ::: "memory");
        }
    }
    __syncthreads();
}

namespace pg8 {
constexpr int BM = 256, BK = 64, HALF = 128, HTB = HALF * BK * 2, STAGE_BYTES = 8 * HTB, NXCD = 8, WGM = 8;
__host__ __device__ __forceinline__ int lds_byte(int r, int c) { const int st = (r >> 4) * 2 + (c >> 5), rr = r & 15, cc = c & 31, ob = rr * 64 + cc * 2; return st * 1024 + (ob ^ (((ob >> 9) & 1) << 5)); }
__host__ __device__ __forceinline__ void stage_rc(int b, int& R, int& C) { const int st = b / 1024, sb = b % 1024, swz = sb ^ (((sb >> 9) & 1) << 5); R = (st >> 1) * 16 + swz / 64; C = (st & 1) * 32 + (swz % 64) / 2; }
__host__ __device__ __forceinline__ int perm32(int rho) { const int n = rho >> 4, i = rho & 15; return 8 * (i >> 2) + 4 * n + (i & 3); }

struct Unit { int pm, pn, e, ui; };

typedef int i32x8 __attribute__((ext_vector_type(8)));
typedef int i32x4 __attribute__((ext_vector_type(4)));
__device__ __forceinline__ i32x8 cat8(bf16x8 a, bf16x8 b) { return __builtin_shufflevector(__builtin_bit_cast(i32x4, a), __builtin_bit_cast(i32x4, b), 0, 1, 2, 3, 4, 5, 6, 7); }
template <class Epi, class Sched, bool ALIGN_EPI = true, bool FP8 = false>
__device__ __forceinline__ void gemm_phase(LAS unsigned char* lds, const char* gA, const int Kb, const Sched& S, const Epi& E, const int tid) {
    const int wid = __builtin_amdgcn_readfirstlane(tid >> 6), lane = tid & 63, wr = wid >> 2, wc = wid & 3, fr = lane & 15, fq = lane >> 4;
    const int nt = Kb / (BK * 2);
    int Ra[2], Ca[2]; unsigned voffB[2];
#pragma unroll
    for (int i = 0; i < 2; ++i) { int R, C; stage_rc(tid * 16 + i * 8192, R, C); const int Rb = Epi::PERM ? ((R & ~31) + perm32(R & 31)) : R;
        Ra[i] = R; Ca[i] = C * 2; voffB[i] = (unsigned)(Rb * Kb + C * 2); }
    const size_t kstep = (size_t)(BK * 2);
    const size_t hstep = (size_t)HALF * Kb;
    const unsigned ldsw = (unsigned)wid * 1024u;
    const int aoff = lds_byte(wr * 64 + fr, fq * 8), boff = lds_byte(wc * 32 + fr, fq * 8);
#define PG8_SA(b, h) (((b) * 2 + (h)) * HTB)
#define PG8_SB(b, h) ((4 + (b) * 2 + (h)) * HTB)
#define PG8_STAGE(bufoff, gbase, voff) do { _Pragma("unroll") for (int _i = 0; _i < 2; ++_i) \
        __builtin_amdgcn_global_load_lds((const unsigned*)((const char*)(gbase) + (voff)[_i]), (LAS unsigned*)(lds + (bufoff) + ldsw + _i * 8192), 16, 0, 0); } while (0)
#define PG8_LDA(dst, b, h) do { _Pragma("unroll") for (int m = 0; m < 4; ++m) _Pragma("unroll") for (int k = 0; k < 2; ++k) dst[m][k] = *(const LAS bf16x8*)(lds + PG8_SA(b, h) + aoff + m * 2048 + k * 1024); } while (0)
#define PG8_LDB(dst, b, h) do { _Pragma("unroll") for (int n = 0; n < 2; ++n) _Pragma("unroll") for (int k = 0; k < 2; ++k) dst[n][k] = *(const LAS bf16x8*)(lds + PG8_SB(b, h) + boff + n * 2048 + k * 1024); } while (0)
#define PG8_MMA(ai, bj, At, Bt) do { __builtin_amdgcn_s_setprio(1); _Pragma("unroll") for (int m = 0; m < 4; ++m) _Pragma("unroll") for (int n = 0; n < 2; ++n) { \
        if constexpr (FP8) asm volatile("v_mfma_scale_f32_16x16x128_f8f6f4 %0, %1, %2, %0, %3, %3 op_sel_hi:[0,0,0]" : "+v"(acc[ai][bj][m][n]) : "v"(cat8(Bt[n][0], Bt[n][1])), "v"(cat8(At[m][0], At[m][1])), "v"(scl)); \
        else { _Pragma("unroll") for (int k = 0; k < 2; ++k) acc[ai][bj][m][n] = __builtin_amdgcn_mfma_f32_16x16x32_bf16(Bt[n][k], At[m][k], acc[ai][bj][m][n], 0, 0, 0); } } __builtin_amdgcn_s_setprio(0); } while (0)
#define PG8_WAIT_V(n) asm volatile("s_waitcnt vmcnt(" #n ")" ::: "memory")
#define PG8_WAIT_L(n) asm volatile("s_waitcnt lgkmcnt(" #n ")" ::: "memory")
#define PG8_BAR __builtin_amdgcn_s_barrier()
#define PG8_SCHED __builtin_amdgcn_sched_barrier(0)
    Unit cur, nxt; int ui = 0;
    if (!S.next(0, cur)) return;
    f32x4 acc[2][2][4][2];
#pragma unroll
    for (int a = 0; a < 2; ++a)
#pragma unroll
        for (int b = 0; b < 2; ++b)
#pragma unroll
            for (int m = 0; m < 4; ++m)
#pragma unroll
                for (int n = 0; n < 2; ++n) acc[a][b][m][n] = (f32x4){0.f, 0.f, 0.f, 0.f};
    bf16x8 At[4][2], B0[2][2], B1[2][2]; const int scl = 0x7f7f7f7f;
    unsigned vA[2][2];
#pragma unroll
    for (int h = 0; h < 2; ++h)
#pragma unroll
        for (int i = 0; i < 2; ++i) vA[h][i] = S.a_row_off(cur, h * HALF + Ra[i]) + (unsigned)Ca[i];
    const char* cB = S.b_tile(cur);
    PG8_STAGE(PG8_SB(0, 0), cB, voffB); PG8_STAGE(PG8_SB(0, 1), cB + hstep, voffB); PG8_STAGE(PG8_SA(0, 0), gA, vA[0]); PG8_STAGE(PG8_SA(0, 1), gA, vA[1]);
    if (wr == 1) PG8_BAR;
    PG8_WAIT_V(2); PG8_BAR;
    PG8_STAGE(PG8_SB(1, 0), cB + kstep, voffB); PG8_STAGE(PG8_SA(1, 0), gA + kstep, vA[0]); PG8_STAGE(PG8_SB(1, 1), cB + hstep + kstep, voffB);
    PG8_WAIT_V(6); PG8_BAR;
    for (;;) {
        const bool has_next = S.next(ui + 1, nxt);
        const char* nB = has_next ? S.b_tile(nxt) : cB;
        for (int t = 0; t < nt; t += 2) {
            const bool last = (t == nt - 2);
            unsigned tN[2][2];
#pragma unroll
            for (int h = 0; h < 2; ++h)
#pragma unroll
                for (int i = 0; i < 2; ++i) tN[h][i] = vA[h][i];
            if (last && has_next) {
#pragma unroll
                for (int h = 0; h < 2; ++h)
#pragma unroll
                    for (int i = 0; i < 2; ++i) tN[h][i] = S.a_row_off(nxt, h * HALF + Ra[i]) + (unsigned)Ca[i];
                PG8_WAIT_L(0);
            }
            const char* a1 = gA + (size_t)(t + 1) * kstep;
            const char* a2 = last ? gA : gA + (size_t)(t + 2) * kstep; const char* b2 = last ? nB : cB + (size_t)(t + 2) * kstep;
            const char* a3 = a2 + kstep; const char* b3 = b2 + kstep;
            PG8_LDB(B0, 0, 0); PG8_LDB(B1, 0, 1); PG8_SCHED; PG8_LDA(At, 0, 0); PG8_STAGE(PG8_SA(1, 1), a1, vA[1]);
#pragma unroll
            for (int h = 0; h < 2; ++h)
#pragma unroll
                for (int i = 0; i < 2; ++i) vA[h][i] = tN[h][i];
            PG8_WAIT_V(8); PG8_WAIT_L(0); PG8_BAR; PG8_MMA(0, 0, At, B0); PG8_MMA(0, 1, At, B1); PG8_BAR; PG8_SCHED;
            PG8_LDA(At, 0, 1); PG8_STAGE(PG8_SB(0, 0), b2, voffB); PG8_STAGE(PG8_SB(0, 1), b2 + hstep, voffB); PG8_STAGE(PG8_SA(0, 0), a2, vA[0]);
            PG8_WAIT_V(8); PG8_WAIT_L(0); PG8_BAR; PG8_MMA(1, 0, At, B0); PG8_MMA(1, 1, At, B1); PG8_BAR; PG8_SCHED;
            PG8_LDB(B0, 1, 0); PG8_LDB(B1, 1, 1); PG8_SCHED; PG8_LDA(At, 1, 0); PG8_STAGE(PG8_SA(0, 1), a2, vA[1]);
            PG8_WAIT_V(8); PG8_WAIT_L(0); PG8_BAR; PG8_MMA(0, 0, At, B0); PG8_MMA(0, 1, At, B1); PG8_BAR; PG8_SCHED;
            PG8_LDA(At, 1, 1); PG8_STAGE(PG8_SB(1, 0), b3, voffB); PG8_STAGE(PG8_SB(1, 1), b3 + hstep, voffB); PG8_STAGE(PG8_SA(1, 0), a3, vA[0]);
            PG8_WAIT_V(8); PG8_WAIT_L(0); PG8_BAR; PG8_MMA(1, 0, At, B0); PG8_MMA(1, 1, At, B1); PG8_BAR; PG8_SCHED;
        }
        if constexpr (ALIGN_EPI) { if (wr == 0) PG8_BAR; }
        if constexpr (FP8) asm volatile("s_nop 15\n\ts_nop 15" ::: "memory");
        E(acc, cur, wr, wc, fr, fq);
        if (!has_next) break;
#pragma unroll
        for (int a = 0; a < 2; ++a)
#pragma unroll
            for (int b = 0; b < 2; ++b)
#pragma unroll
                for (int m = 0; m < 4; ++m)
#pragma unroll
                    for (int n = 0; n < 2; ++n) acc[a][b][m][n] = (f32x4){0.f, 0.f, 0.f, 0.f};
        cur = nxt; cB = nB; ++ui;
        if constexpr (ALIGN_EPI) { if (wr == 1) PG8_BAR; }
    }
    PG8_WAIT_V(0);
    if constexpr (!ALIGN_EPI) { if (wr == 0) PG8_BAR; }
    PG8_BAR;
#undef PG8_SA
#undef PG8_SB
#undef PG8_STAGE
#undef PG8_LDA
#undef PG8_LDB
#undef PG8_MMA
#undef PG8_WAIT_V
#undef PG8_WAIT_L
#undef PG8_BAR
#undef PG8_SCHED
}
}
constexpr size_t MiB = 1u << 20;
constexpr int TP = T * 4 + NE * 256;
constexpr size_t WS_CTL = 0, CTL_ZERO_BYTES = 128 * 1024;
constexpr size_t WS_LB = 1 * MiB, WS_MOD = 1 * MiB + 65536;
constexpr size_t WS_WIN = 2 * MiB, WS_WOUT = 18 * MiB, WS_WF = 22 * MiB, WS_WGU = 24 * MiB, WS_WDN = 280 * MiB;
constexpr size_t WS_X = 408 * MiB, WS_H = 474 * MiB, WS_P = 508 * MiB, WS_CAT = 624 * MiB, WS_ROUTE = 658 * MiB, WS_ACT = 662 * MiB, WS_Y = 810 * MiB;
constexpr size_t WS_SU = 958 * MiB, WS_SS = 990 * MiB, WS_SD = 1022 * MiB, WS_YP = 1023 * MiB, WS_OSCR = 1040 * MiB, WS_H8 = 1072 * MiB, WS_CTXO = 1090 * MiB, WS_FASTEND = 1092 * MiB;
#ifndef MOE_FP8
#define MOE_FP8 1
#endif
constexpr float FP8_SH = 16.f, FP8_SW = 256.f, FP8_SA = 4.f;
constexpr size_t RT_TOPI = 0, RT_TOPW = 512 * 1024, RT_POS = 1024 * 1024, RT_LISTE = 1536 * 1024;
static_assert((size_t)T * 16 <= 512 * 1024 && RT_LISTE + (size_t)NE * T * 4 <= 4 * MiB, "route map");
static_assert(WS_WIN + (size_t)2 * DINX * D * 2 <= WS_WOUT && WS_WGU + (size_t)2 * NE * 2048 * 1024 * 2 <= WS_WDN && WS_WDN + (size_t)2 * NE * 1024 * 1024 * 2 <= WS_X && WS_X + (size_t)T * D * 4 <= WS_H && WS_H + (size_t)T * D * 2 <= WS_P &&
              WS_P + (size_t)T * DINX * 2 <= WS_CAT && WS_CAT + (size_t)T * D * 2 <= WS_ROUTE && WS_ACT + (size_t)TP * D * 2 <= WS_Y && WS_Y + (size_t)TP * D * 2 <= WS_SU &&
              WS_SD + (size_t)(8 * 64 * 128 + 8 * 16384) * 4 <= WS_YP && WS_YP + (size_t)128 * 128 * 2 * 256 * 2 <= WS_OSCR && WS_OSCR + (size_t)256 * 32768 * 4 <= WS_H8 && WS_H8 + (size_t)T * D <= WS_CTXO && WS_CTXO + (size_t)32 * 8192 * 4 <= WS_FASTEND, "ws map");
constexpr int CW_TMO = 0, CW_BAR = 4096, CW_CNT = 16384;
constexpr int RING_OFF = 0, RING_BYTES = 131072, TINFO_OFF = 131072, BT_OFF = 136192, ROWOFF_OFF = 136704, MISC_OFF = 146944, LDS_BYTES = 147456;
constexpr int NWAVES = 8, NTHR = 512;

struct Params { const float* in[22]; float* out; unsigned char* ws; };
constexpr int PTR_OFF = MISC_OFF + 64;
struct Frame {
    LAS unsigned char* lds; unsigned char* ws; int tid, lane, wave, vcu, G, bid;
    __device__ __forceinline__ const float* in(int i) const { const LAS unsigned* q = (const LAS unsigned*)(lds + PTR_OFF) + 2 * i;
        const unsigned lo = __builtin_amdgcn_readfirstlane(q[0]), hi = __builtin_amdgcn_readfirstlane(q[1]); return (const float*)(((unsigned long long)hi << 32) | lo); }
    __device__ __forceinline__ const float* x() const { return in(0); }        __device__ __forceinline__ const float* c() const { return in(1); }
    __device__ __forceinline__ const float* ctxin() const { return in(2); }    __device__ __forceinline__ const float* cctx() const { return in(3); }
    __device__ __forceinline__ const float* w_ada() const { return in(4); }    __device__ __forceinline__ const float* b_ada() const { return in(5); }
    __device__ __forceinline__ const float* norm1_g() const { return in(6); }  __device__ __forceinline__ const float* norm2_g() const { return in(7); }
    __device__ __forceinline__ const float* w_in() const { return in(8); }     __device__ __forceinline__ const float* lbp() const { return in(9); }
    __device__ __forceinline__ const float* hng() const { return in(10); }     __device__ __forceinline__ const float* pool_w() const { return in(11); }
    __device__ __forceinline__ const float* pool_s() const { return in(12); }  __device__ __forceinline__ const float* four_w() const { return in(13); }
    __device__ __forceinline__ const float* w_out() const { return in(14); }   __device__ __forceinline__ const float* router_w() const { return in(15); }
    __device__ __forceinline__ const float* router_b() const { return in(16); } __device__ __forceinline__ const float* w_gu() const { return in(17); }
    __device__ __forceinline__ const float* b_gu() const { return in(18); }    __device__ __forceinline__ const float* w_dn() const { return in(19); }
    __device__ __forceinline__ const float* b_dn() const { return in(20); }    __device__ __forceinline__ const float* fng() const { return in(21); }
    __device__ __forceinline__ float* out() const { return (float*)in(22); }
    __device__ __forceinline__ gu32* ctl() const { return (gu32*)(ws + WS_CTL); }
    __device__ __forceinline__ float* LB() const { return (float*)(ws + WS_LB); }       __device__ __forceinline__ float* MOD() const { return (float*)(ws + WS_MOD); }
    __device__ __forceinline__ float* X() const { return (float*)(ws + WS_X); }
    __device__ __forceinline__ bf16_t* Wt_in() const { return (bf16_t*)(ws + WS_WIN); }  __device__ __forceinline__ bf16_t* Wt_out() const { return (bf16_t*)(ws + WS_WOUT); }
    __device__ __forceinline__ bf16_t* Wt_gu() const { return (bf16_t*)(ws + WS_WGU); }  __device__ __forceinline__ bf16_t* Wt_dn() const { return (bf16_t*)(ws + WS_WDN); }
    __device__ __forceinline__ bf16_t* H() const { return (bf16_t*)(ws + WS_H); }        __device__ __forceinline__ bf16_t* P() const { return (bf16_t*)(ws + WS_P); }
    __device__ __forceinline__ bf16_t* CAT() const { return (bf16_t*)(ws + WS_CAT); }    __device__ __forceinline__ bf16_t* ACT() const { return (bf16_t*)(ws + WS_ACT); }
    __device__ __forceinline__ bf16_t* Y() const { return (bf16_t*)(ws + WS_Y); }
    __device__ __forceinline__ int* TOPI() const { return (int*)(ws + WS_ROUTE + RT_TOPI); }   __device__ __forceinline__ float* TOPW() const { return (float*)(ws + WS_ROUTE + RT_TOPW); }
    __device__ __forceinline__ int* POS() const { return (int*)(ws + WS_ROUTE + RT_POS); }     __device__ __forceinline__ int* LISTE() const { return (int*)(ws + WS_ROUTE + RT_LISTE); }
};
__device__ __forceinline__ void frame_init(Frame& F, const Params& p, unsigned char* lds) {
    F.lds = (LAS unsigned char*)lds; F.tid = threadIdx.x; F.lane = F.tid & 63; F.wave = __builtin_amdgcn_readfirstlane(F.tid >> 6);
    F.G = gridDim.x; F.bid = blockIdx.x; { const int bx = blockIdx.x; F.vcu = (F.G % 8 == 0) ? (bx % 8) * (F.G / 8) + bx / 8 : bx; }
    F.ws = p.ws;
    if (F.tid == 0) { LAS unsigned long long* tab = (LAS unsigned long long*)(F.lds + PTR_OFF);
#pragma unroll
        for (int i = 0; i < 22; ++i) tab[i] = (unsigned long long)p.in[i];
        tab[22] = (unsigned long long)p.out; }
    __syncthreads();
}

__device__ __forceinline__ Frame relaunder(const Frame& F) { Frame R = F; int ln; asm volatile("v_mbcnt_lo_u32_b32 %0, -1, 0\n\tv_mbcnt_hi_u32_b32 %0, -1, %0" : "=v"(ln));
    R.lane = ln; R.tid = F.wave * 64 + ln; unsigned wlo = (unsigned)(unsigned long long)F.ws, whi = (unsigned)((unsigned long long)F.ws >> 32);
    asm volatile("" : "+s"(wlo), "+s"(whi)); R.ws = (unsigned char*)(((unsigned long long)whi << 32) | wlo);
    int sw = F.wave, sv = F.vcu, sg = F.G, sb = F.bid;
    asm volatile("" : "+s"(sw), "+s"(sv), "+s"(sg), "+s"(sb));
    R.wave = sw; R.vcu = sv; R.G = sg; R.bid = sb; R.tid = sw * 64 + ln; return R; }

struct DenseOrder {
    int nM, nN, nwg, G, c, Kb, pm0; const char* Bt;
    __device__ void init(int nM_, int nN_, int G_, int c_, int Kb_, const bf16_t* Bt_, int pm0_ = 0) { nM = nM_; nN = nN_; nwg = nM * nN; G = G_; c = c_; Kb = Kb_; Bt = (const char*)Bt_; pm0 = pm0_; }
    __device__ __forceinline__ bool next(int i, pg8::Unit& u) const {
        const long L = (long)i * G + c; if (L >= nwg) return false;
        int wgid = (int)L; { const int q = nwg / pg8::NXCD, r = nwg % pg8::NXCD, xcd = wgid % pg8::NXCD, off = wgid / pg8::NXCD; wgid = (xcd < r ? xcd * (q + 1) : r * (q + 1) + (xcd - r) * q) + off; }
        const int nig = pg8::WGM * nN, gid = wgid / nig, fm = gid * pg8::WGM, gsz = (nM - fm) < pg8::WGM ? (nM - fm) : pg8::WGM;
        u.pm = pm0 + fm + ((wgid % nig) % gsz); u.pn = (wgid % nig) / gsz; u.e = 0; u.ui = i; return true;
    }
    __device__ __forceinline__ const char* b_tile(const pg8::Unit& u) const { return Bt + (size_t)u.pn * 256 * Kb; }
    __device__ __forceinline__ unsigned a_row_off(const pg8::Unit& u, int r) const { return (unsigned)(u.pm * 256 + r) * (unsigned)Kb; }
};
template <bool GATHER> struct MoeOrder {
    const LAS int* tinfo; const LAS unsigned* rowoff; int ntiles, nN, G, c, Kb; const char* W; size_t wstride;
    __device__ __forceinline__ bool next(int i, pg8::Unit& u) const {
        const int L = i * G + c; if (L >= ntiles * nN) return false;
        u.pm = L / nN; u.pn = L % nN; u.e = __builtin_amdgcn_readfirstlane(tinfo[4 * u.pm]); u.ui = i; return true;
    }
    __device__ __forceinline__ const char* b_tile(const pg8::Unit& u) const { return W + (size_t)u.e * wstride + (size_t)u.pn * 256 * Kb; }
    __device__ __forceinline__ unsigned a_row_off(const pg8::Unit& u, int r) const { if constexpr (GATHER) return rowoff[u.ui * 256 + r]; else return (unsigned)(u.pm * 256 + r) * (unsigned)Kb; }
};

__device__ __forceinline__ unsigned pk_f16(float a, float b) { const _Float16 x = (_Float16)a, y = (_Float16)b; return (unsigned)__builtin_bit_cast(unsigned short, x) | ((unsigned)__builtin_bit_cast(unsigned short, y) << 16); }
__device__ __forceinline__ float f16lo(unsigned w) { return (float)__builtin_bit_cast(_Float16, (unsigned short)(w & 0xffffu)); }
__device__ __forceinline__ float f16hi(unsigned w) { return (float)__builtin_bit_cast(_Float16, (unsigned short)(w >> 16)); }
struct EpiP {
    static constexpr bool PERM = true; bf16_t* O; int ldc; const float* lb;
    __device__ __forceinline__ void operator()(const f32x4 (&acc)[2][2][4][2], const pg8::Unit& u, int wr, int wc, int fr, int fq) const {
        const int row0 = u.pm * 256 + wr * 64 + fr, col0 = u.pn * 256 + wc * 32 + 8 * fq;
        const int mode = u.pn < 2 ? 1 : (u.pn < 6 ? 2 : ((u.pn == 8 || u.pn == 9) ? 3 : 0));
        f32x4 lbv[2][2];
        if (mode == 2) {
#pragma unroll
            for (int bj = 0; bj < 2; ++bj)
#pragma unroll
                for (int n = 0; n < 2; ++n) lbv[bj][n] = *(const f32x4*)(lb + (col0 - 512) + bj * 128 + 4 * n); }
#pragma unroll
        for (int ai = 0; ai < 2; ++ai)
#pragma unroll
            for (int m = 0; m < 4; ++m) { bf16_t* rowp = O + (size_t)(row0 + ai * 128 + m * 16) * ldc + col0;
#pragma unroll
                for (int bj = 0; bj < 2; ++bj) { f32x2 v[4]; { const f32x4 v0 = acc[ai][bj][m][0], v1 = acc[ai][bj][m][1]; v[0] = (f32x2){v0[0], v0[1]}; v[1] = (f32x2){v0[2], v0[3]}; v[2] = (f32x2){v1[0], v1[1]}; v[3] = (f32x2){v1[2], v1[3]}; }
                    u32x4 w;
                    if (mode != 0) {
                        f32x2 sg[4];
#pragma unroll
                        for (int p = 0; p < 4; ++p) { const f32x2 ex = v[p] * (-1.44269504f); f32x2 d; d.x = __builtin_amdgcn_exp2f(ex.x); d.y = __builtin_amdgcn_exp2f(ex.y); d = d + 1.0f; sg[p].x = __builtin_amdgcn_rcpf(d.x); sg[p].y = __builtin_amdgcn_rcpf(d.y); }
                        if (mode == 2) {
#pragma unroll
                            for (int p = 0; p < 4; ++p) { const f32x4 lv = lbv[bj][p >> 1]; const f32x2 lb2 = (f32x2){lv[2 * (p & 1)], lv[2 * (p & 1) + 1]}; const f32x2 f = lb2 + (1.0f - lb2) * sg[p];
                                v[p].x = __builtin_amdgcn_logf(fmaxf(f.x, 1e-30f)); v[p].y = __builtin_amdgcn_logf(fmaxf(f.y, 1e-30f)); }
                            w.x = pk_f16(v[0].x, v[0].y); w.y = pk_f16(v[1].x, v[1].y); w.z = pk_f16(v[2].x, v[2].y); w.w = pk_f16(v[3].x, v[3].y);
                        } else {
#pragma unroll
                            for (int p = 0; p < 4; ++p) v[p] = mode == 1 ? v[p] * sg[p] : sg[p];
                            w.x = cvt_pk_bf16(v[0].x, v[0].y); w.y = cvt_pk_bf16(v[1].x, v[1].y); w.z = cvt_pk_bf16(v[2].x, v[2].y); w.w = cvt_pk_bf16(v[3].x, v[3].y); }
                    } else { w.x = cvt_pk_bf16(v[0].x, v[0].y); w.y = cvt_pk_bf16(v[1].x, v[1].y); w.z = cvt_pk_bf16(v[2].x, v[2].y); w.w = cvt_pk_bf16(v[3].x, v[3].y); }
                    *(u32x4*)(rowp + bj * 128) = w; } }
    }
};
struct EpiRes {
    static constexpr bool PERM = false; const float* base_ctx; const float* base_lat; const float* gate_ctx; const float* gate_lat; float* Xo;
    __device__ __forceinline__ void operator()(const f32x4 (&acc)[2][2][4][2], const pg8::Unit& u, int wr, int wc, int fr, int fq) const {
        const int rt = wr * 64 + fr, col0 = u.pn * 256 + wc * 32 + 4 * fq;
        const float* base = (u.pm == 0 ? base_ctx : base_lat + (size_t)(u.pm - 1) * 256 * D) + (size_t)rt * D + col0; const float* gate = (u.pm == 0 ? gate_ctx : gate_lat) + col0;
        float* op = Xo + (size_t)(u.pm * 256 + rt) * D + col0;
#pragma unroll
        for (int bj = 0; bj < 2; ++bj)
#pragma unroll
            for (int n = 0; n < 2; ++n) { const f32x4 gv = *(const f32x4*)(gate + bj * 128 + n * 16);
#pragma unroll
                for (int ai = 0; ai < 2; ++ai) {
#pragma unroll
                    for (int m = 0; m < 4; ++m) { const size_t o = (size_t)(ai * 128 + m * 16) * D + bj * 128 + n * 16; const f32x4 b = *(const f32x4*)(base + o); *(f32x4*)(op + o) = b + gv * acc[ai][bj][m][n]; }
                    asm volatile("" ::: "memory"); } }
    }
};
struct EpiAct {
    static constexpr bool PERM = true; bf16_t* ACTo; const float* bias;
    __device__ __forceinline__ void operator()(const f32x4 (&acc)[2][2][4][2], const pg8::Unit& u, int wr, int wc, int fr, int fq) const {
        const int x0 = wc * 32 + 8 * fq; const float* bg = bias + (size_t)u.e * 2048 + 128 * u.pn + x0; const float* bu = bg + 1024;
        const f32x4 g0 = *(const f32x4*)bg, g1 = *(const f32x4*)(bg + 4), u0 = *(const f32x4*)bu, u1 = *(const f32x4*)(bu + 4);
#pragma unroll
        for (int ai = 0; ai < 2; ++ai)
#pragma unroll
            for (int m = 0; m < 4; ++m) { const int row = u.pm * 256 + ai * 128 + wr * 64 + m * 16 + fr;
                const f32x4 ga = acc[ai][0][m][0] + g0, gb = acc[ai][0][m][1] + g1, ua = acc[ai][1][m][0] + u0, ub = acc[ai][1][m][1] + u1; float r[8];
#pragma unroll
                for (int j = 0; j < 4; ++j) { const float g = fminf(ga[j], 7.f), up = fminf(fmaxf(ua[j], -7.f), 7.f); r[j] = (up + 1.f) * (g * fsigm(1.702f * g));
                                              const float g2 = fminf(gb[j], 7.f), up2 = fminf(fmaxf(ub[j], -7.f), 7.f); r[4 + j] = (up2 + 1.f) * (g2 * fsigm(1.702f * g2)); }
                u32x4 w; w.x = cvt_pk_bf16(r[0], r[1]); w.y = cvt_pk_bf16(r[2], r[3]); w.z = cvt_pk_bf16(r[4], r[5]); w.w = cvt_pk_bf16(r[6], r[7]);
                *(u32x4*)(ACTo + (size_t)row * D + 128 * u.pn + x0) = w; }
    }
};
struct EpiY {
    static constexpr bool PERM = true; bf16_t* Yo; const float* bias;
    __device__ __forceinline__ void operator()(const f32x4 (&acc)[2][2][4][2], const pg8::Unit& u, int wr, int wc, int fr, int fq) const {
        const int row0 = u.pm * 256 + wr * 64 + fr, col0 = u.pn * 256 + wc * 32 + 8 * fq; const float* bp = bias + (size_t)u.e * D + col0;
        f32x4 bv[2][2];
#pragma unroll
        for (int bj = 0; bj < 2; ++bj)
#pragma unroll
            for (int n = 0; n < 2; ++n) bv[bj][n] = *(const f32x4*)(bp + bj * 128 + 4 * n);
#pragma unroll
        for (int ai = 0; ai < 2; ++ai)
#pragma unroll
            for (int m = 0; m < 4; ++m) { bf16_t* rowp = Yo + (size_t)(row0 + ai * 128 + m * 16) * D + col0;
#pragma unroll
                for (int bj = 0; bj < 2; ++bj) { const f32x4 v0 = acc[ai][bj][m][0] + bv[bj][0], v1 = acc[ai][bj][m][1] + bv[bj][1];
                    u32x4 w; w.x = cvt_pk_bf16(v0[0], v0[1]); w.y = cvt_pk_bf16(v0[2], v0[3]); w.z = cvt_pk_bf16(v1[0], v1[1]); w.w = cvt_pk_bf16(v1[2], v1[3]);
                    *(u32x4*)(rowp + bj * 128) = w; } }
    }
};

__device__ __forceinline__ unsigned pk4_fp8(float a, float b, float c, float d) { int r = __builtin_amdgcn_cvt_pk_fp8_f32(a, b, 0, false); r = __builtin_amdgcn_cvt_pk_fp8_f32(c, d, r, true); return (unsigned)r; }
struct EpiAct8 {
    static constexpr bool PERM = true; unsigned char* ACTo; const float* bias;
    __device__ __forceinline__ void operator()(const f32x4 (&acc)[2][2][4][2], const pg8::Unit& u, int wr, int wc, int fr, int fq) const {
        const int x0 = wc * 32 + 8 * fq; const float* bg = bias + (size_t)u.e * 2048 + 128 * u.pn + x0; const float* bu = bg + 1024; constexpr float isc = 1.f / (FP8_SH * FP8_SW);
        f32x2 g[4], v[4];
#pragma unroll
        for (int p = 0; p < 4; ++p) { g[p] = *(const f32x2*)(bg + 2 * p); v[p] = *(const f32x2*)(bu + 2 * p); }
#pragma unroll
        for (int ai = 0; ai < 2; ++ai)
#pragma unroll
            for (int m = 0; m < 4; ++m) { const int row = u.pm * 256 + ai * 128 + wr * 64 + m * 16 + fr; f32x2 r[4];
#pragma unroll
                for (int p = 0; p < 4; ++p) { const f32x4 ga4 = acc[ai][0][m][p >> 1], ua4 = acc[ai][1][m][p >> 1];
                    f32x2 gg = (f32x2){ga4[2 * (p & 1)], ga4[2 * (p & 1) + 1]} * isc + g[p], uu = (f32x2){ua4[2 * (p & 1)], ua4[2 * (p & 1) + 1]} * isc + v[p];
                    gg.x = fminf(gg.x, 7.f); gg.y = fminf(gg.y, 7.f); uu.x = __builtin_amdgcn_fmed3f(uu.x, -7.f, 7.f); uu.y = __builtin_amdgcn_fmed3f(uu.y, -7.f, 7.f);
                    const f32x2 ex = gg * (-1.702f * 1.44269504f); f32x2 d; d.x = __builtin_amdgcn_exp2f(ex.x); d.y = __builtin_amdgcn_exp2f(ex.y); d = d + 1.0f;
                    f32x2 rc; rc.x = __builtin_amdgcn_rcpf(d.x); rc.y = __builtin_amdgcn_rcpf(d.y);
                    r[p] = (uu * FP8_SA + FP8_SA) * (gg * rc); }
                u32x2 w; w.x = pk4_fp8(r[0].x, r[0].y, r[1].x, r[1].y); w.y = pk4_fp8(r[2].x, r[2].y, r[3].x, r[3].y);
                *(u32x2*)(ACTo + (size_t)row * D + 128 * u.pn + x0) = w; }
    }
};
struct EpiY8 {
    static constexpr bool PERM = true; bf16_t* Yo; const float* bias;
    __device__ __forceinline__ void operator()(const f32x4 (&acc)[2][2][4][2], const pg8::Unit& u, int wr, int wc, int fr, int fq) const {
        const int row0 = u.pm * 256 + wr * 64 + fr, col0 = u.pn * 256 + wc * 32 + 8 * fq; const float* bp = bias + (size_t)u.e * D + col0; constexpr float isc = 1.f / (FP8_SA * FP8_SW);
        f32x4 bv[2][2];
#pragma unroll
        for (int bj = 0; bj < 2; ++bj)
#pragma unroll
            for (int n = 0; n < 2; ++n) bv[bj][n] = *(const f32x4*)(bp + bj * 128 + 4 * n);
#pragma unroll
        for (int ai = 0; ai < 2; ++ai)
#pragma unroll
            for (int m = 0; m < 4; ++m) { bf16_t* rowp = Yo + (size_t)(row0 + ai * 128 + m * 16) * D + col0;
#pragma unroll
                for (int bj = 0; bj < 2; ++bj) { const f32x4 v0 = acc[ai][bj][m][0] * isc + bv[bj][0], v1 = acc[ai][bj][m][1] * isc + bv[bj][1];
                    u32x4 w; w.x = cvt_pk_bf16(v0[0], v0[1]); w.y = cvt_pk_bf16(v0[2], v0[3]); w.z = cvt_pk_bf16(v1[0], v1[1]); w.w = cvt_pk_bf16(v1[2], v1[3]);
                    *(u32x4*)(rowp + bj * 128) = w; } }
    }
};

struct CvtJob { const float* W; bf16_t* WT; int N, K, k0, n0, nrow0; };
__device__ __forceinline__ void cvt_load(const CvtJob& j, int lane, f32x4 (&r)[16]) { const GAS f32x4* src = (const GAS f32x4*)((const GAS float*)j.W + (unsigned)((j.k0 + 8 * (lane >> 3)) * j.N + j.n0 + 8 * (lane & 7)));
    const unsigned rs = (unsigned)j.N >> 2;
#pragma unroll
    for (int i = 0; i < 8; ++i) { r[2 * i] = src[i * rs]; r[2 * i + 1] = src[i * rs + 1]; } }
__device__ __forceinline__ void cvt_store(const CvtJob& j, int lane, const f32x4 (&r)[16]) {
    u32x4 b[8];
#pragma unroll
    for (int i = 0; i < 8; ++i) { b[i].x = cvt_pk_bf16(r[2 * i][0], r[2 * i][1]); b[i].y = cvt_pk_bf16(r[2 * i][2], r[2 * i][3]); b[i].z = cvt_pk_bf16(r[2 * i + 1][0], r[2 * i + 1][1]); b[i].w = cvt_pk_bf16(r[2 * i + 1][2], r[2 * i + 1][3]); }
    GAS u32x4* dst = (GAS u32x4*)((GAS bf16_t*)j.WT + (unsigned)((j.nrow0 + 8 * (lane & 7)) * j.K + j.k0 + 8 * (lane >> 3))); const unsigned rs = (unsigned)j.K >> 3;
#pragma unroll
    for (int q = 0; q < 8; ++q) { const unsigned sel = (q & 1) ? 0x07060302u : 0x05040100u; u32x4 o;
        o.x = __builtin_amdgcn_perm(b[1][q >> 1], b[0][q >> 1], sel); o.y = __builtin_amdgcn_perm(b[3][q >> 1], b[2][q >> 1], sel);
        o.z = __builtin_amdgcn_perm(b[5][q >> 1], b[4][q >> 1], sel); o.w = __builtin_amdgcn_perm(b[7][q >> 1], b[6][q >> 1], sel);
        dst[q * rs] = o; } }
__device__ __forceinline__ void cvt8_load(const CvtJob& j, int lane, f32x4 (&r)[16]) { const GAS f32x4* src = (const GAS f32x4*)((const GAS float*)j.W + (unsigned)((j.k0 + 16 * (lane >> 3)) * j.N + j.n0 + 4 * (lane & 7)));
    const unsigned rs = (unsigned)j.N >> 2;
#pragma unroll
    for (int i = 0; i < 16; ++i) r[i] = src[i * rs]; }
__device__ __forceinline__ void cvt8_store(const CvtJob& j, int lane, const f32x4 (&r)[16]) {
    GAS u32x4* dst = (GAS u32x4*)((GAS unsigned char*)j.WT + (unsigned)((j.nrow0 + 4 * (lane & 7)) * j.K + j.k0 + 16 * (lane >> 3))); const unsigned rs = (unsigned)j.K >> 4;
#pragma unroll
    for (int n = 0; n < 4; ++n) { u32x4 o;
        o.x = pk4_fp8(r[0][n] * FP8_SW, r[1][n] * FP8_SW, r[2][n] * FP8_SW, r[3][n] * FP8_SW); o.y = pk4_fp8(r[4][n] * FP8_SW, r[5][n] * FP8_SW, r[6][n] * FP8_SW, r[7][n] * FP8_SW);
        o.z = pk4_fp8(r[8][n] * FP8_SW, r[9][n] * FP8_SW, r[10][n] * FP8_SW, r[11][n] * FP8_SW); o.w = pk4_fp8(r[12][n] * FP8_SW, r[13][n] * FP8_SW, r[14][n] * FP8_SW, r[15][n] * FP8_SW);
        dst[n * rs] = o; } }
constexpr int NB_IN = (FQ_OFF < DIN ? FQ_OFF : DIN) / 64, I_IN = 16 * NB_IN, I_OUT = 16 * 16, I_GU = MOE_FP8 ? 8 * 64 : 16 * 32, I_DN = MOE_FP8 ? 8 * 32 : 16 * 16;
constexpr int N_IN = 2 * I_IN, N_OUT = 2 * I_OUT, N_GU = 2 * NE * I_GU, N_DN = 2 * NE * I_DN, N_CVT = N_IN + N_OUT + N_GU + N_DN;
__device__ __forceinline__ CvtJob cvt_job(const Frame& F, int it, bool& f8) {
    CvtJob j; int r = it; f8 = false;
    if (r < N_IN) { const int l = r / I_IN, q = r % I_IN, kb = q / NB_IN, nb = q % NB_IN; j = CvtJob{F.w_in() + (size_t)l * D * DIN, F.Wt_in() + (size_t)l * DINX * D, DIN, D, 64 * kb, 64 * nb, 64 * nb}; return j; } r -= N_IN;
    if (r < N_OUT) { const int l = r / I_OUT, q = r % I_OUT, kb = q >> 4, nb = q & 15; j = CvtJob{F.w_out() + (size_t)l * D * D, F.Wt_out() + (size_t)l * D * D, D, D, 64 * kb, 64 * nb, 64 * nb}; return j; } r -= N_OUT;
    f8 = MOE_FP8;
    if (r < N_GU) { const int le = r / I_GU, q = r % I_GU; const int kb = MOE_FP8 ? q >> 6 : q >> 5, nb = MOE_FP8 ? q & 63 : q & 31; const int n0 = (MOE_FP8 ? 32 : 64) * nb, bj = n0 >> 10, xx = n0 & 1023;
        j = CvtJob{F.w_gu() + (size_t)le * D * 2048, (bf16_t*)((unsigned char*)F.Wt_gu() + (size_t)le * 2048 * D * (MOE_FP8 ? 1 : 2)), 2048, D, (MOE_FP8 ? 128 : 64) * kb, n0, 256 * (xx >> 7) + 128 * bj + (xx & 127)}; return j; } r -= N_GU;
    { const int le = r / I_DN, q = r % I_DN; const int kb = MOE_FP8 ? q >> 5 : q >> 4, nb = MOE_FP8 ? q & 31 : q & 15; const int n0 = (MOE_FP8 ? 32 : 64) * nb;
      j = CvtJob{F.w_dn() + (size_t)le * D * D, (bf16_t*)((unsigned char*)F.Wt_dn() + (size_t)le * D * D * (MOE_FP8 ? 1 : 2)), D, D, (MOE_FP8 ? 128 : 64) * kb, n0, n0}; return j; }
}
__device__ __forceinline__ void cvt_ld(const CvtJob& j, bool f8, int lane, f32x4 (&r)[16]) { if (f8) cvt8_load(j, lane, r); else cvt_load(j, lane, r); }
__device__ __forceinline__ void cvt_st(const CvtJob& j, bool f8, int lane, const f32x4 (&r)[16]) { if (f8) cvt8_store(j, lane, r); else cvt_store(j, lane, r); }
constexpr int WIN_UNITS = (T / 256) * (DINX / 256), WIN_BUSY = WIN_UNITS % 256, DEF_WIN = MOE_FP8 ? 3 : 0, DEF_WOUT = 0;
constexpr int DEF_A = (256 - WIN_BUSY) * NWAVES * DEF_WIN, DEF_B = (256 - 4) * NWAVES * DEF_WOUT, DEF_C = DEF_A, DEF_TOTAL = DEF_A + DEF_B + DEF_C;
constexpr int CVT_GU0 = N_IN + N_OUT, CVT_GU1 = CVT_GU0 + NE * I_GU;
static_assert(DEF_A + DEF_B <= NE * I_GU && DEF_C <= NE * I_GU, "deferred slices inside one layer's gate/up items");
__device__ __forceinline__ int cvt_remap(int j) { int it = j; if (it >= CVT_GU0) it += DEF_A + DEF_B; if (it >= CVT_GU1) it += DEF_C; return it; }
__device__ __forceinline__ void cvt_run(Frame& F, int first, int stride, int limit, bool remap) {
    int it = first; if (it >= limit) return;
    f32x4 ra[16], rb[16]; bool fa, fb = false; CvtJob ja = cvt_job(F, remap ? cvt_remap(it) : it, fa), jb; cvt_ld(ja, fa, F.lane, ra);
    for (;;) {
        const int itb = it + stride; const bool hb = itb < limit; if (hb) { jb = cvt_job(F, remap ? cvt_remap(itb) : itb, fb); cvt_ld(jb, fb, F.lane, rb); }
        cvt_st(ja, fa, F.lane, ra); if (!hb) break;
        const int ita = itb + stride; const bool ha = ita < limit; if (ha) { ja = cvt_job(F, remap ? cvt_remap(ita) : ita, fa); cvt_ld(ja, fa, F.lane, ra); }
        cvt_st(jb, fb, F.lane, rb); if (!ha) break;
        it = ita;
    }
}
__device__ __forceinline__ void cvt_deferred(Frame& F, int base, int slot, int per_wave) { if (per_wave == 0) return; const int first = base + (slot * NWAVES + F.wave) * per_wave; cvt_run(F, first, 1, first + per_wave, false); }
__device__ __forceinline__ void ph_prologue(Frame& F) {
    const int gw = F.vcu * NWAVES + F.wave, NGW = F.G * NWAVES;
    for (int i = gw * 64 + F.lane; i < 1024; i += NGW * 64) { const float a = F.lbp()[i], b = F.lbp()[1024 + i], m = fmaxf(a, b), ea = __expf(a - m), eb = __expf(b - m); F.LB()[i] = 0.f; F.LB()[1024 + i] = eb / (ea + eb); }
    if (F.bid < 192) {
        LAS float* sc = (LAS float*)(F.lds); LAS float* part = sc + 2048;
        { const float* c = F.c(); const float* cc = F.cctx(); for (int i = F.tid; i < D; i += NTHR) { const float a = c[i], b = cc[i]; sc[i] = a * fsigm(a); sc[D + i] = b * fsigm(b); } }
        __syncthreads();
        const int l = F.bid / 96, jcol = (F.bid % 96) * 64 + F.lane; const GAS float* W = (const GAS float*)F.w_ada() + (unsigned)(l * D * 6144 + (128 * F.wave) * 6144 + jcol); float a0 = 0.f, a1 = 0.f;
#pragma unroll 16
        for (int i = 0; i < 128; ++i) { const float w = W[(unsigned)i * 6144u]; a0 += sc[128 * F.wave + i] * w; a1 += sc[D + 128 * F.wave + i] * w; }
        part[(F.wave * 2 + 0) * 64 + F.lane] = a0; part[(F.wave * 2 + 1) * 64 + F.lane] = a1;
        __syncthreads();
        if (F.tid < 128) { const int which = F.tid >> 6, col = F.tid & 63; float s = 0.f;
#pragma unroll
            for (int w = 0; w < 8; ++w) s += part[(w * 2 + which) * 64 + col];
            const int j = (F.bid % 96) * 64 + col; F.MOD()[(size_t)(l * 2 + which) * 6144 + j] = s + F.b_ada()[l * 6144 + j]; }
        __syncthreads();
    }
    cvt_run(F, gw, NGW, N_CVT - DEF_TOTAL, true);
}
__device__ __forceinline__ void row_load(const float* xrow, int lane, f32x4 (&v)[4]) { const GAS f32x4* xr = (const GAS f32x4*)xrow + lane;
#pragma unroll
    for (int j = 0; j < 4; ++j) v[j] = xr[64 * j]; }
__device__ __forceinline__ float row_rstd(const f32x4 (&v)[4], int lane) { float s = 0.f;
#pragma unroll
    for (int j = 0; j < 4; ++j) s += (v[j].x * v[j].x + v[j].y * v[j].y) + (v[j].z * v[j].z + v[j].w * v[j].w);
    return rsqrtf(wave_sum(s, lane) * (1.f / D) + 1e-6f); }
__device__ __forceinline__ void row_modulate(const f32x4 (&v)[4], float r, const float* g, const float* sc, const float* sh, int lane, f32x4 (&hv)[4]) {
#pragma unroll
    for (int j = 0; j < 4; ++j) { const f32x4 gg = ((const GAS f32x4*)g)[lane + 64 * j], s1 = ((const GAS f32x4*)sc)[lane + 64 * j], s0 = ((const GAS f32x4*)sh)[lane + 64 * j];
        hv[j] = v[j] * r * gg * (s1 + 1.f) + s0; } }
__device__ __forceinline__ void row_store_fp8(unsigned char* orow, int lane, const f32x4 (&hv)[4]) { GAS unsigned* o4 = (GAS unsigned*)orow + lane;
#pragma unroll
    for (int j = 0; j < 4; ++j) o4[64 * j] = pk4_fp8(hv[j].x * FP8_SH, hv[j].y * FP8_SH, hv[j].z * FP8_SH, hv[j].w * FP8_SH); }
__device__ __forceinline__ void row_store_bf16(bf16_t* orow, int lane, const f32x4 (&hv)[4]) { GAS u32x2* o8 = (GAS u32x2*)orow + lane;
#pragma unroll
    for (int j = 0; j < 4; ++j) { u32x2 w; w.x = pk2(hv[j].x, hv[j].y); w.y = pk2(hv[j].z, hv[j].w); o8[64 * j] = w; } }

__device__ __forceinline__ void ph_mod1(Frame& F, int l) {
    const int gw = F.vcu * NWAVES + F.wave, NGW = F.G * NWAVES;
    for (int row = gw; row < T; row += NGW) {
        const float* xr = l == 0 ? (row < CTX ? F.ctxin() + (size_t)row * D : F.x() + (size_t)(row - CTX) * D) : F.X() + (size_t)row * D;
        const float* m = F.MOD() + (size_t)(l * 2 + (row < CTX ? 1 : 0)) * 6144;
        f32x4 v[4], hv[4]; row_load(xr, F.lane, v); const float r = row_rstd(v, F.lane); row_modulate(v, r, F.norm1_g() + l * D, m + D, m, F.lane, hv); row_store_bf16(F.H() + (size_t)row * D, F.lane, hv);
    }
}

constexpr int RA_ST = 2064, RA_HALF = 16 * RA_ST, RA_BUF = 2 * RA_HALF;
constexpr int RLG_OFF = 2 * RA_BUF, RSCR_OFF = RLG_OFF + 8592;
static_assert(8 * 80 * 32 * 4 <= RLG_OFF && 65 * 33 * 4 <= 8592 && RSCR_OFF + 3520 <= MISC_OFF && RSCR_OFF % 16 == 0, "router LDS map");
__device__ __forceinline__ void split2(float a, float b, unsigned& hi, unsigned& lo) { hi = cvt_pk_bf16(a, b); lo = cvt_pk_bf16(a - bflo(hi), b - bfhi(hi)); }
__device__ __forceinline__ void ph_mod2_route(Frame& F, int l, int cbank) {
    LAS unsigned char* L = F.lds + RING_OFF; LAS float* LG = (LAS float*)(L + RLG_OFF);
    LAS int* lcnt = (LAS int*)(L + RSCR_OFF); LAS int* lbase = lcnt + 32; LAS int* te = lbase + 32; LAS float* tw = (LAS float*)(te + 272); LAS int* trk = (LAS int*)(tw + 272);
    int ln = F.lane; asm volatile("" : "+v"(ln)); const int w = F.wave, fr = ln & 15, g = ln >> 4;
    __syncthreads();
    if (F.tid < 32) lcnt[F.tid] = 0;
    const int row0 = F.bid * 65;
    const float* Xp = F.X(); const float* n2g = F.norm2_g() + l * D; const float* modl = F.MOD() + (size_t)(l * 2) * 6144; bf16_t* Hp = F.H(); unsigned char* H8p = F.ws + WS_H8;
    f32x4 v[2][4];
#pragma unroll
    for (int i = 0; i < 2; ++i) row_load(Xp + (size_t)(row0 + min(2 * w + i, 64)) * D, ln, v[i]);
    bf16x8 Bh[4][2], Bl[4][2];
    { const GAS float* rw = (const GAS float*)F.router_w() + (unsigned)(l * D * NE + (128 * w + 8 * g) * NE + fr);
#pragma unroll
      for (int s_ = 0; s_ < 4; ++s_)
#pragma unroll
          for (int nb = 0; nb < 2; ++nb) { float x[8];
#pragma unroll
              for (int i = 0; i < 8; ++i) x[i] = rw[(32 * s_ + i) * NE + 16 * nb];
              unsigned h_[4], l_[4]; split2(x[0], x[1], h_[0], l_[0]); split2(x[2], x[3], h_[1], l_[1]); split2(x[4], x[5], h_[2], l_[2]); split2(x[6], x[7], h_[3], l_[3]); const u32x4 hi = (u32x4){h_[0], h_[1], h_[2], h_[3]}, lo = (u32x4){l_[0], l_[1], l_[2], l_[3]};
              Bh[s_][nb] = __builtin_bit_cast(bf16x8, hi); Bl[s_][nb] = __builtin_bit_cast(bf16x8, lo); } }
    f32x4 acc[5][2];
#pragma unroll
    for (int b = 0; b < 5; ++b) { acc[b][0] = (f32x4){0.f, 0.f, 0.f, 0.f}; acc[b][1] = (f32x4){0.f, 0.f, 0.f, 0.f}; }
#pragma unroll
    for (int b = 0; b < 5; ++b) {
        LAS unsigned char* Ab = L + (b & 1) * RA_BUF;
#pragma unroll
        for (int i = 0; i < 2; ++i) { const int lr = 16 * b + 2 * w + i, row = row0 + min(lr, 64); const float* m = modl + (row < CTX ? 6144 : 0);
            const float rs = row_rstd(v[i], ln); f32x4 h[4]; row_modulate(v[i], rs, n2g, m + 4 * D, m + 3 * D, ln, h);
            if (lr < 65) { if (MOE_FP8) row_store_fp8(H8p + (size_t)row * D, ln, h); else row_store_bf16(Hp + (size_t)row * D, ln, h); }
#pragma unroll
            for (int j = 0; j < 4; ++j) { unsigned h0, l0, h1, l1; split2(h[j].x, h[j].y, h0, l0); split2(h[j].z, h[j].w, h1, l1); const u32x2 hi = (u32x2){h0, h1}, lo = (u32x2){l0, l1};
                LAS unsigned char* ap = Ab + (2 * w + i) * RA_ST + (4 * ln + 256 * j) * 2; *(LAS u32x2*)ap = hi; *(LAS u32x2*)(ap + RA_HALF) = lo; } }
        if (b < 4) {
#pragma unroll
            for (int i = 0; i < 2; ++i) row_load(Xp + (size_t)(row0 + min(16 * (b + 1) + 2 * w + i, 64)) * D, ln, v[i]); }
        __syncthreads();
#pragma unroll
        for (int s_ = 0; s_ < 4; ++s_) { const LAS unsigned char* ap = Ab + fr * RA_ST + (128 * w + 32 * s_ + 8 * g) * 2; const bf16x8 ah = *(const LAS bf16x8*)ap, al = *(const LAS bf16x8*)(ap + RA_HALF);
#pragma unroll
            for (int nb = 0; nb < 2; ++nb) { f32x4 c = acc[b][nb]; c = __builtin_amdgcn_mfma_f32_16x16x32_bf16(ah, Bh[s_][nb], c, 0, 0, 0); c = __builtin_amdgcn_mfma_f32_16x16x32_bf16(ah, Bl[s_][nb], c, 0, 0, 0);
                c = __builtin_amdgcn_mfma_f32_16x16x32_bf16(al, Bh[s_][nb], c, 0, 0, 0); acc[b][nb] = c; } }
    }
    __syncthreads();
    { LAS float* PT = (LAS float*)L;
#pragma unroll
      for (int b = 0; b < 5; ++b)
#pragma unroll
          for (int nb = 0; nb < 2; ++nb)
#pragma unroll
              for (int r = 0; r < 4; ++r) PT[(w * 80 + 16 * b + 4 * g + r) * 32 + 16 * nb + fr] = acc[b][nb][r];
      __syncthreads();
      for (int i = F.tid; i < 65 * 32; i += NTHR) { const int row = i >> 5, e = i & 31; float sacc = F.router_b()[l * NE + e];
#pragma unroll
          for (int w2 = 0; w2 < 8; ++w2) sacc += PT[(w2 * 80 + row) * 32 + e];
          LG[row * 33 + e] = sacc; } }
    __syncthreads();
    if (F.tid < 65) { const int row = F.tid; float bv[4] = {-3.0e38f, -3.0e38f, -3.0e38f, -3.0e38f}; int bi[4] = {0, 0, 0, 0};
#pragma unroll
        for (int e = 0; e < 32; ++e) { const float x = LG[row * 33 + e]; const bool c0 = x > bv[0], c1 = x > bv[1], c2 = x > bv[2], c3 = x > bv[3];
            bv[3] = c2 ? bv[2] : (c3 ? x : bv[3]); bi[3] = c2 ? bi[2] : (c3 ? e : bi[3]); bv[2] = c1 ? bv[1] : (c2 ? x : bv[2]); bi[2] = c1 ? bi[1] : (c2 ? e : bi[2]);
            bv[1] = c0 ? bv[0] : (c1 ? x : bv[1]); bi[1] = c0 ? bi[0] : (c1 ? e : bi[1]); bv[0] = c0 ? x : bv[0]; bi[0] = c0 ? e : bi[0]; }
        float ex[4], sum = 0.f;
#pragma unroll
        for (int q = 0; q < 4; ++q) { ex[q] = __expf(bv[q] - bv[0]); sum += ex[q]; }
        const float inv = 1.f / sum;
#pragma unroll
        for (int q = 0; q < 4; ++q) { te[row * 4 + q] = bi[q]; tw[row * 4 + q] = ex[q] * inv; trk[row * 4 + q] = (int)__hip_atomic_fetch_add((LAS unsigned*)&lcnt[bi[q]], 1u, __ATOMIC_RELAXED, __HIP_MEMORY_SCOPE_WORKGROUP); } }
    __syncthreads();
    if (F.tid < 32) lbase[F.tid] = (int)__hip_atomic_fetch_add((unsigned*)(F.ctl() + CW_CNT + (cbank * 32 + F.tid) * 64), (unsigned)lcnt[F.tid], RLX_AGENT);
    __syncthreads();
    for (int i = F.tid; i < 65 * 4; i += NTHR) { const int row = row0 + (i >> 2), e = te[i], pos = lbase[e] + trk[i];
        F.TOPI()[row * 4 + (i & 3)] = e; F.TOPW()[row * 4 + (i & 3)] = tw[i]; F.POS()[row * 4 + (i & 3)] = pos; F.LISTE()[(size_t)e * T + pos] = row; }
    __syncthreads();
}

__device__ __forceinline__ int moe_tiles(Frame& F, int l) {
    LAS int* tinfo = (LAS int*)(F.lds + TINFO_OFF); LAS int* bt = (LAS int*)(F.lds + BT_OFF); LAS int* cn = bt + 32; LAS int* ntl = bt + 64;
    __syncthreads();
    if (F.tid < 64) {
        const int e = F.lane & 31; const int c = (int)__hip_atomic_load(F.ctl() + CW_CNT + (l * 32 + e) * 64, RLX_AGENT); const int nt = (c + 255) >> 8;
        int incl = nt;
#pragma unroll
        for (int o = 1; o < 32; o <<= 1) { const int t = lane_get(incl, (F.lane - o) & 63); if (e >= o) incl += t; }
        const int first = incl - nt;
        if (F.lane < 32) { bt[e] = first; cn[e] = c; for (int j = 0; j < nt; ++j) { LAS int* ti = tinfo + 4 * (first + j); ti[0] = e; ti[1] = 0; ti[2] = 256 * j; ti[3] = min(256, c - 256 * j); } if (e == 31) ntl[0] = incl; }
    }
    __syncthreads();
    return ntl[0];
}

__device__ __forceinline__ void ph_gateup(Frame& F, int l) {
    const int ntiles = moe_tiles(F, l); constexpr int EB = MOE_FP8 ? 1 : 2;
    LAS int* tinfo = (LAS int*)(F.lds + TINFO_OFF); LAS unsigned* rowoff = (LAS unsigned*)(F.lds + ROWOFF_OFF);
    MoeOrder<true> S; S.tinfo = tinfo; S.rowoff = rowoff; S.ntiles = ntiles; S.nN = 8; S.G = F.G; S.c = F.vcu; S.Kb = D * EB; S.W = (const char*)F.Wt_gu() + (size_t)l * NE * 2048 * D * EB; S.wstride = (size_t)2048 * D * EB;
    for (int i = 0;; ++i) { pg8::Unit u; if (!S.next(i, u) || i >= 10) break;
        if (F.tid < 256) { const int pos0 = tinfo[4 * u.pm + 2], valid = tinfo[4 * u.pm + 3]; const int tok = F.tid < valid ? F.LISTE()[(size_t)u.e * T + pos0 + F.tid] : 0; rowoff[i * 256 + F.tid] = (unsigned)tok * (unsigned)(D * EB); } }
    __syncthreads();
    if constexpr (MOE_FP8) { EpiAct8 E{(unsigned char*)F.ACT(), F.b_gu() + (size_t)l * NE * 2048};
        pg8::gemm_phase<EpiAct8, MoeOrder<true>, true, true>(F.lds + RING_OFF, (const char*)(F.ws + WS_H8), D, S, E, F.tid); }
    else { EpiAct E{F.ACT(), F.b_gu() + (size_t)l * NE * 2048};
        pg8::gemm_phase<EpiAct, MoeOrder<true>, true, false>(F.lds + RING_OFF, (const char*)F.H(), 2 * D, S, E, F.tid); }
}
__device__ __forceinline__ void ph_down(Frame& F, int l) {
    const int ntiles = moe_tiles(F, l); constexpr int EB = MOE_FP8 ? 1 : 2;
    MoeOrder<false> S; S.tinfo = (LAS int*)(F.lds + TINFO_OFF); S.rowoff = nullptr; S.ntiles = ntiles; S.nN = 4; S.G = F.G; S.c = F.vcu; S.Kb = D * EB; S.W = (const char*)F.Wt_dn() + (size_t)l * NE * D * D * EB; S.wstride = (size_t)D * D * EB;
    if constexpr (MOE_FP8) { EpiY8 E{F.Y(), F.b_dn() + (size_t)l * NE * D};
        pg8::gemm_phase<EpiY8, MoeOrder<false>, true, true>(F.lds + RING_OFF, (const char*)F.ACT(), D, S, E, F.tid); }
    else { EpiY E{F.Y(), F.b_dn() + (size_t)l * NE * D};
        pg8::gemm_phase<EpiY, MoeOrder<false>, true, false>(F.lds + RING_OFF, (const char*)F.ACT(), 2 * D, S, E, F.tid); }
}
__device__ __forceinline__ void ph_win(Frame& F, int l) {
    DenseOrder S; S.init(T / 256, DINX / 256, F.G, F.bid, 2 * D, F.Wt_in() + (size_t)l * DINX * D);
    EpiP E{F.P(), DINX, F.LB() + l * 1024};
    pg8::gemm_phase<EpiP, DenseOrder, true>(F.lds + RING_OFF, (const char*)F.H(), 2 * D, S, E, F.tid);
    if (F.bid >= WIN_BUSY) cvt_deferred(F, l == 0 ? CVT_GU0 : CVT_GU1, F.bid - WIN_BUSY, DEF_WIN);
}
__device__ __forceinline__ void wout_ctx(Frame& F, int l) {
    int ln = F.lane; asm volatile("" : "+v"(ln)); const int w = F.wave, fr = ln & 15, g = ln >> 4, rb = F.bid >> 4, cbk = F.bid & 15;
    const GAS bf16x8* ap = (const GAS bf16x8*)((const GAS bf16_t*)F.CAT() + (unsigned)((16 * rb + fr) * D + 128 * w + 8 * g));
    const GAS bf16x8* bp = (const GAS bf16x8*)((const GAS bf16_t*)F.Wt_out() + (unsigned)(l * D * D + (64 * cbk + fr) * D + 128 * w + 8 * g));
    bf16x8 a[4], b[4][4];
#pragma unroll
    for (int s_ = 0; s_ < 4; ++s_) { a[s_] = ap[4 * s_];
#pragma unroll
        for (int nb = 0; nb < 4; ++nb) b[nb][s_] = bp[(unsigned)(nb * 16 * D / 8) + 4 * s_]; }
    f32x4 acc[4];
#pragma unroll
    for (int nb = 0; nb < 4; ++nb) { acc[nb] = (f32x4){0.f, 0.f, 0.f, 0.f};
#pragma unroll
        for (int s_ = 0; s_ < 4; ++s_) acc[nb] = __builtin_amdgcn_mfma_f32_16x16x32_bf16(a[s_], b[nb][s_], acc[nb], 0, 0, 0); }
    LAS float* PT = (LAS float*)(F.lds + RING_OFF);
    __syncthreads();
#pragma unroll
    for (int nb = 0; nb < 4; ++nb)
#pragma unroll
        for (int r = 0; r < 4; ++r) PT[(w * 16 + 4 * g + r) * 64 + 16 * nb + fr] = acc[nb][r];
    __syncthreads();
    const float* m = F.MOD() + (size_t)(l * 2) * 6144; const float* gate = m + 6144 + 2 * D; const float* base = l == 0 ? F.ctxin() : F.X();
#pragma unroll
    for (int i = 0; i < 2; ++i) { const int o = F.tid + NTHR * i, row = o >> 6, col = o & 63; float sacc = 0.f;
#pragma unroll
        for (int w2 = 0; w2 < 8; ++w2) sacc += PT[(w2 * 16 + row) * 64 + col];
        const int gr = 16 * rb + row, gc = 64 * cbk + col; F.X()[(size_t)gr * D + gc] = base[(size_t)gr * D + gc] + gate[gc] * sacc; }
    __syncthreads();
}
__device__ __forceinline__ void ph_wout(Frame& F, int l) {
    DenseOrder S; S.init(LAT / 256, D / 256, F.G, F.bid, 2 * D, F.Wt_out() + (size_t)l * D * D, 1);
    const float* m = F.MOD() + (size_t)(l * 2) * 6144;
    EpiRes E{l == 0 ? F.ctxin() : F.X(), l == 0 ? F.x() : F.X() + (size_t)CTX * D, m + 6144 + 2 * D, m + 2 * D, F.X()};
    pg8::gemm_phase<EpiRes, DenseOrder, true>(F.lds + RING_OFF, (const char*)F.CAT(), 2 * D, S, E, F.tid);
    if (l == 0) wout_ctx(F, l);
}
__device__ __forceinline__ void combine_gather(const Frame& F, const LAS int* bt, int row, int ln, f32x4 (&v)[4], u32x2 (&y)[4][4], float (&w)[4]) {
    row_load(F.X() + (size_t)row * D, ln, v);
    const GAS int* ti = (const GAS int*)F.TOPI() + (unsigned)(row * 4); const GAS float* tw = (const GAS float*)F.TOPW() + (unsigned)(row * 4); const GAS int* tp = (const GAS int*)F.POS() + (unsigned)(row * 4);
#pragma unroll
    for (int q = 0; q < 4; ++q) { const int e = ti[q]; w[q] = tw[q]; const int srow = 256 * bt[e] + tp[q]; const GAS u32x2* yr = (const GAS u32x2*)((const GAS bf16_t*)F.Y() + (unsigned)srow * (unsigned)D) + ln;
#pragma unroll
        for (int j = 0; j < 4; ++j) y[q][j] = yr[64 * j]; }
}
__device__ __forceinline__ void combine_finish(const Frame& F, int l, int row, int ln, f32x4 (&v)[4], const u32x2 (&y)[4][4], const float (&w)[4]) {
    const float* m = F.MOD() + (size_t)(l * 2 + (row < CTX ? 1 : 0)) * 6144 + 5 * D;
#pragma unroll
    for (int j = 0; j < 4; ++j) { f32x4 s = (f32x4){0.f, 0.f, 0.f, 0.f};
#pragma unroll
        for (int q = 0; q < 4; ++q) s += w[q] * (f32x4){bflo(y[q][j].x), bfhi(y[q][j].x), bflo(y[q][j].y), bfhi(y[q][j].y)};
        v[j] += ((const GAS f32x4*)m)[ln + 64 * j] * s; }
    const float r = row_rstd(v, ln);
    if (l == 0) {
        GAS f32x4* xo = (GAS f32x4*)(F.X() + (size_t)row * D) + ln;
#pragma unroll
        for (int j = 0; j < 4; ++j) xo[64 * j] = v[j];
        const float* m1 = F.MOD() + (size_t)(2 + (row < CTX ? 1 : 0)) * 6144; f32x4 hv[4];
        row_modulate(v, r, F.norm1_g() + D, m1 + D, m1, ln, hv); row_store_bf16(F.H() + (size_t)row * D, ln, hv);
    } else {
        GAS f32x4* o = (GAS f32x4*)(F.out() + (size_t)(row - CTX) * D) + ln; const float* fg = F.fng();
#pragma unroll
        for (int j = 0; j < 4; ++j) o[64 * j] = v[j] * r * ((const GAS f32x4*)fg)[ln + 64 * j];
    }
}
__device__ __forceinline__ void ph_combine(Frame& F, int l) {
    (void)moe_tiles(F, l);
    const LAS int* bt = (const LAS int*)(F.lds + BT_OFF);
    const int gw = F.vcu * NWAVES + F.wave, NGW = F.G * NWAVES; const int rbeg = l == 1 ? CTX : 0;
#pragma unroll 1
    for (int ra = rbeg + gw; ra < T; ra += 2 * NGW) {
        int ln = F.lane; asm volatile("" : "+v"(ln));
        const int rb = ra + NGW; const bool hasb = rb < T; const int rbc = hasb ? rb : ra;
        f32x4 va[4], vb[4]; u32x2 ya[4][4], yb[4][4]; float wa[4], wb[4];
        combine_gather(F, bt, ra, ln, va, ya, wa); combine_gather(F, bt, rbc, ln, vb, yb, wb);
        combine_finish(F, l, ra, ln, va, ya, wa);
        if (hasb) combine_finish(F, l, rb, ln, vb, yb, wb);
    }
}
constexpr size_t WF_MA = 0, WF_MB = 128 * 1024, WF_MC = 256 * 1024, WF_PW = 512 * 1024;
constexpr int ZS = 528;
__device__ __forceinline__ f32x4 mfma16(bf16x8 a, bf16x8 b, f32x4 c) { return __builtin_amdgcn_mfma_f32_16x16x32_bf16(a, b, c, 0, 0, 0); }

__device__ __forceinline__ void ph_prologue2(Frame& F) {
    bf16_t* MA = (bf16_t*)(F.ws + WS_WF + WF_MA); bf16_t* MB = (bf16_t*)(F.ws + WS_WF + WF_MB); bf16_t* MC = (bf16_t*)(F.ws + WS_WF + WF_MC); bf16_t* PW = (bf16_t*)(F.ws + WS_WF + WF_PW);
    const int gt = F.bid * NTHR + F.tid, NT = F.G * NTHR;
    for (int i = gt; i < 256 * 256; i += NT) { const int r = i >> 8, cidx = i & 255, ri = r >> 7, k1 = r & 127, rj = cidx >> 7, t1 = cidx & 127; const float x = 2.f * (float)((k1 * t1) & 127) / 128.f;
        const float cs = cospif(x), sn = sinpif(x); const float v = ri == 0 ? (rj == 0 ? cs : -sn) : (rj == 0 ? -sn : -cs); MA[i] = (bf16_t)f2bf(v); }
    for (int i = gt; i < 128 * 256; i += NT) { const int k2 = i >> 8, cidx = i & 255, rj = cidx >> 7, t2 = cidx & 127; const float x = 2.f * (float)((k2 * t2) & 127) / 128.f; MB[i] = (bf16_t)f2bf(rj == 0 ? cospif(x) : sinpif(x)); }
    for (int i = gt; i < 256 * 512; i += NT) { const int k = i >> 9, cidx = i & 511, rj = cidx >> 8, t = cidx & 255; const float x = 2.f * (float)((k * t) & 255) / 256.f; MC[i] = (bf16_t)f2bf(rj == 0 ? cospif(x) : -sinpif(x)); }
    for (int i = gt; i < 2 * 4 * 64 * 64; i += NT) { const int lg = i >> 12, j = (i >> 6) & 63, ii = i & 63; PW[i] = (bf16_t)f2bf(F.pool_w()[(size_t)lg * 4096 + ii * 64 + j]); }
    LAS float* m12T = (LAS float*)(F.lds);
    LAS float* trig = (LAS float*)(F.lds + 33280);
    LAS float* fws = (LAS float*)(F.lds + 33280 + 512);
    __syncthreads();
    if (F.tid < 64) { trig[F.tid] = cospif(2.f * (float)F.tid / 64.f); trig[64 + F.tid] = sinpif(2.f * (float)F.tid / 64.f); }
    __syncthreads();
    bf16x8 TH[2], TL[2];
    { const int c = 16 * (F.wave >> 1) + (F.lane & 15), g = F.lane >> 4, sel0 = (F.bid & 15) >> 3;
#pragma unroll
      for (int s_ = 0; s_ < 2; ++s_) { float t[8];
#pragma unroll
          for (int i = 0; i < 8; ++i) t[i] = trig[sel0 * 64 + (((32 * s_ + 8 * g + i) * c) & 63)];
          unsigned h_[4], l_[4]; split2(t[0], t[1], h_[0], l_[0]); split2(t[2], t[3], h_[1], l_[1]); split2(t[4], t[5], h_[2], l_[2]); split2(t[6], t[7], h_[3], l_[3]);
          TH[s_] = __builtin_bit_cast(bf16x8, (u32x4){h_[0], h_[1], h_[2], h_[3]}); TL[s_] = __builtin_bit_cast(bf16x8, (u32x4){l_[0], l_[1], l_[2], l_[3]}); } }
    for (int tile = F.bid; tile < 2 * 256; tile += F.G) {
        const int l = tile >> 8, kb = (tile >> 4) & 15, nb = tile & 15, k0 = 64 * kb, n0 = 32 * nb, sel = n0 >> 8, nn0 = n0 & 255;
        const int mb = F.wave >> 1, nh = F.wave & 1, fr = F.lane & 15, g = F.lane >> 4;
        __syncthreads();
        f32x4 wa[8][2];
        { const GAS f32x4* wp = (const GAS f32x4*)((const GAS float*)F.w_in() + (unsigned)(l * D * DIN + (k0 + 16 * mb + fr) * DIN + 2816 + 8 * g));
#pragma unroll
          for (int s_ = 0; s_ < 8; ++s_) { wa[s_][0] = wp[8 * s_]; wa[s_][1] = wp[8 * s_ + 1]; } }
        for (int i = F.tid; i < 256 * 32; i += NTHR) fws[i] = F.four_w()[(size_t)l * 65536 + (size_t)(i >> 5) * 256 + nn0 + (i & 31)];
        __syncthreads();
#pragma unroll
        for (int hh = 0; hh < 4; ++hh) { f32x4 mm = (f32x4){0.f, 0.f, 0.f, 0.f};
#pragma unroll
            for (int s_ = 0; s_ < 2; ++s_) { float t[8];
#pragma unroll
                for (int i = 0; i < 8; ++i) t[i] = fws[(hh * 64 + 32 * s_ + 8 * g + i) * 32 + 16 * nh + fr];
                unsigned h_[4], l_[4]; split2(t[0], t[1], h_[0], l_[0]); split2(t[2], t[3], h_[1], l_[1]); split2(t[4], t[5], h_[2], l_[2]); split2(t[6], t[7], h_[3], l_[3]);
                const bf16x8 BH = __builtin_bit_cast(bf16x8, (u32x4){h_[0], h_[1], h_[2], h_[3]}), BL = __builtin_bit_cast(bf16x8, (u32x4){l_[0], l_[1], l_[2], l_[3]});
                mm = mfma16(TH[s_], BH, mm); mm = mfma16(TH[s_], BL, mm); mm = mfma16(TL[s_], BH, mm); }
            *(LAS f32x4*)(m12T + (16 * nh + fr) * 260 + hh * 64 + 16 * mb + 4 * g) = mm; }
        __syncthreads();
        f32x4 o = (f32x4){0.f, 0.f, 0.f, 0.f};
#pragma unroll
        for (int s_ = 0; s_ < 8; ++s_) { const LAS float* bp = m12T + (16 * nh + fr) * 260 + 32 * s_ + 8 * g; const f32x4 b0 = *(const LAS f32x4*)bp, b1 = *(const LAS f32x4*)(bp + 4);
            unsigned ah[4], al[4], bh[4], bl[4];
            split2(wa[s_][0][0], wa[s_][0][1], ah[0], al[0]); split2(wa[s_][0][2], wa[s_][0][3], ah[1], al[1]); split2(wa[s_][1][0], wa[s_][1][1], ah[2], al[2]); split2(wa[s_][1][2], wa[s_][1][3], ah[3], al[3]);
            split2(b0[0], b0[1], bh[0], bl[0]); split2(b0[2], b0[3], bh[1], bl[1]); split2(b1[0], b1[1], bh[2], bl[2]); split2(b1[2], b1[3], bh[3], bl[3]);
            const bf16x8 AH = __builtin_bit_cast(bf16x8, (u32x4){ah[0], ah[1], ah[2], ah[3]}), AL = __builtin_bit_cast(bf16x8, (u32x4){al[0], al[1], al[2], al[3]});
            const bf16x8 BH = __builtin_bit_cast(bf16x8, (u32x4){bh[0], bh[1], bh[2], bh[3]}), BL = __builtin_bit_cast(bf16x8, (u32x4){bl[0], bl[1], bl[2], bl[3]});
            o = mfma16(AH, BH, o); o = mfma16(AH, BL, o); o = mfma16(AL, BH, o); }
        { float o0 = o[0], o1 = o[1], o2 = o[2], o3 = o[3]; asm volatile("s_nop 15\n\ts_nop 7" : "+v"(o0), "+v"(o1), "+v"(o2), "+v"(o3));
          u32x2 wv; wv.x = pk2(o0, o1); wv.y = pk2(o2, o3);
          *(u32x2*)(F.Wt_in() + (size_t)l * DINX * D + (size_t)(FQ_OFF + n0 + 16 * nh + fr) * D + k0 + 16 * mb + 4 * g) = wv; }
    }
    __syncthreads();
}

template <class SrcF> __device__ __forceinline__ void load_tile_T(LAS unsigned char* zt, const SrcF& src, int tid) {
    const int pg = tid >> 4, cc = tid & 15; u32x4 r[8];
#pragma unroll
    for (int i = 0; i < 8; ++i) r[i] = *(const GAS u32x4*)(src(8 * pg + i) + 8 * cc);
#pragma unroll
    for (int j = 0; j < 8; ++j) { const unsigned sel = (j & 1) ? 0x07060302u : 0x05040100u; u32x4 o;
        o.x = __builtin_amdgcn_perm(r[1][j >> 1], r[0][j >> 1], sel); o.y = __builtin_amdgcn_perm(r[3][j >> 1], r[2][j >> 1], sel);
        o.z = __builtin_amdgcn_perm(r[5][j >> 1], r[4][j >> 1], sel); o.w = __builtin_amdgcn_perm(r[7][j >> 1], r[6][j >> 1], sel);
        *(LAS u32x4*)(zt + (8 * cc + j) * ZS + 16 * pg) = o; }
}
__device__ __forceinline__ void tile_mma(const LAS unsigned char* zt, const bf16_t* mat_row  , f32x4 (&acc)[8], int lane) {
    const int fr = lane & 15, g = lane >> 4;
#pragma unroll
    for (int ks = 0; ks < 8; ++ks) { const bf16x8 b = *(const GAS bf16x8*)(mat_row + 32 * ks + 8 * g);
#pragma unroll
        for (int m = 0; m < 8; ++m) { const bf16x8 a = *(const LAS bf16x8*)(zt + (16 * m + fr) * ZS + (32 * ks + 8 * g) * 2); acc[m] = mfma16(a, b, acc[m]); }
        if (ks & 1) __builtin_amdgcn_sched_barrier(0); }
}
__device__ __forceinline__ void tile_mma2(const LAS unsigned char* zt, const bf16_t* mat_row0, const bf16_t* mat_row1, f32x4 (&acc0)[8], f32x4 (&acc1)[8], int lane) {
    const int fr = lane & 15, g = lane >> 4;
#pragma unroll
    for (int ks = 0; ks < 8; ++ks) { const bf16x8 b0 = *(const GAS bf16x8*)(mat_row0 + 32 * ks + 8 * g), b1 = *(const GAS bf16x8*)(mat_row1 + 32 * ks + 8 * g);
#pragma unroll
        for (int m = 0; m < 8; ++m) { const bf16x8 a = *(const LAS bf16x8*)(zt + (16 * m + fr) * ZS + (32 * ks + 8 * g) * 2); acc0[m] = mfma16(a, b0, acc0[m]); acc1[m] = mfma16(a, b1, acc1[m]); }
        __builtin_amdgcn_sched_barrier(0); }
}
struct SrcA { const bf16_t* P; int t2, hc; __device__ __forceinline__ const bf16_t* operator()(int p) const { const int ri = p >> 7, t1 = p & 127; return P + (size_t)(CTX + 128 * t1 + t2) * DINX + FQ_OFF + ri * 256 + 128 * hc; } };
struct SrcB { const bf16_t* Y; int k1, hc; __device__ __forceinline__ const bf16_t* operator()(int p) const { const int ri = p >> 7, t2 = p & 127; return Y + ((size_t)(k1 * 128 + t2) * 2 + ri) * 256 + 128 * hc; } };
struct SrcC { const bf16_t* P; int ri, hc; __device__ __forceinline__ const bf16_t* operator()(int p) const { return P + (size_t)p * DINX + FQ_OFF + ri * 256 + 128 * hc; } };

__device__ __forceinline__ void fftA_item(Frame& F, int item) {
    const int t2 = item >> 1, hc = item & 1; LAS unsigned char* zt = F.lds + RING_OFF;
    bf16_t* YP = (bf16_t*)(F.ws + WS_YP); const bf16_t* MA = (const bf16_t*)(F.ws + WS_WF + WF_MA);
    __syncthreads();
    load_tile_T(zt, SrcA{F.P(), t2, hc}, F.tid);
    __syncthreads();
    const int fr = F.lane & 15, g = F.lane >> 4, k1 = 16 * F.wave + fr;
    f32x4 ar[8], ai[8];
#pragma unroll
    for (int m = 0; m < 8; ++m) { ar[m] = (f32x4){0.f, 0.f, 0.f, 0.f}; ai[m] = (f32x4){0.f, 0.f, 0.f, 0.f}; }
    tile_mma2(zt, MA + (size_t)k1 * 256, MA + (size_t)(128 + k1) * 256, ar, ai, F.lane);
    const float x = 2.f * (float)(t2 * k1) / 16384.f; const float cs = cospif(x), sn = sinpif(x);
    bf16_t* yr = YP + ((size_t)(k1 * 128 + t2) * 2) * 256 + 128 * hc + 4 * g;
#pragma unroll
    for (int m = 0; m < 8; ++m) { const f32x4 a = ar[m], b = ai[m]; const f32x4 pr = a * cs + b * sn, pi = b * cs - a * sn;
        u32x2 w; w.x = pk2(pr[0], pr[1]); w.y = pk2(pr[2], pr[3]); *(u32x2*)(yr + 16 * m) = w;
        u32x2 v; v.x = pk2(pi[0], pi[1]); v.y = pk2(pi[2], pi[3]); *(u32x2*)(yr + 256 + 16 * m) = v; }
}
__device__ __forceinline__ void fftB_item(Frame& F, int item) {
    const int k1 = item >> 1, hc = item & 1; LAS unsigned char* zt = F.lds + RING_OFF;
    const bf16_t* YP = (const bf16_t*)(F.ws + WS_YP); const bf16_t* MB = (const bf16_t*)(F.ws + WS_WF + WF_MB);
    __syncthreads();
    load_tile_T(zt, SrcB{YP, k1, hc}, F.tid);
    __syncthreads();
    const int fr = F.lane & 15, g = F.lane >> 4, k2 = 16 * F.wave + fr;
    f32x4 acc[8];
#pragma unroll
    for (int m = 0; m < 8; ++m) acc[m] = (f32x4){0.f, 0.f, 0.f, 0.f};
    tile_mma(zt, MB + (size_t)k2 * 256, acc, F.lane);
    bf16_t* o = F.CAT() + (size_t)(CTX + k1 + 128 * k2) * D + 768 + 128 * hc + 4 * g;
#pragma unroll
    for (int m = 0; m < 8; ++m) { const f32x4 a = acc[m] * (1.f / 1024.f); u32x2 w; w.x = pk2(a[0], a[1]); w.y = pk2(a[2], a[3]); *(u32x2*)(o + 16 * m) = w; }
}
__device__ __forceinline__ void fftC_item(Frame& F, int item) {
    const int kh = item >> 1, hc = item & 1; LAS unsigned char* zt = F.lds + RING_OFF; const bf16_t* MC = (const bf16_t*)(F.ws + WS_WF + WF_MC);
    const int fr = F.lane & 15, g = F.lane >> 4, k = 128 * kh + 16 * F.wave + fr;
    f32x4 acc[8];
#pragma unroll
    for (int m = 0; m < 8; ++m) acc[m] = (f32x4){0.f, 0.f, 0.f, 0.f};
    for (int ri = 0; ri < 2; ++ri) {
        __syncthreads();
        load_tile_T(zt, SrcC{F.P(), ri, hc}, F.tid);
        __syncthreads();
        tile_mma(zt, MC + (size_t)k * 512 + ri * 256, acc, F.lane);
    }
    bf16_t* o = F.CAT() + (size_t)k * D + 768 + 128 * hc + 4 * g;
#pragma unroll
    for (int m = 0; m < 8; ++m) { const f32x4 a = acc[m] * (1.f / 128.f); u32x2 w; w.x = pk2(a[0], a[1]); w.y = pk2(a[2], a[3]); *(u32x2*)(o + 16 * m) = w; }
}

template <int GI> __device__ __forceinline__ void pool_sums(Frame& F, int j, LAS float* V, LAS unsigned* U, LAS unsigned char* At) {
    constexpr int win = 2 << GI, lo = win >> 1, hi = win - 1 - lo; const GAS bf16_t* Pc = (const GAS bf16_t*)F.P() + 2560 + GI * 64;
    if (j == 0) {
        for (int idx = F.tid; idx < 256 * 8; idx += NTHR) { const int t = idx >> 3, p8 = idx & 7; const int a = max(t - lo, 0), b = min(t + hi, CTX - 1); u32x4 w[win];
#pragma unroll
            for (int i = 0; i < win; ++i) { const int r = min(max(t - lo + i, 0), CTX - 1); w[i] = *(const GAS u32x4*)(Pc + (unsigned)(r * DINX + 8 * p8)); }
            f32x4 s0 = (f32x4){0.f, 0.f, 0.f, 0.f}, s1 = s0;
#pragma unroll
            for (int i = 0; i < win; ++i) { const int r = t - lo + i; const bool in = r >= 0 && r <= CTX - 1; const u32x4 x = w[i];
                const f32x4 e = (f32x4){bflo(x.x), bflo(x.y), bflo(x.z), bflo(x.w)}, o = (f32x4){bfhi(x.x), bfhi(x.y), bfhi(x.z), bfhi(x.w)}; if (in) { s0 += e; s1 += o; } }
            const u32x4 u = w[lo]; const float inv = 1.f / (float)(b - a + 1); u32x4 ov;
            ov.x = pk2(s0[0] * inv - bflo(u.x), s1[0] * inv - bfhi(u.x)); ov.y = pk2(s0[1] * inv - bflo(u.y), s1[1] * inv - bfhi(u.y));
            ov.z = pk2(s0[2] * inv - bflo(u.z), s1[2] * inv - bfhi(u.z)); ov.w = pk2(s0[3] * inv - bflo(u.w), s1[3] * inv - bfhi(u.w));
            *(LAS u32x4*)(At + t * 144 + 16 * p8) = ov; }
        return; }
    const int r0 = 4 * (j - 1); constexpr int NR = win + 3;
    { const int c = F.tid >> 3, p8 = F.tid & 7; u32x4 w[NR];
#pragma unroll
        for (int i = 0; i < NR; ++i) { const int r = min(max(r0 - lo + i, 0), LAT / GW - 1); w[i] = *(const GAS u32x4*)(Pc + (unsigned)((CTX + r * GW + c) * DINX + 8 * p8)); }
        f32x4 s0[4], s1[4];
#pragma unroll
        for (int q = 0; q < 4; ++q) { s0[q] = (f32x4){0.f, 0.f, 0.f, 0.f}; s1[q] = (f32x4){0.f, 0.f, 0.f, 0.f}; }
#pragma unroll
        for (int i = 0; i < NR; ++i) { const int r = r0 - lo + i; const bool ok = r >= 0 && r <= LAT / GW - 1; const u32x4 x = w[i];
            f32x4 e = (f32x4){bflo(x.x), bflo(x.y), bflo(x.z), bflo(x.w)}, o = (f32x4){bfhi(x.x), bfhi(x.y), bfhi(x.z), bfhi(x.w)}; if (!ok) { e = (f32x4){0.f, 0.f, 0.f, 0.f}; o = e; }
#pragma unroll
            for (int q = 0; q < 4; ++q) if (i >= q && i <= q + win - 1) { s0[q] += e; s1[q] += o; } }
#pragma unroll
        for (int q = 0; q < 4; ++q) { LAS float* vp = V + (q * 64 + c) * 64 + 8 * p8;
            *(LAS f32x4*)vp = (f32x4){s0[q][0], s1[q][0], s0[q][1], s1[q][1]}; *(LAS f32x4*)(vp + 4) = (f32x4){s0[q][2], s1[q][2], s0[q][3], s1[q][3]};
            *(LAS u32x4*)(U + (q * 64 + c) * 32 + 4 * p8) = w[lo + q]; } }
    __syncthreads();
    for (int idx = F.tid; idx < 4 * 8 * 64; idx += NTHR) { const int ch = idx & 63, cb = (idx >> 6) & 7, i = idx >> 9; const int r = r0 + i;
        const float cr = (float)(min(r + hi, LAT / GW - 1) - max(r - lo, 0) + 1); const LAS float* Vr = V + (i * 64) * 64 + ch;
        const int c0 = 8 * cb; float s = 0.f;
#pragma unroll
        for (int q = 0; q < win; ++q) { const int c = c0 - lo + q; s += (c >= 0 && c <= GW - 1) ? Vr[min(max(c, 0), GW - 1) * 64] : 0.f; }
#pragma unroll
        for (int q = 0; q < 8; ++q) { const int c = c0 + q; if (q > 0) { if (c + hi <= GW - 1) s += Vr[(c + hi) * 64]; if (c - 1 - lo >= 0) s -= Vr[(c - 1 - lo) * 64]; }
            const float cc = (float)(min(c + hi, GW - 1) - max(c - lo, 0) + 1); const unsigned uw = U[(i * 64 + c) * 32 + (ch >> 1)]; const float u = (ch & 1) ? bfhi(uw) : bflo(uw);
            *(LAS unsigned short*)(At + (i * 64 + c) * 144 + 2 * ch) = (unsigned short)f2bf(s / (cr * cc) - u); } }
}
__device__ __forceinline__ void pool_item(Frame& F, int l, int item) {
    const int j = item >> 2, gi = item & 3;
    LAS float* V = (LAS float*)(F.lds);
    LAS unsigned* U = (LAS unsigned*)(F.lds + 65536);
    LAS unsigned char* At = F.lds + 65536 + 32768;
    __syncthreads();
    if (gi == 0) pool_sums<0>(F, j, V, U, At); else if (gi == 1) pool_sums<1>(F, j, V, U, At); else if (gi == 2) pool_sums<2>(F, j, V, U, At); else pool_sums<3>(F, j, V, U, At);
    __syncthreads();
    const bf16_t* PW = (const bf16_t*)(F.ws + WS_WF + WF_PW) + (size_t)(l * 4 + gi) * 4096; const int fr = F.lane & 15, g = F.lane >> 4;
    f32x4 acc[4][2];
#pragma unroll
    for (int n = 0; n < 4; ++n) { acc[n][0] = (f32x4){0.f, 0.f, 0.f, 0.f}; acc[n][1] = (f32x4){0.f, 0.f, 0.f, 0.f}; }
#pragma unroll
    for (int ks = 0; ks < 2; ++ks) { bf16x8 b[2];
#pragma unroll
        for (int mt = 0; mt < 2; ++mt) b[mt] = *(const LAS bf16x8*)(At + (32 * F.wave + 16 * mt + fr) * 144 + (32 * ks + 8 * g) * 2);
#pragma unroll
        for (int n = 0; n < 4; ++n) { const bf16x8 a = *(const GAS bf16x8*)(PW + (16 * n + fr) * 64 + 32 * ks + 8 * g);
#pragma unroll
            for (int mt = 0; mt < 2; ++mt) acc[n][mt] = mfma16(a, b[mt], acc[n][mt]); } }
    const int rowbase = j == 0 ? 0 : CTX + 256 * (j - 1);
#pragma unroll
    for (int n = 0; n < 4; ++n) { const f32x4 sc = *(const GAS f32x4*)(F.pool_s() + l * 256 + gi * 64 + 16 * n + 4 * g);
#pragma unroll
        for (int mt = 0; mt < 2; ++mt) { const f32x4 a = acc[n][mt] * sc; u32x2 w; w.x = pk2(a[0], a[1]); w.y = pk2(a[2], a[3]);
            *(u32x2*)(F.CAT() + (size_t)(rowbase + 32 * F.wave + 16 * mt + fr) * D + 512 + gi * 64 + 16 * n + 4 * g) = w; } }
}

constexpr int SC_FT = 0, SC_QT = 18432, SC_VT = 36864, SC_BQ = 55296, SC_BF = 72704, SC_KT = 90112, SC_PM = 108544, SC_G = 117760, SC_TOT = 135168, SC_DEC = 137216, SC_SSQ = 138752, SC_END = 140800;
static_assert(SC_END <= MISC_OFF, "scan LDS map");
template <int DIR, bool FULL> __device__ __forceinline__ void scan_fetch(const Frame& F, int h, int row0, u32x4 (&r)[8]) {
    const GAS bf16_t* P = (const GAS bf16_t*)F.P(); const int tid = F.tid;
    if (tid < 384) { const int tile = tid >> 7, blk = tid & 127, tg = blk >> 4, kc = blk & 15; if (!FULL && tile == 1) return;
        const int colb = tile == 0 ? 512 * (1 + DIR) : (tile == 1 ? 0 : 1536); const GAS bf16_t* src = P + (unsigned)((row0 + 8 * tg) * DINX + colb + h * 128 + 8 * kc);
#pragma unroll
        for (int i = 0; i < 8; ++i) r[i] = *(const GAS u32x4*)(src + (unsigned)(i * DINX)); }
    else if (FULL && DIR == 1) { const int q = tid - 384; const GAS bf16_t* src = P + (unsigned)((row0 + (q >> 4)) * DINX + 2048 + h * 128 + 8 * (q & 15));
#pragma unroll
        for (int i = 0; i < 8; ++i) r[i] = *(const GAS u32x4*)(src + (unsigned)(i * 8 * DINX)); }
}
template <int DIR, bool FULL> __device__ __forceinline__ void scan_commit(const Frame& F, const u32x4 (&r)[8]) {
    LAS unsigned char* L = F.lds + RING_OFF; const int tid = F.tid;
    if (tid < 384) { const int tile = tid >> 7, blk = tid & 127, tg = blk >> 4, kc = blk & 15; if (!FULL && tile == 1) return;
#pragma unroll
        for (int j = 0; j < 8; ++j) { const unsigned sel = (j & 1) ? 0x07060302u : 0x05040100u; u32x4 o;
            o.x = __builtin_amdgcn_perm(r[1][j >> 1], r[0][j >> 1], sel); o.y = __builtin_amdgcn_perm(r[3][j >> 1], r[2][j >> 1], sel);
            o.z = __builtin_amdgcn_perm(r[5][j >> 1], r[4][j >> 1], sel); o.w = __builtin_amdgcn_perm(r[7][j >> 1], r[6][j >> 1], sel);
            *(LAS u32x4*)(L + tile * 18432 + (8 * kc + j) * 144 + 16 * tg) = o; } }
    else if (FULL && DIR == 1) { const int q = tid - 384; LAS unsigned char* dst = L + SC_G + (q >> 4) * 272 + 16 * (q & 15);
#pragma unroll
        for (int i = 0; i < 8; ++i) *(LAS u32x4*)(dst + i * 8 * 272) = r[i]; }
}
template <int DIR, bool FULL> __device__ __forceinline__ void scan_chunk(Frame& F, int l, int h, int nrow0, u32x4 (&pre)[8], f32x4 (&S)[8], f32x4 (&o)[4], float& segsum, const GAS float* oload = nullptr, GAS float* ostore = nullptr) {
    LAS unsigned char* L = F.lds + RING_OFF; int lane = F.lane; asm volatile("" : "+v"(lane));
    const int w = F.wave, tid = w * 64 + lane, fr = lane & 15, g = lane >> 4;
    LAS float* TOT = (LAS float*)(L + SC_TOT); LAS float* DEC = (LAS float*)(L + SC_DEC); LAS float* C1 = DEC + 128; LAS float* C2 = DEC + 256;
    __syncthreads();
    scan_commit<DIR, FULL>(F, pre);
    __syncthreads();
    const int k = tid & 127, qu = tid >> 7;
    float bl[16]; float run = 0.f;
    { const u32x4 fa = *(const LAS u32x4*)(L + SC_FT + k * 144 + 32 * qu), fb = *(const LAS u32x4*)(L + SC_FT + k * 144 + 32 * qu + 16); const unsigned fw[8] = {fa.x, fa.y, fa.z, fa.w, fb.x, fb.y, fb.z, fb.w};
#pragma unroll
      for (int i = 0; i < 16; ++i) { const int ti = (DIR == 0 ? i : 15 - i); run += (ti & 1) ? f16hi(fw[ti >> 1]) : f16lo(fw[ti >> 1]); bl[i] = run; } }
    TOT[qu * 128 + k] = run;
    __syncthreads();
    const float t0 = TOT[k], t1 = TOT[128 + k], t2 = TOT[256 + k], t3 = TOT[384 + k]; const float total = (t0 + t1) + (t2 + t3);
    float off, ref;
    if (DIR == 0) { off = qu == 0 ? 0.f : (qu == 1 ? t0 : (qu == 2 ? t0 + t1 : t0 + t1 + t2)); ref = t0 + t1; }
    else { off = qu == 3 ? 0.f : (qu == 2 ? t3 : (qu == 1 ? t3 + t2 : t3 + t2 + t1)); ref = t3 + t2; }
    if (qu == 0) { DEC[k] = __builtin_amdgcn_exp2f(total); C1[k] = __builtin_amdgcn_exp2f(ref); C2[k] = __builtin_amdgcn_exp2f(total - ref); segsum += total; }
    { unsigned qw[8];
      if (FULL) { const u32x4 qa = *(const LAS u32x4*)(L + SC_QT + k * 144 + 32 * qu), qb = *(const LAS u32x4*)(L + SC_QT + k * 144 + 32 * qu + 16); qw[0] = qa.x; qw[1] = qa.y; qw[2] = qa.z; qw[3] = qa.w; qw[4] = qb.x; qw[5] = qb.y; qw[6] = qb.z; qw[7] = qb.w; }
      float ktv[16]; const float sh = off - ref;
#pragma unroll
      for (int i = 0; i < 16; ++i) { const int ti = (DIR == 0 ? i : 15 - i), t = 16 * qu + ti; const float lf = i == 0 ? bl[0] : bl[i] - bl[i - 1]; const float b = bl[i] + sh;
          const float E = __builtin_amdgcn_exp2f(b), Ei = __builtin_amdgcn_rcpf(E), kk = 1.f - __builtin_amdgcn_exp2f(lf); ktv[ti] = kk * Ei;
          if (FULL) { const float qs = (ti & 1) ? bfhi(qw[ti >> 1]) : bflo(qw[ti >> 1]); *(LAS unsigned short*)(L + SC_BQ + t * 272 + 2 * k) = (unsigned short)(cvt_pk_bf16(qs * E, 0.f)); } }
      u32x4 a, b2; a.x = cvt_pk_bf16(ktv[0], ktv[1]); a.y = cvt_pk_bf16(ktv[2], ktv[3]); a.z = cvt_pk_bf16(ktv[4], ktv[5]); a.w = cvt_pk_bf16(ktv[6], ktv[7]);
      b2.x = cvt_pk_bf16(ktv[8], ktv[9]); b2.y = cvt_pk_bf16(ktv[10], ktv[11]); b2.z = cvt_pk_bf16(ktv[12], ktv[13]); b2.w = cvt_pk_bf16(ktv[14], ktv[15]);
      *(LAS u32x4*)(L + SC_KT + k * 144 + 32 * qu) = a; *(LAS u32x4*)(L + SC_KT + k * 144 + 32 * qu + 16) = b2;
      if (FULL) { const unsigned kw[8] = {a.x, a.y, a.z, a.w, b2.x, b2.y, b2.z, b2.w};
#pragma unroll
          for (int ti = 0; ti < 16; ++ti) *(LAS unsigned short*)(L + SC_BF + (16 * qu + ti) * 272 + 2 * k) = (unsigned short)((ti & 1) ? (kw[ti >> 1] >> 16) : (kw[ti >> 1] & 0xffffu)); } }
    __syncthreads();
    if (nrow0 >= 0) scan_fetch<DIR, FULL>(F, h, nrow0, pre);
    if (FULL) {
#pragma unroll
        for (int tb = 0; tb < 4; ++tb)
#pragma unroll
            for (int r = 0; r < 4; ++r) o[tb][r] = oload ? oload[(tb * 4 + r) * 512] : 0.f; }
    __builtin_amdgcn_sched_barrier(0);
    if (FULL) {
        const int tb = w >> 1;
#pragma unroll
        for (int q = 0; q < 2; ++q) { const int sb = 2 * (w & 1) + q; f32x4 acc = (f32x4){0.f, 0.f, 0.f, 0.f};
#pragma unroll
            for (int ks = 0; ks < 4; ++ks) { const bf16x8 a = *(const LAS bf16x8*)(L + SC_BF + (16 * sb + fr) * 272 + (32 * ks + 8 * g) * 2); const bf16x8 b = *(const LAS bf16x8*)(L + SC_BQ + (16 * tb + fr) * 272 + (32 * ks + 8 * g) * 2);
                acc = mfma16(a, b, acc); }
            const int t = 16 * tb + fr; float m[4];
#pragma unroll
            for (int r = 0; r < 4; ++r) { const int s = 16 * sb + 4 * g + r; const bool keep = DIR == 0 ? (s <= t) : (s >= t); m[r] = keep ? acc[r] : 0.f; }
            u32x2 wv; wv.x = pk2(m[0], m[1]); wv.y = pk2(m[2], m[3]); *(LAS u32x2*)(L + SC_PM + t * 144 + (16 * sb + 4 * g) * 2) = wv; }
        __syncthreads();
    }
    bf16x8 vt[2];
#pragma unroll
    for (int ks = 0; ks < 2; ++ks) vt[ks] = *(const LAS bf16x8*)(L + SC_VT + (16 * w + fr) * 144 + (32 * ks + 8 * g) * 2);
    if (FULL) {
        bf16x8 sf[4];
#pragma unroll
        for (int ks = 0; ks < 4; ++ks) { const f32x4 ca = *(const LAS f32x4*)(C1 + 32 * ks + 4 * g), cb = *(const LAS f32x4*)(C1 + 32 * ks + 16 + 4 * g); const f32x4 x = S[2 * ks] * ca, y = S[2 * ks + 1] * cb;
            u32x4 pkd; pkd.x = pk2(x[0], x[1]); pkd.y = pk2(x[2], x[3]); pkd.z = pk2(y[0], y[1]); pkd.w = pk2(y[2], y[3]); sf[ks] = __builtin_bit_cast(bf16x8, pkd); }
#pragma unroll
        for (int tb = 0; tb < 4; ++tb) { f32x4 acc = o[tb];
#pragma unroll
            for (int ks = 0; ks < 4; ++ks) { const u32x2 a0 = *(const LAS u32x2*)(L + SC_BQ + (16 * tb + fr) * 272 + (32 * ks + 4 * g) * 2), a1 = *(const LAS u32x2*)(L + SC_BQ + (16 * tb + fr) * 272 + (32 * ks + 16 + 4 * g) * 2);
                u32x4 pa; pa.x = a0.x; pa.y = a0.y; pa.z = a1.x; pa.w = a1.y; acc = mfma16(__builtin_bit_cast(bf16x8, pa), sf[ks], acc); }
#pragma unroll
            for (int ks = 0; ks < 2; ++ks) { const bf16x8 a = *(const LAS bf16x8*)(L + SC_PM + (16 * tb + fr) * 144 + (32 * ks + 8 * g) * 2); acc = mfma16(a, vt[ks], acc); }
            o[tb] = acc; __builtin_amdgcn_sched_barrier(0); }
        if (ostore) {
#pragma unroll
            for (int tb = 0; tb < 4; ++tb)
#pragma unroll
                for (int r = 0; r < 4; ++r) ostore[(tb * 4 + r) * 512] = o[tb][r]; }
    }
#pragma unroll
    for (int kb = 0; kb < 8; ++kb) { f32x4 tmp = (f32x4){0.f, 0.f, 0.f, 0.f};
#pragma unroll
        for (int ks = 0; ks < 2; ++ks) { const bf16x8 a = *(const LAS bf16x8*)(L + SC_KT + (16 * kb + fr) * 144 + (32 * ks + 8 * g) * 2); tmp = mfma16(a, vt[ks], tmp); }
        const f32x4 dc = *(const LAS f32x4*)(DEC + 16 * kb + 4 * g), c2 = *(const LAS f32x4*)(C2 + 16 * kb + 4 * g); S[kb] = dc * S[kb] + c2 * tmp; if (kb & 1) __builtin_amdgcn_sched_barrier(0); }
}
__device__ __forceinline__ void state_store(float* dst, const f32x4 (&S)[8], int w, int lane) {
    GAS float* p = (GAS float*)dst + (unsigned)(w * 2048 + lane);
#pragma unroll
    for (int kb = 0; kb < 8; ++kb)
#pragma unroll
        for (int r = 0; r < 4; ++r) p[(kb * 4 + r) * 64] = S[kb][r]; }
__device__ __forceinline__ void state_load(const float* src, f32x4 (&S)[8], int w, int lane) {
    const GAS float* p = (const GAS float*)src + (unsigned)(w * 2048 + lane);
#pragma unroll
    for (int kb = 0; kb < 8; ++kb)
#pragma unroll
        for (int r = 0; r < 4; ++r) S[kb][r] = p[(kb * 4 + r) * 64]; }
__device__ __forceinline__ float* sc_SU(Frame& F) { return (float*)(F.ws + WS_SU); }
__device__ __forceinline__ float* sc_SS(Frame& F) { return (float*)(F.ws + WS_SS); }
__device__ __forceinline__ float* sc_SD(Frame& F) { return (float*)(F.ws + WS_SD); }
__device__ __forceinline__ float* sc_CARRY(Frame& F) { return (float*)(F.ws + WS_SD) + 8 * 64 * 128; }

__device__ __forceinline__ float* sc_OSCR(Frame& F) { return (float*)(F.ws + WS_OSCR) + (size_t)F.bid * 32768; }
template <int DIR> __device__ __forceinline__ void scan_states(Frame& F, int l, int h, int segrow, float* sout, float* dout) {
    f32x4 S[8], odummy[4]; float segsum = 0.f; u32x4 pre[8];
#pragma unroll
    for (int kb = 0; kb < 8; ++kb) S[kb] = (f32x4){0.f, 0.f, 0.f, 0.f};
    scan_fetch<DIR, false>(F, h, segrow + (DIR == 0 ? 0 : 192), pre);
#pragma unroll 1
    for (int i_ = 0; i_ < 4; ++i_) { int i = i_; asm volatile("" : "+s"(i)); const int c = DIR == 0 ? i : 3 - i;
        scan_chunk<DIR, false>(F, l, h, i < 3 ? segrow + 64 * (DIR == 0 ? c + 1 : c - 1) : -1, pre, S, odummy, segsum); }
    state_store(sout, S, F.wave, F.lane);
    if (dout && F.tid < 128) dout[F.tid] = __builtin_amdgcn_exp2f(segsum);
}
__device__ __forceinline__ void scanA_item(Frame& F, int l, int item) {
    const int h = item >> 6, seg = item & 63, segrow = CTX + 256 * seg;
    scan_states<0>(F, l, h, segrow, sc_SU(F) + ((size_t)(h * 2 + 0) * 64 + seg) * 16384, sc_SD(F) + ((h * 2 + 0) * 64 + seg) * 128);
    scan_states<1>(F, l, h, segrow, sc_SU(F) + ((size_t)(h * 2 + 1) * 64 + seg) * 16384, sc_SD(F) + ((h * 2 + 1) * 64 + seg) * 128);
}
__device__ __forceinline__ void scan_full(Frame& F, int l, int h, int segrow, const float* sinf, const float* sinb, float* outf, float* outb) {
    f32x4 S[8], o[4]; float segsum = 0.f; const int w = F.wave, lane = F.lane, fr = lane & 15, g = lane >> 4; u32x4 pre[8];
    GAS float* oscr = (GAS float*)sc_OSCR(F) + (unsigned)F.tid;
    if (sinf) state_load(sinf, S, w, lane); else {
#pragma unroll
        for (int kb = 0; kb < 8; ++kb) S[kb] = (f32x4){0.f, 0.f, 0.f, 0.f}; }
    scan_fetch<0, true>(F, h, segrow, pre);
#pragma unroll 1
    for (int c_ = 0; c_ < 4; ++c_) { int c = c_; asm volatile("" : "+s"(c));
        scan_chunk<0, true>(F, l, h, c < 3 ? segrow + 64 * (c + 1) : -1, pre, S, o, segsum);
#pragma unroll
        for (int tb = 0; tb < 4; ++tb)
#pragma unroll
            for (int r = 0; r < 4; ++r) (oscr + c * 8192)[(tb * 4 + r) * 512] = o[tb][r];
    }
    if (outf) state_store(outf, S, w, lane);
    VM_WAIT();
    if (sinb) state_load(sinb, S, w, lane); else {
#pragma unroll
        for (int kb = 0; kb < 8; ++kb) S[kb] = (f32x4){0.f, 0.f, 0.f, 0.f}; }
    LAS unsigned char* L = F.lds + RING_OFF; LAS float* SSQ = (LAS float*)(L + SC_SSQ);
    const float ngv = F.hng()[l * 512 + h * 128 + 16 * w + fr];
    scan_fetch<1, true>(F, h, segrow + 192, pre);
#pragma unroll 1
    for (int c_ = 3; c_ >= 0; --c_) { int c = c_; asm volatile("" : "+s"(c));
        scan_chunk<1, true>(F, l, h, c > 0 ? segrow + 64 * (c - 1) : -1, pre, S, o, segsum, oscr + c * 8192);
#pragma unroll
        for (int tb = 0; tb < 4; ++tb) { f32x4 q = o[tb] * o[tb];
#pragma unroll
            for (int m = 1; m < 16; m <<= 1) { q[0] += lane_xor(q[0], m, lane); q[1] += lane_xor(q[1], m, lane); q[2] += lane_xor(q[2], m, lane); q[3] += lane_xor(q[3], m, lane); }
            if (fr == 0) {
#pragma unroll
                for (int r = 0; r < 4; ++r) SSQ[(16 * tb + 4 * g + r) * 8 + w] = q[r]; } }
        __syncthreads();
#pragma unroll
        for (int tb = 0; tb < 4; ++tb)
#pragma unroll
            for (int r = 0; r < 4; ++r) { const int t = 16 * tb + 4 * g + r; const f32x4 p0 = *(const LAS f32x4*)(SSQ + t * 8), p1 = *(const LAS f32x4*)(SSQ + t * 8 + 4);
                const float ss = ((p0[0] + p0[1]) + (p0[2] + p0[3])) + ((p1[0] + p1[1]) + (p1[2] + p1[3])); const float rs = rsqrtf(ss * (1.f / 128.f) + 1e-6f);
                const float gp = bf2f(*(const LAS unsigned short*)(L + SC_G + t * 272 + 2 * (16 * w + fr)));
                *(LAS unsigned short*)(L + SC_BQ + t * 272 + 2 * (16 * w + fr)) = (unsigned short)f2bf(o[tb][r] * rs * ngv * gp); }
        __syncthreads();
#pragma unroll
        for (int i = 0; i < 2; ++i) { const int id = F.tid + 512 * i, row = id >> 4, cc = id & 15; const u32x4 d = *(const LAS u32x4*)(L + SC_BQ + row * 272 + 16 * cc);
            *(GAS u32x4*)((GAS bf16_t*)F.CAT() + (unsigned)((segrow + 64 * c + row) * D + h * 128 + 8 * cc)) = d; }
    }
    if (outb) state_store(outb, S, w, lane);
}
__device__ __forceinline__ GAS float* sc_CTXO(const Frame& F, int hd, int c) { return (GAS float*)(F.ws + WS_CTXO) + (unsigned)((hd * 4 + c) * 8192); }
template <int DIR> __device__ __forceinline__ void scan_dir_local(Frame& F, int l, int h, int segrow, float* sout) {
    f32x4 S[8], o[4]; float segsum = 0.f; u32x4 pre[8]; const int hd = h * 2 + DIR;
#pragma unroll
    for (int kb = 0; kb < 8; ++kb) S[kb] = (f32x4){0.f, 0.f, 0.f, 0.f};
    scan_fetch<DIR, true>(F, h, segrow + (DIR == 0 ? 0 : 192), pre);
#pragma unroll 1
    for (int i_ = 0; i_ < 4; ++i_) { int i = i_; asm volatile("" : "+s"(i)); const int c = DIR == 0 ? i : 3 - i;
        scan_chunk<DIR, true>(F, l, h, i < 3 ? segrow + 64 * (DIR == 0 ? c + 1 : c - 1) : -1, pre, S, o, segsum, nullptr, sc_CTXO(F, hd, c) + (unsigned)F.tid); }
    state_store(sout, S, F.wave, F.lane);
}
__device__ __forceinline__ void ctx_finalize(Frame& F, int l, int h) {
    LAS unsigned char* L = F.lds + RING_OFF; LAS float* SSQ = (LAS float*)(L + SC_SSQ);
    const float ngv = F.hng()[l * 512 + h * 128 + 16 * F.wave + (F.lane & 15)];
#pragma unroll 1
    for (int c_ = 0; c_ < 4; ++c_) { int c = c_; asm volatile("" : "+s"(c)); int lane = F.lane; asm volatile("" : "+v"(lane));
        const int w = F.wave, tid = w * 64 + lane, fr = lane & 15, g = lane >> 4, row0 = 64 * c;
        __syncthreads();
        { const GAS bf16_t* gp = (const GAS bf16_t*)F.P() + (unsigned)((row0 + (tid >> 4)) * DINX + 2048 + h * 128 + 8 * (tid & 15)); const int o = (tid >> 4) * 272 + 16 * (tid & 15);
          *(LAS u32x4*)(L + SC_G + o) = *(const GAS u32x4*)gp; *(LAS u32x4*)(L + SC_G + o + 32 * 272) = *(const GAS u32x4*)(gp + (unsigned)(32 * DINX)); }
        f32x4 o[4];
        { const GAS float* of = sc_CTXO(F, h * 2 + 0, c) + (unsigned)tid; const GAS float* ob = sc_CTXO(F, h * 2 + 1, c) + (unsigned)tid;
#pragma unroll
          for (int tb = 0; tb < 4; ++tb)
#pragma unroll
              for (int r = 0; r < 4; ++r) o[tb][r] = of[(tb * 4 + r) * 512] + ob[(tb * 4 + r) * 512]; }
#pragma unroll
        for (int tb = 0; tb < 4; ++tb) { f32x4 q = o[tb] * o[tb];
#pragma unroll
            for (int m = 1; m < 16; m <<= 1) { q[0] += lane_xor(q[0], m, lane); q[1] += lane_xor(q[1], m, lane); q[2] += lane_xor(q[2], m, lane); q[3] += lane_xor(q[3], m, lane); }
            if (fr == 0) {
#pragma unroll
                for (int r = 0; r < 4; ++r) SSQ[(16 * tb + 4 * g + r) * 8 + w] = q[r]; } }
        __syncthreads();
#pragma unroll
        for (int tb = 0; tb < 4; ++tb)
#pragma unroll
            for (int r = 0; r < 4; ++r) { const int t = 16 * tb + 4 * g + r; const f32x4 p0 = *(const LAS f32x4*)(SSQ + t * 8), p1 = *(const LAS f32x4*)(SSQ + t * 8 + 4);
                const float ss = ((p0[0] + p0[1]) + (p0[2] + p0[3])) + ((p1[0] + p1[1]) + (p1[2] + p1[3])); const float rs = rsqrtf(ss * (1.f / 128.f) + 1e-6f);
                const float gp = bf2f(*(const LAS unsigned short*)(L + SC_G + t * 272 + 2 * (16 * w + fr)));
                *(LAS unsigned short*)(L + SC_BQ + t * 272 + 2 * (16 * w + fr)) = (unsigned short)f2bf(o[tb][r] * rs * ngv * gp); }
        __syncthreads();
#pragma unroll
        for (int i = 0; i < 2; ++i) { const int id = tid + 512 * i, row = id >> 4, cc = id & 15; const u32x4 d = *(const LAS u32x4*)(L + SC_BQ + row * 272 + 16 * cc);
            *(GAS u32x4*)((GAS bf16_t*)F.CAT() + (unsigned)((row0 + row) * D + h * 128 + 8 * cc)) = d; }
    }
    __syncthreads();
}
__device__ __forceinline__ void scanB(Frame& F) {
    const int e = F.bid * NTHR + F.tid; if (e >= 8 * 16384) return;
    const int hd = e >> 14, idx = e & 16383, d = hd & 1; const int ln = idx & 63, reg = (idx >> 6) & 3, kb = (idx >> 8) & 7; const int k = 16 * kb + 4 * (ln >> 4) + reg;
    const float* SU = sc_SU(F) + (size_t)hd * 64 * 16384 + idx; const float* SD = sc_SD(F) + hd * 64 * 128 + k; float* SS = sc_SS(F) + (size_t)hd * 64 * 16384 + idx;
    float S = sc_CARRY(F)[hd * 16384 + idx];
    if (d == 0) { for (int seg = 0; seg < 64; ++seg) { SS[(size_t)seg * 16384] = S; S = SD[seg * 128] * S + SU[(size_t)seg * 16384]; } }
    else { for (int seg = 63; seg >= 0; --seg) { SS[(size_t)seg * 16384] = S; S = SD[seg * 128] * S + SU[(size_t)seg * 16384]; } }
}

__device__ __forceinline__ void ph_mixA(Frame& F, int l) {
    scanA_item(F, l, F.bid);
    if (F.bid >= 4 && F.bid < 12) { const int hd = F.bid - 4, h = hd >> 1;
        if (l == 0) { if (hd & 1) scan_dir_local<1>(F, l, h, 0, sc_CARRY(F) + hd * 16384); else scan_dir_local<0>(F, l, h, 0, sc_CARRY(F) + hd * 16384); }
        else { if (hd & 1) scan_states<1>(F, l, h, 0, sc_CARRY(F) + hd * 16384, nullptr); else scan_states<0>(F, l, h, 0, sc_CARRY(F) + hd * 16384, nullptr); }
        return; }
    fftA_item(F, F.bid);
    if (F.bid >= 12 && F.bid < 20) fftA_item(F, F.bid - 8);
    if (l == 0) { pool_item(F, l, F.bid); if (F.bid >= 20 && F.bid < 28) pool_item(F, l, F.bid - 16); else if (F.bid >= 28 && F.bid < 32) pool_item(F, l, F.bid + 228); }
    else { pool_item(F, l, F.bid + 4); if (F.bid >= 20 && F.bid < 28) pool_item(F, l, F.bid - 12); }
}
__device__ __forceinline__ void ph_mixB(Frame& F, int l) {
    scanB(F);
    fftB_item(F, F.bid);
    if (l == 0 && F.bid >= 252) fftC_item(F, F.bid - 252);
    if (l == 0 && F.bid >= 240 && F.bid < 244) ctx_finalize(F, l, F.bid - 240);
}
__device__ __forceinline__ void ph_mixC(Frame& F, int l) {
    const int item = F.bid, h = item >> 6, seg = item & 63;
    scan_full(F, l, h, CTX + 256 * seg, sc_SS(F) + ((size_t)(h * 2 + 0) * 64 + seg) * 16384, sc_SS(F) + ((size_t)(h * 2 + 1) * 64 + seg) * 16384, nullptr, nullptr);
}
#define GRID_BAR() do { Frame R_ = relaunder(F); xcd_barrier(bar, R_.tid); } while (0)
#define PHASE(call) do { Frame R = relaunder(F); call; } while (0)
__global__ void __launch_bounds__(NTHR, 2) mega_fwd(Params p) {
    extern __shared__ __attribute__((aligned(16))) unsigned char lds[];
    Frame F; frame_init(F, p, lds);
    if (F.tid < 16) ((LAS unsigned*)(F.lds + MISC_OFF))[F.tid] = 0u;
    __syncthreads();
    XcdBarrier bar = xcd_barrier_post((unsigned*)(F.ctl() + CW_BAR), (volatile LAS unsigned*)(F.lds + MISC_OFF + 32));
    PHASE(ph_prologue(R)); PHASE(ph_prologue2(R));
    GRID_BAR();
    PHASE(ph_mod1(R, 0));
    GRID_BAR();
#pragma unroll 1
    for (int l = 0; l < 2; ++l) {
        PHASE(ph_win(R, l));            GRID_BAR();
        PHASE(ph_mixA(R, l));           GRID_BAR();
        PHASE(ph_mixB(R, l));           GRID_BAR();
        PHASE(ph_mixC(R, l));           GRID_BAR();
        PHASE(ph_wout(R, l));           GRID_BAR();
        PHASE(ph_mod2_route(R, l, l));  GRID_BAR();
        PHASE(ph_gateup(R, l));         GRID_BAR();
        PHASE(ph_down(R, l));           GRID_BAR();
        PHASE(ph_combine(R, l));
        if (l == 0) GRID_BAR();
    }
}
extern "C" void kernel_launch(void* const* d_in, const int* in_sizes, int n_in, void* d_out, int out_size, void* d_ws, size_t ws_size, hipStream_t stream) {
    static int ok = 0;
    if (ok == 0) {
        if (n_in != 22 || out_size != LAT * D || ws_size < WS_FASTEND) { fprintf(stderr, "kernel_launch: unexpected shapes / workspace (n_in %d, out %d, ws %zu < %zu); nothing launched\n", n_in, out_size, ws_size, (size_t)WS_FASTEND); ok = -1; return; }
        int dev = 0, cus = 0, per_cu = 0;
        if (hipGetDevice(&dev) != hipSuccess || hipDeviceGetAttribute(&cus, hipDeviceAttributeMultiprocessorCount, dev) != hipSuccess) { ok = -1; return; }
        if (hipFuncSetAttribute((const void*)mega_fwd, hipFuncAttributeMaxDynamicSharedMemorySize, LDS_BYTES) != hipSuccess) { fprintf(stderr, "kernel_launch: hipFuncSetAttribute failed\n"); ok = -1; return; }
        if (hipOccupancyMaxActiveBlocksPerMultiprocessor(&per_cu, (const void*)mega_fwd, NTHR, LDS_BYTES) != hipSuccess || per_cu < 1) fprintf(stderr, "kernel_launch: note: occupancy query reports %d workgroups per CU\n", per_cu);
        (void)hipGetLastError();
        if (cus < 256) fprintf(stderr, "kernel_launch: device has %d CUs; this kernel needs 256 co-resident workgroups (one per CU)\n", cus);
        ok = 1;
    }
    if (ok < 0) return;
    if (hipMemsetAsync((char*)d_ws + WS_CTL, 0, CTL_ZERO_BYTES, stream) != hipSuccess) return;
    Params p{}; for (int i = 0; i < 22; ++i) p.in[i] = (const float*)d_in[i]; p.out = (float*)d_out; p.ws = (unsigned char*)d_ws;
    hipLaunchKernelGGL(mega_fwd, dim3(256), dim3(NTHR), LDS_BYTES, stream, p);
}
```

```cpp
#include <hip/hip_runtime.h>
#include <cstdio>
#include <cstdint>
constexpr int D = 1024, LAT = 16384, CTX = 256, T = LAT + CTX, DIN = 3072, NE = 32, TOPK = 4;
constexpr int GW = 64;
#ifndef PSTR
#define PSTR DIN
#endif
constexpr int DINX = 3328, FQ_OFF = 2816;
#define GAS __attribute__((address_space(1)))
#define LAS __attribute__((address_space(3)))
typedef unsigned short bf16_t;
typedef short bf16x8 __attribute__((ext_vector_type(8)));
typedef short bf16x4 __attribute__((ext_vector_type(4)));
typedef float f32x4 __attribute__((ext_vector_type(4)));
typedef float f32x2 __attribute__((ext_vector_type(2)));
typedef unsigned u32x4 __attribute__((ext_vector_type(4)));
typedef unsigned u32x2 __attribute__((ext_vector_type(2)));
typedef GAS unsigned gu32;
#define RLX_AGENT __ATOMIC_RELAXED, __HIP_MEMORY_SCOPE_AGENT
#define LDS_WAIT() asm volatile("s_waitcnt lgkmcnt(0)" ::: "memory")
#define VM_WAIT() asm volatile("s_waitcnt vmcnt(0)" ::: "memory")
__device__ __forceinline__ unsigned cvt_pk_bf16(float lo, float hi) { unsigned r; asm("v_cvt_pk_bf16_f32 %0, %1, %2" : "=v"(r) : "v"(lo), "v"(hi)); return r; }
__device__ __forceinline__ unsigned f2bf(float f) { return cvt_pk_bf16(f, 0.f) & 0xffffu; }
__device__ __forceinline__ unsigned pk2(float lo, float hi) { return cvt_pk_bf16(lo, hi); }
__device__ __forceinline__ float bf2f(unsigned short b) { return __builtin_bit_cast(float, ((unsigned)b) << 16); }
__device__ __forceinline__ float bflo(unsigned w) { return __builtin_bit_cast(float, w << 16); }
__device__ __forceinline__ float bfhi(unsigned w) { return __builtin_bit_cast(float, w & 0xffff0000u); }
__device__ __forceinline__ float fsigm(float x) { return __builtin_amdgcn_rcpf(1.f + __builtin_amdgcn_exp2f(-1.44269504f * x)); }
__device__ __forceinline__ float lane_xor(float v, int m, int lane) { return __builtin_bit_cast(float, __builtin_amdgcn_ds_bpermute((lane ^ m) << 2, __builtin_bit_cast(int, v))); }
__device__ __forceinline__ int lane_get(int v, int src) { return __builtin_amdgcn_ds_bpermute(src << 2, v); }
__device__ __forceinline__ float wave_sum(float v, int lane) {
#pragma unroll
    for (int o = 1; o < 64; o <<= 1) v += lane_xor(v, o, lane);
    return v;
}

#define XB_TMO      128
#define XB_XCNT(j)  (256  + 64 * (j))
#define XB_XSUB(j)  (1280 + 64 * (j))
#define XB_XGEN(j)  (2304 + 64 * (j))
#define XB_TOP      3328
#define XB_TOPGEN   3392
#define XCD_BAR_WORDS 3456
#define XB_SPIN_CAP (1u << 18)
__device__ __forceinline__ unsigned xb_ld(unsigned* p)              { return __hip_atomic_load(p, __ATOMIC_RELAXED, __HIP_MEMORY_SCOPE_AGENT); }
__device__ __forceinline__ unsigned xb_add(unsigned* p, unsigned v) { return __hip_atomic_fetch_add(p, v, __ATOMIC_RELAXED, __HIP_MEMORY_SCOPE_AGENT); }
__device__ __forceinline__ unsigned xb_xcc_id() { return (unsigned)__builtin_amdgcn_s_getreg((3 << 11) | 20) & 0xFu; }
#define XB_SPIN(cond, bar) do { unsigned _sp = 0; while (cond) { __builtin_amdgcn_s_sleep(1); \
    if ((++_sp & 255u) == 0u) { if (xb_ld(&(bar)[XB_TMO])) break; if (_sp > XB_SPIN_CAP) { atomicAdd(&(bar)[XB_TMO], 1u); break; } } } } while (0)
struct XcdBarrier { unsigned* bar; unsigned x; volatile LAS unsigned* st; };
__device__ __forceinline__ XcdBarrier xcd_barrier_post(unsigned* bar, volatile LAS unsigned* st) {
    XcdBarrier b; b.bar = bar; b.x = xb_xcc_id(); b.st = st;
    if (threadIdx.x == 0) (void)xb_add(&bar[XB_XCNT(b.x)], 1u);
    return b;
}
__device__ __forceinline__ void xcd_barrier_complete(unsigned* bar, unsigned x, unsigned& nloc, unsigned& nx) {
    const unsigned G = gridDim.x * gridDim.y * gridDim.z;
    unsigned sum, cnt, mine, sp = 0u;
    for (;;) {
        sum = 0u; cnt = 0u; mine = 0u;
#pragma unroll
        for (unsigned j = 0; j < 16; ++j) { const unsigned c = xb_ld(&bar[XB_XCNT(j)]); sum += c; cnt += (c > 0u) ? 1u : 0u; mine = (j == x) ? c : mine; }
        if (sum == G) break;
        __builtin_amdgcn_s_sleep(1);
        if ((++sp & 255u) == 0u) { if (xb_ld(&bar[XB_TMO])) break; if (sp > XB_SPIN_CAP) { atomicAdd(&bar[XB_TMO], 1u); break; } }
    }
    nloc = mine > 0u ? mine : 1u; nx = cnt > 0u ? cnt : 1u;
}
__device__ __forceinline__ void xcd_barrier(const XcdBarrier& b, const int tid) {
    asm volatile("s_waitcnt vmcnt(0)" ::: "memory");
    unsigned blo = (unsigned)(unsigned long long)b.bar, bhi = (unsigned)((unsigned long long)b.bar >> 32), bx = b.x;
    asm volatile("" : "+s"(blo), "+s"(bhi), "+s"(bx));
    __syncthreads();
    if (tid == 0) {
        unsigned* bar = (unsigned*)(((unsigned long long)bhi << 32) | blo);
        __builtin_amdgcn_s_waitcnt(0);
        unsigned nloc = b.st[0], nx = b.st[1];
        if (nloc == 0u) { xcd_barrier_complete(bar, bx, nloc, nx); b.st[0] = nloc; b.st[1] = nx; }
        const unsigned old = xb_add(&bar[XB_XSUB(bx)], 1u);
        const unsigned gen = old / nloc;
        if (old + 1u == (gen + 1u) * nloc) {
            __builtin_amdgcn_fence(__ATOMIC_RELEASE, "agent");
            asm volatile("s_waitcnt vmcnt(0)" ::: "memory");
            const unsigned og = xb_add(&bar[XB_TOP], 1u);
            const unsigned tg = og / nx;
            if (og + 1u == (tg + 1u) * nx) xb_add(&bar[XB_TOPGEN], 1u);
            else XB_SPIN(xb_ld(&bar[XB_TOPGEN]) == tg, bar);
            __builtin_amdgcn_fence(__ATOMIC_ACQUIRE, "agent");
            xb_add(&bar[XB_XGEN(bx)], 1u);
            asm volatile("s_waitcnt vmcnt(0)" ::: "memory");
        } else {
            XB_SPIN(xb_ld(&bar[XB_XGEN(bx)]) == gen, bar);
            __builtin_amdgcn_fence(__ATOMIC_ACQUIRE, "agent");
            asm volatile("s_waitcnt vmcnt(0)" ::: "memory");
        }
    }
    __syncthreads();
}

namespace pg8 {
constexpr int BM = 256, BK = 64, HALF = 128, HTB = HALF * BK * 2, STAGE_BYTES = 8 * HTB, NXCD = 8, WGM = 8;
__host__ __device__ __forceinline__ int lds_byte(int r, int c) { const int st = (r >> 4) * 2 + (c >> 5), rr = r & 15, cc = c & 31, ob = rr * 64 + cc * 2; return st * 1024 + (ob ^ (((ob >> 9) & 1) << 5)); }
__host__ __device__ __forceinline__ void stage_rc(int b, int& R, int& C) { const int st = b / 1024, sb = b % 1024, swz = sb ^ (((sb >> 9) & 1) << 5); R = (st >> 1) * 16 + swz / 64; C = (st & 1) * 32 + (swz % 64) / 2; }
__host__ __device__ __forceinline__ int perm32(int rho) { const int n = rho >> 4, i = rho & 15; return 8 * (i >> 2) + 4 * n + (i & 3); }

struct Unit { int pm, pn, e, ui; };

typedef int i32x8 __attribute__((ext_vector_type(8)));
typedef int i32x4 __attribute__((ext_vector_type(4)));
__device__ __forceinline__ i32x8 cat8(bf16x8 a, bf16x8 b) { return __builtin_shufflevector(__builtin_bit_cast(i32x4, a), __builtin_bit_cast(i32x4, b), 0, 1, 2, 3, 4, 5, 6, 7); }
template <class Epi, class Sched, bool ALIGN_EPI = true, bool FP8 = false>
__device__ __forceinline__ void gemm_phase(LAS unsigned char* lds, const char* gA, const int Kb, const Sched& S, const Epi& E, const int tid) {
    const int wid = __builtin_amdgcn_readfirstlane(tid >> 6), lane = tid & 63, wr = wid >> 2, wc = wid & 3, fr = lane & 15, fq = lane >> 4;
    const int nt = Kb / (BK * 2);
    int Ra[2], Ca[2]; unsigned voffB[2];
#pragma unroll
    for (int i = 0; i < 2; ++i) { int R, C; stage_rc(tid * 16 + i * 8192, R, C); const int Rb = Epi::PERM ? ((R & ~31) + perm32(R & 31)) : R;
        Ra[i] = R; Ca[i] = C * 2; voffB[i] = (unsigned)(Rb * Kb + C * 2); }
    const size_t kstep = (size_t)(BK * 2);
    const size_t hstep = (size_t)HALF * Kb;
    const unsigned ldsw = (unsigned)wid * 1024u;
    const int aoff = lds_byte(wr * 64 + fr, fq * 8), boff = lds_byte(wc * 32 + fr, fq * 8);
#define PG8_SA(b, h) (((b) * 2 + (h)) * HTB)
#define PG8_SB(b, h) ((4 + (b) * 2 + (h)) * HTB)
#define PG8_STAGE(bufoff, gbase, voff) do { _Pragma("unroll") for (int _i = 0; _i < 2; ++_i) \
        __builtin_amdgcn_global_load_lds((const unsigned*)((const char*)(gbase) + (voff)[_i]), (LAS unsigned*)(lds + (bufoff) + ldsw + _i * 8192), 16, 0, 0); } while (0)
#define PG8_LDA(dst, b, h) do { _Pragma("unroll") for (int m = 0; m < 4; ++m) _Pragma("unroll") for (int k = 0; k < 2; ++k) dst[m][k] = *(const LAS bf16x8*)(lds + PG8_SA(b, h) + aoff + m * 2048 + k * 1024); } while (0)
#define PG8_LDB(dst, b, h) do { _Pragma("unroll") for (int n = 0; n < 2; ++n) _Pragma("unroll") for (int k = 0; k < 2; ++k) dst[n][k] = *(const LAS bf16x8*)(lds + PG8_SB(b, h) + boff + n * 2048 + k * 1024); } while (0)
#define PG8_MMA(ai, bj, At, Bt) do { __builtin_amdgcn_s_setprio(1); _Pragma("unroll") for (int m = 0; m < 4; ++m) _Pragma("unroll") for (int n = 0; n < 2; ++n) { \
        if constexpr (FP8) asm volatile("v_mfma_scale_f32_16x16x128_f8f6f4 %0, %1, %2, %0, %3, %3 op_sel_hi:[0,0,0]" : "+v"(acc[ai][bj][m][n]) : "v"(cat8(Bt[n][0], Bt[n][1])), "v"(cat8(At[m][0], At[m][1])), "v"(scl)); \
        else { _Pragma("unroll") for (int k = 0; k < 2; ++k) acc[ai][bj][m][n] = __builtin_amdgcn_mfma_f32_16x16x32_bf16(Bt[n][k], At[m][k], acc[ai][bj][m][n], 0, 0, 0); } } __builtin_amdgcn_s_setprio(0); } while (0)
#define PG8_WAIT_V(n) asm volatile("s_waitcnt vmcnt(" #n ")" ::: "memory")
#define PG8_WAIT_L(n) asm volatile("s_waitcnt lgkmcnt(" #n ")" ::: "memory")
#define PG8_BAR __builtin_amdgcn_s_barrier()
#define PG8_SCHED __builtin_amdgcn_sched_barrier(0)
    Unit cur, nxt; int ui = 0;
    if (!S.next(0, cur)) return;
    f32x4 acc[2][2][4][2];
#pragma unroll
    for (int a = 0; a < 2; ++a)
#pragma unroll
        for (int b = 0; b < 2; ++b)
#pragma unroll
            for (int m = 0; m < 4; ++m)
#pragma unroll
                for (int n = 0; n < 2; ++n) acc[a][b][m][n] = (f32x4){0.f, 0.f, 0.f, 0.f};
    bf16x8 At[4][2], B0[2][2], B1[2][2]; const int scl = 0x7f7f7f7f;
    unsigned vA[2][2];
#pragma unroll
    for (int h = 0; h < 2; ++h)
#pragma unroll
        for (int i = 0; i < 2; ++i) vA[h][i] = S.a_row_off(cur, h * HALF + Ra[i]) + (unsigned)Ca[i];
    const char* cB = S.b_tile(cur);
    PG8_STAGE(PG8_SB(0, 0), cB, voffB); PG8_STAGE(PG8_SB(0, 1), cB + hstep, voffB); PG8_STAGE(PG8_SA(0, 0), gA, vA[0]); PG8_STAGE(PG8_SA(0, 1), gA, vA[1]);
    if (wr == 1) PG8_BAR;
    PG8_WAIT_V(2); PG8_BAR;
    PG8_STAGE(PG8_SB(1, 0), cB + kstep, voffB); PG8_STAGE(PG8_SA(1, 0), gA + kstep, vA[0]); PG8_STAGE(PG8_SB(1, 1), cB + hstep + kstep, voffB);
    PG8_WAIT_V(6); PG8_BAR;
    for (;;) {
        const bool has_next = S.next(ui + 1, nxt);
        const char* nB = has_next ? S.b_tile(nxt) : cB;
        for (int t = 0; t < nt; t += 2) {
            const bool last = (t == nt - 2);
            unsigned tN[2][2];
#pragma unroll
            for (int h = 0; h < 2; ++h)
#pragma unroll
                for (int i = 0; i < 2; ++i) tN[h][i] = vA[h][i];
            if (last && has_next) {
#pragma unroll
                for (int h = 0; h < 2; ++h)
#pragma unroll
                    for (int i = 0; i < 2; ++i) tN[h][i] = S.a_row_off(nxt, h * HALF + Ra[i]) + (unsigned)Ca[i];
                PG8_WAIT_L(0);
            }
            const char* a1 = gA + (size_t)(t + 1) * kstep;
            const char* a2 = last ? gA : gA + (size_t)(t + 2) * kstep; const char* b2 = last ? nB : cB + (size_t)(t + 2) * kstep;
            const char* a3 = a2 + kstep; const char* b3 = b2 + kstep;
            PG8_LDB(B0, 0, 0); PG8_LDB(B1, 0, 1); PG8_SCHED; PG8_LDA(At, 0, 0); PG8_STAGE(PG8_SA(1, 1), a1, vA[1]);
#pragma unroll
            for (int h = 0; h < 2; ++h)
#pragma unroll
                for (int i = 0; i < 2; ++i) vA[h][i] = tN[h][i];
            PG8_WAIT_V(8); PG8_WAIT_L(0); PG8_BAR; PG8_MMA(0, 0, At, B0); PG8_MMA(0, 1, At, B1); PG8_BAR; PG8_SCHED;
            PG8_LDA(At, 0, 1); PG8_STAGE(PG8_SB(0, 0), b2, voffB); PG8_STAGE(PG8_SB(0, 1), b2 + hstep, voffB); PG8_STAGE(PG8_SA(0, 0), a2, vA[0]);
            PG8_WAIT_V(8); PG8_WAIT_L(0); PG8_BAR; PG8_MMA(1, 0, At, B0); PG8_MMA(1, 1, At, B1); PG8_BAR; PG8_SCHED;
            PG8_LDB(B0, 1, 0); PG8_LDB(B1, 1, 1); PG8_SCHED; PG8_LDA(At, 1, 0); PG8_STAGE(PG8_SA(0, 1), a2, vA[1]);
            PG8_WAIT_V(8); PG8_WAIT_L(0); PG8_BAR; PG8_MMA(0, 0, At, B0); PG8_MMA(0, 1, At, B1); PG8_BAR; PG8_SCHED;
            PG8_LDA(At, 1, 1); PG8_STAGE(PG8_SB(1, 0), b3, voffB); PG8_STAGE(PG8_SB(1, 1), b3 + hstep, voffB); PG8_STAGE(PG8_SA(1, 0), a3, vA[0]);
            PG8_WAIT_V(8); PG8_WAIT_L(0); PG8_BAR; PG8_MMA(1, 0, At, B0); PG8_MMA(1, 1, At, B1); PG8_BAR; PG8_SCHED;
        }
        if constexpr (ALIGN_EPI) { if (wr == 0) PG8_BAR; }
        if constexpr (FP8) asm volatile("s_nop 15\n\ts_nop 15" ::: "memory");
        E(acc, cur, wr, wc, fr, fq);
        if (!has_next) break;
#pragma unroll
        for (int a = 0; a < 2; ++a)
#pragma unroll
            for (int b = 0; b < 2; ++b)
#pragma unroll
                for (int m = 0; m < 4; ++m)
#pragma unroll
                    for (int n = 0; n < 2; ++n) acc[a][b][m][n] = (f32x4){0.f, 0.f, 0.f, 0.f};
        cur = nxt; cB = nB; ++ui;
        if constexpr (ALIGN_EPI) { if (wr == 1) PG8_BAR; }
    }
    PG8_WAIT_V(0);
    if constexpr (!ALIGN_EPI) { if (wr == 0) PG8_BAR; }
    PG8_BAR;
#undef PG8_SA
#undef PG8_SB
#undef PG8_STAGE
#undef PG8_LDA
#undef PG8_LDB
#undef PG8_MMA
#undef PG8_WAIT_V
#undef PG8_WAIT_L
#undef PG8_BAR
#undef PG8_SCHED
}
}
constexpr size_t MiB = 1u << 20;
constexpr int TP = T * 4 + NE * 256;
constexpr size_t WS_CTL = 0, CTL_ZERO_BYTES = 128 * 1024;
constexpr size_t WS_LB = 1 * MiB, WS_MOD = 1 * MiB + 65536;
constexpr size_t WS_WIN = 2 * MiB, WS_WOUT = 18 * MiB, WS_WF = 22 * MiB, WS_WGU = 24 * MiB, WS_WDN = 280 * MiB;
constexpr size_t WS_X = 408 * MiB, WS_H = 474 * MiB, WS_P = 508 * MiB, WS_CAT = 624 * MiB, WS_ROUTE = 658 * MiB, WS_ACT = 662 * MiB, WS_Y = 810 * MiB;
constexpr size_t WS_SU = 958 * MiB, WS_SS = 990 * MiB, WS_SD = 1022 * MiB, WS_YP = 1023 * MiB, WS_OSCR = 1040 * MiB, WS_H8 = 1072 * MiB, WS_CTXO = 1090 * MiB, WS_FASTEND = 1092 * MiB;
#ifndef MOE_FP8
#define MOE_FP8 1
#endif
constexpr float FP8_SH = 16.f, FP8_SW = 256.f, FP8_SA = 4.f;
constexpr size_t RT_TOPI = 0, RT_TOPW = 512 * 1024, RT_POS = 1024 * 1024, RT_LISTE = 1536 * 1024;
static_assert((size_t)T * 16 <= 512 * 1024 && RT_LISTE + (size_t)NE * T * 4 <= 4 * MiB, "route map");
static_assert(WS_WIN + (size_t)2 * DINX * D * 2 <= WS_WOUT && WS_WGU + (size_t)2 * NE * 2048 * 1024 * 2 <= WS_WDN && WS_WDN + (size_t)2 * NE * 1024 * 1024 * 2 <= WS_X && WS_X + (size_t)T * D * 4 <= WS_H && WS_H + (size_t)T * D * 2 <= WS_P &&
              WS_P + (size_t)T * DINX * 2 <= WS_CAT && WS_CAT + (size_t)T * D * 2 <= WS_ROUTE && WS_ACT + (size_t)TP * D * 2 <= WS_Y && WS_Y + (size_t)TP * D * 2 <= WS_SU &&
              WS_SD + (size_t)(8 * 64 * 128 + 8 * 16384) * 4 <= WS_YP && WS_YP + (size_t)128 * 128 * 2 * 256 * 2 <= WS_OSCR && WS_OSCR + (size_t)256 * 32768 * 4 <= WS_H8 && WS_H8 + (size_t)T * D <= WS_CTXO && WS_CTXO + (size_t)32 * 8192 * 4 <= WS_FASTEND, "ws map");
constexpr int CW_TMO = 0, CW_BAR = 4096, CW_CNT = 16384;
constexpr int RING_OFF = 0, RING_BYTES = 131072, TINFO_OFF = 131072, BT_OFF = 136192, ROWOFF_OFF = 136704, MISC_OFF = 146944, LDS_BYTES = 147456;
constexpr int NWAVES = 8, NTHR = 512;

struct Params { const float* in[22]; float* out; unsigned char* ws; };
constexpr int PTR_OFF = MISC_OFF + 64;
struct Frame {
    LAS unsigned char* lds; unsigned char* ws; int tid, lane, wave, vcu, G, bid;
    __device__ __forceinline__ const float* in(int i) const { const LAS unsigned* q = (const LAS unsigned*)(lds + PTR_OFF) + 2 * i;
        const unsigned lo = __builtin_amdgcn_readfirstlane(q[0]), hi = __builtin_amdgcn_readfirstlane(q[1]); return (const float*)(((unsigned long long)hi << 32) | lo); }
    __device__ __forceinline__ const float* x() const { return in(0); }        __device__ __forceinline__ const float* c() const { return in(1); }
    __device__ __forceinline__ const float* ctxin() const { return in(2); }    __device__ __forceinline__ const float* cctx() const { return in(3); }
    __device__ __forceinline__ const float* w_ada() const { return in(4); }    __device__ __forceinline__ const float* b_ada() const { return in(5); }
    __device__ __forceinline__ const float* norm1_g() const { return in(6); }  __device__ __forceinline__ const float* norm2_g() const { return in(7); }
    __device__ __forceinline__ const float* w_in() const { return in(8); }     __device__ __forceinline__ const float* lbp() const { return in(9); }
    __device__ __forceinline__ const float* hng() const { return in(10); }     __device__ __forceinline__ const float* pool_w() const { return in(11); }
    __device__ __forceinline__ const float* pool_s() const { return in(12); }  __device__ __forceinline__ const float* four_w() const { return in(13); }
    __device__ __forceinline__ const float* w_out() const { return in(14); }   __device__ __forceinline__ const float* router_w() const { return in(15); }
    __device__ __forceinline__ const float* router_b() const { return in(16); } __device__ __forceinline__ const float* w_gu() const { return in(17); }
    __device__ __forceinline__ const float* b_gu() const { return in(18); }    __device__ __forceinline__ const float* w_dn() const { return in(19); }
    __device__ __forceinline__ const float* b_dn() const { return in(20); }    __device__ __forceinline__ const float* fng() const { return in(21); }
    __device__ __forceinline__ float* out() const { return (float*)in(22); }
    __device__ __forceinline__ gu32* ctl() const { return (gu32*)(ws + WS_CTL); }
    __device__ __forceinline__ float* LB() const { return (float*)(ws + WS_LB); }       __device__ __forceinline__ float* MOD() const { return (float*)(ws + WS_MOD); }
    __device__ __forceinline__ float* X() const { return (float*)(ws + WS_X); }
    __device__ __forceinline__ bf16_t* Wt_in() const { return (bf16_t*)(ws + WS_WIN); }  __device__ __forceinline__ bf16_t* Wt_out() const { return (bf16_t*)(ws + WS_WOUT); }
    __device__ __forceinline__ bf16_t* Wt_gu() const { return (bf16_t*)(ws + WS_WGU); }  __device__ __forceinline__ bf16_t* Wt_dn() const { return (bf16_t*)(ws + WS_WDN); }
    __device__ __forceinline__ bf16_t* H() const { return (bf16_t*)(ws + WS_H); }        __device__ __forceinline__ bf16_t* P() const { return (bf16_t*)(ws + WS_P); }
    __device__ __forceinline__ bf16_t* CAT() const { return (bf16_t*)(ws + WS_CAT); }    __device__ __forceinline__ bf16_t* ACT() const { return (bf16_t*)(ws + WS_ACT); }
    __device__ __forceinline__ bf16_t* Y() const { return (bf16_t*)(ws + WS_Y); }
    __device__ __forceinline__ int* TOPI() const { return (int*)(ws + WS_ROUTE + RT_TOPI); }   __device__ __forceinline__ float* TOPW() const { return (float*)(ws + WS_ROUTE + RT_TOPW); }
    __device__ __forceinline__ int* POS() const { return (int*)(ws + WS_ROUTE + RT_POS); }     __device__ __forceinline__ int* LISTE() const { return (int*)(ws + WS_ROUTE + RT_LISTE); }
};
__device__ __forceinline__ void frame_init(Frame& F, const Params& p, unsigned char* lds) {
    F.lds = (LAS unsigned char*)lds; F.tid = threadIdx.x; F.lane = F.tid & 63; F.wave = __builtin_amdgcn_readfirstlane(F.tid >> 6);
    F.G = gridDim.x; F.bid = blockIdx.x; { const int bx = blockIdx.x; F.vcu = (F.G % 8 == 0) ? (bx % 8) * (F.G / 8) + bx / 8 : bx; }
    F.ws = p.ws;
    if (F.tid == 0) { LAS unsigned long long* tab = (LAS unsigned long long*)(F.lds + PTR_OFF);
#pragma unroll
        for (int i = 0; i < 22; ++i) tab[i] = (unsigned long long)p.in[i];
        tab[22] = (unsigned long long)p.out; }
    __syncthreads();
}

__device__ __forceinline__ Frame relaunder(const Frame& F) { Frame R = F; int ln; asm volatile("v_mbcnt_lo_u32_b32 %0, -1, 0\n\tv_mbcnt_hi_u32_b32 %0, -1, %0" : "=v"(ln));
    R.lane = ln; R.tid = F.wave * 64 + ln; unsigned wlo = (unsigned)(unsigned long long)F.ws, whi = (unsigned)((unsigned long long)F.ws >> 32);
    asm volatile("" : "+s"(wlo), "+s"(whi)); R.ws = (unsigned char*)(((unsigned long long)whi << 32) | wlo);
    int sw = F.wave, sv = F.vcu, sg = F.G, sb = F.bid;
    asm volatile("" : "+s"(sw), "+s"(sv), "+s"(sg), "+s"(sb));
    R.wave = sw; R.vcu = sv; R.G = sg; R.bid = sb; R.tid = sw * 64 + ln; return R; }

struct DenseOrder {
    int nM, nN, nwg, G, c, Kb, pm0; const char* Bt;
    __device__ void init(int nM_, int nN_, int G_, int c_, int Kb_, const bf16_t* Bt_, int pm0_ = 0) { nM = nM_; nN = nN_; nwg = nM * nN; G = G_; c = c_; Kb = Kb_; Bt = (const char*)Bt_; pm0 = pm0_; }
    __device__ __forceinline__ bool next(int i, pg8::Unit& u) const {
        const long L = (long)i * G + c; if (L >= nwg) return false;
        int wgid = (int)L; { const int q = nwg / pg8::NXCD, r = nwg % pg8::NXCD, xcd = wgid % pg8::NXCD, off = wgid / pg8::NXCD; wgid = (xcd < r ? xcd * (q + 1) : r * (q + 1) + (xcd - r) * q) + off; }
        const int nig = pg8::WGM * nN, gid = wgid / nig, fm = gid * pg8::WGM, gsz = (nM - fm) < pg8::WGM ? (nM - fm) : pg8::WGM;
        u.pm = pm0 + fm + ((wgid % nig) % gsz); u.pn = (wgid % nig) / gsz; u.e = 0; u.ui = i; return true;
    }
    __device__ __forceinline__ const char* b_tile(const pg8::Unit& u) const { return Bt + (size_t)u.pn * 256 * Kb; }
    __device__ __forceinline__ unsigned a_row_off(const pg8::Unit& u, int r) const { return (unsigned)(u.pm * 256 + r) * (unsigned)Kb; }
};
template <bool GATHER> struct MoeOrder {
    const LAS int* tinfo; const LAS unsigned* rowoff; int ntiles, nN, G, c, Kb; const char* W; size_t wstride;
    __device__ __forceinline__ bool next(int i, pg8::Unit& u) const {
        const int L = i * G + c; if (L >= ntiles * nN) return false;
        u.pm = L / nN; u.pn = L % nN; u.e = __builtin_amdgcn_readfirstlane(tinfo[4 * u.pm]); u.ui = i; return true;
    }
    __device__ __forceinline__ const char* b_tile(const pg8::Unit& u) const { return W + (size_t)u.e * wstride + (size_t)u.pn * 256 * Kb; }
    __device__ __forceinline__ unsigned a_row_off(const pg8::Unit& u, int r) const { if constexpr (GATHER) return rowoff[u.ui * 256 + r]; else return (unsigned)(u.pm * 256 + r) * (unsigned)Kb; }
};

__device__ __forceinline__ unsigned pk_f16(float a, float b) { const _Float16 x = (_Float16)a, y = (_Float16)b; return (unsigned)__builtin_bit_cast(unsigned short, x) | ((unsigned)__builtin_bit_cast(unsigned short, y) << 16); }
__device__ __forceinline__ float f16lo(unsigned w) { return (float)__builtin_bit_cast(_Float16, (unsigned short)(w & 0xffffu)); }
__device__ __forceinline__ float f16hi(unsigned w) { return (float)__builtin_bit_cast(_Float16, (unsigned short)(w >> 16)); }
struct EpiP {
    static constexpr bool PERM = true; bf16_t* O; int ldc; const float* lb;
    __device__ __forceinline__ void operator()(const f32x4 (&acc)[2][2][4][2], const pg8::Unit& u, int wr, int wc, int fr, int fq) const {
        const int row0 = u.pm * 256 + wr * 64 + fr, col0 = u.pn * 256 + wc * 32 + 8 * fq;
        const int mode = u.pn < 2 ? 1 : (u.pn < 6 ? 2 : ((u.pn == 8 || u.pn == 9) ? 3 : 0));
        f32x4 lbv[2][2];
        if (mode == 2) {
#pragma unroll
            for (int bj = 0; bj < 2; ++bj)
#pragma unroll
                for (int n = 0; n < 2; ++n) lbv[bj][n] = *(const f32x4*)(lb + (col0 - 512) + bj * 128 + 4 * n); }
#pragma unroll
        for (int ai = 0; ai < 2; ++ai)
#pragma unroll
            for (int m = 0; m < 4; ++m) { bf16_t* rowp = O + (size_t)(row0 + ai * 128 + m * 16) * ldc + col0;
#pragma unroll
                for (int bj = 0; bj < 2; ++bj) { f32x2 v[4]; { const f32x4 v0 = acc[ai][bj][m][0], v1 = acc[ai][bj][m][1]; v[0] = (f32x2){v0[0], v0[1]}; v[1] = (f32x2){v0[2], v0[3]}; v[2] = (f32x2){v1[0], v1[1]}; v[3] = (f32x2){v1[2], v1[3]}; }
                    u32x4 w;
                    if (mode != 0) {
                        f32x2 sg[4];
#pragma unroll
                        for (int p = 0; p < 4; ++p) { const f32x2 ex = v[p] * (-1.44269504f); f32x2 d; d.x = __builtin_amdgcn_exp2f(ex.x); d.y = __builtin_amdgcn_exp2f(ex.y); d = d + 1.0f; sg[p].x = __builtin_amdgcn_rcpf(d.x); sg[p].y = __builtin_amdgcn_rcpf(d.y); }
                        if (mode == 2) {
#pragma unroll
                            for (int p = 0; p < 4; ++p) { const f32x4 lv = lbv[bj][p >> 1]; const f32x2 lb2 = (f32x2){lv[2 * (p & 1)], lv[2 * (p & 1) + 1]}; const f32x2 f = lb2 + (1.0f - lb2) * sg[p];
                                v[p].x = __builtin_amdgcn_logf(fmaxf(f.x, 1e-30f)); v[p].y = __builtin_amdgcn_logf(fmaxf(f.y, 1e-30f)); }
                            w.x = pk_f16(v[0].x, v[0].y); w.y = pk_f16(v[1].x, v[1].y); w.z = pk_f16(v[2].x, v[2].y); w.w = pk_f16(v[3].x, v[3].y);
                        } else {
#pragma unroll
                            for (int p = 0; p < 4; ++p) v[p] = mode == 1 ? v[p] * sg[p] : sg[p];
                            w.x = cvt_pk_bf16(v[0].x, v[0].y); w.y = cvt_pk_bf16(v[1].x, v[1].y); w.z = cvt_pk_bf16(v[2].x, v[2].y); w.w = cvt_pk_bf16(v[3].x, v[3].y); }
                    } else { w.x = cvt_pk_bf16(v[0].x, v[0].y); w.y = cvt_pk_bf16(v[1].x, v[1].y); w.z = cvt_pk_bf16(v[2].x, v[2].y); w.w = cvt_pk_bf16(v[3].x, v[3].y); }
                    *(u32x4*)(rowp + bj * 128) = w; } }
    }
};
struct EpiRes {
    static constexpr bool PERM = false; const float* base_ctx; const float* base_lat; const float* gate_ctx; const float* gate_lat; float* Xo;
    __device__ __forceinline__ void operator()(const f32x4 (&acc)[2][2][4][2], const pg8::Unit& u, int wr, int wc, int fr, int fq) const {
        const int rt = wr * 64 + fr, col0 = u.pn * 256 + wc * 32 + 4 * fq;
        const float* base = (u.pm == 0 ? base_ctx : base_lat + (size_t)(u.pm - 1) * 256 * D) + (size_t)rt * D + col0; const float* gate = (u.pm == 0 ? gate_ctx : gate_lat) + col0;
        float* op = Xo + (size_t)(u.pm * 256 + rt) * D + col0;
#pragma unroll
        for (int bj = 0; bj < 2; ++bj)
#pragma unroll
            for (int n = 0; n < 2; ++n) { const f32x4 gv = *(const f32x4*)(gate + bj * 128 + n * 16);
#pragma unroll
                for (int ai = 0; ai < 2; ++ai) {
#pragma unroll
                    for (int m = 0; m < 4; ++m) { const size_t o = (size_t)(ai * 128 + m * 16) * D + bj * 128 + n * 16; const f32x4 b = *(const f32x4*)(base + o); *(f32x4*)(op + o) = b + gv * acc[ai][bj][m][n]; }
                    asm volatile("" ::: "memory"); } }
    }
};
struct EpiAct {
    static constexpr bool PERM = true; bf16_t* ACTo; const float* bias;
    __device__ __forceinline__ void operator()(const f32x4 (&acc)[2][2][4][2], const pg8::Unit& u, int wr, int wc, int fr, int fq) const {
        const int x0 = wc * 32 + 8 * fq; const float* bg = bias + (size_t)u.e * 2048 + 128 * u.pn + x0; const float* bu = bg + 1024;
        const f32x4 g0 = *(const f32x4*)bg, g1 = *(const f32x4*)(bg + 4), u0 = *(const f32x4*)bu, u1 = *(const f32x4*)(bu + 4);
#pragma unroll
        for (int ai = 0; ai < 2; ++ai)
#pragma unroll
            for (int m = 0; m < 4; ++m) { const int row = u.pm * 256 + ai * 128 + wr * 64 + m * 16 + fr;
                const f32x4 ga = acc[ai][0][m][0] + g0, gb = acc[ai][0][m][1] + g1, ua = acc[ai][1][m][0] + u0, ub = acc[ai][1][m][1] + u1; float r[8];
#pragma unroll
                for (int j = 0; j < 4; ++j) { const float g = fminf(ga[j], 7.f), up = fminf(fmaxf(ua[j], -7.f), 7.f); r[j] = (up + 1.f) * (g * fsigm(1.702f * g));
                                              const float g2 = fminf(gb[j], 7.f), up2 = fminf(fmaxf(ub[j], -7.f), 7.f); r[4 + j] = (up2 + 1.f) * (g2 * fsigm(1.702f * g2)); }
                u32x4 w; w.x = cvt_pk_bf16(r[0], r[1]); w.y = cvt_pk_bf16(r[2], r[3]); w.z = cvt_pk_bf16(r[4], r[5]); w.w = cvt_pk_bf16(r[6], r[7]);
                *(u32x4*)(ACTo + (size_t)row * D + 128 * u.pn + x0) = w; }
    }
};
struct EpiY {
    static constexpr bool PERM = true; bf16_t* Yo; const float* bias;
    __device__ __forceinline__ void operator()(const f32x4 (&acc)[2][2][4][2], const pg8::Unit& u, int wr, int wc, int fr, int fq) const {
        const int row0 = u.pm * 256 + wr * 64 + fr, col0 = u.pn * 256 + wc * 32 + 8 * fq; const float* bp = bias + (size_t)u.e * D + col0;
        f32x4 bv[2][2];
#pragma unroll
        for (int bj = 0; bj < 2; ++bj)
#pragma unroll
            for (int n = 0; n < 2; ++n) bv[bj][n] = *(const f32x4*)(bp + bj * 128 + 4 * n);
#pragma unroll
        for (int ai = 0; ai < 2; ++ai)
#pragma unroll
            for (int m = 0; m < 4; ++m) { bf16_t* rowp = Yo + (size_t)(row0 + ai * 128 + m * 16) * D + col0;
#pragma unroll
                for (int bj = 0; bj < 2; ++bj) { const f32x4 v0 = acc[ai][bj][m][0] + bv[bj][0], v1 = acc[ai][bj][m][1] + bv[bj][1];
                    u32x4 w; w.x = cvt_pk_bf16(v0[0], v0[1]); w.y = cvt_pk_bf16(v0[2], v0[3]); w.z = cvt_pk_bf16(v1[0], v1[1]); w.w = cvt_pk_bf16(v1[2], v1[3]);
                    *(u32x4*)(rowp + bj * 128) = w; } }
    }
};

__device__ __forceinline__ unsigned pk4_fp8(float a, float b, float c, float d) { int r = __builtin_amdgcn_cvt_pk_fp8_f32(a, b, 0, false); r = __builtin_amdgcn_cvt_pk_fp8_f32(c, d, r, true); return (unsigned)r; }
struct EpiAct8 {
    static constexpr bool PERM = true; unsigned char* ACTo; const float* bias;
    __device__ __forceinline__ void operator()(const f32x4 (&acc)[2][2][4][2], const pg8::Unit& u, int wr, int wc, int fr, int fq) const {
        const int x0 = wc * 32 + 8 * fq; const float* bg = bias + (size_t)u.e * 2048 + 128 * u.pn + x0; const float* bu = bg + 1024; constexpr float isc = 1.f / (FP8_SH * FP8_SW);
        f32x2 g[4], v[4];
#pragma unroll
        for (int p = 0; p < 4; ++p) { g[p] = *(const f32x2*)(bg + 2 * p); v[p] = *(const f32x2*)(bu + 2 * p); }
#pragma unroll
        for (int ai = 0; ai < 2; ++ai)
#pragma unroll
            for (int m = 0; m < 4; ++m) { const int row = u.pm * 256 + ai * 128 + wr * 64 + m * 16 + fr; f32x2 r[4];
#pragma unroll
                for (int p = 0; p < 4; ++p) { const f32x4 ga4 = acc[ai][0][m][p >> 1], ua4 = acc[ai][1][m][p >> 1];
                    f32x2 gg = (f32x2){ga4[2 * (p & 1)], ga4[2 * (p & 1) + 1]} * isc + g[p], uu = (f32x2){ua4[2 * (p & 1)], ua4[2 * (p & 1) + 1]} * isc + v[p];
                    gg.x = fminf(gg.x, 7.f); gg.y = fminf(gg.y, 7.f); uu.x = __builtin_amdgcn_fmed3f(uu.x, -7.f, 7.f); uu.y = __builtin_amdgcn_fmed3f(uu.y, -7.f, 7.f);
                    const f32x2 ex = gg * (-1.702f * 1.44269504f); f32x2 d; d.x = __builtin_amdgcn_exp2f(ex.x); d.y = __builtin_amdgcn_exp2f(ex.y); d = d + 1.0f;
                    f32x2 rc; rc.x = __builtin_amdgcn_rcpf(d.x); rc.y = __builtin_amdgcn_rcpf(d.y);
                    r[p] = (uu * FP8_SA + FP8_SA) * (gg * rc); }
                u32x2 w; w.x = pk4_fp8(r[0].x, r[0].y, r[1].x, r[1].y); w.y = pk4_fp8(r[2].x, r[2].y, r[3].x, r[3].y);
                *(u32x2*)(ACTo + (size_t)row * D + 128 * u.pn + x0) = w; }
    }
};
struct EpiY8 {
    static constexpr bool PERM = true; bf16_t* Yo; const float* bias;
    __device__ __forceinline__ void operator()(const f32x4 (&acc)[2][2][4][2], const pg8::Unit& u, int wr, int wc, int fr, int fq) const {
        const int row0 = u.pm * 256 + wr * 64 + fr, col0 = u.pn * 256 + wc * 32 + 8 * fq; const float* bp = bias + (size_t)u.e * D + col0; constexpr float isc = 1.f / (FP8_SA * FP8_SW);
        f32x4 bv[2][2];
#pragma unroll
        for (int bj = 0; bj < 2; ++bj)
#pragma unroll
            for (int n = 0; n < 2; ++n) bv[bj][n] = *(const f32x4*)(bp + bj * 128 + 4 * n);
#pragma unroll
        for (int ai = 0; ai < 2; ++ai)
#pragma unroll
            for (int m = 0; m < 4; ++m) { bf16_t* rowp = Yo + (size_t)(row0 + ai * 128 + m * 16) * D + col0;
#pragma unroll
                for (int bj = 0; bj < 2; ++bj) { const f32x4 v0 = acc[ai][bj][m][0] * isc + bv[bj][0], v1 = acc[ai][bj][m][1] * isc + bv[bj][1];
                    u32x4 w; w.x = cvt_pk_bf16(v0[0], v0[1]); w.y = cvt_pk_bf16(v0[2], v0[3]); w.z = cvt_pk_bf16(v1[0], v1[1]); w.w = cvt_pk_bf16(v1[2], v1[3]);
                    *(u32x4*)(rowp + bj * 128) = w; } }
    }
};

struct CvtJob { const float* W; bf16_t* WT; int N, K, k0, n0, nrow0; };
__device__ __forceinline__ void cvt_load(const CvtJob& j, int lane, f32x4 (&r)[16]) { const GAS f32x4* src = (const GAS f32x4*)((const GAS float*)j.W + (unsigned)((j.k0 + 8 * (lane >> 3)) * j.N + j.n0 + 8 * (lane & 7)));
    const unsigned rs = (unsigned)j.N >> 2;
#pragma unroll
    for (int i = 0; i < 8; ++i) { r[2 * i] = src[i * rs]; r[2 * i + 1] = src[i * rs + 1]; } }
__device__ __forceinline__ void cvt_store(const CvtJob& j, int lane, const f32x4 (&r)[16]) {
    u32x4 b[8];
#pragma unroll
    for (int i = 0; i < 8; ++i) { b[i].x = cvt_pk_bf16(r[2 * i][0], r[2 * i][1]); b[i].y = cvt_pk_bf16(r[2 * i][2], r[2 * i][3]); b[i].z = cvt_pk_bf16(r[2 * i + 1][0], r[2 * i + 1][1]); b[i].w = cvt_pk_bf16(r[2 * i + 1][2], r[2 * i + 1][3]); }
    GAS u32x4* dst = (GAS u32x4*)((GAS bf16_t*)j.WT + (unsigned)((j.nrow0 + 8 * (lane & 7)) * j.K + j.k0 + 8 * (lane >> 3))); const unsigned rs = (unsigned)j.K >> 3;
#pragma unroll
    for (int q = 0; q < 8; ++q) { const unsigned sel = (q & 1) ? 0x07060302u : 0x05040100u; u32x4 o;
        o.x = __builtin_amdgcn_perm(b[1][q >> 1], b[0][q >> 1], sel); o.y = __builtin_amdgcn_perm(b[3][q >> 1], b[2][q >> 1], sel);
        o.z = __builtin_amdgcn_perm(b[5][q >> 1], b[4][q >> 1], sel); o.w = __builtin_amdgcn_perm(b[7][q >> 1], b[6][q >> 1], sel);
        dst[q * rs] = o; } }
__device__ __forceinline__ void cvt8_load(const CvtJob& j, int lane, f32x4 (&r)[16]) { const GAS f32x4* src = (const GAS f32x4*)((const GAS float*)j.W + (unsigned)((j.k0 + 16 * (lane >> 3)) * j.N + j.n0 + 4 * (lane & 7)));
    const unsigned rs = (unsigned)j.N >> 2;
#pragma unroll
    for (int i = 0; i < 16; ++i) r[i] = src[i * rs]; }
__device__ __forceinline__ void cvt8_store(const CvtJob& j, int lane, const f32x4 (&r)[16]) {
    GAS u32x4* dst = (GAS u32x4*)((GAS unsigned char*)j.WT + (unsigned)((j.nrow0 + 4 * (lane & 7)) * j.K + j.k0 + 16 * (lane >> 3))); const unsigned rs = (unsigned)j.K >> 4;
#pragma unroll
    for (int n = 0; n < 4; ++n) { u32x4 o;
        o.x = pk4_fp8(r[0][n] * FP8_SW, r[1][n] * FP8_SW, r[2][n] * FP8_SW, r[3][n] * FP8_SW); o.y = pk4_fp8(r[4][n] * FP8_SW, r[5][n] * FP8_SW, r[6][n] * FP8_SW, r[7][n] * FP8_SW);
        o.z = pk4_fp8(r[8][n] * FP8_SW, r[9][n] * FP8_SW, r[10][n] * FP8_SW, r[11][n] * FP8_SW); o.w = pk4_fp8(r[12][n] * FP8_SW, r[13][n] * FP8_SW, r[14][n] * FP8_SW, r[15][n] * FP8_SW);
        dst[n * rs] = o; } }
constexpr int NB_IN = (FQ_OFF < DIN ? FQ_OFF : DIN) / 64, I_IN = 16 * NB_IN, I_OUT = 16 * 16, I_GU = MOE_FP8 ? 8 * 64 : 16 * 32, I_DN = MOE_FP8 ? 8 * 32 : 16 * 16;
constexpr int N_IN = 2 * I_IN, N_OUT = 2 * I_OUT, N_GU = 2 * NE * I_GU, N_DN = 2 * NE * I_DN, N_CVT = N_IN + N_OUT + N_GU + N_DN;
__device__ __forceinline__ CvtJob cvt_job(const Frame& F, int it, bool& f8) {
    CvtJob j; int r = it; f8 = false;
    if (r < N_IN) { const int l = r / I_IN, q = r % I_IN, kb = q / NB_IN, nb = q % NB_IN; j = CvtJob{F.w_in() + (size_t)l * D * DIN, F.Wt_in() + (size_t)l * DINX * D, DIN, D, 64 * kb, 64 * nb, 64 * nb}; return j; } r -= N_IN;
    if (r < N_OUT) { const int l = r / I_OUT, q = r % I_OUT, kb = q >> 4, nb = q & 15; j = CvtJob{F.w_out() + (size_t)l * D * D, F.Wt_out() + (size_t)l * D * D, D, D, 64 * kb, 64 * nb, 64 * nb}; return j; } r -= N_OUT;
    f8 = MOE_FP8;
    if (r < N_GU) { const int le = r / I_GU, q = r % I_GU; const int kb = MOE_FP8 ? q >> 6 : q >> 5, nb = MOE_FP8 ? q & 63 : q & 31; const int n0 = (MOE_FP8 ? 32 : 64) * nb, bj = n0 >> 10, xx = n0 & 1023;
        j = CvtJob{F.w_gu() + (size_t)le * D * 2048, (bf16_t*)((unsigned char*)F.Wt_gu() + (size_t)le * 2048 * D * (MOE_FP8 ? 1 : 2)), 2048, D, (MOE_FP8 ? 128 : 64) * kb, n0, 256 * (xx >> 7) + 128 * bj + (xx & 127)}; return j; } r -= N_GU;
    { const int le = r / I_DN, q = r % I_DN; const int kb = MOE_FP8 ? q >> 5 : q >> 4, nb = MOE_FP8 ? q & 31 : q & 15; const int n0 = (MOE_FP8 ? 32 : 64) * nb;
      j = CvtJob{F.w_dn() + (size_t)le * D * D, (bf16_t*)((unsigned char*)F.Wt_dn() + (size_t)le * D * D * (MOE_FP8 ? 1 : 2)), D, D, (MOE_FP8 ? 128 : 64) * kb, n0, n0}; return j; }
}
__device__ __forceinline__ void cvt_ld(const CvtJob& j, bool f8, int lane, f32x4 (&r)[16]) { if (f8) cvt8_load(j, lane, r); else cvt_load(j, lane, r); }
__device__ __forceinline__ void cvt_st(const CvtJob& j, bool f8, int lane, const f32x4 (&r)[16]) { if (f8) cvt8_store(j, lane, r); else cvt_store(j, lane, r); }
constexpr int WIN_UNITS = (T / 256) * (DINX / 256), WIN_BUSY = WIN_UNITS % 256, DEF_WIN = MOE_FP8 ? 3 : 0, DEF_WOUT = 0;
constexpr int DEF_A = (256 - WIN_BUSY) * NWAVES * DEF_WIN, DEF_B = (256 - 4) * NWAVES * DEF_WOUT, DEF_C = DEF_A, DEF_TOTAL = DEF_A + DEF_B + DEF_C;
constexpr int CVT_GU0 = N_IN + N_OUT, CVT_GU1 = CVT_GU0 + NE * I_GU;
static_assert(DEF_A + DEF_B <= NE * I_GU && DEF_C <= NE * I_GU, "deferred slices inside one layer's gate/up items");
__device__ __forceinline__ int cvt_remap(int j) { int it = j; if (it >= CVT_GU0) it += DEF_A + DEF_B; if (it >= CVT_GU1) it += DEF_C; return it; }
__device__ __forceinline__ void cvt_run(Frame& F, int first, int stride, int limit, bool remap) {
    int it = first; if (it >= limit) return;
    f32x4 ra[16], rb[16]; bool fa, fb = false; CvtJob ja = cvt_job(F, remap ? cvt_remap(it) : it, fa), jb; cvt_ld(ja, fa, F.lane, ra);
    for (;;) {
        const int itb = it + stride; const bool hb = itb < limit; if (hb) { jb = cvt_job(F, remap ? cvt_remap(itb) : itb, fb); cvt_ld(jb, fb, F.lane, rb); }
        cvt_st(ja, fa, F.lane, ra); if (!hb) break;
        const int ita = itb + stride; const bool ha = ita < limit; if (ha) { ja = cvt_job(F, remap ? cvt_remap(ita) : ita, fa); cvt_ld(ja, fa, F.lane, ra); }
        cvt_st(jb, fb, F.lane, rb); if (!ha) break;
        it = ita;
    }
}
__device__ __forceinline__ void cvt_deferred(Frame& F, int base, int slot, int per_wave) { if (per_wave == 0) return; const int first = base + (slot * NWAVES + F.wave) * per_wave; cvt_run(F, first, 1, first + per_wave, false); }
__device__ __forceinline__ void ph_prologue(Frame& F) {
    const int gw = F.vcu * NWAVES + F.wave, NGW = F.G * NWAVES;
    for (int i = gw * 64 + F.lane; i < 1024; i += NGW * 64) { const float a = F.lbp()[i], b = F.lbp()[1024 + i], m = fmaxf(a, b), ea = __expf(a - m), eb = __expf(b - m); F.LB()[i] = 0.f; F.LB()[1024 + i] = eb / (ea + eb); }
    if (F.bid < 192) {
        LAS float* sc = (LAS float*)(F.lds); LAS float* part = sc + 2048;
        { const float* c = F.c(); const float* cc = F.cctx(); for (int i = F.tid; i < D; i += NTHR) { const float a = c[i], b = cc[i]; sc[i] = a * fsigm(a); sc[D + i] = b * fsigm(b); } }
        __syncthreads();
        const int l = F.bid / 96, jcol = (F.bid % 96) * 64 + F.lane; const GAS float* W = (const GAS float*)F.w_ada() + (unsigned)(l * D * 6144 + (128 * F.wave) * 6144 + jcol); float a0 = 0.f, a1 = 0.f;
#pragma unroll 16
        for (int i = 0; i < 128; ++i) { const float w = W[(unsigned)i * 6144u]; a0 += sc[128 * F.wave + i] * w; a1 += sc[D + 128 * F.wave + i] * w; }
        part[(F.wave * 2 + 0) * 64 + F.lane] = a0; part[(F.wave * 2 + 1) * 64 + F.lane] = a1;
        __syncthreads();
        if (F.tid < 128) { const int which = F.tid >> 6, col = F.tid & 63; float s = 0.f;
#pragma unroll
            for (int w = 0; w < 8; ++w) s += part[(w * 2 + which) * 64 + col];
            const int j = (F.bid % 96) * 64 + col; F.MOD()[(size_t)(l * 2 + which) * 6144 + j] = s + F.b_ada()[l * 6144 + j]; }
        __syncthreads();
    }
    cvt_run(F, gw, NGW, N_CVT - DEF_TOTAL, true);
}
__device__ __forceinline__ void row_load(const float* xrow, int lane, f32x4 (&v)[4]) { const GAS f32x4* xr = (const GAS f32x4*)xrow + lane;
#pragma unroll
    for (int j = 0; j < 4; ++j) v[j] = xr[64 * j]; }
__device__ __forceinline__ float row_rstd(const f32x4 (&v)[4], int lane) { float s = 0.f;
#pragma unroll
    for (int j = 0; j < 4; ++j) s += (v[j].x * v[j].x + v[j].y * v[j].y) + (v[j].z * v[j].z + v[j].w * v[j].w);
    return rsqrtf(wave_sum(s, lane) * (1.f / D) + 1e-6f); }
__device__ __forceinline__ void row_modulate(const f32x4 (&v)[4], float r, const float* g, const float* sc, const float* sh, int lane, f32x4 (&hv)[4]) {
#pragma unroll
    for (int j = 0; j < 4; ++j) { const f32x4 gg = ((const GAS f32x4*)g)[lane + 64 * j], s1 = ((const GAS f32x4*)sc)[lane + 64 * j], s0 = ((const GAS f32x4*)sh)[lane + 64 * j];
        hv[j] = v[j] * r * gg * (s1 + 1.f) + s0; } }
__device__ __forceinline__ void row_store_fp8(unsigned char* orow, int lane, const f32x4 (&hv)[4]) { GAS unsigned* o4 = (GAS unsigned*)orow + lane;
#pragma unroll
    for (int j = 0; j < 4; ++j) o4[64 * j] = pk4_fp8(hv[j].x * FP8_SH, hv[j].y * FP8_SH, hv[j].z * FP8_SH, hv[j].w * FP8_SH); }
__device__ __forceinline__ void row_store_bf16(bf16_t* orow, int lane, const f32x4 (&hv)[4]) { GAS u32x2* o8 = (GAS u32x2*)orow + lane;
#pragma unroll
    for (int j = 0; j < 4; ++j) { u32x2 w; w.x = pk2(hv[j].x, hv[j].y); w.y = pk2(hv[j].z, hv[j].w); o8[64 * j] = w; } }

__device__ __forceinline__ void ph_mod1(Frame& F, int l) {
    const int gw = F.vcu * NWAVES + F.wave, NGW = F.G * NWAVES;
    for (int row = gw; row < T; row += NGW) {
        const float* xr = l == 0 ? (row < CTX ? F.ctxin() + (size_t)row * D : F.x() + (size_t)(row - CTX) * D) : F.X() + (size_t)row * D;
        const float* m = F.MOD() + (size_t)(l * 2 + (row < CTX ? 1 : 0)) * 6144;
        f32x4 v[4], hv[4]; row_load(xr, F.lane, v); const float r = row_rstd(v, F.lane); row_modulate(v, r, F.norm1_g() + l * D, m + D, m, F.lane, hv); row_store_bf16(F.H() + (size_t)row * D, F.lane, hv);
    }
}

constexpr int RA_ST = 2064, RA_HALF = 16 * RA_ST, RA_BUF = 2 * RA_HALF;
constexpr int RLG_OFF = 2 * RA_BUF, RSCR_OFF = RLG_OFF + 8592;
static_assert(8 * 80 * 32 * 4 <= RLG_OFF && 65 * 33 * 4 <= 8592 && RSCR_OFF + 3520 <= MISC_OFF && RSCR_OFF % 16 == 0, "router LDS map");
__device__ __forceinline__ void split2(float a, float b, unsigned& hi, unsigned& lo) { hi = cvt_pk_bf16(a, b); lo = cvt_pk_bf16(a - bflo(hi), b - bfhi(hi)); }
__device__ __forceinline__ void ph_mod2_route(Frame& F, int l, int cbank) {
    LAS unsigned char* L = F.lds + RING_OFF; LAS float* LG = (LAS float*)(L + RLG_OFF);
    LAS int* lcnt = (LAS int*)(L + RSCR_OFF); LAS int* lbase = lcnt + 32; LAS int* te = lbase + 32; LAS float* tw = (LAS float*)(te + 272); LAS int* trk = (LAS int*)(tw + 272);
    int ln = F.lane; asm volatile("" : "+v"(ln)); const int w = F.wave, fr = ln & 15, g = ln >> 4;
    __syncthreads();
    if (F.tid < 32) lcnt[F.tid] = 0;
    const int row0 = F.bid * 65;
    const float* Xp = F.X(); const float* n2g = F.norm2_g() + l * D; const float* modl = F.MOD() + (size_t)(l * 2) * 6144; bf16_t* Hp = F.H(); unsigned char* H8p = F.ws + WS_H8;
    f32x4 v[2][4];
#pragma unroll
    for (int i = 0; i < 2; ++i) row_load(Xp + (size_t)(row0 + min(2 * w + i, 64)) * D, ln, v[i]);
    bf16x8 Bh[4][2], Bl[4][2];
    { const GAS float* rw = (const GAS float*)F.router_w() + (unsigned)(l * D * NE + (128 * w + 8 * g) * NE + fr);
#pragma unroll
      for (int s_ = 0; s_ < 4; ++s_)
#pragma unroll
          for (int nb = 0; nb < 2; ++nb) { float x[8];
#pragma unroll
              for (int i = 0; i < 8; ++i) x[i] = rw[(32 * s_ + i) * NE + 16 * nb];
              unsigned h_[4], l_[4]; split2(x[0], x[1], h_[0], l_[0]); split2(x[2], x[3], h_[1], l_[1]); split2(x[4], x[5], h_[2], l_[2]); split2(x[6], x[7], h_[3], l_[3]); const u32x4 hi = (u32x4){h_[0], h_[1], h_[2], h_[3]}, lo = (u32x4){l_[0], l_[1], l_[2], l_[3]};
              Bh[s_][nb] = __builtin_bit_cast(bf16x8, hi); Bl[s_][nb] = __builtin_bit_cast(bf16x8, lo); } }
    f32x4 acc[5][2];
#pragma unroll
    for (int b = 0; b < 5; ++b) { acc[b][0] = (f32x4){0.f, 0.f, 0.f, 0.f}; acc[b][1] = (f32x4){0.f, 0.f, 0.f, 0.f}; }
#pragma unroll
    for (int b = 0; b < 5; ++b) {
        LAS unsigned char* Ab = L + (b & 1) * RA_BUF;
#pragma unroll
        for (int i = 0; i < 2; ++i) { const int lr = 16 * b + 2 * w + i, row = row0 + min(lr, 64); const float* m = modl + (row < CTX ? 6144 : 0);
            const float rs = row_rstd(v[i], ln); f32x4 h[4]; row_modulate(v[i], rs, n2g, m + 4 * D, m + 3 * D, ln, h);
            if (lr < 65) { if (MOE_FP8) row_store_fp8(H8p + (size_t)row * D, ln, h); else row_store_bf16(Hp + (size_t)row * D, ln, h); }
#pragma unroll
            for (int j = 0; j < 4; ++j) { unsigned h0, l0, h1, l1; split2(h[j].x, h[j].y, h0, l0); split2(h[j].z, h[j].w, h1, l1); const u32x2 hi = (u32x2){h0, h1}, lo = (u32x2){l0, l1};
                LAS unsigned char* ap = Ab + (2 * w + i) * RA_ST + (4 * ln + 256 * j) * 2; *(LAS u32x2*)ap = hi; *(LAS u32x2*)(ap + RA_HALF) = lo; } }
        if (b < 4) {
#pragma unroll
            for (int i = 0; i < 2; ++i) row_load(Xp + (size_t)(row0 + min(16 * (b + 1) + 2 * w + i, 64)) * D, ln, v[i]); }
        __syncthreads();
#pragma unroll
        for (int s_ = 0; s_ < 4; ++s_) { const LAS unsigned char* ap = Ab + fr * RA_ST + (128 * w + 32 * s_ + 8 * g) * 2; const bf16x8 ah = *(const LAS bf16x8*)ap, al = *(const LAS bf16x8*)(ap + RA_HALF);
#pragma unroll
            for (int nb = 0; nb < 2; ++nb) { f32x4 c = acc[b][nb]; c = __builtin_amdgcn_mfma_f32_16x16x32_bf16(ah, Bh[s_][nb], c, 0, 0, 0); c = __builtin_amdgcn_mfma_f32_16x16x32_bf16(ah, Bl[s_][nb], c, 0, 0, 0);
                c = __builtin_amdgcn_mfma_f32_16x16x32_bf16(al, Bh[s_][nb], c, 0, 0, 0); acc[b][nb] = c; } }
    }
    __syncthreads();
    { LAS float* PT = (LAS float*)L;
#pragma unroll
      for (int b = 0; b < 5; ++b)
#pragma unroll
          for (int nb = 0; nb < 2; ++nb)
#pragma unroll
              for (int r = 0; r < 4; ++r) PT[(w * 80 + 16 * b + 4 * g + r) * 32 + 16 * nb + fr] = acc[b][nb][r];
      __syncthreads();
      for (int i = F.tid; i < 65 * 32; i += NTHR) { const int row = i >> 5, e = i & 31; float sacc = F.router_b()[l * NE + e];
#pragma unroll
          for (int w2 = 0; w2 < 8; ++w2) sacc += PT[(w2 * 80 + row) * 32 + e];
          LG[row * 33 + e] = sacc; } }
    __syncthreads();
    if (F.tid < 65) { const int row = F.tid; float bv[4] = {-3.0e38f, -3.0e38f, -3.0e38f, -3.0e38f}; int bi[4] = {0, 0, 0, 0};
#pragma unroll
        for (int e = 0; e < 32; ++e) { const float x = LG[row * 33 + e]; const bool c0 = x > bv[0], c1 = x > bv[1], c2 = x > bv[2], c3 = x > bv[3];
            bv[3] = c2 ? bv[2] : (c3 ? x : bv[3]); bi[3] = c2 ? bi[2] : (c3 ? e : bi[3]); bv[2] = c1 ? bv[1] : (c2 ? x : bv[2]); bi[2] = c1 ? bi[1] : (c2 ? e : bi[2]);
            bv[1] = c0 ? bv[0] : (c1 ? x : bv[1]); bi[1] = c0 ? bi[0] : (c1 ? e : bi[1]); bv[0] = c0 ? x : bv[0]; bi[0] = c0 ? e : bi[0]; }
        float ex[4], sum = 0.f;
#pragma unroll
        for (int q = 0; q < 4; ++q) { ex[q] = __expf(bv[q] - bv[0]); sum += ex[q]; }
        const float inv = 1.f / sum;
#pragma unroll
        for (int q = 0; q < 4; ++q) { te[row * 4 + q] = bi[q]; tw[row * 4 + q] = ex[q] * inv; trk[row * 4 + q] = (int)__hip_atomic_fetch_add((LAS unsigned*)&lcnt[bi[q]], 1u, __ATOMIC_RELAXED, __HIP_MEMORY_SCOPE_WORKGROUP); } }
    __syncthreads();
    if (F.tid < 32) lbase[F.tid] = (int)__hip_atomic_fetch_add((unsigned*)(F.ctl() + CW_CNT + (cbank * 32 + F.tid) * 64), (unsigned)lcnt[F.tid], RLX_AGENT);
    __syncthreads();
    for (int i = F.tid; i < 65 * 4; i += NTHR) { const int row = row0 + (i >> 2), e = te[i], pos = lbase[e] + trk[i];
        F.TOPI()[row * 4 + (i & 3)] = e; F.TOPW()[row * 4 + (i & 3)] = tw[i]; F.POS()[row * 4 + (i & 3)] = pos; F.LISTE()[(size_t)e * T + pos] = row; }
    __syncthreads();
}

__device__ __forceinline__ int moe_tiles(Frame& F, int l) {
    LAS int* tinfo = (LAS int*)(F.lds + TINFO_OFF); LAS int* bt = (LAS int*)(F.lds + BT_OFF); LAS int* cn = bt + 32; LAS int* ntl = bt + 64;
    __syncthreads();
    if (F.tid < 64) {
        const int e = F.lane & 31; const int c = (int)__hip_atomic_load(F.ctl() + CW_CNT + (l * 32 + e) * 64, RLX_AGENT); const int nt = (c + 255) >> 8;
        int incl = nt;
#pragma unroll
        for (int o = 1; o < 32; o <<= 1) { const int t = lane_get(incl, (F.lane - o) & 63); if (e >= o) incl += t; }
        const int first = incl - nt;
        if (F.lane < 32) { bt[e] = first; cn[e] = c; for (int j = 0; j < nt; ++j) { LAS int* ti = tinfo + 4 * (first + j); ti[0] = e; ti[1] = 0; ti[2] = 256 * j; ti[3] = min(256, c - 256 * j); } if (e == 31) ntl[0] = incl; }
    }
    __syncthreads();
    return ntl[0];
}

__device__ __forceinline__ void ph_gateup(Frame& F, int l) {
    const int ntiles = moe_tiles(F, l); constexpr int EB = MOE_FP8 ? 1 : 2;
    LAS int* tinfo = (LAS int*)(F.lds + TINFO_OFF); LAS unsigned* rowoff = (LAS unsigned*)(F.lds + ROWOFF_OFF);
    MoeOrder<true> S; S.tinfo = tinfo; S.rowoff = rowoff; S.ntiles = ntiles; S.nN = 8; S.G = F.G; S.c = F.vcu; S.Kb = D * EB; S.W = (const char*)F.Wt_gu() + (size_t)l * NE * 2048 * D * EB; S.wstride = (size_t)2048 * D * EB;
    for (int i = 0;; ++i) { pg8::Unit u; if (!S.next(i, u) || i >= 10) break;
        if (F.tid < 256) { const int pos0 = tinfo[4 * u.pm + 2], valid = tinfo[4 * u.pm + 3]; const int tok = F.tid < valid ? F.LISTE()[(size_t)u.e * T + pos0 + F.tid] : 0; rowoff[i * 256 + F.tid] = (unsigned)tok * (unsigned)(D * EB); } }
    __syncthreads();
    if constexpr (MOE_FP8) { EpiAct8 E{(unsigned char*)F.ACT(), F.b_gu() + (size_t)l * NE * 2048};
        pg8::gemm_phase<EpiAct8, MoeOrder<true>, true, true>(F.lds + RING_OFF, (const char*)(F.ws + WS_H8), D, S, E, F.tid); }
    else { EpiAct E{F.ACT(), F.b_gu() + (size_t)l * NE * 2048};
        pg8::gemm_phase<EpiAct, MoeOrder<true>, true, false>(F.lds + RING_OFF, (const char*)F.H(), 2 * D, S, E, F.tid); }
}
__device__ __forceinline__ void ph_down(Frame& F, int l) {
    const int ntiles = moe_tiles(F, l); constexpr int EB = MOE_FP8 ? 1 : 2;
    MoeOrder<false> S; S.tinfo = (LAS int*)(F.lds + TINFO_OFF); S.rowoff = nullptr; S.ntiles = ntiles; S.nN = 4; S.G = F.G; S.c = F.vcu; S.Kb = D * EB; S.W = (const char*)F.Wt_dn() + (size_t)l * NE * D * D * EB; S.wstride = (size_t)D * D * EB;
    if constexpr (MOE_FP8) { EpiY8 E{F.Y(), F.b_dn() + (size_t)l * NE * D};
        pg8::gemm_phase<EpiY8, MoeOrder<false>, true, true>(F.lds + RING_OFF, (const char*)F.ACT(), D, S, E, F.tid); }
    else { EpiY E{F.Y(), F.b_dn() + (size_t)l * NE * D};
        pg8::gemm_phase<EpiY, MoeOrder<false>, true, false>(F.lds + RING_OFF, (const char*)F.ACT(), 2 * D, S, E, F.tid); }
}
__device__ __forceinline__ void ph_win(Frame& F, int l) {
    DenseOrder S; S.init(T / 256, DINX / 256, F.G, F.bid, 2 * D, F.Wt_in() + (size_t)l * DINX * D);
    EpiP E{F.P(), DINX, F.LB() + l * 1024};
    pg8::gemm_phase<EpiP, DenseOrder, true>(F.lds + RING_OFF, (const char*)F.H(), 2 * D, S, E, F.tid);
    if (F.bid >= WIN_BUSY) cvt_deferred(F, l == 0 ? CVT_GU0 : CVT_GU1, F.bid - WIN_BUSY, DEF_WIN);
}
__device__ __forceinline__ void wout_ctx(Frame& F, int l) {
    int ln = F.lane; asm volatile("" : "+v"(ln)); const int w = F.wave, fr = ln & 15, g = ln >> 4, rb = F.bid >> 4, cbk = F.bid & 15;
    const GAS bf16x8* ap = (const GAS bf16x8*)((const GAS bf16_t*)F.CAT() + (unsigned)((16 * rb + fr) * D + 128 * w + 8 * g));
    const GAS bf16x8* bp = (const GAS bf16x8*)((const GAS bf16_t*)F.Wt_out() + (unsigned)(l * D * D + (64 * cbk + fr) * D + 128 * w + 8 * g));
    bf16x8 a[4], b[4][4];
#pragma unroll
    for (int s_ = 0; s_ < 4; ++s_) { a[s_] = ap[4 * s_];
#pragma unroll
        for (int nb = 0; nb < 4; ++nb) b[nb][s_] = bp[(unsigned)(nb * 16 * D / 8) + 4 * s_]; }
    f32x4 acc[4];
#pragma unroll
    for (int nb = 0; nb < 4; ++nb) { acc[nb] = (f32x4){0.f, 0.f, 0.f, 0.f};
#pragma unroll
        for (int s_ = 0; s_ < 4; ++s_) acc[nb] = __builtin_amdgcn_mfma_f32_16x16x32_bf16(a[s_], b[nb][s_], acc[nb], 0, 0, 0); }
    LAS float* PT = (LAS float*)(F.lds + RING_OFF);
    __syncthreads();
#pragma unroll
    for (int nb = 0; nb < 4; ++nb)
#pragma unroll
        for (int r = 0; r < 4; ++r) PT[(w * 16 + 4 * g + r) * 64 + 16 * nb + fr] = acc[nb][r];
    __syncthreads();
    const float* m = F.MOD() + (size_t)(l * 2) * 6144; const float* gate = m + 6144 + 2 * D; const float* base = l == 0 ? F.ctxin() : F.X();
#pragma unroll
    for (int i = 0; i < 2; ++i) { const int o = F.tid + NTHR * i, row = o >> 6, col = o & 63; float sacc = 0.f;
#pragma unroll
        for (int w2 = 0; w2 < 8; ++w2) sacc += PT[(w2 * 16 + row) * 64 + col];
        const int gr = 16 * rb + row, gc = 64 * cbk + col; F.X()[(size_t)gr * D + gc] = base[(size_t)gr * D + gc] + gate[gc] * sacc; }
    __syncthreads();
}
__device__ __forceinline__ void ph_wout(Frame& F, int l) {
    DenseOrder S; S.init(LAT / 256, D / 256, F.G, F.bid, 2 * D, F.Wt_out() + (size_t)l * D * D, 1);
    const float* m = F.MOD() + (size_t)(l * 2) * 6144;
    EpiRes E{l == 0 ? F.ctxin() : F.X(), l == 0 ? F.x() : F.X() + (size_t)CTX * D, m + 6144 + 2 * D, m + 2 * D, F.X()};
    pg8::gemm_phase<EpiRes, DenseOrder, true>(F.lds + RING_OFF, (const char*)F.CAT(), 2 * D, S, E, F.tid);
    if (l == 0) wout_ctx(F, l);
}
__device__ __forceinline__ void combine_gather(const Frame& F, const LAS int* bt, int row, int ln, f32x4 (&v)[4], u32x2 (&y)[4][4], float (&w)[4]) {
    row_load(F.X() + (size_t)row * D, ln, v);
    const GAS int* ti = (const GAS int*)F.TOPI() + (unsigned)(row * 4); const GAS float* tw = (const GAS float*)F.TOPW() + (unsigned)(row * 4); const GAS int* tp = (const GAS int*)F.POS() + (unsigned)(row * 4);
#pragma unroll
    for (int q = 0; q < 4; ++q) { const int e = ti[q]; w[q] = tw[q]; const int srow = 256 * bt[e] + tp[q]; const GAS u32x2* yr = (const GAS u32x2*)((const GAS bf16_t*)F.Y() + (unsigned)srow * (unsigned)D) + ln;
#pragma unroll
        for (int j = 0; j < 4; ++j) y[q][j] = yr[64 * j]; }
}
__device__ __forceinline__ void combine_finish(const Frame& F, int l, int row, int ln, f32x4 (&v)[4], const u32x2 (&y)[4][4], const float (&w)[4]) {
    const float* m = F.MOD() + (size_t)(l * 2 + (row < CTX ? 1 : 0)) * 6144 + 5 * D;
#pragma unroll
    for (int j = 0; j < 4; ++j) { f32x4 s = (f32x4){0.f, 0.f, 0.f, 0.f};
#pragma unroll
        for (int q = 0; q < 4; ++q) s += w[q] * (f32x4){bflo(y[q][j].x), bfhi(y[q][j].x), bflo(y[q][j].y), bfhi(y[q][j].y)};
        v[j] += ((const GAS f32x4*)m)[ln + 64 * j] * s; }
    const float r = row_rstd(v, ln);
    if (l == 0) {
        GAS f32x4* xo = (GAS f32x4*)(F.X() + (size_t)row * D) + ln;
#pragma unroll
        for (int j = 0; j < 4; ++j) xo[64 * j] = v[j];
        const float* m1 = F.MOD() + (size_t)(2 + (row < CTX ? 1 : 0)) * 6144; f32x4 hv[4];
        row_modulate(v, r, F.norm1_g() + D, m1 + D, m1, ln, hv); row_store_bf16(F.H() + (size_t)row * D, ln, hv);
    } else {
        GAS f32x4* o = (GAS f32x4*)(F.out() + (size_t)(row - CTX) * D) + ln; const float* fg = F.fng();
#pragma unroll
        for (int j = 0; j < 4; ++j) o[64 * j] = v[j] * r * ((const GAS f32x4*)fg)[ln + 64 * j];
    }
}
__device__ __forceinline__ void ph_combine(Frame& F, int l) {
    (void)moe_tiles(F, l);
    const LAS int* bt = (const LAS int*)(F.lds + BT_OFF);
    const int gw = F.vcu * NWAVES + F.wave, NGW = F.G * NWAVES; const int rbeg = l == 1 ? CTX : 0;
#pragma unroll 1
    for (int ra = rbeg + gw; ra < T; ra += 2 * NGW) {
        int ln = F.lane; asm volatile("" : "+v"(ln));
        const int rb = ra + NGW; const bool hasb = rb < T; const int rbc = hasb ? rb : ra;
        f32x4 va[4], vb[4]; u32x2 ya[4][4], yb[4][4]; float wa[4], wb[4];
        combine_gather(F, bt, ra, ln, va, ya, wa); combine_gather(F, bt, rbc, ln, vb, yb, wb);
        combine_finish(F, l, ra, ln, va, ya, wa);
        if (hasb) combine_finish(F, l, rb, ln, vb, yb, wb);
    }
}
constexpr size_t WF_MA = 0, WF_MB = 128 * 1024, WF_MC = 256 * 1024, WF_PW = 512 * 1024;
constexpr int ZS = 528;
__device__ __forceinline__ f32x4 mfma16(bf16x8 a, bf16x8 b, f32x4 c) { return __builtin_amdgcn_mfma_f32_16x16x32_bf16(a, b, c, 0, 0, 0); }

__device__ __forceinline__ void ph_prologue2(Frame& F) {
    bf16_t* MA = (bf16_t*)(F.ws + WS_WF + WF_MA); bf16_t* MB = (bf16_t*)(F.ws + WS_WF + WF_MB); bf16_t* MC = (bf16_t*)(F.ws + WS_WF + WF_MC); bf16_t* PW = (bf16_t*)(F.ws + WS_WF + WF_PW);
    const int gt = F.bid * NTHR + F.tid, NT = F.G * NTHR;
    for (int i = gt; i < 256 * 256; i += NT) { const int r = i >> 8, cidx = i & 255, ri = r >> 7, k1 = r & 127, rj = cidx >> 7, t1 = cidx & 127; const float x = 2.f * (float)((k1 * t1) & 127) / 128.f;
        const float cs = cospif(x), sn = sinpif(x); const float v = ri == 0 ? (rj == 0 ? cs : -sn) : (rj == 0 ? -sn : -cs); MA[i] = (bf16_t)f2bf(v); }
    for (int i = gt; i < 128 * 256; i += NT) { const int k2 = i >> 8, cidx = i & 255, rj = cidx >> 7, t2 = cidx & 127; const float x = 2.f * (float)((k2 * t2) & 127) / 128.f; MB[i] = (bf16_t)f2bf(rj == 0 ? cospif(x) : sinpif(x)); }
    for (int i = gt; i < 256 * 512; i += NT) { const int k = i >> 9, cidx = i & 511, rj = cidx >> 8, t = cidx & 255; const float x = 2.f * (float)((k * t) & 255) / 256.f; MC[i] = (bf16_t)f2bf(rj == 0 ? cospif(x) : -sinpif(x)); }
    for (int i = gt; i < 2 * 4 * 64 * 64; i += NT) { const int lg = i >> 12, j = (i >> 6) & 63, ii = i & 63; PW[i] = (bf16_t)f2bf(F.pool_w()[(size_t)lg * 4096 + ii * 64 + j]); }
    LAS float* m12T = (LAS float*)(F.lds);
    LAS float* trig = (LAS float*)(F.lds + 33280);
    LAS float* fws = (LAS float*)(F.lds + 33280 + 512);
    __syncthreads();
    if (F.tid < 64) { trig[F.tid] = cospif(2.f * (float)F.tid / 64.f); trig[64 + F.tid] = sinpif(2.f * (float)F.tid / 64.f); }
    __syncthreads();
    bf16x8 TH[2], TL[2];
    { const int c = 16 * (F.wave >> 1) + (F.lane & 15), g = F.lane >> 4, sel0 = (F.bid & 15) >> 3;
#pragma unroll
      for (int s_ = 0; s_ < 2; ++s_) { float t[8];
#pragma unroll
          for (int i = 0; i < 8; ++i) t[i] = trig[sel0 * 64 + (((32 * s_ + 8 * g + i) * c) & 63)];
          unsigned h_[4], l_[4]; split2(t[0], t[1], h_[0], l_[0]); split2(t[2], t[3], h_[1], l_[1]); split2(t[4], t[5], h_[2], l_[2]); split2(t[6], t[7], h_[3], l_[3]);
          TH[s_] = __builtin_bit_cast(bf16x8, (u32x4){h_[0], h_[1], h_[2], h_[3]}); TL[s_] = __builtin_bit_cast(bf16x8, (u32x4){l_[0], l_[1], l_[2], l_[3]}); } }
    for (int tile = F.bid; tile < 2 * 256; tile += F.G) {
        const int l = tile >> 8, kb = (tile >> 4) & 15, nb = tile & 15, k0 = 64 * kb, n0 = 32 * nb, sel = n0 >> 8, nn0 = n0 & 255;
        const int mb = F.wave >> 1, nh = F.wave & 1, fr = F.lane & 15, g = F.lane >> 4;
        __syncthreads();
        f32x4 wa[8][2];
        { const GAS f32x4* wp = (const GAS f32x4*)((const GAS float*)F.w_in() + (unsigned)(l * D * DIN + (k0 + 16 * mb + fr) * DIN + 2816 + 8 * g));
#pragma unroll
          for (int s_ = 0; s_ < 8; ++s_) { wa[s_][0] = wp[8 * s_]; wa[s_][1] = wp[8 * s_ + 1]; } }
        for (int i = F.tid; i < 256 * 32; i += NTHR) fws[i] = F.four_w()[(size_t)l * 65536 + (size_t)(i >> 5) * 256 + nn0 + (i & 31)];
        __syncthreads();
#pragma unroll
        for (int hh = 0; hh < 4; ++hh) { f32x4 mm = (f32x4){0.f, 0.f, 0.f, 0.f};
#pragma unroll
            for (int s_ = 0; s_ < 2; ++s_) { float t[8];
#pragma unroll
                for (int i = 0; i < 8; ++i) t[i] = fws[(hh * 64 + 32 * s_ + 8 * g + i) * 32 + 16 * nh + fr];
                unsigned h_[4], l_[4]; split2(t[0], t[1], h_[0], l_[0]); split2(t[2], t[3], h_[1], l_[1]); split2(t[4], t[5], h_[2], l_[2]); split2(t[6], t[7], h_[3], l_[3]);
                const bf16x8 BH = __builtin_bit_cast(bf16x8, (u32x4){h_[0], h_[1], h_[2], h_[3]}), BL = __builtin_bit_cast(bf16x8, (u32x4){l_[0], l_[1], l_[2], l_[3]});
                mm = mfma16(TH[s_], BH, mm); mm = mfma16(TH[s_], BL, mm); mm = mfma16(TL[s_], BH, mm); }
            *(LAS f32x4*)(m12T + (16 * nh + fr) * 260 + hh * 64 + 16 * mb + 4 * g) = mm; }
        __syncthreads();
        f32x4 o = (f32x4){0.f, 0.f, 0.f, 0.f};
#pragma unroll
        for (int s_ = 0; s_ < 8; ++s_) { const LAS float* bp = m12T + (16 * nh + fr) * 260 + 32 * s_ + 8 * g; const f32x4 b0 = *(const LAS f32x4*)bp, b1 = *(const LAS f32x4*)(bp + 4);
            unsigned ah[4], al[4], bh[4], bl[4];
            split2(wa[s_][0][0], wa[s_][0][1], ah[0], al[0]); split2(wa[s_][0][2], wa[s_][0][3], ah[1], al[1]); split2(wa[s_][1][0], wa[s_][1][1], ah[2], al[2]); split2(wa[s_][1][2], wa[s_][1][3], ah[3], al[3]);
            split2(b0[0], b0[1], bh[0], bl[0]); split2(b0[2], b0[3], bh[1], bl[1]); split2(b1[0], b1[1], bh[2], bl[2]); split2(b1[2], b1[3], bh[3], bl[3]);
            const bf16x8 AH = __builtin_bit_cast(bf16x8, (u32x4){ah[0], ah[1], ah[2], ah[3]}), AL = __builtin_bit_cast(bf16x8, (u32x4){al[0], al[1], al[2], al[3]});
            const bf16x8 BH = __builtin_bit_cast(bf16x8, (u32x4){bh[0], bh[1], bh[2], bh[3]}), BL = __builtin_bit_cast(bf16x8, (u32x4){bl[0], bl[1], bl[2], bl[3]});
            o = mfma16(AH, BH, o); o = mfma16(AH, BL, o); o = mfma16(AL, BH, o); }
        { float o0 = o[0], o1 = o[1], o2 = o[2], o3 = o[3]; asm volatile("s_nop 15\n\ts_nop 7" : "+v"(o0), "+v"(o1), "+v"(o2), "+v"(o3));
          u32x2 wv; wv.x = pk2(o0, o1); wv.y = pk2(o2, o3);
          *(u32x2*)(F.Wt_in() + (size_t)l * DINX * D + (size_t)(FQ_OFF + n0 + 16 * nh + fr) * D + k0 + 16 * mb + 4 * g) = wv; }
    }
    __syncthreads();
}

template <class SrcF> __device__ __forceinline__ void load_tile_T(LAS unsigned char* zt, const SrcF& src, int tid) {
    const int pg = tid >> 4, cc = tid & 15; u32x4 r[8];
#pragma unroll
    for (int i = 0; i < 8; ++i) r[i] = *(const GAS u32x4*)(src(8 * pg + i) + 8 * cc);
#pragma unroll
    for (int j = 0; j < 8; ++j) { const unsigned sel = (j & 1) ? 0x07060302u : 0x05040100u; u32x4 o;
        o.x = __builtin_amdgcn_perm(r[1][j >> 1], r[0][j >> 1], sel); o.y = __builtin_amdgcn_perm(r[3][j >> 1], r[2][j >> 1], sel);
        o.z = __builtin_amdgcn_perm(r[5][j >> 1], r[4][j >> 1], sel); o.w = __builtin_amdgcn_perm(r[7][j >> 1], r[6][j >> 1], sel);
        *(LAS u32x4*)(zt + (8 * cc + j) * ZS + 16 * pg) = o; }
}
__device__ __forceinline__ void tile_mma(const LAS unsigned char* zt, const bf16_t* mat_row  , f32x4 (&acc)[8], int lane) {
    const int fr = lane & 15, g = lane >> 4;
#pragma unroll
    for (int ks = 0; ks < 8; ++ks) { const bf16x8 b = *(const GAS bf16x8*)(mat_row + 32 * ks + 8 * g);
#pragma unroll
        for (int m = 0; m < 8; ++m) { const bf16x8 a = *(const LAS bf16x8*)(zt + (16 * m + fr) * ZS + (32 * ks + 8 * g) * 2); acc[m] = mfma16(a, b, acc[m]); }
        if (ks & 1) __builtin_amdgcn_sched_barrier(0); }
}
__device__ __forceinline__ void tile_mma2(const LAS unsigned char* zt, const bf16_t* mat_row0, const bf16_t* mat_row1, f32x4 (&acc0)[8], f32x4 (&acc1)[8], int lane) {
    const int fr = lane & 15, g = lane >> 4;
#pragma unroll
    for (int ks = 0; ks < 8; ++ks) { const bf16x8 b0 = *(const GAS bf16x8*)(mat_row0 + 32 * ks + 8 * g), b1 = *(const GAS bf16x8*)(mat_row1 + 32 * ks + 8 * g);
#pragma unroll
        for (int m = 0; m < 8; ++m) { const bf16x8 a = *(const LAS bf16x8*)(zt + (16 * m + fr) * ZS + (32 * ks + 8 * g) * 2); acc0[m] = mfma16(a, b0, acc0[m]); acc1[m] = mfma16(a, b1, acc1[m]); }
        __builtin_amdgcn_sched_barrier(0); }
}
struct SrcA { const bf16_t* P; int t2, hc; __device__ __forceinline__ const bf16_t* operator()(int p) const { const int ri = p >> 7, t1 = p & 127; return P + (size_t)(CTX + 128 * t1 + t2) * DINX + FQ_OFF + ri * 256 + 128 * hc; } };
struct SrcB { const bf16_t* Y; int k1, hc; __device__ __forceinline__ const bf16_t* operator()(int p) const { const int ri = p >> 7, t2 = p & 127; return Y + ((size_t)(k1 * 128 + t2) * 2 + ri) * 256 + 128 * hc; } };
struct SrcC { const bf16_t* P; int ri, hc; __device__ __forceinline__ const bf16_t* operator()(int p) const { return P + (size_t)p * DINX + FQ_OFF + ri * 256 + 128 * hc; } };

__device__ __forceinline__ void fftA_item(Frame& F, int item) {
    const int t2 = item >> 1, hc = item & 1; LAS unsigned char* zt = F.lds + RING_OFF;
    bf16_t* YP = (bf16_t*)(F.ws + WS_YP); const bf16_t* MA = (const bf16_t*)(F.ws + WS_WF + WF_MA);
    __syncthreads();
    load_tile_T(zt, SrcA{F.P(), t2, hc}, F.tid);
    __syncthreads();
    const int fr = F.lane & 15, g = F.lane >> 4, k1 = 16 * F.wave + fr;
    f32x4 ar[8], ai[8];
#pragma unroll
    for (int m = 0; m < 8; ++m) { ar[m] = (f32x4){0.f, 0.f, 0.f, 0.f}; ai[m] = (f32x4){0.f, 0.f, 0.f, 0.f}; }
    tile_mma2(zt, MA + (size_t)k1 * 256, MA + (size_t)(128 + k1) * 256, ar, ai, F.lane);
    const float x = 2.f * (float)(t2 * k1) / 16384.f; const float cs = cospif(x), sn = sinpif(x);
    bf16_t* yr = YP + ((size_t)(k1 * 128 + t2) * 2) * 256 + 128 * hc + 4 * g;
#pragma unroll
    for (int m = 0; m < 8; ++m) { const f32x4 a = ar[m], b = ai[m]; const f32x4 pr = a * cs + b * sn, pi = b * cs - a * sn;
        u32x2 w; w.x = pk2(pr[0], pr[1]); w.y = pk2(pr[2], pr[3]); *(u32x2*)(yr + 16 * m) = w;
        u32x2 v; v.x = pk2(pi[0], pi[1]); v.y = pk2(pi[2], pi[3]); *(u32x2*)(yr + 256 + 16 * m) = v; }
}
__device__ __forceinline__ void fftB_item(Frame& F, int item) {
    const int k1 = item >> 1, hc = item & 1; LAS unsigned char* zt = F.lds + RING_OFF;
    const bf16_t* YP = (const bf16_t*)(F.ws + WS_YP); const bf16_t* MB = (const bf16_t*)(F.ws + WS_WF + WF_MB);
    __syncthreads();
    load_tile_T(zt, SrcB{YP, k1, hc}, F.tid);
    __syncthreads();
    const int fr = F.lane & 15, g = F.lane >> 4, k2 = 16 * F.wave + fr;
    f32x4 acc[8];
#pragma unroll
    for (int m = 0; m < 8; ++m) acc[m] = (f32x4){0.f, 0.f, 0.f, 0.f};
    tile_mma(zt, MB + (size_t)k2 * 256, acc, F.lane);
    bf16_t* o = F.CAT() + (size_t)(CTX + k1 + 128 * k2) * D + 768 + 128 * hc + 4 * g;
#pragma unroll
    for (int m = 0; m < 8; ++m) { const f32x4 a = acc[m] * (1.f / 1024.f); u32x2 w; w.x = pk2(a[0], a[1]); w.y = pk2(a[2], a[3]); *(u32x2*)(o + 16 * m) = w; }
}
__device__ __forceinline__ void fftC_item(Frame& F, int item) {
    const int kh = item >> 1, hc = item & 1; LAS unsigned char* zt = F.lds + RING_OFF; const bf16_t* MC = (const bf16_t*)(F.ws + WS_WF + WF_MC);
    const int fr = F.lane & 15, g = F.lane >> 4, k = 128 * kh + 16 * F.wave + fr;
    f32x4 acc[8];
#pragma unroll
    for (int m = 0; m < 8; ++m) acc[m] = (f32x4){0.f, 0.f, 0.f, 0.f};
    for (int ri = 0; ri < 2; ++ri) {
        __syncthreads();
        load_tile_T(zt, SrcC{F.P(), ri, hc}, F.tid);
        __syncthreads();
        tile_mma(zt, MC + (size_t)k * 512 + ri * 256, acc, F.lane);
    }
    bf16_t* o = F.CAT() + (size_t)k * D + 768 + 128 * hc + 4 * g;
#pragma unroll
    for (int m = 0; m < 8; ++m) { const f32x4 a = acc[m] * (1.f / 128.f); u32x2 w; w.x = pk2(a[0], a[1]); w.y = pk2(a[2], a[3]); *(u32x2*)(o + 16 * m) = w; }
}

template <int GI> __device__ __forceinline__ void pool_sums(Frame& F, int j, LAS float* V, LAS unsigned* U, LAS unsigned char* At) {
    constexpr int win = 2 << GI, lo = win >> 1, hi = win - 1 - lo; const GAS bf16_t* Pc = (const GAS bf16_t*)F.P() + 2560 + GI * 64;
    if (j == 0) {
        for (int idx = F.tid; idx < 256 * 8; idx += NTHR) { const int t = idx >> 3, p8 = idx & 7; const int a = max(t - lo, 0), b = min(t + hi, CTX - 1); u32x4 w[win];
#pragma unroll
            for (int i = 0; i < win; ++i) { const int r = min(max(t - lo + i, 0), CTX - 1); w[i] = *(const GAS u32x4*)(Pc + (unsigned)(r * DINX + 8 * p8)); }
            f32x4 s0 = (f32x4){0.f, 0.f, 0.f, 0.f}, s1 = s0;
#pragma unroll
            for (int i = 0; i < win; ++i) { const int r = t - lo + i; const bool in = r >= 0 && r <= CTX - 1; const u32x4 x = w[i];
                const f32x4 e = (f32x4){bflo(x.x), bflo(x.y), bflo(x.z), bflo(x.w)}, o = (f32x4){bfhi(x.x), bfhi(x.y), bfhi(x.z), bfhi(x.w)}; if (in) { s0 += e; s1 += o; } }
            const u32x4 u = w[lo]; const float inv = 1.f / (float)(b - a + 1); u32x4 ov;
            ov.x = pk2(s0[0] * inv - bflo(u.x), s1[0] * inv - bfhi(u.x)); ov.y = pk2(s0[1] * inv - bflo(u.y), s1[1] * inv - bfhi(u.y));
            ov.z = pk2(s0[2] * inv - bflo(u.z), s1[2] * inv - bfhi(u.z)); ov.w = pk2(s0[3] * inv - bflo(u.w), s1[3] * inv - bfhi(u.w));
            *(LAS u32x4*)(At + t * 144 + 16 * p8) = ov; }
        return; }
    const int r0 = 4 * (j - 1); constexpr int NR = win + 3;
    { const int c = F.tid >> 3, p8 = F.tid & 7; u32x4 w[NR];
#pragma unroll
        for (int i = 0; i < NR; ++i) { const int r = min(max(r0 - lo + i, 0), LAT / GW - 1); w[i] = *(const GAS u32x4*)(Pc + (unsigned)((CTX + r * GW + c) * DINX + 8 * p8)); }
        f32x4 s0[4], s1[4];
#pragma unroll
        for (int q = 0; q < 4; ++q) { s0[q] = (f32x4){0.f, 0.f, 0.f, 0.f}; s1[q] = (f32x4){0.f, 0.f, 0.f, 0.f}; }
#pragma unroll
        for (int i = 0; i < NR; ++i) { const int r = r0 - lo + i; const bool ok = r >= 0 && r <= LAT / GW - 1; const u32x4 x = w[i];
            f32x4 e = (f32x4){bflo(x.x), bflo(x.y), bflo(x.z), bflo(x.w)}, o = (f32x4){bfhi(x.x), bfhi(x.y), bfhi(x.z), bfhi(x.w)}; if (!ok) { e = (f32x4){0.f, 0.f, 0.f, 0.f}; o = e; }
#pragma unroll
            for (int q = 0; q < 4; ++q) if (i >= q && i <= q + win - 1) { s0[q] += e; s1[q] += o; } }
#pragma unroll
        for (int q = 0; q < 4; ++q) { LAS float* vp = V + (q * 64 + c) * 64 + 8 * p8;
            *(LAS f32x4*)vp = (f32x4){s0[q][0], s1[q][0], s0[q][1], s1[q][1]}; *(LAS f32x4*)(vp + 4) = (f32x4){s0[q][2], s1[q][2], s0[q][3], s1[q][3]};
            *(LAS u32x4*)(U + (q * 64 + c) * 32 + 4 * p8) = w[lo + q]; } }
    __syncthreads();
    for (int idx = F.tid; idx < 4 * 8 * 64; idx += NTHR) { const int ch = idx & 63, cb = (idx >> 6) & 7, i = idx >> 9; const int r = r0 + i;
        const float cr = (float)(min(r + hi, LAT / GW - 1) - max(r - lo, 0) + 1); const LAS float* Vr = V + (i * 64) * 64 + ch;
        const int c0 = 8 * cb; float s = 0.f;
#pragma unroll
        for (int q = 0; q < win; ++q) { const int c = c0 - lo + q; s += (c >= 0 && c <= GW - 1) ? Vr[min(max(c, 0), GW - 1) * 64] : 0.f; }
#pragma unroll
        for (int q = 0; q < 8; ++q) { const int c = c0 + q; if (q > 0) { if (c + hi <= GW - 1) s += Vr[(c + hi) * 64]; if (c - 1 - lo >= 0) s -= Vr[(c - 1 - lo) * 64]; }
            const float cc = (float)(min(c + hi, GW - 1) - max(c - lo, 0) + 1); const unsigned uw = U[(i * 64 + c) * 32 + (ch >> 1)]; const float u = (ch & 1) ? bfhi(uw) : bflo(uw);
            *(LAS unsigned short*)(At + (i * 64 + c) * 144 + 2 * ch) = (unsigned short)f2bf(s / (cr * cc) - u); } }
}
__device__ __forceinline__ void pool_item(Frame& F, int l, int item) {
    const int j = item >> 2, gi = item & 3;
    LAS float* V = (LAS float*)(F.lds);
    LAS unsigned* U = (LAS unsigned*)(F.lds + 65536);
    LAS unsigned char* At = F.lds + 65536 + 32768;
    __syncthreads();
    if (gi == 0) pool_sums<0>(F, j, V, U, At); else if (gi == 1) pool_sums<1>(F, j, V, U, At); else if (gi == 2) pool_sums<2>(F, j, V, U, At); else pool_sums<3>(F, j, V, U, At);
    __syncthreads();
    const bf16_t* PW = (const bf16_t*)(F.ws + WS_WF + WF_PW) + (size_t)(l * 4 + gi) * 4096; const int fr = F.lane & 15, g = F.lane >> 4;
    f32x4 acc[4][2];
#pragma unroll
    for (int n = 0; n < 4; ++n) { acc[n][0] = (f32x4){0.f, 0.f, 0.f, 0.f}; acc[n][1] = (f32x4){0.f, 0.f, 0.f, 0.f}; }
#pragma unroll
    for (int ks = 0; ks < 2; ++ks) { bf16x8 b[2];
#pragma unroll
        for (int mt = 0; mt < 2; ++mt) b[mt] = *(const LAS bf16x8*)(At + (32 * F.wave + 16 * mt + fr) * 144 + (32 * ks + 8 * g) * 2);
#pragma unroll
        for (int n = 0; n < 4; ++n) { const bf16x8 a = *(const GAS bf16x8*)(PW + (16 * n + fr) * 64 + 32 * ks + 8 * g);
#pragma unroll
            for (int mt = 0; mt < 2; ++mt) acc[n][mt] = mfma16(a, b[mt], acc[n][mt]); } }
    const int rowbase = j == 0 ? 0 : CTX + 256 * (j - 1);
#pragma unroll
    for (int n = 0; n < 4; ++n) { const f32x4 sc = *(const GAS f32x4*)(F.pool_s() + l * 256 + gi * 64 + 16 * n + 4 * g);
#pragma unroll
        for (int mt = 0; mt < 2; ++mt) { const f32x4 a = acc[n][mt] * sc; u32x2 w; w.x = pk2(a[0], a[1]); w.y = pk2(a[2], a[3]);
            *(u32x2*)(F.CAT() + (size_t)(rowbase + 32 * F.wave + 16 * mt + fr) * D + 512 + gi * 64 + 16 * n + 4 * g) = w; } }
}

constexpr int SC_FT = 0, SC_QT = 18432, SC_VT = 36864, SC_BQ = 55296, SC_BF = 72704, SC_KT = 90112, SC_PM = 108544, SC_G = 117760, SC_TOT = 135168, SC_DEC = 137216, SC_SSQ = 138752, SC_END = 140800;
static_assert(SC_END <= MISC_OFF, "scan LDS map");
template <int DIR, bool FULL> __device__ __forceinline__ void scan_fetch(const Frame& F, int h, int row0, u32x4 (&r)[8]) {
    const GAS bf16_t* P = (const GAS bf16_t*)F.P(); const int tid = F.tid;
    if (tid < 384) { const int tile = tid >> 7, blk = tid & 127, tg = blk >> 4, kc = blk & 15; if (!FULL && tile == 1) return;
        const int colb = tile == 0 ? 512 * (1 + DIR) : (tile == 1 ? 0 : 1536); const GAS bf16_t* src = P + (unsigned)((row0 + 8 * tg) * DINX + colb + h * 128 + 8 * kc);
#pragma unroll
        for (int i = 0; i < 8; ++i) r[i] = *(const GAS u32x4*)(src + (unsigned)(i * DINX)); }
    else if (FULL && DIR == 1) { const int q = tid - 384; const GAS bf16_t* src = P + (unsigned)((row0 + (q >> 4)) * DINX + 2048 + h * 128 + 8 * (q & 15));
#pragma unroll
        for (int i = 0; i < 8; ++i) r[i] = *(const GAS u32x4*)(src + (unsigned)(i * 8 * DINX)); }
}
template <int DIR, bool FULL> __device__ __forceinline__ void scan_commit(const Frame& F, const u32x4 (&r)[8]) {
    LAS unsigned char* L = F.lds + RING_OFF; const int tid = F.tid;
    if (tid < 384) { const int tile = tid >> 7, blk = tid & 127, tg = blk >> 4, kc = blk & 15; if (!FULL && tile == 1) return;
#pragma unroll
        for (int j = 0; j < 8; ++j) { const unsigned sel = (j & 1) ? 0x07060302u : 0x05040100u; u32x4 o;
            o.x = __builtin_amdgcn_perm(r[1][j >> 1], r[0][j >> 1], sel); o.y = __builtin_amdgcn_perm(r[3][j >> 1], r[2][j >> 1], sel);
            o.z = __builtin_amdgcn_perm(r[5][j >> 1], r[4][j >> 1], sel); o.w = __builtin_amdgcn_perm(r[7][j >> 1], r[6][j >> 1], sel);
            *(LAS u32x4*)(L + tile * 18432 + (8 * kc + j) * 144 + 16 * tg) = o; } }
    else if (FULL && DIR == 1) { const int q = tid - 384; LAS unsigned char* dst = L + SC_G + (q >> 4) * 272 + 16 * (q & 15);
#pragma unroll
        for (int i = 0; i < 8; ++i) *(LAS u32x4*)(dst + i * 8 * 272) = r[i]; }
}
template <int DIR, bool FULL> __device__ __forceinline__ void scan_chunk(Frame& F, int l, int h, int nrow0, u32x4 (&pre)[8], f32x4 (&S)[8], f32x4 (&o)[4], float& segsum, const GAS float* oload = nullptr, GAS float* ostore = nullptr) {
    LAS unsigned char* L = F.lds + RING_OFF; int lane = F.lane; asm volatile("" : "+v"(lane));
    const int w = F.wave, tid = w * 64 + lane, fr = lane & 15, g = lane >> 4;
    LAS float* TOT = (LAS float*)(L + SC_TOT); LAS float* DEC = (LAS float*)(L + SC_DEC); LAS float* C1 = DEC + 128; LAS float* C2 = DEC + 256;
    __syncthreads();
    scan_commit<DIR, FULL>(F, pre);
    __syncthreads();
    const int k = tid & 127, qu = tid >> 7;
    float bl[16]; float run = 0.f;
    { const u32x4 fa = *(const LAS u32x4*)(L + SC_FT + k * 144 + 32 * qu), fb = *(const LAS u32x4*)(L + SC_FT + k * 144 + 32 * qu + 16); const unsigned fw[8] = {fa.x, fa.y, fa.z, fa.w, fb.x, fb.y, fb.z, fb.w};
#pragma unroll
      for (int i = 0; i < 16; ++i) { const int ti = (DIR == 0 ? i : 15 - i); run += (ti & 1) ? f16hi(fw[ti >> 1]) : f16lo(fw[ti >> 1]); bl[i] = run; } }
    TOT[qu * 128 + k] = run;
    __syncthreads();
    const float t0 = TOT[k], t1 = TOT[128 + k], t2 = TOT[256 + k], t3 = TOT[384 + k]; const float total = (t0 + t1) + (t2 + t3);
    float off, ref;
    if (DIR == 0) { off = qu == 0 ? 0.f : (qu == 1 ? t0 : (qu == 2 ? t0 + t1 : t0 + t1 + t2)); ref = t0 + t1; }
    else { off = qu == 3 ? 0.f : (qu == 2 ? t3 : (qu == 1 ? t3 + t2 : t3 + t2 + t1)); ref = t3 + t2; }
    if (qu == 0) { DEC[k] = __builtin_amdgcn_exp2f(total); C1[k] = __builtin_amdgcn_exp2f(ref); C2[k] = __builtin_amdgcn_exp2f(total - ref); segsum += total; }
    { unsigned qw[8];
      if (FULL) { const u32x4 qa = *(const LAS u32x4*)(L + SC_QT + k * 144 + 32 * qu), qb = *(const LAS u32x4*)(L + SC_QT + k * 144 + 32 * qu + 16); qw[0] = qa.x; qw[1] = qa.y; qw[2] = qa.z; qw[3] = qa.w; qw[4] = qb.x; qw[5] = qb.y; qw[6] = qb.z; qw[7] = qb.w; }
      float ktv[16]; const float sh = off - ref;
#pragma unroll
      for (int i = 0; i < 16; ++i) { const int ti = (DIR == 0 ? i : 15 - i), t = 16 * qu + ti; const float lf = i == 0 ? bl[0] : bl[i] - bl[i - 1]; const float b = bl[i] + sh;
          const float E = __builtin_amdgcn_exp2f(b), Ei = __builtin_amdgcn_rcpf(E), kk = 1.f - __builtin_amdgcn_exp2f(lf); ktv[ti] = kk * Ei;
          if (FULL) { const float qs = (ti & 1) ? bfhi(qw[ti >> 1]) : bflo(qw[ti >> 1]); *(LAS unsigned short*)(L + SC_BQ + t * 272 + 2 * k) = (unsigned short)(cvt_pk_bf16(qs * E, 0.f)); } }
      u32x4 a, b2; a.x = cvt_pk_bf16(ktv[0], ktv[1]); a.y = cvt_pk_bf16(ktv[2], ktv[3]); a.z = cvt_pk_bf16(ktv[4], ktv[5]); a.w = cvt_pk_bf16(ktv[6], ktv[7]);
      b2.x = cvt_pk_bf16(ktv[8], ktv[9]); b2.y = cvt_pk_bf16(ktv[10], ktv[11]); b2.z = cvt_pk_bf16(ktv[12], ktv[13]); b2.w = cvt_pk_bf16(ktv[14], ktv[15]);
      *(LAS u32x4*)(L + SC_KT + k * 144 + 32 * qu) = a; *(LAS u32x4*)(L + SC_KT + k * 144 + 32 * qu + 16) = b2;
      if (FULL) { const unsigned kw[8] = {a.x, a.y, a.z, a.w, b2.x, b2.y, b2.z, b2.w};
#pragma unroll
          for (int ti = 0; ti < 16; ++ti) *(LAS unsigned short*)(L + SC_BF + (16 * qu + ti) * 272 + 2 * k) = (unsigned short)((ti & 1) ? (kw[ti >> 1] >> 16) : (kw[ti >> 1] & 0xffffu)); } }
    __syncthreads();
    if (nrow0 >= 0) scan_fetch<DIR, FULL>(F, h, nrow0, pre);
    if (FULL) {
#pragma unroll
        for (int tb = 0; tb < 4; ++tb)
#pragma unroll
            for (int r = 0; r < 4; ++r) o[tb][r] = oload ? oload[(tb * 4 + r) * 512] : 0.f; }
    __builtin_amdgcn_sched_barrier(0);
    if (FULL) {
        const int tb = w >> 1;
#pragma unroll
        for (int q = 0; q < 2; ++q) { const int sb = 2 * (w & 1) + q; f32x4 acc = (f32x4){0.f, 0.f, 0.f, 0.f};
#pragma unroll
            for (int ks = 0; ks < 4; ++ks) { const bf16x8 a = *(const LAS bf16x8*)(L + SC_BF + (16 * sb + fr) * 272 + (32 * ks + 8 * g) * 2); const bf16x8 b = *(const LAS bf16x8*)(L + SC_BQ + (16 * tb + fr) * 272 + (32 * ks + 8 * g) * 2);
                acc = mfma16(a, b, acc); }
            const int t = 16 * tb + fr; float m[4];
#pragma unroll
            for (int r = 0; r < 4; ++r) { const int s = 16 * sb + 4 * g + r; const bool keep = DIR == 0 ? (s <= t) : (s >= t); m[r] = keep ? acc[r] : 0.f; }
            u32x2 wv; wv.x = pk2(m[0], m[1]); wv.y = pk2(m[2], m[3]); *(LAS u32x2*)(L + SC_PM + t * 144 + (16 * sb + 4 * g) * 2) = wv; }
        __syncthreads();
    }
    bf16x8 vt[2];
#pragma unroll
    for (int ks = 0; ks < 2; ++ks) vt[ks] = *(const LAS bf16x8*)(L + SC_VT + (16 * w + fr) * 144 + (32 * ks + 8 * g) * 2);
    if (FULL) {
        bf16x8 sf[4];
#pragma unroll
        for (int ks = 0; ks < 4; ++ks) { const f32x4 ca = *(const LAS f32x4*)(C1 + 32 * ks + 4 * g), cb = *(const LAS f32x4*)(C1 + 32 * ks + 16 + 4 * g); const f32x4 x = S[2 * ks] * ca, y = S[2 * ks + 1] * cb;
            u32x4 pkd; pkd.x = pk2(x[0], x[1]); pkd.y = pk2(x[2], x[3]); pkd.z = pk2(y[0], y[1]); pkd.w = pk2(y[2], y[3]); sf[ks] = __builtin_bit_cast(bf16x8, pkd); }
#pragma unroll
        for (int tb = 0; tb < 4; ++tb) { f32x4 acc = o[tb];
#pragma unroll
            for (int ks = 0; ks < 4; ++ks) { const u32x2 a0 = *(const LAS u32x2*)(L + SC_BQ + (16 * tb + fr) * 272 + (32 * ks + 4 * g) * 2), a1 = *(const LAS u32x2*)(L + SC_BQ + (16 * tb + fr) * 272 + (32 * ks + 16 + 4 * g) * 2);
                u32x4 pa; pa.x = a0.x; pa.y = a0.y; pa.z = a1.x; pa.w = a1.y; acc = mfma16(__builtin_bit_cast(bf16x8, pa), sf[ks], acc); }
#pragma unroll
            for (int ks = 0; ks < 2; ++ks) { const bf16x8 a = *(const LAS bf16x8*)(L + SC_PM + (16 * tb + fr) * 144 + (32 * ks + 8 * g) * 2); acc = mfma16(a, vt[ks], acc); }
            o[tb] = acc; __builtin_amdgcn_sched_barrier(0); }
        if (ostore) {
#pragma unroll
            for (int tb = 0; tb < 4; ++tb)
#pragma unroll
                for (int r = 0; r < 4; ++r) ostore[(tb * 4 + r) * 512] = o[tb][r]; }
    }
#pragma unroll
    for (int kb = 0; kb < 8; ++kb) { f32x4 tmp = (f32x4){0.f, 0.f, 0.f, 0.f};
#pragma unroll
        for (int ks = 0; ks < 2; ++ks) { const bf16x8 a = *(const LAS bf16x8*)(L + SC_KT + (16 * kb + fr) * 144 + (32 * ks + 8 * g) * 2); tmp = mfma16(a, vt[ks], tmp); }
        const f32x4 dc = *(const LAS f32x4*)(DEC + 16 * kb + 4 * g), c2 = *(const LAS f32x4*)(C2 + 16 * kb + 4 * g); S[kb] = dc * S[kb] + c2 * tmp; if (kb & 1) __builtin_amdgcn_sched_barrier(0); }
}
__device__ __forceinline__ void state_store(float* dst, const f32x4 (&S)[8], int w, int lane) {
    GAS float* p = (GAS float*)dst + (unsigned)(w * 2048 + lane);
#pragma unroll
    for (int kb = 0; kb < 8; ++kb)
#pragma unroll
        for (int r = 0; r < 4; ++r) p[(kb * 4 + r) * 64] = S[kb][r]; }
__device__ __forceinline__ void state_load(const float* src, f32x4 (&S)[8], int w, int lane) {
    const GAS float* p = (const GAS float*)src + (unsigned)(w * 2048 + lane);
#pragma unroll
    for (int kb = 0; kb < 8; ++kb)
#pragma unroll
        for (int r = 0; r < 4; ++r) S[kb][r] = p[(kb * 4 + r) * 64]; }
__device__ __forceinline__ float* sc_SU(Frame& F) { return (float*)(F.ws + WS_SU); }
__device__ __forceinline__ float* sc_SS(Frame& F) { return (float*)(F.ws + WS_SS); }
__device__ __forceinline__ float* sc_SD(Frame& F) { return (float*)(F.ws + WS_SD); }
__device__ __forceinline__ float* sc_CARRY(Frame& F) { return (float*)(F.ws + WS_SD) + 8 * 64 * 128; }

__device__ __forceinline__ float* sc_OSCR(Frame& F) { return (float*)(F.ws + WS_OSCR) + (size_t)F.bid * 32768; }
template <int DIR> __device__ __forceinline__ void scan_states(Frame& F, int l, int h, int segrow, float* sout, float* dout) {
    f32x4 S[8], odummy[4]; float segsum = 0.f; u32x4 pre[8];
#pragma unroll
    for (int kb = 0; kb < 8; ++kb) S[kb] = (f32x4){0.f, 0.f, 0.f, 0.f};
    scan_fetch<DIR, false>(F, h, segrow + (DIR == 0 ? 0 : 192), pre);
#pragma unroll 1
    for (int i_ = 0; i_ < 4; ++i_) { int i = i_; asm volatile("" : "+s"(i)); const int c = DIR == 0 ? i : 3 - i;
        scan_chunk<DIR, false>(F, l, h, i < 3 ? segrow + 64 * (DIR == 0 ? c + 1 : c - 1) : -1, pre, S, odummy, segsum); }
    state_store(sout, S, F.wave, F.lane);
    if (dout && F.tid < 128) dout[F.tid] = __builtin_amdgcn_exp2f(segsum);
}
__device__ __forceinline__ void scanA_item(Frame& F, int l, int item) {
    const int h = item >> 6, seg = item & 63, segrow = CTX + 256 * seg;
    scan_states<0>(F, l, h, segrow, sc_SU(F) + ((size_t)(h * 2 + 0) * 64 + seg) * 16384, sc_SD(F) + ((h * 2 + 0) * 64 + seg) * 128);
    scan_states<1>(F, l, h, segrow, sc_SU(F) + ((size_t)(h * 2 + 1) * 64 + seg) * 16384, sc_SD(F) + ((h * 2 + 1) * 64 + seg) * 128);
}
__device__ __forceinline__ void scan_full(Frame& F, int l, int h, int segrow, const float* sinf, const float* sinb, float* outf, float* outb) {
    f32x4 S[8], o[4]; float segsum = 0.f; const int w = F.wave, lane = F.lane, fr = lane & 15, g = lane >> 4; u32x4 pre[8];
    GAS float* oscr = (GAS float*)sc_OSCR(F) + (unsigned)F.tid;
    if (sinf) state_load(sinf, S, w, lane); else {
#pragma unroll
        for (int kb = 0; kb < 8; ++kb) S[kb] = (f32x4){0.f, 0.f, 0.f, 0.f}; }
    scan_fetch<0, true>(F, h, segrow, pre);
#pragma unroll 1
    for (int c_ = 0; c_ < 4; ++c_) { int c = c_; asm volatile("" : "+s"(c));
        scan_chunk<0, true>(F, l, h, c < 3 ? segrow + 64 * (c + 1) : -1, pre, S, o, segsum);
#pragma unroll
        for (int tb = 0; tb < 4; ++tb)
#pragma unroll
            for (int r = 0; r < 4; ++r) (oscr + c * 8192)[(tb * 4 + r) * 512] = o[tb][r];
    }
    if (outf) state_store(outf, S, w, lane);
    VM_WAIT();
    if (sinb) state_load(sinb, S, w, lane); else {
#pragma unroll
        for (int kb = 0; kb < 8; ++kb) S[kb] = (f32x4){0.f, 0.f, 0.f, 0.f}; }
    LAS unsigned char* L = F.lds + RING_OFF; LAS float* SSQ = (LAS float*)(L + SC_SSQ);
    const float ngv = F.hng()[l * 512 + h * 128 + 16 * w + fr];
    scan_fetch<1, true>(F, h, segrow + 192, pre);
#pragma unroll 1
    for (int c_ = 3; c_ >= 0; --c_) { int c = c_; asm volatile("" : "+s"(c));
        scan_chunk<1, true>(F, l, h, c > 0 ? segrow + 64 * (c - 1) : -1, pre, S, o, segsum, oscr + c * 8192);
#pragma unroll
        for (int tb = 0; tb < 4; ++tb) { f32x4 q = o[tb] * o[tb];
#pragma unroll
            for (int m = 1; m < 16; m <<= 1) { q[0] += lane_xor(q[0], m, lane); q[1] += lane_xor(q[1], m, lane); q[2] += lane_xor(q[2], m, lane); q[3] += lane_xor(q[3], m, lane); }
            if (fr == 0) {
#pragma unroll
                for (int r = 0; r < 4; ++r) SSQ[(16 * tb + 4 * g + r) * 8 + w] = q[r]; } }
        __syncthreads();
#pragma unroll
        for (int tb = 0; tb < 4; ++tb)
#pragma unroll
            for (int r = 0; r < 4; ++r) { const int t = 16 * tb + 4 * g + r; const f32x4 p0 = *(const LAS f32x4*)(SSQ + t * 8), p1 = *(const LAS f32x4*)(SSQ + t * 8 + 4);
                const float ss = ((p0[0] + p0[1]) + (p0[2] + p0[3])) + ((p1[0] + p1[1]) + (p1[2] + p1[3])); const float rs = rsqrtf(ss * (1.f / 128.f) + 1e-6f);
                const float gp = bf2f(*(const LAS unsigned short*)(L + SC_G + t * 272 + 2 * (16 * w + fr)));
                *(LAS unsigned short*)(L + SC_BQ + t * 272 + 2 * (16 * w + fr)) = (unsigned short)f2bf(o[tb][r] * rs * ngv * gp); }
        __syncthreads();
#pragma unroll
        for (int i = 0; i < 2; ++i) { const int id = F.tid + 512 * i, row = id >> 4, cc = id & 15; const u32x4 d = *(const LAS u32x4*)(L + SC_BQ + row * 272 + 16 * cc);
            *(GAS u32x4*)((GAS bf16_t*)F.CAT() + (unsigned)((segrow + 64 * c + row) * D + h * 128 + 8 * cc)) = d; }
    }
    if (outb) state_store(outb, S, w, lane);
}
__device__ __forceinline__ GAS float* sc_CTXO(const Frame& F, int hd, int c) { return (GAS float*)(F.ws + WS_CTXO) + (unsigned)((hd * 4 + c) * 8192); }
template <int DIR> __device__ __forceinline__ void scan_dir_local(Frame& F, int l, int h, int segrow, float* sout) {
    f32x4 S[8], o[4]; float segsum = 0.f; u32x4 pre[8]; const int hd = h * 2 + DIR;
#pragma unroll
    for (int kb = 0; kb < 8; ++kb) S[kb] = (f32x4){0.f, 0.f, 0.f, 0.f};
    scan_fetch<DIR, true>(F, h, segrow + (DIR == 0 ? 0 : 192), pre);
#pragma unroll 1
    for (int i_ = 0; i_ < 4; ++i_) { int i = i_; asm volatile("" : "+s"(i)); const int c = DIR == 0 ? i : 3 - i;
        scan_chunk<DIR, true>(F, l, h, i < 3 ? segrow + 64 * (DIR == 0 ? c + 1 : c - 1) : -1, pre, S, o, segsum, nullptr, sc_CTXO(F, hd, c) + (unsigned)F.tid); }
    state_store(sout, S, F.wave, F.lane);
}
__device__ __forceinline__ void ctx_finalize(Frame& F, int l, int h, int c0) {
    LAS unsigned char* L = F.lds + RING_OFF; LAS float* SSQ = (LAS float*)(L + SC_SSQ);
    const float ngv = F.hng()[l * 512 + h * 128 + 16 * F.wave + (F.lane & 15)];
#pragma unroll 1
    for (int c_ = c0; c_ < c0 + 2; ++c_) { int c = __builtin_amdgcn_readfirstlane(c_); asm volatile("" : "+s"(c)); int lane = F.lane; asm volatile("" : "+v"(lane));
        const int w = F.wave, tid = w * 64 + lane, fr = lane & 15, g = lane >> 4, row0 = 64 * c;
        __syncthreads();
        { const GAS bf16_t* gp = (const GAS bf16_t*)F.P() + (unsigned)((row0 + (tid >> 4)) * DINX + 2048 + h * 128 + 8 * (tid & 15)); const int o = (tid >> 4) * 272 + 16 * (tid & 15);
          *(LAS u32x4*)(L + SC_G + o) = *(const GAS u32x4*)gp; *(LAS u32x4*)(L + SC_G + o + 32 * 272) = *(const GAS u32x4*)(gp + (unsigned)(32 * DINX)); }
        f32x4 o[4];
        { const GAS float* of = sc_CTXO(F, h * 2 + 0, c) + (unsigned)tid; const GAS float* ob = sc_CTXO(F, h * 2 + 1, c) + (unsigned)tid;
#pragma unroll
          for (int tb = 0; tb < 4; ++tb)
#pragma unroll
              for (int r = 0; r < 4; ++r) o[tb][r] = of[(tb * 4 + r) * 512] + ob[(tb * 4 + r) * 512]; }
#pragma unroll
        for (int tb = 0; tb < 4; ++tb) { f32x4 q = o[tb] * o[tb];
#pragma unroll
            for (int m = 1; m < 16; m <<= 1) { q[0] += lane_xor(q[0], m, lane); q[1] += lane_xor(q[1], m, lane); q[2] += lane_xor(q[2], m, lane); q[3] += lane_xor(q[3], m, lane); }
            if (fr == 0) {
#pragma unroll
                for (int r = 0; r < 4; ++r) SSQ[(16 * tb + 4 * g + r) * 8 + w] = q[r]; } }
        __syncthreads();
#pragma unroll
        for (int tb = 0; tb < 4; ++tb)
#pragma unroll
            for (int r = 0; r < 4; ++r) { const int t = 16 * tb + 4 * g + r; const f32x4 p0 = *(const LAS f32x4*)(SSQ + t * 8), p1 = *(const LAS f32x4*)(SSQ + t * 8 + 4);
                const float ss = ((p0[0] + p0[1]) + (p0[2] + p0[3])) + ((p1[0] + p1[1]) + (p1[2] + p1[3])); const float rs = rsqrtf(ss * (1.f / 128.f) + 1e-6f);
                const float gp = bf2f(*(const LAS unsigned short*)(L + SC_G + t * 272 + 2 * (16 * w + fr)));
                *(LAS unsigned short*)(L + SC_BQ + t * 272 + 2 * (16 * w + fr)) = (unsigned short)f2bf(o[tb][r] * rs * ngv * gp); }
        __syncthreads();
#pragma unroll
        for (int i = 0; i < 2; ++i) { const int id = tid + 512 * i, row = id >> 4, cc = id & 15; const u32x4 d = *(const LAS u32x4*)(L + SC_BQ + row * 272 + 16 * cc);
            *(GAS u32x4*)((GAS bf16_t*)F.CAT() + (unsigned)((row0 + row) * D + h * 128 + 8 * cc)) = d; }
    }
    __syncthreads();
}
__device__ __forceinline__ void scanB(Frame& F) {
    const int e = F.bid * NTHR + F.tid; if (e >= 8 * 16384) return;
    const int hd = e >> 14, idx = e & 16383, d = hd & 1; const int ln = idx & 63, reg = (idx >> 6) & 3, kb = (idx >> 8) & 7; const int k = 16 * kb + 4 * (ln >> 4) + reg;
    const float* SU = sc_SU(F) + (size_t)hd * 64 * 16384 + idx; const float* SD = sc_SD(F) + hd * 64 * 128 + k; float* SS = sc_SS(F) + (size_t)hd * 64 * 16384 + idx;
    float S = sc_CARRY(F)[hd * 16384 + idx];
    if (d == 0) { for (int seg = 0; seg < 64; ++seg) { SS[(size_t)seg * 16384] = S; S = SD[seg * 128] * S + SU[(size_t)seg * 16384]; } }
    else { for (int seg = 63; seg >= 0; --seg) { SS[(size_t)seg * 16384] = S; S = SD[seg * 128] * S + SU[(size_t)seg * 16384]; } }
}

__device__ __forceinline__ void ph_mixA(Frame& F, int l) {
    scanA_item(F, l, F.bid);
    if (F.bid >= 4 && F.bid < 12) { const int hd = F.bid - 4, h = hd >> 1;
        if (l == 0) { if (hd & 1) scan_dir_local<1>(F, l, h, 0, sc_CARRY(F) + hd * 16384); else scan_dir_local<0>(F, l, h, 0, sc_CARRY(F) + hd * 16384); }
        else { if (hd & 1) scan_states<1>(F, l, h, 0, sc_CARRY(F) + hd * 16384, nullptr); else scan_states<0>(F, l, h, 0, sc_CARRY(F) + hd * 16384, nullptr); }
        return; }
    fftA_item(F, F.bid);
    if (F.bid >= 12 && F.bid < 20) fftA_item(F, F.bid - 8);
    if (l == 0) { pool_item(F, l, F.bid); if (F.bid >= 20 && F.bid < 28) pool_item(F, l, F.bid - 16); else if (F.bid >= 28 && F.bid < 32) pool_item(F, l, F.bid + 228); }
    else { pool_item(F, l, F.bid + 4); if (F.bid >= 20 && F.bid < 28) pool_item(F, l, F.bid - 12); }
}
__device__ __forceinline__ void ph_mixB(Frame& F, int l) {
    scanB(F);
    if (l == 0) {
        if (F.bid >= 240 && F.bid < 248) { ctx_finalize(F, l, (F.bid - 240) >> 1, 2 * ((F.bid - 240) & 1)); return; }
        if (F.bid >= 252) { fftC_item(F, F.bid - 252); return; }
        fftB_item(F, F.bid);
        if (F.bid >= 220 && F.bid < 228) fftB_item(F, F.bid + 20); else if (F.bid >= 228 && F.bid < 232) fftB_item(F, F.bid + 24);
    } else fftB_item(F, F.bid);
}
__device__ __forceinline__ void ph_mixC(Frame& F, int l) {
    const int item = F.bid, h = item >> 6, seg = item & 63;
    scan_full(F, l, h, CTX + 256 * seg, sc_SS(F) + ((size_t)(h * 2 + 0) * 64 + seg) * 16384, sc_SS(F) + ((size_t)(h * 2 + 1) * 64 + seg) * 16384, nullptr, nullptr);
}
#define GRID_BAR() do { Frame R_ = relaunder(F); xcd_barrier(bar, R_.tid); } while (0)
#define PHASE(call) do { Frame R = relaunder(F); call; } while (0)
__global__ void __launch_bounds__(NTHR, 2) mega_fwd(Params p) {
    extern __shared__ __attribute__((aligned(16))) unsigned char lds[];
    Frame F; frame_init(F, p, lds);
    if (F.tid < 16) ((LAS unsigned*)(F.lds + MISC_OFF))[F.tid] = 0u;
    __syncthreads();
    XcdBarrier bar = xcd_barrier_post((unsigned*)(F.ctl() + CW_BAR), (volatile LAS unsigned*)(F.lds + MISC_OFF + 32));
    PHASE(ph_prologue(R)); PHASE(ph_prologue2(R));
    GRID_BAR();
    PHASE(ph_mod1(R, 0));
    GRID_BAR();
#pragma unroll 1
    for (int l = 0; l < 2; ++l) {
        PHASE(ph_win(R, l));            GRID_BAR();
        PHASE(ph_mixA(R, l));           GRID_BAR();
        PHASE(ph_mixB(R, l));           GRID_BAR();
        PHASE(ph_mixC(R, l));           GRID_BAR();
        PHASE(ph_wout(R, l));           GRID_BAR();
        PHASE(ph_mod2_route(R, l, l));  GRID_BAR();
        PHASE(ph_gateup(R, l));         GRID_BAR();
        PHASE(ph_down(R, l));           GRID_BAR();
        PHASE(ph_combine(R, l));
        if (l == 0) GRID_BAR();
    }
}
extern "C" void kernel_launch(void* const* d_in, const int* in_sizes, int n_in, void* d_out, int out_size, void* d_ws, size_t ws_size, hipStream_t stream) {
    static int ok = 0;
    if (ok == 0) {
        if (n_in != 22 || out_size != LAT * D || ws_size < WS_FASTEND) { fprintf(stderr, "kernel_launch: unexpected shapes / workspace (n_in %d, out %d, ws %zu < %zu); nothing launched\n", n_in, out_size, ws_size, (size_t)WS_FASTEND); ok = -1; return; }
        int dev = 0, cus = 0, per_cu = 0;
        if (hipGetDevice(&dev) != hipSuccess || hipDeviceGetAttribute(&cus, hipDeviceAttributeMultiprocessorCount, dev) != hipSuccess) { ok = -1; return; }
        if (hipFuncSetAttribute((const void*)mega_fwd, hipFuncAttributeMaxDynamicSharedMemorySize, LDS_BYTES) != hipSuccess) { fprintf(stderr, "kernel_launch: hipFuncSetAttribute failed\n"); ok = -1; return; }
        if (hipOccupancyMaxActiveBlocksPerMultiprocessor(&per_cu, (const void*)mega_fwd, NTHR, LDS_BYTES) != hipSuccess || per_cu < 1) fprintf(stderr, "kernel_launch: note: occupancy query reports %d workgroups per CU\n", per_cu);
        (void)hipGetLastError();
        if (cus < 256) fprintf(stderr, "kernel_launch: device has %d CUs; this kernel needs 256 co-resident workgroups (one per CU)\n", cus);
        ok = 1;
    }
    if (ok < 0) return;
    if (hipMemsetAsync((char*)d_ws + WS_CTL, 0, CTL_ZERO_BYTES, stream) != hipSuccess) return;
    Params p{}; for (int i = 0; i < 22; ++i) p.in[i] = (const float*)d_in[i]; p.out = (float*)d_out; p.ws = (unsigned char*)d_ws;
    hipLaunchKernelGGL(mega_fwd, dim3(256), dim3(NTHR), LDS_BYTES, stream, p);
}
```

```cpp
#include <hip/hip_runtime.h>
#include <cstdio>
#include <cstdint>
constexpr int D = 1024, LAT = 16384, CTX = 256, T = LAT + CTX, DIN = 3072, NE = 32, TOPK = 4;
constexpr int GW = 64;
#ifndef PSTR
#define PSTR DIN
#endif
constexpr int DINX = 3328, FQ_OFF = 2816;
#define GAS __attribute__((address_space(1)))
#define LAS __attribute__((address_space(3)))
typedef unsigned short bf16_t;
typedef short bf16x8 __attribute__((ext_vector_type(8)));
typedef short bf16x4 __attribute__((ext_vector_type(4)));
typedef float f32x4 __attribute__((ext_vector_type(4)));
typedef float f32x2 __attribute__((ext_vector_type(2)));
typedef unsigned u32x4 __attribute__((ext_vector_type(4)));
typedef unsigned u32x2 __attribute__((ext_vector_type(2)));
typedef GAS unsigned gu32;
#define RLX_AGENT __ATOMIC_RELAXED, __HIP_MEMORY_SCOPE_AGENT
#define LDS_WAIT() asm volatile("s_waitcnt lgkmcnt(0)" ::: "memory")
#define VM_WAIT() asm volatile("s_waitcnt vmcnt(0)" ::: "memory")
__device__ __forceinline__ unsigned cvt_pk_bf16(float lo, float hi) { unsigned r; asm("v_cvt_pk_bf16_f32 %0, %1, %2" : "=v"(r) : "v"(lo), "v"(hi)); return r; }
__device__ __forceinline__ unsigned f2bf(float f) { return cvt_pk_bf16(f, 0.f) & 0xffffu; }
__device__ __forceinline__ unsigned pk2(float lo, float hi) { return cvt_pk_bf16(lo, hi); }
__device__ __forceinline__ float bf2f(unsigned short b) { return __builtin_bit_cast(float, ((unsigned)b) << 16); }
__device__ __forceinline__ float bflo(unsigned w) { return __builtin_bit_cast(float, w << 16); }
__device__ __forceinline__ float bfhi(unsigned w) { return __builtin_bit_cast(float, w & 0xffff0000u); }
__device__ __forceinline__ float fsigm(float x) { return __builtin_amdgcn_rcpf(1.f + __builtin_amdgcn_exp2f(-1.44269504f * x)); }
__device__ __forceinline__ float lane_xor(float v, int m, int lane) { return __builtin_bit_cast(float, __builtin_amdgcn_ds_bpermute((lane ^ m) << 2, __builtin_bit_cast(int, v))); }
__device__ __forceinline__ int lane_get(int v, int src) { return __builtin_amdgcn_ds_bpermute(src << 2, v); }
template <int CTRL> __device__ __forceinline__ float dpp_get(float x) { return __builtin_bit_cast(float, __builtin_amdgcn_update_dpp(0, __builtin_bit_cast(int, x), CTRL, 0xf, 0xf, false)); }
__device__ __forceinline__ float row16_sum(float x) { x += dpp_get<0x128>(x); x += dpp_get<0x124>(x); x += dpp_get<0x122>(x); x += dpp_get<0x121>(x); return x; }
__device__ __forceinline__ float wave_sum(float v, int lane) { (void)lane; v = row16_sum(v);
    v += __builtin_bit_cast(float, __builtin_amdgcn_update_dpp(0, __builtin_bit_cast(int, v), 0x142, 0xa, 0xf, false));
    v += __builtin_bit_cast(float, __builtin_amdgcn_update_dpp(0, __builtin_bit_cast(int, v), 0x143, 0xc, 0xf, false));
    return __builtin_bit_cast(float, __builtin_amdgcn_readlane(__builtin_bit_cast(int, v), 63)); }

#define XB_TMO      128
#define XB_XCNT(j)  (256  + 64 * (j))
#define XB_XSUB(j)  (1280 + 64 * (j))
#define XB_XGEN(j)  (2304 + 64 * (j))
#define XB_TOP      3328
#define XB_TOPGEN   3392
#define XCD_BAR_WORDS 3456
#define XB_SPIN_CAP (1u << 18)
__device__ __forceinline__ unsigned xb_ld(unsigned* p)              { return __hip_atomic_load(p, __ATOMIC_RELAXED, __HIP_MEMORY_SCOPE_AGENT); }
__device__ __forceinline__ unsigned xb_add(unsigned* p, unsigned v) { return __hip_atomic_fetch_add(p, v, __ATOMIC_RELAXED, __HIP_MEMORY_SCOPE_AGENT); }
__device__ __forceinline__ unsigned xb_xcc_id() { return (unsigned)__builtin_amdgcn_s_getreg((3 << 11) | 20) & 0xFu; }
#define XB_SPIN(cond, bar) do { unsigned _sp = 0; while (cond) { __builtin_amdgcn_s_sleep(1); \
    if ((++_sp & 255u) == 0u) { if (xb_ld(&(bar)[XB_TMO])) break; if (_sp > XB_SPIN_CAP) { atomicAdd(&(bar)[XB_TMO], 1u); break; } } } } while (0)
struct XcdBarrier { unsigned* bar; unsigned x; volatile LAS unsigned* st; };
__device__ __forceinline__ XcdBarrier xcd_barrier_post(unsigned* bar, volatile LAS unsigned* st) {
    XcdBarrier b; b.bar = bar; b.x = xb_xcc_id(); b.st = st;
    if (threadIdx.x == 0) (void)xb_add(&bar[XB_XCNT(b.x)], 1u);
    return b;
}
__device__ __forceinline__ void xcd_barrier_complete(unsigned* bar, unsigned x, unsigned& nloc, unsigned& nx) {
    const unsigned G = gridDim.x * gridDim.y * gridDim.z;
    unsigned sum, cnt, mine, sp = 0u;
    for (;;) {
        sum = 0u; cnt = 0u; mine = 0u;
#pragma unroll
        for (unsigned j = 0; j < 16; ++j) { const unsigned c = xb_ld(&bar[XB_XCNT(j)]); sum += c; cnt += (c > 0u) ? 1u : 0u; mine = (j == x) ? c : mine; }
        if (sum == G) break;
        __builtin_amdgcn_s_sleep(1);
        if ((++sp & 255u) == 0u) { if (xb_ld(&bar[XB_TMO])) break; if (sp > XB_SPIN_CAP) { atomicAdd(&bar[XB_TMO], 1u); break; } }
    }
    nloc = mine > 0u ? mine : 1u; nx = cnt > 0u ? cnt : 1u;
}
__device__ __forceinline__ void xcd_barrier(const XcdBarrier& b, const int tid) {
    asm volatile("s_waitcnt vmcnt(0)" ::: "memory");
    unsigned blo = (unsigned)(unsigned long long)b.bar, bhi = (unsigned)((unsigned long long)b.bar >> 32), bx = b.x;
    asm volatile("" : "+s"(blo), "+s"(bhi), "+s"(bx));
    __syncthreads();
    if (tid == 0) {
        unsigned* bar = (unsigned*)(((unsigned long long)bhi << 32) | blo);
        __builtin_amdgcn_s_waitcnt(0);
        unsigned nloc = b.st[0], nx = b.st[1];
        if (nloc == 0u) { xcd_barrier_complete(bar, bx, nloc, nx); b.st[0] = nloc; b.st[1] = nx; }
        const unsigned old = xb_add(&bar[XB_XSUB(bx)], 1u);
        const unsigned gen = old / nloc;
        if (old + 1u == (gen + 1u) * nloc) {
            __builtin_amdgcn_fence(__ATOMIC_RELEASE, "agent");
            asm volatile("s_waitcnt vmcnt(0)" ::: "memory");
            const unsigned og = xb_add(&bar[XB_TOP], 1u);
            const unsigned tg = og / nx;
            if (og + 1u == (tg + 1u) * nx) xb_add(&bar[XB_TOPGEN], 1u);
            else XB_SPIN(xb_ld(&bar[XB_TOPGEN]) == tg, bar);
            __builtin_amdgcn_fence(__ATOMIC_ACQUIRE, "agent");
            xb_add(&bar[XB_XGEN(bx)], 1u);
            asm volatile("s_waitcnt vmcnt(0)" ::: "memory");
        } else {
            XB_SPIN(xb_ld(&bar[XB_XGEN(bx)]) == gen, bar);
            __builtin_amdgcn_fence(__ATOMIC_ACQUIRE, "agent");
            asm volatile("s_waitcnt vmcnt(0)" ::: "memory");
        }
    }
    __syncthreads();
}

namespace pg8 {
constexpr int BM = 256, BK = 64, HALF = 128, HTB = HALF * BK * 2, STAGE_BYTES = 8 * HTB, NXCD = 8, WGM = 8;
__host__ __device__ __forceinline__ int lds_byte(int r, int c) { const int st = (r >> 4) * 2 + (c >> 5), rr = r & 15, cc = c & 31, ob = rr * 64 + cc * 2; return st * 1024 + (ob ^ (((ob >> 9) & 1) << 5)); }
__host__ __device__ __forceinline__ void stage_rc(int b, int& R, int& C) { const int st = b / 1024, sb = b % 1024, swz = sb ^ (((sb >> 9) & 1) << 5); R = (st >> 1) * 16 + swz / 64; C = (st & 1) * 32 + (swz % 64) / 2; }
__host__ __device__ __forceinline__ int perm32(int rho) { const int n = rho >> 4, i = rho & 15; return 8 * (i >> 2) + 4 * n + (i & 3); }

struct Unit { int pm, pn, e, ui; };

typedef int i32x8 __attribute__((ext_vector_type(8)));
typedef int i32x4 __attribute__((ext_vector_type(4)));
__device__ __forceinline__ i32x8 cat8(bf16x8 a, bf16x8 b) { return __builtin_shufflevector(__builtin_bit_cast(i32x4, a), __builtin_bit_cast(i32x4, b), 0, 1, 2, 3, 4, 5, 6, 7); }
template <class Epi, class Sched, bool ALIGN_EPI = true, bool FP8 = false>
__device__ __forceinline__ void gemm_phase(LAS unsigned char* lds, const char* gA, const int Kb, const Sched& S, const Epi& E, const int tid) {
    const int wid = __builtin_amdgcn_readfirstlane(tid >> 6), lane = tid & 63, wr = wid >> 2, wc = wid & 3, fr = lane & 15, fq = lane >> 4;
    const int nt = Kb / (BK * 2);
    int Ra[2], Ca[2]; unsigned voffB[2];
#pragma unroll
    for (int i = 0; i < 2; ++i) { int R, C; stage_rc(tid * 16 + i * 8192, R, C); const int Rb = 64 * (R >> 5) + (Epi::PERM ? perm32(R & 31) : (R & 31));
        Ra[i] = R; Ca[i] = C * 2; voffB[i] = (unsigned)(Rb * Kb + C * 2); }
    const size_t kstep = (size_t)(BK * 2);
    const size_t hstep = (size_t)32 * Kb;
    const unsigned ldsw = (unsigned)wid * 1024u;
    const int aoff = lds_byte(wr * 64 + fr, fq * 8), boff = lds_byte(wc * 32 + fr, fq * 8);
#define PG8_SA(b, h) (((b) * 2 + (h)) * HTB)
#define PG8_SB(b, h) ((4 + (b) * 2 + (h)) * HTB)
#define PG8_STAGE(bufoff, gbase, voff) do { _Pragma("unroll") for (int _i = 0; _i < 2; ++_i) \
        __builtin_amdgcn_global_load_lds((const unsigned*)((const char*)(gbase) + (voff)[_i]), (LAS unsigned*)(lds + (bufoff) + ldsw + _i * 8192), 16, 0, 0); } while (0)
#define PG8_LDA(dst, b, h) do { _Pragma("unroll") for (int m = 0; m < 4; ++m) _Pragma("unroll") for (int k = 0; k < 2; ++k) dst[m][k] = *(const LAS bf16x8*)(lds + PG8_SA(b, h) + aoff + m * 2048 + k * 1024); } while (0)
#define PG8_LDB(dst, b, h) do { _Pragma("unroll") for (int n = 0; n < 2; ++n) _Pragma("unroll") for (int k = 0; k < 2; ++k) dst[n][k] = *(const LAS bf16x8*)(lds + PG8_SB(b, h) + boff + n * 2048 + k * 1024); } while (0)
#define PG8_MMA(ai, bj, At, Bt) do { __builtin_amdgcn_s_setprio(1); _Pragma("unroll") for (int m = 0; m < 4; ++m) _Pragma("unroll") for (int n = 0; n < 2; ++n) { \
        if constexpr (FP8) asm volatile("v_mfma_scale_f32_16x16x128_f8f6f4 %0, %1, %2, %0, %3, %3 op_sel_hi:[0,0,0]" : "+v"(acc[ai][bj][m][n]) : "v"(cat8(Bt[n][0], Bt[n][1])), "v"(cat8(At[m][0], At[m][1])), "v"(scl)); \
        else { _Pragma("unroll") for (int k = 0; k < 2; ++k) acc[ai][bj][m][n] = __builtin_amdgcn_mfma_f32_16x16x32_bf16(Bt[n][k], At[m][k], acc[ai][bj][m][n], 0, 0, 0); } } __builtin_amdgcn_s_setprio(0); } while (0)
#define PG8_WAIT_V(n) asm volatile("s_waitcnt vmcnt(" #n ")" ::: "memory")
#define PG8_WAIT_L(n) asm volatile("s_waitcnt lgkmcnt(" #n ")" ::: "memory")
#define PG8_BAR __builtin_amdgcn_s_barrier()
#define PG8_SCHED __builtin_amdgcn_sched_barrier(0)
    Unit cur, nxt; int ui = 0;
    if (!S.next(0, cur)) return;
    f32x4 acc[2][2][4][2];
#pragma unroll
    for (int a = 0; a < 2; ++a)
#pragma unroll
        for (int b = 0; b < 2; ++b)
#pragma unroll
            for (int m = 0; m < 4; ++m)
#pragma unroll
                for (int n = 0; n < 2; ++n) acc[a][b][m][n] = (f32x4){0.f, 0.f, 0.f, 0.f};
    bf16x8 At[4][2], B0[2][2], B1[2][2]; const int scl = 0x7f7f7f7f;
    unsigned vA[2][2];
#pragma unroll
    for (int h = 0; h < 2; ++h)
#pragma unroll
        for (int i = 0; i < 2; ++i) vA[h][i] = S.a_row_off(cur, h * HALF + Ra[i]) + (unsigned)Ca[i];
    const char* cB = S.b_tile(cur);
    PG8_STAGE(PG8_SB(0, 0), cB, voffB); PG8_STAGE(PG8_SB(0, 1), cB + hstep, voffB); PG8_STAGE(PG8_SA(0, 0), gA, vA[0]); PG8_STAGE(PG8_SA(0, 1), gA, vA[1]);
    if (wr == 1) PG8_BAR;
    PG8_WAIT_V(2); PG8_BAR;
    PG8_STAGE(PG8_SB(1, 0), cB + kstep, voffB); PG8_STAGE(PG8_SA(1, 0), gA + kstep, vA[0]); PG8_STAGE(PG8_SB(1, 1), cB + hstep + kstep, voffB);
    PG8_WAIT_V(6); PG8_BAR;
    for (;;) {
        const bool has_next = S.next(ui + 1, nxt);
        const char* nB = has_next ? S.b_tile(nxt) : cB;
        for (int t = 0; t < nt; t += 2) {
            const bool last = (t == nt - 2);
            unsigned tN[2][2];
#pragma unroll
            for (int h = 0; h < 2; ++h)
#pragma unroll
                for (int i = 0; i < 2; ++i) tN[h][i] = vA[h][i];
            if (last && has_next) {
#pragma unroll
                for (int h = 0; h < 2; ++h)
#pragma unroll
                    for (int i = 0; i < 2; ++i) tN[h][i] = S.a_row_off(nxt, h * HALF + Ra[i]) + (unsigned)Ca[i];
                PG8_WAIT_L(0);
            }
            const char* a1 = gA + (size_t)(t + 1) * kstep;
            const char* a2 = last ? gA : gA + (size_t)(t + 2) * kstep; const char* b2 = last ? nB : cB + (size_t)(t + 2) * kstep;
            const char* a3 = a2 + kstep; const char* b3 = b2 + kstep;
            PG8_LDB(B0, 0, 0); PG8_LDB(B1, 0, 1); PG8_SCHED; PG8_LDA(At, 0, 0); PG8_STAGE(PG8_SA(1, 1), a1, vA[1]);
#pragma unroll
            for (int h = 0; h < 2; ++h)
#pragma unroll
                for (int i = 0; i < 2; ++i) vA[h][i] = tN[h][i];
            PG8_WAIT_V(8); PG8_WAIT_L(0); PG8_BAR; PG8_MMA(0, 0, At, B0); PG8_MMA(0, 1, At, B1); PG8_BAR; PG8_SCHED;
            PG8_LDA(At, 0, 1); PG8_STAGE(PG8_SB(0, 0), b2, voffB); PG8_STAGE(PG8_SB(0, 1), b2 + hstep, voffB); PG8_STAGE(PG8_SA(0, 0), a2, vA[0]);
            PG8_WAIT_V(8); PG8_WAIT_L(0); PG8_BAR; PG8_MMA(1, 0, At, B0); PG8_MMA(1, 1, At, B1); PG8_BAR; PG8_SCHED;
            PG8_LDB(B0, 1, 0); PG8_LDB(B1, 1, 1); PG8_SCHED; PG8_LDA(At, 1, 0); PG8_STAGE(PG8_SA(0, 1), a2, vA[1]);
            PG8_WAIT_V(8); PG8_WAIT_L(0); PG8_BAR; PG8_MMA(0, 0, At, B0); PG8_MMA(0, 1, At, B1); PG8_BAR; PG8_SCHED;
            PG8_LDA(At, 1, 1); PG8_STAGE(PG8_SB(1, 0), b3, voffB); PG8_STAGE(PG8_SB(1, 1), b3 + hstep, voffB); PG8_STAGE(PG8_SA(1, 0), a3, vA[0]);
            PG8_WAIT_V(8); PG8_WAIT_L(0); PG8_BAR; PG8_MMA(1, 0, At, B0); PG8_MMA(1, 1, At, B1); PG8_BAR; PG8_SCHED;
        }
        if constexpr (ALIGN_EPI) { if (wr == 0) PG8_BAR; }
        if constexpr (FP8) asm volatile("s_nop 15\n\ts_nop 15" ::: "memory");
        E(acc, cur, wr, wc, fr, fq);
        if (!has_next) break;
#pragma unroll
        for (int a = 0; a < 2; ++a)
#pragma unroll
            for (int b = 0; b < 2; ++b)
#pragma unroll
                for (int m = 0; m < 4; ++m)
#pragma unroll
                    for (int n = 0; n < 2; ++n) acc[a][b][m][n] = (f32x4){0.f, 0.f, 0.f, 0.f};
        cur = nxt; cB = nB; ++ui;
        if constexpr (ALIGN_EPI) { if (wr == 1) PG8_BAR; }
    }
    PG8_WAIT_V(0);
    if constexpr (!ALIGN_EPI) { if (wr == 0) PG8_BAR; }
    PG8_BAR;
#undef PG8_SA
#undef PG8_SB
#undef PG8_STAGE
#undef PG8_LDA
#undef PG8_LDB
#undef PG8_MMA
#undef PG8_WAIT_V
#undef PG8_WAIT_L
#undef PG8_BAR
#undef PG8_SCHED
}
}
constexpr size_t MiB = 1u << 20;
constexpr int TP = T * 4 + NE * 256;
constexpr size_t WS_CTL = 0, CTL_ZERO_BYTES = 128 * 1024;
constexpr size_t WS_LB = 1 * MiB, WS_MOD = 1 * MiB + 65536;
constexpr size_t WS_WIN = 2 * MiB, WS_WOUT = 18 * MiB, WS_WF = 22 * MiB, WS_WGU = 24 * MiB, WS_WDN = 280 * MiB;
constexpr size_t WS_X = 408 * MiB, WS_H = 474 * MiB, WS_P = 508 * MiB, WS_CAT = 624 * MiB, WS_ROUTE = 658 * MiB, WS_ACT = 662 * MiB, WS_Y = 810 * MiB;
constexpr size_t WS_SU = 958 * MiB, WS_SS = 990 * MiB, WS_SD = 1022 * MiB, WS_YP = 1023 * MiB, WS_OSCR = 1040 * MiB, WS_H8 = 1072 * MiB, WS_CTXO = 1090 * MiB, WS_FASTEND = 1092 * MiB;
#ifndef MOE_FP8
#define MOE_FP8 1
#endif
constexpr float FP8_SH = 16.f, FP8_SW = 256.f, FP8_SA = 4.f;
constexpr size_t RT_TOPI = 0, RT_TOPW = 512 * 1024, RT_POS = 1024 * 1024, RT_LISTE = 1536 * 1024;
static_assert((size_t)T * 16 <= 512 * 1024 && RT_LISTE + (size_t)NE * T * 4 <= 4 * MiB, "route map");
static_assert(WS_WIN + (size_t)2 * DINX * D * 2 <= WS_WOUT && WS_WGU + (size_t)2 * NE * 2048 * 1024 * 2 <= WS_WDN && WS_WDN + (size_t)2 * NE * 1024 * 1024 * 2 <= WS_X && WS_X + (size_t)T * D * 4 <= WS_H && WS_H + (size_t)T * D * 2 <= WS_P &&
              WS_P + (size_t)T * DINX * 2 <= WS_CAT && WS_CAT + (size_t)T * D * 2 <= WS_ROUTE && WS_ACT + (size_t)TP * D * 2 <= WS_Y && WS_Y + (size_t)TP * D * 2 <= WS_SU &&
              WS_SD + (size_t)(8 * 64 * 128 + 8 * 16384) * 4 <= WS_YP && WS_YP + (size_t)128 * 128 * 2 * 256 * 2 <= WS_OSCR && WS_OSCR + (size_t)256 * 32768 * 4 <= WS_H8 && WS_H8 + (size_t)T * D <= WS_CTXO && WS_CTXO + (size_t)32 * 8192 * 4 <= WS_FASTEND, "ws map");
constexpr int CW_TMO = 0, CW_BAR = 4096, CW_CVT = 8192, CW_CNT = 16384;
constexpr int RING_OFF = 0, RING_BYTES = 131072, TINFO_OFF = 131072, BT_OFF = 136192, ROWOFF_OFF = 136704, MISC_OFF = 146944, LDS_BYTES = 147456;
constexpr int NWAVES = 8, NTHR = 512;

__device__ unsigned g_ctl[CTL_ZERO_BYTES / 4];
constexpr int CW_DONE = 64, CW_ADA = 192;
struct Params { const float* in[22]; float* out; unsigned char* ws; };
constexpr int PTR_OFF = MISC_OFF + 64;
struct Frame {
    LAS unsigned char* lds; unsigned char* ws; int tid, lane, wave, vcu, G, bid;
    __device__ __forceinline__ const float* in(int i) const { const LAS unsigned* q = (const LAS unsigned*)(lds + PTR_OFF) + 2 * i;
        const unsigned lo = __builtin_amdgcn_readfirstlane(q[0]), hi = __builtin_amdgcn_readfirstlane(q[1]); return (const float*)(((unsigned long long)hi << 32) | lo); }
    __device__ __forceinline__ const float* x() const { return in(0); }        __device__ __forceinline__ const float* c() const { return in(1); }
    __device__ __forceinline__ const float* ctxin() const { return in(2); }    __device__ __forceinline__ const float* cctx() const { return in(3); }
    __device__ __forceinline__ const float* w_ada() const { return in(4); }    __device__ __forceinline__ const float* b_ada() const { return in(5); }
    __device__ __forceinline__ const float* norm1_g() const { return in(6); }  __device__ __forceinline__ const float* norm2_g() const { return in(7); }
    __device__ __forceinline__ const float* w_in() const { return in(8); }     __device__ __forceinline__ const float* lbp() const { return in(9); }
    __device__ __forceinline__ const float* hng() const { return in(10); }     __device__ __forceinline__ const float* pool_w() const { return in(11); }
    __device__ __forceinline__ const float* pool_s() const { return in(12); }  __device__ __forceinline__ const float* four_w() const { return in(13); }
    __device__ __forceinline__ const float* w_out() const { return in(14); }   __device__ __forceinline__ const float* router_w() const { return in(15); }
    __device__ __forceinline__ const float* router_b() const { return in(16); } __device__ __forceinline__ const float* w_gu() const { return in(17); }
    __device__ __forceinline__ const float* b_gu() const { return in(18); }    __device__ __forceinline__ const float* w_dn() const { return in(19); }
    __device__ __forceinline__ const float* b_dn() const { return in(20); }    __device__ __forceinline__ const float* fng() const { return in(21); }
    __device__ __forceinline__ float* out() const { return (float*)in(22); }
    __device__ __forceinline__ gu32* ctl() const { return (gu32*)g_ctl; }
    __device__ __forceinline__ float* LB() const { return (float*)(ws + WS_LB); }       __device__ __forceinline__ float* MOD() const { return (float*)(ws + WS_MOD); }
    __device__ __forceinline__ float* X() const { return (float*)(ws + WS_X); }
    __device__ __forceinline__ bf16_t* Wt_in() const { return (bf16_t*)(ws + WS_WIN); }  __device__ __forceinline__ bf16_t* Wt_out() const { return (bf16_t*)(ws + WS_WOUT); }
    __device__ __forceinline__ bf16_t* Wt_gu() const { return (bf16_t*)(ws + WS_WGU); }  __device__ __forceinline__ bf16_t* Wt_dn() const { return (bf16_t*)(ws + WS_WDN); }
    __device__ __forceinline__ bf16_t* H() const { return (bf16_t*)(ws + WS_H); }        __device__ __forceinline__ bf16_t* P() const { return (bf16_t*)(ws + WS_P); }
    __device__ __forceinline__ bf16_t* CAT() const { return (bf16_t*)(ws + WS_CAT); }    __device__ __forceinline__ bf16_t* ACT() const { return (bf16_t*)(ws + WS_ACT); }
    __device__ __forceinline__ bf16_t* Y() const { return (bf16_t*)(ws + WS_Y); }
    __device__ __forceinline__ int* TOPI() const { return (int*)(ws + WS_ROUTE + RT_TOPI); }   __device__ __forceinline__ float* TOPW() const { return (float*)(ws + WS_ROUTE + RT_TOPW); }
    __device__ __forceinline__ int* POS() const { return (int*)(ws + WS_ROUTE + RT_POS); }     __device__ __forceinline__ int* LISTE() const { return (int*)(ws + WS_ROUTE + RT_LISTE); }
};
__device__ __forceinline__ void frame_init(Frame& F, const Params& p, unsigned char* lds) {
    F.lds = (LAS unsigned char*)lds; F.tid = threadIdx.x; F.lane = F.tid & 63; F.wave = __builtin_amdgcn_readfirstlane(F.tid >> 6);
    F.G = gridDim.x; F.bid = blockIdx.x; { const int bx = blockIdx.x; F.vcu = (F.G % 8 == 0) ? (bx % 8) * (F.G / 8) + bx / 8 : bx; }
    F.ws = p.ws;
    if (F.tid == 0) { LAS unsigned long long* tab = (LAS unsigned long long*)(F.lds + PTR_OFF);
#pragma unroll
        for (int i = 0; i < 22; ++i) tab[i] = (unsigned long long)p.in[i];
        tab[22] = (unsigned long long)p.out; }
    __syncthreads();
}

__device__ __forceinline__ Frame relaunder(const Frame& F) { Frame R = F; int ln; asm volatile("v_mbcnt_lo_u32_b32 %0, -1, 0\n\tv_mbcnt_hi_u32_b32 %0, -1, %0" : "=v"(ln));
    R.lane = ln; R.tid = F.wave * 64 + ln; unsigned wlo = (unsigned)(unsigned long long)F.ws, whi = (unsigned)((unsigned long long)F.ws >> 32);
    asm volatile("" : "+s"(wlo), "+s"(whi)); R.ws = (unsigned char*)(((unsigned long long)whi << 32) | wlo);
    int sw = F.wave, sv = F.vcu, sg = F.G, sb = F.bid;
    asm volatile("" : "+s"(sw), "+s"(sv), "+s"(sg), "+s"(sb));
    R.wave = sw; R.vcu = sv; R.G = sg; R.bid = sb; R.tid = sw * 64 + ln; return R; }

struct DenseOrder {
    int nM, nN, nwg, G, c, Kb, pm0; const char* Bt;
    __device__ void init(int nM_, int nN_, int G_, int c_, int Kb_, const bf16_t* Bt_, int pm0_ = 0) { nM = nM_; nN = nN_; nwg = nM * nN; G = G_; c = c_; Kb = Kb_; Bt = (const char*)Bt_; pm0 = pm0_; }
    __device__ __forceinline__ bool next(int i, pg8::Unit& u) const {
        const long L = (long)i * G + c; if (L >= nwg) return false;
        int wgid = (int)L; { const int q = nwg / pg8::NXCD, r = nwg % pg8::NXCD, xcd = wgid % pg8::NXCD, off = wgid / pg8::NXCD; wgid = (xcd < r ? xcd * (q + 1) : r * (q + 1) + (xcd - r) * q) + off; }
        const int nig = pg8::WGM * nN, gid = wgid / nig, fm = gid * pg8::WGM, gsz = (nM - fm) < pg8::WGM ? (nM - fm) : pg8::WGM;
        u.pm = pm0 + fm + ((wgid % nig) % gsz); u.pn = (wgid % nig) / gsz; u.e = 0; u.ui = i; return true;
    }
    __device__ __forceinline__ const char* b_tile(const pg8::Unit& u) const { return Bt + (size_t)u.pn * 256 * Kb; }
    __device__ __forceinline__ unsigned a_row_off(const pg8::Unit& u, int r) const { return (unsigned)(u.pm * 256 + r) * (unsigned)Kb; }
};
template <bool GATHER> struct MoeOrder {
    const LAS int* tinfo; const LAS unsigned* rowoff; int ntiles, nN, G, c, Kb; const char* W; size_t wstride;
    __device__ __forceinline__ bool next(int i, pg8::Unit& u) const {
        const int L = i * G + c; if (L >= ntiles * nN) return false;
        u.pm = L / nN; u.pn = L % nN; u.e = __builtin_amdgcn_readfirstlane(tinfo[4 * u.pm]); u.ui = i; return true;
    }
    __device__ __forceinline__ const char* b_tile(const pg8::Unit& u) const { return W + (size_t)u.e * wstride + (size_t)u.pn * 256 * Kb; }
    __device__ __forceinline__ unsigned a_row_off(const pg8::Unit& u, int r) const { if constexpr (GATHER) return rowoff[u.ui * 256 + r]; else return (unsigned)(u.pm * 256 + r) * (unsigned)Kb; }
};

__device__ __forceinline__ unsigned pk_f16(float a, float b) { const _Float16 x = (_Float16)a, y = (_Float16)b; return (unsigned)__builtin_bit_cast(unsigned short, x) | ((unsigned)__builtin_bit_cast(unsigned short, y) << 16); }
__device__ __forceinline__ float f16lo(unsigned w) { return (float)__builtin_bit_cast(_Float16, (unsigned short)(w & 0xffffu)); }
__device__ __forceinline__ float f16hi(unsigned w) { return (float)__builtin_bit_cast(_Float16, (unsigned short)(w >> 16)); }
struct EpiP {
    static constexpr bool PERM = true; bf16_t* O; int ldc; const float* lb;
    __device__ __forceinline__ void operator()(const f32x4 (&acc)[2][2][4][2], const pg8::Unit& u, int wr, int wc, int fr, int fq) const {
        const int row0 = u.pm * 256 + wr * 64 + fr, col0 = u.pn * 256 + wc * 64 + 8 * fq;
        const int mode = u.pn < 2 ? 1 : (u.pn < 6 ? 2 : ((u.pn == 8 || u.pn == 9) ? 3 : 0));
        f32x4 lbv[2][2];
        if (mode == 2) {
#pragma unroll
            for (int bj = 0; bj < 2; ++bj)
#pragma unroll
                for (int n = 0; n < 2; ++n) lbv[bj][n] = *(const f32x4*)(lb + (col0 - 512) + bj * 32 + 4 * n); }
#pragma unroll
        for (int ai = 0; ai < 2; ++ai)
#pragma unroll
            for (int m = 0; m < 4; ++m) { bf16_t* rowp = O + (size_t)(row0 + ai * 128 + m * 16) * ldc + col0;
#pragma unroll
                for (int bj = 0; bj < 2; ++bj) { f32x2 v[4]; { const f32x4 v0 = acc[ai][bj][m][0], v1 = acc[ai][bj][m][1]; v[0] = (f32x2){v0[0], v0[1]}; v[1] = (f32x2){v0[2], v0[3]}; v[2] = (f32x2){v1[0], v1[1]}; v[3] = (f32x2){v1[2], v1[3]}; }
                    u32x4 w;
                    if (mode != 0) {
                        f32x2 sg[4];
#pragma unroll
                        for (int p = 0; p < 4; ++p) { const f32x2 ex = v[p] * (-1.44269504f); f32x2 d; d.x = __builtin_amdgcn_exp2f(ex.x); d.y = __builtin_amdgcn_exp2f(ex.y); d = d + 1.0f; sg[p].x = __builtin_amdgcn_rcpf(d.x); sg[p].y = __builtin_amdgcn_rcpf(d.y); }
                        if (mode == 2) {
#pragma unroll
                            for (int p = 0; p < 4; ++p) { const f32x4 lv = lbv[bj][p >> 1]; const f32x2 lb2 = (f32x2){lv[2 * (p & 1)], lv[2 * (p & 1) + 1]}; const f32x2 f = lb2 + (1.0f - lb2) * sg[p];
                                v[p].x = __builtin_amdgcn_logf(fmaxf(f.x, 1e-30f)); v[p].y = __builtin_amdgcn_logf(fmaxf(f.y, 1e-30f)); }
                            w.x = pk_f16(v[0].x, v[0].y); w.y = pk_f16(v[1].x, v[1].y); w.z = pk_f16(v[2].x, v[2].y); w.w = pk_f16(v[3].x, v[3].y);
                        } else {
#pragma unroll
                            for (int p = 0; p < 4; ++p) v[p] = mode == 1 ? v[p] * sg[p] : sg[p];
                            w.x = cvt_pk_bf16(v[0].x, v[0].y); w.y = cvt_pk_bf16(v[1].x, v[1].y); w.z = cvt_pk_bf16(v[2].x, v[2].y); w.w = cvt_pk_bf16(v[3].x, v[3].y); }
                    } else { w.x = cvt_pk_bf16(v[0].x, v[0].y); w.y = cvt_pk_bf16(v[1].x, v[1].y); w.z = cvt_pk_bf16(v[2].x, v[2].y); w.w = cvt_pk_bf16(v[3].x, v[3].y); }
                    *(u32x4*)(rowp + bj * 32) = w; } }
    }
};
struct EpiRes {
    static constexpr bool PERM = false; const float* base_ctx; const float* base_lat; const float* gate_ctx; const float* gate_lat; float* Xo;
    __device__ __forceinline__ void operator()(const f32x4 (&acc)[2][2][4][2], const pg8::Unit& u, int wr, int wc, int fr, int fq) const {
        const int rt = wr * 64 + fr, col0 = u.pn * 256 + wc * 64 + 4 * fq;
        const float* base = (u.pm == 0 ? base_ctx : base_lat + (size_t)(u.pm - 1) * 256 * D) + (size_t)rt * D + col0; const float* gate = (u.pm == 0 ? gate_ctx : gate_lat) + col0;
        float* op = Xo + (size_t)(u.pm * 256 + rt) * D + col0;
#pragma unroll
        for (int bj = 0; bj < 2; ++bj)
#pragma unroll
            for (int n = 0; n < 2; ++n) { const f32x4 gv = *(const f32x4*)(gate + bj * 32 + n * 16);
                { f32x4 bv[2][4];
#pragma unroll
                  for (int ai = 0; ai < 2; ++ai)
#pragma unroll
                      for (int m = 0; m < 4; ++m) bv[ai][m] = *(const f32x4*)(base + (size_t)(ai * 128 + m * 16) * D + bj * 32 + n * 16);
                  __builtin_amdgcn_sched_barrier(0);
#pragma unroll
                  for (int ai = 0; ai < 2; ++ai)
#pragma unroll
                      for (int m = 0; m < 4; ++m) *(f32x4*)(op + (size_t)(ai * 128 + m * 16) * D + bj * 32 + n * 16) = bv[ai][m] + gv * acc[ai][bj][m][n];
                  asm volatile("" ::: "memory"); } }
    }
};
struct EpiAct {
    static constexpr bool PERM = true; bf16_t* ACTo; const float* bias;
    __device__ __forceinline__ void operator()(const f32x4 (&acc)[2][2][4][2], const pg8::Unit& u, int wr, int wc, int fr, int fq) const {
        const int x0 = wc * 32 + 8 * fq; const float* bg = bias + (size_t)u.e * 2048 + 128 * u.pn + x0; const float* bu = bg + 1024;
        const f32x4 g0 = *(const f32x4*)bg, g1 = *(const f32x4*)(bg + 4), u0 = *(const f32x4*)bu, u1 = *(const f32x4*)(bu + 4);
#pragma unroll
        for (int ai = 0; ai < 2; ++ai)
#pragma unroll
            for (int m = 0; m < 4; ++m) { const int row = u.pm * 256 + ai * 128 + wr * 64 + m * 16 + fr;
                const f32x4 ga = acc[ai][0][m][0] + g0, gb = acc[ai][0][m][1] + g1, ua = acc[ai][1][m][0] + u0, ub = acc[ai][1][m][1] + u1; float r[8];
#pragma unroll
                for (int j = 0; j < 4; ++j) { const float g = fminf(ga[j], 7.f), up = fminf(fmaxf(ua[j], -7.f), 7.f); r[j] = (up + 1.f) * (g * fsigm(1.702f * g));
                                              const float g2 = fminf(gb[j], 7.f), up2 = fminf(fmaxf(ub[j], -7.f), 7.f); r[4 + j] = (up2 + 1.f) * (g2 * fsigm(1.702f * g2)); }
                u32x4 w; w.x = cvt_pk_bf16(r[0], r[1]); w.y = cvt_pk_bf16(r[2], r[3]); w.z = cvt_pk_bf16(r[4], r[5]); w.w = cvt_pk_bf16(r[6], r[7]);
                *(u32x4*)(ACTo + (size_t)row * D + 128 * u.pn + x0) = w; }
    }
};
struct EpiY {
    static constexpr bool PERM = true; bf16_t* Yo; const float* bias;
    __device__ __forceinline__ void operator()(const f32x4 (&acc)[2][2][4][2], const pg8::Unit& u, int wr, int wc, int fr, int fq) const {
        const int row0 = u.pm * 256 + wr * 64 + fr, col0 = u.pn * 256 + wc * 64 + 8 * fq; const float* bp = bias + (size_t)u.e * D + col0;
        f32x4 bv[2][2];
#pragma unroll
        for (int bj = 0; bj < 2; ++bj)
#pragma unroll
            for (int n = 0; n < 2; ++n) bv[bj][n] = *(const f32x4*)(bp + bj * 32 + 4 * n);
#pragma unroll
        for (int ai = 0; ai < 2; ++ai)
#pragma unroll
            for (int m = 0; m < 4; ++m) { bf16_t* rowp = Yo + (size_t)(row0 + ai * 128 + m * 16) * D + col0;
#pragma unroll
                for (int bj = 0; bj < 2; ++bj) { const f32x4 v0 = acc[ai][bj][m][0] + bv[bj][0], v1 = acc[ai][bj][m][1] + bv[bj][1];
                    u32x4 w; w.x = cvt_pk_bf16(v0[0], v0[1]); w.y = cvt_pk_bf16(v0[2], v0[3]); w.z = cvt_pk_bf16(v1[0], v1[1]); w.w = cvt_pk_bf16(v1[2], v1[3]);
                    *(u32x4*)(rowp + bj * 32) = w; } }
    }
};

__device__ __forceinline__ unsigned pk4_fp8(float a, float b, float c, float d) { int r = __builtin_amdgcn_cvt_pk_fp8_f32(a, b, 0, false); r = __builtin_amdgcn_cvt_pk_fp8_f32(c, d, r, true); return (unsigned)r; }
struct EpiAct8 {
    static constexpr bool PERM = true; unsigned char* ACTo; const float* bias;
    __device__ __forceinline__ void operator()(const f32x4 (&acc)[2][2][4][2], const pg8::Unit& u, int wr, int wc, int fr, int fq) const {
        const int x0 = wc * 32 + 8 * fq; const float* bg = bias + (size_t)u.e * 2048 + 128 * u.pn + x0; const float* bu = bg + 1024; constexpr float isc = 1.f / (FP8_SH * FP8_SW);
        f32x2 g[4], v[4];
#pragma unroll
        for (int p = 0; p < 4; ++p) { g[p] = *(const f32x2*)(bg + 2 * p); v[p] = *(const f32x2*)(bu + 2 * p); }
#pragma unroll
        for (int ai = 0; ai < 2; ++ai)
#pragma unroll
            for (int m = 0; m < 4; ++m) { const int row = u.pm * 256 + ai * 128 + wr * 64 + m * 16 + fr; f32x2 r[4];
#pragma unroll
                for (int p = 0; p < 4; ++p) { const f32x4 ga4 = acc[ai][0][m][p >> 1], ua4 = acc[ai][1][m][p >> 1];
                    f32x2 gg = (f32x2){ga4[2 * (p & 1)], ga4[2 * (p & 1) + 1]} * isc + g[p], uu = (f32x2){ua4[2 * (p & 1)], ua4[2 * (p & 1) + 1]} * isc + v[p];
                    gg.x = fminf(gg.x, 7.f); gg.y = fminf(gg.y, 7.f); uu.x = __builtin_amdgcn_fmed3f(uu.x, -7.f, 7.f); uu.y = __builtin_amdgcn_fmed3f(uu.y, -7.f, 7.f);
                    const f32x2 ex = gg * (-1.702f * 1.44269504f); f32x2 d; d.x = __builtin_amdgcn_exp2f(ex.x); d.y = __builtin_amdgcn_exp2f(ex.y); d = d + 1.0f;
                    f32x2 rc; rc.x = __builtin_amdgcn_rcpf(d.x); rc.y = __builtin_amdgcn_rcpf(d.y);
                    r[p] = (uu * FP8_SA + FP8_SA) * (gg * rc); }
                u32x2 w; w.x = pk4_fp8(r[0].x, r[0].y, r[1].x, r[1].y); w.y = pk4_fp8(r[2].x, r[2].y, r[3].x, r[3].y);
                *(u32x2*)(ACTo + (size_t)row * D + 128 * u.pn + x0) = w; }
    }
};
struct EpiY8 {
    static constexpr bool PERM = true; bf16_t* Yo; const float* bias;
    __device__ __forceinline__ void operator()(const f32x4 (&acc)[2][2][4][2], const pg8::Unit& u, int wr, int wc, int fr, int fq) const {
        const int row0 = u.pm * 256 + wr * 64 + fr, col0 = u.pn * 256 + wc * 64 + 8 * fq; const float* bp = bias + (size_t)u.e * D + col0; constexpr float isc = 1.f / (FP8_SA * FP8_SW);
        f32x4 bv[2][2];
#pragma unroll
        for (int bj = 0; bj < 2; ++bj)
#pragma unroll
            for (int n = 0; n < 2; ++n) bv[bj][n] = *(const f32x4*)(bp + bj * 32 + 4 * n);
#pragma unroll
        for (int ai = 0; ai < 2; ++ai)
#pragma unroll
            for (int m = 0; m < 4; ++m) { bf16_t* rowp = Yo + (size_t)(row0 + ai * 128 + m * 16) * D + col0;
#pragma unroll
                for (int bj = 0; bj < 2; ++bj) { const f32x4 v0 = acc[ai][bj][m][0] * isc + bv[bj][0], v1 = acc[ai][bj][m][1] * isc + bv[bj][1];
                    u32x4 w; w.x = cvt_pk_bf16(v0[0], v0[1]); w.y = cvt_pk_bf16(v0[2], v0[3]); w.z = cvt_pk_bf16(v1[0], v1[1]); w.w = cvt_pk_bf16(v1[2], v1[3]);
                    *(u32x4*)(rowp + bj * 32) = w; } }
    }
};

struct CvtJob { const float* W; bf16_t* WT; int N, K, k0, n0, nrow0; };
__device__ __forceinline__ void cvt_load(const CvtJob& j, int lane, f32x4 (&r)[16]) { const GAS f32x4* src = (const GAS f32x4*)((const GAS float*)j.W + (unsigned)((j.k0 + 8 * (lane >> 3)) * j.N + j.n0 + 8 * (lane & 7)));
    const unsigned rs = (unsigned)j.N >> 2;
#pragma unroll
    for (int i = 0; i < 8; ++i) { r[2 * i] = src[i * rs]; r[2 * i + 1] = src[i * rs + 1]; } }
__device__ __forceinline__ void cvt_store(const CvtJob& j, int lane, const f32x4 (&r)[16]) {
    u32x4 b[8];
#pragma unroll
    for (int i = 0; i < 8; ++i) { b[i].x = cvt_pk_bf16(r[2 * i][0], r[2 * i][1]); b[i].y = cvt_pk_bf16(r[2 * i][2], r[2 * i][3]); b[i].z = cvt_pk_bf16(r[2 * i + 1][0], r[2 * i + 1][1]); b[i].w = cvt_pk_bf16(r[2 * i + 1][2], r[2 * i + 1][3]); }
    GAS u32x4* dst = (GAS u32x4*)((GAS bf16_t*)j.WT + (unsigned)((j.nrow0 + 8 * (lane & 7)) * j.K + j.k0 + 8 * (lane >> 3))); const unsigned rs = (unsigned)j.K >> 3;
#pragma unroll
    for (int q = 0; q < 8; ++q) { const unsigned sel = (q & 1) ? 0x07060302u : 0x05040100u; u32x4 o;
        o.x = __builtin_amdgcn_perm(b[1][q >> 1], b[0][q >> 1], sel); o.y = __builtin_amdgcn_perm(b[3][q >> 1], b[2][q >> 1], sel);
        o.z = __builtin_amdgcn_perm(b[5][q >> 1], b[4][q >> 1], sel); o.w = __builtin_amdgcn_perm(b[7][q >> 1], b[6][q >> 1], sel);
        dst[q * rs] = o; } }
__device__ __forceinline__ void cvt8_load(const CvtJob& j, int lane, f32x4 (&r)[16]) { const GAS f32x4* src = (const GAS f32x4*)((const GAS float*)j.W + (unsigned)((j.k0 + 16 * (lane >> 3)) * j.N + j.n0 + 4 * (lane & 7)));
    const unsigned rs = (unsigned)j.N >> 2;
#pragma unroll
    for (int i = 0; i < 16; ++i) r[i] = src[i * rs]; }
__device__ __forceinline__ void cvt8_store(const CvtJob& j, int lane, const f32x4 (&r)[16]) {
    GAS u32x4* dst = (GAS u32x4*)((GAS unsigned char*)j.WT + (unsigned)((j.nrow0 + 4 * (lane & 7)) * j.K + j.k0 + 16 * (lane >> 3))); const unsigned rs = (unsigned)j.K >> 4;
#pragma unroll
    for (int n = 0; n < 4; ++n) { u32x4 o;
        o.x = pk4_fp8(r[0][n] * FP8_SW, r[1][n] * FP8_SW, r[2][n] * FP8_SW, r[3][n] * FP8_SW); o.y = pk4_fp8(r[4][n] * FP8_SW, r[5][n] * FP8_SW, r[6][n] * FP8_SW, r[7][n] * FP8_SW);
        o.z = pk4_fp8(r[8][n] * FP8_SW, r[9][n] * FP8_SW, r[10][n] * FP8_SW, r[11][n] * FP8_SW); o.w = pk4_fp8(r[12][n] * FP8_SW, r[13][n] * FP8_SW, r[14][n] * FP8_SW, r[15][n] * FP8_SW);
        dst[n * rs] = o; } }
constexpr int NB_IN = (FQ_OFF < DIN ? FQ_OFF : DIN) / 64, I_IN = 16 * NB_IN, I_OUT = 16 * 16, I_GU = MOE_FP8 ? 8 * 64 : 16 * 32, I_DN = MOE_FP8 ? 8 * 32 : 16 * 16;
constexpr int N_IN = 2 * I_IN, N_OUT = 2 * I_OUT, N_GU = 2 * NE * I_GU, N_DN = 2 * NE * I_DN, N_CVT = N_IN + N_OUT + N_GU + N_DN;
__device__ __forceinline__ CvtJob cvt_job(const Frame& F, int it, bool& f8) {
    CvtJob j; int r = it; f8 = false;
    if (r < N_IN) { const int l = r / I_IN, q = r % I_IN, kb = q / NB_IN, nb = q % NB_IN; j = CvtJob{F.w_in() + (size_t)l * D * DIN, F.Wt_in() + (size_t)l * DINX * D, DIN, D, 64 * kb, 64 * nb, 64 * nb}; return j; } r -= N_IN;
    if (r < N_OUT) { const int l = r / I_OUT, q = r % I_OUT, kb = q >> 4, nb = q & 15; j = CvtJob{F.w_out() + (size_t)l * D * D, F.Wt_out() + (size_t)l * D * D, D, D, 64 * kb, 64 * nb, 64 * nb}; return j; } r -= N_OUT;
    f8 = MOE_FP8;
    if (r < N_GU) { const int le = r / I_GU, q = r % I_GU; const int kb = MOE_FP8 ? q >> 6 : q >> 5, nb = MOE_FP8 ? q & 63 : q & 31; const int n0 = (MOE_FP8 ? 32 : 64) * nb, bj = n0 >> 10, xx = n0 & 1023;
        j = CvtJob{F.w_gu() + (size_t)le * D * 2048, (bf16_t*)((unsigned char*)F.Wt_gu() + (size_t)le * 2048 * D * (MOE_FP8 ? 1 : 2)), 2048, D, (MOE_FP8 ? 128 : 64) * kb, n0, 256 * (xx >> 7) + 64 * ((xx & 127) >> 5) + 32 * bj + (xx & 31)}; return j; } r -= N_GU;
    { const int le = r / I_DN, q = r % I_DN; const int kb = MOE_FP8 ? q >> 5 : q >> 4, nb = MOE_FP8 ? q & 31 : q & 15; const int n0 = (MOE_FP8 ? 32 : 64) * nb;
      j = CvtJob{F.w_dn() + (size_t)le * D * D, (bf16_t*)((unsigned char*)F.Wt_dn() + (size_t)le * D * D * (MOE_FP8 ? 1 : 2)), D, D, (MOE_FP8 ? 128 : 64) * kb, n0, n0}; return j; }
}
__device__ __forceinline__ void cvt_ld(const CvtJob& j, bool f8, int lane, f32x4 (&r)[16]) { if (f8) cvt8_load(j, lane, r); else cvt_load(j, lane, r); }
__device__ __forceinline__ void cvt_st(const CvtJob& j, bool f8, int lane, const f32x4 (&r)[16]) { if (f8) cvt8_store(j, lane, r); else cvt_store(j, lane, r); }
constexpr int WIN_UNITS = (T / 256) * (DINX / 256), WIN_BUSY = WIN_UNITS % 256, DEF_WIN = MOE_FP8 ? 5 : 0, DEF_WOUT = 0;
constexpr int DEF_GT = 0, DEF_DT = 0, GT_WG0 = 128, DT_WG0 = 64;
constexpr int DEF_A = (256 - WIN_BUSY) * NWAVES * DEF_WIN, DEF_B = (256 - 4) * NWAVES * DEF_WOUT, DEF_C0 = DEF_A, DEF_C1 = (256 - GT_WG0) * NWAVES * DEF_GT, DEF_C2 = (256 - DT_WG0) * NWAVES * DEF_DT, DEF_C = DEF_C0 + DEF_C1 + DEF_C2, DEF_TOTAL = DEF_A + DEF_B + DEF_C;
constexpr int CVT_GU0 = N_IN + N_OUT, CVT_GU1 = CVT_GU0 + NE * I_GU;
static_assert(DEF_A + DEF_B <= NE * I_GU && DEF_C <= NE * I_GU, "deferred slices inside one layer's gate/up items");
__device__ __forceinline__ int cvt_remap(int j) { int it = j; if (it >= CVT_GU0) it += DEF_A + DEF_B; if (it >= CVT_GU1) it += DEF_C; return it; }
__device__ __forceinline__ void cvt_run(Frame& F, int first, int stride, int limit, bool remap) {
    int it = first; if (it >= limit) return;
    f32x4 ra[16], rb[16]; bool fa, fb = false; CvtJob ja = cvt_job(F, remap ? cvt_remap(it) : it, fa), jb; cvt_ld(ja, fa, F.lane, ra);
    for (;;) {
        const int itb = it + stride; const bool hb = itb < limit; if (hb) { jb = cvt_job(F, remap ? cvt_remap(itb) : itb, fb); cvt_ld(jb, fb, F.lane, rb); }
        cvt_st(ja, fa, F.lane, ra); if (!hb) break;
        const int ita = itb + stride; const bool ha = ita < limit; if (ha) { ja = cvt_job(F, remap ? cvt_remap(ita) : ita, fa); cvt_ld(ja, fa, F.lane, ra); }
        cvt_st(jb, fb, F.lane, rb); if (!ha) break;
        it = ita;
    }
}
__device__ __forceinline__ int cvt_grab(Frame& F, gu32* ctr) { int v = 0; if (F.lane == 0) v = (int)__hip_atomic_fetch_add((unsigned*)ctr, 1u, RLX_AGENT); return v; }
__device__ __forceinline__ void cvt_run_dyn(Frame& F, int njobs) {
    const int x = F.vcu >> 5, per = (njobs + 7) >> 3, lo = x * per, hi = min(lo + per, njobs); gu32* ctr = F.ctl() + CW_CVT + 64 * x;
#define CVT_IDX(raw) ({ const int i_ = lo + __builtin_amdgcn_readfirstlane(raw); i_ < hi ? i_ : -1; })
    int ga = cvt_grab(F, ctr), gb = cvt_grab(F, ctr);
    const int ia = CVT_IDX(ga); if (ia < 0) return;
    f32x4 ra[16], rb[16]; bool fa, fb = false; CvtJob ja = cvt_job(F, cvt_remap(ia), fa), jb;
    int gc = cvt_grab(F, ctr);
    cvt_ld(ja, fa, F.lane, ra);
    int ib = CVT_IDX(gb);
    for (;;) {
        const int gd = cvt_grab(F, ctr);
        if (ib >= 0) { jb = cvt_job(F, cvt_remap(ib), fb); cvt_ld(jb, fb, F.lane, rb); }
        cvt_st(ja, fa, F.lane, ra); if (ib < 0) break;
        const int ic = CVT_IDX(gc);
        const int ge = cvt_grab(F, ctr);
        if (ic >= 0) { ja = cvt_job(F, cvt_remap(ic), fa); cvt_ld(ja, fa, F.lane, ra); }
        cvt_st(jb, fb, F.lane, rb); if (ic < 0) break;
        ib = CVT_IDX(gd); gc = ge;
    }
#undef CVT_IDX
}
struct Cvt8Bases { const float* wgu; const float* wdn; unsigned char* tgu; unsigned char* tdn; };
__device__ __forceinline__ CvtJob cvt_job8r(const Cvt8Bases& B, int r) {
    const bool dn = r >= N_GU; const int rr = dn ? r - N_GU : r, le = dn ? rr >> 8 : rr >> 9, q = dn ? rr & 255 : rr & 511, kb = dn ? q >> 5 : q >> 6, nb = dn ? q & 31 : q & 63;
    const int n0 = 32 * nb, bj = n0 >> 10, xx = n0 & 1023, N = dn ? D : 2048;
    CvtJob j; j.W = (dn ? B.wdn : B.wgu) + (size_t)le * D * N; j.WT = (bf16_t*)((dn ? B.tdn : B.tgu) + (size_t)le * N * D); j.N = N; j.K = D; j.k0 = 128 * kb; j.n0 = n0;
    j.nrow0 = dn ? n0 : 256 * (xx >> 7) + 64 * ((xx & 127) >> 5) + 32 * bj + (xx & 31); return j; }
static_assert(I_GU == 512 && I_DN == 256, "cvt_job8r shifts");
static_assert(MOE_FP8 == 1, "the gate/up row interleave (per 32 columns) assumes the 32-column e4m3 conversion items");
__device__ __forceinline__ CvtJob cvt_job8(const Cvt8Bases& B, int j8) { int r = j8 + DEF_A + DEF_B; r += (r + N_IN + N_OUT >= CVT_GU1) ? DEF_C : 0; return cvt_job8r(B, r); }
__device__ __forceinline__ void cvt_run8_range(Frame& F, int first, int count) {
    if (count <= 0) return;
    const Cvt8Bases B{F.w_gu(), F.w_dn(), (unsigned char*)F.Wt_gu(), (unsigned char*)F.Wt_dn()};
    f32x4 ra[16], rb[16]; CvtJob ja = cvt_job8r(B, first), jb; cvt8_load(ja, F.lane, ra);
#pragma unroll 1
    for (int k = 0; k < count; k += 2) {
        jb = cvt_job8r(B, first + min(k + 1, count - 1)); cvt8_load(jb, F.lane, rb);
        cvt8_store(ja, F.lane, ra);
        ja = cvt_job8r(B, first + min(k + 2, count - 1)); cvt8_load(ja, F.lane, ra);
        cvt8_store(jb, F.lane, rb);
    }
}
__device__ __forceinline__ void cvt_run8(Frame& F, int gw, int ngw) {
    constexpr int NJ8 = N_GU + N_DN - DEF_TOTAL; if (gw >= NJ8) return;
    const Cvt8Bases B{F.w_gu(), F.w_dn(), (unsigned char*)F.Wt_gu(), (unsigned char*)F.Wt_dn()};
    const int trips = (NJ8 + ngw - 1) / ngw, klast = (NJ8 - 1 - gw) / ngw;
    f32x4 ra[16], rb[16]; CvtJob ja = cvt_job8(B, gw), jb; cvt8_load(ja, F.lane, ra);
#pragma unroll 1
    for (int k = 0; k < trips; k += 2) {
        jb = cvt_job8(B, gw + min(k + 1, klast) * ngw); cvt8_load(jb, F.lane, rb);
        cvt8_store(ja, F.lane, ra);
        ja = cvt_job8(B, gw + min(k + 2, klast) * ngw); cvt8_load(ja, F.lane, ra);
        cvt8_store(jb, F.lane, rb);
    }
}
__device__ __forceinline__ void cvt_deferred(Frame& F, int base, int slot, int per_wave) { if (per_wave == 0) return; const int first = base + (slot * NWAVES + F.wave) * per_wave;
    if (MOE_FP8) cvt_run8_range(F, first - CVT_GU0, per_wave); else cvt_run(F, first, 1, first + per_wave, false); }
__device__ __forceinline__ void ph_prologue(Frame& F) {
    const int gw = F.vcu * NWAVES + F.wave, NGW = F.G * NWAVES;
    for (int i = gw * 64 + F.lane; i < 1024; i += NGW * 64) { const float a = F.lbp()[i], b = F.lbp()[1024 + i], m = fmaxf(a, b), ea = __expf(a - m), eb = __expf(b - m); F.LB()[i] = 0.f; F.LB()[1024 + i] = eb / (ea + eb); }
    if (F.bid < 192) {
        LAS float* sc = (LAS float*)(F.lds); LAS float* part = sc + 2048;
        { const float* c = F.c(); const float* cc = F.cctx(); for (int i = F.tid; i < D; i += NTHR) { const float a = c[i], b = cc[i]; sc[i] = a * fsigm(a); sc[D + i] = b * fsigm(b); } }
        __syncthreads();
        const int l = F.bid / 96, q = F.lane & 15, rg = F.lane >> 4, rbase = 128 * F.wave + 32 * rg; const GAS f32x4* W = (const GAS f32x4*)((const GAS float*)F.w_ada() + (unsigned)(l * D * 6144 + rbase * 6144 + (F.bid % 96) * 64 + 4 * q));
        f32x4 a0 = (f32x4){0.f, 0.f, 0.f, 0.f}, a1 = a0;
#pragma unroll
        for (int hb = 0; hb < 2; ++hb) { f32x4 wv[16];
#pragma unroll
            for (int i = 0; i < 16; ++i) wv[i] = W[(unsigned)(16 * hb + i) * 1536u];
#pragma unroll
            for (int i = 0; i < 16; ++i) { a0 += sc[rbase + 16 * hb + i] * wv[i]; a1 += sc[D + rbase + 16 * hb + i] * wv[i]; } }
#pragma unroll
        for (int c = 0; c < 4; ++c) { a0[c] += lane_xor(a0[c], 16, F.lane); a0[c] += lane_xor(a0[c], 32, F.lane); a1[c] += lane_xor(a1[c], 16, F.lane); a1[c] += lane_xor(a1[c], 32, F.lane); }
        if (rg == 0) { *(LAS f32x4*)(part + (F.wave * 2 + 0) * 64 + 4 * q) = a0; *(LAS f32x4*)(part + (F.wave * 2 + 1) * 64 + 4 * q) = a1; }
        __syncthreads();
        if (F.tid < 128) { const int which = F.tid >> 6, col = F.tid & 63; float s = 0.f;
#pragma unroll
            for (int w = 0; w < 8; ++w) s += part[(w * 2 + which) * 64 + col];
            const int j = (F.bid % 96) * 64 + col; F.MOD()[(size_t)(l * 2 + which) * 6144 + j] = s + F.b_ada()[l * 6144 + j]; }
        asm volatile("s_waitcnt vmcnt(0)" ::: "memory");
        __syncthreads();
        if (F.tid == 0) { __builtin_amdgcn_fence(__ATOMIC_RELEASE, "agent"); (void)__hip_atomic_fetch_add((unsigned*)(F.ctl() + CW_ADA), 1u, RLX_AGENT); }
    }
    cvt_run(F, gw, NGW, N_IN + N_OUT, false);
    if (MOE_FP8) cvt_run8(F, gw, NGW); else cvt_run(F, N_IN + N_OUT + gw, NGW, N_CVT, false);
}
__device__ __forceinline__ void row_load(const float* xrow, int lane, f32x4 (&v)[4]) { const GAS f32x4* xr = (const GAS f32x4*)xrow + lane;
#pragma unroll
    for (int j = 0; j < 4; ++j) v[j] = xr[64 * j]; }
__device__ __forceinline__ float row_rstd(const f32x4 (&v)[4], int lane) { float s = 0.f;
#pragma unroll
    for (int j = 0; j < 4; ++j) s += (v[j].x * v[j].x + v[j].y * v[j].y) + (v[j].z * v[j].z + v[j].w * v[j].w);
    return rsqrtf(wave_sum(s, lane) * (1.f / D) + 1e-6f); }
__device__ __forceinline__ void row_modulate(const f32x4 (&v)[4], float r, const float* g, const float* sc, const float* sh, int lane, f32x4 (&hv)[4]) {
#pragma unroll
    for (int j = 0; j < 4; ++j) { const f32x4 gg = ((const GAS f32x4*)g)[lane + 64 * j], s1 = ((const GAS f32x4*)sc)[lane + 64 * j], s0 = ((const GAS f32x4*)sh)[lane + 64 * j];
        hv[j] = v[j] * r * gg * (s1 + 1.f) + s0; } }
__device__ __forceinline__ void row_store_fp8(unsigned char* orow, int lane, const f32x4 (&hv)[4]) { GAS unsigned* o4 = (GAS unsigned*)orow + lane;
#pragma unroll
    for (int j = 0; j < 4; ++j) o4[64 * j] = pk4_fp8(hv[j].x * FP8_SH, hv[j].y * FP8_SH, hv[j].z * FP8_SH, hv[j].w * FP8_SH); }
__device__ __forceinline__ void row_store_bf16(bf16_t* orow, int lane, const f32x4 (&hv)[4]) { GAS u32x2* o8 = (GAS u32x2*)orow + lane;
#pragma unroll
    for (int j = 0; j < 4; ++j) { u32x2 w; w.x = pk2(hv[j].x, hv[j].y); w.y = pk2(hv[j].z, hv[j].w); o8[64 * j] = w; } }

__device__ __forceinline__ void ph_mod1_wait(Frame& F) {
    if (F.tid == 0) { unsigned* fl = (unsigned*)(F.ctl() + CW_ADA); unsigned sp = 0;
        while (xb_ld(fl) < 192u) { __builtin_amdgcn_s_sleep(2); if (++sp > (1u << 20)) break; }
        __builtin_amdgcn_fence(__ATOMIC_ACQUIRE, "agent"); }
    __syncthreads();
}
__device__ __forceinline__ void ph_mod1(Frame& F, int l) {
    const int gw = F.vcu * NWAVES + F.wave, NGW = F.G * NWAVES; int ln = F.lane; asm volatile("" : "+v"(ln));
    const float* ml = F.MOD() + (size_t)(l * 2) * 6144; f32x4 cg[4], cs[4];
#pragma unroll
    for (int j = 0; j < 4; ++j) { const f32x4 gg = ((const GAS f32x4*)(F.norm1_g() + l * D))[ln + 64 * j], s1 = ((const GAS f32x4*)(ml + D))[ln + 64 * j]; cg[j] = gg * (s1 + 1.f); cs[j] = ((const GAS f32x4*)ml)[ln + 64 * j]; }
#pragma unroll 1
    for (int ra = gw; ra < T; ra += 2 * NGW) { const int rb = ra + NGW; const bool hasb = rb < T; const int rbc = hasb ? rb : ra;
        const float* xa = l == 0 ? (ra < CTX ? F.ctxin() + (size_t)ra * D : F.x() + (size_t)(ra - CTX) * D) : F.X() + (size_t)ra * D;
        const float* xb = l == 0 ? (rbc < CTX ? F.ctxin() + (size_t)rbc * D : F.x() + (size_t)(rbc - CTX) * D) : F.X() + (size_t)rbc * D;
        f32x4 va[4], vb[4], hv[4]; row_load(xa, ln, va); row_load(xb, ln, vb);
        { const float r = row_rstd(va, ln);
          if (ra < CTX) { const float* m = ml + 6144; row_modulate(va, r, F.norm1_g() + l * D, m + D, m, ln, hv); }
          else {
#pragma unroll
              for (int j = 0; j < 4; ++j) hv[j] = va[j] * r * cg[j] + cs[j]; }
          row_store_bf16(F.H() + (size_t)ra * D, ln, hv); }
        if (hasb) { const float r = row_rstd(vb, ln);
#pragma unroll
            for (int j = 0; j < 4; ++j) hv[j] = vb[j] * r * cg[j] + cs[j];
            row_store_bf16(F.H() + (size_t)rb * D, ln, hv); }
    }
}

constexpr int RA_ST = 2064, RA_HALF = 16 * RA_ST, RA_BUF = 2 * RA_HALF;
constexpr int RLG_OFF = 2 * RA_BUF, RSCR_OFF = RLG_OFF + 8592;
static_assert(8 * 80 * 32 * 4 <= RLG_OFF && 65 * 33 * 4 <= 8592 && RSCR_OFF + 3520 <= MISC_OFF && RSCR_OFF % 16 == 0, "router LDS map");
__device__ __forceinline__ void split2(float a, float b, unsigned& hi, unsigned& lo) { hi = cvt_pk_bf16(a, b); lo = cvt_pk_bf16(a - bflo(hi), b - bfhi(hi)); }
__device__ __forceinline__ void ph_mod2_route(Frame& F, int l, int cbank) {
    LAS unsigned char* L = F.lds + RING_OFF; LAS float* LG = (LAS float*)(L + RLG_OFF);
    LAS int* lcnt = (LAS int*)(L + RSCR_OFF); LAS int* lbase = lcnt + 32; LAS int* te = lbase + 32; LAS float* tw = (LAS float*)(te + 272); LAS int* trk = (LAS int*)(tw + 272);
    int ln = F.lane; asm volatile("" : "+v"(ln)); const int w = F.wave, fr = ln & 15, g = ln >> 4;
    __syncthreads();
    if (F.tid < 32) lcnt[F.tid] = 0;
    const int row0 = F.bid * 65;
    const float* Xp = F.X(); const float* n2g = F.norm2_g() + l * D; const float* modl = F.MOD() + (size_t)(l * 2) * 6144; bf16_t* Hp = F.H(); unsigned char* H8p = F.ws + WS_H8;
    f32x4 v[2][4];
#pragma unroll
    for (int i = 0; i < 2; ++i) row_load(Xp + (size_t)(row0 + min(2 * w + i, 64)) * D, ln, v[i]);
    bf16x8 Bh[4][2], Bl[4][2];
    { const GAS float* rw = (const GAS float*)F.router_w() + (unsigned)(l * D * NE + (128 * w + 8 * g) * NE + fr);
      float xw[4][2][8];
#pragma unroll
      for (int s_ = 0; s_ < 4; ++s_)
#pragma unroll
          for (int nb = 0; nb < 2; ++nb)
#pragma unroll
              for (int i = 0; i < 8; ++i) xw[s_][nb][i] = rw[(32 * s_ + i) * NE + 16 * nb];
      __builtin_amdgcn_sched_barrier(0);
#pragma unroll
      for (int s_ = 0; s_ < 4; ++s_)
#pragma unroll
          for (int nb = 0; nb < 2; ++nb) { const float (&x)[8] = xw[s_][nb];
              unsigned h_[4], l_[4]; split2(x[0], x[1], h_[0], l_[0]); split2(x[2], x[3], h_[1], l_[1]); split2(x[4], x[5], h_[2], l_[2]); split2(x[6], x[7], h_[3], l_[3]); const u32x4 hi = (u32x4){h_[0], h_[1], h_[2], h_[3]}, lo = (u32x4){l_[0], l_[1], l_[2], l_[3]};
              Bh[s_][nb] = __builtin_bit_cast(bf16x8, hi); Bl[s_][nb] = __builtin_bit_cast(bf16x8, lo); } }
    f32x4 acc[5][2];
#pragma unroll
    for (int b = 0; b < 5; ++b) { acc[b][0] = (f32x4){0.f, 0.f, 0.f, 0.f}; acc[b][1] = (f32x4){0.f, 0.f, 0.f, 0.f}; }
    const bool alllat = row0 >= CTX; f32x4 cg[4], cs[4];
#pragma unroll
    for (int j = 0; j < 4; ++j) { const f32x4 gg = ((const GAS f32x4*)n2g)[ln + 64 * j], s1 = ((const GAS f32x4*)(modl + 4 * D))[ln + 64 * j]; cg[j] = gg * (s1 + 1.f); cs[j] = ((const GAS f32x4*)(modl + 3 * D))[ln + 64 * j]; }
#pragma unroll
    for (int b = 0; b < 5; ++b) {
        LAS unsigned char* Ab = L + (b & 1) * RA_BUF;
#pragma unroll
        for (int i = 0; i < 2; ++i) { const int lr = 16 * b + 2 * w + i, row = row0 + min(lr, 64); const float* m = modl + (row < CTX ? 6144 : 0);
            const float rs = row_rstd(v[i], ln); f32x4 h[4];
            if (alllat) {
#pragma unroll
                for (int j = 0; j < 4; ++j) h[j] = v[i][j] * rs * cg[j] + cs[j]; }
            else row_modulate(v[i], rs, n2g, m + 4 * D, m + 3 * D, ln, h);
            if (lr < 65) { if (MOE_FP8) row_store_fp8(H8p + (size_t)row * D, ln, h); else row_store_bf16(Hp + (size_t)row * D, ln, h); }
#pragma unroll
            for (int j = 0; j < 4; ++j) { unsigned h0, l0, h1, l1; split2(h[j].x, h[j].y, h0, l0); split2(h[j].z, h[j].w, h1, l1); const u32x2 hi = (u32x2){h0, h1}, lo = (u32x2){l0, l1};
                LAS unsigned char* ap = Ab + (2 * w + i) * RA_ST + (4 * ln + 256 * j) * 2; *(LAS u32x2*)ap = hi; *(LAS u32x2*)(ap + RA_HALF) = lo; } }
        if (b < 4) {
#pragma unroll
            for (int i = 0; i < 2; ++i) row_load(Xp + (size_t)(row0 + min(16 * (b + 1) + 2 * w + i, 64)) * D, ln, v[i]); }
        __syncthreads();
#pragma unroll
        for (int s_ = 0; s_ < 4; ++s_) { const LAS unsigned char* ap = Ab + fr * RA_ST + (128 * w + 32 * s_ + 8 * g) * 2; const bf16x8 ah = *(const LAS bf16x8*)ap, al = *(const LAS bf16x8*)(ap + RA_HALF);
#pragma unroll
            for (int nb = 0; nb < 2; ++nb) { f32x4 c = acc[b][nb]; c = __builtin_amdgcn_mfma_f32_16x16x32_bf16(ah, Bh[s_][nb], c, 0, 0, 0); c = __builtin_amdgcn_mfma_f32_16x16x32_bf16(ah, Bl[s_][nb], c, 0, 0, 0);
                c = __builtin_amdgcn_mfma_f32_16x16x32_bf16(al, Bh[s_][nb], c, 0, 0, 0); acc[b][nb] = c; } }
    }
    __syncthreads();
    { LAS float* PT = (LAS float*)L;
#pragma unroll
      for (int b = 0; b < 5; ++b)
#pragma unroll
          for (int nb = 0; nb < 2; ++nb)
#pragma unroll
              for (int r = 0; r < 4; ++r) PT[(w * 80 + 16 * b + 4 * g + r) * 32 + 16 * nb + fr] = acc[b][nb][r];
      __syncthreads();
      const float rbias = F.router_b()[l * NE + (F.tid & 31)];
      for (int i = F.tid; i < 65 * 32; i += NTHR) { const int row = i >> 5, e = i & 31; float sacc = rbias, pt[8];
#pragma unroll
          for (int w2 = 0; w2 < 8; ++w2) pt[w2] = PT[(w2 * 80 + row) * 32 + e];
          __builtin_amdgcn_sched_barrier(0);
#pragma unroll
          for (int w2 = 0; w2 < 8; ++w2) sacc += pt[w2];
          LG[row * 33 + e] = sacc; } }
    __syncthreads();
    if (F.tid < 65) { const int row = F.tid; float bv[4] = {-3.0e38f, -3.0e38f, -3.0e38f, -3.0e38f}; int bi[4] = {0, 0, 0, 0}; float lgv[32];
#pragma unroll
        for (int e = 0; e < 32; ++e) lgv[e] = LG[row * 33 + e];
        __builtin_amdgcn_sched_barrier(0);
#pragma unroll
        for (int e = 0; e < 32; ++e) { const float x = lgv[e]; const bool c0 = x > bv[0], c1 = x > bv[1], c2 = x > bv[2], c3 = x > bv[3];
            bv[3] = c2 ? bv[2] : (c3 ? x : bv[3]); bi[3] = c2 ? bi[2] : (c3 ? e : bi[3]); bv[2] = c1 ? bv[1] : (c2 ? x : bv[2]); bi[2] = c1 ? bi[1] : (c2 ? e : bi[2]);
            bv[1] = c0 ? bv[0] : (c1 ? x : bv[1]); bi[1] = c0 ? bi[0] : (c1 ? e : bi[1]); bv[0] = c0 ? x : bv[0]; bi[0] = c0 ? e : bi[0]; }
        float ex[4], sum = 0.f;
#pragma unroll
        for (int q = 0; q < 4; ++q) { ex[q] = __expf(bv[q] - bv[0]); sum += ex[q]; }
        const float inv = 1.f / sum;
#pragma unroll
        for (int q = 0; q < 4; ++q) { te[row * 4 + q] = bi[q]; tw[row * 4 + q] = ex[q] * inv; trk[row * 4 + q] = (int)__hip_atomic_fetch_add((LAS unsigned*)&lcnt[bi[q]], 1u, __ATOMIC_RELAXED, __HIP_MEMORY_SCOPE_WORKGROUP); } }
    __syncthreads();
    if (F.tid < 32) lbase[F.tid] = (int)__hip_atomic_fetch_add((unsigned*)(F.ctl() + CW_CNT + (cbank * 32 + F.tid) * 64), (unsigned)lcnt[F.tid], RLX_AGENT);
    __syncthreads();
    for (int i = F.tid; i < 65 * 4; i += NTHR) { const int row = row0 + (i >> 2), e = te[i], pos = lbase[e] + trk[i];
        F.TOPI()[row * 4 + (i & 3)] = e; F.TOPW()[row * 4 + (i & 3)] = tw[i]; F.POS()[row * 4 + (i & 3)] = pos; F.LISTE()[(size_t)e * T + pos] = row; }
    __syncthreads();
}

__device__ __forceinline__ int moe_tiles(Frame& F, int l, bool fresh = true) {
    LAS int* tinfo = (LAS int*)(F.lds + TINFO_OFF); LAS int* bt = (LAS int*)(F.lds + BT_OFF); LAS int* cn = bt + 32; LAS int* ntl = bt + 64;
    if (!fresh) return ntl[0];
    __syncthreads();
    if (F.tid < 64) {
        const int e = F.lane & 31; const int c = (int)__hip_atomic_load(F.ctl() + CW_CNT + (l * 32 + e) * 64, RLX_AGENT); const int nt = (c + 255) >> 8;
        int incl = nt;
#pragma unroll
        for (int o = 1; o < 32; o <<= 1) { const int t = lane_get(incl, (F.lane - o) & 63); if (e >= o) incl += t; }
        const int first = incl - nt;
        if (F.lane < 32) { bt[e] = first; cn[e] = c; for (int j = 0; j < nt; ++j) { LAS int* ti = tinfo + 4 * (first + j); ti[0] = e; ti[1] = 0; ti[2] = 256 * j; ti[3] = min(256, c - 256 * j); } if (e == 31) ntl[0] = incl; }
    }
    __syncthreads();
    return ntl[0];
}

__device__ __forceinline__ void ph_gateup(Frame& F, int l) {
    const int ntiles = moe_tiles(F, l); constexpr int EB = MOE_FP8 ? 1 : 2;
    LAS int* tinfo = (LAS int*)(F.lds + TINFO_OFF); LAS unsigned* rowoff = (LAS unsigned*)(F.lds + ROWOFF_OFF);
    MoeOrder<true> S; S.tinfo = tinfo; S.rowoff = rowoff; S.ntiles = ntiles; S.nN = 8; S.G = F.G; S.c = F.vcu; S.Kb = D * EB; S.W = (const char*)F.Wt_gu() + (size_t)l * NE * 2048 * D * EB; S.wstride = (size_t)2048 * D * EB;
    { const int nun = min(10, max(0, (ntiles * 8 - S.c + S.G - 1) / S.G));
      if (F.tid < 256) { int tk[10];
#pragma unroll
          for (int i = 0; i < 10; ++i) { tk[i] = 0; if (i < nun) { const int pm = (i * S.G + S.c) >> 3; const int e = tinfo[4 * pm], pos0 = tinfo[4 * pm + 2], valid = tinfo[4 * pm + 3]; if (F.tid < valid) tk[i] = F.LISTE()[(size_t)e * T + pos0 + F.tid]; } }
#pragma unroll
          for (int i = 0; i < 10; ++i) if (i < nun) rowoff[i * 256 + F.tid] = (unsigned)tk[i] * (unsigned)(D * EB); } }
    __syncthreads();
    if constexpr (MOE_FP8) { EpiAct8 E{(unsigned char*)F.ACT(), F.b_gu() + (size_t)l * NE * 2048};
        pg8::gemm_phase<EpiAct8, MoeOrder<true>, true, true>(F.lds + RING_OFF, (const char*)(F.ws + WS_H8), D, S, E, F.tid);
        if (l == 0 && F.vcu >= GT_WG0) cvt_deferred(F, CVT_GU1 + DEF_C0, F.vcu - GT_WG0, DEF_GT); }
    else { EpiAct E{F.ACT(), F.b_gu() + (size_t)l * NE * 2048};
        pg8::gemm_phase<EpiAct, MoeOrder<true>, true, false>(F.lds + RING_OFF, (const char*)F.H(), 2 * D, S, E, F.tid); }
}
__device__ __forceinline__ void ph_down(Frame& F, int l) {
    const int ntiles = moe_tiles(F, l, false); constexpr int EB = MOE_FP8 ? 1 : 2;
    MoeOrder<false> S; S.tinfo = (LAS int*)(F.lds + TINFO_OFF); S.rowoff = nullptr; S.ntiles = ntiles; S.nN = 4; S.G = F.G; S.c = F.vcu; S.Kb = D * EB; S.W = (const char*)F.Wt_dn() + (size_t)l * NE * D * D * EB; S.wstride = (size_t)D * D * EB;
    if constexpr (MOE_FP8) { EpiY8 E{F.Y(), F.b_dn() + (size_t)l * NE * D};
        pg8::gemm_phase<EpiY8, MoeOrder<false>, true, true>(F.lds + RING_OFF, (const char*)F.ACT(), D, S, E, F.tid);
        if (l == 0 && F.vcu >= DT_WG0) cvt_deferred(F, CVT_GU1 + DEF_C0 + DEF_C1, F.vcu - DT_WG0, DEF_DT); }
    else { EpiY E{F.Y(), F.b_dn() + (size_t)l * NE * D};
        pg8::gemm_phase<EpiY, MoeOrder<false>, true, false>(F.lds + RING_OFF, (const char*)F.ACT(), 2 * D, S, E, F.tid); }
}
__device__ __forceinline__ void ph_win(Frame& F, int l) {
    DenseOrder S; S.init(T / 256, DINX / 256, F.G, F.bid, 2 * D, F.Wt_in() + (size_t)l * DINX * D);
    EpiP E{F.P(), DINX, F.LB() + l * 1024};
    pg8::gemm_phase<EpiP, DenseOrder, true>(F.lds + RING_OFF, (const char*)F.H(), 2 * D, S, E, F.tid);
    if (F.bid >= WIN_BUSY) cvt_deferred(F, l == 0 ? CVT_GU0 : CVT_GU1, F.bid - WIN_BUSY, DEF_WIN);
}
__device__ __forceinline__ void wout_ctx(Frame& F, int l) {
    int ln = F.lane; asm volatile("" : "+v"(ln)); const int w = F.wave, fr = ln & 15, g = ln >> 4, rb = F.bid >> 4, cbk = F.bid & 15;
    const GAS bf16x8* ap = (const GAS bf16x8*)((const GAS bf16_t*)F.CAT() + (unsigned)((16 * rb + fr) * D + 128 * w + 8 * g));
    const GAS bf16x8* bp = (const GAS bf16x8*)((const GAS bf16_t*)F.Wt_out() + (unsigned)(l * D * D + (64 * cbk + fr) * D + 128 * w + 8 * g));
    bf16x8 a[4], b[4][4];
#pragma unroll
    for (int s_ = 0; s_ < 4; ++s_) { a[s_] = ap[4 * s_];
#pragma unroll
        for (int nb = 0; nb < 4; ++nb) b[nb][s_] = bp[(unsigned)(nb * 16 * D / 8) + 4 * s_]; }
    f32x4 acc[4];
#pragma unroll
    for (int nb = 0; nb < 4; ++nb) { acc[nb] = (f32x4){0.f, 0.f, 0.f, 0.f};
#pragma unroll
        for (int s_ = 0; s_ < 4; ++s_) acc[nb] = __builtin_amdgcn_mfma_f32_16x16x32_bf16(a[s_], b[nb][s_], acc[nb], 0, 0, 0); }
    LAS float* PT = (LAS float*)(F.lds + RING_OFF);
    __syncthreads();
#pragma unroll
    for (int nb = 0; nb < 4; ++nb)
#pragma unroll
        for (int r = 0; r < 4; ++r) PT[(w * 16 + 4 * g + r) * 64 + 16 * nb + fr] = acc[nb][r];
    __syncthreads();
    const float* m = F.MOD() + (size_t)(l * 2) * 6144; const float* gate = m + 6144 + 2 * D; const float* base = l == 0 ? F.ctxin() : F.X();
    float bs[2], gs[2], pt[2][8];
#pragma unroll
    for (int i = 0; i < 2; ++i) { const int o = F.tid + NTHR * i, row = o >> 6, col = o & 63, gr = 16 * rb + row, gc = 64 * cbk + col; bs[i] = base[(size_t)gr * D + gc]; gs[i] = gate[gc];
#pragma unroll
        for (int w2 = 0; w2 < 8; ++w2) pt[i][w2] = PT[(w2 * 16 + row) * 64 + col]; }
    __builtin_amdgcn_sched_barrier(0);
#pragma unroll
    for (int i = 0; i < 2; ++i) { const int o = F.tid + NTHR * i, row = o >> 6, col = o & 63; float sacc = 0.f;
#pragma unroll
        for (int w2 = 0; w2 < 8; ++w2) sacc += pt[i][w2];
        const int gr = 16 * rb + row, gc = 64 * cbk + col; F.X()[(size_t)gr * D + gc] = bs[i] + gs[i] * sacc; }
    __syncthreads();
}
__device__ __forceinline__ void ph_wout(Frame& F, int l) {
    DenseOrder S; S.init(LAT / 256, D / 256, F.G, F.bid, 2 * D, F.Wt_out() + (size_t)l * D * D, 1);
    const float* m = F.MOD() + (size_t)(l * 2) * 6144;
    EpiRes E{l == 0 ? F.ctxin() : F.X(), l == 0 ? F.x() : F.X() + (size_t)CTX * D, m + 6144 + 2 * D, m + 2 * D, F.X()};
    pg8::gemm_phase<EpiRes, DenseOrder, true>(F.lds + RING_OFF, (const char*)F.CAT(), 2 * D, S, E, F.tid);
    if (l == 0) wout_ctx(F, l);
}
__device__ __forceinline__ void combine_gather(const Frame& F, const LAS int* bt, int row, int ln, f32x4 (&v)[4], u32x2 (&y)[4][4], float (&w)[4]) {
    row_load(F.X() + (size_t)row * D, ln, v);
    const GAS int* ti = (const GAS int*)F.TOPI() + (unsigned)(row * 4); const GAS float* tw = (const GAS float*)F.TOPW() + (unsigned)(row * 4); const GAS int* tp = (const GAS int*)F.POS() + (unsigned)(row * 4);
#pragma unroll
    for (int q = 0; q < 4; ++q) { const int e = ti[q]; w[q] = tw[q]; const int srow = 256 * bt[e] + tp[q]; const GAS u32x2* yr = (const GAS u32x2*)((const GAS bf16_t*)F.Y() + (unsigned)srow * (unsigned)D) + ln;
#pragma unroll
        for (int j = 0; j < 4; ++j) y[q][j] = yr[64 * j]; }
}
struct CombCoef { f32x4 gt[4], cg[4], cs[4]; };
__device__ __forceinline__ void combine_finish(const Frame& F, const CombCoef& C, int l, int row, int ln, f32x4 (&v)[4], const u32x2 (&y)[4][4], const float (&w)[4]) {
    const bool ctx = row < CTX; const float* m = F.MOD() + (size_t)(l * 2 + 1) * 6144 + 5 * D;
#pragma unroll
    for (int j = 0; j < 4; ++j) { f32x4 s = (f32x4){0.f, 0.f, 0.f, 0.f};
#pragma unroll
        for (int q = 0; q < 4; ++q) s += w[q] * (f32x4){bflo(y[q][j].x), bfhi(y[q][j].x), bflo(y[q][j].y), bfhi(y[q][j].y)};
        v[j] += (ctx ? ((const GAS f32x4*)m)[ln + 64 * j] : C.gt[j]) * s; }
    const float r = row_rstd(v, ln);
    if (l == 0) {
        GAS f32x4* xo = (GAS f32x4*)(F.X() + (size_t)row * D) + ln;
#pragma unroll
        for (int j = 0; j < 4; ++j) xo[64 * j] = v[j];
        f32x4 hv[4];
        if (ctx) { const float* m1 = F.MOD() + (size_t)3 * 6144; row_modulate(v, r, F.norm1_g() + D, m1 + D, m1, ln, hv); }
        else {
#pragma unroll
            for (int j = 0; j < 4; ++j) hv[j] = v[j] * r * C.cg[j] + C.cs[j]; }
        row_store_bf16(F.H() + (size_t)row * D, ln, hv);
    } else {
        GAS f32x4* o = (GAS f32x4*)(F.out() + (size_t)(row - CTX) * D) + ln;
#pragma unroll
        for (int j = 0; j < 4; ++j) o[64 * j] = v[j] * r * C.cg[j];
    }
}
__device__ __forceinline__ void ph_combine(Frame& F, int l) {
    (void)moe_tiles(F, l, false);
    const LAS int* bt = (const LAS int*)(F.lds + BT_OFF);
    const int gw = F.vcu * NWAVES + F.wave, NGW = F.G * NWAVES; const int rbeg = l == 1 ? CTX : 0;
    CombCoef C;
    { int l0 = F.lane; asm volatile("" : "+v"(l0)); const float* mg = F.MOD() + (size_t)(l * 2) * 6144 + 5 * D; const float* m1 = F.MOD() + (size_t)2 * 6144;
#pragma unroll
      for (int j = 0; j < 4; ++j) { C.gt[j] = ((const GAS f32x4*)mg)[l0 + 64 * j];
          if (l == 0) { const f32x4 gg = ((const GAS f32x4*)(F.norm1_g() + D))[l0 + 64 * j], s1 = ((const GAS f32x4*)(m1 + D))[l0 + 64 * j]; C.cg[j] = gg * (s1 + 1.f); C.cs[j] = ((const GAS f32x4*)m1)[l0 + 64 * j]; }
          else { C.cg[j] = ((const GAS f32x4*)F.fng())[l0 + 64 * j]; C.cs[j] = (f32x4){0.f, 0.f, 0.f, 0.f}; } } }
#pragma unroll 1
    for (int ra = rbeg + gw; ra < T; ra += 2 * NGW) {
        int ln = F.lane; asm volatile("" : "+v"(ln));
        const int rb = ra + NGW; const bool hasb = rb < T; const int rbc = hasb ? rb : ra;
        f32x4 va[4], vb[4]; u32x2 ya[4][4], yb[4][4]; float wa[4], wb[4];
        combine_gather(F, bt, ra, ln, va, ya, wa); combine_gather(F, bt, rbc, ln, vb, yb, wb);
        combine_finish(F, C, l, ra, ln, va, ya, wa);
        if (hasb) combine_finish(F, C, l, rb, ln, vb, yb, wb);
    }
}
constexpr size_t WF_MA = 0, WF_MB = 128 * 1024, WF_MC = 256 * 1024, WF_PW = 512 * 1024;
constexpr int ZS = 528;
__device__ __forceinline__ f32x4 mfma16(bf16x8 a, bf16x8 b, f32x4 c) { return __builtin_amdgcn_mfma_f32_16x16x32_bf16(a, b, c, 0, 0, 0); }

__device__ __forceinline__ void ph_prologue2(Frame& F) {
    bf16_t* MA = (bf16_t*)(F.ws + WS_WF + WF_MA); bf16_t* MB = (bf16_t*)(F.ws + WS_WF + WF_MB); bf16_t* MC = (bf16_t*)(F.ws + WS_WF + WF_MC); bf16_t* PW = (bf16_t*)(F.ws + WS_WF + WF_PW);
    const int gt = F.bid * NTHR + F.tid, NT = F.G * NTHR;
    for (int i = gt; i < 256 * 256; i += NT) { const int r = i >> 8, cidx = i & 255, ri = r >> 7, k1 = r & 127, rj = cidx >> 7, t1 = cidx & 127; const float x = 2.f * (float)((k1 * t1) & 127) / 128.f;
        const float cs = cospif(x), sn = sinpif(x); const float v = ri == 0 ? (rj == 0 ? cs : -sn) : (rj == 0 ? -sn : -cs); MA[i] = (bf16_t)f2bf(v); }
    for (int i = gt; i < 128 * 256; i += NT) { const int k2 = i >> 8, cidx = i & 255, rj = cidx >> 7, t2 = cidx & 127; const float x = 2.f * (float)((k2 * t2) & 127) / 128.f; MB[i] = (bf16_t)f2bf(rj == 0 ? cospif(x) : sinpif(x)); }
    for (int i = gt; i < 256 * 512; i += NT) { const int k = i >> 9, cidx = i & 511, rj = cidx >> 8, t = cidx & 255; const float x = 2.f * (float)((k * t) & 255) / 256.f; MC[i] = (bf16_t)f2bf(rj == 0 ? cospif(x) : -sinpif(x)); }
    for (int i = gt; i < 2 * 4 * 64 * 64; i += NT) { const int lg = i >> 12, j = (i >> 6) & 63, ii = i & 63; PW[i] = (bf16_t)f2bf(F.pool_w()[(size_t)lg * 4096 + ii * 64 + j]); }
    LAS float* m12T = (LAS float*)(F.lds);
    LAS float* trig = (LAS float*)(F.lds + 33280);
    LAS float* fws = (LAS float*)(F.lds + 33280 + 512);
    __syncthreads();
    if (F.tid < 64) { trig[F.tid] = cospif(2.f * (float)F.tid / 64.f); trig[64 + F.tid] = sinpif(2.f * (float)F.tid / 64.f); }
    __syncthreads();
    bf16x8 TH[2], TL[2];
    { const int c = 16 * (F.wave >> 1) + (F.lane & 15), g = F.lane >> 4, sel0 = (F.bid & 15) >> 3;
#pragma unroll
      for (int s_ = 0; s_ < 2; ++s_) { float t[8];
#pragma unroll
          for (int i = 0; i < 8; ++i) t[i] = trig[sel0 * 64 + (((32 * s_ + 8 * g + i) * c) & 63)];
          unsigned h_[4], l_[4]; split2(t[0], t[1], h_[0], l_[0]); split2(t[2], t[3], h_[1], l_[1]); split2(t[4], t[5], h_[2], l_[2]); split2(t[6], t[7], h_[3], l_[3]);
          TH[s_] = __builtin_bit_cast(bf16x8, (u32x4){h_[0], h_[1], h_[2], h_[3]}); TL[s_] = __builtin_bit_cast(bf16x8, (u32x4){l_[0], l_[1], l_[2], l_[3]}); } }
    for (int tile = F.bid; tile < 2 * 256; tile += F.G) {
        const int l = tile >> 8, kb = (tile >> 4) & 15, nb = tile & 15, k0 = 64 * kb, n0 = 32 * nb, sel = n0 >> 8, nn0 = n0 & 255;
        const int mb = F.wave >> 1, nh = F.wave & 1, fr = F.lane & 15, g = F.lane >> 4;
        __syncthreads();
        f32x4 wa[8][2];
        { const GAS f32x4* wp = (const GAS f32x4*)((const GAS float*)F.w_in() + (unsigned)(l * D * DIN + (k0 + 16 * mb + fr) * DIN + 2816 + 8 * g));
#pragma unroll
          for (int s_ = 0; s_ < 8; ++s_) { wa[s_][0] = wp[8 * s_]; wa[s_][1] = wp[8 * s_ + 1]; } }
        { float fv[16]; const GAS float* fp = (const GAS float*)F.four_w() + (unsigned)(l * 65536 + (F.tid >> 5) * 256 + nn0 + (F.tid & 31));
#pragma unroll
          for (int i = 0; i < 16; ++i) fv[i] = fp[(unsigned)i * 16u * 256u];
#pragma unroll
          for (int i = 0; i < 16; ++i) fws[F.tid + NTHR * i] = fv[i]; }
        __syncthreads();
#pragma unroll
        for (int hh = 0; hh < 4; ++hh) { f32x4 mm = (f32x4){0.f, 0.f, 0.f, 0.f};
#pragma unroll
            for (int s_ = 0; s_ < 2; ++s_) { float t[8];
#pragma unroll
                for (int i = 0; i < 8; ++i) t[i] = fws[(hh * 64 + 32 * s_ + 8 * g + i) * 32 + 16 * nh + fr];
                unsigned h_[4], l_[4]; split2(t[0], t[1], h_[0], l_[0]); split2(t[2], t[3], h_[1], l_[1]); split2(t[4], t[5], h_[2], l_[2]); split2(t[6], t[7], h_[3], l_[3]);
                const bf16x8 BH = __builtin_bit_cast(bf16x8, (u32x4){h_[0], h_[1], h_[2], h_[3]}), BL = __builtin_bit_cast(bf16x8, (u32x4){l_[0], l_[1], l_[2], l_[3]});
                mm = mfma16(TH[s_], BH, mm); mm = mfma16(TH[s_], BL, mm); mm = mfma16(TL[s_], BH, mm); }
            *(LAS f32x4*)(m12T + (16 * nh + fr) * 260 + hh * 64 + 16 * mb + 4 * g) = mm; }
        __syncthreads();
        f32x4 o = (f32x4){0.f, 0.f, 0.f, 0.f};
#pragma unroll
        for (int s_ = 0; s_ < 8; ++s_) { const LAS float* bp = m12T + (16 * nh + fr) * 260 + 32 * s_ + 8 * g; const f32x4 b0 = *(const LAS f32x4*)bp, b1 = *(const LAS f32x4*)(bp + 4);
            unsigned ah[4], al[4], bh[4], bl[4];
            split2(wa[s_][0][0], wa[s_][0][1], ah[0], al[0]); split2(wa[s_][0][2], wa[s_][0][3], ah[1], al[1]); split2(wa[s_][1][0], wa[s_][1][1], ah[2], al[2]); split2(wa[s_][1][2], wa[s_][1][3], ah[3], al[3]);
            split2(b0[0], b0[1], bh[0], bl[0]); split2(b0[2], b0[3], bh[1], bl[1]); split2(b1[0], b1[1], bh[2], bl[2]); split2(b1[2], b1[3], bh[3], bl[3]);
            const bf16x8 AH = __builtin_bit_cast(bf16x8, (u32x4){ah[0], ah[1], ah[2], ah[3]}), AL = __builtin_bit_cast(bf16x8, (u32x4){al[0], al[1], al[2], al[3]});
            const bf16x8 BH = __builtin_bit_cast(bf16x8, (u32x4){bh[0], bh[1], bh[2], bh[3]}), BL = __builtin_bit_cast(bf16x8, (u32x4){bl[0], bl[1], bl[2], bl[3]});
            o = mfma16(AH, BH, o); o = mfma16(AH, BL, o); o = mfma16(AL, BH, o); }
        { float o0 = o[0], o1 = o[1], o2 = o[2], o3 = o[3]; asm volatile("s_nop 15\n\ts_nop 7" : "+v"(o0), "+v"(o1), "+v"(o2), "+v"(o3));
          u32x2 wv; wv.x = pk2(o0, o1); wv.y = pk2(o2, o3);
          *(u32x2*)(F.Wt_in() + (size_t)l * DINX * D + (size_t)(FQ_OFF + n0 + 16 * nh + fr) * D + k0 + 16 * mb + 4 * g) = wv; }
    }
    __syncthreads();
}

template <class SrcF> __device__ __forceinline__ void load_tile_T(LAS unsigned char* zt, const SrcF& src, int tid) {
    const int pg = tid >> 4, cc = tid & 15; u32x4 r[8];
#pragma unroll
    for (int i = 0; i < 8; ++i) r[i] = *(const GAS u32x4*)(src(8 * pg + i) + 8 * cc);
#pragma unroll
    for (int j = 0; j < 8; ++j) { const unsigned sel = (j & 1) ? 0x07060302u : 0x05040100u; u32x4 o;
        o.x = __builtin_amdgcn_perm(r[1][j >> 1], r[0][j >> 1], sel); o.y = __builtin_amdgcn_perm(r[3][j >> 1], r[2][j >> 1], sel);
        o.z = __builtin_amdgcn_perm(r[5][j >> 1], r[4][j >> 1], sel); o.w = __builtin_amdgcn_perm(r[7][j >> 1], r[6][j >> 1], sel);
        *(LAS u32x4*)(zt + (8 * cc + j) * ZS + 16 * pg) = o; }
}
__device__ __forceinline__ void tile_mma(const LAS unsigned char* zt, const bf16_t* mat_row  , f32x4 (&acc)[8], int lane) {
    const int fr = lane & 15, g = lane >> 4; bf16x8 b[8];
#pragma unroll
    for (int ks = 0; ks < 8; ++ks) b[ks] = *(const GAS bf16x8*)(mat_row + 32 * ks + 8 * g);
    __builtin_amdgcn_sched_barrier(0);
#pragma unroll
    for (int ks = 0; ks < 8; ++ks) { bf16x8 a[8];
#pragma unroll
        for (int m = 0; m < 8; ++m) a[m] = *(const LAS bf16x8*)(zt + (16 * m + fr) * ZS + (32 * ks + 8 * g) * 2);
        __builtin_amdgcn_sched_barrier(0);
#pragma unroll
        for (int m = 0; m < 8; ++m) acc[m] = mfma16(a[m], b[ks], acc[m]);
        __builtin_amdgcn_sched_barrier(0); }
}
__device__ __forceinline__ void tile_mma2(const LAS unsigned char* zt, const bf16_t* mat_row0, const bf16_t* mat_row1, f32x4 (&acc0)[8], f32x4 (&acc1)[8], int lane) {
    const int fr = lane & 15, g = lane >> 4; bf16x8 b0[8], b1[8];
#pragma unroll
    for (int ks = 0; ks < 8; ++ks) { b0[ks] = *(const GAS bf16x8*)(mat_row0 + 32 * ks + 8 * g); b1[ks] = *(const GAS bf16x8*)(mat_row1 + 32 * ks + 8 * g); }
    __builtin_amdgcn_sched_barrier(0);
#pragma unroll
    for (int ks = 0; ks < 8; ++ks) { bf16x8 a[8];
#pragma unroll
        for (int m = 0; m < 8; ++m) a[m] = *(const LAS bf16x8*)(zt + (16 * m + fr) * ZS + (32 * ks + 8 * g) * 2);
        __builtin_amdgcn_sched_barrier(0);
#pragma unroll
        for (int m = 0; m < 8; ++m) { acc0[m] = mfma16(a[m], b0[ks], acc0[m]); acc1[m] = mfma16(a[m], b1[ks], acc1[m]); }
        __builtin_amdgcn_sched_barrier(0); }
}
struct SrcA { const bf16_t* P; int t2, hc; __device__ __forceinline__ const bf16_t* operator()(int p) const { const int ri = p >> 7, t1 = p & 127; return P + (size_t)(CTX + 128 * t1 + t2) * DINX + FQ_OFF + ri * 256 + 128 * hc; } };
struct SrcB { const bf16_t* Y; int k1, hc; __device__ __forceinline__ const bf16_t* operator()(int p) const { const int ri = p >> 7, t2 = p & 127; return Y + ((size_t)(k1 * 128 + t2) * 2 + ri) * 256 + 128 * hc; } };
struct SrcC { const bf16_t* P; int ri, hc; __device__ __forceinline__ const bf16_t* operator()(int p) const { return P + (size_t)p * DINX + FQ_OFF + ri * 256 + 128 * hc; } };

__device__ __forceinline__ void fftA_item(Frame& F, int item) {
    const int t2 = item >> 1, hc = item & 1; LAS unsigned char* zt = F.lds + RING_OFF;
    bf16_t* YP = (bf16_t*)(F.ws + WS_YP); const bf16_t* MA = (const bf16_t*)(F.ws + WS_WF + WF_MA);
    __syncthreads();
    load_tile_T(zt, SrcA{F.P(), t2, hc}, F.tid);
    __syncthreads();
    const int fr = F.lane & 15, g = F.lane >> 4, k1 = 16 * F.wave + fr;
    f32x4 ar[8], ai[8];
#pragma unroll
    for (int m = 0; m < 8; ++m) { ar[m] = (f32x4){0.f, 0.f, 0.f, 0.f}; ai[m] = (f32x4){0.f, 0.f, 0.f, 0.f}; }
    tile_mma2(zt, MA + (size_t)k1 * 256, MA + (size_t)(128 + k1) * 256, ar, ai, F.lane);
    const float x = 2.f * (float)(t2 * k1) / 16384.f; const float cs = cospif(x), sn = sinpif(x);
    bf16_t* yr = YP + ((size_t)(k1 * 128 + t2) * 2) * 256 + 128 * hc + 4 * g;
#pragma unroll
    for (int m = 0; m < 8; ++m) { const f32x4 a = ar[m], b = ai[m]; const f32x4 pr = a * cs + b * sn, pi = b * cs - a * sn;
        u32x2 w; w.x = pk2(pr[0], pr[1]); w.y = pk2(pr[2], pr[3]); *(u32x2*)(yr + 16 * m) = w;
        u32x2 v; v.x = pk2(pi[0], pi[1]); v.y = pk2(pi[2], pi[3]); *(u32x2*)(yr + 256 + 16 * m) = v; }
}
__device__ __forceinline__ void fftB_item(Frame& F, int item) {
    const int k1 = item >> 1, hc = item & 1; LAS unsigned char* zt = F.lds + RING_OFF;
    const bf16_t* YP = (const bf16_t*)(F.ws + WS_YP); const bf16_t* MB = (const bf16_t*)(F.ws + WS_WF + WF_MB);
    __syncthreads();
    load_tile_T(zt, SrcB{YP, k1, hc}, F.tid);
    __syncthreads();
    const int fr = F.lane & 15, g = F.lane >> 4, k2 = 16 * F.wave + fr;
    f32x4 acc[8];
#pragma unroll
    for (int m = 0; m < 8; ++m) acc[m] = (f32x4){0.f, 0.f, 0.f, 0.f};
    tile_mma(zt, MB + (size_t)k2 * 256, acc, F.lane);
    bf16_t* o = F.CAT() + (size_t)(CTX + k1 + 128 * k2) * D + 768 + 128 * hc + 4 * g;
#pragma unroll
    for (int m = 0; m < 8; ++m) { const f32x4 a = acc[m] * (1.f / 1024.f); u32x2 w; w.x = pk2(a[0], a[1]); w.y = pk2(a[2], a[3]); *(u32x2*)(o + 16 * m) = w; }
}
__device__ __forceinline__ void fftC_item(Frame& F, int item) {
    const int kh = item >> 1, hc = item & 1; LAS unsigned char* zt = F.lds + RING_OFF; const bf16_t* MC = (const bf16_t*)(F.ws + WS_WF + WF_MC);
    const int fr = F.lane & 15, g = F.lane >> 4, k = 128 * kh + 16 * F.wave + fr;
    f32x4 acc[8];
#pragma unroll
    for (int m = 0; m < 8; ++m) acc[m] = (f32x4){0.f, 0.f, 0.f, 0.f};
    for (int ri = 0; ri < 2; ++ri) {
        __syncthreads();
        load_tile_T(zt, SrcC{F.P(), ri, hc}, F.tid);
        __syncthreads();
        tile_mma(zt, MC + (size_t)k * 512 + ri * 256, acc, F.lane);
    }
    bf16_t* o = F.CAT() + (size_t)k * D + 768 + 128 * hc + 4 * g;
#pragma unroll
    for (int m = 0; m < 8; ++m) { const f32x4 a = acc[m] * (1.f / 128.f); u32x2 w; w.x = pk2(a[0], a[1]); w.y = pk2(a[2], a[3]); *(u32x2*)(o + 16 * m) = w; }
}

template <int GI> __device__ __forceinline__ void pool_sums(Frame& F, int j, LAS float* V, LAS unsigned* U, LAS unsigned char* At) {
    constexpr int win = 2 << GI, lo = win >> 1, hi = win - 1 - lo; const GAS bf16_t* Pc = (const GAS bf16_t*)F.P() + 2560 + GI * 64;
    if (j == 0) {
        for (int idx = F.tid; idx < 256 * 8; idx += NTHR) { const int t = idx >> 3, p8 = idx & 7; const int a = max(t - lo, 0), b = min(t + hi, CTX - 1); u32x4 w[win];
#pragma unroll
            for (int i = 0; i < win; ++i) { const int r = min(max(t - lo + i, 0), CTX - 1); w[i] = *(const GAS u32x4*)(Pc + (unsigned)(r * DINX + 8 * p8)); }
            f32x4 s0 = (f32x4){0.f, 0.f, 0.f, 0.f}, s1 = s0;
#pragma unroll
            for (int i = 0; i < win; ++i) { const int r = t - lo + i; const bool in = r >= 0 && r <= CTX - 1; const u32x4 x = w[i];
                const f32x4 e = (f32x4){bflo(x.x), bflo(x.y), bflo(x.z), bflo(x.w)}, o = (f32x4){bfhi(x.x), bfhi(x.y), bfhi(x.z), bfhi(x.w)}; if (in) { s0 += e; s1 += o; } }
            const u32x4 u = w[lo]; const float inv = 1.f / (float)(b - a + 1); u32x4 ov;
            ov.x = pk2(s0[0] * inv - bflo(u.x), s1[0] * inv - bfhi(u.x)); ov.y = pk2(s0[1] * inv - bflo(u.y), s1[1] * inv - bfhi(u.y));
            ov.z = pk2(s0[2] * inv - bflo(u.z), s1[2] * inv - bfhi(u.z)); ov.w = pk2(s0[3] * inv - bflo(u.w), s1[3] * inv - bfhi(u.w));
            *(LAS u32x4*)(At + t * 144 + 16 * p8) = ov; }
        return; }
    const int r0 = 4 * (j - 1); constexpr int NR = win + 3;
    { const int c = F.tid >> 3, p8 = F.tid & 7; u32x4 w[NR];
#pragma unroll
        for (int i = 0; i < NR; ++i) { const int r = min(max(r0 - lo + i, 0), LAT / GW - 1); w[i] = *(const GAS u32x4*)(Pc + (unsigned)((CTX + r * GW + c) * DINX + 8 * p8)); }
        f32x4 s0[4], s1[4];
#pragma unroll
        for (int q = 0; q < 4; ++q) { s0[q] = (f32x4){0.f, 0.f, 0.f, 0.f}; s1[q] = (f32x4){0.f, 0.f, 0.f, 0.f}; }
#pragma unroll
        for (int i = 0; i < NR; ++i) { const int r = r0 - lo + i; const bool ok = r >= 0 && r <= LAT / GW - 1; const u32x4 x = w[i];
            f32x4 e = (f32x4){bflo(x.x), bflo(x.y), bflo(x.z), bflo(x.w)}, o = (f32x4){bfhi(x.x), bfhi(x.y), bfhi(x.z), bfhi(x.w)}; if (!ok) { e = (f32x4){0.f, 0.f, 0.f, 0.f}; o = e; }
#pragma unroll
            for (int q = 0; q < 4; ++q) if (i >= q && i <= q + win - 1) { s0[q] += e; s1[q] += o; } }
#pragma unroll
        for (int q = 0; q < 4; ++q) { LAS float* vp = V + (q * 64 + c) * 64 + 8 * p8;
            *(LAS f32x4*)vp = (f32x4){s0[q][0], s1[q][0], s0[q][1], s1[q][1]}; *(LAS f32x4*)(vp + 4) = (f32x4){s0[q][2], s1[q][2], s0[q][3], s1[q][3]};
            *(LAS u32x4*)(U + (q * 64 + c) * 32 + 4 * p8) = w[lo + q]; } }
    __syncthreads();
    for (int idx = F.tid; idx < 4 * 8 * 64; idx += NTHR) { const int ch = idx & 63, cb = (idx >> 6) & 7, i = idx >> 9; const int r = r0 + i;
        const float cr = (float)(min(r + hi, LAT / GW - 1) - max(r - lo, 0) + 1); const LAS float* Vr = V + (i * 64) * 64 + ch;
        const int c0 = 8 * cb; float vv[win + 7]; unsigned uw[8];
#pragma unroll
        for (int q = 0; q < win + 7; ++q) { const int c = c0 - lo + q; const float x = Vr[min(max(c, 0), GW - 1) * 64]; vv[q] = (c >= 0 && c <= GW - 1) ? x : 0.f; }
#pragma unroll
        for (int q = 0; q < 8; ++q) uw[q] = U[(i * 64 + c0 + q) * 32 + (ch >> 1)];
        __builtin_amdgcn_sched_barrier(0);
        float s = 0.f;
#pragma unroll
        for (int q = 0; q < win; ++q) s += vv[q];
#pragma unroll
        for (int q = 0; q < 8; ++q) { const int c = c0 + q; if (q > 0) { s += vv[q + win - 1]; s -= vv[q - 1]; }
            const float cc = (float)(min(c + hi, GW - 1) - max(c - lo, 0) + 1); const float u = (ch & 1) ? bfhi(uw[q]) : bflo(uw[q]);
            *(LAS unsigned short*)(At + (i * 64 + c) * 144 + 2 * ch) = (unsigned short)f2bf(s / (cr * cc) - u); } }
}
__device__ __forceinline__ void pool_item(Frame& F, int l, int item) {
    const int j = item >> 2, gi = item & 3;
    LAS float* V = (LAS float*)(F.lds);
    LAS unsigned* U = (LAS unsigned*)(F.lds + 65536);
    LAS unsigned char* At = F.lds + 65536 + 32768;
    __syncthreads();
    if (gi == 0) pool_sums<0>(F, j, V, U, At); else if (gi == 1) pool_sums<1>(F, j, V, U, At); else if (gi == 2) pool_sums<2>(F, j, V, U, At); else pool_sums<3>(F, j, V, U, At);
    __syncthreads();
    const bf16_t* PW = (const bf16_t*)(F.ws + WS_WF + WF_PW) + (size_t)(l * 4 + gi) * 4096; const int fr = F.lane & 15, g = F.lane >> 4;
    f32x4 acc[4][2];
#pragma unroll
    for (int n = 0; n < 4; ++n) { acc[n][0] = (f32x4){0.f, 0.f, 0.f, 0.f}; acc[n][1] = (f32x4){0.f, 0.f, 0.f, 0.f}; }
    f32x4 scv[4];
#pragma unroll
    for (int n = 0; n < 4; ++n) scv[n] = *(const GAS f32x4*)(F.pool_s() + l * 256 + gi * 64 + 16 * n + 4 * g);
    bf16x8 pa[2][4], pb[2][2];
#pragma unroll
    for (int ks = 0; ks < 2; ++ks) {
#pragma unroll
        for (int n = 0; n < 4; ++n) pa[ks][n] = *(const GAS bf16x8*)(PW + (16 * n + fr) * 64 + 32 * ks + 8 * g);
#pragma unroll
        for (int mt = 0; mt < 2; ++mt) pb[ks][mt] = *(const LAS bf16x8*)(At + (32 * F.wave + 16 * mt + fr) * 144 + (32 * ks + 8 * g) * 2); }
    __builtin_amdgcn_sched_barrier(0);
#pragma unroll
    for (int ks = 0; ks < 2; ++ks)
#pragma unroll
        for (int n = 0; n < 4; ++n)
#pragma unroll
            for (int mt = 0; mt < 2; ++mt) acc[n][mt] = mfma16(pa[ks][n], pb[ks][mt], acc[n][mt]);
    const int rowbase = j == 0 ? 0 : CTX + 256 * (j - 1);
#pragma unroll
    for (int n = 0; n < 4; ++n) { const f32x4 sc = scv[n];
#pragma unroll
        for (int mt = 0; mt < 2; ++mt) { const f32x4 a = acc[n][mt] * sc; u32x2 w; w.x = pk2(a[0], a[1]); w.y = pk2(a[2], a[3]);
            *(u32x2*)(F.CAT() + (size_t)(rowbase + 32 * F.wave + 16 * mt + fr) * D + 512 + gi * 64 + 16 * n + 4 * g) = w; } }
}

constexpr int SC_FT = 0, SC_QT = 18432, SC_VT = 36864, SC_BQ = 55296, SC_BF = 72704, SC_KT = 90112, SC_PM = 108544, SC_G = 117760, SC_TOT = 135168, SC_DEC = 137216, SC_SSQ = 138752, SC_END = 140800;
static_assert(SC_END + 2048 <= MISC_OFF, "scan LDS map (+ the per-wave norm factors behind SC_END)");
template <int DIR, bool FULL> __device__ __forceinline__ void scan_fetch(const Frame& F, int h, int row0, u32x4 (&r)[8]) {
    const GAS bf16_t* P = (const GAS bf16_t*)F.P(); const int tid = F.tid;
    if (tid < 384) { const int tile = tid >> 7, blk = tid & 127, tg = blk >> 4, kc = blk & 15; if (!FULL && tile == 1) return;
        const int colb = tile == 0 ? 512 * (1 + DIR) : (tile == 1 ? 0 : 1536); const GAS bf16_t* src = P + (unsigned)((row0 + 8 * tg) * DINX + colb + h * 128 + 8 * kc);
#pragma unroll
        for (int i = 0; i < 8; ++i) r[i] = *(const GAS u32x4*)(src + (unsigned)(i * DINX)); }
    else if (FULL && DIR == 1) { const int q = tid - 384; const GAS bf16_t* src = P + (unsigned)((row0 + (q >> 4)) * DINX + 2048 + h * 128 + 8 * (q & 15));
#pragma unroll
        for (int i = 0; i < 8; ++i) r[i] = *(const GAS u32x4*)(src + (unsigned)(i * 8 * DINX)); }
}
template <int DIR, bool FULL> __device__ __forceinline__ void scan_commit(const Frame& F, const u32x4 (&r)[8]) {
    LAS unsigned char* L = F.lds + RING_OFF; const int tid = F.tid;
    if (tid < 384) { const int tile = tid >> 7, blk = tid & 127, tg = blk >> 4, kc = blk & 15; if (!FULL && tile == 1) return;
#pragma unroll
        for (int j = 0; j < 8; ++j) { const unsigned sel = (j & 1) ? 0x07060302u : 0x05040100u; u32x4 o;
            o.x = __builtin_amdgcn_perm(r[1][j >> 1], r[0][j >> 1], sel); o.y = __builtin_amdgcn_perm(r[3][j >> 1], r[2][j >> 1], sel);
            o.z = __builtin_amdgcn_perm(r[5][j >> 1], r[4][j >> 1], sel); o.w = __builtin_amdgcn_perm(r[7][j >> 1], r[6][j >> 1], sel);
            *(LAS u32x4*)(L + tile * 18432 + (8 * kc + j) * 144 + 16 * tg) = o; } }
    else if (FULL && DIR == 1) { const int q = tid - 384; LAS unsigned char* dst = L + SC_G + (q >> 4) * 272 + 16 * (q & 15);
#pragma unroll
        for (int i = 0; i < 8; ++i) *(LAS u32x4*)(dst + i * 8 * 272) = r[i]; }
}
template <int DIR, bool FULL> __device__ __forceinline__ void scan_chunk(Frame& F, int l, int h, int nrow0, u32x4 (&pre)[8], f32x4 (&S)[8], f32x4 (&o)[4], float& segsum, const GAS float* oload = nullptr, GAS float* ostore = nullptr) {
    LAS unsigned char* L = F.lds + RING_OFF; int lane = F.lane; asm volatile("" : "+v"(lane));
    const int w = F.wave, tid = w * 64 + lane, fr = lane & 15, g = lane >> 4;
    LAS float* TOT = (LAS float*)(L + SC_TOT); LAS float* DEC = (LAS float*)(L + SC_DEC); LAS float* C1 = DEC + 128; LAS float* C2 = DEC + 256;
    __syncthreads();
    scan_commit<DIR, FULL>(F, pre);
    if (FULL) {
#pragma unroll
        for (int tb = 0; tb < 4; ++tb)
#pragma unroll
            for (int r = 0; r < 4; ++r) o[tb][r] = oload ? oload[(tb * 4 + r) * 512] : 0.f; }
    if (nrow0 >= 0) scan_fetch<DIR, FULL>(F, h, nrow0, pre);
    __syncthreads();
    const int k = tid & 127, qu = tid >> 7;
    float bl[16]; float run = 0.f;
    { const u32x4 fa = *(const LAS u32x4*)(L + SC_FT + k * 144 + 32 * qu), fb = *(const LAS u32x4*)(L + SC_FT + k * 144 + 32 * qu + 16); const unsigned fw[8] = {fa.x, fa.y, fa.z, fa.w, fb.x, fb.y, fb.z, fb.w};
#pragma unroll
      for (int i = 0; i < 16; ++i) { const int ti = (DIR == 0 ? i : 15 - i); run += (ti & 1) ? f16hi(fw[ti >> 1]) : f16lo(fw[ti >> 1]); bl[i] = run; } }
    TOT[qu * 128 + k] = run;
    __syncthreads();
    const float t0 = TOT[k], t1 = TOT[128 + k], t2 = TOT[256 + k], t3 = TOT[384 + k]; const float total = (t0 + t1) + (t2 + t3);
    float off, ref;
    if (DIR == 0) { off = qu == 0 ? 0.f : (qu == 1 ? t0 : (qu == 2 ? t0 + t1 : t0 + t1 + t2)); ref = t0 + t1; }
    else { off = qu == 3 ? 0.f : (qu == 2 ? t3 : (qu == 1 ? t3 + t2 : t3 + t2 + t1)); ref = t3 + t2; }
    if (qu == 0) { DEC[k] = __builtin_amdgcn_exp2f(total); C1[k] = __builtin_amdgcn_exp2f(ref); C2[k] = __builtin_amdgcn_exp2f(total - ref); segsum += total; }
    { unsigned qw[8];
      if (FULL) { const u32x4 qa = *(const LAS u32x4*)(L + SC_QT + k * 144 + 32 * qu), qb = *(const LAS u32x4*)(L + SC_QT + k * 144 + 32 * qu + 16); qw[0] = qa.x; qw[1] = qa.y; qw[2] = qa.z; qw[3] = qa.w; qw[4] = qb.x; qw[5] = qb.y; qw[6] = qb.z; qw[7] = qb.w; }
      float ktv[16]; const float sh = off - ref; float eprev = __builtin_amdgcn_exp2f(-sh);
#pragma unroll
      for (int i = 0; i < 16; ++i) { const int ti = (DIR == 0 ? i : 15 - i), t = 16 * qu + ti; const float b = bl[i] + sh;
          const float Ei = __builtin_amdgcn_exp2f(-b); ktv[ti] = Ei - eprev; eprev = Ei;
          if (FULL) { const float E = __builtin_amdgcn_exp2f(b); const float qs = (ti & 1) ? bfhi(qw[ti >> 1]) : bflo(qw[ti >> 1]); *(LAS unsigned short*)(L + SC_BQ + t * 272 + 2 * k) = (unsigned short)(cvt_pk_bf16(qs * E, 0.f)); } }
      u32x4 a, b2; a.x = cvt_pk_bf16(ktv[0], ktv[1]); a.y = cvt_pk_bf16(ktv[2], ktv[3]); a.z = cvt_pk_bf16(ktv[4], ktv[5]); a.w = cvt_pk_bf16(ktv[6], ktv[7]);
      b2.x = cvt_pk_bf16(ktv[8], ktv[9]); b2.y = cvt_pk_bf16(ktv[10], ktv[11]); b2.z = cvt_pk_bf16(ktv[12], ktv[13]); b2.w = cvt_pk_bf16(ktv[14], ktv[15]);
      *(LAS u32x4*)(L + SC_KT + k * 144 + 32 * qu) = a; *(LAS u32x4*)(L + SC_KT + k * 144 + 32 * qu + 16) = b2;
      if (FULL) { const unsigned kw[8] = {a.x, a.y, a.z, a.w, b2.x, b2.y, b2.z, b2.w};
#pragma unroll
          for (int ti = 0; ti < 16; ++ti) *(LAS unsigned short*)(L + SC_BF + (16 * qu + ti) * 272 + 2 * k) = (unsigned short)((ti & 1) ? (kw[ti >> 1] >> 16) : (kw[ti >> 1] & 0xffffu)); } }
    __syncthreads();
    __builtin_amdgcn_sched_barrier(0);
    if (FULL) {
        const int tb = w >> 1; bf16x8 sa[2][4], sbq[4];
#pragma unroll
        for (int ks = 0; ks < 4; ++ks) { sbq[ks] = *(const LAS bf16x8*)(L + SC_BQ + (16 * tb + fr) * 272 + (32 * ks + 8 * g) * 2);
#pragma unroll
            for (int q = 0; q < 2; ++q) sa[q][ks] = *(const LAS bf16x8*)(L + SC_BF + (16 * (2 * (w & 1) + q) + fr) * 272 + (32 * ks + 8 * g) * 2); }
        __builtin_amdgcn_sched_barrier(0);
#pragma unroll
        for (int q = 0; q < 2; ++q) { const int sb = 2 * (w & 1) + q; f32x4 acc = (f32x4){0.f, 0.f, 0.f, 0.f};
#pragma unroll
            for (int ks = 0; ks < 4; ++ks) acc = mfma16(sa[q][ks], sbq[ks], acc);
            const int t = 16 * tb + fr; float m[4];
#pragma unroll
            for (int r = 0; r < 4; ++r) { const int s = 16 * sb + 4 * g + r; const bool keep = DIR == 0 ? (s <= t) : (s >= t); m[r] = keep ? acc[r] : 0.f; }
            u32x2 wv; wv.x = pk2(m[0], m[1]); wv.y = pk2(m[2], m[3]); *(LAS u32x2*)(L + SC_PM + t * 144 + (16 * sb + 4 * g) * 2) = wv; }
        __syncthreads();
    }
    bf16x8 vt[2];
#pragma unroll
    for (int ks = 0; ks < 2; ++ks) vt[ks] = *(const LAS bf16x8*)(L + SC_VT + (16 * w + fr) * 144 + (32 * ks + 8 * g) * 2);
    if (FULL) {
        bf16x8 sf[4];
        { f32x4 ca[4], cb[4];
#pragma unroll
          for (int ks = 0; ks < 4; ++ks) { ca[ks] = *(const LAS f32x4*)(C1 + 32 * ks + 4 * g); cb[ks] = *(const LAS f32x4*)(C1 + 32 * ks + 16 + 4 * g); }
          __builtin_amdgcn_sched_barrier(0);
#pragma unroll
          for (int ks = 0; ks < 4; ++ks) { const f32x4 x = S[2 * ks] * ca[ks], y = S[2 * ks + 1] * cb[ks];
              u32x4 pkd; pkd.x = pk2(x[0], x[1]); pkd.y = pk2(x[2], x[3]); pkd.z = pk2(y[0], y[1]); pkd.w = pk2(y[2], y[3]); sf[ks] = __builtin_bit_cast(bf16x8, pkd); } }
#pragma unroll
        for (int tp = 0; tp < 2; ++tp) { u32x2 qa[2][4][2]; bf16x8 pm[2][2];
#pragma unroll
            for (int t2 = 0; t2 < 2; ++t2) { const int tb = 2 * tp + t2;
#pragma unroll
                for (int ks = 0; ks < 4; ++ks) { qa[t2][ks][0] = *(const LAS u32x2*)(L + SC_BQ + (16 * tb + fr) * 272 + (32 * ks + 4 * g) * 2); qa[t2][ks][1] = *(const LAS u32x2*)(L + SC_BQ + (16 * tb + fr) * 272 + (32 * ks + 16 + 4 * g) * 2); }
#pragma unroll
                for (int ks = 0; ks < 2; ++ks) pm[t2][ks] = *(const LAS bf16x8*)(L + SC_PM + (16 * tb + fr) * 144 + (32 * ks + 8 * g) * 2); }
            __builtin_amdgcn_sched_barrier(0);
#pragma unroll
            for (int t2 = 0; t2 < 2; ++t2) { const int tb = 2 * tp + t2; f32x4 acc = o[tb];
#pragma unroll
                for (int ks = 0; ks < 4; ++ks) { u32x4 pa; pa.x = qa[t2][ks][0].x; pa.y = qa[t2][ks][0].y; pa.z = qa[t2][ks][1].x; pa.w = qa[t2][ks][1].y; acc = mfma16(__builtin_bit_cast(bf16x8, pa), sf[ks], acc); }
#pragma unroll
                for (int ks = 0; ks < 2; ++ks) acc = mfma16(pm[t2][ks], vt[ks], acc);
                o[tb] = acc; }
            __builtin_amdgcn_sched_barrier(0); }
        if (ostore) {
#pragma unroll
            for (int tb = 0; tb < 4; ++tb)
#pragma unroll
                for (int r = 0; r < 4; ++r) ostore[(tb * 4 + r) * 512] = o[tb][r]; }
    }
#pragma unroll
    for (int hf = 0; hf < 4; ++hf) { bf16x8 ka[2][2]; f32x4 dc[2], c2[2];
#pragma unroll
        for (int kq = 0; kq < 2; ++kq) { const int kb = 2 * hf + kq;
#pragma unroll
            for (int ks = 0; ks < 2; ++ks) ka[kq][ks] = *(const LAS bf16x8*)(L + SC_KT + (16 * kb + fr) * 144 + (32 * ks + 8 * g) * 2);
            dc[kq] = *(const LAS f32x4*)(DEC + 16 * kb + 4 * g); c2[kq] = *(const LAS f32x4*)(C2 + 16 * kb + 4 * g); }
        __builtin_amdgcn_sched_barrier(0);
#pragma unroll
        for (int kq = 0; kq < 2; ++kq) { const int kb = 2 * hf + kq; f32x4 tmp = (f32x4){0.f, 0.f, 0.f, 0.f};
#pragma unroll
            for (int ks = 0; ks < 2; ++ks) tmp = mfma16(ka[kq][ks], vt[ks], tmp);
            S[kb] = dc[kq] * S[kb] + c2[kq] * tmp; }
        __builtin_amdgcn_sched_barrier(0); }
}
__device__ __forceinline__ void state_store(float* dst, const f32x4 (&S)[8], int w, int lane) {
    GAS float* p = (GAS float*)dst + (unsigned)(w * 2048 + lane);
#pragma unroll
    for (int kb = 0; kb < 8; ++kb)
#pragma unroll
        for (int r = 0; r < 4; ++r) p[(kb * 4 + r) * 64] = S[kb][r]; }
__device__ __forceinline__ void state_load(const float* src, f32x4 (&S)[8], int w, int lane) {
    const GAS float* p = (const GAS float*)src + (unsigned)(w * 2048 + lane);
#pragma unroll
    for (int kb = 0; kb < 8; ++kb)
#pragma unroll
        for (int r = 0; r < 4; ++r) S[kb][r] = p[(kb * 4 + r) * 64]; }
__device__ __forceinline__ float* sc_SU(Frame& F) { return (float*)(F.ws + WS_SU); }
__device__ __forceinline__ float* sc_SS(Frame& F) { return (float*)(F.ws + WS_SS); }
__device__ __forceinline__ float* sc_SD(Frame& F) { return (float*)(F.ws + WS_SD); }
__device__ __forceinline__ float* sc_CARRY(Frame& F) { return (float*)(F.ws + WS_SD) + 8 * 64 * 128; }

__device__ __forceinline__ float* sc_OSCR(Frame& F) { return (float*)(F.ws + WS_OSCR) + (size_t)F.bid * 32768; }
template <int DIR> __device__ __forceinline__ void scan_states(Frame& F, int l, int h, int segrow, float* sout, float* dout) {
    f32x4 S[8], odummy[4]; float segsum = 0.f; u32x4 pre[8];
#pragma unroll
    for (int kb = 0; kb < 8; ++kb) S[kb] = (f32x4){0.f, 0.f, 0.f, 0.f};
    scan_fetch<DIR, false>(F, h, segrow + (DIR == 0 ? 0 : 192), pre);
#pragma unroll 1
    for (int i_ = 0; i_ < 4; ++i_) { int i = i_; asm volatile("" : "+s"(i)); const int c = DIR == 0 ? i : 3 - i;
        scan_chunk<DIR, false>(F, l, h, i < 3 ? segrow + 64 * (DIR == 0 ? c + 1 : c - 1) : -1, pre, S, odummy, segsum); }
    state_store(sout, S, F.wave, F.lane);
    if (dout && F.tid < 128) dout[F.tid] = __builtin_amdgcn_exp2f(segsum);
}
__device__ __forceinline__ void scanA_item(Frame& F, int l, int item) {
    const int h = item >> 6, seg = item & 63, segrow = CTX + 256 * seg;
    scan_states<0>(F, l, h, segrow, sc_SU(F) + ((size_t)(h * 2 + 0) * 64 + seg) * 16384, sc_SD(F) + ((h * 2 + 0) * 64 + seg) * 128);
    scan_states<1>(F, l, h, segrow, sc_SU(F) + ((size_t)(h * 2 + 1) * 64 + seg) * 16384, sc_SD(F) + ((h * 2 + 1) * 64 + seg) * 128);
}
__device__ __forceinline__ void scan_full(Frame& F, int l, int h, int segrow, const float* sinf, const float* sinb, float* outf, float* outb) {
    f32x4 S[8], o[4]; float segsum = 0.f; const int w = F.wave, lane = F.lane, fr = lane & 15, g = lane >> 4; u32x4 pre[8];
    GAS float* oscr = (GAS float*)sc_OSCR(F) + (unsigned)F.tid;
    if (sinf) state_load(sinf, S, w, lane); else {
#pragma unroll
        for (int kb = 0; kb < 8; ++kb) S[kb] = (f32x4){0.f, 0.f, 0.f, 0.f}; }
    scan_fetch<0, true>(F, h, segrow, pre);
#pragma unroll 1
    for (int c_ = 0; c_ < 4; ++c_) { int c = c_; asm volatile("" : "+s"(c));
        scan_chunk<0, true>(F, l, h, c < 3 ? segrow + 64 * (c + 1) : -1, pre, S, o, segsum);
#pragma unroll
        for (int tb = 0; tb < 4; ++tb)
#pragma unroll
            for (int r = 0; r < 4; ++r) (oscr + c * 8192)[(tb * 4 + r) * 512] = o[tb][r];
    }
    if (outf) state_store(outf, S, w, lane);
    VM_WAIT();
    if (sinb) state_load(sinb, S, w, lane); else {
#pragma unroll
        for (int kb = 0; kb < 8; ++kb) S[kb] = (f32x4){0.f, 0.f, 0.f, 0.f}; }
    LAS unsigned char* L = F.lds + RING_OFF; LAS float* SSQ = (LAS float*)(L + SC_SSQ);
    const float ngv = F.hng()[l * 512 + h * 128 + 16 * w + fr];
    scan_fetch<1, true>(F, h, segrow + 192, pre);
#pragma unroll 1
    for (int c_ = 3; c_ >= 0; --c_) { int c = c_; asm volatile("" : "+s"(c));
        scan_chunk<1, true>(F, l, h, c > 0 ? segrow + 64 * (c - 1) : -1, pre, S, o, segsum, oscr + c * 8192);
#pragma unroll
        for (int tb = 0; tb < 4; ++tb) { f32x4 q = o[tb] * o[tb];
            q[0] = row16_sum(q[0]); q[1] = row16_sum(q[1]); q[2] = row16_sum(q[2]); q[3] = row16_sum(q[3]);
            if (fr == 0) {
#pragma unroll
                for (int r = 0; r < 4; ++r) SSQ[(16 * tb + 4 * g + r) * 8 + w] = q[r]; } }
        __syncthreads();
        { const f32x4 p0 = *(const LAS f32x4*)(SSQ + lane * 8), p1 = *(const LAS f32x4*)(SSQ + lane * 8 + 4);
          const float ss = ((p0[0] + p0[1]) + (p0[2] + p0[3])) + ((p1[0] + p1[1]) + (p1[2] + p1[3])); ((LAS float*)(L + SC_END))[w * 64 + lane] = rsqrtf(ss * (1.f / 128.f) + 1e-6f); }
#pragma unroll
        for (int tb = 0; tb < 4; ++tb)
#pragma unroll
            for (int r = 0; r < 4; ++r) { const int t = 16 * tb + 4 * g + r; const float rs = ((const LAS float*)(L + SC_END))[w * 64 + t];
                *(LAS unsigned short*)(L + SC_BQ + t * 272 + 2 * (16 * w + fr)) = (unsigned short)f2bf(o[tb][r] * rs * ngv); }
        __syncthreads();
#pragma unroll
        for (int i = 0; i < 2; ++i) { const int id = F.tid + 512 * i, row = id >> 4, cc = id & 15; const u32x4 d = *(const LAS u32x4*)(L + SC_BQ + row * 272 + 16 * cc), gt = *(const LAS u32x4*)(L + SC_G + row * 272 + 16 * cc);
            u32x4 e;
            e.x = pk2(bflo(d.x) * bflo(gt.x), bfhi(d.x) * bfhi(gt.x)); e.y = pk2(bflo(d.y) * bflo(gt.y), bfhi(d.y) * bfhi(gt.y)); e.z = pk2(bflo(d.z) * bflo(gt.z), bfhi(d.z) * bfhi(gt.z)); e.w = pk2(bflo(d.w) * bflo(gt.w), bfhi(d.w) * bfhi(gt.w));
            *(GAS u32x4*)((GAS bf16_t*)F.CAT() + (unsigned)((segrow + 64 * c + row) * D + h * 128 + 8 * cc)) = e; }
    }
    if (outb) state_store(outb, S, w, lane);
}
__device__ __forceinline__ GAS float* sc_CTXO(const Frame& F, int hd, int c) { return (GAS float*)(F.ws + WS_CTXO) + (unsigned)((hd * 4 + c) * 8192); }
template <int DIR> __device__ __forceinline__ void scan_dir_local(Frame& F, int l, int h, int segrow, float* sout) {
    f32x4 S[8], o[4]; float segsum = 0.f; u32x4 pre[8]; const int hd = h * 2 + DIR;
#pragma unroll
    for (int kb = 0; kb < 8; ++kb) S[kb] = (f32x4){0.f, 0.f, 0.f, 0.f};
    scan_fetch<DIR, true>(F, h, segrow + (DIR == 0 ? 0 : 192), pre);
#pragma unroll 1
    for (int i_ = 0; i_ < 4; ++i_) { int i = i_; asm volatile("" : "+s"(i)); const int c = DIR == 0 ? i : 3 - i;
        scan_chunk<DIR, true>(F, l, h, i < 3 ? segrow + 64 * (DIR == 0 ? c + 1 : c - 1) : -1, pre, S, o, segsum, nullptr, sc_CTXO(F, hd, c) + (unsigned)F.tid); }
    state_store(sout, S, F.wave, F.lane);
}
__device__ __forceinline__ void ctx_finalize(Frame& F, int l, int h, int c0) {
    LAS unsigned char* L = F.lds + RING_OFF; LAS float* SSQ = (LAS float*)(L + SC_SSQ);
    const float ngv = F.hng()[l * 512 + h * 128 + 16 * F.wave + (F.lane & 15)];
#pragma unroll 1
    for (int c_ = c0; c_ < c0 + 1; ++c_) { int c = __builtin_amdgcn_readfirstlane(c_); asm volatile("" : "+s"(c)); int lane = F.lane; asm volatile("" : "+v"(lane));
        const int w = F.wave, tid = w * 64 + lane, fr = lane & 15, g = lane >> 4, row0 = 64 * c;
        __syncthreads();
        { const GAS bf16_t* gp = (const GAS bf16_t*)F.P() + (unsigned)((row0 + (tid >> 4)) * DINX + 2048 + h * 128 + 8 * (tid & 15)); const int o = (tid >> 4) * 272 + 16 * (tid & 15);
          *(LAS u32x4*)(L + SC_G + o) = *(const GAS u32x4*)gp; *(LAS u32x4*)(L + SC_G + o + 32 * 272) = *(const GAS u32x4*)(gp + (unsigned)(32 * DINX)); }
        f32x4 o[4];
        { const GAS float* of = sc_CTXO(F, h * 2 + 0, c) + (unsigned)tid; const GAS float* ob = sc_CTXO(F, h * 2 + 1, c) + (unsigned)tid;
#pragma unroll
          for (int tb = 0; tb < 4; ++tb)
#pragma unroll
              for (int r = 0; r < 4; ++r) o[tb][r] = of[(tb * 4 + r) * 512] + ob[(tb * 4 + r) * 512]; }
#pragma unroll
        for (int tb = 0; tb < 4; ++tb) { f32x4 q = o[tb] * o[tb];
            q[0] = row16_sum(q[0]); q[1] = row16_sum(q[1]); q[2] = row16_sum(q[2]); q[3] = row16_sum(q[3]);
            if (fr == 0) {
#pragma unroll
                for (int r = 0; r < 4; ++r) SSQ[(16 * tb + 4 * g + r) * 8 + w] = q[r]; } }
        __syncthreads();
        { const f32x4 p0 = *(const LAS f32x4*)(SSQ + lane * 8), p1 = *(const LAS f32x4*)(SSQ + lane * 8 + 4);
          const float ss = ((p0[0] + p0[1]) + (p0[2] + p0[3])) + ((p1[0] + p1[1]) + (p1[2] + p1[3])); ((LAS float*)(L + SC_END))[w * 64 + lane] = rsqrtf(ss * (1.f / 128.f) + 1e-6f); }
#pragma unroll
        for (int tb = 0; tb < 4; ++tb)
#pragma unroll
            for (int r = 0; r < 4; ++r) { const int t = 16 * tb + 4 * g + r; const float rs = ((const LAS float*)(L + SC_END))[w * 64 + t];
                const float gp = bf2f(*(const LAS unsigned short*)(L + SC_G + t * 272 + 2 * (16 * w + fr)));
                *(LAS unsigned short*)(L + SC_BQ + t * 272 + 2 * (16 * w + fr)) = (unsigned short)f2bf(o[tb][r] * rs * ngv * gp); }
        __syncthreads();
#pragma unroll
        for (int i = 0; i < 2; ++i) { const int id = tid + 512 * i, row = id >> 4, cc = id & 15; const u32x4 d = *(const LAS u32x4*)(L + SC_BQ + row * 272 + 16 * cc);
            *(GAS u32x4*)((GAS bf16_t*)F.CAT() + (unsigned)((row0 + row) * D + h * 128 + 8 * cc)) = d; }
    }
    __syncthreads();
}
__device__ __forceinline__ void scanB(Frame& F) {
    const int e = F.bid * NTHR + F.tid; if (e >= 8 * 16384) return;
    const int hd = e >> 14, idx = e & 16383, d = hd & 1; const int ln = idx & 63, reg = (idx >> 6) & 3, kb = (idx >> 8) & 7; const int k = 16 * kb + 4 * (ln >> 4) + reg;
    const float* SU = sc_SU(F) + (size_t)hd * 64 * 16384 + idx; const float* SD = sc_SD(F) + hd * 64 * 128 + k; float* SS = sc_SS(F) + (size_t)hd * 64 * 16384 + idx;
    float S = sc_CARRY(F)[hd * 16384 + idx];
#pragma unroll 1
    for (int b_ = 0; b_ < 4; ++b_) { const int s0 = d == 0 ? 16 * b_ : 63 - 16 * b_, st = d == 0 ? 1 : -1; float u[16], dd[16];
#pragma unroll
        for (int i = 0; i < 16; ++i) { const int seg = s0 + st * i; u[i] = ((const GAS float*)SU)[(unsigned)seg * 16384u]; dd[i] = ((const GAS float*)SD)[seg * 128]; }
#pragma unroll
        for (int i = 0; i < 16; ++i) { const int seg = s0 + st * i; ((GAS float*)SS)[(unsigned)seg * 16384u] = S; S = dd[i] * S + u[i]; } }
}

__device__ __forceinline__ void ph_mixA(Frame& F, int l) {
    scanA_item(F, l, F.bid);
    if (F.bid >= 4 && F.bid < 12) { const int hd = F.bid - 4, h = hd >> 1;
        if (l == 0) { if (hd & 1) scan_dir_local<1>(F, l, h, 0, sc_CARRY(F) + hd * 16384); else scan_dir_local<0>(F, l, h, 0, sc_CARRY(F) + hd * 16384); }
        else { if (hd & 1) scan_states<1>(F, l, h, 0, sc_CARRY(F) + hd * 16384, nullptr); else scan_states<0>(F, l, h, 0, sc_CARRY(F) + hd * 16384, nullptr); }
        return; }
    fftA_item(F, F.bid);
    if (F.bid >= 12 && F.bid < 20) fftA_item(F, F.bid - 8);
    const int xg = 3 - (F.bid & 3);
    if (l == 0) { pool_item(F, l, F.bid); if (F.bid >= 20 && F.bid < 28) pool_item(F, l, (F.bid < 24 ? 4 : 8) + xg); else if (F.bid >= 28 && F.bid < 32) pool_item(F, l, 256 + xg); }
    else { pool_item(F, l, F.bid + 4); if (F.bid >= 20 && F.bid < 28) pool_item(F, l, (F.bid < 24 ? 8 : 12) + xg); }
}
__device__ __forceinline__ void ph_mixB(Frame& F, int l) {
    scanB(F);
    if (l == 0) {
        if (F.bid >= 232 && F.bid < 248) { ctx_finalize(F, l, (F.bid - 232) >> 2, (F.bid - 232) & 3); return; }
        if (F.bid >= 252) { fftC_item(F, F.bid - 252); return; }
        fftB_item(F, F.bid);
        if (F.bid >= 200 && F.bid < 216) fftB_item(F, F.bid + 32); else if (F.bid >= 216 && F.bid < 220) fftB_item(F, F.bid + 36);
    } else fftB_item(F, F.bid);
}
__device__ __forceinline__ void ph_mixC(Frame& F, int l) {
    const int item = F.bid, h = item >> 6, seg = item & 63;
    scan_full(F, l, h, CTX + 256 * seg, sc_SS(F) + ((size_t)(h * 2 + 0) * 64 + seg) * 16384, sc_SS(F) + ((size_t)(h * 2 + 1) * 64 + seg) * 16384, nullptr, nullptr);
}
#define GRID_BAR() do { Frame R_ = relaunder(F); xcd_barrier(bar, R_.tid); } while (0)
#define PHASE(call) do { Frame R = relaunder(F); call; } while (0)
__global__ void __launch_bounds__(NTHR, 2) mega_fwd(Params p) {
    extern __shared__ __attribute__((aligned(16))) unsigned char lds[];
    Frame F; frame_init(F, p, lds);
    if (F.tid < 16) ((LAS unsigned*)(F.lds + MISC_OFF))[F.tid] = 0u;
    __syncthreads();
    XcdBarrier bar = xcd_barrier_post((unsigned*)(F.ctl() + CW_BAR), (volatile LAS unsigned*)(F.lds + MISC_OFF + 32));
#pragma unroll 1
    for (int st_ = 0; st_ < 2; ++st_) { int st = __builtin_amdgcn_readfirstlane(st_); asm volatile("" : "+s"(st)); if (((st ^ F.bid) & 1) == 0) PHASE(ph_prologue(R)); else PHASE(ph_prologue2(R)); }
    PHASE(ph_mod1_wait(R)); PHASE(ph_mod1(R, 0));
    GRID_BAR();
#pragma unroll 1
    for (int l = 0; l < 2; ++l) {
        PHASE(ph_win(R, l));            GRID_BAR();
        PHASE(ph_mixA(R, l));           GRID_BAR();
        PHASE(ph_mixB(R, l));           GRID_BAR();
        PHASE(ph_mixC(R, l));           GRID_BAR();
        PHASE(ph_wout(R, l));           GRID_BAR();
        PHASE(ph_mod2_route(R, l, l));  GRID_BAR();
        PHASE(ph_gateup(R, l));         GRID_BAR();
        PHASE(ph_down(R, l));           GRID_BAR();
        PHASE(ph_combine(R, l));
        if (l == 0) GRID_BAR();
    }
    {
        Frame R = relaunder(F); LAS unsigned* fl = (LAS unsigned*)(R.lds + MISC_OFF + 16);
        __syncthreads();
        if (R.tid == 0) { asm volatile("s_waitcnt vmcnt(0)" ::: "memory"); const unsigned old = __hip_atomic_fetch_add((unsigned*)(R.ctl() + CW_DONE), 1u, RLX_AGENT); fl[0] = old == (unsigned)(R.G - 1) ? 1u : 0u; }
        __syncthreads();
        if (fl[0]) { for (int i = R.tid; i < (int)(CTL_ZERO_BYTES / 4); i += NTHR) R.ctl()[i] = 0u; }
    }
}
extern "C" void kernel_launch(void* const* d_in, const int* in_sizes, int n_in, void* d_out, int out_size, void* d_ws, size_t ws_size, hipStream_t stream) {
    static int ok = 0;
    if (ok == 0) {
        if (n_in != 22 || out_size != LAT * D || ws_size < WS_FASTEND) { fprintf(stderr, "kernel_launch: unexpected shapes / workspace (n_in %d, out %d, ws %zu < %zu); nothing launched\n", n_in, out_size, ws_size, (size_t)WS_FASTEND); ok = -1; return; }
        int dev = 0, cus = 0, per_cu = 0;
        if (hipGetDevice(&dev) != hipSuccess || hipDeviceGetAttribute(&cus, hipDeviceAttributeMultiprocessorCount, dev) != hipSuccess) { ok = -1; return; }
        if (hipFuncSetAttribute((const void*)mega_fwd, hipFuncAttributeMaxDynamicSharedMemorySize, LDS_BYTES) != hipSuccess) { fprintf(stderr, "kernel_launch: hipFuncSetAttribute failed\n"); ok = -1; return; }
        if (hipOccupancyMaxActiveBlocksPerMultiprocessor(&per_cu, (const void*)mega_fwd, NTHR, LDS_BYTES) != hipSuccess || per_cu < 1) fprintf(stderr, "kernel_launch: note: occupancy query reports %d workgroups per CU\n", per_cu);
        (void)hipGetLastError();
        if (cus < 256) fprintf(stderr, "kernel_launch: device has %d CUs; this kernel needs 256 co-resident workgroups (one per CU)\n", cus);
        ok = 1;
    }
    if (ok < 0) return;
    Params p{}; for (int i = 0; i < 22; ++i) p.in[i] = (const float*)d_in[i]; p.out = (float*)d_out; p.ws = (unsigned char*)d_ws;
    hipLaunchKernelGGL(mega_fwd, dim3(256), dim3(NTHR), LDS_BYTES, stream, p);
}
```
